# Optimizing an MI355X kernel written in HIP

```python
import math
import jax, jax.numpy as jnp
from jax import lax
import numpy as np

D_MODEL = 2048
BATCH = 8
SEQ = 2048
DEPTH = 1

MLA_HEADS = 8
QK_NOPE_DIM = 128
QK_ROPE_DIM = 64
QK_HEAD_DIM = QK_NOPE_DIM + QK_ROPE_DIM
V_HEAD_DIM = 128
Q_LORA_RANK = 512
KV_LORA_RANK = 256
ROPE_THETA = 10000.0
ATTN_BLOCK = 128
MLA_WIDTH = MLA_HEADS * V_HEAD_DIM

SSD_HEADS = 16
SSD_HEAD_DIM = 64
SSD_D_INNER = SSD_HEADS * SSD_HEAD_DIM
SSD_GROUPS = 2
SSD_STATE = 128
SSD_CONV = 4
SSD_CHUNK = 128
SSD_CONV_DIM = SSD_D_INNER + 2 * SSD_GROUPS * SSD_STATE

MIX_WIDTH = MLA_WIDTH + SSD_D_INNER

IN_SPLITS = (
    Q_LORA_RANK,
    Q_LORA_RANK + KV_LORA_RANK,
    Q_LORA_RANK + KV_LORA_RANK + QK_ROPE_DIM,
    Q_LORA_RANK + KV_LORA_RANK + QK_ROPE_DIM + SSD_D_INNER,
    Q_LORA_RANK + KV_LORA_RANK + QK_ROPE_DIM + SSD_D_INNER + SSD_CONV_DIM,
)
IN_COLS = Q_LORA_RANK + KV_LORA_RANK + QK_ROPE_DIM + SSD_D_INNER + SSD_CONV_DIM + SSD_HEADS

PEER_HEADS = 8
PEER_KEYS = 128
PEER_EXPERTS = PEER_KEYS * PEER_KEYS
PEER_TOPK = 16
PEER_KEY_DIM = 256
PEER_HALF = PEER_KEY_DIM // 2
PEER_TOKEN_BLOCK = 128

N_MOD = 6
EPS = 1e-6

kernel_name = "hybrid_mla_ssd_peer_adaln_block"


def rms_norm(x, gain=None):
    xf = x.astype(jnp.float32)
    y = xf * lax.rsqrt(jnp.mean(xf * xf, axis=-1, keepdims=True) + EPS)
    if gain is not None:
        y = y * gain.astype(jnp.float32)
    return y.astype(x.dtype)


def rope(x, positions):
    r = x.shape[-1]
    half = r // 2
    inv_freq = 1.0 / (ROPE_THETA ** (jnp.arange(half, dtype=jnp.float32) * (2.0 / r)))
    ang = positions.astype(jnp.float32)[:, :, None, None] * inv_freq
    cos, sin = jnp.cos(ang), jnp.sin(ang)
    xf = x.astype(jnp.float32)
    x1, x2 = xf[..., :half], xf[..., half:]
    return jnp.concatenate([x1 * cos - x2 * sin, x2 * cos + x1 * sin], axis=-1).astype(x.dtype)


def mla_attention(c_q, c_kv, k_rope, positions, q_a_norm, w_uq, kv_a_norm, w_ukv, q_norm, k_norm):
    b, s, _ = c_q.shape
    q = (rms_norm(c_q, q_a_norm) @ w_uq).reshape(b, s, MLA_HEADS, QK_HEAD_DIM)
    kv = (rms_norm(c_kv, kv_a_norm) @ w_ukv).reshape(b, s, MLA_HEADS, QK_NOPE_DIM + V_HEAD_DIM)
    k_nope, v = kv[..., :QK_NOPE_DIM], kv[..., QK_NOPE_DIM:]
    k_pe = jnp.broadcast_to(k_rope[:, :, None, :], (b, s, MLA_HEADS, QK_ROPE_DIM))
    k = jnp.concatenate([k_nope, k_pe], axis=-1)
    q = rms_norm(q, q_norm)
    k = rms_norm(k, k_norm)
    q = jnp.concatenate([q[..., :QK_NOPE_DIM], rope(q[..., QK_NOPE_DIM:], positions)], axis=-1)
    k = jnp.concatenate([k[..., :QK_NOPE_DIM], rope(k[..., QK_NOPE_DIM:], positions)], axis=-1)
    q = q.transpose(0, 2, 1, 3)
    k = k.transpose(0, 2, 1, 3)
    v = v.transpose(0, 2, 1, 3)
    scale = QK_HEAD_DIM ** -0.5
    outs = []
    for i in range(s // ATTN_BLOCK):
        lo = i * ATTN_BLOCK
        hi = lo + ATTN_BLOCK
        qb = q[:, :, lo:hi]
        kb = k[:, :, :hi]
        vb = v[:, :, :hi]
        sc = jnp.einsum('bhqd,bhkd->bhqk', qb, kb).astype(jnp.float32) * scale
        mask = jnp.arange(hi)[None, :] <= (lo + jnp.arange(ATTN_BLOCK))[:, None]
        sc = jnp.where(mask, sc, -jnp.inf)
        p = jax.nn.softmax(sc, axis=-1).astype(v.dtype)
        outs.append(jnp.einsum('bhqk,bhkd->bqhd', p, vb))
    o = jnp.concatenate(outs, axis=1)
    return o.reshape(b, s, MLA_WIDTH)


def causal_depthwise_conv(u, w, bias):
    ch = u.shape[-1]
    y = lax.conv_general_dilated(
        u, w[:, None, :].astype(u.dtype), window_strides=(1,), padding=[(SSD_CONV - 1, 0)],
        dimension_numbers=('NWC', 'WIO', 'NWC'), feature_group_count=ch)
    return y + bias


def segsum(a):
    n = a.shape[-1]
    cs = jnp.cumsum(a, axis=-1)
    diff = cs[..., :, None] - cs[..., None, :]
    mask = jnp.tril(jnp.ones((n, n), dtype=bool))
    return jnp.where(mask, diff, -jnp.inf)


def ssd_chunked(x, dt, a, bmat, cmat):
    b, s, h, p = x.shape
    n = bmat.shape[-1]
    nc = s // SSD_CHUNK
    xd = (x.astype(jnp.float32) * dt[..., None]).reshape(b, nc, SSD_CHUNK, h, p)
    a_dt = (dt * a).reshape(b, nc, SSD_CHUNK, h).transpose(0, 3, 1, 2)
    bc = bmat.astype(jnp.float32).reshape(b, nc, SSD_CHUNK, h, n)
    cc = cmat.astype(jnp.float32).reshape(b, nc, SSD_CHUNK, h, n)
    a_cs = jnp.cumsum(a_dt, axis=-1)
    decay = jnp.exp(segsum(a_dt))
    cb = jnp.einsum('bclhn,bcshn->bhcls', cc, bc) * decay
    y_diag = jnp.einsum('bhcls,bcshp->bclhp', cb, xd)
    decay_states = jnp.exp(a_cs[..., -1:] - a_cs)
    states = jnp.einsum('bclhn,bhcl,bclhp->bchpn', bc, decay_states, xd)
    chunk_decay = jnp.exp(a_cs[..., -1])

    def step(prev, inp):
        st, dec = inp
        return prev * dec[..., None, None] + st, prev

    init = jnp.zeros((b, h, p, n), jnp.float32)
    _, prev_states = lax.scan(step, init, (states.transpose(1, 0, 2, 3, 4), chunk_decay.transpose(2, 0, 1)))
    prev_states = prev_states.transpose(1, 0, 2, 3, 4)
    y_off = jnp.einsum('bclhn,bchpn,bhcl->bclhp', cc, prev_states, jnp.exp(a_cs))
    return (y_diag + y_off).reshape(b, s, h, p)


def ssd_mixer(z, xbc, dt_raw, conv_w, conv_b, dt_bias, a_log, d_skip, ssd_norm):
    b, s, _ = z.shape
    xbc = jax.nn.silu(causal_depthwise_conv(xbc, conv_w, conv_b))
    gn = SSD_GROUPS * SSD_STATE
    xs = xbc[..., :SSD_D_INNER].reshape(b, s, SSD_HEADS, SSD_HEAD_DIM)
    bm = xbc[..., SSD_D_INNER:SSD_D_INNER + gn].reshape(b, s, SSD_GROUPS, SSD_STATE)
    cm = xbc[..., SSD_D_INNER + gn:].reshape(b, s, SSD_GROUPS, SSD_STATE)
    rep = SSD_HEADS // SSD_GROUPS
    bm = jnp.repeat(bm, rep, axis=2)
    cm = jnp.repeat(cm, rep, axis=2)
    dt = jax.nn.softplus(dt_raw.astype(jnp.float32) + dt_bias.astype(jnp.float32))
    a = -jnp.exp(a_log.astype(jnp.float32))
    y = ssd_chunked(xs, dt, a, bm, cm) + xs.astype(jnp.float32) * d_skip.astype(jnp.float32)[:, None]
    y = y.reshape(b, s, SSD_D_INNER) * jax.nn.silu(z.astype(jnp.float32))
    gs = SSD_D_INNER // SSD_GROUPS
    y = rms_norm(y.reshape(b, s, SSD_GROUPS, gs), ssd_norm.reshape(SSD_GROUPS, gs))
    return y.reshape(b, s, SSD_D_INNER).astype(z.dtype)


def peer_ffn(h, w_query, sub_keys, u_experts, v_experts):
    b, s, d = h.shape
    t = b * s
    ht = h.reshape(t, d)
    q = (ht @ w_query).reshape(t, PEER_HEADS, 2, PEER_HALF)
    sc = jnp.einsum('thjd,hjkd->thjk', q, sub_keys).astype(jnp.float32)
    top_s, top_i = lax.top_k(sc, PEER_TOPK)
    cand_s = top_s[:, :, 0, :, None] + top_s[:, :, 1, None, :]
    cand_i = top_i[:, :, 0, :, None] * PEER_KEYS + top_i[:, :, 1, None, :]
    kk = PEER_TOPK * PEER_TOPK
    best_s, best_pos = lax.top_k(cand_s.reshape(t, PEER_HEADS, kk), PEER_TOPK)
    expert_idx = jnp.take_along_axis(cand_i.reshape(t, PEER_HEADS, kk), best_pos, axis=-1)
    gates = jax.nn.softmax(best_s, axis=-1)

    def block(args):
        hb, ib, gb = args
        u = jnp.take(u_experts, ib, axis=0)
        pre = jnp.einsum('thkd,td->thk', u, hb).astype(jnp.float32)
        act = (jax.nn.gelu(pre, approximate=False) * gb).astype(hb.dtype)
        vsel = jnp.take(v_experts, ib, axis=0)
        return jnp.einsum('thk,thkd->td', act, vsel)

    nb = t // PEER_TOKEN_BLOCK
    out = lax.map(block, (ht.reshape(nb, PEER_TOKEN_BLOCK, d),
                          expert_idx.reshape(nb, PEER_TOKEN_BLOCK, PEER_HEADS, PEER_TOPK),
                          gates.reshape(nb, PEER_TOKEN_BLOCK, PEER_HEADS, PEER_TOPK)))
    return out.reshape(b, s, d)


def setup_inputs(seed: int = 0) -> dict:
    key = jax.random.key(seed)
    ks = jax.random.split(key, 24)
    f32 = jnp.float32
    L = DEPTH

    def nrm(k, shape, scale):
        return jax.random.normal(k, shape, f32) * scale

    def gain(k, shape):
        return 1.0 + 0.02 * jax.random.normal(k, shape, f32)

    x = nrm(ks[0], (BATCH, SEQ, D_MODEL), 1.0)
    c = nrm(ks[1], (BATCH, D_MODEL), 1.0)
    offs = jax.random.randint(ks[2], (BATCH, 1), 0, 1024, dtype=jnp.int32)
    positions = jnp.arange(SEQ, dtype=jnp.int32)[None, :] + offs
    w_ada = nrm(ks[3], (L, D_MODEL, N_MOD * D_MODEL), 0.5 * D_MODEL ** -0.5)
    b_ada = nrm(ks[4], (L, N_MOD * D_MODEL), 0.02)
    w_in = nrm(ks[5], (L, D_MODEL, IN_COLS), D_MODEL ** -0.5)
    q_a_norm = gain(ks[6], (L, Q_LORA_RANK))
    w_uq = nrm(ks[7], (L, Q_LORA_RANK, MLA_HEADS * QK_HEAD_DIM), Q_LORA_RANK ** -0.5)
    kv_a_norm = gain(ks[8], (L, KV_LORA_RANK))
    w_ukv = nrm(ks[9], (L, KV_LORA_RANK, MLA_HEADS * (QK_NOPE_DIM + V_HEAD_DIM)), KV_LORA_RANK ** -0.5)
    q_norm = gain(ks[10], (L, QK_HEAD_DIM))
    k_norm = gain(ks[11], (L, QK_HEAD_DIM))
    attn_out_norm = gain(ks[12], (L, MLA_WIDTH))
    conv_w = nrm(ks[13], (L, SSD_CONV, SSD_CONV_DIM), SSD_CONV ** -0.5)
    conv_b = nrm(ks[14], (L, SSD_CONV_DIM), 0.02)
    dt0 = jnp.exp(jax.random.uniform(ks[15], (L, SSD_HEADS), f32, math.log(1e-3), math.log(1e-1)))
    dt_bias = dt0 + jnp.log(-jnp.expm1(-dt0))
    a_log = jnp.log(jax.random.uniform(ks[16], (L, SSD_HEADS), f32, 1.0, 16.0))
    d_skip = gain(ks[17], (L, SSD_HEADS))
    ssd_norm = gain(ks[18], (L, SSD_D_INNER))
    w_out = nrm(ks[19], (L, MIX_WIDTH, D_MODEL), MIX_WIDTH ** -0.5)
    w_query = nrm(ks[20], (L, D_MODEL, PEER_HEADS * PEER_KEY_DIM), D_MODEL ** -0.5)
    sub_keys = nrm(ks[21], (L, PEER_HEADS, 2, PEER_KEYS, PEER_HALF), PEER_HALF ** -0.5)
    u_experts = nrm(ks[22], (L, PEER_EXPERTS, D_MODEL), D_MODEL ** -0.5)
    v_experts = nrm(ks[23], (L, PEER_EXPERTS, D_MODEL), 0.5)
    return {"x": x, "c": c, "positions": positions, "w_ada": w_ada, "b_ada": b_ada, "w_in": w_in,
            "q_a_norm": q_a_norm, "w_uq": w_uq, "kv_a_norm": kv_a_norm, "w_ukv": w_ukv,
            "q_norm": q_norm, "k_norm": k_norm, "attn_out_norm": attn_out_norm,
            "conv_w": conv_w, "conv_b": conv_b, "dt_bias": dt_bias, "a_log": a_log,
            "d_skip": d_skip, "ssd_norm": ssd_norm, "w_out": w_out, "w_query": w_query,
            "sub_keys": sub_keys, "u_experts": u_experts, "v_experts": v_experts}


def reference(x, c, positions, w_ada, b_ada, w_in, q_a_norm, w_uq, kv_a_norm, w_ukv, q_norm, k_norm,
              attn_out_norm, conv_w, conv_b, dt_bias, a_log, d_skip, ssd_norm, w_out, w_query,
              sub_keys, u_experts, v_experts):
    c_act = jax.nn.silu(c)
    for l in range(DEPTH):
        mod = (c_act @ w_ada[l] + b_ada[l])[:, None, :]
        sh1, sc1, g1, sh2, sc2, g2 = jnp.split(mod, N_MOD, axis=-1)
        h = rms_norm(x) * (1.0 + sc1) + sh1
        proj = h @ w_in[l]
        c_q, c_kv, k_rope, z, xbc, dt_raw = jnp.split(proj, IN_SPLITS, axis=-1)
        attn = mla_attention(c_q, c_kv, k_rope, positions, q_a_norm[l], w_uq[l], kv_a_norm[l], w_ukv[l],
                             q_norm[l], k_norm[l])
        attn = rms_norm(attn, attn_out_norm[l])
        ssm = ssd_mixer(z, xbc, dt_raw, conv_w[l], conv_b[l], dt_bias[l], a_log[l], d_skip[l], ssd_norm[l])
        mix = jnp.concatenate([attn, ssm], axis=-1) @ w_out[l]
        x = x + g1 * mix
        h2 = rms_norm(x) * (1.0 + sc2) + sh2
        x = x + g2 * peer_ffn(h2, w_query[l], sub_keys[l], u_experts[l], v_experts[l])
    return x
```

```cpp
#include <hip/hip_runtime.h>
#include <cstdint>
#include <cstdio>
#include <cmath>

constexpr int DM = 2048, NB = 8, SEQ = 2048, T = NB * SEQ;
constexpr int IN_COLS = 3408, NPROJ = 3584;
constexpr int C_CQ = 0, C_CKV = 512, C_KR = 768, C_Z = 832, C_XBC = 1856, C_DT = 3392;
constexpr int NQ = 1536, NKV = 2048;
constexpr float EPS = 1e-6f;
constexpr int NTHR = 512, NWAVES = 8;

typedef unsigned short bf16_t;
typedef unsigned u32x4 __attribute__((ext_vector_type(4)));
typedef float f32x4 __attribute__((ext_vector_type(4)));
typedef unsigned u32x2 __attribute__((ext_vector_type(2)));
#define GAS __attribute__((address_space(1)))
#define LAS __attribute__((address_space(3)))
typedef GAS unsigned gu32;
typedef GAS unsigned long long gu64;
#define RLX_AGENT __ATOMIC_RELAXED, __HIP_MEMORY_SCOPE_AGENT

__device__ __forceinline__ unsigned f2bf(float f) { unsigned u = __builtin_bit_cast(unsigned, f); return (u + 0x7fffu + ((u >> 16) & 1u)) >> 16; }
__device__ __forceinline__ float bf2f(unsigned h) { return __builtin_bit_cast(float, h << 16); }
__device__ __forceinline__ unsigned pk2(float lo, float hi) { return f2bf(lo) | (f2bf(hi) << 16); }
__device__ __forceinline__ float bflo(unsigned w) { return __builtin_bit_cast(float, w << 16); }
__device__ __forceinline__ float bfhi(unsigned w) { return __builtin_bit_cast(float, w & 0xffff0000u); }
__device__ __forceinline__ float silu_f(float v) { return v / (1.f + __expf(-v)); }
__device__ __forceinline__ float wave_sum(float v) {
#pragma unroll
    for (int o = 1; o < 64; o <<= 1) v += __shfl_xor(v, o);
    return v;
}

constexpr size_t MiB = 1u << 20;
constexpr size_t WS_CTL = 0, CTL_ZERO_BYTES = 64 * 1024, WS_MOD = 1 * MiB, WS_ROPEC = 2 * MiB, WS_ROPES = 4 * MiB, WS_SUBK = 6 * MiB, WS_WUQT = 7 * MiB, WS_WUKVT = 9 * MiB,
                 WS_WINT = 10 * MiB, WS_WOUTT = 24 * MiB, WS_WQT = 32 * MiB,
                 WS_US = 40 * MiB, WS_VS = 41 * MiB, WS_CS = 50 * MiB, WS_DT = 51 * MiB, WS_IDX = 52 * MiB, WS_GATE = 60 * MiB, WS_U16 = 68 * MiB, WS_V16 = 132 * MiB, WS_U8 = 68 * MiB, WS_V8 = 100 * MiB, WS_U4 = 420 * MiB, WS_V4 = 440 * MiB,
                 WS_K = 68 * MiB, WS_YSSD = 68 * MiB, WS_XBCA = 116 * MiB, WS_ATTN = 164 * MiB,
                 WS_H = 196 * MiB, WS_Q = 196 * MiB, WS_MIXIN = 196 * MiB, WS_H2 = 196 * MiB,
                 WS_PROJ = 260 * MiB, WS_QP = 260 * MiB, WS_QRAW = 372 * MiB, WS_KVRAW = 420 * MiB, WS_V = 484 * MiB, WS_END = 516 * MiB;
constexpr int CW_BAR = 1024;

struct Params {
    const float *x, *c; const int* pos;
    const float *w_ada, *b_ada, *w_in, *q_a_norm, *w_uq, *kv_a_norm, *w_ukv, *q_norm, *k_norm, *attn_out_norm, *conv_w, *conv_b, *dt_bias, *a_log,
        *d_skip, *ssd_norm, *w_out, *w_query, *sub_keys, *u_exp, *v_exp;
    float* out; unsigned char* ws;
    int ph_lo, ph_hi;
};
namespace pg8 {
#define PG8_LAS __attribute__((address_space(3)))
typedef unsigned short bf16_t;
typedef short bf16x8 __attribute__((ext_vector_type(8)));
typedef float f32x4 __attribute__((ext_vector_type(4)));
typedef unsigned u32x4 __attribute__((ext_vector_type(4)));
constexpr int BM = 256, BK = 64, HALF = 128, HTB = HALF * BK * 2  , STAGE_BYTES = 8 * HTB, NXCD = 8, WGM = 8;

__host__ __device__ __forceinline__ int lds_byte(int r, int c) { const int st = (r >> 4) * 2 + (c >> 5), rr = r & 15, cc = c & 31, ob = rr * 64 + cc * 2; return st * 1024 + (ob ^ (((ob >> 9) & 1) << 5)); }
__host__ __device__ __forceinline__ void stage_rc(int b, int& R, int& C) { const int st = b / 1024, sb = b % 1024, swz = sb ^ (((sb >> 9) & 1) << 5); R = (st >> 1) * 16 + swz / 64; C = (st & 1) * 32 + (swz % 64) / 2; }
__host__ __device__ __forceinline__ int perm32(int rho) { const int n = rho >> 4, i = rho & 15; return 8 * (i >> 2) + 4 * n + (i & 3); }

struct Unit { int pm, pn; };
struct Gemm { const bf16_t* A; const bf16_t* Bt; int M, N, K, lda; };

struct StaticOrder {
    int nM, nN, nwg, G, c;
    __host__ __device__ void init(int M, int N, int G_, int c_) { nM = M / BM; nN = N / BM; nwg = nM * nN; G = G_; c = c_; }
    __host__ __device__ bool next(int i, Unit& u) const {
        const long L = (long)i * G + c; if (L >= nwg) return false;
        int wgid = (int)L; { const int q = nwg / NXCD, r = nwg % NXCD, xcd = wgid % NXCD, off = wgid / NXCD; wgid = (xcd < r ? xcd * (q + 1) : r * (q + 1) + (xcd - r) * q) + off; }
        const int nig = WGM * nN, gid = wgid / nig, fm = gid * WGM, gsz = (nM - fm) < WGM ? (nM - fm) : WGM;
        u.pm = fm + ((wgid % nig) % gsz); u.pn = (wgid % nig) / gsz; return true;
    }
    __device__ __forceinline__ void a_ready(const Unit&) const {}
    __device__ __forceinline__ void done(const Unit&) const {}
};

__device__ __forceinline__ unsigned cvt_pk_bf16(float lo, float hi) { unsigned r; asm volatile("v_cvt_pk_bf16_f32 %0, %1, %2" : "=v"(r) : "v"(lo), "v"(hi)); return r; }
typedef float f32x2 __attribute__((ext_vector_type(2)));
__device__ __forceinline__ f32x2 gelu_pk(f32x2 v) {
    const f32x2 av = __builtin_elementwise_abs(v), d = av * 0.2316418882f + 1.0f;
    f32x2 t; t.x = __builtin_amdgcn_rcpf(d.x); t.y = __builtin_amdgcn_rcpf(d.y);
    f32x2 q = t * 0.5307027145f + (-0.7265760135f); q = q * t + 0.7107068705f; q = q * t + (-0.142248368f); q = q * t + 0.127414796f; q = q * t;
    const f32x2 s = (v * v) * (-0.72134752044f);
    f32x2 e; e.x = __builtin_amdgcn_exp2f(s.x); e.y = __builtin_amdgcn_exp2f(s.y);
    const f32x2 m = v * (q * e), r = v - m;
    f32x2 o; o.x = v.x < 0.f ? m.x : r.x; o.y = v.y < 0.f ? m.y : r.y; return o;
}

template <int ACT  > struct EpiBf16 {
    static constexpr bool PERM = true, AFTER_DRAIN = false; static_assert(ACT == 0 || ACT == 1, "EpiBf16: ACT is 0 (none) or 1 (gelu_pk)");
    bf16_t* O; int ldc; const float* bias; int split_cols; size_t split_stride; float scale0;
    __device__ __forceinline__ void operator()(const f32x4 (&acc)[2][2][4][2], const Unit& u, int wr, int wc, int fr, int fq) const {
        const int row0 = u.pm * BM + wr * 64 + fr; int colt = u.pn * BM; bf16_t* base = O;
        float sc = 1.f; if (split_cols) { const int t = colt / split_cols; base += (size_t)t * split_stride; colt -= t * split_cols; if (t == 0) sc = scale0; }
        const int col0 = colt + wc * 32 + 8 * fq, bcol0 = u.pn * BM + wc * 32 + 8 * fq;
        f32x4 bv[2][2];
#pragma unroll
        for (int bj = 0; bj < 2; ++bj)
#pragma unroll
            for (int n = 0; n < 2; ++n) bv[bj][n] = bias ? *(const f32x4*)(bias + bcol0 + bj * HALF + 4 * n) : (f32x4){0.f, 0.f, 0.f, 0.f};
#pragma unroll
        for (int ai = 0; ai < 2; ++ai)
#pragma unroll
            for (int m = 0; m < 4; ++m) { bf16_t* rowp = base + (size_t)(row0 + ai * HALF + m * 16) * ldc + col0;
#pragma unroll
                for (int bj = 0; bj < 2; ++bj) { f32x4 v0 = acc[ai][bj][m][0] + bv[bj][0], v1 = acc[ai][bj][m][1] + bv[bj][1];
                    if (ACT == 1) { f32x2 a = gelu_pk((f32x2){v0[0], v0[1]}), b = gelu_pk((f32x2){v0[2], v0[3]}), c = gelu_pk((f32x2){v1[0], v1[1]}), d = gelu_pk((f32x2){v1[2], v1[3]});
                        v0 = (f32x4){a.x, a.y, b.x, b.y}; v1 = (f32x4){c.x, c.y, d.x, d.y}; }
                    v0 = v0 * sc; v1 = v1 * sc; u32x4 w; w.x = cvt_pk_bf16(v0[0], v0[1]); w.y = cvt_pk_bf16(v0[2], v0[3]); w.z = cvt_pk_bf16(v1[0], v1[1]); w.w = cvt_pk_bf16(v1[2], v1[3]);
                    *(u32x4*)(rowp + bj * HALF) = w; } }
    }
};
struct EpiResid {
    static constexpr bool PERM = false, AFTER_DRAIN = false;
    const float* resid; float* out; const float* gate; int ldc, rows_per_batch, gate_stride;
    __device__ __forceinline__ void operator()(const f32x4 (&acc)[2][2][4][2], const Unit& u, int wr, int wc, int fr, int fq) const {
        const int col0 = u.pn * BM + wc * 32 + 4 * fq;
        const int b = (u.pm * BM) / rows_per_batch;
        f32x4 gv[2][2];
#pragma unroll
        for (int bj = 0; bj < 2; ++bj)
#pragma unroll
            for (int n = 0; n < 2; ++n) gv[bj][n] = *(const f32x4*)(gate + (size_t)b * gate_stride + col0 + bj * HALF + n * 16);
#pragma unroll
        for (int ai = 0; ai < 2; ++ai)
#pragma unroll
            for (int m = 0; m < 4; ++m) {
                const size_t off = (size_t)(u.pm * BM + ai * HALF + wr * 64 + m * 16 + fr) * ldc + col0;
#pragma unroll
                for (int bj = 0; bj < 2; ++bj)
#pragma unroll
                    for (int n = 0; n < 2; ++n) {
                        const f32x4 bs = *(const f32x4*)(resid + off + bj * HALF + n * 16);
                        *(f32x4*)(out + off + bj * HALF + n * 16) = bs + gv[bj][n] * acc[ai][bj][m][n];
                    }
                if (m & 1) asm volatile("" ::: "memory");
            }
    }
};
template <class Epi, class Sched, bool ALIGN_EPI = false, bool SP2 = false>
__device__ __forceinline__ void gemm_phase(PG8_LAS unsigned char* lds, const Gemm g, const Sched& S, const Epi& E) {
    const int tid = threadIdx.x, wid = __builtin_amdgcn_readfirstlane(tid >> 6), lane = tid & 63, wr = wid >> 2, wc = wid & 3, fr = lane & 15, fq = lane >> 4;
    const int K = g.K, nt = K / BK;
    unsigned voffA[2], voffB[2];
#pragma unroll
    for (int i = 0; i < 2; ++i) { int R, C; stage_rc(tid * 16 + i * 8192, R, C); const int Rb = Epi::PERM ? ((R & ~31) + perm32(R & 31)) : R;
        voffA[i] = (unsigned)(R * g.lda + C) * 2u; voffB[i] = (unsigned)(Rb * K + C) * 2u; }
    const size_t kstep = (size_t)(BK * 2);
    const size_t hstep = (size_t)HALF * K * 2;
    const size_t tstep = 2 * hstep; const size_t hstepA = (size_t)HALF * g.lda * 2, tstepA = 2 * hstepA;
    const unsigned ldsw = (unsigned)wid * 1024u;
    const int aoff = lds_byte(wr * 64 + fr, fq * 8), boff = lds_byte(wc * 32 + fr, fq * 8);
#define PG8_SA(b, h) (((b) * 2 + (h)) * HTB)
#define PG8_SB(b, h) ((4 + (b) * 2 + (h)) * HTB)
#define PG8_STAGE(bufoff, gbase, voff) do { _Pragma("unroll") for (int _i = 0; _i < 2; ++_i) \
        __builtin_amdgcn_global_load_lds((const unsigned*)((const char*)(gbase) + (voff)[_i]), (PG8_LAS unsigned*)(lds + (bufoff) + ldsw + _i * 8192), 16, 0, 0); } while (0)
#define PG8_LDA(dst, b, h) do { _Pragma("unroll") for (int m = 0; m < 4; ++m) _Pragma("unroll") for (int k = 0; k < 2; ++k) dst[m][k] = *(const PG8_LAS bf16x8*)(lds + PG8_SA(b, h) + aoff + m * 2048 + k * 1024); } while (0)
#define PG8_LDB(dst, b, h) do { _Pragma("unroll") for (int n = 0; n < 2; ++n) _Pragma("unroll") for (int k = 0; k < 2; ++k) dst[n][k] = *(const PG8_LAS bf16x8*)(lds + PG8_SB(b, h) + boff + n * 2048 + k * 1024); } while (0)
#define PG8_MMA(ai, bj, At, Bt) do { __builtin_amdgcn_s_setprio(1); _Pragma("unroll") for (int m = 0; m < 4; ++m) _Pragma("unroll") for (int n = 0; n < 2; ++n) _Pragma("unroll") for (int k = 0; k < 2; ++k) \
        acc[ai][bj][m][n] = __builtin_amdgcn_mfma_f32_16x16x32_bf16(Bt[n][k], At[m][k], acc[ai][bj][m][n], 0, 0, 0); __builtin_amdgcn_s_setprio(0); } while (0)
#define PG8_WAIT_V(n) asm volatile("s_waitcnt vmcnt(" #n ")" ::: "memory")
#define PG8_WAIT_L(n) asm volatile("s_waitcnt lgkmcnt(" #n ")" ::: "memory")
#define PG8_BAR __builtin_amdgcn_s_barrier()
#define PG8_SCHED __builtin_amdgcn_sched_barrier(0)
    Unit cur, nxt; int ui = 0;
    if (!S.next(0, cur)) return;
    f32x4 acc[2][2][4][2];
#pragma unroll
    for (int a = 0; a < 2; ++a)
#pragma unroll
        for (int b = 0; b < 2; ++b)
#pragma unroll
            for (int m = 0; m < 4; ++m)
#pragma unroll
                for (int n = 0; n < 2; ++n) acc[a][b][m][n] = (f32x4){0.f, 0.f, 0.f, 0.f};
    bf16x8 At[4][2], B0[2][2], B1[2][2];
    const char* cA = (const char*)g.A + (size_t)cur.pm * tstepA; const char* cB = (const char*)g.Bt + (size_t)cur.pn * tstep;
    S.a_ready(cur);
    if constexpr (SP2) {
        PG8_STAGE(PG8_SB(0, 0), cB, voffB); PG8_STAGE(PG8_SB(0, 1), cB + hstep, voffB); PG8_STAGE(PG8_SA(0, 0), cA, voffA); PG8_STAGE(PG8_SA(0, 1), cA + hstepA, voffA);
        if (wr == 1) PG8_BAR;
        PG8_WAIT_V(2); PG8_BAR;
        PG8_STAGE(PG8_SB(1, 0), cB + kstep, voffB); PG8_STAGE(PG8_SA(1, 0), cA + kstep, voffA); PG8_STAGE(PG8_SB(1, 1), cB + hstep + kstep, voffB);
        PG8_WAIT_V(6); PG8_BAR;
    } else {
        PG8_STAGE(PG8_SB(0, 0), cB, voffB); PG8_STAGE(PG8_SA(0, 0), cA, voffA); PG8_STAGE(PG8_SB(0, 1), cB + hstep, voffB); PG8_STAGE(PG8_SA(0, 1), cA + hstepA, voffA);
        if (wr == 1) PG8_BAR;
        PG8_WAIT_V(4); PG8_BAR;
        PG8_STAGE(PG8_SB(1, 0), cB + kstep, voffB); PG8_STAGE(PG8_SA(1, 0), cA + kstep, voffA); PG8_STAGE(PG8_SB(1, 1), cB + hstep + kstep, voffB);
        PG8_WAIT_V(6); PG8_BAR;
    }
    for (;;) {
        const bool has_next = S.next(ui + 1, nxt);
        const char* nA = has_next ? (const char*)g.A + (size_t)nxt.pm * tstepA : cA; const char* nB = has_next ? (const char*)g.Bt + (size_t)nxt.pn * tstep : cB;
        for (int t = 0; t < nt; t += 2) {
            const bool last = (t == nt - 2);
            const char* a1 = cA + (size_t)(t + 1) * kstep;
            const char* a2 = last ? nA : cA + (size_t)(t + 2) * kstep; const char* b2 = last ? nB : cB + (size_t)(t + 2) * kstep;
            const char* a3 = a2 + kstep; const char* b3 = b2 + kstep;
            if (last && has_next) S.a_ready(nxt);
            if constexpr (SP2) {
            PG8_LDB(B0, 0, 0); PG8_LDB(B1, 0, 1); PG8_SCHED; PG8_LDA(At, 0, 0); PG8_STAGE(PG8_SA(1, 1), a1 + hstepA, voffA);
            PG8_WAIT_V(8); PG8_WAIT_L(0); PG8_BAR; PG8_MMA(0, 0, At, B0); PG8_MMA(0, 1, At, B1); PG8_BAR; PG8_SCHED;
            PG8_LDA(At, 0, 1); PG8_STAGE(PG8_SB(0, 0), b2, voffB); PG8_STAGE(PG8_SB(0, 1), b2 + hstep, voffB); PG8_STAGE(PG8_SA(0, 0), a2, voffA);
            PG8_WAIT_V(8); PG8_WAIT_L(0); PG8_BAR; PG8_MMA(1, 0, At, B0); PG8_MMA(1, 1, At, B1); PG8_BAR; PG8_SCHED;
            PG8_LDB(B0, 1, 0); PG8_LDB(B1, 1, 1); PG8_SCHED; PG8_LDA(At, 1, 0); PG8_STAGE(PG8_SA(0, 1), a2 + hstepA, voffA);
            PG8_WAIT_V(8); PG8_WAIT_L(0); PG8_BAR; PG8_MMA(0, 0, At, B0); PG8_MMA(0, 1, At, B1); PG8_BAR; PG8_SCHED;
            PG8_LDA(At, 1, 1); PG8_STAGE(PG8_SB(1, 0), b3, voffB); PG8_STAGE(PG8_SB(1, 1), b3 + hstep, voffB); PG8_STAGE(PG8_SA(1, 0), a3, voffA);
            PG8_WAIT_V(8); PG8_WAIT_L(0); PG8_BAR; PG8_MMA(1, 0, At, B0); PG8_MMA(1, 1, At, B1); PG8_BAR; PG8_SCHED;
            } else {
            PG8_LDB(B0, 0, 0); PG8_SCHED; PG8_LDA(At, 0, 0); PG8_STAGE(PG8_SA(1, 1), a1 + hstepA, voffA);
            PG8_WAIT_L(8); PG8_BAR; PG8_WAIT_L(0); PG8_MMA(0, 0, At, B0); PG8_BAR; PG8_SCHED;
            PG8_LDB(B1, 0, 1); PG8_STAGE(PG8_SB(0, 0), b2, voffB);
            PG8_BAR; PG8_WAIT_L(0); PG8_MMA(0, 1, At, B1); PG8_BAR;
            PG8_LDA(At, 0, 1); PG8_STAGE(PG8_SA(0, 0), a2, voffA);
            PG8_BAR; PG8_WAIT_L(0); PG8_MMA(1, 0, At, B0); PG8_BAR; PG8_SCHED;
            PG8_STAGE(PG8_SB(0, 1), b2 + hstep, voffB);
            PG8_WAIT_V(6); PG8_BAR; PG8_MMA(1, 1, At, B1); PG8_BAR;
            PG8_LDB(B0, 1, 0); PG8_SCHED; PG8_LDA(At, 1, 0); PG8_STAGE(PG8_SA(0, 1), a2 + hstepA, voffA);
            PG8_WAIT_L(8); PG8_BAR; PG8_WAIT_L(0); PG8_MMA(0, 0, At, B0); PG8_BAR; PG8_SCHED;
            PG8_LDB(B1, 1, 1); PG8_STAGE(PG8_SB(1, 0), b3, voffB);
            PG8_BAR; PG8_WAIT_L(0); PG8_MMA(0, 1, At, B1); PG8_BAR;
            PG8_LDA(At, 1, 1); PG8_STAGE(PG8_SA(1, 0), a3, voffA);
            PG8_BAR; PG8_WAIT_L(0); PG8_MMA(1, 0, At, B0); PG8_BAR; PG8_SCHED;
            PG8_STAGE(PG8_SB(1, 1), b3 + hstep, voffB);
            PG8_WAIT_V(6); PG8_BAR; PG8_MMA(1, 1, At, B1); PG8_BAR;
            }
        }
        if constexpr (ALIGN_EPI) { if (wr == 0) PG8_BAR; }
        if constexpr (!Epi::AFTER_DRAIN) { E(acc, cur, wr, wc, fr, fq); S.done(cur); }
        if (!has_next) break;
#pragma unroll
        for (int a = 0; a < 2; ++a)
#pragma unroll
            for (int b = 0; b < 2; ++b)
#pragma unroll
                for (int m = 0; m < 4; ++m)
#pragma unroll
                    for (int n = 0; n < 2; ++n) acc[a][b][m][n] = (f32x4){0.f, 0.f, 0.f, 0.f};
        cur = nxt; cA = nA; cB = nB; ++ui;
        if constexpr (ALIGN_EPI) { if (wr == 1) PG8_BAR; }
    }
    PG8_WAIT_V(0);
    if constexpr (!ALIGN_EPI) { if (wr == 0) PG8_BAR; }
    PG8_BAR;
    if constexpr (Epi::AFTER_DRAIN) { E.fused(acc, cur, wr, wc, fr, fq, lds, wid, lane); S.done(cur); }
#undef PG8_SA
#undef PG8_SB
#undef PG8_STAGE
#undef PG8_LDA
#undef PG8_LDB
#undef PG8_MMA
#undef PG8_WAIT_V
#undef PG8_WAIT_L
#undef PG8_BAR
#undef PG8_SCHED
}
}
#define LDS_WAIT() asm volatile("s_waitcnt lgkmcnt(0)" ::: "memory")
#define XB_TMO      128
#define XB_XCNT(j)  (256  + 64 * (j))
#define XB_XSUB(j)  (1280 + 64 * (j))
#define XB_XGEN(j)  (2304 + 64 * (j))
#define XB_TOP      3328
#define XB_TOPGEN   3392
#define XCD_BAR_WORDS 3456
#define XB_SPIN_CAP (1u << 18)

__device__ __forceinline__ unsigned xb_ld(unsigned* p)              { return __hip_atomic_load(p, __ATOMIC_RELAXED, __HIP_MEMORY_SCOPE_AGENT); }
__device__ __forceinline__ unsigned xb_add(unsigned* p, unsigned v) { return __hip_atomic_fetch_add(p, v, __ATOMIC_RELAXED, __HIP_MEMORY_SCOPE_AGENT); }
__device__ __forceinline__ unsigned xb_xcc_id() { return (unsigned)__builtin_amdgcn_s_getreg((3 << 11) | 20) & 0xFu; }
#define XB_SPIN(cond, bar) do { unsigned _sp = 0; while (cond) { __builtin_amdgcn_s_sleep(1); \
    if ((++_sp & 255u) == 0u) { if (xb_ld(&(bar)[XB_TMO])) break; if (_sp > XB_SPIN_CAP) { atomicAdd(&(bar)[XB_TMO], 1u); break; } } } } while (0)

struct XcdBarrier {
    unsigned* bar; unsigned x;
    volatile LAS unsigned* st;
};

__device__ __forceinline__ XcdBarrier xcd_barrier_post(unsigned* bar, volatile LAS unsigned* st) {
    XcdBarrier b; b.bar = bar; b.x = xb_xcc_id(); b.st = st;
    if (threadIdx.x == 0) (void)xb_add(&bar[XB_XCNT(b.x)], 1u);
    return b;
}
__device__ __forceinline__ void xcd_barrier_complete(unsigned* bar, unsigned x, unsigned& nloc, unsigned& nx) {
    const unsigned G = gridDim.x * gridDim.y * gridDim.z;
    unsigned sum, cnt, mine, sp = 0u;
    for (;;) {
        sum = 0u; cnt = 0u; mine = 0u;
#pragma unroll
        for (unsigned j = 0; j < 16; ++j) { const unsigned c = xb_ld(&bar[XB_XCNT(j)]); sum += c; cnt += (c > 0u) ? 1u : 0u; mine = (j == x) ? c : mine; }
        if (sum == G) break;
        __builtin_amdgcn_s_sleep(1);
        if ((++sp & 255u) == 0u) { if (xb_ld(&bar[XB_TMO])) break; if (sp > XB_SPIN_CAP) { atomicAdd(&bar[XB_TMO], 1u); break; } }
    }
    nloc = mine > 0u ? mine : 1u; nx = cnt > 0u ? cnt : 1u;
}

__device__ __forceinline__ void xcd_barrier(const XcdBarrier& b) {
    asm volatile("s_waitcnt vmcnt(0)" ::: "memory");
    __syncthreads();
    if (threadIdx.x == 0) {
        unsigned* bar = b.bar;
        __builtin_amdgcn_s_waitcnt(0);
        unsigned nloc = b.st[0], nx = b.st[1];
        if (nloc == 0u) { xcd_barrier_complete(bar, b.x, nloc, nx); b.st[0] = nloc; b.st[1] = nx; }
        const unsigned old = xb_add(&bar[XB_XSUB(b.x)], 1u);
        const unsigned gen = old / nloc;
        if (old + 1u == (gen + 1u) * nloc) {
            __builtin_amdgcn_fence(__ATOMIC_RELEASE, "agent");
            asm volatile("s_waitcnt vmcnt(0)" ::: "memory");
            const unsigned og = xb_add(&bar[XB_TOP], 1u);
            const unsigned tg = og / nx;
            if (og + 1u == (tg + 1u) * nx) xb_add(&bar[XB_TOPGEN], 1u);
            else XB_SPIN(xb_ld(&bar[XB_TOPGEN]) == tg, bar);
            __builtin_amdgcn_fence(__ATOMIC_ACQUIRE, "agent");
            xb_add(&bar[XB_XGEN(b.x)], 1u);
            asm volatile("s_waitcnt vmcnt(0)" ::: "memory");
        } else {
            XB_SPIN(xb_ld(&bar[XB_XGEN(b.x)]) == gen, bar);
            __builtin_amdgcn_fence(__ATOMIC_ACQUIRE, "agent");
            asm volatile("s_waitcnt vmcnt(0)" ::: "memory");
        }
    }
    __syncthreads();
}
#define SYNC() __syncthreads()
__device__ __forceinline__ float sq2(unsigned w) { const float a = bflo(w), b = bfhi(w); return a * a + b * b; }

__device__ __forceinline__ void ph_mod(const Params& p, unsigned char* lds, int tid, int vb) {
    float* cact = (float*)lds; float* red = (float*)(lds + 65536);
    const int lane = tid & 63, wv = tid >> 6, c4 = lane & 31, kh = lane >> 5;
    for (int i = tid; i < NB * DM; i += NTHR) { const int b = i / DM, k = i % DM; cact[k * NB + b] = silu_f(p.c[i]); }
    SYNC();
    const int n = vb * 128 + 4 * c4;
    f32x4 acc[NB];
#pragma unroll
    for (int b = 0; b < NB; ++b) acc[b] = (f32x4){0.f, 0.f, 0.f, 0.f};
    const float* w = p.w_ada + (size_t)(wv * 256 + kh) * (6 * DM) + n;
#pragma unroll 8
    for (int i = 0; i < 128; ++i) {
        const f32x4 wk = *(const f32x4*)(w + (size_t)(2 * i) * (6 * DM));
        const f32x4 ca = *(const f32x4*)(cact + (wv * 256 + 2 * i + kh) * NB), cb = *(const f32x4*)(cact + (wv * 256 + 2 * i + kh) * NB + 4);
        acc[0] += wk * ca.x; acc[1] += wk * ca.y; acc[2] += wk * ca.z; acc[3] += wk * ca.w; acc[4] += wk * cb.x; acc[5] += wk * cb.y; acc[6] += wk * cb.z; acc[7] += wk * cb.w;
    }
#pragma unroll
    for (int b = 0; b < NB; ++b) { acc[b].x += __shfl_xor(acc[b].x, 32); acc[b].y += __shfl_xor(acc[b].y, 32); acc[b].z += __shfl_xor(acc[b].z, 32); acc[b].w += __shfl_xor(acc[b].w, 32); }
    if (lane < 32) {
#pragma unroll
        for (int b = 0; b < NB; ++b) *(f32x4*)(red + (wv * NB + b) * 128 + 4 * c4) = acc[b];
    }
    SYNC();
    for (int o = tid; o < NB * 128; o += NTHR) {
        const int b = o >> 7, col = o & 127;
        float s = p.b_ada[vb * 128 + col];
#pragma unroll
        for (int w8 = 0; w8 < 8; ++w8) s += red[(w8 * NB + b) * 128 + col];
        ((float*)(p.ws + WS_MOD))[b * 6 * DM + vb * 128 + col] = s;
    }
    SYNC();
}
__device__ __forceinline__ void ph_rope_tab(const Params& p, int gtid, int gn) {
    for (int i = gtid; i < T * 32; i += gn) {
        const int t = i >> 5, f = i & 31;
        const float inv = 1.0f / powf(10000.0f, (float)f * (2.0f / 64.0f));
        const float ang = (float)p.pos[t] * inv;
        ((float*)(p.ws + WS_ROPEC))[i] = (float)cos((double)ang);
        ((float*)(p.ws + WS_ROPES))[i] = (float)sin((double)ang);
    }
}
__device__ __forceinline__ void tr_item(const float* W, int K, int N, int Npad, bf16_t* WT, const float* g0, const float* g1, int gs, float* scr, int item, int lane) {
    const int nblk = Npad / 128, kb = item / nblk, nb = item % nblk, k0 = 32 * kb, n0 = 128 * nb;
    const int c4 = lane & 31, kh = lane >> 5, n = n0 + 4 * c4; const bool ok = n < N;
#pragma unroll 8
    for (int i = 0; i < 16; ++i) {
        const int kk = 2 * i + kh, k = k0 + kk;
        f32x4 v = ok ? *(const f32x4*)(W + (size_t)k * N + n) : (f32x4){0.f, 0.f, 0.f, 0.f};
        if (g0) v = v * ((k < gs) ? g0[k] : g1[k - gs]);
        *(f32x4*)(scr + kk * 132 + 4 * c4) = v;
    }
    asm volatile("s_waitcnt lgkmcnt(0)" ::: "memory");
#pragma unroll
    for (int j = 0; j < 8; ++j) {
        const int idx = lane + 64 * j, nn = idx >> 2, ck = idx & 3; const float* sp = scr + (8 * ck) * 132 + nn;
        u32x4 o; o.x = pk2(sp[0 * 132], sp[1 * 132]); o.y = pk2(sp[2 * 132], sp[3 * 132]); o.z = pk2(sp[4 * 132], sp[5 * 132]); o.w = pk2(sp[6 * 132], sp[7 * 132]);
        *(u32x4*)(WT + (size_t)(n0 + nn) * K + k0 + 8 * ck) = o;
    }
    asm volatile("s_waitcnt lgkmcnt(0)" ::: "memory");
}
constexpr int TR_N0 = (DM / 32) * (NPROJ / 128), TR_N1 = (512 / 32) * (NQ / 128), TR_N2 = (256 / 32) * (NKV / 128), TR_N3 = (DM / 32) * (DM / 128), TR_N4 = TR_N3;
constexpr int TR_TOTAL = TR_N0 + TR_N1 + TR_N2 + TR_N3 + TR_N4;
__device__ __forceinline__ void ph_transposes(const Params& p, unsigned char* lds, int wave, int lane, int first, int stride) {
    float* scr = (float*)(lds + wave * 17408);
    for (int it = first; it < TR_TOTAL; it += stride) {
        int r = it;
        if (r < TR_N0) { tr_item(p.w_in, DM, IN_COLS, NPROJ, (bf16_t*)(p.ws + WS_WINT), nullptr, nullptr, 0, scr, r, lane); continue; } r -= TR_N0;
        if (r < TR_N1) { tr_item(p.w_uq, 512, NQ, NQ, (bf16_t*)(p.ws + WS_WUQT), p.q_a_norm, p.q_a_norm, 512, scr, r, lane); continue; } r -= TR_N1;
        if (r < TR_N2) { tr_item(p.w_ukv, 256, NKV, NKV, (bf16_t*)(p.ws + WS_WUKVT), p.kv_a_norm, p.kv_a_norm, 256, scr, r, lane); continue; } r -= TR_N2;
        if (r < TR_N3) { tr_item(p.w_out, DM, DM, DM, (bf16_t*)(p.ws + WS_WOUTT), p.attn_out_norm, p.ssd_norm, 1024, scr, r, lane); continue; } r -= TR_N3;
        tr_item(p.w_query, DM, DM, DM, (bf16_t*)(p.ws + WS_WQT), nullptr, nullptr, 0, scr, r, lane);
    }
}
__device__ __forceinline__ void ph_convert(const float* src, bf16_t* dst, size_t n4, int gtid, int gn) {
    for (size_t i = gtid; i < n4; i += (size_t)gn) {
        const f32x4 v = ((const f32x4*)src)[i];
        uint2 o; o.x = pk2(v.x, v.y); o.y = pk2(v.z, v.w);
        ((uint2*)dst)[i] = o;
    }
}
__device__ __forceinline__ void ph_modrows(const float* in, bf16_t* outp, const float* mod, int sh_idx, int sc_idx, int gwave, int gnw, int lane) {
    for (int row = gwave; row < T; row += gnw) {
        const int b = row / SEQ;
        const f32x4* xr = (const f32x4*)(in + (size_t)row * DM) + lane;
        f32x4 v[8]; float s = 0.f;
#pragma unroll
        for (int j = 0; j < 8; ++j) { v[j] = xr[64 * j]; s += (v[j].x * v[j].x + v[j].y * v[j].y) + (v[j].z * v[j].z + v[j].w * v[j].w); }
        const float r = rsqrtf(wave_sum(s) * (1.f / DM) + EPS);
        const f32x4* sh = (const f32x4*)(mod + (size_t)b * 6 * DM + sh_idx * DM) + lane;
        const f32x4* sc = (const f32x4*)(mod + (size_t)b * 6 * DM + sc_idx * DM) + lane;
        uint2* o = (uint2*)(outp + (size_t)row * DM) + lane;
#pragma unroll
        for (int j = 0; j < 8; ++j) {
            const f32x4 a = sh[64 * j], m = sc[64 * j];
            uint2 w; w.x = pk2(v[j].x * r * (1.f + m.x) + a.x, v[j].y * r * (1.f + m.y) + a.y); w.y = pk2(v[j].z * r * (1.f + m.z) + a.z, v[j].w * r * (1.f + m.w) + a.w);
            o[64 * j] = w;
        }
    }
}
constexpr float QSCALE = 0.07216878364870322f * 1.4426950408889634f;
__device__ __forceinline__ float ssq8(u32x4 w) { return (sq2(w.x) + sq2(w.y)) + (sq2(w.z) + sq2(w.w)); }
__device__ __forceinline__ u32x4 scale8(u32x4 w, float s, const float (&g)[8]) {
    u32x4 o; o.x = pk2(bflo(w.x) * s * g[0], bfhi(w.x) * s * g[1]); o.y = pk2(bflo(w.y) * s * g[2], bfhi(w.y) * s * g[3]);
    o.z = pk2(bflo(w.z) * s * g[4], bfhi(w.z) * s * g[5]); o.w = pk2(bflo(w.w) * s * g[6], bfhi(w.w) * s * g[7]); return o;
}
__device__ __forceinline__ u32x4 rope8(u32x4 w, u32x4 pw, float s, const float (&go)[8], const float (&gp)[8], f32x4 c0, f32x4 c1, f32x4 s0, f32x4 s1, float sgn) {
    const float a[8] = {bflo(w.x) * s * go[0], bfhi(w.x) * s * go[1], bflo(w.y) * s * go[2], bfhi(w.y) * s * go[3], bflo(w.z) * s * go[4], bfhi(w.z) * s * go[5], bflo(w.w) * s * go[6], bfhi(w.w) * s * go[7]};
    const float b[8] = {bflo(pw.x) * s * gp[0], bfhi(pw.x) * s * gp[1], bflo(pw.y) * s * gp[2], bfhi(pw.y) * s * gp[3], bflo(pw.z) * s * gp[4], bfhi(pw.z) * s * gp[5], bflo(pw.w) * s * gp[6], bfhi(pw.w) * s * gp[7]};
    u32x4 o;
    o.x = pk2(a[0] * c0.x + sgn * b[0] * s0.x, a[1] * c0.y + sgn * b[1] * s0.y); o.y = pk2(a[2] * c0.z + sgn * b[2] * s0.z, a[3] * c0.w + sgn * b[3] * s0.w);
    o.z = pk2(a[4] * c1.x + sgn * b[4] * s1.x, a[5] * c1.y + sgn * b[5] * s1.y); o.w = pk2(a[6] * c1.z + sgn * b[6] * s1.z, a[7] * c1.w + sgn * b[7] * s1.w);
    return o;
}
__device__ __forceinline__ u32x4 shfl_xor4(u32x4 w, int m) { u32x4 o; o.x = __shfl_xor(w.x, m); o.y = __shfl_xor(w.y, m); o.z = __shfl_xor(w.z, m); o.w = __shfl_xor(w.w, m); return o; }
__device__ __forceinline__ void ph_qkv_post(const Params& p, int gwave, int gnw, int lane) {
    unsigned char* ws = p.ws;
    const int g16 = lane >> 4, pos = lane & 15, hr = lane >> 3, rpos = lane & 7, f0 = (rpos & 3) * 8;
    const float sgn = (rpos < 4) ? -1.f : 1.f;
    float gqn[8], gqr[8], gqp[8], gkn[8], gkr[8], gkp[8];
#pragma unroll
    for (int i = 0; i < 8; ++i) { gqn[i] = p.q_norm[pos * 8 + i]; gqr[i] = p.q_norm[128 + rpos * 8 + i]; gqp[i] = p.q_norm[128 + (rpos ^ 4) * 8 + i];
                                  gkn[i] = p.k_norm[pos * 8 + i]; gkr[i] = p.k_norm[128 + rpos * 8 + i]; gkp[i] = p.k_norm[128 + (rpos ^ 4) * 8 + i]; }
    for (int t = gwave; t < T; t += gnw) {
        const bf16_t* proj = (const bf16_t*)(ws + WS_PROJ) + (size_t)t * NPROJ;
        const bf16_t* qraw = (const bf16_t*)(ws + WS_QRAW) + (size_t)t * NQ;
        const bf16_t* kvraw = (const bf16_t*)(ws + WS_KVRAW) + (size_t)t * NKV;
        const u32x4 cq = *(const u32x4*)(proj + C_CQ + lane * 8);
        const u32x4 ck = *(const u32x4*)(proj + C_CKV + (lane & 31) * 8);
        const u32x4 kr = *(const u32x4*)(proj + C_KR + rpos * 8);
        const u32x4 qn0 = *(const u32x4*)(qraw + g16 * 192 + pos * 8), qn1 = *(const u32x4*)(qraw + (4 + g16) * 192 + pos * 8), qr = *(const u32x4*)(qraw + hr * 192 + 128 + rpos * 8);
        const u32x4 kn0 = *(const u32x4*)(kvraw + g16 * 256 + pos * 8), kn1 = *(const u32x4*)(kvraw + (4 + g16) * 256 + pos * 8);
        const u32x4 v0 = *(const u32x4*)(kvraw + g16 * 256 + 128 + pos * 8), v1 = *(const u32x4*)(kvraw + (4 + g16) * 256 + 128 + pos * 8);
        const float* rcp = (const float*)(ws + WS_ROPEC) + (size_t)t * 32 + f0; const float* rsp = (const float*)(ws + WS_ROPES) + (size_t)t * 32 + f0;
        const f32x4 c0 = *(const f32x4*)rcp, c1 = *(const f32x4*)(rcp + 4), s0 = *(const f32x4*)rsp, s1 = *(const f32x4*)(rsp + 4);
        const float rcq = rsqrtf(wave_sum(ssq8(cq)) * (1.f / 512.f) + EPS);
        const float rckv = rsqrtf(wave_sum(lane < 32 ? ssq8(ck) : 0.f) * (1.f / 256.f) + EPS);
        float skr = ssq8(kr), nq0 = ssq8(qn0), nq1 = ssq8(qn1), rqs = ssq8(qr), nk0 = ssq8(kn0), nk1 = ssq8(kn1);
#pragma unroll
        for (int o = 1; o < 8; o <<= 1) { skr += __shfl_xor(skr, o); rqs += __shfl_xor(rqs, o); nq0 += __shfl_xor(nq0, o); nq1 += __shfl_xor(nq1, o); nk0 += __shfl_xor(nk0, o); nk1 += __shfl_xor(nk1, o); }
        nq0 += __shfl_xor(nq0, 8); nq1 += __shfl_xor(nq1, 8); nk0 += __shfl_xor(nk0, 8); nk1 += __shfl_xor(nk1, 8);
        const float rc2 = rcq * rcq, rk2 = rckv * rckv;
        const float tq0 = nq0 + __shfl(rqs, 8 * g16), tq1 = nq1 + __shfl(rqs, 8 * (4 + g16));
        const float tqa = __shfl(nq0, 16 * (hr & 3)), tqb = __shfl(nq1, 16 * (hr & 3));
        const float tqr = rqs + ((hr < 4) ? tqa : tqb);
        const float sq0 = rsqrtf(tq0 * rc2 * (1.f / 192.f) + EPS) * rcq * QSCALE, sq1 = rsqrtf(tq1 * rc2 * (1.f / 192.f) + EPS) * rcq * QSCALE, sqr = rsqrtf(tqr * rc2 * (1.f / 192.f) + EPS) * rcq * QSCALE;
        const float rk0 = rsqrtf((nk0 * rk2 + skr) * (1.f / 192.f) + EPS), rk1 = rsqrtf((nk1 * rk2 + skr) * (1.f / 192.f) + EPS);
        const float rka = __shfl(rk0, 16 * (hr & 3)), rkb = __shfl(rk1, 16 * (hr & 3));
        const float rkr = (hr < 4) ? rka : rkb;
        const u32x4 pqr = shfl_xor4(qr, 4), pkr = shfl_xor4(kr, 4);
        const int b = t / SEQ, sidx = t % SEQ;
        bf16_t* Q0 = (bf16_t*)(ws + WS_Q) + ((size_t)(b * 8 + g16) * SEQ + sidx) * 192; bf16_t* Q1 = Q0 + (size_t)4 * SEQ * 192; bf16_t* Qr = (bf16_t*)(ws + WS_Q) + ((size_t)(b * 8 + hr) * SEQ + sidx) * 192;
        bf16_t* K0 = (bf16_t*)(ws + WS_K) + ((size_t)(b * 8 + g16) * SEQ + sidx) * 192; bf16_t* K1 = K0 + (size_t)4 * SEQ * 192; bf16_t* Kr = (bf16_t*)(ws + WS_K) + ((size_t)(b * 8 + hr) * SEQ + sidx) * 192;
        bf16_t* V0 = (bf16_t*)(ws + WS_V) + ((size_t)(b * 8 + g16) * SEQ + sidx) * 128; bf16_t* V1 = V0 + (size_t)4 * SEQ * 128;
        *(u32x4*)(Q0 + pos * 8) = scale8(qn0, sq0, gqn); *(u32x4*)(Q1 + pos * 8) = scale8(qn1, sq1, gqn);
        *(u32x4*)(Qr + 128 + rpos * 8) = rope8(qr, pqr, sqr, gqr, gqp, c0, c1, s0, s1, sgn);
        *(u32x4*)(K0 + pos * 8) = scale8(kn0, rckv * rk0, gkn); *(u32x4*)(K1 + pos * 8) = scale8(kn1, rckv * rk1, gkn);
        *(u32x4*)(Kr + 128 + rpos * 8) = rope8(kr, pkr, rkr, gkr, gkp, c0, c1, s0, s1, sgn);
        const float one[8] = {1.f, 1.f, 1.f, 1.f, 1.f, 1.f, 1.f, 1.f};
        *(u32x4*)(V0 + pos * 8) = scale8(v0, rckv, one); *(u32x4*)(V1 + pos * 8) = scale8(v1, rckv, one);
    }
}
__device__ __forceinline__ void ph_attn_naive(const Params& p, unsigned char* lds, int tid, int bid, int G) {
    const int lane = tid & 63, wv = tid >> 6;
    float* ps = (float*)lds + wv * SEQ;
    float* qs = (float*)(lds + 65536) + wv * 192;
    for (int it = 0; it < (T * 8) / (G * 8); ++it) {
        const int sb = (it & 1) ? (G - 1 - bid) : bid;
        const int gi = it * (G * 8) + sb * 8 + wv;
        const int bh = gi / SEQ, s = gi % SEQ, b = bh >> 3, h = bh & 7;
        const bf16_t* Q = (const bf16_t*)(p.ws + WS_Q) + (size_t)gi * 192;
        const bf16_t* K = (const bf16_t*)(p.ws + WS_K) + (size_t)bh * SEQ * 192;
        const bf16_t* V = (const bf16_t*)(p.ws + WS_KVRAW) + (size_t)(b * SEQ) * NKV + h * 256 + 128;
        for (int d = lane; d < 192; d += 64) qs[d] = bf2f(Q[d]);
        SYNC();
        float mx = -1e30f;
        for (int k0 = 0; k0 <= s; k0 += 64) {
            const int key = k0 + lane; float sc = -INFINITY;
            if (key <= s) {
                const u32x4* kp = (const u32x4*)(K + (size_t)key * 192); float a = 0.f;
                for (int c = 0; c < 24; ++c) { const u32x4 w = kp[c]; const float* q = &qs[c * 8];
                    a += bflo(w.x) * q[0] + bfhi(w.x) * q[1] + bflo(w.y) * q[2] + bfhi(w.y) * q[3] + bflo(w.z) * q[4] + bfhi(w.z) * q[5] + bflo(w.w) * q[6] + bfhi(w.w) * q[7]; }
                sc = a;
            }
            ps[key] = sc;
            mx = fmaxf(mx, sc);
        }
#pragma unroll
        for (int o = 1; o < 64; o <<= 1) mx = fmaxf(mx, __shfl_xor(mx, o));
        SYNC();
        float sum = 0.f;
        for (int key = lane; key <= s; key += 64) { const float e = exp2f(ps[key] - mx); ps[key] = e; sum += e; }
        sum = wave_sum(sum);
        SYNC();
        float o0 = 0.f, o1 = 0.f;
        for (int key = 0; key <= s; ++key) { const float pr = ps[key]; const unsigned w = *(const unsigned*)(V + (size_t)key * NKV + 2 * lane); o0 += pr * bflo(w); o1 += pr * bfhi(w); }
        const float inv = 1.f / sum; o0 *= inv; o1 *= inv;
        const int t = b * SEQ + s;
        *(unsigned*)((bf16_t*)(p.ws + WS_ATTN) + (size_t)t * 1024 + h * 128 + 2 * lane) = pk2(o0, o1);
        SYNC();
    }
}
__device__ __forceinline__ void ph_conv_naive(const Params& p, int gtid, int gn) {
    const bf16_t* proj = (const bf16_t*)(p.ws + WS_PROJ);
    for (int i = gtid; i < T * 1552; i += gn) {
        const int t = i / 1552, c = i % 1552, s = t % SEQ;
        if (c < 1536) {
            float a = p.conv_b[c];
            for (int k = 0; k < 4; ++k) { const int ss = s - 3 + k; if (ss >= 0) a += p.conv_w[k * 1536 + c] * bf2f(proj[(size_t)(t - 3 + k) * NPROJ + C_XBC + c]); }
            ((bf16_t*)(p.ws + WS_XBCA))[(size_t)t * 1536 + c] = (bf16_t)f2bf(silu_f(a));
        } else {
            const int hh = c - 1536; const float v = bf2f(proj[(size_t)t * NPROJ + C_DT + hh]) + p.dt_bias[hh];
            ((float*)(p.ws + WS_DT))[(size_t)t * 16 + hh] = (v > 20.f) ? v : log1pf(__expf(v));
        }
    }
}
__device__ __forceinline__ void ph_ssd_naive(const Params& p, int vb, int lt) {
    const int b = vb >> 4, h = vb & 15, g = h >> 3, pp = lt >> 2, nq = lt & 3;
    const bf16_t* xa = (const bf16_t*)(p.ws + WS_XBCA); const float* dtp = (const float*)(p.ws + WS_DT);
    const bf16_t* proj = (const bf16_t*)(p.ws + WS_PROJ);
    const float a = -__expf(p.a_log[h]), dsk = p.d_skip[h];
    float st[32];
#pragma unroll
    for (int n = 0; n < 32; ++n) st[n] = 0.f;
    for (int s = 0; s < SEQ; ++s) {
        const size_t t = (size_t)b * SEQ + s;
        const float dt = dtp[t * 16 + h], dA = __expf(dt * a);
        const float xv = bf2f(xa[t * 1536 + h * 64 + pp]);
        const bf16_t* Bp = xa + t * 1536 + 1024 + g * 128 + nq * 32; const bf16_t* Cp = xa + t * 1536 + 1280 + g * 128 + nq * 32;
        float y = 0.f; const float dx = dt * xv;
#pragma unroll
        for (int n = 0; n < 32; ++n) { st[n] = st[n] * dA + dx * bf2f(Bp[n]); y += bf2f(Cp[n]) * st[n]; }
        y += __shfl_xor(y, 1); y += __shfl_xor(y, 2);
        if (nq == 0) {
            const float z = bf2f(proj[t * NPROJ + C_Z + h * 64 + pp]);
            ((bf16_t*)(p.ws + WS_YSSD))[t * 1024 + h * 64 + pp] = (bf16_t)f2bf((y + dsk * xv) * silu_f(z));
        }
    }
}
__device__ __forceinline__ void ph_mixnorm(const Params& p, int gwave, int gnw, int lane) {
    for (int t = gwave; t < T; t += gnw) {
        const uint2* ain = (const uint2*)((const bf16_t*)(p.ws + WS_ATTN) + (size_t)t * 1024); const uint2* yin = (const uint2*)((const bf16_t*)(p.ws + WS_YSSD) + (size_t)t * 1024);
        uint2 a[4], y[4]; float sa = 0.f, s0 = 0.f, s1 = 0.f;
#pragma unroll
        for (int j = 0; j < 4; ++j) { a[j] = ain[lane + 64 * j]; y[j] = yin[lane + 64 * j]; sa += sq2(a[j].x) + sq2(a[j].y); const float q = sq2(y[j].x) + sq2(y[j].y); if (j < 2) s0 += q; else s1 += q; }
        const float ra = rsqrtf(wave_sum(sa) * (1.f / 1024.f) + EPS), r0 = rsqrtf(wave_sum(s0) * (1.f / 512.f) + EPS), r1 = rsqrtf(wave_sum(s1) * (1.f / 512.f) + EPS);
        uint2* o = (uint2*)((bf16_t*)(p.ws + WS_MIXIN) + (size_t)t * DM);
#pragma unroll
        for (int j = 0; j < 4; ++j) {
            uint2 r; r.x = pk2(bflo(a[j].x) * ra, bfhi(a[j].x) * ra); r.y = pk2(bflo(a[j].y) * ra, bfhi(a[j].y) * ra); o[lane + 64 * j] = r;
            const float rr = (j < 2) ? r0 : r1;
            uint2 q; q.x = pk2(bflo(y[j].x) * rr, bfhi(y[j].x) * rr); q.y = pk2(bflo(y[j].y) * rr, bfhi(y[j].y) * rr); o[256 + lane + 64 * j] = q;
        }
    }
}
__device__ __forceinline__ void ph_route_naive(const Params& p, unsigned char* lds, int tid, int bid, int G) {
    const int sub = tid >> 7, lt = tid & 127;
    float* base = (float*)(lds + sub * 4096);
    float* q = base; float* sc = base + 256; float* ts = base + 512; int* ti = (int*)(base + 544); float* cs = base + 576; float* bs = base + 832; int* bi = (int*)(base + 848);
    const bf16_t* sk = (const bf16_t*)(p.ws + WS_SUBK);
    for (int it = 0; it < (T * 8) / (G * 4); ++it) {
        const int vb = it * (G * 4) + bid * 4 + sub, t = vb >> 3, h = vb & 7;
        const bf16_t* qp = (const bf16_t*)(p.ws + WS_QP) + (size_t)t * DM + h * 256;
        q[lt] = bf2f(qp[lt]); q[128 + lt] = bf2f(qp[128 + lt]);
        SYNC();
#pragma unroll
        for (int j = 0; j < 2; ++j) {
            const u32x4* kp = (const u32x4*)(sk + ((size_t)(h * 2 + j) * 128 + lt) * 128); float a = 0.f;
            for (int c = 0; c < 16; ++c) { const u32x4 w = kp[c]; const float* qq = q + j * 128 + c * 8;
                a += bflo(w.x) * qq[0] + bfhi(w.x) * qq[1] + bflo(w.y) * qq[2] + bfhi(w.y) * qq[3] + bflo(w.z) * qq[4] + bfhi(w.z) * qq[5] + bflo(w.w) * qq[6] + bfhi(w.w) * qq[7]; }
            sc[j * 128 + lt] = a;
        }
        SYNC();
#pragma unroll
        for (int j = 0; j < 2; ++j) {
            const float v = sc[j * 128 + lt]; int rank = 0;
            for (int k = 0; k < 128; ++k) { const float o = sc[j * 128 + k]; rank += (o > v || (o == v && k < lt)) ? 1 : 0; }
            if (rank < 16) { ts[j * 16 + rank] = v; ti[j * 16 + rank] = lt; }
        }
        SYNC();
        cs[lt] = ts[lt >> 4] + ts[16 + (lt & 15)]; cs[128 + lt] = ts[8 + (lt >> 4)] + ts[16 + (lt & 15)];
        SYNC();
#pragma unroll
        for (int r = 0; r < 2; ++r) {
            const int ci = lt + 128 * r; const float v = cs[ci]; int rank = 0;
            for (int k = 0; k < 256; ++k) { const float o = cs[k]; rank += (o > v || (o == v && k < ci)) ? 1 : 0; }
            if (rank < 16) { bs[rank] = v; bi[rank] = ti[ci >> 4] * 128 + ti[16 + (ci & 15)]; }
        }
        SYNC();
        if (lt < 16) {
            const float mx = bs[0]; float sum = 0.f;
            for (int k = 0; k < 16; ++k) sum += __expf(bs[k] - mx);
            ((float*)(p.ws + WS_GATE))[(size_t)t * 128 + h * 16 + lt] = __expf(bs[lt] - mx) / sum;
            ((int*)(p.ws + WS_IDX))[(size_t)t * 128 + h * 16 + lt] = bi[lt];
        }
        SYNC();
    }
}
__device__ __forceinline__ void ph_peer_naive(const Params& p, unsigned char* lds, int tid, int bid, int G) {
    const int half = tid >> 8, lt = tid & 255, lane = tid & 63, wv = lt >> 6;
    float* red = (float*)(lds + half * 64);
    const bf16_t* U = (const bf16_t*)(p.ws + WS_U16); const bf16_t* V = (const bf16_t*)(p.ws + WS_V16);
    for (int it = 0; it < T / (G * 2); ++it) {
        const int t = it * (G * 2) + bid * 2 + half, b = t / SEQ;
        const u32x4 hw = *(const u32x4*)((const bf16_t*)(p.ws + WS_H2) + (size_t)t * DM + lt * 8);
        const float h0 = bflo(hw.x), h1 = bfhi(hw.x), h2 = bflo(hw.y), h3 = bfhi(hw.y), h4 = bflo(hw.z), h5 = bfhi(hw.z), h6 = bflo(hw.w), h7 = bfhi(hw.w);
        float o0 = 0.f, o1 = 0.f, o2 = 0.f, o3 = 0.f, o4 = 0.f, o5 = 0.f, o6 = 0.f, o7 = 0.f;
        const int* idx = (const int*)(p.ws + WS_IDX) + (size_t)t * 128; const float* gate = (const float*)(p.ws + WS_GATE) + (size_t)t * 128;
        for (int e = 0; e < 128; ++e) {
            const int ex = idx[e];
            const u32x4 uw = *(const u32x4*)(U + (size_t)ex * DM + lt * 8);
            float d = bflo(uw.x) * h0 + bfhi(uw.x) * h1 + bflo(uw.y) * h2 + bfhi(uw.y) * h3 + bflo(uw.z) * h4 + bfhi(uw.z) * h5 + bflo(uw.w) * h6 + bfhi(uw.w) * h7;
            d = wave_sum(d);
            if (lane == 0) red[wv] = d;
            SYNC();
            const float pre = red[0] + red[1] + red[2] + red[3];
            const float a = 0.5f * pre * (1.f + erff(pre * 0.70710678118654752f)) * gate[e];
            SYNC();
            const u32x4 vw = *(const u32x4*)(V + (size_t)ex * DM + lt * 8);
            o0 += a * bflo(vw.x); o1 += a * bfhi(vw.x); o2 += a * bflo(vw.y); o3 += a * bfhi(vw.y); o4 += a * bflo(vw.z); o5 += a * bfhi(vw.z); o6 += a * bflo(vw.w); o7 += a * bfhi(vw.w);
        }
        const float* g2 = (const float*)(p.ws + WS_MOD) + (size_t)b * 6 * DM + 5 * DM + lt * 8;
        float* outp = p.out + (size_t)t * DM + lt * 8;
        const f32x4 x0 = *(const f32x4*)outp, x1 = *(const f32x4*)(outp + 4), ga = *(const f32x4*)g2, gb = *(const f32x4*)(g2 + 4);
        *(f32x4*)outp = (f32x4){x0.x + ga.x * o0, x0.y + ga.y * o1, x0.z + ga.z * o2, x0.w + ga.w * o3};
        *(f32x4*)(outp + 4) = (f32x4){x1.x + gb.x * o4, x1.y + gb.y * o5, x1.z + gb.z * o6, x1.w + gb.w * o7};
    }
}
typedef __bf16 bf16x2_t __attribute__((ext_vector_type(2)));
__device__ __forceinline__ float dot2bf(unsigned a, unsigned b, float c) { return __builtin_amdgcn_fdot2_f32_bf16(__builtin_bit_cast(bf16x2_t, a), __builtin_bit_cast(bf16x2_t, b), c, false); }
__device__ __forceinline__ void ph_peer(const Params& p, LAS unsigned char* ldsl, int wave, int lane, int gwave, int gnw) {
    LAS unsigned char* ring = ldsl + wave * 16384;
    const bf16_t* U = (const bf16_t*)(p.ws + WS_U16); const bf16_t* V = (const bf16_t*)(p.ws + WS_V16);
    const int e_lane = (lane >> 2) & 15; const unsigned lane16 = (unsigned)lane * 16u;
#define PEER_ISSUE(R) do { const int R_ = (R); const int i_ = ((R_ >> 5) << 4) + (R_ & 15); \
        const int e_ = (i_ < 64) ? __builtin_amdgcn_readlane(idx0, i_) : __builtin_amdgcn_readlane(idx1, i_ - 64); \
        const char* base_ = (const char*)(((R_ >> 4) & 1) ? V : U) + (size_t)(unsigned)e_ * (DM * 2); \
        const unsigned* src_ = (const unsigned*)(base_ + lane16); \
        LAS unsigned* dst_ = (LAS unsigned*)(ring + (R_ & 3) * 4096); \
        __builtin_amdgcn_global_load_lds(src_, dst_, 16, 0, 0); \
        __builtin_amdgcn_global_load_lds(src_, dst_, 16, 1024, 0); \
        __builtin_amdgcn_global_load_lds(src_, dst_, 16, 2048, 0); \
        __builtin_amdgcn_global_load_lds(src_, dst_, 16, 3072, 0); } while (0)
#define PEER_WAIT(n) asm volatile("s_waitcnt vmcnt(" #n ")" ::: "memory")
    for (int t = gwave; t < T; t += gnw) {
        const int b = t / SEQ;
        const int idx0 = ((const int*)(p.ws + WS_IDX))[(size_t)t * 128 + lane], idx1 = ((const int*)(p.ws + WS_IDX))[(size_t)t * 128 + 64 + lane];
        const float g0 = ((const float*)(p.ws + WS_GATE))[(size_t)t * 128 + lane], g1 = ((const float*)(p.ws + WS_GATE))[(size_t)t * 128 + 64 + lane];
        u32x4 hreg[4];
#pragma unroll
        for (int j = 0; j < 4; ++j) hreg[j] = *(const u32x4*)((const bf16_t*)(p.ws + WS_H2) + (size_t)t * DM + j * 512 + lane * 8);
        float out[4][8];
#pragma unroll
        for (int j = 0; j < 4; ++j)
#pragma unroll
            for (int i = 0; i < 8; ++i) out[j][i] = 0.f;
        PEER_ISSUE(0); PEER_ISSUE(1); PEER_ISSUE(2);
        for (int hh = 0; hh < 8; ++hh) {
            float pd[16];
#pragma unroll
            for (int k = 0; k < 16; ++k) {
                PEER_ISSUE(hh * 32 + k + 3); PEER_WAIT(12);
                const LAS unsigned char* sl = ring + (k & 3) * 4096 + lane * 16;
                float a = 0.f;
#pragma unroll
                for (int j = 0; j < 4; ++j) { const u32x4 w = *(const LAS u32x4*)(sl + j * 1024);
                    a = dot2bf(w.x, hreg[j].x, a); a = dot2bf(w.y, hreg[j].y, a); a = dot2bf(w.z, hreg[j].z, a); a = dot2bf(w.w, hreg[j].w, a); }
                asm volatile("" : "+v"(a));
                pd[k] = a;
            }
            float q8[8], q4[4], q2[2], q1;
            { const bool hi = (lane & 32) != 0;
#pragma unroll
              for (int i = 0; i < 8; ++i) { const float keep = hi ? pd[i + 8] : pd[i], send = hi ? pd[i] : pd[i + 8]; q8[i] = keep + __shfl_xor(send, 32); } }
            { const bool hi = (lane & 16) != 0;
#pragma unroll
              for (int i = 0; i < 4; ++i) { const float keep = hi ? q8[i + 4] : q8[i], send = hi ? q8[i] : q8[i + 4]; q4[i] = keep + __shfl_xor(send, 16); } }
            { const bool hi = (lane & 8) != 0;
#pragma unroll
              for (int i = 0; i < 2; ++i) { const float keep = hi ? q4[i + 2] : q4[i], send = hi ? q4[i] : q4[i + 2]; q2[i] = keep + __shfl_xor(send, 8); } }
            { const bool hi = (lane & 4) != 0; const float keep = hi ? q2[1] : q2[0], send = hi ? q2[0] : q2[1]; q1 = keep + __shfl_xor(send, 4); }
            q1 += __shfl_xor(q1, 1); q1 += __shfl_xor(q1, 2);
            const float gsel = (hh < 4) ? g0 : g1;
            const float gate = __shfl(gsel, (hh & 3) * 16 + e_lane);
            const float act = 0.5f * q1 * (1.f + erff(q1 * 0.70710678118654752f)) * gate;
#pragma unroll
            for (int k = 0; k < 16; ++k) {
                if (k < 13) { PEER_ISSUE(hh * 32 + 16 + k + 3); PEER_WAIT(12); }
                else if (hh < 7) { PEER_ISSUE(hh * 32 + 16 + k + 3); PEER_WAIT(12); }
                else if (k == 13) PEER_WAIT(8); else if (k == 14) PEER_WAIT(4); else PEER_WAIT(0);
                const float a = __builtin_bit_cast(float, __builtin_amdgcn_readlane(__builtin_bit_cast(int, act), 4 * k));
                const LAS unsigned char* sl = ring + (k & 3) * 4096 + lane * 16;
#pragma unroll
                for (int j = 0; j < 4; ++j) { const u32x4 w = *(const LAS u32x4*)(sl + j * 1024);
                    out[j][0] += a * bflo(w.x); out[j][1] += a * bfhi(w.x); out[j][2] += a * bflo(w.y); out[j][3] += a * bfhi(w.y);
                    out[j][4] += a * bflo(w.z); out[j][5] += a * bfhi(w.z); out[j][6] += a * bflo(w.w); out[j][7] += a * bfhi(w.w);
                    asm volatile("" : "+v"(out[j][0]), "+v"(out[j][1]), "+v"(out[j][2]), "+v"(out[j][3]), "+v"(out[j][4]), "+v"(out[j][5]), "+v"(out[j][6]), "+v"(out[j][7])); }
            }
        }
        const float* g2 = (const float*)(p.ws + WS_MOD) + (size_t)b * 6 * DM + 5 * DM;
        float* outp = p.out + (size_t)t * DM;
#pragma unroll
        for (int j = 0; j < 4; ++j) {
            const int c = j * 512 + lane * 8;
            const f32x4 x0 = *(const f32x4*)(outp + c), x1 = *(const f32x4*)(outp + c + 4), ga = *(const f32x4*)(g2 + c), gb = *(const f32x4*)(g2 + c + 4);
            *(f32x4*)(outp + c) = (f32x4){x0.x + ga.x * out[j][0], x0.y + ga.y * out[j][1], x0.z + ga.z * out[j][2], x0.w + ga.w * out[j][3]};
            *(f32x4*)(outp + c + 4) = (f32x4){x1.x + gb.x * out[j][4], x1.y + gb.y * out[j][5], x1.z + gb.z * out[j][6], x1.w + gb.w * out[j][7]};
        }
    }
#undef PEER_ISSUE
#undef PEER_WAIT
}
typedef short bf16x8 __attribute__((ext_vector_type(8)));
typedef short s16x4 __attribute__((ext_vector_type(4)));
typedef float f32x16 __attribute__((ext_vector_type(16)));
typedef float f32x2_t __attribute__((ext_vector_type(2)));
__device__ __forceinline__ int crow(int r, int hi) { return (r & 3) + 8 * (r >> 2) + 4 * hi; }
__device__ __forceinline__ unsigned cvtpk(float lo, float hi) { f32x2_t v = {lo, hi}; bf16x2_t b = __builtin_convertvector(v, bf16x2_t); return __builtin_bit_cast(unsigned, b); }
__device__ __forceinline__ s16x4 vtr(const LAS unsigned char* pp) { return __builtin_bit_cast(s16x4, __builtin_amdgcn_ds_read_tr16_b64_v4i16((LAS s16x4*)pp)); }
#define TR_PAIR(lo_, hi_, addr_, off_, hioff_) do { asm volatile("ds_read_b64_tr_b16 %0, %1 offset:%c2" : "=&v"(lo_) : "v"(addr_), "i"(off_) : "memory"); \
        asm volatile("ds_read_b64_tr_b16 %0, %1 offset:%c2" : "=&v"(hi_) : "v"(addr_), "i"((off_) + (hioff_)) : "memory"); } while (0)
#define LDS_WAIT_PIN() do { asm volatile("s_waitcnt lgkmcnt(0)" ::: "memory"); __builtin_amdgcn_sched_barrier(0); } while (0)
constexpr int AT_SLOT = 40960, AT_VOFF = 24576;
__device__ __forceinline__ void attn_unit(const Params& p, LAS unsigned char* ldsl, int bh, int qb, int wave, int lane) {
    const int r32 = lane & 31, hi = lane >> 5, b = bh >> 3, h = bh & 7;
    const bf16_t* Kbh = (const bf16_t*)(p.ws + WS_K) + (size_t)bh * SEQ * 192;
    const bf16_t* Vb = (const bf16_t*)(p.ws + WS_V) + (size_t)bh * SEQ * 128;
    const bf16_t* Qw = (const bf16_t*)(p.ws + WS_Q) + ((size_t)bh * SEQ + qb * 256 + wave * 32 + r32) * 192 + 8 * hi;
    const int NT = (qb * 256 + 256) / 64;
    int koff[3];
#pragma unroll
    for (int i = 0; i < 3; ++i) { const int o = 64 * (wave * 3 + i) + lane, k = o / 24, sl = o - 24 * k; int c = sl - ((k >> 1) & 7); c += (c < 0) ? 24 : 0; koff[i] = k * 192 + c * 8; }
    const int vid = wave * 2;
    const bf16_t* vsrc = Vb + (size_t)(16 * (vid & 3) + (lane >> 2)) * 128 + (vid >> 2) * 32 + (lane & 3) * 8;
#define AT_ISSUE(t, slot) do { const bf16_t* ks_ = Kbh + (size_t)(t) * 64 * 192; LAS unsigned char* sb_ = ldsl + (slot) * AT_SLOT; \
        __builtin_amdgcn_global_load_lds((const unsigned*)(ks_ + koff[0]), (LAS unsigned*)(sb_ + (wave * 3 + 0) * 1024), 16, 0, 0); \
        __builtin_amdgcn_global_load_lds((const unsigned*)(ks_ + koff[1]), (LAS unsigned*)(sb_ + (wave * 3 + 1) * 1024), 16, 0, 0); \
        __builtin_amdgcn_global_load_lds((const unsigned*)(ks_ + koff[2]), (LAS unsigned*)(sb_ + (wave * 3 + 2) * 1024), 16, 0, 0); \
        const bf16_t* vs_ = vsrc + (size_t)(t) * 64 * 128; \
        __builtin_amdgcn_global_load_lds((const unsigned*)(vs_), (LAS unsigned*)(sb_ + AT_VOFF + vid * 1024), 16, 0, 0); \
        __builtin_amdgcn_global_load_lds((const unsigned*)(vs_ + (size_t)16 * 128), (LAS unsigned*)(sb_ + AT_VOFF + (vid + 1) * 1024), 16, 0, 0); } while (0)
    bf16x8 qr[12];
#pragma unroll
    for (int s = 0; s < 12; ++s) qr[s] = *(const bf16x8*)(Qw + 16 * s);
#pragma unroll
    for (int s = 0; s < 12; ++s) asm volatile("" : "+v"(qr[s]));
    AT_ISSUE(0, 0); AT_ISSUE(1, 1);
    f32x16 o[4];
#pragma unroll
    for (int d0 = 0; d0 < 4; ++d0)
#pragma unroll
        for (int r = 0; r < 16; ++r) o[d0][r] = 0.f;
    float m = -1e30f, l = 0.f;
    const int kfo = r32 * 384, kc0 = hi + ((r32 >> 1) & 7);
    const int vfo = AT_VOFF + ((lane >> 4) & 1) * 32 + (lane & 3) * 8 + (4 * hi + ((lane & 15) >> 2)) * 64;
    const int qrel = wave * 32 + r32;
    int slot = 0;
    for (int t = 0; t < NT; ++t) {
        if (t + 1 < NT) asm volatile("s_waitcnt vmcnt(5)" ::: "memory"); else asm volatile("s_waitcnt vmcnt(0)" ::: "memory");
        __builtin_amdgcn_s_barrier(); asm volatile("" ::: "memory");
        if (t + 2 < NT) { const int s2 = (slot == 0) ? 2 : slot - 1; AT_ISSUE(t + 2, s2); }
        const int jb = t - (NT - 4);
        if (!(jb >= 0 && 64 * jb > wave * 32 + 31)) {
            const LAS unsigned char* kp = ldsl + slot * AT_SLOT + kfo;
            int kc = kc0; asm volatile("" : "+v"(kc));
            f32x16 p0, p1;
#pragma unroll
            for (int r = 0; r < 16; ++r) { p0[r] = 0.f; p1[r] = 0.f; }
#pragma unroll
            for (int s = 0; s < 12; ++s) {
                int sl_ = kc + 2 * s; sl_ -= (sl_ >= 24) ? 24 : 0;
                const bf16x8 k0 = *(const LAS bf16x8*)(kp + sl_ * 16), k1 = *(const LAS bf16x8*)(kp + sl_ * 16 + 32 * 384);
                p0 = __builtin_amdgcn_mfma_f32_32x32x16_bf16(k0, qr[s], p0, 0, 0, 0);
                p1 = __builtin_amdgcn_mfma_f32_32x32x16_bf16(k1, qr[s], p1, 0, 0, 0);
            }
            if (jb >= 0 && 64 * jb + 63 > wave * 32) {
#pragma unroll
                for (int r = 0; r < 16; ++r) { const int kv = 64 * jb + crow(r, hi); if (kv > qrel) p0[r] = -INFINITY; if (kv + 32 > qrel) p1[r] = -INFINITY; }
            }
            float rm = fmaxf(p0[0], p1[0]);
#pragma unroll
            for (int r = 1; r < 16; ++r) rm = fmaxf(rm, fmaxf(p0[r], p1[r]));
            rm = fmaxf(rm, __shfl_xor(rm, 32));
            const float mn = fmaxf(m, rm);
            if (__any(mn > m)) {
                const float alpha = __builtin_amdgcn_exp2f(m - mn);
                l *= alpha;
#pragma unroll
                for (int r = 0; r < 16; ++r) { const float ar = __shfl(alpha, crow(r, hi));
#pragma unroll
                    for (int d0 = 0; d0 < 4; ++d0) o[d0][r] *= ar; }
                m = mn;
            }
            float ls = 0.f;
#pragma unroll
            for (int r = 0; r < 16; ++r) { p0[r] = __builtin_amdgcn_exp2f(p0[r] - m); p1[r] = __builtin_amdgcn_exp2f(p1[r] - m); ls += p0[r] + p1[r]; }
            l += ls;
            bf16x8 pa[4];
            { u32x4 w;
              w.x = cvtpk(p0[0], p0[1]); w.y = cvtpk(p0[2], p0[3]); w.z = cvtpk(p0[4], p0[5]); w.w = cvtpk(p0[6], p0[7]); pa[0] = __builtin_bit_cast(bf16x8, w);
              w.x = cvtpk(p0[8], p0[9]); w.y = cvtpk(p0[10], p0[11]); w.z = cvtpk(p0[12], p0[13]); w.w = cvtpk(p0[14], p0[15]); pa[1] = __builtin_bit_cast(bf16x8, w);
              w.x = cvtpk(p1[0], p1[1]); w.y = cvtpk(p1[2], p1[3]); w.z = cvtpk(p1[4], p1[5]); w.w = cvtpk(p1[6], p1[7]); pa[2] = __builtin_bit_cast(bf16x8, w);
              w.x = cvtpk(p1[8], p1[9]); w.y = cvtpk(p1[10], p1[11]); w.z = cvtpk(p1[12], p1[13]); w.w = cvtpk(p1[14], p1[15]); pa[3] = __builtin_bit_cast(bf16x8, w); }
            const unsigned vpa = (unsigned)(size_t)(ldsl + slot * AT_SLOT + vfo);
#pragma unroll
            for (int d0 = 0; d0 < 4; ++d0) {
                s16x4 lo[4], hh[4];
                TR_PAIR(lo[0], hh[0], vpa, d0 * 4096 + 0 * 1024, 512); TR_PAIR(lo[1], hh[1], vpa, d0 * 4096 + 1 * 1024, 512);
                TR_PAIR(lo[2], hh[2], vpa, d0 * 4096 + 2 * 1024, 512); TR_PAIR(lo[3], hh[3], vpa, d0 * 4096 + 3 * 1024, 512);
                LDS_WAIT_PIN();
#pragma unroll
                for (int ks = 0; ks < 4; ++ks)
                    o[d0] = __builtin_amdgcn_mfma_f32_32x32x16_bf16(pa[ks], (bf16x8){lo[ks][0], lo[ks][1], lo[ks][2], lo[ks][3], hh[ks][0], hh[ks][1], hh[ks][2], hh[ks][3]}, o[d0], 0, 0, 0);
            }
        }
        slot = (slot == 2) ? 0 : slot + 1;
    }
    l += __shfl_xor(l, 32);
    const float inv = 1.f / l;
    bf16_t* Ow = (bf16_t*)(p.ws + WS_ATTN) + ((size_t)b * SEQ + qb * 256 + wave * 32) * 1024 + h * 128 + r32;
#pragma unroll
    for (int r = 0; r < 16; ++r) { const float ir = __shfl(inv, crow(r, hi));
#pragma unroll
        for (int d0 = 0; d0 < 4; ++d0) Ow[(size_t)crow(r, hi) * 1024 + d0 * 32] = (bf16_t)f2bf(o[d0][r] * ir); }
    asm volatile("s_waitcnt lgkmcnt(0)" ::: "memory"); __builtin_amdgcn_s_barrier(); asm volatile("" ::: "memory");
#undef AT_ISSUE
}
__device__ __forceinline__ void ph_attn(const Params& p, LAS unsigned char* ldsl, int bid, int G, int wave, int lane) {
    const int vcu = (bid & 7) * (G >> 3) + (bid >> 3);
    const int bh = vcu >> 2, s = vcu & 3;
    attn_unit(p, ldsl, bh, 7 - s, wave, lane);
    attn_unit(p, ldsl, bh, s, wave, lane);
}
__device__ __forceinline__ int f2sort(float f) { const int u = __builtin_bit_cast(int, f); return u ^ ((u >> 31) & 0x7fffffff); }
__device__ __forceinline__ float sort2f(int k) { return __builtin_bit_cast(float, k ^ ((k >> 31) & 0x7fffffff)); }
#define CE_(a_, b_) do { const int hi_ = max(a_, b_); b_ = min(a_, b_); a_ = hi_; } while (0)
#define INS16(L, x) do { int x_ = (x); _Pragma("unroll") for (int i_ = 0; i_ < 16; ++i_) { const int hi_ = max(L[i_], x_); x_ = min(L[i_], x_); L[i_] = hi_; } } while (0)
#define SORT16(v) do { CE_(v[0], v[13]); CE_(v[1], v[12]); CE_(v[2], v[15]); CE_(v[3], v[14]); CE_(v[4], v[8]); CE_(v[5], v[6]); CE_(v[7], v[11]); CE_(v[9], v[10]); CE_(v[0], v[5]); CE_(v[1], v[7]); CE_(v[2], v[9]); CE_(v[3], v[4]); CE_(v[6], v[13]); CE_(v[8], v[14]); CE_(v[10], v[15]); CE_(v[11], v[12]); CE_(v[0], v[1]); CE_(v[2], v[3]); CE_(v[4], v[5]); CE_(v[6], v[8]); CE_(v[7], v[9]); CE_(v[10], v[11]); CE_(v[12], v[13]); CE_(v[14], v[15]); CE_(v[0], v[2]); CE_(v[1], v[3]); CE_(v[4], v[10]); CE_(v[5], v[11]); CE_(v[6], v[7]); CE_(v[8], v[9]); CE_(v[12], v[14]); CE_(v[13], v[15]); CE_(v[1], v[2]); CE_(v[3], v[12]); CE_(v[4], v[6]); CE_(v[5], v[7]); CE_(v[8], v[10]); CE_(v[9], v[11]); CE_(v[13], v[14]); CE_(v[1], v[4]); CE_(v[2], v[6]); CE_(v[5], v[8]); CE_(v[7], v[10]); CE_(v[9], v[13]); CE_(v[11], v[14]); CE_(v[2], v[4]); CE_(v[3], v[6]); CE_(v[9], v[12]); CE_(v[11], v[13]); CE_(v[3], v[5]); CE_(v[6], v[8]); CE_(v[7], v[9]); CE_(v[10], v[12]); CE_(v[3], v[4]); CE_(v[5], v[6]); CE_(v[7], v[8]); CE_(v[9], v[10]); CE_(v[11], v[12]); CE_(v[6], v[7]); CE_(v[8], v[9]); } while (0)
#define BMERGE16(v) do { CE_(v[0], v[8]); CE_(v[1], v[9]); CE_(v[2], v[10]); CE_(v[3], v[11]); CE_(v[4], v[12]); CE_(v[5], v[13]); CE_(v[6], v[14]); CE_(v[7], v[15]); CE_(v[0], v[4]); CE_(v[1], v[5]); CE_(v[2], v[6]); CE_(v[3], v[7]); CE_(v[8], v[12]); CE_(v[9], v[13]); CE_(v[10], v[14]); CE_(v[11], v[15]); CE_(v[0], v[2]); CE_(v[1], v[3]); CE_(v[4], v[6]); CE_(v[5], v[7]); CE_(v[8], v[10]); CE_(v[9], v[11]); CE_(v[12], v[14]); CE_(v[13], v[15]); CE_(v[0], v[1]); CE_(v[2], v[3]); CE_(v[4], v[5]); CE_(v[6], v[7]); CE_(v[8], v[9]); CE_(v[10], v[11]); CE_(v[12], v[13]); CE_(v[14], v[15]); } while (0)
__device__ __forceinline__ void ph_route(const Params& p, LAS unsigned char* ldsl, int wave, int lane, int gwave, int gnw) {
    const int r32 = lane & 31, hi = lane >> 5;
    const bf16_t* SK = (const bf16_t*)(p.ws + WS_SUBK);
    LAS unsigned char* tab = ldsl + wave * 4096 + lane * 32;
    for (int item = gwave; item < (T / 32) * 8; item += gnw) {
        const int tile = item >> 3, h = item & 7, t0 = tile * 32;
        int hi4 = hi * 4; asm volatile("" : "+v"(hi4));
        int S0[16], S1[16];
#pragma unroll
        for (int j = 0; j < 2; ++j) {
            const bf16_t* qp = (const bf16_t*)(p.ws + WS_QP) + (size_t)(t0 + r32) * DM + h * 256 + j * 128 + 8 * hi;
            asm volatile("" : "+v"(qp));
            bf16x8 bq[8];
#pragma unroll
            for (int s = 0; s < 8; ++s) bq[s] = *(const bf16x8*)(qp + 16 * s);
            int L[16];
#pragma unroll
            for (int kb = 0; kb < 4; ++kb) {
                const bf16_t* ap = SK + ((size_t)(h * 2 + j) * 128 + kb * 32 + r32) * 128 + 8 * hi;
                asm volatile("" : "+v"(ap));
                f32x16 acc;
#pragma unroll
                for (int r = 0; r < 16; ++r) acc[r] = 0.f;
#pragma unroll
                for (int s = 0; s < 8; ++s) acc = __builtin_amdgcn_mfma_f32_32x32x16_bf16(*(const bf16x8*)(ap + 16 * s), bq[s], acc, 0, 0, 0);
                int v[16];
#pragma unroll
                for (int r = 0; r < 16; ++r) v[r] = (f2sort(acc[r]) & ~127) | ((127 - (kb * 32 + (r & 3) + 8 * (r >> 2))) - hi4);
                SORT16(v);
                if (kb == 0) {
#pragma unroll
                    for (int i = 0; i < 16; ++i) L[i] = v[i];
                } else {
#pragma unroll
                    for (int i = 0; i < 16; ++i) L[i] = max(L[i], v[15 - i]);
                    BMERGE16(L);
                }
                __builtin_amdgcn_sched_barrier(0);
            }
            int Y[16];
#pragma unroll
            for (int i = 0; i < 16; ++i) Y[i] = __shfl_xor(L[i], 32);
#pragma unroll
            for (int i = 0; i < 16; ++i) L[i] = max(L[i], Y[15 - i]);
            BMERGE16(L);
#pragma unroll
            for (int i = 0; i < 16; ++i) { if (j == 0) S0[i] = L[i]; else S1[i] = L[i]; }
        }
        float f0[16], f1[16];
        {
            unsigned w0[4], w1[4];
#pragma unroll
            for (int i = 0; i < 16; ++i) { f0[i] = sort2f(S0[i] & ~127); f1[i] = sort2f(S1[i] & ~127); }
#pragma unroll
            for (int q = 0; q < 4; ++q) {
                w0[q] = (unsigned)(127 - (S0[4 * q] & 127)) | ((unsigned)(127 - (S0[4 * q + 1] & 127)) << 8) | ((unsigned)(127 - (S0[4 * q + 2] & 127)) << 16) | ((unsigned)(127 - (S0[4 * q + 3] & 127)) << 24);
                w1[q] = (unsigned)(127 - (S1[4 * q] & 127)) | ((unsigned)(127 - (S1[4 * q + 1] & 127)) << 8) | ((unsigned)(127 - (S1[4 * q + 2] & 127)) << 16) | ((unsigned)(127 - (S1[4 * q + 3] & 127)) << 24);
            }
            *(LAS u32x4*)(tab) = (u32x4){w0[0], w0[1], w0[2], w0[3]};
            *(LAS u32x4*)(tab + 16) = (u32x4){w1[0], w1[1], w1[2], w1[3]};
        }
        int Lv[16];
        Lv[0] = (f2sort(f0[0] + f1[0]) & ~255) | 255;
        Lv[1] = (f2sort(f0[0] + f1[1]) & ~255) | 254;
        Lv[2] = (f2sort(f0[0] + f1[2]) & ~255) | 253;
        Lv[3] = (f2sort(f0[0] + f1[3]) & ~255) | 252;
        Lv[4] = (f2sort(f0[0] + f1[4]) & ~255) | 251;
        Lv[5] = (f2sort(f0[0] + f1[5]) & ~255) | 250;
        Lv[6] = (f2sort(f0[0] + f1[6]) & ~255) | 249;
        Lv[7] = (f2sort(f0[0] + f1[7]) & ~255) | 248;
        Lv[8] = (f2sort(f0[0] + f1[8]) & ~255) | 247;
        Lv[9] = (f2sort(f0[0] + f1[9]) & ~255) | 246;
        Lv[10] = (f2sort(f0[0] + f1[10]) & ~255) | 245;
        Lv[11] = (f2sort(f0[0] + f1[11]) & ~255) | 244;
        Lv[12] = (f2sort(f0[0] + f1[12]) & ~255) | 243;
        Lv[13] = (f2sort(f0[0] + f1[13]) & ~255) | 242;
        Lv[14] = (f2sort(f0[0] + f1[14]) & ~255) | 241;
        Lv[15] = (f2sort(f0[0] + f1[15]) & ~255) | 240;
        { int cv_ = (f2sort(f0[1] + f1[0]) & ~255) | 239; INS16(Lv, cv_); __builtin_amdgcn_sched_barrier(0); }
        { int cv_ = (f2sort(f0[1] + f1[1]) & ~255) | 238; INS16(Lv, cv_); __builtin_amdgcn_sched_barrier(0); }
        { int cv_ = (f2sort(f0[1] + f1[2]) & ~255) | 237; INS16(Lv, cv_); __builtin_amdgcn_sched_barrier(0); }
        { int cv_ = (f2sort(f0[1] + f1[3]) & ~255) | 236; INS16(Lv, cv_); __builtin_amdgcn_sched_barrier(0); }
        { int cv_ = (f2sort(f0[1] + f1[4]) & ~255) | 235; INS16(Lv, cv_); __builtin_amdgcn_sched_barrier(0); }
        { int cv_ = (f2sort(f0[1] + f1[5]) & ~255) | 234; INS16(Lv, cv_); __builtin_amdgcn_sched_barrier(0); }
        { int cv_ = (f2sort(f0[1] + f1[6]) & ~255) | 233; INS16(Lv, cv_); __builtin_amdgcn_sched_barrier(0); }
        { int cv_ = (f2sort(f0[1] + f1[7]) & ~255) | 232; INS16(Lv, cv_); __builtin_amdgcn_sched_barrier(0); }
        { int cv_ = (f2sort(f0[2] + f1[0]) & ~255) | 223; INS16(Lv, cv_); __builtin_amdgcn_sched_barrier(0); }
        { int cv_ = (f2sort(f0[2] + f1[1]) & ~255) | 222; INS16(Lv, cv_); __builtin_amdgcn_sched_barrier(0); }
        { int cv_ = (f2sort(f0[2] + f1[2]) & ~255) | 221; INS16(Lv, cv_); __builtin_amdgcn_sched_barrier(0); }
        { int cv_ = (f2sort(f0[2] + f1[3]) & ~255) | 220; INS16(Lv, cv_); __builtin_amdgcn_sched_barrier(0); }
        { int cv_ = (f2sort(f0[2] + f1[4]) & ~255) | 219; INS16(Lv, cv_); __builtin_amdgcn_sched_barrier(0); }
        { int cv_ = (f2sort(f0[3] + f1[0]) & ~255) | 207; INS16(Lv, cv_); __builtin_amdgcn_sched_barrier(0); }
        { int cv_ = (f2sort(f0[3] + f1[1]) & ~255) | 206; INS16(Lv, cv_); __builtin_amdgcn_sched_barrier(0); }
        { int cv_ = (f2sort(f0[3] + f1[2]) & ~255) | 205; INS16(Lv, cv_); __builtin_amdgcn_sched_barrier(0); }
        { int cv_ = (f2sort(f0[3] + f1[3]) & ~255) | 204; INS16(Lv, cv_); __builtin_amdgcn_sched_barrier(0); }
        { int cv_ = (f2sort(f0[4] + f1[0]) & ~255) | 191; INS16(Lv, cv_); __builtin_amdgcn_sched_barrier(0); }
        { int cv_ = (f2sort(f0[4] + f1[1]) & ~255) | 190; INS16(Lv, cv_); __builtin_amdgcn_sched_barrier(0); }
        { int cv_ = (f2sort(f0[4] + f1[2]) & ~255) | 189; INS16(Lv, cv_); __builtin_amdgcn_sched_barrier(0); }
        { int cv_ = (f2sort(f0[5] + f1[0]) & ~255) | 175; INS16(Lv, cv_); __builtin_amdgcn_sched_barrier(0); }
        { int cv_ = (f2sort(f0[5] + f1[1]) & ~255) | 174; INS16(Lv, cv_); __builtin_amdgcn_sched_barrier(0); }
        { int cv_ = (f2sort(f0[6] + f1[0]) & ~255) | 159; INS16(Lv, cv_); __builtin_amdgcn_sched_barrier(0); }
        { int cv_ = (f2sort(f0[6] + f1[1]) & ~255) | 158; INS16(Lv, cv_); __builtin_amdgcn_sched_barrier(0); }
        { int cv_ = (f2sort(f0[7] + f1[0]) & ~255) | 143; INS16(Lv, cv_); __builtin_amdgcn_sched_barrier(0); }
        { int cv_ = (f2sort(f0[7] + f1[1]) & ~255) | 142; INS16(Lv, cv_); __builtin_amdgcn_sched_barrier(0); }
        { int cv_ = (f2sort(f0[8] + f1[0]) & ~255) | 127; INS16(Lv, cv_); __builtin_amdgcn_sched_barrier(0); }
        { int cv_ = (f2sort(f0[9] + f1[0]) & ~255) | 111; INS16(Lv, cv_); __builtin_amdgcn_sched_barrier(0); }
        { int cv_ = (f2sort(f0[10] + f1[0]) & ~255) | 95; INS16(Lv, cv_); __builtin_amdgcn_sched_barrier(0); }
        { int cv_ = (f2sort(f0[11] + f1[0]) & ~255) | 79; INS16(Lv, cv_); __builtin_amdgcn_sched_barrier(0); }
        { int cv_ = (f2sort(f0[12] + f1[0]) & ~255) | 63; INS16(Lv, cv_); __builtin_amdgcn_sched_barrier(0); }
        { int cv_ = (f2sort(f0[13] + f1[0]) & ~255) | 47; INS16(Lv, cv_); __builtin_amdgcn_sched_barrier(0); }
        { int cv_ = (f2sort(f0[14] + f1[0]) & ~255) | 31; INS16(Lv, cv_); __builtin_amdgcn_sched_barrier(0); }
        { int cv_ = (f2sort(f0[15] + f1[0]) & ~255) | 15; INS16(Lv, cv_); __builtin_amdgcn_sched_barrier(0); }
        float g[16]; float sum = 0.f; const float mx = sort2f(Lv[0] & ~255);
        int Le[16];
#pragma unroll
        for (int i = 0; i < 16; ++i) {
            g[i] = __expf(sort2f(Lv[i] & ~255) - mx); sum += g[i];
            const int pos = 255 - (Lv[i] & 255);
            const int ia = *(const LAS unsigned char*)(tab + (pos >> 4)), ib = *(const LAS unsigned char*)(tab + 16 + (pos & 15));
            Le[i] = ia * 128 + ib;
        }
        const float inv = 1.f / sum;
        if (hi == 0) {
            int* ip = (int*)(p.ws + WS_IDX) + (size_t)(t0 + r32) * 128 + h * 16; float* gp = (float*)(p.ws + WS_GATE) + (size_t)(t0 + r32) * 128 + h * 16;
#pragma unroll
            for (int i = 0; i < 4; ++i) {
                *(u32x4*)(ip + 4 * i) = (u32x4){(unsigned)Le[4 * i], (unsigned)Le[4 * i + 1], (unsigned)Le[4 * i + 2], (unsigned)Le[4 * i + 3]};
                *(f32x4*)(gp + 4 * i) = (f32x4){g[4 * i] * inv, g[4 * i + 1] * inv, g[4 * i + 2] * inv, g[4 * i + 3] * inv};
            }
        }
        asm volatile("s_waitcnt lgkmcnt(0)" ::: "memory");
    }
}
__device__ __forceinline__ void ph_conv(const Params& p, int gwave, int gnw, int lane) {
    const bf16_t* proj = (const bf16_t*)(p.ws + WS_PROJ);
    bf16_t* xa = (bf16_t*)(p.ws + WS_XBCA);
    for (int task = gwave; task < 1536 + 256; task += gnw) {
        if (task < 1536) {
            const int run = task / 3, cg = (task % 3) * 64 + lane, c0 = cg * 8;
            const int t0 = run * 32, s0 = t0 % SEQ;
            float w0[8], w1[8], w2[8], w3[8], bs[8], h1[8], h2[8], h3[8];
#pragma unroll
            for (int i = 0; i < 8; ++i) { w0[i] = p.conv_w[0 * 1536 + c0 + i]; w1[i] = p.conv_w[1 * 1536 + c0 + i]; w2[i] = p.conv_w[2 * 1536 + c0 + i]; w3[i] = p.conv_w[3 * 1536 + c0 + i]; bs[i] = p.conv_b[c0 + i]; h1[i] = 0.f; h2[i] = 0.f; h3[i] = 0.f; }
            const bf16_t* src = proj + (size_t)t0 * NPROJ + C_XBC + c0;
            if (s0 > 0) {
                const u32x4 a = *(const u32x4*)(src - (size_t)1 * NPROJ), b = *(const u32x4*)(src - (size_t)2 * NPROJ), c = *(const u32x4*)(src - (size_t)3 * NPROJ);
                h1[0] = bflo(a.x); h1[1] = bfhi(a.x); h1[2] = bflo(a.y); h1[3] = bfhi(a.y); h1[4] = bflo(a.z); h1[5] = bfhi(a.z); h1[6] = bflo(a.w); h1[7] = bfhi(a.w);
                h2[0] = bflo(b.x); h2[1] = bfhi(b.x); h2[2] = bflo(b.y); h2[3] = bfhi(b.y); h2[4] = bflo(b.z); h2[5] = bfhi(b.z); h2[6] = bflo(b.w); h2[7] = bfhi(b.w);
                h3[0] = bflo(c.x); h3[1] = bfhi(c.x); h3[2] = bflo(c.y); h3[3] = bfhi(c.y); h3[4] = bflo(c.z); h3[5] = bfhi(c.z); h3[6] = bflo(c.w); h3[7] = bfhi(c.w);
            }
            bf16_t* dst = xa + (size_t)t0 * 1536 + c0;
#pragma unroll 16
            for (int i = 0; i < 32; ++i) {
                const u32x4 a = *(const u32x4*)(src + (size_t)i * NPROJ);
                float cur[8] = {bflo(a.x), bfhi(a.x), bflo(a.y), bfhi(a.y), bflo(a.z), bfhi(a.z), bflo(a.w), bfhi(a.w)};
                float o[8];
#pragma unroll
                for (int k = 0; k < 8; ++k) { o[k] = silu_f(bs[k] + w3[k] * cur[k] + w2[k] * h1[k] + w1[k] * h2[k] + w0[k] * h3[k]); h3[k] = h2[k]; h2[k] = h1[k]; h1[k] = cur[k]; }
                u32x4 w; w.x = pk2(o[0], o[1]); w.y = pk2(o[2], o[3]); w.z = pk2(o[4], o[5]); w.w = pk2(o[6], o[7]);
                *(u32x4*)(dst + (size_t)i * 1536) = w;
            }
        } else {
            const int t = (task - 1536) * 64 + lane;
            const u32x4 a = *(const u32x4*)(proj + (size_t)t * NPROJ + C_DT), b = *(const u32x4*)(proj + (size_t)t * NPROJ + C_DT + 8);
            const float raw[16] = {bflo(a.x), bfhi(a.x), bflo(a.y), bfhi(a.y), bflo(a.z), bfhi(a.z), bflo(a.w), bfhi(a.w), bflo(b.x), bfhi(b.x), bflo(b.y), bfhi(b.y), bflo(b.z), bfhi(b.z), bflo(b.w), bfhi(b.w)};
            float* dto = (float*)(p.ws + WS_DT) + (size_t)t * 16; float* cso = (float*)(p.ws + WS_CS) + (size_t)t * 16;
            float dtv[16], csv[16];
#pragma unroll
            for (int hh = 0; hh < 16; ++hh) {
                const float v = raw[hh] + p.dt_bias[hh];
                const float dt = (v > 20.f) ? v : log1pf(__expf(v));
                float c = dt * (-__expf(p.a_log[hh]));
#pragma unroll
                for (int o = 1; o < 64; o <<= 1) { const float u = __shfl_up(c, o); if (lane >= o) c += u; }
                dtv[hh] = dt; csv[hh] = c;
            }
#pragma unroll
            for (int q = 0; q < 4; ++q) { *(f32x4*)(dto + 4 * q) = (f32x4){dtv[4 * q], dtv[4 * q + 1], dtv[4 * q + 2], dtv[4 * q + 3]}; *(f32x4*)(cso + 4 * q) = (f32x4){csv[4 * q], csv[4 * q + 1], csv[4 * q + 2], csv[4 * q + 3]}; }
        }
    }
}
constexpr int P4_ROW = 1152;
__device__ __forceinline__ void fp4_row_load(const Params& p, int row, int lane, f32x4 (&v)[8]) {
    const f32x4* src = (const f32x4*)(((row >= 16384) ? p.v_exp : p.u_exp) + (size_t)(row & 16383) * DM) + lane;
#pragma unroll
    for (int j = 0; j < 8; ++j) v[j] = src[64 * j];
}
__device__ __forceinline__ void fp4_row_store(const Params& p, int row, int lane, const f32x4 (&v)[8]) {
    float mx = 0.f;
#pragma unroll
    for (int j = 0; j < 8; ++j) mx = fmaxf(mx, fmaxf(fmaxf(fabsf(v[j].x), fabsf(v[j].y)), fmaxf(fabsf(v[j].z), fabsf(v[j].w))));
    unsigned sb = f2bf(mx * (1.f / 6.f));
    if (bf2f(sb) * 6.f < mx) sb += 1u;
    if (sb == 0u) sb = 0x3f80u;
    const float inv = 1.f / bf2f(sb);
    unsigned w[4];
#pragma unroll
    for (int q = 0; q < 4; ++q) {
        const f32x4 a = v[2 * q] * inv, b = v[2 * q + 1] * inv;
        unsigned r = 0u;
        r = __builtin_amdgcn_cvt_scalef32_pk_fp4_f32(r, a.x, a.y, 1.0f, 0);
        r = __builtin_amdgcn_cvt_scalef32_pk_fp4_f32(r, a.z, a.w, 1.0f, 1);
        r = __builtin_amdgcn_cvt_scalef32_pk_fp4_f32(r, b.x, b.y, 1.0f, 2);
        r = __builtin_amdgcn_cvt_scalef32_pk_fp4_f32(r, b.z, b.w, 1.0f, 3);
        w[q] = r;
    }
    unsigned char* dst = p.ws + ((row >= 16384) ? WS_V4 : WS_U4) + (size_t)(row & 16383) * P4_ROW;
    *(u32x4*)(dst + lane * 16) = (u32x4){w[0], w[1], w[2], w[3]};
    *(unsigned short*)(dst + 1024 + lane * 2) = (unsigned short)sb;
}
constexpr int SSD_IN = 41472, SSD_BM = 0, SSD_CM = 16384, SSD_XS = 32768, SSD_Z = 36864, SSD_DT = 40960, SSD_CS = 41216, SSD_ST = 2 * SSD_IN, SSD_PART = SSD_ST + 16384, SSD_SYNC = SSD_PART + 3 * 4096;
__device__ __forceinline__ void ssd_decay_block(f32x16& cbt, const f32x4 (&c4)[4], const f32x4 (&d4)[4], float cs_l, int sb, int l, int hi, bool diag) {
#pragma unroll
    for (int q = 0; q < 4; ++q) {
#pragma unroll
        for (int i = 0; i < 4; ++i) {
            const int s = 32 * sb + 8 * q + 4 * hi + i;
            float e = __expf(cs_l - c4[q][i]) * d4[q][i];
            if (diag) e = (s <= l) ? e : 0.f;
            cbt[4 * q + i] *= e;
        }
    }
}
__device__ __forceinline__ void ph_ssd(const Params& p, LAS unsigned char* ldsl, int bid, int wave, int lane) {
    const int b = bid >> 5, h = (bid >> 1) & 15, ph = bid & 1, g = h >> 3;
    const int r32 = lane & 31, hi = lane >> 5;
    const size_t tb0 = (size_t)b * SEQ;
    LAS unsigned* sync = (LAS unsigned*)(ldsl + SSD_SYNC);
    if (threadIdx.x < 16) sync[threadIdx.x] = (threadIdx.x >= 14) ? 0xffffffffu : 0u;
    for (int i = threadIdx.x; i < 8192 / 16; i += NTHR) *(LAS u32x4*)(ldsl + SSD_ST + i * 16) = (u32x4){0u, 0u, 0u, 0u};
    asm volatile("s_waitcnt lgkmcnt(0)" ::: "memory"); __builtin_amdgcn_s_barrier(); asm volatile("" ::: "memory");
    if (wave >= 6) {
        const int cvw = bid * 2 + (wave - 6);
        f32x4 ra[8], rb[8], rc[8], rd[8];
        fp4_row_load(p, cvw, lane, ra); fp4_row_load(p, 512 + cvw, lane, rb); fp4_row_load(p, 1024 + cvw, lane, rc); fp4_row_load(p, 1536 + cvw, lane, rd);
        for (int c = 0; c < 16; ++c) {
            fp4_row_store(p, (4 * c) * 512 + cvw, lane, ra);
            if (c + 1 < 16) fp4_row_load(p, (4 * c + 4) * 512 + cvw, lane, ra);
            fp4_row_store(p, (4 * c + 1) * 512 + cvw, lane, rb);
            if (c + 1 < 16) fp4_row_load(p, (4 * c + 5) * 512 + cvw, lane, rb);
            fp4_row_store(p, (4 * c + 2) * 512 + cvw, lane, rc);
            if (c + 1 < 16) fp4_row_load(p, (4 * c + 6) * 512 + cvw, lane, rc);
            fp4_row_store(p, (4 * c + 3) * 512 + cvw, lane, rd);
            if (c + 1 < 16) fp4_row_load(p, (4 * c + 7) * 512 + cvw, lane, rd);
        }
    } else {
        const bf16_t* xa = (const bf16_t*)(p.ws + WS_XBCA); const bf16_t* proj = (const bf16_t*)(p.ws + WS_PROJ);
        const float dsk = p.d_skip[h];
        const unsigned sa = (unsigned)(size_t)(ldsl + SSD_SYNC);
        const int dq = (wave - 2) & 3;
        const int dr0 = 4 * dq + (lane >> 4);
        const bf16_t* bsrc = xa + (tb0 + dr0) * 1536 + 1024 + g * 128 + (((lane & 15) ^ (dr0 & 15)) * 8);
        const bf16_t* csrc = xa + (tb0 + dr0) * 1536 + 1280 + g * 128 + (((lane & 15) ^ (dr0 & 15)) * 8);
        const bf16_t* xsrc = xa + (tb0 + 16 * dq + (lane >> 2)) * 1536 + h * 64 + ph * 32 + (lane & 3) * 8;
        const bf16_t* zsrc = proj + (tb0 + 16 * dq + (lane >> 2)) * NPROJ + C_Z + h * 64 + ph * 32 + (lane & 3) * 8;
        const float* dsrc = (const float*)(p.ws + ((dq == 0) ? WS_DT : WS_CS)) + (tb0 + lane) * 16 + h;
#define SSD_G16(src, dst) __builtin_amdgcn_global_load_lds((const unsigned*)(src), (LAS unsigned*)(dst), 16, 0, 0)
#define SSD_ISSUE(c, buf) do { if (wave >= 2) { LAS unsigned char* in_ = ldsl + (buf) * SSD_IN; const size_t to_ = (size_t)(c) * 64 * 1536; \
        SSD_G16(bsrc + to_, in_ + SSD_BM + dq * 1024); SSD_G16(bsrc + to_ + 16 * 1536, in_ + SSD_BM + (dq + 4) * 1024); SSD_G16(bsrc + to_ + 32 * 1536, in_ + SSD_BM + (dq + 8) * 1024); SSD_G16(bsrc + to_ + 48 * 1536, in_ + SSD_BM + (dq + 12) * 1024); \
        SSD_G16(csrc + to_, in_ + SSD_CM + dq * 1024); SSD_G16(csrc + to_ + 16 * 1536, in_ + SSD_CM + (dq + 4) * 1024); SSD_G16(csrc + to_ + 32 * 1536, in_ + SSD_CM + (dq + 8) * 1024); SSD_G16(csrc + to_ + 48 * 1536, in_ + SSD_CM + (dq + 12) * 1024); \
        SSD_G16(xsrc + to_, in_ + SSD_XS + dq * 1024); SSD_G16(zsrc + (size_t)(c) * 64 * NPROJ, in_ + SSD_Z + dq * 1024); \
        if (dq < 2) __builtin_amdgcn_global_load_lds((const unsigned*)(dsrc + (size_t)(c) * 64 * 16), (LAS unsigned*)(in_ + ((dq == 0) ? SSD_DT : SSD_CS)), 4, 0, 0); } } while (0)
#define SSD_FLAG_SET(w_, v_) asm volatile("ds_write_b32 %0, %1" :: "v"(sa + 4u * (w_)), "v"((unsigned)(v_)) : "memory")
#define SSD_FLAG_WAIT(w_, v_) do { for (;;) { unsigned fl_; asm volatile("ds_read_b32 %0, %1\n\ts_waitcnt lgkmcnt(0)" : "=&v"(fl_) : "v"(sa + 4u * (w_)) : "memory"); \
        if (__builtin_amdgcn_readfirstlane(fl_) >= (unsigned)(v_)) break; __builtin_amdgcn_s_sleep(1); } asm volatile("" ::: "memory"); } while (0)
        f32x16 S;
#pragma unroll
        for (int r = 0; r < 16; ++r) S[r] = 0.f;
        SSD_ISSUE(0, 0);
        const int xfo = ((lane >> 4) & 1) * 32 + (lane & 3) * 8 + (4 * hi + ((lane & 15) >> 2)) * 64;
        for (int c = 0; c < SEQ / 64; ++c) {
            if (wave >= 2) asm volatile("s_waitcnt vmcnt(0)" ::: "memory");
            asm volatile("s_waitcnt lgkmcnt(0)" ::: "memory");
            {
                const unsigned tgt = (unsigned)(c + 1);
                asm volatile("ds_write_b32 %0, %1" :: "v"(sa + 32u + 4u * (unsigned)wave), "v"(tgt) : "memory");
                for (;;) { u32x4 a, b_; asm volatile("ds_read_b128 %0, %2 offset:32\n\tds_read_b128 %1, %2 offset:48\n\ts_waitcnt lgkmcnt(0)" : "=&v"(a), "=&v"(b_) : "v"(sa) : "memory");
                    const unsigned m = min(min(min(a.x, a.y), min(a.z, a.w)), min(min(b_.x, b_.y), min(b_.z, b_.w)));
                    if (__builtin_amdgcn_readfirstlane(m) >= tgt) break; __builtin_amdgcn_s_sleep(1); }
            }
            asm volatile("" ::: "memory");
            if (c + 1 < SEQ / 64) SSD_ISSUE(c + 1, (c + 1) & 1);
            const LAS unsigned char* in = ldsl + (c & 1) * SSD_IN;
            const LAS unsigned char* STin = ldsl + SSD_ST + (c & 1) * 8192;
            LAS unsigned char* STout = ldsl + SSD_ST + ((c + 1) & 1) * 8192;
            const LAS float* dtl = (const LAS float*)(in + SSD_DT); const LAS float* csl = (const LAS float*)(in + SSD_CS);
            if (wave < 2) {
                const int lb = wave, l = 32 * lb + r32;
                const float cs_l = csl[l];
                f32x16 acc, acc2;
#pragma unroll
                for (int r = 0; r < 16; ++r) { acc[r] = 0.f; acc2[r] = 0.f; }
#pragma unroll
                for (int ks = 0; ks < 8; ks += 2) {
                    acc = __builtin_amdgcn_mfma_f32_32x32x16_bf16(*(const LAS bf16x8*)(STin + (2 * ks + hi) * 512 + r32 * 16), *(const LAS bf16x8*)(in + SSD_CM + l * 256 + (((2 * ks + hi) ^ (l & 15)) << 4)), acc, 0, 0, 0);
                    acc2 = __builtin_amdgcn_mfma_f32_32x32x16_bf16(*(const LAS bf16x8*)(STin + (2 * ks + 2 + hi) * 512 + r32 * 16), *(const LAS bf16x8*)(in + SSD_CM + l * 256 + (((2 * ks + 2 + hi) ^ (l & 15)) << 4)), acc2, 0, 0, 0);
                }
                { const float ecs = __expf(cs_l);
#pragma unroll
                  for (int r = 0; r < 16; ++r) acc[r] = (acc[r] + acc2[r]) * ecs; }
                u32x2 xw[4], zw[4];
#pragma unroll
                for (int q = 0; q < 4; ++q) { xw[q] = *(const LAS u32x2*)(in + SSD_XS + l * 64 + (8 * q + 4 * hi) * 2); zw[q] = *(const LAS u32x2*)(in + SSD_Z + l * 64 + (8 * q + 4 * hi) * 2); }
                SSD_FLAG_WAIT(1 + lb, c + 1);
                { const LAS unsigned char* pp = ldsl + SSD_PART + lb * 4096 + lane * 64;
#pragma unroll
                  for (int q = 0; q < 4; ++q) { const f32x4 v = *(const LAS f32x4*)(pp + q * 16); acc[4 * q] += v[0]; acc[4 * q + 1] += v[1]; acc[4 * q + 2] += v[2]; acc[4 * q + 3] += v[3]; } }
                if (wave == 1) {
                    SSD_FLAG_WAIT(3, c + 1);
                    const LAS unsigned char* pp = ldsl + SSD_PART + 2 * 4096 + lane * 64;
#pragma unroll
                    for (int q = 0; q < 4; ++q) { const f32x4 v = *(const LAS f32x4*)(pp + q * 16); acc[4 * q] += v[0]; acc[4 * q + 1] += v[1]; acc[4 * q + 2] += v[2]; acc[4 * q + 3] += v[3]; }
                }
                bf16_t* yo = (bf16_t*)(p.ws + WS_YSSD) + (tb0 + (size_t)c * 64 + l) * 1024 + h * 64 + ph * 32 + 4 * hi;
#pragma unroll
                for (int q = 0; q < 4; ++q) {
                    const float y0 = (acc[4 * q + 0] + dsk * bflo(xw[q].x)) * silu_f(bflo(zw[q].x)), y1 = (acc[4 * q + 1] + dsk * bfhi(xw[q].x)) * silu_f(bfhi(zw[q].x));
                    const float y2 = (acc[4 * q + 2] + dsk * bflo(xw[q].y)) * silu_f(bflo(zw[q].y)), y3 = (acc[4 * q + 3] + dsk * bfhi(xw[q].y)) * silu_f(bfhi(zw[q].y));
                    u32x2 o; o.x = pk2(y0, y1); o.y = pk2(y2, y3);
                    *(u32x2*)(yo + 8 * q) = o;
                }
            } else {
                if (wave < 5) {
                    const int ib = wave - 2, sb = (ib == 1) ? 1 : 0, lbk = (ib == 0) ? 0 : 1;
                    const int l = 32 * lbk + r32, srow = 32 * sb + r32;
                    const unsigned xpa = (unsigned)(size_t)(in + SSD_XS + xfo + (32 * sb) * 64);
                    s16x4 lo0, hh0, lo1, hh1; TR_PAIR(lo0, hh0, xpa, 0, 512); TR_PAIR(lo1, hh1, xpa, 1024, 512);
                    const float cs_l = csl[l];
                    bf16x8 af[8], bf[8]; f32x4 c4[4], d4[4];
#pragma unroll
                    for (int ks = 0; ks < 8; ++ks) { af[ks] = *(const LAS bf16x8*)(in + SSD_BM + srow * 256 + (((2 * ks + hi) ^ (srow & 15)) << 4)); bf[ks] = *(const LAS bf16x8*)(in + SSD_CM + l * 256 + (((2 * ks + hi) ^ (l & 15)) << 4)); }
#pragma unroll
                    for (int q = 0; q < 4; ++q) { c4[q] = *(const LAS f32x4*)(csl + 32 * sb + 8 * q + 4 * hi); d4[q] = *(const LAS f32x4*)(dtl + 32 * sb + 8 * q + 4 * hi); }
                    LDS_WAIT_PIN();
                    f32x16 ca, cb;
#pragma unroll
                    for (int r = 0; r < 16; ++r) { ca[r] = 0.f; cb[r] = 0.f; }
#pragma unroll
                    for (int ks = 0; ks < 8; ks += 2) {
                        ca = __builtin_amdgcn_mfma_f32_32x32x16_bf16(af[ks], bf[ks], ca, 0, 0, 0);
                        cb = __builtin_amdgcn_mfma_f32_32x32x16_bf16(af[ks + 1], bf[ks + 1], cb, 0, 0, 0);
                    }
                    ca += cb;
                    if (ib == 2) ssd_decay_block(ca, c4, d4, cs_l, 0, l, hi, false); else ssd_decay_block(ca, c4, d4, cs_l, sb, l, hi, true);
                    u32x4 w0, w1;
                    w0.x = cvtpk(ca[0], ca[1]); w0.y = cvtpk(ca[2], ca[3]); w0.z = cvtpk(ca[4], ca[5]); w0.w = cvtpk(ca[6], ca[7]);
                    w1.x = cvtpk(ca[8], ca[9]); w1.y = cvtpk(ca[10], ca[11]); w1.z = cvtpk(ca[12], ca[13]); w1.w = cvtpk(ca[14], ca[15]);
                    f32x16 pa;
#pragma unroll
                    for (int r = 0; r < 16; ++r) pa[r] = 0.f;
                    pa = __builtin_amdgcn_mfma_f32_32x32x16_bf16((bf16x8){lo0[0], lo0[1], lo0[2], lo0[3], hh0[0], hh0[1], hh0[2], hh0[3]}, __builtin_bit_cast(bf16x8, w0), pa, 0, 0, 0);
                    pa = __builtin_amdgcn_mfma_f32_32x32x16_bf16((bf16x8){lo1[0], lo1[1], lo1[2], lo1[3], hh1[0], hh1[1], hh1[2], hh1[3]}, __builtin_bit_cast(bf16x8, w1), pa, 0, 0, 0);
                    LAS unsigned char* pp = ldsl + SSD_PART + ib * 4096 + lane * 64;
#pragma unroll
                    for (int q = 0; q < 4; ++q) *(LAS f32x4*)(pp + q * 16) = (f32x4){pa[4 * q], pa[4 * q + 1], pa[4 * q + 2], pa[4 * q + 3]};
                    asm volatile("s_waitcnt lgkmcnt(0)" ::: "memory");
                    SSD_FLAG_SET(1 + ib, c + 1);
                }
                const int nb = wave - 2;
                const float cs63 = csl[63];
                { const float dec = __expf(cs63);
#pragma unroll
                  for (int r = 0; r < 16; ++r) S[r] *= dec; }
                const int brow = 4 * hi + ((lane & 15) >> 2), bch = 4 * nb + 2 * ((lane >> 4) & 1) + ((lane & 3) >> 1);
                const unsigned xpa = (unsigned)(size_t)(in + xfo);
                const unsigned bpa = (unsigned)(size_t)(in + SSD_BM + brow * 256 + ((bch ^ brow) << 4) + (lane & 1) * 8);
                const unsigned bpb = (unsigned)(size_t)(in + SSD_BM + (brow + 8) * 256 + ((bch ^ (brow + 8)) << 4) + (lane & 1) * 8);
                s16x4 lo[4], hh[4], blo[4], bhh[4]; f32x4 c0[4], c1[4], d0[4], d1[4];
                TR_PAIR(lo[0], hh[0], xpa, SSD_XS + 0 * 1024, 512); TR_PAIR(lo[1], hh[1], xpa, SSD_XS + 1 * 1024, 512); TR_PAIR(lo[2], hh[2], xpa, SSD_XS + 2 * 1024, 512); TR_PAIR(lo[3], hh[3], xpa, SSD_XS + 3 * 1024, 512);
                asm volatile("ds_read_b64_tr_b16 %0, %1 offset:%c2" : "=&v"(blo[0]) : "v"(bpa), "i"(0 * 4096) : "memory"); asm volatile("ds_read_b64_tr_b16 %0, %1 offset:%c2" : "=&v"(bhh[0]) : "v"(bpb), "i"(0 * 4096) : "memory");
                asm volatile("ds_read_b64_tr_b16 %0, %1 offset:%c2" : "=&v"(blo[1]) : "v"(bpa), "i"(1 * 4096) : "memory"); asm volatile("ds_read_b64_tr_b16 %0, %1 offset:%c2" : "=&v"(bhh[1]) : "v"(bpb), "i"(1 * 4096) : "memory");
                asm volatile("ds_read_b64_tr_b16 %0, %1 offset:%c2" : "=&v"(blo[2]) : "v"(bpa), "i"(2 * 4096) : "memory"); asm volatile("ds_read_b64_tr_b16 %0, %1 offset:%c2" : "=&v"(bhh[2]) : "v"(bpb), "i"(2 * 4096) : "memory");
                asm volatile("ds_read_b64_tr_b16 %0, %1 offset:%c2" : "=&v"(blo[3]) : "v"(bpa), "i"(3 * 4096) : "memory"); asm volatile("ds_read_b64_tr_b16 %0, %1 offset:%c2" : "=&v"(bhh[3]) : "v"(bpb), "i"(3 * 4096) : "memory");
#pragma unroll
                for (int ks = 0; ks < 4; ++ks) { c0[ks] = *(const LAS f32x4*)(csl + 16 * ks + 4 * hi); c1[ks] = *(const LAS f32x4*)(csl + 16 * ks + 8 + 4 * hi);
                                                 d0[ks] = *(const LAS f32x4*)(dtl + 16 * ks + 4 * hi); d1[ks] = *(const LAS f32x4*)(dtl + 16 * ks + 8 + 4 * hi); }
                LDS_WAIT_PIN();
                u32x4 aw[4];
#pragma unroll
                for (int ks = 0; ks < 4; ++ks) {
                    float xf[8];
#pragma unroll
                    for (int j = 0; j < 4; ++j) { xf[j] = bf2f((unsigned short)lo[ks][j]) * __expf(cs63 - c0[ks][j]) * d0[ks][j]; xf[4 + j] = bf2f((unsigned short)hh[ks][j]) * __expf(cs63 - c1[ks][j]) * d1[ks][j]; }
                    aw[ks].x = cvtpk(xf[0], xf[1]); aw[ks].y = cvtpk(xf[2], xf[3]); aw[ks].z = cvtpk(xf[4], xf[5]); aw[ks].w = cvtpk(xf[6], xf[7]);
                }
#pragma unroll
                for (int ks = 0; ks < 4; ++ks)
                    S = __builtin_amdgcn_mfma_f32_32x32x16_bf16(__builtin_bit_cast(bf16x8, aw[ks]), (bf16x8){blo[ks][0], blo[ks][1], blo[ks][2], blo[ks][3], bhh[ks][0], bhh[ks][1], bhh[ks][2], bhh[ks][3]}, S, 0, 0, 0);
                const int n = 32 * nb + r32;
#pragma unroll
                for (int r = 0; r < 16; ++r) *(LAS unsigned short*)(STout + (n >> 3) * 512 + crow(r, hi) * 16 + (n & 7) * 2) = (unsigned short)f2bf(S[r]);
            }
        }
#undef SSD_ISSUE
#undef SSD_G16
#undef SSD_FLAG_SET
#undef SSD_FLAG_WAIT
    }
    asm volatile("s_waitcnt vmcnt(0) lgkmcnt(0)" ::: "memory");
    __builtin_amdgcn_s_barrier(); asm volatile("" ::: "memory");
}
__device__ __forceinline__ void ph_peer4(const Params& p, LAS unsigned char* ldsl, int wave, int lane, int gwave, int gnw) {
    LAS unsigned char* ring = ldsl + wave * 16384;
    const unsigned char* U = (const unsigned char*)(p.ws + WS_U4); const unsigned char* V = (const unsigned char*)(p.ws + WS_V4);
    const int e_lane = (lane >> 2) & 15; const unsigned lane16 = (unsigned)lane * 16u, lanesc = 1024u + (unsigned)(lane >> 1) * 4u;
#define P4_ISSUE(R) do { const int R_ = (R); const int i_ = ((R_ >> 5) << 4) + (R_ & 15); \
        const int e_ = (i_ < 64) ? __builtin_amdgcn_readlane(idx0, i_) : __builtin_amdgcn_readlane(idx1, i_ - 64); \
        const unsigned char* base_ = (((R_ >> 4) & 1) ? V : U) + (size_t)(unsigned)e_ * P4_ROW; \
        LAS unsigned char* dst_ = ring + (R_ & 7) * 1280; \
        __builtin_amdgcn_global_load_lds((const unsigned*)(base_ + lane16), (LAS unsigned*)(dst_), 16, 0, 0); \
        __builtin_amdgcn_global_load_lds((const unsigned*)(base_ + lanesc), (LAS unsigned*)(dst_ + 1024), 4, 0, 0); } while (0)
#define P4_WAIT(n) asm volatile("s_waitcnt vmcnt(" #n ")" ::: "memory")
#define P4_CVT(wd, bs) __builtin_amdgcn_cvt_scalef32_pk_f32_fp4((wd), 1.0f, (bs))
    for (int t = gwave; t < T; t += gnw) {
        const int b = t / SEQ;
        const int idx0 = ((const int*)(p.ws + WS_IDX))[(size_t)t * 128 + lane], idx1 = ((const int*)(p.ws + WS_IDX))[(size_t)t * 128 + 64 + lane];
        float gv0 = ((const float*)(p.ws + WS_GATE))[(size_t)t * 128 + lane], gv1 = ((const float*)(p.ws + WS_GATE))[(size_t)t * 128 + 64 + lane];
        f32x2_t hf[16];
        {
            const bf16_t* hp = (const bf16_t*)(p.ws + WS_H2) + (size_t)t * DM + lane * 4;
#pragma unroll
            for (int j = 0; j < 8; ++j) { const u32x2 a = *(const u32x2*)(hp + j * 256); hf[2 * j] = (f32x2_t){bflo(a.x), bfhi(a.x)}; hf[2 * j + 1] = (f32x2_t){bflo(a.y), bfhi(a.y)}; }
        }
        f32x2_t out[16];
#pragma unroll
        for (int i = 0; i < 16; ++i) out[i] = (f32x2_t){0.f, 0.f};
        asm volatile("" : "+v"(gv0), "+v"(gv1));
        P4_ISSUE(0); P4_ISSUE(1); P4_ISSUE(2); P4_ISSUE(3); P4_ISSUE(4); P4_ISSUE(5); P4_ISSUE(6);
        for (int hh = 0; hh < 8; ++hh) {
            float pd[16];
#pragma unroll
            for (int k = 0; k < 16; ++k) {
                P4_ISSUE(hh * 32 + k + 7); P4_WAIT(14);
                const LAS unsigned char* sl = ring + (k & 7) * 1280;
                const u32x4 w = *(const LAS u32x4*)(sl + lane * 16);
                const unsigned sw = *(const LAS unsigned*)(sl + 1024 + lane * 4);
                const float scl = (lane & 1) ? bfhi(sw) : bflo(sw);
                f32x2_t a2 = (f32x2_t){0.f, 0.f};
                a2 += P4_CVT(w.x, 0) * hf[0]; a2 += P4_CVT(w.x, 1) * hf[1]; a2 += P4_CVT(w.x, 2) * hf[2]; a2 += P4_CVT(w.x, 3) * hf[3];
                a2 += P4_CVT(w.y, 0) * hf[4]; a2 += P4_CVT(w.y, 1) * hf[5]; a2 += P4_CVT(w.y, 2) * hf[6]; a2 += P4_CVT(w.y, 3) * hf[7];
                a2 += P4_CVT(w.z, 0) * hf[8]; a2 += P4_CVT(w.z, 1) * hf[9]; a2 += P4_CVT(w.z, 2) * hf[10]; a2 += P4_CVT(w.z, 3) * hf[11];
                a2 += P4_CVT(w.w, 0) * hf[12]; a2 += P4_CVT(w.w, 1) * hf[13]; a2 += P4_CVT(w.w, 2) * hf[14]; a2 += P4_CVT(w.w, 3) * hf[15];
                float a = (a2.x + a2.y) * scl;
                asm volatile("" : "+v"(a));
                pd[k] = a;
            }
            float q8[8], q4[4], q2[2], q1;
            { const bool hi = (lane & 32) != 0;
#pragma unroll
              for (int i = 0; i < 8; ++i) { const float keep = hi ? pd[i + 8] : pd[i], send = hi ? pd[i] : pd[i + 8]; q8[i] = keep + __shfl_xor(send, 32); } }
            { const bool hi = (lane & 16) != 0;
#pragma unroll
              for (int i = 0; i < 4; ++i) { const float keep = hi ? q8[i + 4] : q8[i], send = hi ? q8[i] : q8[i + 4]; q4[i] = keep + __shfl_xor(send, 16); } }
            { const bool hi = (lane & 8) != 0;
#pragma unroll
              for (int i = 0; i < 2; ++i) { const float keep = hi ? q4[i + 2] : q4[i], send = hi ? q4[i] : q4[i + 2]; q2[i] = keep + __shfl_xor(send, 8); } }
            { const bool hi = (lane & 4) != 0; const float keep = hi ? q2[1] : q2[0], send = hi ? q2[0] : q2[1]; q1 = keep + __shfl_xor(send, 4); }
            q1 += __shfl_xor(q1, 1); q1 += __shfl_xor(q1, 2);
            const float act = 0.5f * q1 * (1.f + erff(q1 * 0.70710678118654752f)) * __shfl((hh < 4) ? gv0 : gv1, (hh & 3) * 16 + e_lane);
#pragma unroll
            for (int k = 0; k < 16; ++k) {
                if (k < 9) { P4_ISSUE(hh * 32 + 16 + k + 7); P4_WAIT(14); }
                else if (hh < 7) { P4_ISSUE(hh * 32 + 16 + k + 7); P4_WAIT(14); }
                else if (k == 9) P4_WAIT(12); else if (k == 10) P4_WAIT(10); else if (k == 11) P4_WAIT(8); else if (k == 12) P4_WAIT(6); else if (k == 13) P4_WAIT(4); else if (k == 14) P4_WAIT(2); else P4_WAIT(0);
                const LAS unsigned char* sl = ring + (k & 7) * 1280;
                const u32x4 w = *(const LAS u32x4*)(sl + lane * 16);
                const unsigned sw = *(const LAS unsigned*)(sl + 1024 + lane * 4);
                const float a = __builtin_bit_cast(float, __builtin_amdgcn_readlane(__builtin_bit_cast(int, act), 4 * k)) * ((lane & 1) ? bfhi(sw) : bflo(sw));
                const f32x2_t aa = (f32x2_t){a, a};
                out[0] += aa * P4_CVT(w.x, 0); out[1] += aa * P4_CVT(w.x, 1); out[2] += aa * P4_CVT(w.x, 2); out[3] += aa * P4_CVT(w.x, 3);
                out[4] += aa * P4_CVT(w.y, 0); out[5] += aa * P4_CVT(w.y, 1); out[6] += aa * P4_CVT(w.y, 2); out[7] += aa * P4_CVT(w.y, 3);
                asm volatile("" : "+v"(out[0]), "+v"(out[1]), "+v"(out[2]), "+v"(out[3]), "+v"(out[4]), "+v"(out[5]), "+v"(out[6]), "+v"(out[7]));
                out[8] += aa * P4_CVT(w.z, 0); out[9] += aa * P4_CVT(w.z, 1); out[10] += aa * P4_CVT(w.z, 2); out[11] += aa * P4_CVT(w.z, 3);
                out[12] += aa * P4_CVT(w.w, 0); out[13] += aa * P4_CVT(w.w, 1); out[14] += aa * P4_CVT(w.w, 2); out[15] += aa * P4_CVT(w.w, 3);
                asm volatile("" : "+v"(out[8]), "+v"(out[9]), "+v"(out[10]), "+v"(out[11]), "+v"(out[12]), "+v"(out[13]), "+v"(out[14]), "+v"(out[15]));
            }
        }
        const float* g2 = (const float*)(p.ws + WS_MOD) + (size_t)b * 6 * DM + 5 * DM;
        float* outp = p.out + (size_t)t * DM;
#pragma unroll
        for (int j = 0; j < 8; ++j) {
            const int c = j * 256 + lane * 4;
            const f32x4 x0 = *(const f32x4*)(outp + c), ga = *(const f32x4*)(g2 + c);
            *(f32x4*)(outp + c) = (f32x4){x0.x + ga.x * out[2 * j].x, x0.y + ga.y * out[2 * j].y, x0.z + ga.z * out[2 * j + 1].x, x0.w + ga.w * out[2 * j + 1].y};
        }
    }
#undef P4_ISSUE
#undef P4_WAIT
#undef P4_CVT
}
constexpr int RING_BYTES = 131072, LDSCTL_OFF = 146432, MISC_OFF = LDSCTL_OFF + 320, LDS_BYTES = 147456;
static_assert(SSD_SYNC + 64 <= LDSCTL_OFF, "SSD LDS map");
constexpr int NPH = 13;
#ifndef MK_PER_PHASE
#define MK_PER_PHASE 0
#endif

__global__ void __launch_bounds__(NTHR, 2) mega(Params p) {
    extern __shared__ __attribute__((aligned(16))) unsigned char lds[];
    LAS unsigned char* ldsl = (LAS unsigned char*)lds;
    const int tid = threadIdx.x, lane = tid & 63, wave = __builtin_amdgcn_readfirstlane(tid >> 6);
    const int G = gridDim.x, bid = blockIdx.x;
    unsigned char* ws = p.ws;
    gu32* ctl = (gu32*)(ws + WS_CTL);
    for (int u = tid; u < (LDS_BYTES - LDSCTL_OFF) / 4; u += NTHR) ((LAS unsigned*)(ldsl + LDSCTL_OFF))[u] = 0u;
    __syncthreads();
    volatile LAS unsigned* MISC = (volatile LAS unsigned*)(ldsl + MISC_OFF);
    XcdBarrier bar; bar.bar = (unsigned*)(ctl + CW_BAR); bar.x = 0; bar.st = nullptr;
    if (!MK_PER_PHASE) bar = xcd_barrier_post((unsigned*)(ctl + CW_BAR), MISC + 8);
#define IN(k) (p.ph_lo <= (k) && (k) < p.ph_hi)
#define LN() ({ int l_ = lane; asm volatile("" : "+v"(l_)); l_; })
#define WV() ({ int w_ = wave; asm volatile("" : "+s"(w_)); w_; })
#define SEAM(k) do { if ((k) + 1 < p.ph_hi) xcd_barrier(bar); } while (0)
    const int gtid = bid * NTHR + tid, gn = G * NTHR, gwave = bid * NWAVES + wave, gnw = G * NWAVES;
    float* mod = (float*)(ws + WS_MOD);

    if (IN(0)) {
        if (bid < 96) ph_mod(p, lds, tid, bid);
        else ph_transposes(p, lds, WV(), LN(), (bid - 96) * NWAVES + wave, (G - 96) * NWAVES);
        ph_rope_tab(p, gtid, gn);
        ph_convert(p.sub_keys, (bf16_t*)(ws + WS_SUBK), (size_t)8 * 2 * 128 * 128 / 4, gtid, gn);
        SEAM(0);
    }
    if (IN(1)) { ph_modrows(p.x, (bf16_t*)(ws + WS_H), mod, 0, 1, gwave, gnw, LN()); SEAM(1); }
    if (IN(2)) {
        pg8::Gemm g{(const bf16_t*)(ws + WS_H), (const bf16_t*)(ws + WS_WINT), T, NPROJ, DM, DM}; pg8::StaticOrder S; S.init(T, NPROJ, G, bid);
        pg8::EpiBf16<0> E{(bf16_t*)(ws + WS_PROJ), NPROJ, nullptr, 0, 0, 1.f};
        pg8::gemm_phase<pg8::EpiBf16<0>, pg8::StaticOrder, true, true>(ldsl, g, S, E);
        SEAM(2);
    }
    if (IN(3)) {
        { pg8::Gemm g{(const bf16_t*)(ws + WS_PROJ) + C_CQ, (const bf16_t*)(ws + WS_WUQT), T, NQ, 512, NPROJ}; pg8::StaticOrder S; S.init(T, NQ, G, bid);
          pg8::EpiBf16<0> E{(bf16_t*)(ws + WS_QRAW), NQ, nullptr, 0, 0, 1.f};
          pg8::gemm_phase<pg8::EpiBf16<0>, pg8::StaticOrder, true, true>(ldsl, g, S, E); }
        { pg8::Gemm g{(const bf16_t*)(ws + WS_PROJ) + C_CKV, (const bf16_t*)(ws + WS_WUKVT), T, NKV, 256, NPROJ}; pg8::StaticOrder S; S.init(T, NKV, G, bid);
          pg8::EpiBf16<0> E{(bf16_t*)(ws + WS_KVRAW), NKV, nullptr, 0, 0, 1.f};
          pg8::gemm_phase<pg8::EpiBf16<0>, pg8::StaticOrder, true, true>(ldsl, g, S, E); }
        SEAM(3);
    }
    if (IN(4)) { ph_qkv_post(p, gwave, gnw, LN()); ph_conv(p, gwave, gnw, LN()); SEAM(4); }
    if (IN(5)) { ph_attn(p, ldsl, bid, G, WV(), LN()); SEAM(5); }
    if (IN(6)) { ph_ssd(p, ldsl, bid, WV(), LN()); SEAM(6); }
    if (IN(7)) { ph_mixnorm(p, gwave, gnw, LN()); SEAM(7); }
    if (IN(8)) {
        pg8::Gemm g{(const bf16_t*)(ws + WS_MIXIN), (const bf16_t*)(ws + WS_WOUTT), T, DM, DM, DM}; pg8::StaticOrder S; S.init(T, DM, G, bid);
        pg8::EpiResid E{p.x, p.out, mod + 2 * DM, DM, SEQ, 6 * DM};
        pg8::gemm_phase<pg8::EpiResid, pg8::StaticOrder, true, true>(ldsl, g, S, E);
        SEAM(8);
    }
    if (IN(9)) {
        ph_modrows(p.out, (bf16_t*)(ws + WS_H2), mod, 3, 4, gwave, gnw, LN());
        SEAM(9);
    }
    if (IN(10)) {
        pg8::Gemm g{(const bf16_t*)(ws + WS_H2), (const bf16_t*)(ws + WS_WQT), T, DM, DM, DM}; pg8::StaticOrder S; S.init(T, DM, G, bid);
        pg8::EpiBf16<0> E{(bf16_t*)(ws + WS_QP), DM, nullptr, 0, 0, 1.f};
        pg8::gemm_phase<pg8::EpiBf16<0>, pg8::StaticOrder, true, true>(ldsl, g, S, E);
        SEAM(10);
    }
    if (IN(11)) { ph_route(p, ldsl, WV(), LN(), gwave, gnw); SEAM(11); }
    if (IN(12)) { ph_peer4(p, ldsl, WV(), LN(), gwave, gnw); }
#undef IN
#undef SEAM
}

extern "C" void kernel_launch(void* const* d_in, const int* in_sizes, int n_in, void* d_out, int out_size, void* d_ws, size_t ws_size, hipStream_t stream) {
    static int grid = 0;
    if (grid == 0) {
        if (n_in != 24 || ws_size < WS_END) { fprintf(stderr, "kernel_launch: unexpected inputs / workspace (%d, %zu)\n", n_in, ws_size); grid = -1; return; }
        if (hipFuncSetAttribute((const void*)mega, hipFuncAttributeMaxDynamicSharedMemorySize, LDS_BYTES) != hipSuccess) { fprintf(stderr, "kernel_launch: hipFuncSetAttribute failed\n"); grid = -1; return; }
        (void)hipGetLastError();
        grid = 256;
    }
    if (grid < 0) return;
    (void)hipMemsetAsync((char*)d_ws + WS_CTL, 0, CTL_ZERO_BYTES, stream);
    Params p{};
    p.x = (const float*)d_in[0]; p.c = (const float*)d_in[1]; p.pos = (const int*)d_in[2]; p.w_ada = (const float*)d_in[3]; p.b_ada = (const float*)d_in[4];
    p.w_in = (const float*)d_in[5]; p.q_a_norm = (const float*)d_in[6]; p.w_uq = (const float*)d_in[7]; p.kv_a_norm = (const float*)d_in[8]; p.w_ukv = (const float*)d_in[9];
    p.q_norm = (const float*)d_in[10]; p.k_norm = (const float*)d_in[11]; p.attn_out_norm = (const float*)d_in[12]; p.conv_w = (const float*)d_in[13]; p.conv_b = (const float*)d_in[14];
    p.dt_bias = (const float*)d_in[15]; p.a_log = (const float*)d_in[16]; p.d_skip = (const float*)d_in[17]; p.ssd_norm = (const float*)d_in[18]; p.w_out = (const float*)d_in[19];
    p.w_query = (const float*)d_in[20]; p.sub_keys = (const float*)d_in[21]; p.u_exp = (const float*)d_in[22]; p.v_exp = (const float*)d_in[23];
    p.out = (float*)d_out; p.ws = (unsigned char*)d_ws;
#if MK_PER_PHASE
    for (int ph = 0; ph < NPH; ++ph) { p.ph_lo = ph; p.ph_hi = ph + 1; hipLaunchKernelGGL(mega, dim3(grid), dim3(NTHR), LDS_BYTES, stream, p); }
#elif defined(PROBE_SEQ)
    { const int seq[] = {PROBE_SEQ}; const int nl = (int)(sizeof(seq) / sizeof(int)) / 2;
      for (int li = 0; li < nl; ++li) { if (li) (void)hipMemsetAsync((char*)d_ws + WS_CTL, 0, CTL_ZERO_BYTES, stream);
          p.ph_lo = seq[2 * li]; p.ph_hi = seq[2 * li + 1]; hipLaunchKernelGGL(mega, dim3(grid), dim3(NTHR), LDS_BYTES, stream, p); } }
#else
    p.ph_lo = 0; p.ph_hi = NPH;
    hipLaunchKernelGGL(mega, dim3(grid), dim3(NTHR), LDS_BYTES, stream, p);
#endif
}
```

```cpp
#include <hip/hip_runtime.h>
#include <cstdint>
#include <cstdio>
#include <cmath>

constexpr int DM = 2048, NB = 8, SEQ = 2048, T = NB * SEQ;
constexpr int IN_COLS = 3408, NPROJ = 3584;
constexpr int C_CQ = 0, C_CKV = 512, C_KR = 768, C_Z = 832, C_XBC = 1856, C_DT = 3392;
constexpr int NQ = 1536, NKV = 2048;
constexpr float EPS = 1e-6f;
constexpr int NTHR = 512, NWAVES = 8;

typedef unsigned short bf16_t;
typedef unsigned u32x4 __attribute__((ext_vector_type(4)));
typedef float f32x4 __attribute__((ext_vector_type(4)));
typedef unsigned u32x2 __attribute__((ext_vector_type(2)));
#define GAS __attribute__((address_space(1)))
#define LAS __attribute__((address_space(3)))
typedef GAS unsigned gu32;
typedef GAS unsigned long long gu64;
#define RLX_AGENT __ATOMIC_RELAXED, __HIP_MEMORY_SCOPE_AGENT

__device__ __forceinline__ unsigned f2bf(float f) { unsigned u = __builtin_bit_cast(unsigned, f); return (u + 0x7fffu + ((u >> 16) & 1u)) >> 16; }
__device__ __forceinline__ float bf2f(unsigned h) { return __builtin_bit_cast(float, h << 16); }
__device__ __forceinline__ unsigned pk2(float lo, float hi) { return f2bf(lo) | (f2bf(hi) << 16); }
__device__ __forceinline__ float bflo(unsigned w) { return __builtin_bit_cast(float, w << 16); }
__device__ __forceinline__ float bfhi(unsigned w) { return __builtin_bit_cast(float, w & 0xffff0000u); }
__device__ __forceinline__ float silu_f(float v) { return v / (1.f + __expf(-v)); }
__device__ __forceinline__ float wave_sum(float v) {
#pragma unroll
    for (int o = 1; o < 64; o <<= 1) v += __shfl_xor(v, o);
    return v;
}

constexpr size_t MiB = 1u << 20;
constexpr size_t WS_CTL = 0, CTL_ZERO_BYTES = 64 * 1024, WS_MOD = 1 * MiB, WS_ROPEC = 2 * MiB, WS_ROPES = 4 * MiB, WS_SUBK = 6 * MiB, WS_WUQT = 7 * MiB, WS_WUKVT = 9 * MiB,
                 WS_WINT = 10 * MiB, WS_WOUTT = 24 * MiB, WS_WQT = 32 * MiB,
                 WS_US = 40 * MiB, WS_VS = 41 * MiB, WS_CS = 50 * MiB, WS_DT = 51 * MiB, WS_IDX = 52 * MiB, WS_GATE = 60 * MiB, WS_U16 = 68 * MiB, WS_V16 = 132 * MiB, WS_U8 = 68 * MiB, WS_V8 = 100 * MiB, WS_U4 = 420 * MiB, WS_V4 = 440 * MiB,
                 WS_K = 68 * MiB, WS_YSSD = 68 * MiB, WS_XBCA = 116 * MiB, WS_ATTN = 164 * MiB,
                 WS_H = 196 * MiB, WS_Q = 196 * MiB, WS_MIXIN = 196 * MiB, WS_H2 = 196 * MiB,
                 WS_PROJ = 260 * MiB, WS_QP = 260 * MiB, WS_QRAW = 372 * MiB, WS_KVRAW = 420 * MiB, WS_V = 484 * MiB, WS_END = 516 * MiB;
constexpr int CW_BAR = 1024;

struct Params {
    const float *x, *c; const int* pos;
    const float *w_ada, *b_ada, *w_in, *q_a_norm, *w_uq, *kv_a_norm, *w_ukv, *q_norm, *k_norm, *attn_out_norm, *conv_w, *conv_b, *dt_bias, *a_log,
        *d_skip, *ssd_norm, *w_out, *w_query, *sub_keys, *u_exp, *v_exp;
    float* out; unsigned char* ws;
    int ph_lo, ph_hi;
};
namespace pg8 {
#define PG8_LAS __attribute__((address_space(3)))
typedef unsigned short bf16_t;
typedef short bf16x8 __attribute__((ext_vector_type(8)));
typedef float f32x4 __attribute__((ext_vector_type(4)));
typedef unsigned u32x4 __attribute__((ext_vector_type(4)));
constexpr int BM = 256, BK = 64, HALF = 128, HTB = HALF * BK * 2  , STAGE_BYTES = 8 * HTB, NXCD = 8, WGM = 8;

__host__ __device__ __forceinline__ int lds_byte(int r, int c) { const int st = (r >> 4) * 2 + (c >> 5), rr = r & 15, cc = c & 31, ob = rr * 64 + cc * 2; return st * 1024 + (ob ^ (((ob >> 9) & 1) << 5)); }
__host__ __device__ __forceinline__ void stage_rc(int b, int& R, int& C) { const int st = b / 1024, sb = b % 1024, swz = sb ^ (((sb >> 9) & 1) << 5); R = (st >> 1) * 16 + swz / 64; C = (st & 1) * 32 + (swz % 64) / 2; }
__host__ __device__ __forceinline__ int perm32(int rho) { const int n = rho >> 4, i = rho & 15; return 8 * (i >> 2) + 4 * n + (i & 3); }

struct Unit { int pm, pn; };
struct Gemm { const bf16_t* A; const bf16_t* Bt; int M, N, K, lda; };

struct StaticOrder {
    int nM, nN, nwg, G, c;
    __host__ __device__ void init(int M, int N, int G_, int c_) { nM = M / BM; nN = N / BM; nwg = nM * nN; G = G_; c = c_; }
    __host__ __device__ bool next(int i, Unit& u) const {
        const long L = (long)i * G + c; if (L >= nwg) return false;
        int wgid = (int)L; { const int q = nwg / NXCD, r = nwg % NXCD, xcd = wgid % NXCD, off = wgid / NXCD; wgid = (xcd < r ? xcd * (q + 1) : r * (q + 1) + (xcd - r) * q) + off; }
        const int nig = WGM * nN, gid = wgid / nig, fm = gid * WGM, gsz = (nM - fm) < WGM ? (nM - fm) : WGM;
        u.pm = fm + ((wgid % nig) % gsz); u.pn = (wgid % nig) / gsz; return true;
    }
    __device__ __forceinline__ void a_ready(const Unit&) const {}
    __device__ __forceinline__ void done(const Unit&) const {}
};

__device__ __forceinline__ unsigned cvt_pk_bf16(float lo, float hi) { unsigned r; asm volatile("v_cvt_pk_bf16_f32 %0, %1, %2" : "=v"(r) : "v"(lo), "v"(hi)); return r; }
typedef float f32x2 __attribute__((ext_vector_type(2)));
__device__ __forceinline__ f32x2 gelu_pk(f32x2 v) {
    const f32x2 av = __builtin_elementwise_abs(v), d = av * 0.2316418882f + 1.0f;
    f32x2 t; t.x = __builtin_amdgcn_rcpf(d.x); t.y = __builtin_amdgcn_rcpf(d.y);
    f32x2 q = t * 0.5307027145f + (-0.7265760135f); q = q * t + 0.7107068705f; q = q * t + (-0.142248368f); q = q * t + 0.127414796f; q = q * t;
    const f32x2 s = (v * v) * (-0.72134752044f);
    f32x2 e; e.x = __builtin_amdgcn_exp2f(s.x); e.y = __builtin_amdgcn_exp2f(s.y);
    const f32x2 m = v * (q * e), r = v - m;
    f32x2 o; o.x = v.x < 0.f ? m.x : r.x; o.y = v.y < 0.f ? m.y : r.y; return o;
}

template <int ACT  > struct EpiBf16 {
    static constexpr bool PERM = true, AFTER_DRAIN = false; static_assert(ACT == 0 || ACT == 1, "EpiBf16: ACT is 0 (none) or 1 (gelu_pk)");
    bf16_t* O; int ldc; const float* bias; int split_cols; size_t split_stride; float scale0;
    __device__ __forceinline__ void operator()(const f32x4 (&acc)[2][2][4][2], const Unit& u, int wr, int wc, int fr, int fq) const {
        const int row0 = u.pm * BM + wr * 64 + fr; int colt = u.pn * BM; bf16_t* base = O;
        float sc = 1.f; if (split_cols) { const int t = colt / split_cols; base += (size_t)t * split_stride; colt -= t * split_cols; if (t == 0) sc = scale0; }
        const int col0 = colt + wc * 32 + 8 * fq, bcol0 = u.pn * BM + wc * 32 + 8 * fq;
        f32x4 bv[2][2];
#pragma unroll
        for (int bj = 0; bj < 2; ++bj)
#pragma unroll
            for (int n = 0; n < 2; ++n) bv[bj][n] = bias ? *(const f32x4*)(bias + bcol0 + bj * HALF + 4 * n) : (f32x4){0.f, 0.f, 0.f, 0.f};
#pragma unroll
        for (int ai = 0; ai < 2; ++ai)
#pragma unroll
            for (int m = 0; m < 4; ++m) { bf16_t* rowp = base + (size_t)(row0 + ai * HALF + m * 16) * ldc + col0;
#pragma unroll
                for (int bj = 0; bj < 2; ++bj) { f32x4 v0 = acc[ai][bj][m][0] + bv[bj][0], v1 = acc[ai][bj][m][1] + bv[bj][1];
                    if (ACT == 1) { f32x2 a = gelu_pk((f32x2){v0[0], v0[1]}), b = gelu_pk((f32x2){v0[2], v0[3]}), c = gelu_pk((f32x2){v1[0], v1[1]}), d = gelu_pk((f32x2){v1[2], v1[3]});
                        v0 = (f32x4){a.x, a.y, b.x, b.y}; v1 = (f32x4){c.x, c.y, d.x, d.y}; }
                    v0 = v0 * sc; v1 = v1 * sc; u32x4 w; w.x = cvt_pk_bf16(v0[0], v0[1]); w.y = cvt_pk_bf16(v0[2], v0[3]); w.z = cvt_pk_bf16(v1[0], v1[1]); w.w = cvt_pk_bf16(v1[2], v1[3]);
                    *(u32x4*)(rowp + bj * HALF) = w; } }
    }
};
struct EpiResid {
    static constexpr bool PERM = false, AFTER_DRAIN = false;
    const float* resid; float* out; const float* gate; int ldc, rows_per_batch, gate_stride;
    __device__ __forceinline__ void operator()(const f32x4 (&acc)[2][2][4][2], const Unit& u, int wr, int wc, int fr, int fq) const {
        const int col0 = u.pn * BM + wc * 32 + 4 * fq;
        const int b = (u.pm * BM) / rows_per_batch;
        f32x4 gv[2][2];
#pragma unroll
        for (int bj = 0; bj < 2; ++bj)
#pragma unroll
            for (int n = 0; n < 2; ++n) gv[bj][n] = *(const f32x4*)(gate + (size_t)b * gate_stride + col0 + bj * HALF + n * 16);
#pragma unroll
        for (int ai = 0; ai < 2; ++ai)
#pragma unroll
            for (int m = 0; m < 4; ++m) {
                const size_t off = (size_t)(u.pm * BM + ai * HALF + wr * 64 + m * 16 + fr) * ldc + col0;
#pragma unroll
                for (int bj = 0; bj < 2; ++bj)
#pragma unroll
                    for (int n = 0; n < 2; ++n) {
                        const f32x4 bs = *(const f32x4*)(resid + off + bj * HALF + n * 16);
                        *(f32x4*)(out + off + bj * HALF + n * 16) = bs + gv[bj][n] * acc[ai][bj][m][n];
                    }
                if (m & 1) asm volatile("" ::: "memory");
            }
    }
};
template <class Epi, class Sched, bool ALIGN_EPI = false, bool SP2 = false>
__device__ __forceinline__ void gemm_phase(PG8_LAS unsigned char* lds, const Gemm g, const Sched& S, const Epi& E) {
    const int tid = threadIdx.x, wid = __builtin_amdgcn_readfirstlane(tid >> 6), lane = tid & 63, wr = wid >> 2, wc = wid & 3, fr = lane & 15, fq = lane >> 4;
    const int K = g.K, nt = K / BK;
    unsigned voffA[2], voffB[2];
#pragma unroll
    for (int i = 0; i < 2; ++i) { int R, C; stage_rc(tid * 16 + i * 8192, R, C); const int Rb = Epi::PERM ? ((R & ~31) + perm32(R & 31)) : R;
        voffA[i] = (unsigned)(R * g.lda + C) * 2u; voffB[i] = (unsigned)(Rb * K + C) * 2u; }
    const size_t kstep = (size_t)(BK * 2);
    const size_t hstep = (size_t)HALF * K * 2;
    const size_t tstep = 2 * hstep; const size_t hstepA = (size_t)HALF * g.lda * 2, tstepA = 2 * hstepA;
    const unsigned ldsw = (unsigned)wid * 1024u;
    const int aoff = lds_byte(wr * 64 + fr, fq * 8), boff = lds_byte(wc * 32 + fr, fq * 8);
#define PG8_SA(b, h) (((b) * 2 + (h)) * HTB)
#define PG8_SB(b, h) ((4 + (b) * 2 + (h)) * HTB)
#define PG8_STAGE(bufoff, gbase, voff) do { _Pragma("unroll") for (int _i = 0; _i < 2; ++_i) \
        __builtin_amdgcn_global_load_lds((const unsigned*)((const char*)(gbase) + (voff)[_i]), (PG8_LAS unsigned*)(lds + (bufoff) + ldsw + _i * 8192), 16, 0, 0); } while (0)
#define PG8_LDA(dst, b, h) do { _Pragma("unroll") for (int m = 0; m < 4; ++m) _Pragma("unroll") for (int k = 0; k < 2; ++k) dst[m][k] = *(const PG8_LAS bf16x8*)(lds + PG8_SA(b, h) + aoff + m * 2048 + k * 1024); } while (0)
#define PG8_LDB(dst, b, h) do { _Pragma("unroll") for (int n = 0; n < 2; ++n) _Pragma("unroll") for (int k = 0; k < 2; ++k) dst[n][k] = *(const PG8_LAS bf16x8*)(lds + PG8_SB(b, h) + boff + n * 2048 + k * 1024); } while (0)
#define PG8_MMA(ai, bj, At, Bt) do { __builtin_amdgcn_s_setprio(1); _Pragma("unroll") for (int m = 0; m < 4; ++m) _Pragma("unroll") for (int n = 0; n < 2; ++n) _Pragma("unroll") for (int k = 0; k < 2; ++k) \
        acc[ai][bj][m][n] = __builtin_amdgcn_mfma_f32_16x16x32_bf16(Bt[n][k], At[m][k], acc[ai][bj][m][n], 0, 0, 0); __builtin_amdgcn_s_setprio(0); } while (0)
#define PG8_WAIT_V(n) asm volatile("s_waitcnt vmcnt(" #n ")" ::: "memory")
#define PG8_WAIT_L(n) asm volatile("s_waitcnt lgkmcnt(" #n ")" ::: "memory")
#define PG8_BAR __builtin_amdgcn_s_barrier()
#define PG8_SCHED __builtin_amdgcn_sched_barrier(0)
    Unit cur, nxt; int ui = 0;
    if (!S.next(0, cur)) return;
    f32x4 acc[2][2][4][2];
#pragma unroll
    for (int a = 0; a < 2; ++a)
#pragma unroll
        for (int b = 0; b < 2; ++b)
#pragma unroll
            for (int m = 0; m < 4; ++m)
#pragma unroll
                for (int n = 0; n < 2; ++n) acc[a][b][m][n] = (f32x4){0.f, 0.f, 0.f, 0.f};
    bf16x8 At[4][2], B0[2][2], B1[2][2];
    const char* cA = (const char*)g.A + (size_t)cur.pm * tstepA; const char* cB = (const char*)g.Bt + (size_t)cur.pn * tstep;
    S.a_ready(cur);
    if constexpr (SP2) {
        PG8_STAGE(PG8_SB(0, 0), cB, voffB); PG8_STAGE(PG8_SB(0, 1), cB + hstep, voffB); PG8_STAGE(PG8_SA(0, 0), cA, voffA); PG8_STAGE(PG8_SA(0, 1), cA + hstepA, voffA);
        if (wr == 1) PG8_BAR;
        PG8_WAIT_V(2); PG8_BAR;
        PG8_STAGE(PG8_SB(1, 0), cB + kstep, voffB); PG8_STAGE(PG8_SA(1, 0), cA + kstep, voffA); PG8_STAGE(PG8_SB(1, 1), cB + hstep + kstep, voffB);
        PG8_WAIT_V(6); PG8_BAR;
    } else {
        PG8_STAGE(PG8_SB(0, 0), cB, voffB); PG8_STAGE(PG8_SA(0, 0), cA, voffA); PG8_STAGE(PG8_SB(0, 1), cB + hstep, voffB); PG8_STAGE(PG8_SA(0, 1), cA + hstepA, voffA);
        if (wr == 1) PG8_BAR;
        PG8_WAIT_V(4); PG8_BAR;
        PG8_STAGE(PG8_SB(1, 0), cB + kstep, voffB); PG8_STAGE(PG8_SA(1, 0), cA + kstep, voffA); PG8_STAGE(PG8_SB(1, 1), cB + hstep + kstep, voffB);
        PG8_WAIT_V(6); PG8_BAR;
    }
    for (;;) {
        const bool has_next = S.next(ui + 1, nxt);
        const char* nA = has_next ? (const char*)g.A + (size_t)nxt.pm * tstepA : cA; const char* nB = has_next ? (const char*)g.Bt + (size_t)nxt.pn * tstep : cB;
        for (int t = 0; t < nt; t += 2) {
            const bool last = (t == nt - 2);
            const char* a1 = cA + (size_t)(t + 1) * kstep;
            const char* a2 = last ? nA : cA + (size_t)(t + 2) * kstep; const char* b2 = last ? nB : cB + (size_t)(t + 2) * kstep;
            const char* a3 = a2 + kstep; const char* b3 = b2 + kstep;
            if (last && has_next) S.a_ready(nxt);
            if constexpr (SP2) {
            PG8_LDB(B0, 0, 0); PG8_LDB(B1, 0, 1); PG8_SCHED; PG8_LDA(At, 0, 0); PG8_STAGE(PG8_SA(1, 1), a1 + hstepA, voffA);
            PG8_WAIT_V(8); PG8_WAIT_L(0); PG8_BAR; PG8_MMA(0, 0, At, B0); PG8_MMA(0, 1, At, B1); PG8_BAR; PG8_SCHED;
            PG8_LDA(At, 0, 1); PG8_STAGE(PG8_SB(0, 0), b2, voffB); PG8_STAGE(PG8_SB(0, 1), b2 + hstep, voffB); PG8_STAGE(PG8_SA(0, 0), a2, voffA);
            PG8_WAIT_V(8); PG8_WAIT_L(0); PG8_BAR; PG8_MMA(1, 0, At, B0); PG8_MMA(1, 1, At, B1); PG8_BAR; PG8_SCHED;
            PG8_LDB(B0, 1, 0); PG8_LDB(B1, 1, 1); PG8_SCHED; PG8_LDA(At, 1, 0); PG8_STAGE(PG8_SA(0, 1), a2 + hstepA, voffA);
            PG8_WAIT_V(8); PG8_WAIT_L(0); PG8_BAR; PG8_MMA(0, 0, At, B0); PG8_MMA(0, 1, At, B1); PG8_BAR; PG8_SCHED;
            PG8_LDA(At, 1, 1); PG8_STAGE(PG8_SB(1, 0), b3, voffB); PG8_STAGE(PG8_SB(1, 1), b3 + hstep, voffB); PG8_STAGE(PG8_SA(1, 0), a3, voffA);
            PG8_WAIT_V(8); PG8_WAIT_L(0); PG8_BAR; PG8_MMA(1, 0, At, B0); PG8_MMA(1, 1, At, B1); PG8_BAR; PG8_SCHED;
            } else {
            PG8_LDB(B0, 0, 0); PG8_SCHED; PG8_LDA(At, 0, 0); PG8_STAGE(PG8_SA(1, 1), a1 + hstepA, voffA);
            PG8_WAIT_L(8); PG8_BAR; PG8_WAIT_L(0); PG8_MMA(0, 0, At, B0); PG8_BAR; PG8_SCHED;
            PG8_LDB(B1, 0, 1); PG8_STAGE(PG8_SB(0, 0), b2, voffB);
            PG8_BAR; PG8_WAIT_L(0); PG8_MMA(0, 1, At, B1); PG8_BAR;
            PG8_LDA(At, 0, 1); PG8_STAGE(PG8_SA(0, 0), a2, voffA);
            PG8_BAR; PG8_WAIT_L(0); PG8_MMA(1, 0, At, B0); PG8_BAR; PG8_SCHED;
            PG8_STAGE(PG8_SB(0, 1), b2 + hstep, voffB);
            PG8_WAIT_V(6); PG8_BAR; PG8_MMA(1, 1, At, B1); PG8_BAR;
            PG8_LDB(B0, 1, 0); PG8_SCHED; PG8_LDA(At, 1, 0); PG8_STAGE(PG8_SA(0, 1), a2 + hstepA, voffA);
            PG8_WAIT_L(8); PG8_BAR; PG8_WAIT_L(0); PG8_MMA(0, 0, At, B0); PG8_BAR; PG8_SCHED;
            PG8_LDB(B1, 1, 1); PG8_STAGE(PG8_SB(1, 0), b3, voffB);
            PG8_BAR; PG8_WAIT_L(0); PG8_MMA(0, 1, At, B1); PG8_BAR;
            PG8_LDA(At, 1, 1); PG8_STAGE(PG8_SA(1, 0), a3, voffA);
            PG8_BAR; PG8_WAIT_L(0); PG8_MMA(1, 0, At, B0); PG8_BAR; PG8_SCHED;
            PG8_STAGE(PG8_SB(1, 1), b3 + hstep, voffB);
            PG8_WAIT_V(6); PG8_BAR; PG8_MMA(1, 1, At, B1); PG8_BAR;
            }
        }
        if constexpr (ALIGN_EPI) { if (wr == 0) PG8_BAR; }
        if constexpr (!Epi::AFTER_DRAIN) { E(acc, cur, wr, wc, fr, fq); S.done(cur); }
        if (!has_next) break;
#pragma unroll
        for (int a = 0; a < 2; ++a)
#pragma unroll
            for (int b = 0; b < 2; ++b)
#pragma unroll
                for (int m = 0; m < 4; ++m)
#pragma unroll
                    for (int n = 0; n < 2; ++n) acc[a][b][m][n] = (f32x4){0.f, 0.f, 0.f, 0.f};
        cur = nxt; cA = nA; cB = nB; ++ui;
        if constexpr (ALIGN_EPI) { if (wr == 1) PG8_BAR; }
    }
    PG8_WAIT_V(0);
    if constexpr (!ALIGN_EPI) { if (wr == 0) PG8_BAR; }
    PG8_BAR;
    if constexpr (Epi::AFTER_DRAIN) { E.fused(acc, cur, wr, wc, fr, fq, lds, wid, lane); S.done(cur); }
#undef PG8_SA
#undef PG8_SB
#undef PG8_STAGE
#undef PG8_LDA
#undef PG8_LDB
#undef PG8_MMA
#undef PG8_WAIT_V
#undef PG8_WAIT_L
#undef PG8_BAR
#undef PG8_SCHED
}
}
#define LDS_WAIT() asm volatile("s_waitcnt lgkmcnt(0)" ::: "memory")
#define XB_TMO      128
#define XB_XCNT(j)  (256  + 64 * (j))
#define XB_XSUB(j)  (1280 + 64 * (j))
#define XB_XGEN(j)  (2304 + 64 * (j))
#define XB_TOP      3328
#define XB_TOPGEN   3392
#define XCD_BAR_WORDS 3456
#define XB_SPIN_CAP (1u << 18)

__device__ __forceinline__ unsigned xb_ld(unsigned* p)              { return __hip_atomic_load(p, __ATOMIC_RELAXED, __HIP_MEMORY_SCOPE_AGENT); }
__device__ __forceinline__ unsigned xb_add(unsigned* p, unsigned v) { return __hip_atomic_fetch_add(p, v, __ATOMIC_RELAXED, __HIP_MEMORY_SCOPE_AGENT); }
__device__ __forceinline__ unsigned xb_xcc_id() { return (unsigned)__builtin_amdgcn_s_getreg((3 << 11) | 20) & 0xFu; }
#define XB_SPIN(cond, bar) do { unsigned _sp = 0; while (cond) { __builtin_amdgcn_s_sleep(1); \
    if ((++_sp & 255u) == 0u) { if (xb_ld(&(bar)[XB_TMO])) break; if (_sp > XB_SPIN_CAP) { atomicAdd(&(bar)[XB_TMO], 1u); break; } } } } while (0)

struct XcdBarrier {
    unsigned* bar; unsigned x;
    volatile LAS unsigned* st;
};

__device__ __forceinline__ XcdBarrier xcd_barrier_post(unsigned* bar, volatile LAS unsigned* st) {
    XcdBarrier b; b.bar = bar; b.x = xb_xcc_id(); b.st = st;
    if (threadIdx.x == 0) (void)xb_add(&bar[XB_XCNT(b.x)], 1u);
    return b;
}
__device__ __forceinline__ void xcd_barrier_complete(unsigned* bar, unsigned x, unsigned& nloc, unsigned& nx) {
    const unsigned G = gridDim.x * gridDim.y * gridDim.z;
    unsigned sum, cnt, mine, sp = 0u;
    for (;;) {
        sum = 0u; cnt = 0u; mine = 0u;
#pragma unroll
        for (unsigned j = 0; j < 16; ++j) { const unsigned c = xb_ld(&bar[XB_XCNT(j)]); sum += c; cnt += (c > 0u) ? 1u : 0u; mine = (j == x) ? c : mine; }
        if (sum == G) break;
        __builtin_amdgcn_s_sleep(1);
        if ((++sp & 255u) == 0u) { if (xb_ld(&bar[XB_TMO])) break; if (sp > XB_SPIN_CAP) { atomicAdd(&bar[XB_TMO], 1u); break; } }
    }
    nloc = mine > 0u ? mine : 1u; nx = cnt > 0u ? cnt : 1u;
}

__device__ __forceinline__ void xcd_barrier(const XcdBarrier& b) {
    asm volatile("s_waitcnt vmcnt(0)" ::: "memory");
    __syncthreads();
    if (threadIdx.x == 0) {
        unsigned* bar = b.bar;
        __builtin_amdgcn_s_waitcnt(0);
        unsigned nloc = b.st[0], nx = b.st[1];
        if (nloc == 0u) { xcd_barrier_complete(bar, b.x, nloc, nx); b.st[0] = nloc; b.st[1] = nx; }
        const unsigned old = xb_add(&bar[XB_XSUB(b.x)], 1u);
        const unsigned gen = old / nloc;
        if (old + 1u == (gen + 1u) * nloc) {
            __builtin_amdgcn_fence(__ATOMIC_RELEASE, "agent");
            asm volatile("s_waitcnt vmcnt(0)" ::: "memory");
            const unsigned og = xb_add(&bar[XB_TOP], 1u);
            const unsigned tg = og / nx;
            if (og + 1u == (tg + 1u) * nx) xb_add(&bar[XB_TOPGEN], 1u);
            else XB_SPIN(xb_ld(&bar[XB_TOPGEN]) == tg, bar);
            __builtin_amdgcn_fence(__ATOMIC_ACQUIRE, "agent");
            xb_add(&bar[XB_XGEN(b.x)], 1u);
            asm volatile("s_waitcnt vmcnt(0)" ::: "memory");
        } else {
            XB_SPIN(xb_ld(&bar[XB_XGEN(b.x)]) == gen, bar);
            __builtin_amdgcn_fence(__ATOMIC_ACQUIRE, "agent");
            asm volatile("s_waitcnt vmcnt(0)" ::: "memory");
        }
    }
    __syncthreads();
}
#define SYNC() __syncthreads()
__device__ __forceinline__ float silu_fast(float v) { return v * __builtin_amdgcn_rcpf(1.f + __expf(-v)); }
__device__ __forceinline__ float sq2(unsigned w) { const float a = bflo(w), b = bfhi(w); return a * a + b * b; }

__device__ __forceinline__ void ph_mod(const Params& p, unsigned char* lds, int tid, int vb) {
    float* cact = (float*)lds; float* red = (float*)(lds + 65536);
    const int lane = tid & 63, wv = tid >> 6, c4 = lane & 31, kh = lane >> 5;
    for (int i = tid; i < NB * DM; i += NTHR) { const int b = i / DM, k = i % DM; cact[k * NB + b] = silu_f(p.c[i]); }
    SYNC();
    const int n = vb * 128 + 4 * c4;
    f32x4 acc[NB];
#pragma unroll
    for (int b = 0; b < NB; ++b) acc[b] = (f32x4){0.f, 0.f, 0.f, 0.f};
    const float* w = p.w_ada + (size_t)(wv * 256 + kh) * (6 * DM) + n;
#pragma unroll 8
    for (int i = 0; i < 128; ++i) {
        const f32x4 wk = *(const f32x4*)(w + (size_t)(2 * i) * (6 * DM));
        const f32x4 ca = *(const f32x4*)(cact + (wv * 256 + 2 * i + kh) * NB), cb = *(const f32x4*)(cact + (wv * 256 + 2 * i + kh) * NB + 4);
        acc[0] += wk * ca.x; acc[1] += wk * ca.y; acc[2] += wk * ca.z; acc[3] += wk * ca.w; acc[4] += wk * cb.x; acc[5] += wk * cb.y; acc[6] += wk * cb.z; acc[7] += wk * cb.w;
    }
#pragma unroll
    for (int b = 0; b < NB; ++b) { acc[b].x += __shfl_xor(acc[b].x, 32); acc[b].y += __shfl_xor(acc[b].y, 32); acc[b].z += __shfl_xor(acc[b].z, 32); acc[b].w += __shfl_xor(acc[b].w, 32); }
    if (lane < 32) {
#pragma unroll
        for (int b = 0; b < NB; ++b) *(f32x4*)(red + (wv * NB + b) * 128 + 4 * c4) = acc[b];
    }
    SYNC();
    for (int o = tid; o < NB * 128; o += NTHR) {
        const int b = o >> 7, col = o & 127;
        float s = p.b_ada[vb * 128 + col];
#pragma unroll
        for (int w8 = 0; w8 < 8; ++w8) s += red[(w8 * NB + b) * 128 + col];
        ((float*)(p.ws + WS_MOD))[b * 6 * DM + vb * 128 + col] = s;
    }
    SYNC();
}
__device__ __forceinline__ void ph_rope_tab(const Params& p, int gtid, int gn) {
    for (int i = gtid; i < T * 32; i += gn) {
        const int t = i >> 5, f = i & 31;
        const float inv = 1.0f / powf(10000.0f, (float)f * (2.0f / 64.0f));
        const float ang = (float)p.pos[t] * inv;
        ((float*)(p.ws + WS_ROPEC))[i] = (float)cos((double)ang);
        ((float*)(p.ws + WS_ROPES))[i] = (float)sin((double)ang);
    }
}
__device__ __forceinline__ void tr_item(const float* W, int K, int N, int Npad, bf16_t* WT, const float* g0, const float* g1, int gs, float* scr, int item, int lane) {
    const int nblk = Npad / 128, kb = item / nblk, nb = item % nblk, k0 = 32 * kb, n0 = 128 * nb;
    const int c4 = lane & 31, kh = lane >> 5, n = n0 + 4 * c4; const bool ok = n < N;
#pragma unroll 8
    for (int i = 0; i < 16; ++i) {
        const int kk = 2 * i + kh, k = k0 + kk;
        f32x4 v = ok ? *(const f32x4*)(W + (size_t)k * N + n) : (f32x4){0.f, 0.f, 0.f, 0.f};
        if (g0) v = v * ((k < gs) ? g0[k] : g1[k - gs]);
        *(f32x4*)(scr + kk * 132 + 4 * c4) = v;
    }
    asm volatile("s_waitcnt lgkmcnt(0)" ::: "memory");
#pragma unroll
    for (int j = 0; j < 8; ++j) {
        const int idx = lane + 64 * j, nn = idx >> 2, ck = idx & 3; const float* sp = scr + (8 * ck) * 132 + nn;
        u32x4 o; o.x = pk2(sp[0 * 132], sp[1 * 132]); o.y = pk2(sp[2 * 132], sp[3 * 132]); o.z = pk2(sp[4 * 132], sp[5 * 132]); o.w = pk2(sp[6 * 132], sp[7 * 132]);
        *(u32x4*)(WT + (size_t)(n0 + nn) * K + k0 + 8 * ck) = o;
    }
    asm volatile("s_waitcnt lgkmcnt(0)" ::: "memory");
}
constexpr int TR_N0 = (DM / 32) * (NPROJ / 128), TR_N1 = (512 / 32) * (NQ / 128), TR_N2 = (256 / 32) * (NKV / 128), TR_N3 = (DM / 32) * (DM / 128), TR_N4 = TR_N3;
constexpr int TR_TOTAL = TR_N0 + TR_N1 + TR_N2 + TR_N3 + TR_N4;
__device__ __forceinline__ void ph_transposes(const Params& p, unsigned char* lds, int wave, int lane, int first, int stride) {
    float* scr = (float*)(lds + wave * 17408);
    for (int it = first; it < TR_TOTAL; it += stride) {
        int r = it;
        if (r < TR_N0) { tr_item(p.w_in, DM, IN_COLS, NPROJ, (bf16_t*)(p.ws + WS_WINT), nullptr, nullptr, 0, scr, r, lane); continue; } r -= TR_N0;
        if (r < TR_N1) { tr_item(p.w_uq, 512, NQ, NQ, (bf16_t*)(p.ws + WS_WUQT), p.q_a_norm, p.q_a_norm, 512, scr, r, lane); continue; } r -= TR_N1;
        if (r < TR_N2) { tr_item(p.w_ukv, 256, NKV, NKV, (bf16_t*)(p.ws + WS_WUKVT), p.kv_a_norm, p.kv_a_norm, 256, scr, r, lane); continue; } r -= TR_N2;
        if (r < TR_N3) { tr_item(p.w_out, DM, DM, DM, (bf16_t*)(p.ws + WS_WOUTT), p.attn_out_norm, p.ssd_norm, 1024, scr, r, lane); continue; } r -= TR_N3;
        tr_item(p.w_query, DM, DM, DM, (bf16_t*)(p.ws + WS_WQT), nullptr, nullptr, 0, scr, r, lane);
    }
}
__device__ __forceinline__ void ph_convert(const float* src, bf16_t* dst, size_t n4, int gtid, int gn) {
    for (size_t i = gtid; i < n4; i += (size_t)gn) {
        const f32x4 v = ((const f32x4*)src)[i];
        uint2 o; o.x = pk2(v.x, v.y); o.y = pk2(v.z, v.w);
        ((uint2*)dst)[i] = o;
    }
}
__device__ __forceinline__ void ph_modrows(const float* in, bf16_t* outp, const float* mod, int sh_idx, int sc_idx, int gwave, int gnw, int lane) {
    for (int row = gwave; row < T; row += gnw) {
        const int b = row / SEQ;
        const f32x4* xr = (const f32x4*)(in + (size_t)row * DM) + lane;
        f32x4 v[8]; float s = 0.f;
#pragma unroll
        for (int j = 0; j < 8; ++j) { v[j] = xr[64 * j]; s += (v[j].x * v[j].x + v[j].y * v[j].y) + (v[j].z * v[j].z + v[j].w * v[j].w); }
        const float r = rsqrtf(wave_sum(s) * (1.f / DM) + EPS);
        const f32x4* sh = (const f32x4*)(mod + (size_t)b * 6 * DM + sh_idx * DM) + lane;
        const f32x4* sc = (const f32x4*)(mod + (size_t)b * 6 * DM + sc_idx * DM) + lane;
        uint2* o = (uint2*)(outp + (size_t)row * DM) + lane;
#pragma unroll
        for (int j = 0; j < 8; ++j) {
            const f32x4 a = sh[64 * j], m = sc[64 * j];
            uint2 w; w.x = pk2(v[j].x * r * (1.f + m.x) + a.x, v[j].y * r * (1.f + m.y) + a.y); w.y = pk2(v[j].z * r * (1.f + m.z) + a.z, v[j].w * r * (1.f + m.w) + a.w);
            o[64 * j] = w;
        }
    }
}
constexpr float QSCALE = 0.07216878364870322f * 1.4426950408889634f;
__device__ __forceinline__ float ssq8(u32x4 w) { return (sq2(w.x) + sq2(w.y)) + (sq2(w.z) + sq2(w.w)); }
__device__ __forceinline__ u32x4 scale8(u32x4 w, float s, const float (&g)[8]) {
    u32x4 o; o.x = pk2(bflo(w.x) * s * g[0], bfhi(w.x) * s * g[1]); o.y = pk2(bflo(w.y) * s * g[2], bfhi(w.y) * s * g[3]);
    o.z = pk2(bflo(w.z) * s * g[4], bfhi(w.z) * s * g[5]); o.w = pk2(bflo(w.w) * s * g[6], bfhi(w.w) * s * g[7]); return o;
}
__device__ __forceinline__ u32x4 rope8(u32x4 w, u32x4 pw, float s, const float (&go)[8], const float (&gp)[8], f32x4 c0, f32x4 c1, f32x4 s0, f32x4 s1, float sgn) {
    const float a[8] = {bflo(w.x) * s * go[0], bfhi(w.x) * s * go[1], bflo(w.y) * s * go[2], bfhi(w.y) * s * go[3], bflo(w.z) * s * go[4], bfhi(w.z) * s * go[5], bflo(w.w) * s * go[6], bfhi(w.w) * s * go[7]};
    const float b[8] = {bflo(pw.x) * s * gp[0], bfhi(pw.x) * s * gp[1], bflo(pw.y) * s * gp[2], bfhi(pw.y) * s * gp[3], bflo(pw.z) * s * gp[4], bfhi(pw.z) * s * gp[5], bflo(pw.w) * s * gp[6], bfhi(pw.w) * s * gp[7]};
    u32x4 o;
    o.x = pk2(a[0] * c0.x + sgn * b[0] * s0.x, a[1] * c0.y + sgn * b[1] * s0.y); o.y = pk2(a[2] * c0.z + sgn * b[2] * s0.z, a[3] * c0.w + sgn * b[3] * s0.w);
    o.z = pk2(a[4] * c1.x + sgn * b[4] * s1.x, a[5] * c1.y + sgn * b[5] * s1.y); o.w = pk2(a[6] * c1.z + sgn * b[6] * s1.z, a[7] * c1.w + sgn * b[7] * s1.w);
    return o;
}
__device__ __forceinline__ u32x4 shfl_xor4(u32x4 w, int m) { u32x4 o; o.x = __shfl_xor(w.x, m); o.y = __shfl_xor(w.y, m); o.z = __shfl_xor(w.z, m); o.w = __shfl_xor(w.w, m); return o; }
__device__ __forceinline__ void ph_qkv_post(const Params& p, int gwave, int gnw, int lane) {
    unsigned char* ws = p.ws;
    const int g16 = lane >> 4, pos = lane & 15, hr = lane >> 3, rpos = lane & 7, f0 = (rpos & 3) * 8;
    const float sgn = (rpos < 4) ? -1.f : 1.f;
    float gqn[8], gqr[8], gqp[8], gkn[8], gkr[8], gkp[8];
#pragma unroll
    for (int i = 0; i < 8; ++i) { gqn[i] = p.q_norm[pos * 8 + i]; gqr[i] = p.q_norm[128 + rpos * 8 + i]; gqp[i] = p.q_norm[128 + (rpos ^ 4) * 8 + i];
                                  gkn[i] = p.k_norm[pos * 8 + i]; gkr[i] = p.k_norm[128 + rpos * 8 + i]; gkp[i] = p.k_norm[128 + (rpos ^ 4) * 8 + i]; }
    for (int t = gwave; t < T; t += gnw) {
        const bf16_t* proj = (const bf16_t*)(ws + WS_PROJ) + (size_t)t * NPROJ;
        const bf16_t* qraw = (const bf16_t*)(ws + WS_QRAW) + (size_t)t * NQ;
        const bf16_t* kvraw = (const bf16_t*)(ws + WS_KVRAW) + (size_t)t * NKV;
        const u32x4 cq = *(const u32x4*)(proj + C_CQ + lane * 8);
        const u32x4 ck = *(const u32x4*)(proj + C_CKV + (lane & 31) * 8);
        const u32x4 kr = *(const u32x4*)(proj + C_KR + rpos * 8);
        const u32x4 qn0 = *(const u32x4*)(qraw + g16 * 192 + pos * 8), qn1 = *(const u32x4*)(qraw + (4 + g16) * 192 + pos * 8), qr = *(const u32x4*)(qraw + hr * 192 + 128 + rpos * 8);
        const u32x4 kn0 = *(const u32x4*)(kvraw + g16 * 256 + pos * 8), kn1 = *(const u32x4*)(kvraw + (4 + g16) * 256 + pos * 8);
        const u32x4 v0 = *(const u32x4*)(kvraw + g16 * 256 + 128 + pos * 8), v1 = *(const u32x4*)(kvraw + (4 + g16) * 256 + 128 + pos * 8);
        const float* rcp = (const float*)(ws + WS_ROPEC) + (size_t)t * 32 + f0; const float* rsp = (const float*)(ws + WS_ROPES) + (size_t)t * 32 + f0;
        const f32x4 c0 = *(const f32x4*)rcp, c1 = *(const f32x4*)(rcp + 4), s0 = *(const f32x4*)rsp, s1 = *(const f32x4*)(rsp + 4);
        const float rcq = rsqrtf(wave_sum(ssq8(cq)) * (1.f / 512.f) + EPS);
        const float rckv = rsqrtf(wave_sum(lane < 32 ? ssq8(ck) : 0.f) * (1.f / 256.f) + EPS);
        float skr = ssq8(kr), nq0 = ssq8(qn0), nq1 = ssq8(qn1), rqs = ssq8(qr), nk0 = ssq8(kn0), nk1 = ssq8(kn1);
#pragma unroll
        for (int o = 1; o < 8; o <<= 1) { skr += __shfl_xor(skr, o); rqs += __shfl_xor(rqs, o); nq0 += __shfl_xor(nq0, o); nq1 += __shfl_xor(nq1, o); nk0 += __shfl_xor(nk0, o); nk1 += __shfl_xor(nk1, o); }
        nq0 += __shfl_xor(nq0, 8); nq1 += __shfl_xor(nq1, 8); nk0 += __shfl_xor(nk0, 8); nk1 += __shfl_xor(nk1, 8);
        const float rc2 = rcq * rcq, rk2 = rckv * rckv;
        const float tq0 = nq0 + __shfl(rqs, 8 * g16), tq1 = nq1 + __shfl(rqs, 8 * (4 + g16));
        const float tqa = __shfl(nq0, 16 * (hr & 3)), tqb = __shfl(nq1, 16 * (hr & 3));
        const float tqr = rqs + ((hr < 4) ? tqa : tqb);
        const float sq0 = rsqrtf(tq0 * rc2 * (1.f / 192.f) + EPS) * rcq * QSCALE, sq1 = rsqrtf(tq1 * rc2 * (1.f / 192.f) + EPS) * rcq * QSCALE, sqr = rsqrtf(tqr * rc2 * (1.f / 192.f) + EPS) * rcq * QSCALE;
        const float rk0 = rsqrtf((nk0 * rk2 + skr) * (1.f / 192.f) + EPS), rk1 = rsqrtf((nk1 * rk2 + skr) * (1.f / 192.f) + EPS);
        const float rka = __shfl(rk0, 16 * (hr & 3)), rkb = __shfl(rk1, 16 * (hr & 3));
        const float rkr = (hr < 4) ? rka : rkb;
        const u32x4 pqr = shfl_xor4(qr, 4), pkr = shfl_xor4(kr, 4);
        const int b = t / SEQ, sidx = t % SEQ;
        bf16_t* Q0 = (bf16_t*)(ws + WS_Q) + ((size_t)(b * 8 + g16) * SEQ + sidx) * 192; bf16_t* Q1 = Q0 + (size_t)4 * SEQ * 192; bf16_t* Qr = (bf16_t*)(ws + WS_Q) + ((size_t)(b * 8 + hr) * SEQ + sidx) * 192;
        bf16_t* K0 = (bf16_t*)(ws + WS_K) + ((size_t)(b * 8 + g16) * SEQ + sidx) * 192; bf16_t* K1 = K0 + (size_t)4 * SEQ * 192; bf16_t* Kr = (bf16_t*)(ws + WS_K) + ((size_t)(b * 8 + hr) * SEQ + sidx) * 192;
        bf16_t* V0 = (bf16_t*)(ws + WS_V) + ((size_t)(b * 8 + g16) * SEQ + sidx) * 128; bf16_t* V1 = V0 + (size_t)4 * SEQ * 128;
        *(u32x4*)(Q0 + pos * 8) = scale8(qn0, sq0, gqn); *(u32x4*)(Q1 + pos * 8) = scale8(qn1, sq1, gqn);
        *(u32x4*)(Qr + 128 + rpos * 8) = rope8(qr, pqr, sqr, gqr, gqp, c0, c1, s0, s1, sgn);
        *(u32x4*)(K0 + pos * 8) = scale8(kn0, rckv * rk0, gkn); *(u32x4*)(K1 + pos * 8) = scale8(kn1, rckv * rk1, gkn);
        *(u32x4*)(Kr + 128 + rpos * 8) = rope8(kr, pkr, rkr, gkr, gkp, c0, c1, s0, s1, sgn);
        const float one[8] = {1.f, 1.f, 1.f, 1.f, 1.f, 1.f, 1.f, 1.f};
        *(u32x4*)(V0 + pos * 8) = scale8(v0, rckv, one); *(u32x4*)(V1 + pos * 8) = scale8(v1, rckv, one);
    }
}
__device__ __forceinline__ void ph_attn_naive(const Params& p, unsigned char* lds, int tid, int bid, int G) {
    const int lane = tid & 63, wv = tid >> 6;
    float* ps = (float*)lds + wv * SEQ;
    float* qs = (float*)(lds + 65536) + wv * 192;
    for (int it = 0; it < (T * 8) / (G * 8); ++it) {
        const int sb = (it & 1) ? (G - 1 - bid) : bid;
        const int gi = it * (G * 8) + sb * 8 + wv;
        const int bh = gi / SEQ, s = gi % SEQ, b = bh >> 3, h = bh & 7;
        const bf16_t* Q = (const bf16_t*)(p.ws + WS_Q) + (size_t)gi * 192;
        const bf16_t* K = (const bf16_t*)(p.ws + WS_K) + (size_t)bh * SEQ * 192;
        const bf16_t* V = (const bf16_t*)(p.ws + WS_KVRAW) + (size_t)(b * SEQ) * NKV + h * 256 + 128;
        for (int d = lane; d < 192; d += 64) qs[d] = bf2f(Q[d]);
        SYNC();
        float mx = -1e30f;
        for (int k0 = 0; k0 <= s; k0 += 64) {
            const int key = k0 + lane; float sc = -INFINITY;
            if (key <= s) {
                const u32x4* kp = (const u32x4*)(K + (size_t)key * 192); float a = 0.f;
                for (int c = 0; c < 24; ++c) { const u32x4 w = kp[c]; const float* q = &qs[c * 8];
                    a += bflo(w.x) * q[0] + bfhi(w.x) * q[1] + bflo(w.y) * q[2] + bfhi(w.y) * q[3] + bflo(w.z) * q[4] + bfhi(w.z) * q[5] + bflo(w.w) * q[6] + bfhi(w.w) * q[7]; }
                sc = a;
            }
            ps[key] = sc;
            mx = fmaxf(mx, sc);
        }
#pragma unroll
        for (int o = 1; o < 64; o <<= 1) mx = fmaxf(mx, __shfl_xor(mx, o));
        SYNC();
        float sum = 0.f;
        for (int key = lane; key <= s; key += 64) { const float e = exp2f(ps[key] - mx); ps[key] = e; sum += e; }
        sum = wave_sum(sum);
        SYNC();
        float o0 = 0.f, o1 = 0.f;
        for (int key = 0; key <= s; ++key) { const float pr = ps[key]; const unsigned w = *(const unsigned*)(V + (size_t)key * NKV + 2 * lane); o0 += pr * bflo(w); o1 += pr * bfhi(w); }
        const float inv = 1.f / sum; o0 *= inv; o1 *= inv;
        const int t = b * SEQ + s;
        *(unsigned*)((bf16_t*)(p.ws + WS_ATTN) + (size_t)t * 1024 + h * 128 + 2 * lane) = pk2(o0, o1);
        SYNC();
    }
}
__device__ __forceinline__ void ph_conv_naive(const Params& p, int gtid, int gn) {
    const bf16_t* proj = (const bf16_t*)(p.ws + WS_PROJ);
    for (int i = gtid; i < T * 1552; i += gn) {
        const int t = i / 1552, c = i % 1552, s = t % SEQ;
        if (c < 1536) {
            float a = p.conv_b[c];
            for (int k = 0; k < 4; ++k) { const int ss = s - 3 + k; if (ss >= 0) a += p.conv_w[k * 1536 + c] * bf2f(proj[(size_t)(t - 3 + k) * NPROJ + C_XBC + c]); }
            ((bf16_t*)(p.ws + WS_XBCA))[(size_t)t * 1536 + c] = (bf16_t)f2bf(silu_f(a));
        } else {
            const int hh = c - 1536; const float v = bf2f(proj[(size_t)t * NPROJ + C_DT + hh]) + p.dt_bias[hh];
            ((float*)(p.ws + WS_DT))[(size_t)t * 16 + hh] = (v > 20.f) ? v : log1pf(__expf(v));
        }
    }
}
__device__ __forceinline__ void ph_ssd_naive(const Params& p, int vb, int lt) {
    const int b = vb >> 4, h = vb & 15, g = h >> 3, pp = lt >> 2, nq = lt & 3;
    const bf16_t* xa = (const bf16_t*)(p.ws + WS_XBCA); const float* dtp = (const float*)(p.ws + WS_DT);
    const bf16_t* proj = (const bf16_t*)(p.ws + WS_PROJ);
    const float a = -__expf(p.a_log[h]), dsk = p.d_skip[h];
    float st[32];
#pragma unroll
    for (int n = 0; n < 32; ++n) st[n] = 0.f;
    for (int s = 0; s < SEQ; ++s) {
        const size_t t = (size_t)b * SEQ + s;
        const float dt = dtp[t * 16 + h], dA = __expf(dt * a);
        const float xv = bf2f(xa[t * 1536 + h * 64 + pp]);
        const bf16_t* Bp = xa + t * 1536 + 1024 + g * 128 + nq * 32; const bf16_t* Cp = xa + t * 1536 + 1280 + g * 128 + nq * 32;
        float y = 0.f; const float dx = dt * xv;
#pragma unroll
        for (int n = 0; n < 32; ++n) { st[n] = st[n] * dA + dx * bf2f(Bp[n]); y += bf2f(Cp[n]) * st[n]; }
        y += __shfl_xor(y, 1); y += __shfl_xor(y, 2);
        if (nq == 0) {
            const float z = bf2f(proj[t * NPROJ + C_Z + h * 64 + pp]);
            ((bf16_t*)(p.ws + WS_YSSD))[t * 1024 + h * 64 + pp] = (bf16_t)f2bf((y + dsk * xv) * silu_f(z));
        }
    }
}
__device__ __forceinline__ void ph_mixnorm(const Params& p, int gwave, int gnw, int lane) {
    for (int t = gwave; t < T; t += gnw) {
        const uint2* ain = (const uint2*)((const bf16_t*)(p.ws + WS_ATTN) + (size_t)t * 1024); const uint2* yin = (const uint2*)((const bf16_t*)(p.ws + WS_YSSD) + (size_t)t * 1024);
        uint2 a[4], y[4]; float sa = 0.f, s0 = 0.f, s1 = 0.f;
#pragma unroll
        for (int j = 0; j < 4; ++j) { a[j] = ain[lane + 64 * j]; y[j] = yin[lane + 64 * j]; sa += sq2(a[j].x) + sq2(a[j].y); const float q = sq2(y[j].x) + sq2(y[j].y); if (j < 2) s0 += q; else s1 += q; }
        const float ra = rsqrtf(wave_sum(sa) * (1.f / 1024.f) + EPS), r0 = rsqrtf(wave_sum(s0) * (1.f / 512.f) + EPS), r1 = rsqrtf(wave_sum(s1) * (1.f / 512.f) + EPS);
        uint2* o = (uint2*)((bf16_t*)(p.ws + WS_MIXIN) + (size_t)t * DM);
#pragma unroll
        for (int j = 0; j < 4; ++j) {
            uint2 r; r.x = pk2(bflo(a[j].x) * ra, bfhi(a[j].x) * ra); r.y = pk2(bflo(a[j].y) * ra, bfhi(a[j].y) * ra); o[lane + 64 * j] = r;
            const float rr = (j < 2) ? r0 : r1;
            uint2 q; q.x = pk2(bflo(y[j].x) * rr, bfhi(y[j].x) * rr); q.y = pk2(bflo(y[j].y) * rr, bfhi(y[j].y) * rr); o[256 + lane + 64 * j] = q;
        }
    }
}
__device__ __forceinline__ void ph_route_naive(const Params& p, unsigned char* lds, int tid, int bid, int G) {
    const int sub = tid >> 7, lt = tid & 127;
    float* base = (float*)(lds + sub * 4096);
    float* q = base; float* sc = base + 256; float* ts = base + 512; int* ti = (int*)(base + 544); float* cs = base + 576; float* bs = base + 832; int* bi = (int*)(base + 848);
    const bf16_t* sk = (const bf16_t*)(p.ws + WS_SUBK);
    for (int it = 0; it < (T * 8) / (G * 4); ++it) {
        const int vb = it * (G * 4) + bid * 4 + sub, t = vb >> 3, h = vb & 7;
        const bf16_t* qp = (const bf16_t*)(p.ws + WS_QP) + (size_t)t * DM + h * 256;
        q[lt] = bf2f(qp[lt]); q[128 + lt] = bf2f(qp[128 + lt]);
        SYNC();
#pragma unroll
        for (int j = 0; j < 2; ++j) {
            const u32x4* kp = (const u32x4*)(sk + ((size_t)(h * 2 + j) * 128 + lt) * 128); float a = 0.f;
            for (int c = 0; c < 16; ++c) { const u32x4 w = kp[c]; const float* qq = q + j * 128 + c * 8;
                a += bflo(w.x) * qq[0] + bfhi(w.x) * qq[1] + bflo(w.y) * qq[2] + bfhi(w.y) * qq[3] + bflo(w.z) * qq[4] + bfhi(w.z) * qq[5] + bflo(w.w) * qq[6] + bfhi(w.w) * qq[7]; }
            sc[j * 128 + lt] = a;
        }
        SYNC();
#pragma unroll
        for (int j = 0; j < 2; ++j) {
            const float v = sc[j * 128 + lt]; int rank = 0;
            for (int k = 0; k < 128; ++k) { const float o = sc[j * 128 + k]; rank += (o > v || (o == v && k < lt)) ? 1 : 0; }
            if (rank < 16) { ts[j * 16 + rank] = v; ti[j * 16 + rank] = lt; }
        }
        SYNC();
        cs[lt] = ts[lt >> 4] + ts[16 + (lt & 15)]; cs[128 + lt] = ts[8 + (lt >> 4)] + ts[16 + (lt & 15)];
        SYNC();
#pragma unroll
        for (int r = 0; r < 2; ++r) {
            const int ci = lt + 128 * r; const float v = cs[ci]; int rank = 0;
            for (int k = 0; k < 256; ++k) { const float o = cs[k]; rank += (o > v || (o == v && k < ci)) ? 1 : 0; }
            if (rank < 16) { bs[rank] = v; bi[rank] = ti[ci >> 4] * 128 + ti[16 + (ci & 15)]; }
        }
        SYNC();
        if (lt < 16) {
            const float mx = bs[0]; float sum = 0.f;
            for (int k = 0; k < 16; ++k) sum += __expf(bs[k] - mx);
            ((float*)(p.ws + WS_GATE))[(size_t)t * 128 + h * 16 + lt] = __expf(bs[lt] - mx) / sum;
            ((int*)(p.ws + WS_IDX))[(size_t)t * 128 + h * 16 + lt] = bi[lt];
        }
        SYNC();
    }
}
__device__ __forceinline__ void ph_peer_naive(const Params& p, unsigned char* lds, int tid, int bid, int G) {
    const int half = tid >> 8, lt = tid & 255, lane = tid & 63, wv = lt >> 6;
    float* red = (float*)(lds + half * 64);
    const bf16_t* U = (const bf16_t*)(p.ws + WS_U16); const bf16_t* V = (const bf16_t*)(p.ws + WS_V16);
    for (int it = 0; it < T / (G * 2); ++it) {
        const int t = it * (G * 2) + bid * 2 + half, b = t / SEQ;
        const u32x4 hw = *(const u32x4*)((const bf16_t*)(p.ws + WS_H2) + (size_t)t * DM + lt * 8);
        const float h0 = bflo(hw.x), h1 = bfhi(hw.x), h2 = bflo(hw.y), h3 = bfhi(hw.y), h4 = bflo(hw.z), h5 = bfhi(hw.z), h6 = bflo(hw.w), h7 = bfhi(hw.w);
        float o0 = 0.f, o1 = 0.f, o2 = 0.f, o3 = 0.f, o4 = 0.f, o5 = 0.f, o6 = 0.f, o7 = 0.f;
        const int* idx = (const int*)(p.ws + WS_IDX) + (size_t)t * 128; const float* gate = (const float*)(p.ws + WS_GATE) + (size_t)t * 128;
        for (int e = 0; e < 128; ++e) {
            const int ex = idx[e];
            const u32x4 uw = *(const u32x4*)(U + (size_t)ex * DM + lt * 8);
            float d = bflo(uw.x) * h0 + bfhi(uw.x) * h1 + bflo(uw.y) * h2 + bfhi(uw.y) * h3 + bflo(uw.z) * h4 + bfhi(uw.z) * h5 + bflo(uw.w) * h6 + bfhi(uw.w) * h7;
            d = wave_sum(d);
            if (lane == 0) red[wv] = d;
            SYNC();
            const float pre = red[0] + red[1] + red[2] + red[3];
            const float a = 0.5f * pre * (1.f + erff(pre * 0.70710678118654752f)) * gate[e];
            SYNC();
            const u32x4 vw = *(const u32x4*)(V + (size_t)ex * DM + lt * 8);
            o0 += a * bflo(vw.x); o1 += a * bfhi(vw.x); o2 += a * bflo(vw.y); o3 += a * bfhi(vw.y); o4 += a * bflo(vw.z); o5 += a * bfhi(vw.z); o6 += a * bflo(vw.w); o7 += a * bfhi(vw.w);
        }
        const float* g2 = (const float*)(p.ws + WS_MOD) + (size_t)b * 6 * DM + 5 * DM + lt * 8;
        float* outp = p.out + (size_t)t * DM + lt * 8;
        const f32x4 x0 = *(const f32x4*)outp, x1 = *(const f32x4*)(outp + 4), ga = *(const f32x4*)g2, gb = *(const f32x4*)(g2 + 4);
        *(f32x4*)outp = (f32x4){x0.x + ga.x * o0, x0.y + ga.y * o1, x0.z + ga.z * o2, x0.w + ga.w * o3};
        *(f32x4*)(outp + 4) = (f32x4){x1.x + gb.x * o4, x1.y + gb.y * o5, x1.z + gb.z * o6, x1.w + gb.w * o7};
    }
}
typedef __bf16 bf16x2_t __attribute__((ext_vector_type(2)));
__device__ __forceinline__ float dot2bf(unsigned a, unsigned b, float c) { return __builtin_amdgcn_fdot2_f32_bf16(__builtin_bit_cast(bf16x2_t, a), __builtin_bit_cast(bf16x2_t, b), c, false); }
__device__ __forceinline__ void ph_peer(const Params& p, LAS unsigned char* ldsl, int wave, int lane, int gwave, int gnw) {
    LAS unsigned char* ring = ldsl + wave * 16384;
    const bf16_t* U = (const bf16_t*)(p.ws + WS_U16); const bf16_t* V = (const bf16_t*)(p.ws + WS_V16);
    const int e_lane = (lane >> 2) & 15; const unsigned lane16 = (unsigned)lane * 16u;
#define PEER_ISSUE(R) do { const int R_ = (R); const int i_ = ((R_ >> 5) << 4) + (R_ & 15); \
        const int e_ = (i_ < 64) ? __builtin_amdgcn_readlane(idx0, i_) : __builtin_amdgcn_readlane(idx1, i_ - 64); \
        const char* base_ = (const char*)(((R_ >> 4) & 1) ? V : U) + (size_t)(unsigned)e_ * (DM * 2); \
        const unsigned* src_ = (const unsigned*)(base_ + lane16); \
        LAS unsigned* dst_ = (LAS unsigned*)(ring + (R_ & 3) * 4096); \
        __builtin_amdgcn_global_load_lds(src_, dst_, 16, 0, 0); \
        __builtin_amdgcn_global_load_lds(src_, dst_, 16, 1024, 0); \
        __builtin_amdgcn_global_load_lds(src_, dst_, 16, 2048, 0); \
        __builtin_amdgcn_global_load_lds(src_, dst_, 16, 3072, 0); } while (0)
#define PEER_WAIT(n) asm volatile("s_waitcnt vmcnt(" #n ")" ::: "memory")
    for (int t = gwave; t < T; t += gnw) {
        const int b = t / SEQ;
        const int idx0 = ((const int*)(p.ws + WS_IDX))[(size_t)t * 128 + lane], idx1 = ((const int*)(p.ws + WS_IDX))[(size_t)t * 128 + 64 + lane];
        const float g0 = ((const float*)(p.ws + WS_GATE))[(size_t)t * 128 + lane], g1 = ((const float*)(p.ws + WS_GATE))[(size_t)t * 128 + 64 + lane];
        u32x4 hreg[4];
#pragma unroll
        for (int j = 0; j < 4; ++j) hreg[j] = *(const u32x4*)((const bf16_t*)(p.ws + WS_H2) + (size_t)t * DM + j * 512 + lane * 8);
        float out[4][8];
#pragma unroll
        for (int j = 0; j < 4; ++j)
#pragma unroll
            for (int i = 0; i < 8; ++i) out[j][i] = 0.f;
        PEER_ISSUE(0); PEER_ISSUE(1); PEER_ISSUE(2);
        for (int hh = 0; hh < 8; ++hh) {
            float pd[16];
#pragma unroll
            for (int k = 0; k < 16; ++k) {
                PEER_ISSUE(hh * 32 + k + 3); PEER_WAIT(12);
                const LAS unsigned char* sl = ring + (k & 3) * 4096 + lane * 16;
                float a = 0.f;
#pragma unroll
                for (int j = 0; j < 4; ++j) { const u32x4 w = *(const LAS u32x4*)(sl + j * 1024);
                    a = dot2bf(w.x, hreg[j].x, a); a = dot2bf(w.y, hreg[j].y, a); a = dot2bf(w.z, hreg[j].z, a); a = dot2bf(w.w, hreg[j].w, a); }
                asm volatile("" : "+v"(a));
                pd[k] = a;
            }
            float q8[8], q4[4], q2[2], q1;
            { const bool hi = (lane & 32) != 0;
#pragma unroll
              for (int i = 0; i < 8; ++i) { const float keep = hi ? pd[i + 8] : pd[i], send = hi ? pd[i] : pd[i + 8]; q8[i] = keep + __shfl_xor(send, 32); } }
            { const bool hi = (lane & 16) != 0;
#pragma unroll
              for (int i = 0; i < 4; ++i) { const float keep = hi ? q8[i + 4] : q8[i], send = hi ? q8[i] : q8[i + 4]; q4[i] = keep + __shfl_xor(send, 16); } }
            { const bool hi = (lane & 8) != 0;
#pragma unroll
              for (int i = 0; i < 2; ++i) { const float keep = hi ? q4[i + 2] : q4[i], send = hi ? q4[i] : q4[i + 2]; q2[i] = keep + __shfl_xor(send, 8); } }
            { const bool hi = (lane & 4) != 0; const float keep = hi ? q2[1] : q2[0], send = hi ? q2[0] : q2[1]; q1 = keep + __shfl_xor(send, 4); }
            q1 += __shfl_xor(q1, 1); q1 += __shfl_xor(q1, 2);
            const float gsel = (hh < 4) ? g0 : g1;
            const float gate = __shfl(gsel, (hh & 3) * 16 + e_lane);
            const float act = 0.5f * q1 * (1.f + erff(q1 * 0.70710678118654752f)) * gate;
#pragma unroll
            for (int k = 0; k < 16; ++k) {
                if (k < 13) { PEER_ISSUE(hh * 32 + 16 + k + 3); PEER_WAIT(12); }
                else if (hh < 7) { PEER_ISSUE(hh * 32 + 16 + k + 3); PEER_WAIT(12); }
                else if (k == 13) PEER_WAIT(8); else if (k == 14) PEER_WAIT(4); else PEER_WAIT(0);
                const float a = __builtin_bit_cast(float, __builtin_amdgcn_readlane(__builtin_bit_cast(int, act), 4 * k));
                const LAS unsigned char* sl = ring + (k & 3) * 4096 + lane * 16;
#pragma unroll
                for (int j = 0; j < 4; ++j) { const u32x4 w = *(const LAS u32x4*)(sl + j * 1024);
                    out[j][0] += a * bflo(w.x); out[j][1] += a * bfhi(w.x); out[j][2] += a * bflo(w.y); out[j][3] += a * bfhi(w.y);
                    out[j][4] += a * bflo(w.z); out[j][5] += a * bfhi(w.z); out[j][6] += a * bflo(w.w); out[j][7] += a * bfhi(w.w);
                    asm volatile("" : "+v"(out[j][0]), "+v"(out[j][1]), "+v"(out[j][2]), "+v"(out[j][3]), "+v"(out[j][4]), "+v"(out[j][5]), "+v"(out[j][6]), "+v"(out[j][7])); }
            }
        }
        const float* g2 = (const float*)(p.ws + WS_MOD) + (size_t)b * 6 * DM + 5 * DM;
        float* outp = p.out + (size_t)t * DM;
#pragma unroll
        for (int j = 0; j < 4; ++j) {
            const int c = j * 512 + lane * 8;
            const f32x4 x0 = *(const f32x4*)(outp + c), x1 = *(const f32x4*)(outp + c + 4), ga = *(const f32x4*)(g2 + c), gb = *(const f32x4*)(g2 + c + 4);
            *(f32x4*)(outp + c) = (f32x4){x0.x + ga.x * out[j][0], x0.y + ga.y * out[j][1], x0.z + ga.z * out[j][2], x0.w + ga.w * out[j][3]};
            *(f32x4*)(outp + c + 4) = (f32x4){x1.x + gb.x * out[j][4], x1.y + gb.y * out[j][5], x1.z + gb.z * out[j][6], x1.w + gb.w * out[j][7]};
        }
    }
#undef PEER_ISSUE
#undef PEER_WAIT
}
typedef short bf16x8 __attribute__((ext_vector_type(8)));
typedef short s16x4 __attribute__((ext_vector_type(4)));
typedef float f32x16 __attribute__((ext_vector_type(16)));
typedef float f32x2_t __attribute__((ext_vector_type(2)));
__device__ __forceinline__ int crow(int r, int hi) { return (r & 3) + 8 * (r >> 2) + 4 * hi; }
__device__ __forceinline__ unsigned cvtpk(float lo, float hi) { f32x2_t v = {lo, hi}; bf16x2_t b = __builtin_convertvector(v, bf16x2_t); return __builtin_bit_cast(unsigned, b); }
__device__ __forceinline__ s16x4 vtr(const LAS unsigned char* pp) { return __builtin_bit_cast(s16x4, __builtin_amdgcn_ds_read_tr16_b64_v4i16((LAS s16x4*)pp)); }
#define TR_PAIR(lo_, hi_, addr_, off_, hioff_) do { asm volatile("ds_read_b64_tr_b16 %0, %1 offset:%c2" : "=&v"(lo_) : "v"(addr_), "i"(off_) : "memory"); \
        asm volatile("ds_read_b64_tr_b16 %0, %1 offset:%c2" : "=&v"(hi_) : "v"(addr_), "i"((off_) + (hioff_)) : "memory"); } while (0)
#define LDS_WAIT_PIN() do { asm volatile("s_waitcnt lgkmcnt(0)" ::: "memory"); __builtin_amdgcn_sched_barrier(0); } while (0)
constexpr int AT_SLOT = 40960, AT_VOFF = 24576;
__device__ __forceinline__ void attn_unit(const Params& p, LAS unsigned char* ldsl, int bh, int qb, int wave, int lane) {
    const int r32 = lane & 31, hi = lane >> 5, b = bh >> 3, h = bh & 7;
    const bf16_t* Kbh = (const bf16_t*)(p.ws + WS_K) + (size_t)bh * SEQ * 192;
    const bf16_t* Vb = (const bf16_t*)(p.ws + WS_V) + (size_t)bh * SEQ * 128;
    const bf16_t* Qw = (const bf16_t*)(p.ws + WS_Q) + ((size_t)bh * SEQ + qb * 256 + wave * 32 + r32) * 192 + 8 * hi;
    const int NT = (qb * 256 + 256) / 64;
    int koff[3];
#pragma unroll
    for (int i = 0; i < 3; ++i) { const int o = 64 * (wave * 3 + i) + lane, k = o / 24, sl = o - 24 * k; int c = sl - ((k >> 1) & 7); c += (c < 0) ? 24 : 0; koff[i] = k * 192 + c * 8; }
    const int vid = wave * 2;
    const bf16_t* vsrc = Vb + (size_t)(16 * (vid & 3) + (lane >> 2)) * 128 + (vid >> 2) * 32 + (lane & 3) * 8;
#define AT_ISSUE(t, slot) do { const bf16_t* ks_ = Kbh + (size_t)(t) * 64 * 192; LAS unsigned char* sb_ = ldsl + (slot) * AT_SLOT; \
        __builtin_amdgcn_global_load_lds((const unsigned*)(ks_ + koff[0]), (LAS unsigned*)(sb_ + (wave * 3 + 0) * 1024), 16, 0, 0); \
        __builtin_amdgcn_global_load_lds((const unsigned*)(ks_ + koff[1]), (LAS unsigned*)(sb_ + (wave * 3 + 1) * 1024), 16, 0, 0); \
        __builtin_amdgcn_global_load_lds((const unsigned*)(ks_ + koff[2]), (LAS unsigned*)(sb_ + (wave * 3 + 2) * 1024), 16, 0, 0); \
        const bf16_t* vs_ = vsrc + (size_t)(t) * 64 * 128; \
        __builtin_amdgcn_global_load_lds((const unsigned*)(vs_), (LAS unsigned*)(sb_ + AT_VOFF + vid * 1024), 16, 0, 0); \
        __builtin_amdgcn_global_load_lds((const unsigned*)(vs_ + (size_t)16 * 128), (LAS unsigned*)(sb_ + AT_VOFF + (vid + 1) * 1024), 16, 0, 0); } while (0)
    bf16x8 qr[12];
#pragma unroll
    for (int s = 0; s < 12; ++s) qr[s] = *(const bf16x8*)(Qw + 16 * s);
#pragma unroll
    for (int s = 0; s < 12; ++s) asm volatile("" : "+v"(qr[s]));
    AT_ISSUE(0, 0); AT_ISSUE(1, 1);
    f32x16 o[4];
#pragma unroll
    for (int d0 = 0; d0 < 4; ++d0)
#pragma unroll
        for (int r = 0; r < 16; ++r) o[d0][r] = 0.f;
    float m = -1e30f, l = 0.f;
    const int kfo = r32 * 384, kc0 = hi + ((r32 >> 1) & 7);
    const int vfo = AT_VOFF + ((lane >> 4) & 1) * 32 + (lane & 3) * 8 + (4 * hi + ((lane & 15) >> 2)) * 64;
    const int qrel = wave * 32 + r32;
    int slot = 0;
    for (int t = 0; t < NT; ++t) {
        if (t + 1 < NT) asm volatile("s_waitcnt vmcnt(5)" ::: "memory"); else asm volatile("s_waitcnt vmcnt(0)" ::: "memory");
        __builtin_amdgcn_s_barrier(); asm volatile("" ::: "memory");
        if (t + 2 < NT) { const int s2 = (slot == 0) ? 2 : slot - 1; AT_ISSUE(t + 2, s2); }
        const int jb = t - (NT - 4);
        if (!(jb >= 0 && 64 * jb > wave * 32 + 31)) {
            const LAS unsigned char* kp = ldsl + slot * AT_SLOT + kfo;
            int kc = kc0; asm volatile("" : "+v"(kc));
            f32x16 p0, p1;
#pragma unroll
            for (int r = 0; r < 16; ++r) { p0[r] = 0.f; p1[r] = 0.f; }
#pragma unroll
            for (int s = 0; s < 12; ++s) {
                int sl_ = kc + 2 * s; sl_ -= (sl_ >= 24) ? 24 : 0;
                const bf16x8 k0 = *(const LAS bf16x8*)(kp + sl_ * 16), k1 = *(const LAS bf16x8*)(kp + sl_ * 16 + 32 * 384);
                p0 = __builtin_amdgcn_mfma_f32_32x32x16_bf16(k0, qr[s], p0, 0, 0, 0);
                p1 = __builtin_amdgcn_mfma_f32_32x32x16_bf16(k1, qr[s], p1, 0, 0, 0);
            }
            if (jb >= 0 && 64 * jb + 63 > wave * 32) {
#pragma unroll
                for (int r = 0; r < 16; ++r) { const int kv = 64 * jb + crow(r, hi); if (kv > qrel) p0[r] = -INFINITY; if (kv + 32 > qrel) p1[r] = -INFINITY; }
            }
            float rm = fmaxf(p0[0], p1[0]);
#pragma unroll
            for (int r = 1; r < 16; ++r) rm = fmaxf(rm, fmaxf(p0[r], p1[r]));
            rm = fmaxf(rm, __shfl_xor(rm, 32));
            const float mn = fmaxf(m, rm);
            if (__any(mn > m)) {
                const float alpha = __builtin_amdgcn_exp2f(m - mn);
                l *= alpha;
#pragma unroll
                for (int r = 0; r < 16; ++r) { const float ar = __shfl(alpha, crow(r, hi));
#pragma unroll
                    for (int d0 = 0; d0 < 4; ++d0) o[d0][r] *= ar; }
                m = mn;
            }
            float ls = 0.f;
#pragma unroll
            for (int r = 0; r < 16; ++r) { p0[r] = __builtin_amdgcn_exp2f(p0[r] - m); p1[r] = __builtin_amdgcn_exp2f(p1[r] - m); ls += p0[r] + p1[r]; }
            l += ls;
            bf16x8 pa[4];
            { u32x4 w;
              w.x = cvtpk(p0[0], p0[1]); w.y = cvtpk(p0[2], p0[3]); w.z = cvtpk(p0[4], p0[5]); w.w = cvtpk(p0[6], p0[7]); pa[0] = __builtin_bit_cast(bf16x8, w);
              w.x = cvtpk(p0[8], p0[9]); w.y = cvtpk(p0[10], p0[11]); w.z = cvtpk(p0[12], p0[13]); w.w = cvtpk(p0[14], p0[15]); pa[1] = __builtin_bit_cast(bf16x8, w);
              w.x = cvtpk(p1[0], p1[1]); w.y = cvtpk(p1[2], p1[3]); w.z = cvtpk(p1[4], p1[5]); w.w = cvtpk(p1[6], p1[7]); pa[2] = __builtin_bit_cast(bf16x8, w);
              w.x = cvtpk(p1[8], p1[9]); w.y = cvtpk(p1[10], p1[11]); w.z = cvtpk(p1[12], p1[13]); w.w = cvtpk(p1[14], p1[15]); pa[3] = __builtin_bit_cast(bf16x8, w); }
            const unsigned vpa = (unsigned)(size_t)(ldsl + slot * AT_SLOT + vfo);
#pragma unroll
            for (int d0 = 0; d0 < 4; ++d0) {
                s16x4 lo[4], hh[4];
                TR_PAIR(lo[0], hh[0], vpa, d0 * 4096 + 0 * 1024, 512); TR_PAIR(lo[1], hh[1], vpa, d0 * 4096 + 1 * 1024, 512);
                TR_PAIR(lo[2], hh[2], vpa, d0 * 4096 + 2 * 1024, 512); TR_PAIR(lo[3], hh[3], vpa, d0 * 4096 + 3 * 1024, 512);
                LDS_WAIT_PIN();
#pragma unroll
                for (int ks = 0; ks < 4; ++ks)
                    o[d0] = __builtin_amdgcn_mfma_f32_32x32x16_bf16(pa[ks], (bf16x8){lo[ks][0], lo[ks][1], lo[ks][2], lo[ks][3], hh[ks][0], hh[ks][1], hh[ks][2], hh[ks][3]}, o[d0], 0, 0, 0);
            }
        }
        slot = (slot == 2) ? 0 : slot + 1;
    }
    l += __shfl_xor(l, 32);
    const float inv = 1.f / l;
    bf16_t* Ow = (bf16_t*)(p.ws + WS_ATTN) + ((size_t)b * SEQ + qb * 256 + wave * 32) * 1024 + h * 128 + r32;
#pragma unroll
    for (int r = 0; r < 16; ++r) { const float ir = __shfl(inv, crow(r, hi));
#pragma unroll
        for (int d0 = 0; d0 < 4; ++d0) Ow[(size_t)crow(r, hi) * 1024 + d0 * 32] = (bf16_t)f2bf(o[d0][r] * ir); }
    asm volatile("s_waitcnt lgkmcnt(0)" ::: "memory"); __builtin_amdgcn_s_barrier(); asm volatile("" ::: "memory");
#undef AT_ISSUE
}
__device__ __forceinline__ void ph_attn(const Params& p, LAS unsigned char* ldsl, int bid, int G, int wave, int lane) {
    const int vcu = (bid & 7) * (G >> 3) + (bid >> 3);
    const int bh = vcu >> 2, s = vcu & 3;
    attn_unit(p, ldsl, bh, 7 - s, wave, lane);
    attn_unit(p, ldsl, bh, s, wave, lane);
}
__device__ __forceinline__ int f2sort(float f) { const int u = __builtin_bit_cast(int, f); return u ^ ((u >> 31) & 0x7fffffff); }
__device__ __forceinline__ float sort2f(int k) { return __builtin_bit_cast(float, k ^ ((k >> 31) & 0x7fffffff)); }
#define CE_(a_, b_) do { const int hi_ = max(a_, b_); b_ = min(a_, b_); a_ = hi_; } while (0)
#define INS16(L, x) do { int x_ = (x); _Pragma("unroll") for (int i_ = 0; i_ < 16; ++i_) { const int hi_ = max(L[i_], x_); x_ = min(L[i_], x_); L[i_] = hi_; } } while (0)
#define SORT16(v) do { CE_(v[0], v[13]); CE_(v[1], v[12]); CE_(v[2], v[15]); CE_(v[3], v[14]); CE_(v[4], v[8]); CE_(v[5], v[6]); CE_(v[7], v[11]); CE_(v[9], v[10]); CE_(v[0], v[5]); CE_(v[1], v[7]); CE_(v[2], v[9]); CE_(v[3], v[4]); CE_(v[6], v[13]); CE_(v[8], v[14]); CE_(v[10], v[15]); CE_(v[11], v[12]); CE_(v[0], v[1]); CE_(v[2], v[3]); CE_(v[4], v[5]); CE_(v[6], v[8]); CE_(v[7], v[9]); CE_(v[10], v[11]); CE_(v[12], v[13]); CE_(v[14], v[15]); CE_(v[0], v[2]); CE_(v[1], v[3]); CE_(v[4], v[10]); CE_(v[5], v[11]); CE_(v[6], v[7]); CE_(v[8], v[9]); CE_(v[12], v[14]); CE_(v[13], v[15]); CE_(v[1], v[2]); CE_(v[3], v[12]); CE_(v[4], v[6]); CE_(v[5], v[7]); CE_(v[8], v[10]); CE_(v[9], v[11]); CE_(v[13], v[14]); CE_(v[1], v[4]); CE_(v[2], v[6]); CE_(v[5], v[8]); CE_(v[7], v[10]); CE_(v[9], v[13]); CE_(v[11], v[14]); CE_(v[2], v[4]); CE_(v[3], v[6]); CE_(v[9], v[12]); CE_(v[11], v[13]); CE_(v[3], v[5]); CE_(v[6], v[8]); CE_(v[7], v[9]); CE_(v[10], v[12]); CE_(v[3], v[4]); CE_(v[5], v[6]); CE_(v[7], v[8]); CE_(v[9], v[10]); CE_(v[11], v[12]); CE_(v[6], v[7]); CE_(v[8], v[9]); } while (0)
#define BMERGE16(v) do { CE_(v[0], v[8]); CE_(v[1], v[9]); CE_(v[2], v[10]); CE_(v[3], v[11]); CE_(v[4], v[12]); CE_(v[5], v[13]); CE_(v[6], v[14]); CE_(v[7], v[15]); CE_(v[0], v[4]); CE_(v[1], v[5]); CE_(v[2], v[6]); CE_(v[3], v[7]); CE_(v[8], v[12]); CE_(v[9], v[13]); CE_(v[10], v[14]); CE_(v[11], v[15]); CE_(v[0], v[2]); CE_(v[1], v[3]); CE_(v[4], v[6]); CE_(v[5], v[7]); CE_(v[8], v[10]); CE_(v[9], v[11]); CE_(v[12], v[14]); CE_(v[13], v[15]); CE_(v[0], v[1]); CE_(v[2], v[3]); CE_(v[4], v[5]); CE_(v[6], v[7]); CE_(v[8], v[9]); CE_(v[10], v[11]); CE_(v[12], v[13]); CE_(v[14], v[15]); } while (0)
__device__ __forceinline__ void ph_route(const Params& p, LAS unsigned char* ldsl, int wave, int lane, int gwave, int gnw) {
    const int r32 = lane & 31, hi = lane >> 5;
    const bf16_t* SK = (const bf16_t*)(p.ws + WS_SUBK);
    LAS unsigned char* tab = ldsl + wave * 4096 + lane * 32;
    for (int item = gwave; item < (T / 32) * 8; item += gnw) {
        const int tile = item >> 3, h = item & 7, t0 = tile * 32;
        int hi4 = hi * 4; asm volatile("" : "+v"(hi4));
        int S0[16], S1[16];
#pragma unroll
        for (int j = 0; j < 2; ++j) {
            const bf16_t* qp = (const bf16_t*)(p.ws + WS_QP) + (size_t)(t0 + r32) * DM + h * 256 + j * 128 + 8 * hi;
            asm volatile("" : "+v"(qp));
            bf16x8 bq[8];
#pragma unroll
            for (int s = 0; s < 8; ++s) bq[s] = *(const bf16x8*)(qp + 16 * s);
            int L[16];
#pragma unroll
            for (int kb = 0; kb < 4; ++kb) {
                const bf16_t* ap = SK + ((size_t)(h * 2 + j) * 128 + kb * 32 + r32) * 128 + 8 * hi;
                asm volatile("" : "+v"(ap));
                f32x16 acc;
#pragma unroll
                for (int r = 0; r < 16; ++r) acc[r] = 0.f;
#pragma unroll
                for (int s = 0; s < 8; ++s) acc = __builtin_amdgcn_mfma_f32_32x32x16_bf16(*(const bf16x8*)(ap + 16 * s), bq[s], acc, 0, 0, 0);
                int v[16];
#pragma unroll
                for (int r = 0; r < 16; ++r) v[r] = (f2sort(acc[r]) & ~127) | ((127 - (kb * 32 + (r & 3) + 8 * (r >> 2))) - hi4);
                SORT16(v);
                if (kb == 0) {
#pragma unroll
                    for (int i = 0; i < 16; ++i) L[i] = v[i];
                } else {
#pragma unroll
                    for (int i = 0; i < 16; ++i) L[i] = max(L[i], v[15 - i]);
                    BMERGE16(L);
                }
                __builtin_amdgcn_sched_barrier(0);
            }
            int Y[16];
#pragma unroll
            for (int i = 0; i < 16; ++i) Y[i] = __shfl_xor(L[i], 32);
#pragma unroll
            for (int i = 0; i < 16; ++i) L[i] = max(L[i], Y[15 - i]);
            BMERGE16(L);
#pragma unroll
            for (int i = 0; i < 16; ++i) { if (j == 0) S0[i] = L[i]; else S1[i] = L[i]; }
        }
        float f0[16], f1[16];
        {
            unsigned w0[4], w1[4];
#pragma unroll
            for (int i = 0; i < 16; ++i) { f0[i] = sort2f(S0[i] & ~127); f1[i] = sort2f(S1[i] & ~127); }
#pragma unroll
            for (int q = 0; q < 4; ++q) {
                w0[q] = (unsigned)(127 - (S0[4 * q] & 127)) | ((unsigned)(127 - (S0[4 * q + 1] & 127)) << 8) | ((unsigned)(127 - (S0[4 * q + 2] & 127)) << 16) | ((unsigned)(127 - (S0[4 * q + 3] & 127)) << 24);
                w1[q] = (unsigned)(127 - (S1[4 * q] & 127)) | ((unsigned)(127 - (S1[4 * q + 1] & 127)) << 8) | ((unsigned)(127 - (S1[4 * q + 2] & 127)) << 16) | ((unsigned)(127 - (S1[4 * q + 3] & 127)) << 24);
            }
            *(LAS u32x4*)(tab) = (u32x4){w0[0], w0[1], w0[2], w0[3]};
            *(LAS u32x4*)(tab + 16) = (u32x4){w1[0], w1[1], w1[2], w1[3]};
        }
        int Lv[16];
        Lv[0] = (f2sort(f0[0] + f1[0]) & ~255) | 255;
        Lv[1] = (f2sort(f0[0] + f1[1]) & ~255) | 254;
        Lv[2] = (f2sort(f0[0] + f1[2]) & ~255) | 253;
        Lv[3] = (f2sort(f0[0] + f1[3]) & ~255) | 252;
        Lv[4] = (f2sort(f0[0] + f1[4]) & ~255) | 251;
        Lv[5] = (f2sort(f0[0] + f1[5]) & ~255) | 250;
        Lv[6] = (f2sort(f0[0] + f1[6]) & ~255) | 249;
        Lv[7] = (f2sort(f0[0] + f1[7]) & ~255) | 248;
        Lv[8] = (f2sort(f0[0] + f1[8]) & ~255) | 247;
        Lv[9] = (f2sort(f0[0] + f1[9]) & ~255) | 246;
        Lv[10] = (f2sort(f0[0] + f1[10]) & ~255) | 245;
        Lv[11] = (f2sort(f0[0] + f1[11]) & ~255) | 244;
        Lv[12] = (f2sort(f0[0] + f1[12]) & ~255) | 243;
        Lv[13] = (f2sort(f0[0] + f1[13]) & ~255) | 242;
        Lv[14] = (f2sort(f0[0] + f1[14]) & ~255) | 241;
        Lv[15] = (f2sort(f0[0] + f1[15]) & ~255) | 240;
        { int cv_ = (f2sort(f0[1] + f1[0]) & ~255) | 239; INS16(Lv, cv_); __builtin_amdgcn_sched_barrier(0); }
        { int cv_ = (f2sort(f0[1] + f1[1]) & ~255) | 238; INS16(Lv, cv_); __builtin_amdgcn_sched_barrier(0); }
        { int cv_ = (f2sort(f0[1] + f1[2]) & ~255) | 237; INS16(Lv, cv_); __builtin_amdgcn_sched_barrier(0); }
        { int cv_ = (f2sort(f0[1] + f1[3]) & ~255) | 236; INS16(Lv, cv_); __builtin_amdgcn_sched_barrier(0); }
        { int cv_ = (f2sort(f0[1] + f1[4]) & ~255) | 235; INS16(Lv, cv_); __builtin_amdgcn_sched_barrier(0); }
        { int cv_ = (f2sort(f0[1] + f1[5]) & ~255) | 234; INS16(Lv, cv_); __builtin_amdgcn_sched_barrier(0); }
        { int cv_ = (f2sort(f0[1] + f1[6]) & ~255) | 233; INS16(Lv, cv_); __builtin_amdgcn_sched_barrier(0); }
        { int cv_ = (f2sort(f0[1] + f1[7]) & ~255) | 232; INS16(Lv, cv_); __builtin_amdgcn_sched_barrier(0); }
        { int cv_ = (f2sort(f0[2] + f1[0]) & ~255) | 223; INS16(Lv, cv_); __builtin_amdgcn_sched_barrier(0); }
        { int cv_ = (f2sort(f0[2] + f1[1]) & ~255) | 222; INS16(Lv, cv_); __builtin_amdgcn_sched_barrier(0); }
        { int cv_ = (f2sort(f0[2] + f1[2]) & ~255) | 221; INS16(Lv, cv_); __builtin_amdgcn_sched_barrier(0); }
        { int cv_ = (f2sort(f0[2] + f1[3]) & ~255) | 220; INS16(Lv, cv_); __builtin_amdgcn_sched_barrier(0); }
        { int cv_ = (f2sort(f0[2] + f1[4]) & ~255) | 219; INS16(Lv, cv_); __builtin_amdgcn_sched_barrier(0); }
        { int cv_ = (f2sort(f0[3] + f1[0]) & ~255) | 207; INS16(Lv, cv_); __builtin_amdgcn_sched_barrier(0); }
        { int cv_ = (f2sort(f0[3] + f1[1]) & ~255) | 206; INS16(Lv, cv_); __builtin_amdgcn_sched_barrier(0); }
        { int cv_ = (f2sort(f0[3] + f1[2]) & ~255) | 205; INS16(Lv, cv_); __builtin_amdgcn_sched_barrier(0); }
        { int cv_ = (f2sort(f0[3] + f1[3]) & ~255) | 204; INS16(Lv, cv_); __builtin_amdgcn_sched_barrier(0); }
        { int cv_ = (f2sort(f0[4] + f1[0]) & ~255) | 191; INS16(Lv, cv_); __builtin_amdgcn_sched_barrier(0); }
        { int cv_ = (f2sort(f0[4] + f1[1]) & ~255) | 190; INS16(Lv, cv_); __builtin_amdgcn_sched_barrier(0); }
        { int cv_ = (f2sort(f0[4] + f1[2]) & ~255) | 189; INS16(Lv, cv_); __builtin_amdgcn_sched_barrier(0); }
        { int cv_ = (f2sort(f0[5] + f1[0]) & ~255) | 175; INS16(Lv, cv_); __builtin_amdgcn_sched_barrier(0); }
        { int cv_ = (f2sort(f0[5] + f1[1]) & ~255) | 174; INS16(Lv, cv_); __builtin_amdgcn_sched_barrier(0); }
        { int cv_ = (f2sort(f0[6] + f1[0]) & ~255) | 159; INS16(Lv, cv_); __builtin_amdgcn_sched_barrier(0); }
        { int cv_ = (f2sort(f0[6] + f1[1]) & ~255) | 158; INS16(Lv, cv_); __builtin_amdgcn_sched_barrier(0); }
        { int cv_ = (f2sort(f0[7] + f1[0]) & ~255) | 143; INS16(Lv, cv_); __builtin_amdgcn_sched_barrier(0); }
        { int cv_ = (f2sort(f0[7] + f1[1]) & ~255) | 142; INS16(Lv, cv_); __builtin_amdgcn_sched_barrier(0); }
        { int cv_ = (f2sort(f0[8] + f1[0]) & ~255) | 127; INS16(Lv, cv_); __builtin_amdgcn_sched_barrier(0); }
        { int cv_ = (f2sort(f0[9] + f1[0]) & ~255) | 111; INS16(Lv, cv_); __builtin_amdgcn_sched_barrier(0); }
        { int cv_ = (f2sort(f0[10] + f1[0]) & ~255) | 95; INS16(Lv, cv_); __builtin_amdgcn_sched_barrier(0); }
        { int cv_ = (f2sort(f0[11] + f1[0]) & ~255) | 79; INS16(Lv, cv_); __builtin_amdgcn_sched_barrier(0); }
        { int cv_ = (f2sort(f0[12] + f1[0]) & ~255) | 63; INS16(Lv, cv_); __builtin_amdgcn_sched_barrier(0); }
        { int cv_ = (f2sort(f0[13] + f1[0]) & ~255) | 47; INS16(Lv, cv_); __builtin_amdgcn_sched_barrier(0); }
        { int cv_ = (f2sort(f0[14] + f1[0]) & ~255) | 31; INS16(Lv, cv_); __builtin_amdgcn_sched_barrier(0); }
        { int cv_ = (f2sort(f0[15] + f1[0]) & ~255) | 15; INS16(Lv, cv_); __builtin_amdgcn_sched_barrier(0); }
        float g[16]; float sum = 0.f; const float mx = sort2f(Lv[0] & ~255);
        int Le[16];
#pragma unroll
        for (int i = 0; i < 16; ++i) {
            g[i] = __expf(sort2f(Lv[i] & ~255) - mx); sum += g[i];
            const int pos = 255 - (Lv[i] & 255);
            const int ia = *(const LAS unsigned char*)(tab + (pos >> 4)), ib = *(const LAS unsigned char*)(tab + 16 + (pos & 15));
            Le[i] = ia * 128 + ib;
        }
        const float inv = 1.f / sum;
        if (hi == 0) {
            int* ip = (int*)(p.ws + WS_IDX) + (size_t)(t0 + r32) * 128 + h * 16; float* gp = (float*)(p.ws + WS_GATE) + (size_t)(t0 + r32) * 128 + h * 16;
#pragma unroll
            for (int i = 0; i < 4; ++i) {
                *(u32x4*)(ip + 4 * i) = (u32x4){(unsigned)Le[4 * i], (unsigned)Le[4 * i + 1], (unsigned)Le[4 * i + 2], (unsigned)Le[4 * i + 3]};
                *(f32x4*)(gp + 4 * i) = (f32x4){g[4 * i] * inv, g[4 * i + 1] * inv, g[4 * i + 2] * inv, g[4 * i + 3] * inv};
            }
        }
        asm volatile("s_waitcnt lgkmcnt(0)" ::: "memory");
    }
}
__device__ __forceinline__ void ph_conv(const Params& p, int gwave, int gnw, int lane) {
    const bf16_t* proj = (const bf16_t*)(p.ws + WS_PROJ);
    bf16_t* xa = (bf16_t*)(p.ws + WS_XBCA);
    for (int task = gwave; task < 1536 + 256; task += gnw) {
        if (task < 1536) {
            const int run = task / 3, cg = (task % 3) * 64 + lane, c0 = cg * 8;
            const int t0 = run * 32, s0 = t0 % SEQ;
            float w0[8], w1[8], w2[8], w3[8], bs[8], h1[8], h2[8], h3[8];
#pragma unroll
            for (int i = 0; i < 8; ++i) { w0[i] = p.conv_w[0 * 1536 + c0 + i]; w1[i] = p.conv_w[1 * 1536 + c0 + i]; w2[i] = p.conv_w[2 * 1536 + c0 + i]; w3[i] = p.conv_w[3 * 1536 + c0 + i]; bs[i] = p.conv_b[c0 + i]; h1[i] = 0.f; h2[i] = 0.f; h3[i] = 0.f; }
            const bf16_t* src = proj + (size_t)t0 * NPROJ + C_XBC + c0;
            if (s0 > 0) {
                const u32x4 a = *(const u32x4*)(src - (size_t)1 * NPROJ), b = *(const u32x4*)(src - (size_t)2 * NPROJ), c = *(const u32x4*)(src - (size_t)3 * NPROJ);
                h1[0] = bflo(a.x); h1[1] = bfhi(a.x); h1[2] = bflo(a.y); h1[3] = bfhi(a.y); h1[4] = bflo(a.z); h1[5] = bfhi(a.z); h1[6] = bflo(a.w); h1[7] = bfhi(a.w);
                h2[0] = bflo(b.x); h2[1] = bfhi(b.x); h2[2] = bflo(b.y); h2[3] = bfhi(b.y); h2[4] = bflo(b.z); h2[5] = bfhi(b.z); h2[6] = bflo(b.w); h2[7] = bfhi(b.w);
                h3[0] = bflo(c.x); h3[1] = bfhi(c.x); h3[2] = bflo(c.y); h3[3] = bfhi(c.y); h3[4] = bflo(c.z); h3[5] = bfhi(c.z); h3[6] = bflo(c.w); h3[7] = bfhi(c.w);
            }
            bf16_t* dst = xa + (size_t)t0 * 1536 + c0;
#pragma unroll 16
            for (int i = 0; i < 32; ++i) {
                const u32x4 a = *(const u32x4*)(src + (size_t)i * NPROJ);
                float cur[8] = {bflo(a.x), bfhi(a.x), bflo(a.y), bfhi(a.y), bflo(a.z), bfhi(a.z), bflo(a.w), bfhi(a.w)};
                float o[8];
#pragma unroll
                for (int k = 0; k < 8; ++k) { o[k] = silu_fast(bs[k] + w3[k] * cur[k] + w2[k] * h1[k] + w1[k] * h2[k] + w0[k] * h3[k]); h3[k] = h2[k]; h2[k] = h1[k]; h1[k] = cur[k]; }
                u32x4 w; w.x = pk2(o[0], o[1]); w.y = pk2(o[2], o[3]); w.z = pk2(o[4], o[5]); w.w = pk2(o[6], o[7]);
                *(u32x4*)(dst + (size_t)i * 1536) = w;
            }
        } else {
            const int t = (task - 1536) * 64 + lane;
            const u32x4 a = *(const u32x4*)(proj + (size_t)t * NPROJ + C_DT), b = *(const u32x4*)(proj + (size_t)t * NPROJ + C_DT + 8);
            const float raw[16] = {bflo(a.x), bfhi(a.x), bflo(a.y), bfhi(a.y), bflo(a.z), bfhi(a.z), bflo(a.w), bfhi(a.w), bflo(b.x), bfhi(b.x), bflo(b.y), bfhi(b.y), bflo(b.z), bfhi(b.z), bflo(b.w), bfhi(b.w)};
            float* dto = (float*)(p.ws + WS_DT) + (size_t)t * 16; float* cso = (float*)(p.ws + WS_CS) + (size_t)t * 16;
            float dtv[16], csv[16];
#pragma unroll
            for (int hh = 0; hh < 16; ++hh) {
                const float v = raw[hh] + p.dt_bias[hh];
                const float dt = (v > 20.f) ? v : log1pf(__expf(v));
                float c = dt * (-__expf(p.a_log[hh]));
#pragma unroll
                for (int o = 1; o < 64; o <<= 1) { const float u = __shfl_up(c, o); if (lane >= o) c += u; }
                dtv[hh] = dt; csv[hh] = c;
            }
#pragma unroll
            for (int q = 0; q < 4; ++q) { *(f32x4*)(dto + 4 * q) = (f32x4){dtv[4 * q], dtv[4 * q + 1], dtv[4 * q + 2], dtv[4 * q + 3]}; *(f32x4*)(cso + 4 * q) = (f32x4){csv[4 * q], csv[4 * q + 1], csv[4 * q + 2], csv[4 * q + 3]}; }
        }
    }
}
constexpr int P4_ROW = 1152;
__device__ __forceinline__ void fp4_row_load(const Params& p, int row, int lane, f32x4 (&v)[8]) {
    const f32x4* src = (const f32x4*)(((row >= 16384) ? p.v_exp : p.u_exp) + (size_t)(row & 16383) * DM) + lane;
#pragma unroll
    for (int j = 0; j < 8; ++j) v[j] = src[64 * j];
}
__device__ __forceinline__ void fp4_row_store(const Params& p, int row, int lane, const f32x4 (&v)[8]) {
    float mx = 0.f;
#pragma unroll
    for (int j = 0; j < 8; ++j) mx = fmaxf(mx, fmaxf(fmaxf(fabsf(v[j].x), fabsf(v[j].y)), fmaxf(fabsf(v[j].z), fabsf(v[j].w))));
    unsigned sb = f2bf(mx * (1.f / 6.f));
    if (bf2f(sb) * 6.f < mx) sb += 1u;
    if (sb == 0u) sb = 0x3f80u;
    const float inv = 1.f / bf2f(sb);
    unsigned w[4];
#pragma unroll
    for (int q = 0; q < 4; ++q) {
        const f32x4 a = v[2 * q] * inv, b = v[2 * q + 1] * inv;
        unsigned r = 0u;
        r = __builtin_amdgcn_cvt_scalef32_pk_fp4_f32(r, a.x, a.y, 1.0f, 0);
        r = __builtin_amdgcn_cvt_scalef32_pk_fp4_f32(r, a.z, a.w, 1.0f, 1);
        r = __builtin_amdgcn_cvt_scalef32_pk_fp4_f32(r, b.x, b.y, 1.0f, 2);
        r = __builtin_amdgcn_cvt_scalef32_pk_fp4_f32(r, b.z, b.w, 1.0f, 3);
        w[q] = r;
    }
    unsigned char* dst = p.ws + ((row >= 16384) ? WS_V4 : WS_U4) + (size_t)(row & 16383) * P4_ROW;
    *(u32x4*)(dst + lane * 16) = (u32x4){w[0], w[1], w[2], w[3]};
    *(unsigned short*)(dst + 1024 + lane * 2) = (unsigned short)sb;
}
constexpr int SSD_IN = 41472, SSD_BM = 0, SSD_CM = 16384, SSD_XS = 32768, SSD_Z = 36864, SSD_DT = 40960, SSD_CS = 41216, SSD_ST = 3 * SSD_IN, SSD_PART = SSD_ST + 16384, SSD_SYNC = SSD_PART + 4096;
__device__ __forceinline__ void ssd_decay_block(f32x16& cbt, const LAS float* csl, const LAS float* dtl, float cs_l, int sb, int l, int hi, bool diag) {
#pragma unroll
    for (int q = 0; q < 4; ++q) {
        const f32x4 c4 = *(const LAS f32x4*)(csl + 32 * sb + 8 * q + 4 * hi), d4 = *(const LAS f32x4*)(dtl + 32 * sb + 8 * q + 4 * hi);
#pragma unroll
        for (int i = 0; i < 4; ++i) {
            const int s = 32 * sb + 8 * q + 4 * hi + i;
            float e = __expf(cs_l - c4[i]) * d4[i];
            if (diag) e = (s <= l) ? e : 0.f;
            cbt[4 * q + i] *= e;
        }
    }
}
__device__ __forceinline__ void ph_ssd(const Params& p, LAS unsigned char* ldsl, int bid, int wave, int lane) {
    const int b = bid >> 5, h = (bid >> 1) & 15, ph = bid & 1, g = h >> 3;
    const int r32 = lane & 31, hi = lane >> 5;
    const size_t tb0 = (size_t)b * SEQ;
    LAS unsigned* sync = (LAS unsigned*)(ldsl + SSD_SYNC);
    if (threadIdx.x < 16) sync[threadIdx.x] = (threadIdx.x >= 14) ? 0xffffffffu : 0u;
    for (int i = threadIdx.x; i < 8192 / 16; i += NTHR) *(LAS u32x4*)(ldsl + SSD_ST + i * 16) = (u32x4){0u, 0u, 0u, 0u};
    asm volatile("s_waitcnt lgkmcnt(0)" ::: "memory"); __builtin_amdgcn_s_barrier(); asm volatile("" ::: "memory");
    if (wave >= 6) {
        const int cvw = bid * 2 + (wave - 6);
        f32x4 ra[8], rb[8], rc[8], rd[8];
        fp4_row_load(p, cvw, lane, ra); fp4_row_load(p, 512 + cvw, lane, rb); fp4_row_load(p, 1024 + cvw, lane, rc); fp4_row_load(p, 1536 + cvw, lane, rd);
        for (int c = 0; c < 16; ++c) {
            fp4_row_store(p, (4 * c) * 512 + cvw, lane, ra);
            if (c + 1 < 16) fp4_row_load(p, (4 * c + 4) * 512 + cvw, lane, ra);
            fp4_row_store(p, (4 * c + 1) * 512 + cvw, lane, rb);
            if (c + 1 < 16) fp4_row_load(p, (4 * c + 5) * 512 + cvw, lane, rb);
            fp4_row_store(p, (4 * c + 2) * 512 + cvw, lane, rc);
            if (c + 1 < 16) fp4_row_load(p, (4 * c + 6) * 512 + cvw, lane, rc);
            fp4_row_store(p, (4 * c + 3) * 512 + cvw, lane, rd);
            if (c + 1 < 16) fp4_row_load(p, (4 * c + 7) * 512 + cvw, lane, rd);
        }
    } else {
        const bf16_t* xa = (const bf16_t*)(p.ws + WS_XBCA); const bf16_t* proj = (const bf16_t*)(p.ws + WS_PROJ);
        const float dsk = p.d_skip[h];
        const int dq = (wave - 2) & 3;
        const int dr0 = 4 * dq + (lane >> 4);
        const bf16_t* bsrc = xa + (tb0 + dr0) * 1536 + 1024 + g * 128 + (((lane & 15) ^ (dr0 & 15)) * 8);
        const bf16_t* csrc = xa + (tb0 + dr0) * 1536 + 1280 + g * 128 + (((lane & 15) ^ (dr0 & 15)) * 8);
        const bf16_t* xsrc = xa + (tb0 + 16 * dq + (lane >> 2)) * 1536 + h * 64 + ph * 32 + (lane & 3) * 8;
        const bf16_t* zsrc = proj + (tb0 + 16 * dq + (lane >> 2)) * NPROJ + C_Z + h * 64 + ph * 32 + (lane & 3) * 8;
        const float* dsrc = (const float*)(p.ws + ((dq == 0) ? WS_DT : WS_CS)) + (tb0 + lane) * 16 + h;
#define SSD_G16(src, dst) __builtin_amdgcn_global_load_lds((const unsigned*)(src), (LAS unsigned*)(dst), 16, 0, 0)
#define SSD_ISSUE(c, buf) do { if (wave >= 2) { LAS unsigned char* in_ = ldsl + (buf) * SSD_IN; const size_t to_ = (size_t)(c) * 64 * 1536; \
        SSD_G16(bsrc + to_, in_ + SSD_BM + dq * 1024); SSD_G16(bsrc + to_ + 16 * 1536, in_ + SSD_BM + (dq + 4) * 1024); SSD_G16(bsrc + to_ + 32 * 1536, in_ + SSD_BM + (dq + 8) * 1024); SSD_G16(bsrc + to_ + 48 * 1536, in_ + SSD_BM + (dq + 12) * 1024); \
        SSD_G16(csrc + to_, in_ + SSD_CM + dq * 1024); SSD_G16(csrc + to_ + 16 * 1536, in_ + SSD_CM + (dq + 4) * 1024); SSD_G16(csrc + to_ + 32 * 1536, in_ + SSD_CM + (dq + 8) * 1024); SSD_G16(csrc + to_ + 48 * 1536, in_ + SSD_CM + (dq + 12) * 1024); \
        SSD_G16(xsrc + to_, in_ + SSD_XS + dq * 1024); SSD_G16(zsrc + (size_t)(c) * 64 * NPROJ, in_ + SSD_Z + dq * 1024); \
        if (dq < 2) __builtin_amdgcn_global_load_lds((const unsigned*)(dsrc + (size_t)(c) * 64 * 16), (LAS unsigned*)(in_ + ((dq == 0) ? SSD_DT : SSD_CS)), 4, 0, 0); } } while (0)
        f32x16 S;
#pragma unroll
        for (int r = 0; r < 16; ++r) S[r] = 0.f;
        SSD_ISSUE(0, 0); SSD_ISSUE(1, 1);
        const int xfo = ((lane >> 4) & 1) * 32 + (lane & 3) * 8 + (4 * hi + ((lane & 15) >> 2)) * 64;
        for (int c = 0; c < SEQ / 64; ++c) {
            if (wave >= 2) { if (c + 1 >= SEQ / 64) asm volatile("s_waitcnt vmcnt(0)" ::: "memory"); else if (dq < 2) asm volatile("s_waitcnt vmcnt(11)" ::: "memory"); else asm volatile("s_waitcnt vmcnt(10)" ::: "memory"); }
            asm volatile("s_waitcnt lgkmcnt(0)" ::: "memory");
            {
                const unsigned sa = (unsigned)(size_t)(ldsl + SSD_SYNC), tgt = (unsigned)(c + 1);
                asm volatile("ds_write_b32 %0, %1" :: "v"(sa + 32u + 4u * (unsigned)wave), "v"(tgt) : "memory");
                for (;;) { u32x4 a, b_; asm volatile("ds_read_b128 %0, %2 offset:32\n\tds_read_b128 %1, %2 offset:48\n\ts_waitcnt lgkmcnt(0)" : "=&v"(a), "=&v"(b_) : "v"(sa) : "memory");
                    const unsigned m = min(min(min(a.x, a.y), min(a.z, a.w)), min(min(b_.x, b_.y), min(b_.z, b_.w)));
                    if (__builtin_amdgcn_readfirstlane(m) >= tgt) break; __builtin_amdgcn_s_sleep(1); }
            }
            asm volatile("" ::: "memory");
            if (c + 2 < SEQ / 64) SSD_ISSUE(c + 2, (c + 2) % 3);
            const LAS unsigned char* in = ldsl + (c % 3) * SSD_IN;
            const LAS unsigned char* STin = ldsl + SSD_ST + (c & 1) * 8192;
            LAS unsigned char* STout = ldsl + SSD_ST + ((c + 1) & 1) * 8192;
            const LAS float* dtl = (const LAS float*)(in + SSD_DT); const LAS float* csl = (const LAS float*)(in + SSD_CS);
            if (wave < 2) {
                const int lb = wave, l = 32 * lb + r32;
                if (wave == 0) {
                    const int l1 = 32 + r32; const float cs_l1 = csl[l1];
                    f32x16 ca, cb;
#pragma unroll
                    for (int r = 0; r < 16; ++r) { ca[r] = 0.f; cb[r] = 0.f; }
#pragma unroll
                    for (int ks = 0; ks < 8; ks += 2) {
                        ca = __builtin_amdgcn_mfma_f32_32x32x16_bf16(*(const LAS bf16x8*)(in + SSD_BM + r32 * 256 + (((2 * ks + hi) ^ (r32 & 15)) << 4)), *(const LAS bf16x8*)(in + SSD_CM + l1 * 256 + (((2 * ks + hi) ^ (l1 & 15)) << 4)), ca, 0, 0, 0);
                        cb = __builtin_amdgcn_mfma_f32_32x32x16_bf16(*(const LAS bf16x8*)(in + SSD_BM + r32 * 256 + (((2 * ks + 2 + hi) ^ (r32 & 15)) << 4)), *(const LAS bf16x8*)(in + SSD_CM + l1 * 256 + (((2 * ks + 2 + hi) ^ (l1 & 15)) << 4)), cb, 0, 0, 0);
                    }
                    ca += cb;
                    ssd_decay_block(ca, csl, dtl, cs_l1, 0, l1, hi, false);
                    u32x4 w0, w1;
                    w0.x = cvtpk(ca[0], ca[1]); w0.y = cvtpk(ca[2], ca[3]); w0.z = cvtpk(ca[4], ca[5]); w0.w = cvtpk(ca[6], ca[7]);
                    w1.x = cvtpk(ca[8], ca[9]); w1.y = cvtpk(ca[10], ca[11]); w1.z = cvtpk(ca[12], ca[13]); w1.w = cvtpk(ca[14], ca[15]);
                    const unsigned xpa = (unsigned)(size_t)(in + SSD_XS + xfo);
                    f32x16 pa;
#pragma unroll
                    for (int r = 0; r < 16; ++r) pa[r] = 0.f;
                    { s16x4 lo0, hh0, lo1, hh1; TR_PAIR(lo0, hh0, xpa, 0, 512); TR_PAIR(lo1, hh1, xpa, 1024, 512); LDS_WAIT_PIN();
                      pa = __builtin_amdgcn_mfma_f32_32x32x16_bf16((bf16x8){lo0[0], lo0[1], lo0[2], lo0[3], hh0[0], hh0[1], hh0[2], hh0[3]}, __builtin_bit_cast(bf16x8, w0), pa, 0, 0, 0);
                      pa = __builtin_amdgcn_mfma_f32_32x32x16_bf16((bf16x8){lo1[0], lo1[1], lo1[2], lo1[3], hh1[0], hh1[1], hh1[2], hh1[3]}, __builtin_bit_cast(bf16x8, w1), pa, 0, 0, 0); }
                    LAS unsigned char* pp = ldsl + SSD_PART + lane * 64;
#pragma unroll
                    for (int q = 0; q < 4; ++q) *(LAS f32x4*)(pp + q * 16) = (f32x4){pa[4 * q], pa[4 * q + 1], pa[4 * q + 2], pa[4 * q + 3]};
                    asm volatile("s_waitcnt lgkmcnt(0)" ::: "memory");
                    asm volatile("ds_write_b32 %0, %1" :: "v"((unsigned)(size_t)(ldsl + SSD_SYNC) + 4u), "v"((unsigned)(c + 1)) : "memory");
                }
                const float cs_l = csl[l];
                bf16x8 cf[8];
#pragma unroll
                for (int ks = 0; ks < 8; ++ks) cf[ks] = *(const LAS bf16x8*)(in + SSD_CM + l * 256 + (((2 * ks + hi) ^ (l & 15)) << 4));
                f32x16 acc, acc2;
#pragma unroll
                for (int r = 0; r < 16; ++r) { acc[r] = 0.f; acc2[r] = 0.f; }
#pragma unroll
                for (int ks = 0; ks < 8; ks += 2) {
                    acc = __builtin_amdgcn_mfma_f32_32x32x16_bf16(*(const LAS bf16x8*)(STin + (2 * ks + hi) * 512 + r32 * 16), cf[ks], acc, 0, 0, 0);
                    acc2 = __builtin_amdgcn_mfma_f32_32x32x16_bf16(*(const LAS bf16x8*)(STin + (2 * ks + 2 + hi) * 512 + r32 * 16), cf[ks + 1], acc2, 0, 0, 0);
                }
                { const float ecs = __expf(cs_l);
#pragma unroll
                  for (int r = 0; r < 16; ++r) acc[r] = (acc[r] + acc2[r]) * ecs; }
                {
                    f32x16 ca, cb;
#pragma unroll
                    for (int r = 0; r < 16; ++r) { ca[r] = 0.f; cb[r] = 0.f; }
#pragma unroll
                    for (int ks = 0; ks < 8; ks += 2) {
                        ca = __builtin_amdgcn_mfma_f32_32x32x16_bf16(*(const LAS bf16x8*)(in + SSD_BM + l * 256 + (((2 * ks + hi) ^ (l & 15)) << 4)), cf[ks], ca, 0, 0, 0);
                        cb = __builtin_amdgcn_mfma_f32_32x32x16_bf16(*(const LAS bf16x8*)(in + SSD_BM + l * 256 + (((2 * ks + 2 + hi) ^ (l & 15)) << 4)), cf[ks + 1], cb, 0, 0, 0);
                    }
                    ca += cb;
                    ssd_decay_block(ca, csl, dtl, cs_l, lb, l, hi, true);
                    u32x4 w0, w1;
                    w0.x = cvtpk(ca[0], ca[1]); w0.y = cvtpk(ca[2], ca[3]); w0.z = cvtpk(ca[4], ca[5]); w0.w = cvtpk(ca[6], ca[7]);
                    w1.x = cvtpk(ca[8], ca[9]); w1.y = cvtpk(ca[10], ca[11]); w1.z = cvtpk(ca[12], ca[13]); w1.w = cvtpk(ca[14], ca[15]);
                    const unsigned xpa = (unsigned)(size_t)(in + SSD_XS + xfo + (32 * lb) * 64);
                    { s16x4 lo0, hh0, lo1, hh1; TR_PAIR(lo0, hh0, xpa, 0, 512); TR_PAIR(lo1, hh1, xpa, 1024, 512); LDS_WAIT_PIN();
                      acc = __builtin_amdgcn_mfma_f32_32x32x16_bf16((bf16x8){lo0[0], lo0[1], lo0[2], lo0[3], hh0[0], hh0[1], hh0[2], hh0[3]}, __builtin_bit_cast(bf16x8, w0), acc, 0, 0, 0);
                      acc = __builtin_amdgcn_mfma_f32_32x32x16_bf16((bf16x8){lo1[0], lo1[1], lo1[2], lo1[3], hh1[0], hh1[1], hh1[2], hh1[3]}, __builtin_bit_cast(bf16x8, w1), acc, 0, 0, 0); }
                }
                if (wave == 1) {
                    for (;;) { unsigned fl; asm volatile("ds_read_b32 %0, %1 offset:4\n\ts_waitcnt lgkmcnt(0)" : "=&v"(fl) : "v"((unsigned)(size_t)(ldsl + SSD_SYNC)) : "memory");
                        if (__builtin_amdgcn_readfirstlane(fl) >= (unsigned)(c + 1)) break; __builtin_amdgcn_s_sleep(1); }
                    asm volatile("" ::: "memory");
                    const LAS unsigned char* pp = ldsl + SSD_PART + lane * 64;
#pragma unroll
                    for (int q = 0; q < 4; ++q) { const f32x4 v = *(const LAS f32x4*)(pp + q * 16); acc[4 * q] += v[0]; acc[4 * q + 1] += v[1]; acc[4 * q + 2] += v[2]; acc[4 * q + 3] += v[3]; }
                }
                bf16_t* yo = (bf16_t*)(p.ws + WS_YSSD) + (tb0 + (size_t)c * 64 + l) * 1024 + h * 64 + ph * 32 + 4 * hi;
#pragma unroll
                for (int q = 0; q < 4; ++q) {
                    const u32x2 xw = *(const LAS u32x2*)(in + SSD_XS + l * 64 + (8 * q + 4 * hi) * 2), zw = *(const LAS u32x2*)(in + SSD_Z + l * 64 + (8 * q + 4 * hi) * 2);
                    const float y0 = (acc[4 * q + 0] + dsk * bflo(xw.x)) * silu_fast(bflo(zw.x)), y1 = (acc[4 * q + 1] + dsk * bfhi(xw.x)) * silu_fast(bfhi(zw.x));
                    const float y2 = (acc[4 * q + 2] + dsk * bflo(xw.y)) * silu_fast(bflo(zw.y)), y3 = (acc[4 * q + 3] + dsk * bfhi(xw.y)) * silu_fast(bfhi(zw.y));
                    u32x2 o; o.x = pk2(y0, y1); o.y = pk2(y2, y3);
                    *(u32x2*)(yo + 8 * q) = o;
                }
            } else {
                const int nb = wave - 2;
                const float cs63 = csl[63];
                { const float dec = __expf(cs63);
#pragma unroll
                  for (int r = 0; r < 16; ++r) S[r] *= dec; }
                const int brow = 4 * hi + ((lane & 15) >> 2), bch = 4 * nb + 2 * ((lane >> 4) & 1) + ((lane & 3) >> 1);
                const unsigned xpa = (unsigned)(size_t)(in + xfo);
                const unsigned bpa = (unsigned)(size_t)(in + SSD_BM + brow * 256 + ((bch ^ brow) << 4) + (lane & 1) * 8);
                const unsigned bpb = (unsigned)(size_t)(in + SSD_BM + (brow + 8) * 256 + ((bch ^ (brow + 8)) << 4) + (lane & 1) * 8);
#pragma unroll
                for (int ks = 0; ks < 4; ++ks) {
                    s16x4 lo, hh, blo, bhh;
                    TR_PAIR(lo, hh, xpa, SSD_XS + (16 * ks) * 64, 512);
                    asm volatile("ds_read_b64_tr_b16 %0, %1 offset:%c2" : "=&v"(blo) : "v"(bpa), "i"((16 * ks) * 256) : "memory");
                    asm volatile("ds_read_b64_tr_b16 %0, %1 offset:%c2" : "=&v"(bhh) : "v"(bpb), "i"((16 * ks) * 256) : "memory");
                    const f32x4 c0 = *(const LAS f32x4*)(csl + 16 * ks + 4 * hi), c1 = *(const LAS f32x4*)(csl + 16 * ks + 8 + 4 * hi);
                    const f32x4 d0 = *(const LAS f32x4*)(dtl + 16 * ks + 4 * hi), d1 = *(const LAS f32x4*)(dtl + 16 * ks + 8 + 4 * hi);
                    LDS_WAIT_PIN();
                    float xf[8];
#pragma unroll
                    for (int j = 0; j < 4; ++j) { xf[j] = bf2f((unsigned short)lo[j]) * __expf(cs63 - c0[j]) * d0[j]; xf[4 + j] = bf2f((unsigned short)hh[j]) * __expf(cs63 - c1[j]) * d1[j]; }
                    u32x4 aw; aw.x = cvtpk(xf[0], xf[1]); aw.y = cvtpk(xf[2], xf[3]); aw.z = cvtpk(xf[4], xf[5]); aw.w = cvtpk(xf[6], xf[7]);
                    S = __builtin_amdgcn_mfma_f32_32x32x16_bf16(__builtin_bit_cast(bf16x8, aw), (bf16x8){blo[0], blo[1], blo[2], blo[3], bhh[0], bhh[1], bhh[2], bhh[3]}, S, 0, 0, 0);
                }
                const int n = 32 * nb + r32;
#pragma unroll
                for (int r = 0; r < 16; ++r) *(LAS unsigned short*)(STout + (n >> 3) * 512 + crow(r, hi) * 16 + (n & 7) * 2) = (unsigned short)f2bf(S[r]);
            }
        }
#undef SSD_ISSUE
#undef SSD_G16
    }
    asm volatile("s_waitcnt vmcnt(0) lgkmcnt(0)" ::: "memory");
    __builtin_amdgcn_s_barrier(); asm volatile("" ::: "memory");
}
__device__ __forceinline__ void ph_peer4(const Params& p, LAS unsigned char* ldsl, int wave, int lane, int gwave, int gnw) {
    LAS unsigned char* ring = ldsl + wave * 16384;
    const unsigned char* U = (const unsigned char*)(p.ws + WS_U4); const unsigned char* V = (const unsigned char*)(p.ws + WS_V4);
    const int e_lane = (lane >> 2) & 15; const unsigned lane16 = (unsigned)lane * 16u, lanesc = 1024u + (unsigned)(lane >> 1) * 4u;
#define P4_ISSUE(R) do { const int R_ = (R); const int i_ = ((R_ >> 5) << 4) + (R_ & 15); \
        const int e_ = (i_ < 64) ? __builtin_amdgcn_readlane(idx0, i_) : __builtin_amdgcn_readlane(idx1, i_ - 64); \
        const unsigned char* base_ = (((R_ >> 4) & 1) ? V : U) + (size_t)(unsigned)e_ * P4_ROW; \
        LAS unsigned char* dst_ = ring + (R_ & 7) * 1280; \
        __builtin_amdgcn_global_load_lds((const unsigned*)(base_ + lane16), (LAS unsigned*)(dst_), 16, 0, 0); \
        __builtin_amdgcn_global_load_lds((const unsigned*)(base_ + lanesc), (LAS unsigned*)(dst_ + 1024), 4, 0, 0); } while (0)
#define P4_WAIT(n) asm volatile("s_waitcnt vmcnt(" #n ")" ::: "memory")
#define P4_CVT(wd, bs) __builtin_amdgcn_cvt_scalef32_pk_f32_fp4((wd), 1.0f, (bs))
    for (int t = gwave; t < T; t += gnw) {
        const int b = t / SEQ;
        const int idx0 = ((const int*)(p.ws + WS_IDX))[(size_t)t * 128 + lane], idx1 = ((const int*)(p.ws + WS_IDX))[(size_t)t * 128 + 64 + lane];
        float gv0 = ((const float*)(p.ws + WS_GATE))[(size_t)t * 128 + lane], gv1 = ((const float*)(p.ws + WS_GATE))[(size_t)t * 128 + 64 + lane];
        f32x2_t hf[16];
        {
            const bf16_t* hp = (const bf16_t*)(p.ws + WS_H2) + (size_t)t * DM + lane * 4;
#pragma unroll
            for (int j = 0; j < 8; ++j) { const u32x2 a = *(const u32x2*)(hp + j * 256); hf[2 * j] = (f32x2_t){bflo(a.x), bfhi(a.x)}; hf[2 * j + 1] = (f32x2_t){bflo(a.y), bfhi(a.y)}; }
        }
        f32x2_t out[16];
#pragma unroll
        for (int i = 0; i < 16; ++i) out[i] = (f32x2_t){0.f, 0.f};
        asm volatile("" : "+v"(gv0), "+v"(gv1));
        P4_ISSUE(0); P4_ISSUE(1); P4_ISSUE(2); P4_ISSUE(3); P4_ISSUE(4); P4_ISSUE(5); P4_ISSUE(6);
        for (int hh = 0; hh < 8; ++hh) {
            float pd[16];
#pragma unroll
            for (int k = 0; k < 16; ++k) {
                P4_ISSUE(hh * 32 + k + 7); P4_WAIT(14);
                const LAS unsigned char* sl = ring + (k & 7) * 1280;
                const u32x4 w = *(const LAS u32x4*)(sl + lane * 16);
                const unsigned sw = *(const LAS unsigned*)(sl + 1024 + lane * 4);
                const float scl = (lane & 1) ? bfhi(sw) : bflo(sw);
                f32x2_t a2 = (f32x2_t){0.f, 0.f};
                a2 += P4_CVT(w.x, 0) * hf[0]; a2 += P4_CVT(w.x, 1) * hf[1]; a2 += P4_CVT(w.x, 2) * hf[2]; a2 += P4_CVT(w.x, 3) * hf[3];
                a2 += P4_CVT(w.y, 0) * hf[4]; a2 += P4_CVT(w.y, 1) * hf[5]; a2 += P4_CVT(w.y, 2) * hf[6]; a2 += P4_CVT(w.y, 3) * hf[7];
                a2 += P4_CVT(w.z, 0) * hf[8]; a2 += P4_CVT(w.z, 1) * hf[9]; a2 += P4_CVT(w.z, 2) * hf[10]; a2 += P4_CVT(w.z, 3) * hf[11];
                a2 += P4_CVT(w.w, 0) * hf[12]; a2 += P4_CVT(w.w, 1) * hf[13]; a2 += P4_CVT(w.w, 2) * hf[14]; a2 += P4_CVT(w.w, 3) * hf[15];
                float a = (a2.x + a2.y) * scl;
                asm volatile("" : "+v"(a));
                pd[k] = a;
            }
            float q8[8], q4[4], q2[2], q1;
            { const bool hi = (lane & 32) != 0;
#pragma unroll
              for (int i = 0; i < 8; ++i) { const float keep = hi ? pd[i + 8] : pd[i], send = hi ? pd[i] : pd[i + 8]; q8[i] = keep + __shfl_xor(send, 32); } }
            { const bool hi = (lane & 16) != 0;
#pragma unroll
              for (int i = 0; i < 4; ++i) { const float keep = hi ? q8[i + 4] : q8[i], send = hi ? q8[i] : q8[i + 4]; q4[i] = keep + __shfl_xor(send, 16); } }
            { const bool hi = (lane & 8) != 0;
#pragma unroll
              for (int i = 0; i < 2; ++i) { const float keep = hi ? q4[i + 2] : q4[i], send = hi ? q4[i] : q4[i + 2]; q2[i] = keep + __shfl_xor(send, 8); } }
            { const bool hi = (lane & 4) != 0; const float keep = hi ? q2[1] : q2[0], send = hi ? q2[0] : q2[1]; q1 = keep + __shfl_xor(send, 4); }
            q1 += __shfl_xor(q1, 1); q1 += __shfl_xor(q1, 2);
            const float act = 0.5f * q1 * (1.f + erff(q1 * 0.70710678118654752f)) * __shfl((hh < 4) ? gv0 : gv1, (hh & 3) * 16 + e_lane);
#pragma unroll
            for (int k = 0; k < 16; ++k) {
                if (k < 9) { P4_ISSUE(hh * 32 + 16 + k + 7); P4_WAIT(14); }
                else if (hh < 7) { P4_ISSUE(hh * 32 + 16 + k + 7); P4_WAIT(14); }
                else if (k == 9) P4_WAIT(12); else if (k == 10) P4_WAIT(10); else if (k == 11) P4_WAIT(8); else if (k == 12) P4_WAIT(6); else if (k == 13) P4_WAIT(4); else if (k == 14) P4_WAIT(2); else P4_WAIT(0);
                const LAS unsigned char* sl = ring + (k & 7) * 1280;
                const u32x4 w = *(const LAS u32x4*)(sl + lane * 16);
                const unsigned sw = *(const LAS unsigned*)(sl + 1024 + lane * 4);
                const float a = __builtin_bit_cast(float, __builtin_amdgcn_readlane(__builtin_bit_cast(int, act), 4 * k)) * ((lane & 1) ? bfhi(sw) : bflo(sw));
                const f32x2_t aa = (f32x2_t){a, a};
                out[0] += aa * P4_CVT(w.x, 0); out[1] += aa * P4_CVT(w.x, 1); out[2] += aa * P4_CVT(w.x, 2); out[3] += aa * P4_CVT(w.x, 3);
                out[4] += aa * P4_CVT(w.y, 0); out[5] += aa * P4_CVT(w.y, 1); out[6] += aa * P4_CVT(w.y, 2); out[7] += aa * P4_CVT(w.y, 3);
                asm volatile("" : "+v"(out[0]), "+v"(out[1]), "+v"(out[2]), "+v"(out[3]), "+v"(out[4]), "+v"(out[5]), "+v"(out[6]), "+v"(out[7]));
                out[8] += aa * P4_CVT(w.z, 0); out[9] += aa * P4_CVT(w.z, 1); out[10] += aa * P4_CVT(w.z, 2); out[11] += aa * P4_CVT(w.z, 3);
                out[12] += aa * P4_CVT(w.w, 0); out[13] += aa * P4_CVT(w.w, 1); out[14] += aa * P4_CVT(w.w, 2); out[15] += aa * P4_CVT(w.w, 3);
                asm volatile("" : "+v"(out[8]), "+v"(out[9]), "+v"(out[10]), "+v"(out[11]), "+v"(out[12]), "+v"(out[13]), "+v"(out[14]), "+v"(out[15]));
            }
        }
        const float* g2 = (const float*)(p.ws + WS_MOD) + (size_t)b * 6 * DM + 5 * DM;
        float* outp = p.out + (size_t)t * DM;
#pragma unroll
        for (int j = 0; j < 8; ++j) {
            const int c = j * 256 + lane * 4;
            const f32x4 x0 = *(const f32x4*)(outp + c), ga = *(const f32x4*)(g2 + c);
            *(f32x4*)(outp + c) = (f32x4){x0.x + ga.x * out[2 * j].x, x0.y + ga.y * out[2 * j].y, x0.z + ga.z * out[2 * j + 1].x, x0.w + ga.w * out[2 * j + 1].y};
        }
    }
#undef P4_ISSUE
#undef P4_WAIT
#undef P4_CVT
}
constexpr int RING_BYTES = 131072, LDSCTL_OFF = 146432, MISC_OFF = LDSCTL_OFF + 320, LDS_BYTES = 147456;
static_assert(SSD_SYNC + 64 <= LDSCTL_OFF, "SSD LDS map");
constexpr int NPH = 13;
#ifndef MK_PER_PHASE
#define MK_PER_PHASE 0
#endif

__global__ void __launch_bounds__(NTHR, 2) mega(Params p) {
    extern __shared__ __attribute__((aligned(16))) unsigned char lds[];
    LAS unsigned char* ldsl = (LAS unsigned char*)lds;
    const int tid = threadIdx.x, lane = tid & 63, wave = __builtin_amdgcn_readfirstlane(tid >> 6);
    const int G = gridDim.x, bid = blockIdx.x;
    unsigned char* ws = p.ws;
    gu32* ctl = (gu32*)(ws + WS_CTL);
    for (int u = tid; u < (LDS_BYTES - LDSCTL_OFF) / 4; u += NTHR) ((LAS unsigned*)(ldsl + LDSCTL_OFF))[u] = 0u;
    __syncthreads();
    volatile LAS unsigned* MISC = (volatile LAS unsigned*)(ldsl + MISC_OFF);
    XcdBarrier bar; bar.bar = (unsigned*)(ctl + CW_BAR); bar.x = 0; bar.st = nullptr;
    if (!MK_PER_PHASE) bar = xcd_barrier_post((unsigned*)(ctl + CW_BAR), MISC + 8);
#define IN(k) (p.ph_lo <= (k) && (k) < p.ph_hi)
#define LN() ({ int l_ = lane; asm volatile("" : "+v"(l_)); l_; })
#define WV() ({ int w_ = wave; asm volatile("" : "+s"(w_)); w_; })
#define SEAM(k) do { if ((k) + 1 < p.ph_hi) xcd_barrier(bar); } while (0)
    const int gtid = bid * NTHR + tid, gn = G * NTHR, gwave = bid * NWAVES + wave, gnw = G * NWAVES;
    float* mod = (float*)(ws + WS_MOD);

    if (IN(0)) {
        if (bid < 96) ph_mod(p, lds, tid, bid);
        else ph_transposes(p, lds, WV(), LN(), (bid - 96) * NWAVES + wave, (G - 96) * NWAVES);
        ph_rope_tab(p, gtid, gn);
        ph_convert(p.sub_keys, (bf16_t*)(ws + WS_SUBK), (size_t)8 * 2 * 128 * 128 / 4, gtid, gn);
        SEAM(0);
    }
    if (IN(1)) { ph_modrows(p.x, (bf16_t*)(ws + WS_H), mod, 0, 1, gwave, gnw, LN()); SEAM(1); }
    if (IN(2)) {
        pg8::Gemm g{(const bf16_t*)(ws + WS_H), (const bf16_t*)(ws + WS_WINT), T, NPROJ, DM, DM}; pg8::StaticOrder S; S.init(T, NPROJ, G, bid);
        pg8::EpiBf16<0> E{(bf16_t*)(ws + WS_PROJ), NPROJ, nullptr, 0, 0, 1.f};
        pg8::gemm_phase<pg8::EpiBf16<0>, pg8::StaticOrder, true, true>(ldsl, g, S, E);
        SEAM(2);
    }
    if (IN(3)) {
        { pg8::Gemm g{(const bf16_t*)(ws + WS_PROJ) + C_CQ, (const bf16_t*)(ws + WS_WUQT), T, NQ, 512, NPROJ}; pg8::StaticOrder S; S.init(T, NQ, G, bid);
          pg8::EpiBf16<0> E{(bf16_t*)(ws + WS_QRAW), NQ, nullptr, 0, 0, 1.f};
          pg8::gemm_phase<pg8::EpiBf16<0>, pg8::StaticOrder, true, true>(ldsl, g, S, E); }
        { pg8::Gemm g{(const bf16_t*)(ws + WS_PROJ) + C_CKV, (const bf16_t*)(ws + WS_WUKVT), T, NKV, 256, NPROJ}; pg8::StaticOrder S; S.init(T, NKV, G, bid);
          pg8::EpiBf16<0> E{(bf16_t*)(ws + WS_KVRAW), NKV, nullptr, 0, 0, 1.f};
          pg8::gemm_phase<pg8::EpiBf16<0>, pg8::StaticOrder, true, true>(ldsl, g, S, E); }
        SEAM(3);
    }
    if (IN(4)) { ph_qkv_post(p, gwave, gnw, LN()); ph_conv(p, gwave, gnw, LN()); SEAM(4); }
    if (IN(5)) { ph_attn(p, ldsl, bid, G, WV(), LN()); ph_ssd(p, ldsl, bid, WV(), LN()); SEAM(5); }
    if (IN(7)) { ph_mixnorm(p, gwave, gnw, LN()); SEAM(7); }
    if (IN(8)) {
        pg8::Gemm g{(const bf16_t*)(ws + WS_MIXIN), (const bf16_t*)(ws + WS_WOUTT), T, DM, DM, DM}; pg8::StaticOrder S; S.init(T, DM, G, bid);
        pg8::EpiResid E{p.x, p.out, mod + 2 * DM, DM, SEQ, 6 * DM};
        pg8::gemm_phase<pg8::EpiResid, pg8::StaticOrder, true, true>(ldsl, g, S, E);
        SEAM(8);
    }
    if (IN(9)) {
        ph_modrows(p.out, (bf16_t*)(ws + WS_H2), mod, 3, 4, gwave, gnw, LN());
        SEAM(9);
    }
    if (IN(10)) {
        pg8::Gemm g{(const bf16_t*)(ws + WS_H2), (const bf16_t*)(ws + WS_WQT), T, DM, DM, DM}; pg8::StaticOrder S; S.init(T, DM, G, bid);
        pg8::EpiBf16<0> E{(bf16_t*)(ws + WS_QP), DM, nullptr, 0, 0, 1.f};
        pg8::gemm_phase<pg8::EpiBf16<0>, pg8::StaticOrder, true, true>(ldsl, g, S, E);
        SEAM(10);
    }
    if (IN(11)) { ph_route(p, ldsl, WV(), LN(), gwave, gnw); SEAM(11); }
    if (IN(12)) { ph_peer4(p, ldsl, WV(), LN(), gwave, gnw); }
#undef IN
#undef SEAM
}

extern "C" void kernel_launch(void* const* d_in, const int* in_sizes, int n_in, void* d_out, int out_size, void* d_ws, size_t ws_size, hipStream_t stream) {
    static int grid = 0;
    if (grid == 0) {
        if (n_in != 24 || ws_size < WS_END) { fprintf(stderr, "kernel_launch: unexpected inputs / workspace (%d, %zu)\n", n_in, ws_size); grid = -1; return; }
        if (hipFuncSetAttribute((const void*)mega, hipFuncAttributeMaxDynamicSharedMemorySize, LDS_BYTES) != hipSuccess) { fprintf(stderr, "kernel_launch: hipFuncSetAttribute failed\n"); grid = -1; return; }
        (void)hipGetLastError();
        grid = 256;
    }
    if (grid < 0) return;
    (void)hipMemsetAsync((char*)d_ws + WS_CTL, 0, CTL_ZERO_BYTES, stream);
    Params p{};
    p.x = (const float*)d_in[0]; p.c = (const float*)d_in[1]; p.pos = (const int*)d_in[2]; p.w_ada = (const float*)d_in[3]; p.b_ada = (const float*)d_in[4];
    p.w_in = (const float*)d_in[5]; p.q_a_norm = (const float*)d_in[6]; p.w_uq = (const float*)d_in[7]; p.kv_a_norm = (const float*)d_in[8]; p.w_ukv = (const float*)d_in[9];
    p.q_norm = (const float*)d_in[10]; p.k_norm = (const float*)d_in[11]; p.attn_out_norm = (const float*)d_in[12]; p.conv_w = (const float*)d_in[13]; p.conv_b = (const float*)d_in[14];
    p.dt_bias = (const float*)d_in[15]; p.a_log = (const float*)d_in[16]; p.d_skip = (const float*)d_in[17]; p.ssd_norm = (const float*)d_in[18]; p.w_out = (const float*)d_in[19];
    p.w_query = (const float*)d_in[20]; p.sub_keys = (const float*)d_in[21]; p.u_exp = (const float*)d_in[22]; p.v_exp = (const float*)d_in[23];
    p.out = (float*)d_out; p.ws = (unsigned char*)d_ws;
#if MK_PER_PHASE
    for (int ph = 0; ph < NPH; ++ph) { p.ph_lo = ph; p.ph_hi = ph + 1; hipLaunchKernelGGL(mega, dim3(grid), dim3(NTHR), LDS_BYTES, stream, p); }
#elif defined(PROBE_SEQ)
    { const int seq[] = {PROBE_SEQ}; const int nl = (int)(sizeof(seq) / sizeof(int)) / 2;
      for (int li = 0; li < nl; ++li) { if (li) (void)hipMemsetAsync((char*)d_ws + WS_CTL, 0, CTL_ZERO_BYTES, stream);
          p.ph_lo = seq[2 * li]; p.ph_hi = seq[2 * li + 1]; hipLaunchKernelGGL(mega, dim3(grid), dim3(NTHR), LDS_BYTES, stream, p); } }
#else
    p.ph_lo = 0; p.ph_hi = NPH;
    hipLaunchKernelGGL(mega, dim3(grid), dim3(NTHR), LDS_BYTES, stream, p);
#endif
}
```

```cpp
#include <hip/hip_runtime.h>
#include <cstdint>
#include <cstdio>
#include <cmath>

constexpr int DM = 2048, NB = 8, SEQ = 2048, T = NB * SEQ;
constexpr int IN_COLS = 3408, NPROJ = 3584;
constexpr int C_CQ = 0, C_CKV = 512, C_KR = 768, C_Z = 832, C_XBC = 1856, C_DT = 3392;
constexpr int NQ = 1536, NKV = 2048;
constexpr float EPS = 1e-6f;
constexpr int NTHR = 512, NWAVES = 8;

typedef unsigned short bf16_t;
typedef unsigned u32x4 __attribute__((ext_vector_type(4)));
typedef float f32x4 __attribute__((ext_vector_type(4)));
typedef unsigned u32x2 __attribute__((ext_vector_type(2)));
#define GAS __attribute__((address_space(1)))
#define LAS __attribute__((address_space(3)))
typedef GAS unsigned gu32;
typedef GAS unsigned long long gu64;
#define RLX_AGENT __ATOMIC_RELAXED, __HIP_MEMORY_SCOPE_AGENT

__device__ __forceinline__ unsigned f2bf(float f) { unsigned u = __builtin_bit_cast(unsigned, f); return (u + 0x7fffu + ((u >> 16) & 1u)) >> 16; }
__device__ __forceinline__ float bf2f(unsigned h) { return __builtin_bit_cast(float, h << 16); }
__device__ __forceinline__ unsigned pk2(float lo, float hi) { return f2bf(lo) | (f2bf(hi) << 16); }
__device__ __forceinline__ float bflo(unsigned w) { return __builtin_bit_cast(float, w << 16); }
__device__ __forceinline__ float bfhi(unsigned w) { return __builtin_bit_cast(float, w & 0xffff0000u); }
__device__ __forceinline__ float silu_f(float v) { return v / (1.f + __expf(-v)); }
__device__ __forceinline__ float wave_sum(float v) {
#pragma unroll
    for (int o = 1; o < 64; o <<= 1) v += __shfl_xor(v, o);
    return v;
}

constexpr size_t MiB = 1u << 20;
constexpr size_t WS_CTL = 0, CTL_ZERO_BYTES = 64 * 1024, WS_MOD = 1 * MiB, WS_ROPEC = 2 * MiB, WS_ROPES = 4 * MiB, WS_SUBK = 6 * MiB, WS_WUQT = 7 * MiB, WS_WUKVT = 9 * MiB,
                 WS_WINT = 10 * MiB, WS_WOUTT = 24 * MiB, WS_WQT = 32 * MiB,
                 WS_US = 40 * MiB, WS_VS = 41 * MiB, WS_PSQX = 42 * MiB, WS_BIAS2 = 44 * MiB, WS_CS = 50 * MiB, WS_DT = 51 * MiB, WS_IDX = 52 * MiB, WS_GATE = 60 * MiB, WS_U16 = 68 * MiB, WS_V16 = 132 * MiB, WS_U8 = 68 * MiB, WS_V8 = 100 * MiB, WS_U4 = 420 * MiB, WS_V4 = 440 * MiB,
                 WS_K = 68 * MiB, WS_YSSD = 68 * MiB, WS_XBCA = 116 * MiB, WS_ATTN = 164 * MiB,
                 WS_H = 196 * MiB, WS_Q = 196 * MiB, WS_MIXIN = 196 * MiB, WS_H2 = 196 * MiB, WS_X1M = 68 * MiB,
                 WS_PROJ = 260 * MiB, WS_QP = 260 * MiB, WS_QRAW = 372 * MiB, WS_KVRAW = 420 * MiB, WS_V = 484 * MiB, WS_END = 516 * MiB;
constexpr int CW_BAR = 1024;

struct Params {
    const float *x, *c; const int* pos;
    const float *w_ada, *b_ada, *w_in, *q_a_norm, *w_uq, *kv_a_norm, *w_ukv, *q_norm, *k_norm, *attn_out_norm, *conv_w, *conv_b, *dt_bias, *a_log,
        *d_skip, *ssd_norm, *w_out, *w_query, *sub_keys, *u_exp, *v_exp;
    float* out; unsigned char* ws;
    int ph_lo, ph_hi;
};
namespace pg8 {
#define PG8_LAS __attribute__((address_space(3)))
typedef unsigned short bf16_t;
typedef short bf16x8 __attribute__((ext_vector_type(8)));
typedef float f32x4 __attribute__((ext_vector_type(4)));
typedef unsigned u32x4 __attribute__((ext_vector_type(4)));
constexpr int BM = 256, BK = 64, HALF = 128, HTB = HALF * BK * 2  , STAGE_BYTES = 8 * HTB, NXCD = 8, WGM = 8;

__host__ __device__ __forceinline__ int lds_byte(int r, int c) { const int st = (r >> 4) * 2 + (c >> 5), rr = r & 15, cc = c & 31, ob = rr * 64 + cc * 2; return st * 1024 + (ob ^ (((ob >> 9) & 1) << 5)); }
__host__ __device__ __forceinline__ void stage_rc(int b, int& R, int& C) { const int st = b / 1024, sb = b % 1024, swz = sb ^ (((sb >> 9) & 1) << 5); R = (st >> 1) * 16 + swz / 64; C = (st & 1) * 32 + (swz % 64) / 2; }
__host__ __device__ __forceinline__ int perm32(int rho) { const int n = rho >> 4, i = rho & 15; return 8 * (i >> 2) + 4 * n + (i & 3); }

struct Unit { int pm, pn; };
struct Gemm { const bf16_t* A; const bf16_t* Bt; int M, N, K, lda; };

struct StaticOrder {
    int nM, nN, nwg, G, c;
    __host__ __device__ void init(int M, int N, int G_, int c_) { nM = M / BM; nN = N / BM; nwg = nM * nN; G = G_; c = c_; }
    __host__ __device__ bool next(int i, Unit& u) const {
        const long L = (long)i * G + c; if (L >= nwg) return false;
        int wgid = (int)L; { const int q = nwg / NXCD, r = nwg % NXCD, xcd = wgid % NXCD, off = wgid / NXCD; wgid = (xcd < r ? xcd * (q + 1) : r * (q + 1) + (xcd - r) * q) + off; }
        const int nig = WGM * nN, gid = wgid / nig, fm = gid * WGM, gsz = (nM - fm) < WGM ? (nM - fm) : WGM;
        u.pm = fm + ((wgid % nig) % gsz); u.pn = (wgid % nig) / gsz; return true;
    }
    __device__ __forceinline__ void a_ready(const Unit&) const {}
    __device__ __forceinline__ void done(const Unit&) const {}
};

__device__ __forceinline__ unsigned cvt_pk_bf16(float lo, float hi) { unsigned r; asm volatile("v_cvt_pk_bf16_f32 %0, %1, %2" : "=v"(r) : "v"(lo), "v"(hi)); return r; }
typedef float f32x2 __attribute__((ext_vector_type(2)));
__device__ __forceinline__ f32x2 gelu_pk(f32x2 v) {
    const f32x2 av = __builtin_elementwise_abs(v), d = av * 0.2316418882f + 1.0f;
    f32x2 t; t.x = __builtin_amdgcn_rcpf(d.x); t.y = __builtin_amdgcn_rcpf(d.y);
    f32x2 q = t * 0.5307027145f + (-0.7265760135f); q = q * t + 0.7107068705f; q = q * t + (-0.142248368f); q = q * t + 0.127414796f; q = q * t;
    const f32x2 s = (v * v) * (-0.72134752044f);
    f32x2 e; e.x = __builtin_amdgcn_exp2f(s.x); e.y = __builtin_amdgcn_exp2f(s.y);
    const f32x2 m = v * (q * e), r = v - m;
    f32x2 o; o.x = v.x < 0.f ? m.x : r.x; o.y = v.y < 0.f ? m.y : r.y; return o;
}

template <int ACT  > struct EpiBf16 {
    static constexpr bool PERM = true, AFTER_DRAIN = false; static_assert(ACT == 0 || ACT == 1, "EpiBf16: ACT is 0 (none) or 1 (gelu_pk)");
    bf16_t* O; int ldc; const float* bias; int split_cols; size_t split_stride; float scale0;
    __device__ __forceinline__ void operator()(const f32x4 (&acc)[2][2][4][2], const Unit& u, int wr, int wc, int fr, int fq) const {
        const int row0 = u.pm * BM + wr * 64 + fr; int colt = u.pn * BM; bf16_t* base = O;
        float sc = 1.f; if (split_cols) { const int t = colt / split_cols; base += (size_t)t * split_stride; colt -= t * split_cols; if (t == 0) sc = scale0; }
        const int col0 = colt + wc * 32 + 8 * fq, bcol0 = u.pn * BM + wc * 32 + 8 * fq;
        f32x4 bv[2][2];
#pragma unroll
        for (int bj = 0; bj < 2; ++bj)
#pragma unroll
            for (int n = 0; n < 2; ++n) bv[bj][n] = bias ? *(const f32x4*)(bias + bcol0 + bj * HALF + 4 * n) : (f32x4){0.f, 0.f, 0.f, 0.f};
#pragma unroll
        for (int ai = 0; ai < 2; ++ai)
#pragma unroll
            for (int m = 0; m < 4; ++m) { bf16_t* rowp = base + (size_t)(row0 + ai * HALF + m * 16) * ldc + col0;
#pragma unroll
                for (int bj = 0; bj < 2; ++bj) { f32x4 v0 = acc[ai][bj][m][0] + bv[bj][0], v1 = acc[ai][bj][m][1] + bv[bj][1];
                    if (ACT == 1) { f32x2 a = gelu_pk((f32x2){v0[0], v0[1]}), b = gelu_pk((f32x2){v0[2], v0[3]}), c = gelu_pk((f32x2){v1[0], v1[1]}), d = gelu_pk((f32x2){v1[2], v1[3]});
                        v0 = (f32x4){a.x, a.y, b.x, b.y}; v1 = (f32x4){c.x, c.y, d.x, d.y}; }
                    v0 = v0 * sc; v1 = v1 * sc; u32x4 w; w.x = cvt_pk_bf16(v0[0], v0[1]); w.y = cvt_pk_bf16(v0[2], v0[3]); w.z = cvt_pk_bf16(v1[0], v1[1]); w.w = cvt_pk_bf16(v1[2], v1[3]);
                    *(u32x4*)(rowp + bj * HALF) = w; } }
    }
};
struct EpiResid {
    static constexpr bool PERM = false, AFTER_DRAIN = false;
    const float* resid; float* out; const float* gate; int ldc, rows_per_batch, gate_stride;
    __device__ __forceinline__ void operator()(const f32x4 (&acc)[2][2][4][2], const Unit& u, int wr, int wc, int fr, int fq) const {
        const int col0 = u.pn * BM + wc * 32 + 4 * fq;
        const int b = (u.pm * BM) / rows_per_batch;
        f32x4 gv[2][2];
#pragma unroll
        for (int bj = 0; bj < 2; ++bj)
#pragma unroll
            for (int n = 0; n < 2; ++n) gv[bj][n] = *(const f32x4*)(gate + (size_t)b * gate_stride + col0 + bj * HALF + n * 16);
#pragma unroll
        for (int ai = 0; ai < 2; ++ai)
#pragma unroll
            for (int m = 0; m < 4; ++m) {
                const size_t off = (size_t)(u.pm * BM + ai * HALF + wr * 64 + m * 16 + fr) * ldc + col0;
#pragma unroll
                for (int bj = 0; bj < 2; ++bj)
#pragma unroll
                    for (int n = 0; n < 2; ++n) {
                        const f32x4 bs = *(const f32x4*)(resid + off + bj * HALF + n * 16);
                        *(f32x4*)(out + off + bj * HALF + n * 16) = bs + gv[bj][n] * acc[ai][bj][m][n];
                    }
                if (m & 1) asm volatile("" ::: "memory");
            }
    }
};

struct EpiX1 {
    static constexpr bool PERM = true, AFTER_DRAIN = false;
    const float* resid; const float* mod; bf16_t* xm; float* psq; int ldc, rows_per_batch;
    __device__ __forceinline__ void operator()(const f32x4 (&acc)[2][2][4][2], const Unit& u, int wr, int wc, int fr, int fq) const {
        const int b = (u.pm * BM) / rows_per_batch;
        const float* g1 = mod + (size_t)b * 6 * ldc + 2 * ldc; const float* s2 = mod + (size_t)b * 6 * ldc + 4 * ldc;
        const int col0 = u.pn * BM + wc * 32 + 8 * fq;
        f32x4 gv[2][2], sv[2][2];
#pragma unroll
        for (int bj = 0; bj < 2; ++bj)
#pragma unroll
            for (int n = 0; n < 2; ++n) { gv[bj][n] = *(const f32x4*)(g1 + col0 + bj * HALF + 4 * n); sv[bj][n] = *(const f32x4*)(s2 + col0 + bj * HALF + 4 * n) + 1.0f; }
#pragma unroll
        for (int ai = 0; ai < 2; ++ai)
#pragma unroll
            for (int m = 0; m < 4; ++m) {
                const int row = u.pm * BM + ai * HALF + wr * 64 + m * 16 + fr; const size_t off = (size_t)row * ldc + col0;
                float ss = 0.f;
#pragma unroll
                for (int bj = 0; bj < 2; ++bj) {
                    const f32x4 r0 = *(const f32x4*)(resid + off + bj * HALF), r1 = *(const f32x4*)(resid + off + bj * HALF + 4);
                    const f32x4 x0 = r0 + gv[bj][0] * acc[ai][bj][m][0], x1 = r1 + gv[bj][1] * acc[ai][bj][m][1];
                    ss += (x0[0] * x0[0] + x0[1] * x0[1]) + (x0[2] * x0[2] + x0[3] * x0[3]) + (x1[0] * x1[0] + x1[1] * x1[1]) + (x1[2] * x1[2] + x1[3] * x1[3]);
                    const f32x4 y0 = x0 * sv[bj][0], y1 = x1 * sv[bj][1];
                    u32x4 w; w.x = cvt_pk_bf16(y0[0], y0[1]); w.y = cvt_pk_bf16(y0[2], y0[3]); w.z = cvt_pk_bf16(y1[0], y1[1]); w.w = cvt_pk_bf16(y1[2], y1[3]);
                    *(u32x4*)(xm + off + bj * HALF) = w;
                }
                ss += __shfl_xor(ss, 16); ss += __shfl_xor(ss, 32);
                if (fq == 0) psq[(size_t)row * 32 + u.pn * 4 + wc] = ss;
                if (m & 1) asm volatile("" ::: "memory");
            }
    }
};
struct EpiScaleBias {
    static constexpr bool PERM = true, AFTER_DRAIN = false;
    bf16_t* O; int ldc; const float* bias; int rows_per_batch; const PG8_LAS float* rt; int pm0;
    __device__ __forceinline__ void operator()(const f32x4 (&acc)[2][2][4][2], const Unit& u, int wr, int wc, int fr, int fq) const {
        const int b = (u.pm * BM) / rows_per_batch; const float* bp = bias + (size_t)b * ldc;
        const int col0 = u.pn * BM + wc * 32 + 8 * fq;
        const PG8_LAS float* rtu = rt + ((u.pm == pm0) ? 0 : 256);
        f32x4 bv[2][2];
#pragma unroll
        for (int bj = 0; bj < 2; ++bj)
#pragma unroll
            for (int n = 0; n < 2; ++n) bv[bj][n] = *(const f32x4*)(bp + col0 + bj * HALF + 4 * n);
#pragma unroll
        for (int ai = 0; ai < 2; ++ai)
#pragma unroll
            for (int m = 0; m < 4; ++m) {
                const int lr = ai * HALF + wr * 64 + m * 16 + fr; const float rs = rtu[lr];
                bf16_t* rowp = O + (size_t)(u.pm * BM + lr) * ldc + col0;
#pragma unroll
                for (int bj = 0; bj < 2; ++bj) {
                    const f32x4 v0 = acc[ai][bj][m][0] * rs + bv[bj][0], v1 = acc[ai][bj][m][1] * rs + bv[bj][1];
                    u32x4 w; w.x = cvt_pk_bf16(v0[0], v0[1]); w.y = cvt_pk_bf16(v0[2], v0[3]); w.z = cvt_pk_bf16(v1[0], v1[1]); w.w = cvt_pk_bf16(v1[2], v1[3]);
                    *(u32x4*)(rowp + bj * HALF) = w;
                }
            }
    }
};
template <class Epi, class Sched, bool ALIGN_EPI = false, bool SP2 = false>
__device__ __forceinline__ void gemm_phase(PG8_LAS unsigned char* lds, const Gemm g, const Sched& S, const Epi& E) {
    const int tid = threadIdx.x, wid = __builtin_amdgcn_readfirstlane(tid >> 6), lane = tid & 63, wr = wid >> 2, wc = wid & 3, fr = lane & 15, fq = lane >> 4;
    const int K = g.K, nt = K / BK;
    unsigned voffA[2], voffB[2];
#pragma unroll
    for (int i = 0; i < 2; ++i) { int R, C; stage_rc(tid * 16 + i * 8192, R, C); const int Rb = Epi::PERM ? ((R & ~31) + perm32(R & 31)) : R;
        voffA[i] = (unsigned)(R * g.lda + C) * 2u; voffB[i] = (unsigned)(Rb * K + C) * 2u; }
    const size_t kstep = (size_t)(BK * 2);
    const size_t hstep = (size_t)HALF * K * 2;
    const size_t tstep = 2 * hstep; const size_t hstepA = (size_t)HALF * g.lda * 2, tstepA = 2 * hstepA;
    const unsigned ldsw = (unsigned)wid * 1024u;
    const int aoff = lds_byte(wr * 64 + fr, fq * 8), boff = lds_byte(wc * 32 + fr, fq * 8);
#define PG8_SA(b, h) (((b) * 2 + (h)) * HTB)
#define PG8_SB(b, h) ((4 + (b) * 2 + (h)) * HTB)
#define PG8_STAGE(bufoff, gbase, voff) do { _Pragma("unroll") for (int _i = 0; _i < 2; ++_i) \
        __builtin_amdgcn_global_load_lds((const unsigned*)((const char*)(gbase) + (voff)[_i]), (PG8_LAS unsigned*)(lds + (bufoff) + ldsw + _i * 8192), 16, 0, 0); } while (0)
#define PG8_LDA(dst, b, h) do { _Pragma("unroll") for (int m = 0; m < 4; ++m) _Pragma("unroll") for (int k = 0; k < 2; ++k) dst[m][k] = *(const PG8_LAS bf16x8*)(lds + PG8_SA(b, h) + aoff + m * 2048 + k * 1024); } while (0)
#define PG8_LDB(dst, b, h) do { _Pragma("unroll") for (int n = 0; n < 2; ++n) _Pragma("unroll") for (int k = 0; k < 2; ++k) dst[n][k] = *(const PG8_LAS bf16x8*)(lds + PG8_SB(b, h) + boff + n * 2048 + k * 1024); } while (0)
#define PG8_MMA(ai, bj, At, Bt) do { __builtin_amdgcn_s_setprio(1); _Pragma("unroll") for (int m = 0; m < 4; ++m) _Pragma("unroll") for (int n = 0; n < 2; ++n) _Pragma("unroll") for (int k = 0; k < 2; ++k) \
        acc[ai][bj][m][n] = __builtin_amdgcn_mfma_f32_16x16x32_bf16(Bt[n][k], At[m][k], acc[ai][bj][m][n], 0, 0, 0); __builtin_amdgcn_s_setprio(0); } while (0)
#define PG8_WAIT_V(n) asm volatile("s_waitcnt vmcnt(" #n ")" ::: "memory")
#define PG8_WAIT_L(n) asm volatile("s_waitcnt lgkmcnt(" #n ")" ::: "memory")
#define PG8_BAR __builtin_amdgcn_s_barrier()
#define PG8_SCHED __builtin_amdgcn_sched_barrier(0)
    Unit cur, nxt; int ui = 0;
    if (!S.next(0, cur)) return;
    f32x4 acc[2][2][4][2];
#pragma unroll
    for (int a = 0; a < 2; ++a)
#pragma unroll
        for (int b = 0; b < 2; ++b)
#pragma unroll
            for (int m = 0; m < 4; ++m)
#pragma unroll
                for (int n = 0; n < 2; ++n) acc[a][b][m][n] = (f32x4){0.f, 0.f, 0.f, 0.f};
    bf16x8 At[4][2], B0[2][2], B1[2][2];
    const char* cA = (const char*)g.A + (size_t)cur.pm * tstepA; const char* cB = (const char*)g.Bt + (size_t)cur.pn * tstep;
    S.a_ready(cur);
    if constexpr (SP2) {
        PG8_STAGE(PG8_SB(0, 0), cB, voffB); PG8_STAGE(PG8_SB(0, 1), cB + hstep, voffB); PG8_STAGE(PG8_SA(0, 0), cA, voffA); PG8_STAGE(PG8_SA(0, 1), cA + hstepA, voffA);
        if (wr == 1) PG8_BAR;
        PG8_WAIT_V(2); PG8_BAR;
        PG8_STAGE(PG8_SB(1, 0), cB + kstep, voffB); PG8_STAGE(PG8_SA(1, 0), cA + kstep, voffA); PG8_STAGE(PG8_SB(1, 1), cB + hstep + kstep, voffB);
        PG8_WAIT_V(6); PG8_BAR;
    } else {
        PG8_STAGE(PG8_SB(0, 0), cB, voffB); PG8_STAGE(PG8_SA(0, 0), cA, voffA); PG8_STAGE(PG8_SB(0, 1), cB + hstep, voffB); PG8_STAGE(PG8_SA(0, 1), cA + hstepA, voffA);
        if (wr == 1) PG8_BAR;
        PG8_WAIT_V(4); PG8_BAR;
        PG8_STAGE(PG8_SB(1, 0), cB + kstep, voffB); PG8_STAGE(PG8_SA(1, 0), cA + kstep, voffA); PG8_STAGE(PG8_SB(1, 1), cB + hstep + kstep, voffB);
        PG8_WAIT_V(6); PG8_BAR;
    }
    for (;;) {
        const bool has_next = S.next(ui + 1, nxt);
        const char* nA = has_next ? (const char*)g.A + (size_t)nxt.pm * tstepA : cA; const char* nB = has_next ? (const char*)g.Bt + (size_t)nxt.pn * tstep : cB;
        for (int t = 0; t < nt; t += 2) {
            const bool last = (t == nt - 2);
            const char* a1 = cA + (size_t)(t + 1) * kstep;
            const char* a2 = last ? nA : cA + (size_t)(t + 2) * kstep; const char* b2 = last ? nB : cB + (size_t)(t + 2) * kstep;
            const char* a3 = a2 + kstep; const char* b3 = b2 + kstep;
            if (last && has_next) S.a_ready(nxt);
            if constexpr (SP2) {
            PG8_LDB(B0, 0, 0); PG8_LDB(B1, 0, 1); PG8_SCHED; PG8_LDA(At, 0, 0); PG8_STAGE(PG8_SA(1, 1), a1 + hstepA, voffA);
            PG8_WAIT_V(8); PG8_WAIT_L(0); PG8_BAR; PG8_MMA(0, 0, At, B0); PG8_MMA(0, 1, At, B1); PG8_BAR; PG8_SCHED;
            PG8_LDA(At, 0, 1); PG8_STAGE(PG8_SB(0, 0), b2, voffB); PG8_STAGE(PG8_SB(0, 1), b2 + hstep, voffB); PG8_STAGE(PG8_SA(0, 0), a2, voffA);
            PG8_WAIT_V(8); PG8_WAIT_L(0); PG8_BAR; PG8_MMA(1, 0, At, B0); PG8_MMA(1, 1, At, B1); PG8_BAR; PG8_SCHED;
            PG8_LDB(B0, 1, 0); PG8_LDB(B1, 1, 1); PG8_SCHED; PG8_LDA(At, 1, 0); PG8_STAGE(PG8_SA(0, 1), a2 + hstepA, voffA);
            PG8_WAIT_V(8); PG8_WAIT_L(0); PG8_BAR; PG8_MMA(0, 0, At, B0); PG8_MMA(0, 1, At, B1); PG8_BAR; PG8_SCHED;
            PG8_LDA(At, 1, 1); PG8_STAGE(PG8_SB(1, 0), b3, voffB); PG8_STAGE(PG8_SB(1, 1), b3 + hstep, voffB); PG8_STAGE(PG8_SA(1, 0), a3, voffA);
            PG8_WAIT_V(8); PG8_WAIT_L(0); PG8_BAR; PG8_MMA(1, 0, At, B0); PG8_MMA(1, 1, At, B1); PG8_BAR; PG8_SCHED;
            } else {
            PG8_LDB(B0, 0, 0); PG8_SCHED; PG8_LDA(At, 0, 0); PG8_STAGE(PG8_SA(1, 1), a1 + hstepA, voffA);
            PG8_WAIT_L(8); PG8_BAR; PG8_WAIT_L(0); PG8_MMA(0, 0, At, B0); PG8_BAR; PG8_SCHED;
            PG8_LDB(B1, 0, 1); PG8_STAGE(PG8_SB(0, 0), b2, voffB);
            PG8_BAR; PG8_WAIT_L(0); PG8_MMA(0, 1, At, B1); PG8_BAR;
            PG8_LDA(At, 0, 1); PG8_STAGE(PG8_SA(0, 0), a2, voffA);
            PG8_BAR; PG8_WAIT_L(0); PG8_MMA(1, 0, At, B0); PG8_BAR; PG8_SCHED;
            PG8_STAGE(PG8_SB(0, 1), b2 + hstep, voffB);
            PG8_WAIT_V(6); PG8_BAR; PG8_MMA(1, 1, At, B1); PG8_BAR;
            PG8_LDB(B0, 1, 0); PG8_SCHED; PG8_LDA(At, 1, 0); PG8_STAGE(PG8_SA(0, 1), a2 + hstepA, voffA);
            PG8_WAIT_L(8); PG8_BAR; PG8_WAIT_L(0); PG8_MMA(0, 0, At, B0); PG8_BAR; PG8_SCHED;
            PG8_LDB(B1, 1, 1); PG8_STAGE(PG8_SB(1, 0), b3, voffB);
            PG8_BAR; PG8_WAIT_L(0); PG8_MMA(0, 1, At, B1); PG8_BAR;
            PG8_LDA(At, 1, 1); PG8_STAGE(PG8_SA(1, 0), a3, voffA);
            PG8_BAR; PG8_WAIT_L(0); PG8_MMA(1, 0, At, B0); PG8_BAR; PG8_SCHED;
            PG8_STAGE(PG8_SB(1, 1), b3 + hstep, voffB);
            PG8_WAIT_V(6); PG8_BAR; PG8_MMA(1, 1, At, B1); PG8_BAR;
            }
        }
        if constexpr (ALIGN_EPI) { if (wr == 0) PG8_BAR; }
        if constexpr (!Epi::AFTER_DRAIN) { E(acc, cur, wr, wc, fr, fq); S.done(cur); }
        if (!has_next) break;
#pragma unroll
        for (int a = 0; a < 2; ++a)
#pragma unroll
            for (int b = 0; b < 2; ++b)
#pragma unroll
                for (int m = 0; m < 4; ++m)
#pragma unroll
                    for (int n = 0; n < 2; ++n) acc[a][b][m][n] = (f32x4){0.f, 0.f, 0.f, 0.f};
        cur = nxt; cA = nA; cB = nB; ++ui;
        if constexpr (ALIGN_EPI) { if (wr == 1) PG8_BAR; }
    }
    PG8_WAIT_V(0);
    if constexpr (!ALIGN_EPI) { if (wr == 0) PG8_BAR; }
    PG8_BAR;
    if constexpr (Epi::AFTER_DRAIN) { E.fused(acc, cur, wr, wc, fr, fq, lds, wid, lane); S.done(cur); }
#undef PG8_SA
#undef PG8_SB
#undef PG8_STAGE
#undef PG8_LDA
#undef PG8_LDB
#undef PG8_MMA
#undef PG8_WAIT_V
#undef PG8_WAIT_L
#undef PG8_BAR
#undef PG8_SCHED
}
}
#define LDS_WAIT() asm volatile("s_waitcnt lgkmcnt(0)" ::: "memory")
#define XB_TMO      128
#define XB_XCNT(j)  (256  + 64 * (j))
#define XB_XSUB(j)  (1280 + 64 * (j))
#define XB_XGEN(j)  (2304 + 64 * (j))
#define XB_TOP      3328
#define XB_TOPGEN   3392
#define XCD_BAR_WORDS 3456
#define XB_SPIN_CAP (1u << 18)

__device__ __forceinline__ unsigned xb_ld(unsigned* p)              { return __hip_atomic_load(p, __ATOMIC_RELAXED, __HIP_MEMORY_SCOPE_AGENT); }
__device__ __forceinline__ unsigned xb_add(unsigned* p, unsigned v) { return __hip_atomic_fetch_add(p, v, __ATOMIC_RELAXED, __HIP_MEMORY_SCOPE_AGENT); }
__device__ __forceinline__ unsigned xb_xcc_id() { return (unsigned)__builtin_amdgcn_s_getreg((3 << 11) | 20) & 0xFu; }
#define XB_SPIN(cond, bar) do { unsigned _sp = 0; while (cond) { __builtin_amdgcn_s_sleep(1); \
    if ((++_sp & 255u) == 0u) { if (xb_ld(&(bar)[XB_TMO])) break; if (_sp > XB_SPIN_CAP) { atomicAdd(&(bar)[XB_TMO], 1u); break; } } } } while (0)

struct XcdBarrier {
    unsigned* bar; unsigned x;
    volatile LAS unsigned* st;
};

__device__ __forceinline__ XcdBarrier xcd_barrier_post(unsigned* bar, volatile LAS unsigned* st) {
    XcdBarrier b; b.bar = bar; b.x = xb_xcc_id(); b.st = st;
    if (threadIdx.x == 0) (void)xb_add(&bar[XB_XCNT(b.x)], 1u);
    return b;
}
__device__ __forceinline__ void xcd_barrier_complete(unsigned* bar, unsigned x, unsigned& nloc, unsigned& nx) {
    const unsigned G = gridDim.x * gridDim.y * gridDim.z;
    unsigned sum, cnt, mine, sp = 0u;
    for (;;) {
        sum = 0u; cnt = 0u; mine = 0u;
#pragma unroll
        for (unsigned j = 0; j < 16; ++j) { const unsigned c = xb_ld(&bar[XB_XCNT(j)]); sum += c; cnt += (c > 0u) ? 1u : 0u; mine = (j == x) ? c : mine; }
        if (sum == G) break;
        __builtin_amdgcn_s_sleep(1);
        if ((++sp & 255u) == 0u) { if (xb_ld(&bar[XB_TMO])) break; if (sp > XB_SPIN_CAP) { atomicAdd(&bar[XB_TMO], 1u); break; } }
    }
    nloc = mine > 0u ? mine : 1u; nx = cnt > 0u ? cnt : 1u;
}

__device__ __forceinline__ void xcd_barrier(const XcdBarrier& b) {
    asm volatile("s_waitcnt vmcnt(0)" ::: "memory");
    __syncthreads();
    if (threadIdx.x == 0) {
        unsigned* bar = b.bar;
        __builtin_amdgcn_s_waitcnt(0);
        unsigned nloc = b.st[0], nx = b.st[1];
        if (nloc == 0u) { xcd_barrier_complete(bar, b.x, nloc, nx); b.st[0] = nloc; b.st[1] = nx; }
        const unsigned old = xb_add(&bar[XB_XSUB(b.x)], 1u);
        const unsigned gen = old / nloc;
        if (old + 1u == (gen + 1u) * nloc) {
            __builtin_amdgcn_fence(__ATOMIC_RELEASE, "agent");
            asm volatile("s_waitcnt vmcnt(0)" ::: "memory");
            const unsigned og = xb_add(&bar[XB_TOP], 1u);
            const unsigned tg = og / nx;
            if (og + 1u == (tg + 1u) * nx) xb_add(&bar[XB_TOPGEN], 1u);
            else XB_SPIN(xb_ld(&bar[XB_TOPGEN]) == tg, bar);
            __builtin_amdgcn_fence(__ATOMIC_ACQUIRE, "agent");
            xb_add(&bar[XB_XGEN(b.x)], 1u);
            asm volatile("s_waitcnt vmcnt(0)" ::: "memory");
        } else {
            XB_SPIN(xb_ld(&bar[XB_XGEN(b.x)]) == gen, bar);
            __builtin_amdgcn_fence(__ATOMIC_ACQUIRE, "agent");
            asm volatile("s_waitcnt vmcnt(0)" ::: "memory");
        }
    }
    __syncthreads();
}
#define SYNC() __syncthreads()
__device__ __forceinline__ float silu_fast(float v) { return v * __builtin_amdgcn_rcpf(1.f + __expf(-v)); }
__device__ __forceinline__ float sq2(unsigned w) { const float a = bflo(w), b = bfhi(w); return a * a + b * b; }

__device__ __forceinline__ void ph_mod(const Params& p, unsigned char* lds, int tid, int vb) {
    float* cact = (float*)lds; float* red = (float*)(lds + 65536);
    const int lane = tid & 63, wv = tid >> 6, c4 = lane & 31, kh = lane >> 5;
    for (int i = tid; i < NB * DM; i += NTHR) { const int b = i / DM, k = i % DM; cact[k * NB + b] = silu_f(p.c[i]); }
    SYNC();
    const int n = vb * 128 + 4 * c4;
    f32x4 acc[NB];
#pragma unroll
    for (int b = 0; b < NB; ++b) acc[b] = (f32x4){0.f, 0.f, 0.f, 0.f};
    const float* w = p.w_ada + (size_t)(wv * 256 + kh) * (6 * DM) + n;
#pragma unroll 8
    for (int i = 0; i < 128; ++i) {
        const f32x4 wk = *(const f32x4*)(w + (size_t)(2 * i) * (6 * DM));
        const f32x4 ca = *(const f32x4*)(cact + (wv * 256 + 2 * i + kh) * NB), cb = *(const f32x4*)(cact + (wv * 256 + 2 * i + kh) * NB + 4);
        acc[0] += wk * ca.x; acc[1] += wk * ca.y; acc[2] += wk * ca.z; acc[3] += wk * ca.w; acc[4] += wk * cb.x; acc[5] += wk * cb.y; acc[6] += wk * cb.z; acc[7] += wk * cb.w;
    }
#pragma unroll
    for (int b = 0; b < NB; ++b) { acc[b].x += __shfl_xor(acc[b].x, 32); acc[b].y += __shfl_xor(acc[b].y, 32); acc[b].z += __shfl_xor(acc[b].z, 32); acc[b].w += __shfl_xor(acc[b].w, 32); }
    if (lane < 32) {
#pragma unroll
        for (int b = 0; b < NB; ++b) *(f32x4*)(red + (wv * NB + b) * 128 + 4 * c4) = acc[b];
    }
    SYNC();
    for (int o = tid; o < NB * 128; o += NTHR) {
        const int b = o >> 7, col = o & 127;
        float s = p.b_ada[vb * 128 + col];
#pragma unroll
        for (int w8 = 0; w8 < 8; ++w8) s += red[(w8 * NB + b) * 128 + col];
        ((float*)(p.ws + WS_MOD))[b * 6 * DM + vb * 128 + col] = s;
    }
    SYNC();
}
__device__ __forceinline__ void ph_rope_tab(const Params& p, int gtid, int gn) {
    for (int i = gtid; i < T * 32; i += gn) {
        const int t = i >> 5, f = i & 31;
        const float inv = 1.0f / powf(10000.0f, (float)f * (2.0f / 64.0f));
        const float ang = (float)p.pos[t] * inv;
        ((float*)(p.ws + WS_ROPEC))[i] = (float)cos((double)ang);
        ((float*)(p.ws + WS_ROPES))[i] = (float)sin((double)ang);
    }
}
__device__ __forceinline__ void tr_item(const float* W, int K, int N, int Npad, bf16_t* WT, const float* g0, const float* g1, int gs, float* scr, int item, int lane) {
    const int nblk = Npad / 128, kb = item / nblk, nb = item % nblk, k0 = 32 * kb, n0 = 128 * nb;
    const int c4 = lane & 31, kh = lane >> 5, n = n0 + 4 * c4; const bool ok = n < N;
#pragma unroll 8
    for (int i = 0; i < 16; ++i) {
        const int kk = 2 * i + kh, k = k0 + kk;
        f32x4 v = ok ? *(const f32x4*)(W + (size_t)k * N + n) : (f32x4){0.f, 0.f, 0.f, 0.f};
        if (g0) v = v * ((k < gs) ? g0[k] : g1[k - gs]);
        *(f32x4*)(scr + kk * 132 + 4 * c4) = v;
    }
    asm volatile("s_waitcnt lgkmcnt(0)" ::: "memory");
#pragma unroll
    for (int j = 0; j < 8; ++j) {
        const int idx = lane + 64 * j, nn = idx >> 2, ck = idx & 3; const float* sp = scr + (8 * ck) * 132 + nn;
        u32x4 o; o.x = pk2(sp[0 * 132], sp[1 * 132]); o.y = pk2(sp[2 * 132], sp[3 * 132]); o.z = pk2(sp[4 * 132], sp[5 * 132]); o.w = pk2(sp[6 * 132], sp[7 * 132]);
        *(u32x4*)(WT + (size_t)(n0 + nn) * K + k0 + 8 * ck) = o;
    }
    asm volatile("s_waitcnt lgkmcnt(0)" ::: "memory");
}
constexpr int TR_N0 = (DM / 32) * (NPROJ / 128), TR_N1 = (512 / 32) * (NQ / 128), TR_N2 = (256 / 32) * (NKV / 128), TR_N3 = (DM / 32) * (DM / 128), TR_N4 = TR_N3;
constexpr int TR_TOTAL = TR_N0 + TR_N1 + TR_N2 + TR_N3 + TR_N4;
__device__ __forceinline__ void ph_transposes(const Params& p, unsigned char* lds, int wave, int lane, int first, int stride) {
    float* scr = (float*)(lds + wave * 17408);
    for (int it = first; it < TR_TOTAL; it += stride) {
        int r = it;
        if (r < TR_N0) { tr_item(p.w_in, DM, IN_COLS, NPROJ, (bf16_t*)(p.ws + WS_WINT), nullptr, nullptr, 0, scr, r, lane); continue; } r -= TR_N0;
        if (r < TR_N1) { tr_item(p.w_uq, 512, NQ, NQ, (bf16_t*)(p.ws + WS_WUQT), p.q_a_norm, p.q_a_norm, 512, scr, r, lane); continue; } r -= TR_N1;
        if (r < TR_N2) { tr_item(p.w_ukv, 256, NKV, NKV, (bf16_t*)(p.ws + WS_WUKVT), p.kv_a_norm, p.kv_a_norm, 256, scr, r, lane); continue; } r -= TR_N2;
        if (r < TR_N3) { tr_item(p.w_out, DM, DM, DM, (bf16_t*)(p.ws + WS_WOUTT), p.attn_out_norm, p.ssd_norm, 1024, scr, r, lane); continue; } r -= TR_N3;
        tr_item(p.w_query, DM, DM, DM, (bf16_t*)(p.ws + WS_WQT), nullptr, nullptr, 0, scr, r, lane);
    }
}
__device__ __forceinline__ void ph_convert(const float* src, bf16_t* dst, size_t n4, int gtid, int gn) {
    for (size_t i = gtid; i < n4; i += (size_t)gn) {
        const f32x4 v = ((const f32x4*)src)[i];
        uint2 o; o.x = pk2(v.x, v.y); o.y = pk2(v.z, v.w);
        ((uint2*)dst)[i] = o;
    }
}
__device__ __forceinline__ void ph_modrows(const float* in, bf16_t* outp, const float* mod, int sh_idx, int sc_idx, int gwave, int gnw, int lane) {
    for (int row = gwave; row < T; row += gnw) {
        const int b = row / SEQ;
        const f32x4* xr = (const f32x4*)(in + (size_t)row * DM) + lane;
        f32x4 v[8]; float s = 0.f;
#pragma unroll
        for (int j = 0; j < 8; ++j) { v[j] = xr[64 * j]; s += (v[j].x * v[j].x + v[j].y * v[j].y) + (v[j].z * v[j].z + v[j].w * v[j].w); }
        const float r = rsqrtf(wave_sum(s) * (1.f / DM) + EPS);
        const f32x4* sh = (const f32x4*)(mod + (size_t)b * 6 * DM + sh_idx * DM) + lane;
        const f32x4* sc = (const f32x4*)(mod + (size_t)b * 6 * DM + sc_idx * DM) + lane;
        uint2* o = (uint2*)(outp + (size_t)row * DM) + lane;
#pragma unroll
        for (int j = 0; j < 8; ++j) {
            const f32x4 a = sh[64 * j], m = sc[64 * j];
            uint2 w; w.x = pk2(v[j].x * r * (1.f + m.x) + a.x, v[j].y * r * (1.f + m.y) + a.y); w.y = pk2(v[j].z * r * (1.f + m.z) + a.z, v[j].w * r * (1.f + m.w) + a.w);
            o[64 * j] = w;
        }
    }
}
__device__ __forceinline__ void ph_bias2(const Params& p, int gwave, int gnw, int lane) {
    const float* mod = (const float*)(p.ws + WS_MOD);
    for (int n = gwave; n < DM; n += gnw) {
        const bf16_t* wr_ = (const bf16_t*)(p.ws + WS_WQT) + (size_t)n * DM + lane * 8;
        float wv[4][8];
#pragma unroll
        for (int j = 0; j < 4; ++j) { const u32x4 w = *(const u32x4*)(wr_ + j * 512);
            wv[j][0] = bflo(w.x); wv[j][1] = bfhi(w.x); wv[j][2] = bflo(w.y); wv[j][3] = bfhi(w.y); wv[j][4] = bflo(w.z); wv[j][5] = bfhi(w.z); wv[j][6] = bflo(w.w); wv[j][7] = bfhi(w.w); }
#pragma unroll
        for (int b = 0; b < NB; ++b) {
            const float* sh = mod + (size_t)b * 6 * DM + 3 * DM + lane * 8; float a = 0.f;
#pragma unroll
            for (int j = 0; j < 4; ++j) { const f32x4 s0 = *(const f32x4*)(sh + j * 512), s1 = *(const f32x4*)(sh + j * 512 + 4);
                a += (wv[j][0] * s0[0] + wv[j][1] * s0[1]) + (wv[j][2] * s0[2] + wv[j][3] * s0[3]) + (wv[j][4] * s1[0] + wv[j][5] * s1[1]) + (wv[j][6] * s1[2] + wv[j][7] * s1[3]); }
            a = wave_sum(a);
            if (lane == 0) ((float*)(p.ws + WS_BIAS2))[b * DM + n] = a;
        }
    }
}
constexpr float QSCALE = 0.07216878364870322f * 1.4426950408889634f;
__device__ __forceinline__ float ssq8(u32x4 w) { return (sq2(w.x) + sq2(w.y)) + (sq2(w.z) + sq2(w.w)); }
__device__ __forceinline__ u32x4 scale8(u32x4 w, float s, const float (&g)[8]) {
    u32x4 o; o.x = pk2(bflo(w.x) * s * g[0], bfhi(w.x) * s * g[1]); o.y = pk2(bflo(w.y) * s * g[2], bfhi(w.y) * s * g[3]);
    o.z = pk2(bflo(w.z) * s * g[4], bfhi(w.z) * s * g[5]); o.w = pk2(bflo(w.w) * s * g[6], bfhi(w.w) * s * g[7]); return o;
}
__device__ __forceinline__ u32x4 rope8(u32x4 w, u32x4 pw, float s, const float (&go)[8], const float (&gp)[8], f32x4 c0, f32x4 c1, f32x4 s0, f32x4 s1, float sgn) {
    const float a[8] = {bflo(w.x) * s * go[0], bfhi(w.x) * s * go[1], bflo(w.y) * s * go[2], bfhi(w.y) * s * go[3], bflo(w.z) * s * go[4], bfhi(w.z) * s * go[5], bflo(w.w) * s * go[6], bfhi(w.w) * s * go[7]};
    const float b[8] = {bflo(pw.x) * s * gp[0], bfhi(pw.x) * s * gp[1], bflo(pw.y) * s * gp[2], bfhi(pw.y) * s * gp[3], bflo(pw.z) * s * gp[4], bfhi(pw.z) * s * gp[5], bflo(pw.w) * s * gp[6], bfhi(pw.w) * s * gp[7]};
    u32x4 o;
    o.x = pk2(a[0] * c0.x + sgn * b[0] * s0.x, a[1] * c0.y + sgn * b[1] * s0.y); o.y = pk2(a[2] * c0.z + sgn * b[2] * s0.z, a[3] * c0.w + sgn * b[3] * s0.w);
    o.z = pk2(a[4] * c1.x + sgn * b[4] * s1.x, a[5] * c1.y + sgn * b[5] * s1.y); o.w = pk2(a[6] * c1.z + sgn * b[6] * s1.z, a[7] * c1.w + sgn * b[7] * s1.w);
    return o;
}
__device__ __forceinline__ u32x4 shfl_xor4(u32x4 w, int m) { u32x4 o; o.x = __shfl_xor(w.x, m); o.y = __shfl_xor(w.y, m); o.z = __shfl_xor(w.z, m); o.w = __shfl_xor(w.w, m); return o; }
__device__ __forceinline__ void ph_qkv_post(const Params& p, int gwave, int gnw, int lane) {
    unsigned char* ws = p.ws;
    const int g16 = lane >> 4, pos = lane & 15, hr = lane >> 3, rpos = lane & 7, f0 = (rpos & 3) * 8;
    const float sgn = (rpos < 4) ? -1.f : 1.f;
    float gqn[8], gqr[8], gqp[8], gkn[8], gkr[8], gkp[8];
#pragma unroll
    for (int i = 0; i < 8; ++i) { gqn[i] = p.q_norm[pos * 8 + i]; gqr[i] = p.q_norm[128 + rpos * 8 + i]; gqp[i] = p.q_norm[128 + (rpos ^ 4) * 8 + i];
                                  gkn[i] = p.k_norm[pos * 8 + i]; gkr[i] = p.k_norm[128 + rpos * 8 + i]; gkp[i] = p.k_norm[128 + (rpos ^ 4) * 8 + i]; }
    for (int t = gwave; t < T; t += gnw) {
        const bf16_t* proj = (const bf16_t*)(ws + WS_PROJ) + (size_t)t * NPROJ;
        const bf16_t* qraw = (const bf16_t*)(ws + WS_QRAW) + (size_t)t * NQ;
        const bf16_t* kvraw = (const bf16_t*)(ws + WS_KVRAW) + (size_t)t * NKV;
        const u32x4 cq = *(const u32x4*)(proj + C_CQ + lane * 8);
        const u32x4 ck = *(const u32x4*)(proj + C_CKV + (lane & 31) * 8);
        const u32x4 kr = *(const u32x4*)(proj + C_KR + rpos * 8);
        const u32x4 qn0 = *(const u32x4*)(qraw + g16 * 192 + pos * 8), qn1 = *(const u32x4*)(qraw + (4 + g16) * 192 + pos * 8), qr = *(const u32x4*)(qraw + hr * 192 + 128 + rpos * 8);
        const u32x4 kn0 = *(const u32x4*)(kvraw + g16 * 256 + pos * 8), kn1 = *(const u32x4*)(kvraw + (4 + g16) * 256 + pos * 8);
        const u32x4 v0 = *(const u32x4*)(kvraw + g16 * 256 + 128 + pos * 8), v1 = *(const u32x4*)(kvraw + (4 + g16) * 256 + 128 + pos * 8);
        const float* rcp = (const float*)(ws + WS_ROPEC) + (size_t)t * 32 + f0; const float* rsp = (const float*)(ws + WS_ROPES) + (size_t)t * 32 + f0;
        const f32x4 c0 = *(const f32x4*)rcp, c1 = *(const f32x4*)(rcp + 4), s0 = *(const f32x4*)rsp, s1 = *(const f32x4*)(rsp + 4);
        const float rcq = rsqrtf(wave_sum(ssq8(cq)) * (1.f / 512.f) + EPS);
        const float rckv = rsqrtf(wave_sum(lane < 32 ? ssq8(ck) : 0.f) * (1.f / 256.f) + EPS);
        float skr = ssq8(kr), nq0 = ssq8(qn0), nq1 = ssq8(qn1), rqs = ssq8(qr), nk0 = ssq8(kn0), nk1 = ssq8(kn1);
#pragma unroll
        for (int o = 1; o < 8; o <<= 1) { skr += __shfl_xor(skr, o); rqs += __shfl_xor(rqs, o); nq0 += __shfl_xor(nq0, o); nq1 += __shfl_xor(nq1, o); nk0 += __shfl_xor(nk0, o); nk1 += __shfl_xor(nk1, o); }
        nq0 += __shfl_xor(nq0, 8); nq1 += __shfl_xor(nq1, 8); nk0 += __shfl_xor(nk0, 8); nk1 += __shfl_xor(nk1, 8);
        const float rc2 = rcq * rcq, rk2 = rckv * rckv;
        const float tq0 = nq0 + __shfl(rqs, 8 * g16), tq1 = nq1 + __shfl(rqs, 8 * (4 + g16));
        const float tqa = __shfl(nq0, 16 * (hr & 3)), tqb = __shfl(nq1, 16 * (hr & 3));
        const float tqr = rqs + ((hr < 4) ? tqa : tqb);
        const float sq0 = rsqrtf(tq0 * rc2 * (1.f / 192.f) + EPS) * rcq * QSCALE, sq1 = rsqrtf(tq1 * rc2 * (1.f / 192.f) + EPS) * rcq * QSCALE, sqr = rsqrtf(tqr * rc2 * (1.f / 192.f) + EPS) * rcq * QSCALE;
        const float rk0 = rsqrtf((nk0 * rk2 + skr) * (1.f / 192.f) + EPS), rk1 = rsqrtf((nk1 * rk2 + skr) * (1.f / 192.f) + EPS);
        const float rka = __shfl(rk0, 16 * (hr & 3)), rkb = __shfl(rk1, 16 * (hr & 3));
        const float rkr = (hr < 4) ? rka : rkb;
        const u32x4 pqr = shfl_xor4(qr, 4), pkr = shfl_xor4(kr, 4);
        const int b = t / SEQ, sidx = t % SEQ;
        bf16_t* Q0 = (bf16_t*)(ws + WS_Q) + ((size_t)(b * 8 + g16) * SEQ + sidx) * 192; bf16_t* Q1 = Q0 + (size_t)4 * SEQ * 192; bf16_t* Qr = (bf16_t*)(ws + WS_Q) + ((size_t)(b * 8 + hr) * SEQ + sidx) * 192;
        bf16_t* K0 = (bf16_t*)(ws + WS_K) + ((size_t)(b * 8 + g16) * SEQ + sidx) * 192; bf16_t* K1 = K0 + (size_t)4 * SEQ * 192; bf16_t* Kr = (bf16_t*)(ws + WS_K) + ((size_t)(b * 8 + hr) * SEQ + sidx) * 192;
        bf16_t* V0 = (bf16_t*)(ws + WS_V) + ((size_t)(b * 8 + g16) * SEQ + sidx) * 128; bf16_t* V1 = V0 + (size_t)4 * SEQ * 128;
        *(u32x4*)(Q0 + pos * 8) = scale8(qn0, sq0, gqn); *(u32x4*)(Q1 + pos * 8) = scale8(qn1, sq1, gqn);
        *(u32x4*)(Qr + 128 + rpos * 8) = rope8(qr, pqr, sqr, gqr, gqp, c0, c1, s0, s1, sgn);
        *(u32x4*)(K0 + pos * 8) = scale8(kn0, rckv * rk0, gkn); *(u32x4*)(K1 + pos * 8) = scale8(kn1, rckv * rk1, gkn);
        *(u32x4*)(Kr + 128 + rpos * 8) = rope8(kr, pkr, rkr, gkr, gkp, c0, c1, s0, s1, sgn);
        const float one[8] = {1.f, 1.f, 1.f, 1.f, 1.f, 1.f, 1.f, 1.f};
        *(u32x4*)(V0 + pos * 8) = scale8(v0, rckv, one); *(u32x4*)(V1 + pos * 8) = scale8(v1, rckv, one);
    }
}
__device__ __forceinline__ void ph_attn_naive(const Params& p, unsigned char* lds, int tid, int bid, int G) {
    const int lane = tid & 63, wv = tid >> 6;
    float* ps = (float*)lds + wv * SEQ;
    float* qs = (float*)(lds + 65536) + wv * 192;
    for (int it = 0; it < (T * 8) / (G * 8); ++it) {
        const int sb = (it & 1) ? (G - 1 - bid) : bid;
        const int gi = it * (G * 8) + sb * 8 + wv;
        const int bh = gi / SEQ, s = gi % SEQ, b = bh >> 3, h = bh & 7;
        const bf16_t* Q = (const bf16_t*)(p.ws + WS_Q) + (size_t)gi * 192;
        const bf16_t* K = (const bf16_t*)(p.ws + WS_K) + (size_t)bh * SEQ * 192;
        const bf16_t* V = (const bf16_t*)(p.ws + WS_KVRAW) + (size_t)(b * SEQ) * NKV + h * 256 + 128;
        for (int d = lane; d < 192; d += 64) qs[d] = bf2f(Q[d]);
        SYNC();
        float mx = -1e30f;
        for (int k0 = 0; k0 <= s; k0 += 64) {
            const int key = k0 + lane; float sc = -INFINITY;
            if (key <= s) {
                const u32x4* kp = (const u32x4*)(K + (size_t)key * 192); float a = 0.f;
                for (int c = 0; c < 24; ++c) { const u32x4 w = kp[c]; const float* q = &qs[c * 8];
                    a += bflo(w.x) * q[0] + bfhi(w.x) * q[1] + bflo(w.y) * q[2] + bfhi(w.y) * q[3] + bflo(w.z) * q[4] + bfhi(w.z) * q[5] + bflo(w.w) * q[6] + bfhi(w.w) * q[7]; }
                sc = a;
            }
            ps[key] = sc;
            mx = fmaxf(mx, sc);
        }
#pragma unroll
        for (int o = 1; o < 64; o <<= 1) mx = fmaxf(mx, __shfl_xor(mx, o));
        SYNC();
        float sum = 0.f;
        for (int key = lane; key <= s; key += 64) { const float e = exp2f(ps[key] - mx); ps[key] = e; sum += e; }
        sum = wave_sum(sum);
        SYNC();
        float o0 = 0.f, o1 = 0.f;
        for (int key = 0; key <= s; ++key) { const float pr = ps[key]; const unsigned w = *(const unsigned*)(V + (size_t)key * NKV + 2 * lane); o0 += pr * bflo(w); o1 += pr * bfhi(w); }
        const float inv = 1.f / sum; o0 *= inv; o1 *= inv;
        const int t = b * SEQ + s;
        *(unsigned*)((bf16_t*)(p.ws + WS_ATTN) + (size_t)t * 1024 + h * 128 + 2 * lane) = pk2(o0, o1);
        SYNC();
    }
}
__device__ __forceinline__ void ph_conv_naive(const Params& p, int gtid, int gn) {
    const bf16_t* proj = (const bf16_t*)(p.ws + WS_PROJ);
    for (int i = gtid; i < T * 1552; i += gn) {
        const int t = i / 1552, c = i % 1552, s = t % SEQ;
        if (c < 1536) {
            float a = p.conv_b[c];
            for (int k = 0; k < 4; ++k) { const int ss = s - 3 + k; if (ss >= 0) a += p.conv_w[k * 1536 + c] * bf2f(proj[(size_t)(t - 3 + k) * NPROJ + C_XBC + c]); }
            ((bf16_t*)(p.ws + WS_XBCA))[(size_t)t * 1536 + c] = (bf16_t)f2bf(silu_f(a));
        } else {
            const int hh = c - 1536; const float v = bf2f(proj[(size_t)t * NPROJ + C_DT + hh]) + p.dt_bias[hh];
            ((float*)(p.ws + WS_DT))[(size_t)t * 16 + hh] = (v > 20.f) ? v : log1pf(__expf(v));
        }
    }
}
__device__ __forceinline__ void ph_ssd_naive(const Params& p, int vb, int lt) {
    const int b = vb >> 4, h = vb & 15, g = h >> 3, pp = lt >> 2, nq = lt & 3;
    const bf16_t* xa = (const bf16_t*)(p.ws + WS_XBCA); const float* dtp = (const float*)(p.ws + WS_DT);
    const bf16_t* proj = (const bf16_t*)(p.ws + WS_PROJ);
    const float a = -__expf(p.a_log[h]), dsk = p.d_skip[h];
    float st[32];
#pragma unroll
    for (int n = 0; n < 32; ++n) st[n] = 0.f;
    for (int s = 0; s < SEQ; ++s) {
        const size_t t = (size_t)b * SEQ + s;
        const float dt = dtp[t * 16 + h], dA = __expf(dt * a);
        const float xv = bf2f(xa[t * 1536 + h * 64 + pp]);
        const bf16_t* Bp = xa + t * 1536 + 1024 + g * 128 + nq * 32; const bf16_t* Cp = xa + t * 1536 + 1280 + g * 128 + nq * 32;
        float y = 0.f; const float dx = dt * xv;
#pragma unroll
        for (int n = 0; n < 32; ++n) { st[n] = st[n] * dA + dx * bf2f(Bp[n]); y += bf2f(Cp[n]) * st[n]; }
        y += __shfl_xor(y, 1); y += __shfl_xor(y, 2);
        if (nq == 0) {
            const float z = bf2f(proj[t * NPROJ + C_Z + h * 64 + pp]);
            ((bf16_t*)(p.ws + WS_YSSD))[t * 1024 + h * 64 + pp] = (bf16_t)f2bf((y + dsk * xv) * silu_f(z));
        }
    }
}
__device__ __forceinline__ void ph_mixnorm(const Params& p, int gwave, int gnw, int lane) {
    for (int t = gwave; t < T; t += gnw) {
        const uint2* ain = (const uint2*)((const bf16_t*)(p.ws + WS_ATTN) + (size_t)t * 1024); const uint2* yin = (const uint2*)((const bf16_t*)(p.ws + WS_YSSD) + (size_t)t * 1024);
        uint2 a[4], y[4]; float sa = 0.f, s0 = 0.f, s1 = 0.f;
#pragma unroll
        for (int j = 0; j < 4; ++j) { a[j] = ain[lane + 64 * j]; y[j] = yin[lane + 64 * j]; sa += sq2(a[j].x) + sq2(a[j].y); const float q = sq2(y[j].x) + sq2(y[j].y); if (j < 2) s0 += q; else s1 += q; }
        const float ra = rsqrtf(wave_sum(sa) * (1.f / 1024.f) + EPS), r0 = rsqrtf(wave_sum(s0) * (1.f / 512.f) + EPS), r1 = rsqrtf(wave_sum(s1) * (1.f / 512.f) + EPS);
        uint2* o = (uint2*)((bf16_t*)(p.ws + WS_MIXIN) + (size_t)t * DM);
#pragma unroll
        for (int j = 0; j < 4; ++j) {
            uint2 r; r.x = pk2(bflo(a[j].x) * ra, bfhi(a[j].x) * ra); r.y = pk2(bflo(a[j].y) * ra, bfhi(a[j].y) * ra); o[lane + 64 * j] = r;
            const float rr = (j < 2) ? r0 : r1;
            uint2 q; q.x = pk2(bflo(y[j].x) * rr, bfhi(y[j].x) * rr); q.y = pk2(bflo(y[j].y) * rr, bfhi(y[j].y) * rr); o[256 + lane + 64 * j] = q;
        }
    }
}
__device__ __forceinline__ void ph_route_naive(const Params& p, unsigned char* lds, int tid, int bid, int G) {
    const int sub = tid >> 7, lt = tid & 127;
    float* base = (float*)(lds + sub * 4096);
    float* q = base; float* sc = base + 256; float* ts = base + 512; int* ti = (int*)(base + 544); float* cs = base + 576; float* bs = base + 832; int* bi = (int*)(base + 848);
    const bf16_t* sk = (const bf16_t*)(p.ws + WS_SUBK);
    for (int it = 0; it < (T * 8) / (G * 4); ++it) {
        const int vb = it * (G * 4) + bid * 4 + sub, t = vb >> 3, h = vb & 7;
        const bf16_t* qp = (const bf16_t*)(p.ws + WS_QP) + (size_t)t * DM + h * 256;
        q[lt] = bf2f(qp[lt]); q[128 + lt] = bf2f(qp[128 + lt]);
        SYNC();
#pragma unroll
        for (int j = 0; j < 2; ++j) {
            const u32x4* kp = (const u32x4*)(sk + ((size_t)(h * 2 + j) * 128 + lt) * 128); float a = 0.f;
            for (int c = 0; c < 16; ++c) { const u32x4 w = kp[c]; const float* qq = q + j * 128 + c * 8;
                a += bflo(w.x) * qq[0] + bfhi(w.x) * qq[1] + bflo(w.y) * qq[2] + bfhi(w.y) * qq[3] + bflo(w.z) * qq[4] + bfhi(w.z) * qq[5] + bflo(w.w) * qq[6] + bfhi(w.w) * qq[7]; }
            sc[j * 128 + lt] = a;
        }
        SYNC();
#pragma unroll
        for (int j = 0; j < 2; ++j) {
            const float v = sc[j * 128 + lt]; int rank = 0;
            for (int k = 0; k < 128; ++k) { const float o = sc[j * 128 + k]; rank += (o > v || (o == v && k < lt)) ? 1 : 0; }
            if (rank < 16) { ts[j * 16 + rank] = v; ti[j * 16 + rank] = lt; }
        }
        SYNC();
        cs[lt] = ts[lt >> 4] + ts[16 + (lt & 15)]; cs[128 + lt] = ts[8 + (lt >> 4)] + ts[16 + (lt & 15)];
        SYNC();
#pragma unroll
        for (int r = 0; r < 2; ++r) {
            const int ci = lt + 128 * r; const float v = cs[ci]; int rank = 0;
            for (int k = 0; k < 256; ++k) { const float o = cs[k]; rank += (o > v || (o == v && k < ci)) ? 1 : 0; }
            if (rank < 16) { bs[rank] = v; bi[rank] = ti[ci >> 4] * 128 + ti[16 + (ci & 15)]; }
        }
        SYNC();
        if (lt < 16) {
            const float mx = bs[0]; float sum = 0.f;
            for (int k = 0; k < 16; ++k) sum += __expf(bs[k] - mx);
            ((float*)(p.ws + WS_GATE))[(size_t)t * 128 + h * 16 + lt] = __expf(bs[lt] - mx) / sum;
            ((int*)(p.ws + WS_IDX))[(size_t)t * 128 + h * 16 + lt] = bi[lt];
        }
        SYNC();
    }
}
__device__ __forceinline__ void ph_peer_naive(const Params& p, unsigned char* lds, int tid, int bid, int G) {
    const int half = tid >> 8, lt = tid & 255, lane = tid & 63, wv = lt >> 6;
    float* red = (float*)(lds + half * 64);
    const bf16_t* U = (const bf16_t*)(p.ws + WS_U16); const bf16_t* V = (const bf16_t*)(p.ws + WS_V16);
    for (int it = 0; it < T / (G * 2); ++it) {
        const int t = it * (G * 2) + bid * 2 + half, b = t / SEQ;
        const u32x4 hw = *(const u32x4*)((const bf16_t*)(p.ws + WS_H2) + (size_t)t * DM + lt * 8);
        const float h0 = bflo(hw.x), h1 = bfhi(hw.x), h2 = bflo(hw.y), h3 = bfhi(hw.y), h4 = bflo(hw.z), h5 = bfhi(hw.z), h6 = bflo(hw.w), h7 = bfhi(hw.w);
        float o0 = 0.f, o1 = 0.f, o2 = 0.f, o3 = 0.f, o4 = 0.f, o5 = 0.f, o6 = 0.f, o7 = 0.f;
        const int* idx = (const int*)(p.ws + WS_IDX) + (size_t)t * 128; const float* gate = (const float*)(p.ws + WS_GATE) + (size_t)t * 128;
        for (int e = 0; e < 128; ++e) {
            const int ex = idx[e];
            const u32x4 uw = *(const u32x4*)(U + (size_t)ex * DM + lt * 8);
            float d = bflo(uw.x) * h0 + bfhi(uw.x) * h1 + bflo(uw.y) * h2 + bfhi(uw.y) * h3 + bflo(uw.z) * h4 + bfhi(uw.z) * h5 + bflo(uw.w) * h6 + bfhi(uw.w) * h7;
            d = wave_sum(d);
            if (lane == 0) red[wv] = d;
            SYNC();
            const float pre = red[0] + red[1] + red[2] + red[3];
            const float a = 0.5f * pre * (1.f + erff(pre * 0.70710678118654752f)) * gate[e];
            SYNC();
            const u32x4 vw = *(const u32x4*)(V + (size_t)ex * DM + lt * 8);
            o0 += a * bflo(vw.x); o1 += a * bfhi(vw.x); o2 += a * bflo(vw.y); o3 += a * bfhi(vw.y); o4 += a * bflo(vw.z); o5 += a * bfhi(vw.z); o6 += a * bflo(vw.w); o7 += a * bfhi(vw.w);
        }
        const float* g2 = (const float*)(p.ws + WS_MOD) + (size_t)b * 6 * DM + 5 * DM + lt * 8;
        float* outp = p.out + (size_t)t * DM + lt * 8;
        const f32x4 x0 = *(const f32x4*)outp, x1 = *(const f32x4*)(outp + 4), ga = *(const f32x4*)g2, gb = *(const f32x4*)(g2 + 4);
        *(f32x4*)outp = (f32x4){x0.x + ga.x * o0, x0.y + ga.y * o1, x0.z + ga.z * o2, x0.w + ga.w * o3};
        *(f32x4*)(outp + 4) = (f32x4){x1.x + gb.x * o4, x1.y + gb.y * o5, x1.z + gb.z * o6, x1.w + gb.w * o7};
    }
}
typedef __bf16 bf16x2_t __attribute__((ext_vector_type(2)));
__device__ __forceinline__ float dot2bf(unsigned a, unsigned b, float c) { return __builtin_amdgcn_fdot2_f32_bf16(__builtin_bit_cast(bf16x2_t, a), __builtin_bit_cast(bf16x2_t, b), c, false); }
__device__ __forceinline__ void ph_peer(const Params& p, LAS unsigned char* ldsl, int wave, int lane, int gwave, int gnw) {
    LAS unsigned char* ring = ldsl + wave * 16384;
    const bf16_t* U = (const bf16_t*)(p.ws + WS_U16); const bf16_t* V = (const bf16_t*)(p.ws + WS_V16);
    const int e_lane = (lane >> 2) & 15; const unsigned lane16 = (unsigned)lane * 16u;
#define PEER_ISSUE(R) do { const int R_ = (R); const int i_ = ((R_ >> 5) << 4) + (R_ & 15); \
        const int e_ = (i_ < 64) ? __builtin_amdgcn_readlane(idx0, i_) : __builtin_amdgcn_readlane(idx1, i_ - 64); \
        const char* base_ = (const char*)(((R_ >> 4) & 1) ? V : U) + (size_t)(unsigned)e_ * (DM * 2); \
        const unsigned* src_ = (const unsigned*)(base_ + lane16); \
        LAS unsigned* dst_ = (LAS unsigned*)(ring + (R_ & 3) * 4096); \
        __builtin_amdgcn_global_load_lds(src_, dst_, 16, 0, 0); \
        __builtin_amdgcn_global_load_lds(src_, dst_, 16, 1024, 0); \
        __builtin_amdgcn_global_load_lds(src_, dst_, 16, 2048, 0); \
        __builtin_amdgcn_global_load_lds(src_, dst_, 16, 3072, 0); } while (0)
#define PEER_WAIT(n) asm volatile("s_waitcnt vmcnt(" #n ")" ::: "memory")
    for (int t = gwave; t < T; t += gnw) {
        const int b = t / SEQ;
        const int idx0 = ((const int*)(p.ws + WS_IDX))[(size_t)t * 128 + lane], idx1 = ((const int*)(p.ws + WS_IDX))[(size_t)t * 128 + 64 + lane];
        const float g0 = ((const float*)(p.ws + WS_GATE))[(size_t)t * 128 + lane], g1 = ((const float*)(p.ws + WS_GATE))[(size_t)t * 128 + 64 + lane];
        u32x4 hreg[4];
#pragma unroll
        for (int j = 0; j < 4; ++j) hreg[j] = *(const u32x4*)((const bf16_t*)(p.ws + WS_H2) + (size_t)t * DM + j * 512 + lane * 8);
        float out[4][8];
#pragma unroll
        for (int j = 0; j < 4; ++j)
#pragma unroll
            for (int i = 0; i < 8; ++i) out[j][i] = 0.f;
        PEER_ISSUE(0); PEER_ISSUE(1); PEER_ISSUE(2);
        for (int hh = 0; hh < 8; ++hh) {
            float pd[16];
#pragma unroll
            for (int k = 0; k < 16; ++k) {
                PEER_ISSUE(hh * 32 + k + 3); PEER_WAIT(12);
                const LAS unsigned char* sl = ring + (k & 3) * 4096 + lane * 16;
                float a = 0.f;
#pragma unroll
                for (int j = 0; j < 4; ++j) { const u32x4 w = *(const LAS u32x4*)(sl + j * 1024);
                    a = dot2bf(w.x, hreg[j].x, a); a = dot2bf(w.y, hreg[j].y, a); a = dot2bf(w.z, hreg[j].z, a); a = dot2bf(w.w, hreg[j].w, a); }
                asm volatile("" : "+v"(a));
                pd[k] = a;
            }
            float q8[8], q4[4], q2[2], q1;
            { const bool hi = (lane & 32) != 0;
#pragma unroll
              for (int i = 0; i < 8; ++i) { const float keep = hi ? pd[i + 8] : pd[i], send = hi ? pd[i] : pd[i + 8]; q8[i] = keep + __shfl_xor(send, 32); } }
            { const bool hi = (lane & 16) != 0;
#pragma unroll
              for (int i = 0; i < 4; ++i) { const float keep = hi ? q8[i + 4] : q8[i], send = hi ? q8[i] : q8[i + 4]; q4[i] = keep + __shfl_xor(send, 16); } }
            { const bool hi = (lane & 8) != 0;
#pragma unroll
              for (int i = 0; i < 2; ++i) { const float keep = hi ? q4[i + 2] : q4[i], send = hi ? q4[i] : q4[i + 2]; q2[i] = keep + __shfl_xor(send, 8); } }
            { const bool hi = (lane & 4) != 0; const float keep = hi ? q2[1] : q2[0], send = hi ? q2[0] : q2[1]; q1 = keep + __shfl_xor(send, 4); }
            q1 += __shfl_xor(q1, 1); q1 += __shfl_xor(q1, 2);
            const float gsel = (hh < 4) ? g0 : g1;
            const float gate = __shfl(gsel, (hh & 3) * 16 + e_lane);
            const float act = 0.5f * q1 * (1.f + erff(q1 * 0.70710678118654752f)) * gate;
#pragma unroll
            for (int k = 0; k < 16; ++k) {
                if (k < 13) { PEER_ISSUE(hh * 32 + 16 + k + 3); PEER_WAIT(12); }
                else if (hh < 7) { PEER_ISSUE(hh * 32 + 16 + k + 3); PEER_WAIT(12); }
                else if (k == 13) PEER_WAIT(8); else if (k == 14) PEER_WAIT(4); else PEER_WAIT(0);
                const float a = __builtin_bit_cast(float, __builtin_amdgcn_readlane(__builtin_bit_cast(int, act), 4 * k));
                const LAS unsigned char* sl = ring + (k & 3) * 4096 + lane * 16;
#pragma unroll
                for (int j = 0; j < 4; ++j) { const u32x4 w = *(const LAS u32x4*)(sl + j * 1024);
                    out[j][0] += a * bflo(w.x); out[j][1] += a * bfhi(w.x); out[j][2] += a * bflo(w.y); out[j][3] += a * bfhi(w.y);
                    out[j][4] += a * bflo(w.z); out[j][5] += a * bfhi(w.z); out[j][6] += a * bflo(w.w); out[j][7] += a * bfhi(w.w);
                    asm volatile("" : "+v"(out[j][0]), "+v"(out[j][1]), "+v"(out[j][2]), "+v"(out[j][3]), "+v"(out[j][4]), "+v"(out[j][5]), "+v"(out[j][6]), "+v"(out[j][7])); }
            }
        }
        const float* g2 = (const float*)(p.ws + WS_MOD) + (size_t)b * 6 * DM + 5 * DM;
        float* outp = p.out + (size_t)t * DM;
#pragma unroll
        for (int j = 0; j < 4; ++j) {
            const int c = j * 512 + lane * 8;
            const f32x4 x0 = *(const f32x4*)(outp + c), x1 = *(const f32x4*)(outp + c + 4), ga = *(const f32x4*)(g2 + c), gb = *(const f32x4*)(g2 + c + 4);
            *(f32x4*)(outp + c) = (f32x4){x0.x + ga.x * out[j][0], x0.y + ga.y * out[j][1], x0.z + ga.z * out[j][2], x0.w + ga.w * out[j][3]};
            *(f32x4*)(outp + c + 4) = (f32x4){x1.x + gb.x * out[j][4], x1.y + gb.y * out[j][5], x1.z + gb.z * out[j][6], x1.w + gb.w * out[j][7]};
        }
    }
#undef PEER_ISSUE
#undef PEER_WAIT
}
typedef short bf16x8 __attribute__((ext_vector_type(8)));
typedef short s16x4 __attribute__((ext_vector_type(4)));
typedef float f32x16 __attribute__((ext_vector_type(16)));
typedef float f32x2_t __attribute__((ext_vector_type(2)));
__device__ __forceinline__ int crow(int r, int hi) { return (r & 3) + 8 * (r >> 2) + 4 * hi; }
__device__ __forceinline__ unsigned cvtpk(float lo, float hi) { f32x2_t v = {lo, hi}; bf16x2_t b = __builtin_convertvector(v, bf16x2_t); return __builtin_bit_cast(unsigned, b); }
__device__ __forceinline__ s16x4 vtr(const LAS unsigned char* pp) { return __builtin_bit_cast(s16x4, __builtin_amdgcn_ds_read_tr16_b64_v4i16((LAS s16x4*)pp)); }
#define TR_PAIR(lo_, hi_, addr_, off_, hioff_) do { asm volatile("ds_read_b64_tr_b16 %0, %1 offset:%c2" : "=&v"(lo_) : "v"(addr_), "i"(off_) : "memory"); \
        asm volatile("ds_read_b64_tr_b16 %0, %1 offset:%c2" : "=&v"(hi_) : "v"(addr_), "i"((off_) + (hioff_)) : "memory"); } while (0)
#define LDS_WAIT_PIN() do { asm volatile("s_waitcnt lgkmcnt(0)" ::: "memory"); __builtin_amdgcn_sched_barrier(0); } while (0)
constexpr int AT_SLOT = 40960, AT_VOFF = 24576;
__device__ __forceinline__ void attn_unit(const Params& p, LAS unsigned char* ldsl, int bh, int qb, int wave, int lane) {
    const int r32 = lane & 31, hi = lane >> 5, b = bh >> 3, h = bh & 7;
    const bf16_t* Kbh = (const bf16_t*)(p.ws + WS_K) + (size_t)bh * SEQ * 192;
    const bf16_t* Vb = (const bf16_t*)(p.ws + WS_V) + (size_t)bh * SEQ * 128;
    const bf16_t* Qw = (const bf16_t*)(p.ws + WS_Q) + ((size_t)bh * SEQ + qb * 256 + wave * 32 + r32) * 192 + 8 * hi;
    const int NT = (qb * 256 + 256) / 64;
    int koff[3];
#pragma unroll
    for (int i = 0; i < 3; ++i) { const int o = 64 * (wave * 3 + i) + lane, k = o / 24, sl = o - 24 * k; int c = sl - ((k >> 1) & 7); c += (c < 0) ? 24 : 0; koff[i] = k * 192 + c * 8; }
    const int vid = wave * 2;
    const bf16_t* vsrc = Vb + (size_t)(16 * (vid & 3) + (lane >> 2)) * 128 + (vid >> 2) * 32 + (lane & 3) * 8;
#define AT_ISSUE(t, slot) do { const bf16_t* ks_ = Kbh + (size_t)(t) * 64 * 192; LAS unsigned char* sb_ = ldsl + (slot) * AT_SLOT; \
        __builtin_amdgcn_global_load_lds((const unsigned*)(ks_ + koff[0]), (LAS unsigned*)(sb_ + (wave * 3 + 0) * 1024), 16, 0, 0); \
        __builtin_amdgcn_global_load_lds((const unsigned*)(ks_ + koff[1]), (LAS unsigned*)(sb_ + (wave * 3 + 1) * 1024), 16, 0, 0); \
        __builtin_amdgcn_global_load_lds((const unsigned*)(ks_ + koff[2]), (LAS unsigned*)(sb_ + (wave * 3 + 2) * 1024), 16, 0, 0); \
        const bf16_t* vs_ = vsrc + (size_t)(t) * 64 * 128; \
        __builtin_amdgcn_global_load_lds((const unsigned*)(vs_), (LAS unsigned*)(sb_ + AT_VOFF + vid * 1024), 16, 0, 0); \
        __builtin_amdgcn_global_load_lds((const unsigned*)(vs_ + (size_t)16 * 128), (LAS unsigned*)(sb_ + AT_VOFF + (vid + 1) * 1024), 16, 0, 0); } while (0)
    bf16x8 qr[12];
#pragma unroll
    for (int s = 0; s < 12; ++s) qr[s] = *(const bf16x8*)(Qw + 16 * s);
#pragma unroll
    for (int s = 0; s < 12; ++s) asm volatile("" : "+v"(qr[s]));
    AT_ISSUE(0, 0); AT_ISSUE(1, 1);
    f32x16 o[4];
#pragma unroll
    for (int d0 = 0; d0 < 4; ++d0)
#pragma unroll
        for (int r = 0; r < 16; ++r) o[d0][r] = 0.f;
    float m = -1e30f, l = 0.f;
    const int kfo = r32 * 384, kc0 = hi + ((r32 >> 1) & 7);
    const int vfo = AT_VOFF + ((lane >> 4) & 1) * 32 + (lane & 3) * 8 + (4 * hi + ((lane & 15) >> 2)) * 64;
    const int qrel = wave * 32 + r32;
    int slot = 0;
    for (int t = 0; t < NT; ++t) {
        if (t + 1 < NT) asm volatile("s_waitcnt vmcnt(5)" ::: "memory"); else asm volatile("s_waitcnt vmcnt(0)" ::: "memory");
        __builtin_amdgcn_s_barrier(); asm volatile("" ::: "memory");
        if (t + 2 < NT) { const int s2 = (slot == 0) ? 2 : slot - 1; AT_ISSUE(t + 2, s2); }
        const int jb = t - (NT - 4);
        if (!(jb >= 0 && 64 * jb > wave * 32 + 31)) {
            const LAS unsigned char* kp = ldsl + slot * AT_SLOT + kfo;
            int kc = kc0; asm volatile("" : "+v"(kc));
            f32x16 p0, p1;
#pragma unroll
            for (int r = 0; r < 16; ++r) { p0[r] = 0.f; p1[r] = 0.f; }
#pragma unroll
            for (int s = 0; s < 12; ++s) {
                int sl_ = kc + 2 * s; sl_ -= (sl_ >= 24) ? 24 : 0;
                const bf16x8 k0 = *(const LAS bf16x8*)(kp + sl_ * 16), k1 = *(const LAS bf16x8*)(kp + sl_ * 16 + 32 * 384);
                p0 = __builtin_amdgcn_mfma_f32_32x32x16_bf16(k0, qr[s], p0, 0, 0, 0);
                p1 = __builtin_amdgcn_mfma_f32_32x32x16_bf16(k1, qr[s], p1, 0, 0, 0);
            }
            if (jb >= 0 && 64 * jb + 63 > wave * 32) {
#pragma unroll
                for (int r = 0; r < 16; ++r) { const int kv = 64 * jb + crow(r, hi); if (kv > qrel) p0[r] = -INFINITY; if (kv + 32 > qrel) p1[r] = -INFINITY; }
            }
            float rm = fmaxf(p0[0], p1[0]);
#pragma unroll
            for (int r = 1; r < 16; ++r) rm = fmaxf(rm, fmaxf(p0[r], p1[r]));
            rm = fmaxf(rm, __shfl_xor(rm, 32));
            const float mn = fmaxf(m, rm);
            if (__any(mn > m)) {
                const float alpha = __builtin_amdgcn_exp2f(m - mn);
                l *= alpha;
#pragma unroll
                for (int r = 0; r < 16; ++r) { const float ar = __shfl(alpha, crow(r, hi));
#pragma unroll
                    for (int d0 = 0; d0 < 4; ++d0) o[d0][r] *= ar; }
                m = mn;
            }
            float ls = 0.f;
#pragma unroll
            for (int r = 0; r < 16; ++r) { p0[r] = __builtin_amdgcn_exp2f(p0[r] - m); p1[r] = __builtin_amdgcn_exp2f(p1[r] - m); ls += p0[r] + p1[r]; }
            l += ls;
            bf16x8 pa[4];
            { u32x4 w;
              w.x = cvtpk(p0[0], p0[1]); w.y = cvtpk(p0[2], p0[3]); w.z = cvtpk(p0[4], p0[5]); w.w = cvtpk(p0[6], p0[7]); pa[0] = __builtin_bit_cast(bf16x8, w);
              w.x = cvtpk(p0[8], p0[9]); w.y = cvtpk(p0[10], p0[11]); w.z = cvtpk(p0[12], p0[13]); w.w = cvtpk(p0[14], p0[15]); pa[1] = __builtin_bit_cast(bf16x8, w);
              w.x = cvtpk(p1[0], p1[1]); w.y = cvtpk(p1[2], p1[3]); w.z = cvtpk(p1[4], p1[5]); w.w = cvtpk(p1[6], p1[7]); pa[2] = __builtin_bit_cast(bf16x8, w);
              w.x = cvtpk(p1[8], p1[9]); w.y = cvtpk(p1[10], p1[11]); w.z = cvtpk(p1[12], p1[13]); w.w = cvtpk(p1[14], p1[15]); pa[3] = __builtin_bit_cast(bf16x8, w); }
            const unsigned vpa = (unsigned)(size_t)(ldsl + slot * AT_SLOT + vfo);
#pragma unroll
            for (int d0 = 0; d0 < 4; ++d0) {
                s16x4 lo[4], hh[4];
                TR_PAIR(lo[0], hh[0], vpa, d0 * 4096 + 0 * 1024, 512); TR_PAIR(lo[1], hh[1], vpa, d0 * 4096 + 1 * 1024, 512);
                TR_PAIR(lo[2], hh[2], vpa, d0 * 4096 + 2 * 1024, 512); TR_PAIR(lo[3], hh[3], vpa, d0 * 4096 + 3 * 1024, 512);
                LDS_WAIT_PIN();
#pragma unroll
                for (int ks = 0; ks < 4; ++ks)
                    o[d0] = __builtin_amdgcn_mfma_f32_32x32x16_bf16(pa[ks], (bf16x8){lo[ks][0], lo[ks][1], lo[ks][2], lo[ks][3], hh[ks][0], hh[ks][1], hh[ks][2], hh[ks][3]}, o[d0], 0, 0, 0);
            }
        }
        slot = (slot == 2) ? 0 : slot + 1;
    }
    l += __shfl_xor(l, 32);
    const float inv = 1.f / l;
    bf16_t* Ow = (bf16_t*)(p.ws + WS_ATTN) + ((size_t)b * SEQ + qb * 256 + wave * 32) * 1024 + h * 128 + r32;
#pragma unroll
    for (int r = 0; r < 16; ++r) { const float ir = __shfl(inv, crow(r, hi));
#pragma unroll
        for (int d0 = 0; d0 < 4; ++d0) Ow[(size_t)crow(r, hi) * 1024 + d0 * 32] = (bf16_t)f2bf(o[d0][r] * ir); }
    asm volatile("s_waitcnt lgkmcnt(0)" ::: "memory"); __builtin_amdgcn_s_barrier(); asm volatile("" ::: "memory");
#undef AT_ISSUE
}
__device__ __forceinline__ void ph_attn(const Params& p, LAS unsigned char* ldsl, int bid, int G, int wave, int lane) {
    const int vcu = (bid & 7) * (G >> 3) + (bid >> 3);
    const int bh = vcu >> 2, s = vcu & 3;
    attn_unit(p, ldsl, bh, 7 - s, wave, lane);
    attn_unit(p, ldsl, bh, s, wave, lane);
}
__device__ __forceinline__ int f2sort(float f) { const int u = __builtin_bit_cast(int, f); return u ^ ((u >> 31) & 0x7fffffff); }
__device__ __forceinline__ float sort2f(int k) { return __builtin_bit_cast(float, k ^ ((k >> 31) & 0x7fffffff)); }
#define CE_(a_, b_) do { const int hi_ = max(a_, b_); b_ = min(a_, b_); a_ = hi_; } while (0)
#define INS16(L, x) do { int x_ = (x); _Pragma("unroll") for (int i_ = 0; i_ < 16; ++i_) { const int hi_ = max(L[i_], x_); x_ = min(L[i_], x_); L[i_] = hi_; } } while (0)
#define SORT16(v) do { CE_(v[0], v[13]); CE_(v[1], v[12]); CE_(v[2], v[15]); CE_(v[3], v[14]); CE_(v[4], v[8]); CE_(v[5], v[6]); CE_(v[7], v[11]); CE_(v[9], v[10]); CE_(v[0], v[5]); CE_(v[1], v[7]); CE_(v[2], v[9]); CE_(v[3], v[4]); CE_(v[6], v[13]); CE_(v[8], v[14]); CE_(v[10], v[15]); CE_(v[11], v[12]); CE_(v[0], v[1]); CE_(v[2], v[3]); CE_(v[4], v[5]); CE_(v[6], v[8]); CE_(v[7], v[9]); CE_(v[10], v[11]); CE_(v[12], v[13]); CE_(v[14], v[15]); CE_(v[0], v[2]); CE_(v[1], v[3]); CE_(v[4], v[10]); CE_(v[5], v[11]); CE_(v[6], v[7]); CE_(v[8], v[9]); CE_(v[12], v[14]); CE_(v[13], v[15]); CE_(v[1], v[2]); CE_(v[3], v[12]); CE_(v[4], v[6]); CE_(v[5], v[7]); CE_(v[8], v[10]); CE_(v[9], v[11]); CE_(v[13], v[14]); CE_(v[1], v[4]); CE_(v[2], v[6]); CE_(v[5], v[8]); CE_(v[7], v[10]); CE_(v[9], v[13]); CE_(v[11], v[14]); CE_(v[2], v[4]); CE_(v[3], v[6]); CE_(v[9], v[12]); CE_(v[11], v[13]); CE_(v[3], v[5]); CE_(v[6], v[8]); CE_(v[7], v[9]); CE_(v[10], v[12]); CE_(v[3], v[4]); CE_(v[5], v[6]); CE_(v[7], v[8]); CE_(v[9], v[10]); CE_(v[11], v[12]); CE_(v[6], v[7]); CE_(v[8], v[9]); } while (0)
#define BMERGE16(v) do { CE_(v[0], v[8]); CE_(v[1], v[9]); CE_(v[2], v[10]); CE_(v[3], v[11]); CE_(v[4], v[12]); CE_(v[5], v[13]); CE_(v[6], v[14]); CE_(v[7], v[15]); CE_(v[0], v[4]); CE_(v[1], v[5]); CE_(v[2], v[6]); CE_(v[3], v[7]); CE_(v[8], v[12]); CE_(v[9], v[13]); CE_(v[10], v[14]); CE_(v[11], v[15]); CE_(v[0], v[2]); CE_(v[1], v[3]); CE_(v[4], v[6]); CE_(v[5], v[7]); CE_(v[8], v[10]); CE_(v[9], v[11]); CE_(v[12], v[14]); CE_(v[13], v[15]); CE_(v[0], v[1]); CE_(v[2], v[3]); CE_(v[4], v[5]); CE_(v[6], v[7]); CE_(v[8], v[9]); CE_(v[10], v[11]); CE_(v[12], v[13]); CE_(v[14], v[15]); } while (0)
__device__ __forceinline__ void ph_route(const Params& p, LAS unsigned char* ldsl, int wave, int lane, int gwave, int gnw) {
    const int r32 = lane & 31, hi = lane >> 5;
    const bf16_t* SK = (const bf16_t*)(p.ws + WS_SUBK);
    LAS unsigned char* tab = ldsl + wave * 4096 + lane * 32;
    for (int item = gwave; item < (T / 32) * 8; item += gnw) {
        const int tile = item >> 3, h = item & 7, t0 = tile * 32;
        int hi4 = hi * 4; asm volatile("" : "+v"(hi4));
        int S0[16], S1[16];
#pragma unroll
        for (int j = 0; j < 2; ++j) {
            const bf16_t* qp = (const bf16_t*)(p.ws + WS_QP) + (size_t)(t0 + r32) * DM + h * 256 + j * 128 + 8 * hi;
            asm volatile("" : "+v"(qp));
            bf16x8 bq[8];
#pragma unroll
            for (int s = 0; s < 8; ++s) bq[s] = *(const bf16x8*)(qp + 16 * s);
            int L[16];
#pragma unroll
            for (int kb = 0; kb < 4; ++kb) {
                const bf16_t* ap = SK + ((size_t)(h * 2 + j) * 128 + kb * 32 + r32) * 128 + 8 * hi;
                asm volatile("" : "+v"(ap));
                f32x16 acc;
#pragma unroll
                for (int r = 0; r < 16; ++r) acc[r] = 0.f;
#pragma unroll
                for (int s = 0; s < 8; ++s) acc = __builtin_amdgcn_mfma_f32_32x32x16_bf16(*(const bf16x8*)(ap + 16 * s), bq[s], acc, 0, 0, 0);
                int v[16];
#pragma unroll
                for (int r = 0; r < 16; ++r) v[r] = (f2sort(acc[r]) & ~127) | ((127 - (kb * 32 + (r & 3) + 8 * (r >> 2))) - hi4);
                SORT16(v);
                if (kb == 0) {
#pragma unroll
                    for (int i = 0; i < 16; ++i) L[i] = v[i];
                } else {
#pragma unroll
                    for (int i = 0; i < 16; ++i) L[i] = max(L[i], v[15 - i]);
                    BMERGE16(L);
                }
                __builtin_amdgcn_sched_barrier(0);
            }
            int Y[16];
#pragma unroll
            for (int i = 0; i < 16; ++i) Y[i] = __shfl_xor(L[i], 32);
#pragma unroll
            for (int i = 0; i < 16; ++i) L[i] = max(L[i], Y[15 - i]);
            BMERGE16(L);
#pragma unroll
            for (int i = 0; i < 16; ++i) { if (j == 0) S0[i] = L[i]; else S1[i] = L[i]; }
        }
        float f0[16], f1[16];
        {
            unsigned w0[4], w1[4];
#pragma unroll
            for (int i = 0; i < 16; ++i) { f0[i] = sort2f(S0[i] & ~127); f1[i] = sort2f(S1[i] & ~127); }
#pragma unroll
            for (int q = 0; q < 4; ++q) {
                w0[q] = (unsigned)(127 - (S0[4 * q] & 127)) | ((unsigned)(127 - (S0[4 * q + 1] & 127)) << 8) | ((unsigned)(127 - (S0[4 * q + 2] & 127)) << 16) | ((unsigned)(127 - (S0[4 * q + 3] & 127)) << 24);
                w1[q] = (unsigned)(127 - (S1[4 * q] & 127)) | ((unsigned)(127 - (S1[4 * q + 1] & 127)) << 8) | ((unsigned)(127 - (S1[4 * q + 2] & 127)) << 16) | ((unsigned)(127 - (S1[4 * q + 3] & 127)) << 24);
            }
            *(LAS u32x4*)(tab) = (u32x4){w0[0], w0[1], w0[2], w0[3]};
            *(LAS u32x4*)(tab + 16) = (u32x4){w1[0], w1[1], w1[2], w1[3]};
        }
        int Lv[16];
        Lv[0] = (f2sort(f0[0] + f1[0]) & ~255) | 255;
        Lv[1] = (f2sort(f0[0] + f1[1]) & ~255) | 254;
        Lv[2] = (f2sort(f0[0] + f1[2]) & ~255) | 253;
        Lv[3] = (f2sort(f0[0] + f1[3]) & ~255) | 252;
        Lv[4] = (f2sort(f0[0] + f1[4]) & ~255) | 251;
        Lv[5] = (f2sort(f0[0] + f1[5]) & ~255) | 250;
        Lv[6] = (f2sort(f0[0] + f1[6]) & ~255) | 249;
        Lv[7] = (f2sort(f0[0] + f1[7]) & ~255) | 248;
        Lv[8] = (f2sort(f0[0] + f1[8]) & ~255) | 247;
        Lv[9] = (f2sort(f0[0] + f1[9]) & ~255) | 246;
        Lv[10] = (f2sort(f0[0] + f1[10]) & ~255) | 245;
        Lv[11] = (f2sort(f0[0] + f1[11]) & ~255) | 244;
        Lv[12] = (f2sort(f0[0] + f1[12]) & ~255) | 243;
        Lv[13] = (f2sort(f0[0] + f1[13]) & ~255) | 242;
        Lv[14] = (f2sort(f0[0] + f1[14]) & ~255) | 241;
        Lv[15] = (f2sort(f0[0] + f1[15]) & ~255) | 240;
        { int cv_ = (f2sort(f0[1] + f1[0]) & ~255) | 239; INS16(Lv, cv_); __builtin_amdgcn_sched_barrier(0); }
        { int cv_ = (f2sort(f0[1] + f1[1]) & ~255) | 238; INS16(Lv, cv_); __builtin_amdgcn_sched_barrier(0); }
        { int cv_ = (f2sort(f0[1] + f1[2]) & ~255) | 237; INS16(Lv, cv_); __builtin_amdgcn_sched_barrier(0); }
        { int cv_ = (f2sort(f0[1] + f1[3]) & ~255) | 236; INS16(Lv, cv_); __builtin_amdgcn_sched_barrier(0); }
        { int cv_ = (f2sort(f0[1] + f1[4]) & ~255) | 235; INS16(Lv, cv_); __builtin_amdgcn_sched_barrier(0); }
        { int cv_ = (f2sort(f0[1] + f1[5]) & ~255) | 234; INS16(Lv, cv_); __builtin_amdgcn_sched_barrier(0); }
        { int cv_ = (f2sort(f0[1] + f1[6]) & ~255) | 233; INS16(Lv, cv_); __builtin_amdgcn_sched_barrier(0); }
        { int cv_ = (f2sort(f0[1] + f1[7]) & ~255) | 232; INS16(Lv, cv_); __builtin_amdgcn_sched_barrier(0); }
        { int cv_ = (f2sort(f0[2] + f1[0]) & ~255) | 223; INS16(Lv, cv_); __builtin_amdgcn_sched_barrier(0); }
        { int cv_ = (f2sort(f0[2] + f1[1]) & ~255) | 222; INS16(Lv, cv_); __builtin_amdgcn_sched_barrier(0); }
        { int cv_ = (f2sort(f0[2] + f1[2]) & ~255) | 221; INS16(Lv, cv_); __builtin_amdgcn_sched_barrier(0); }
        { int cv_ = (f2sort(f0[2] + f1[3]) & ~255) | 220; INS16(Lv, cv_); __builtin_amdgcn_sched_barrier(0); }
        { int cv_ = (f2sort(f0[2] + f1[4]) & ~255) | 219; INS16(Lv, cv_); __builtin_amdgcn_sched_barrier(0); }
        { int cv_ = (f2sort(f0[3] + f1[0]) & ~255) | 207; INS16(Lv, cv_); __builtin_amdgcn_sched_barrier(0); }
        { int cv_ = (f2sort(f0[3] + f1[1]) & ~255) | 206; INS16(Lv, cv_); __builtin_amdgcn_sched_barrier(0); }
        { int cv_ = (f2sort(f0[3] + f1[2]) & ~255) | 205; INS16(Lv, cv_); __builtin_amdgcn_sched_barrier(0); }
        { int cv_ = (f2sort(f0[3] + f1[3]) & ~255) | 204; INS16(Lv, cv_); __builtin_amdgcn_sched_barrier(0); }
        { int cv_ = (f2sort(f0[4] + f1[0]) & ~255) | 191; INS16(Lv, cv_); __builtin_amdgcn_sched_barrier(0); }
        { int cv_ = (f2sort(f0[4] + f1[1]) & ~255) | 190; INS16(Lv, cv_); __builtin_amdgcn_sched_barrier(0); }
        { int cv_ = (f2sort(f0[4] + f1[2]) & ~255) | 189; INS16(Lv, cv_); __builtin_amdgcn_sched_barrier(0); }
        { int cv_ = (f2sort(f0[5] + f1[0]) & ~255) | 175; INS16(Lv, cv_); __builtin_amdgcn_sched_barrier(0); }
        { int cv_ = (f2sort(f0[5] + f1[1]) & ~255) | 174; INS16(Lv, cv_); __builtin_amdgcn_sched_barrier(0); }
        { int cv_ = (f2sort(f0[6] + f1[0]) & ~255) | 159; INS16(Lv, cv_); __builtin_amdgcn_sched_barrier(0); }
        { int cv_ = (f2sort(f0[6] + f1[1]) & ~255) | 158; INS16(Lv, cv_); __builtin_amdgcn_sched_barrier(0); }
        { int cv_ = (f2sort(f0[7] + f1[0]) & ~255) | 143; INS16(Lv, cv_); __builtin_amdgcn_sched_barrier(0); }
        { int cv_ = (f2sort(f0[7] + f1[1]) & ~255) | 142; INS16(Lv, cv_); __builtin_amdgcn_sched_barrier(0); }
        { int cv_ = (f2sort(f0[8] + f1[0]) & ~255) | 127; INS16(Lv, cv_); __builtin_amdgcn_sched_barrier(0); }
        { int cv_ = (f2sort(f0[9] + f1[0]) & ~255) | 111; INS16(Lv, cv_); __builtin_amdgcn_sched_barrier(0); }
        { int cv_ = (f2sort(f0[10] + f1[0]) & ~255) | 95; INS16(Lv, cv_); __builtin_amdgcn_sched_barrier(0); }
        { int cv_ = (f2sort(f0[11] + f1[0]) & ~255) | 79; INS16(Lv, cv_); __builtin_amdgcn_sched_barrier(0); }
        { int cv_ = (f2sort(f0[12] + f1[0]) & ~255) | 63; INS16(Lv, cv_); __builtin_amdgcn_sched_barrier(0); }
        { int cv_ = (f2sort(f0[13] + f1[0]) & ~255) | 47; INS16(Lv, cv_); __builtin_amdgcn_sched_barrier(0); }
        { int cv_ = (f2sort(f0[14] + f1[0]) & ~255) | 31; INS16(Lv, cv_); __builtin_amdgcn_sched_barrier(0); }
        { int cv_ = (f2sort(f0[15] + f1[0]) & ~255) | 15; INS16(Lv, cv_); __builtin_amdgcn_sched_barrier(0); }
        float g[16]; float sum = 0.f; const float mx = sort2f(Lv[0] & ~255);
        int Le[16];
#pragma unroll
        for (int i = 0; i < 16; ++i) {
            g[i] = __expf(sort2f(Lv[i] & ~255) - mx); sum += g[i];
            const int pos = 255 - (Lv[i] & 255);
            const int ia = *(const LAS unsigned char*)(tab + (pos >> 4)), ib = *(const LAS unsigned char*)(tab + 16 + (pos & 15));
            Le[i] = ia * 128 + ib;
        }
        const float inv = 1.f / sum;
        if (hi == 0) {
            int* ip = (int*)(p.ws + WS_IDX) + (size_t)(t0 + r32) * 128 + h * 16; float* gp = (float*)(p.ws + WS_GATE) + (size_t)(t0 + r32) * 128 + h * 16;
#pragma unroll
            for (int i = 0; i < 4; ++i) {
                *(u32x4*)(ip + 4 * i) = (u32x4){(unsigned)Le[4 * i], (unsigned)Le[4 * i + 1], (unsigned)Le[4 * i + 2], (unsigned)Le[4 * i + 3]};
                *(f32x4*)(gp + 4 * i) = (f32x4){g[4 * i] * inv, g[4 * i + 1] * inv, g[4 * i + 2] * inv, g[4 * i + 3] * inv};
            }
        }
        asm volatile("s_waitcnt lgkmcnt(0)" ::: "memory");
    }
}
__device__ __forceinline__ void ph_conv(const Params& p, int gwave, int gnw, int lane) {
    const bf16_t* proj = (const bf16_t*)(p.ws + WS_PROJ);
    bf16_t* xa = (bf16_t*)(p.ws + WS_XBCA);
    for (int task = gwave; task < 1536 + 256; task += gnw) {
        if (task < 1536) {
            const int run = task / 3, cg = (task % 3) * 64 + lane, c0 = cg * 8;
            const int t0 = run * 32, s0 = t0 % SEQ;
            float w0[8], w1[8], w2[8], w3[8], bs[8], h1[8], h2[8], h3[8];
#pragma unroll
            for (int i = 0; i < 8; ++i) { w0[i] = p.conv_w[0 * 1536 + c0 + i]; w1[i] = p.conv_w[1 * 1536 + c0 + i]; w2[i] = p.conv_w[2 * 1536 + c0 + i]; w3[i] = p.conv_w[3 * 1536 + c0 + i]; bs[i] = p.conv_b[c0 + i]; h1[i] = 0.f; h2[i] = 0.f; h3[i] = 0.f; }
            const bf16_t* src = proj + (size_t)t0 * NPROJ + C_XBC + c0;
            if (s0 > 0) {
                const u32x4 a = *(const u32x4*)(src - (size_t)1 * NPROJ), b = *(const u32x4*)(src - (size_t)2 * NPROJ), c = *(const u32x4*)(src - (size_t)3 * NPROJ);
                h1[0] = bflo(a.x); h1[1] = bfhi(a.x); h1[2] = bflo(a.y); h1[3] = bfhi(a.y); h1[4] = bflo(a.z); h1[5] = bfhi(a.z); h1[6] = bflo(a.w); h1[7] = bfhi(a.w);
                h2[0] = bflo(b.x); h2[1] = bfhi(b.x); h2[2] = bflo(b.y); h2[3] = bfhi(b.y); h2[4] = bflo(b.z); h2[5] = bfhi(b.z); h2[6] = bflo(b.w); h2[7] = bfhi(b.w);
                h3[0] = bflo(c.x); h3[1] = bfhi(c.x); h3[2] = bflo(c.y); h3[3] = bfhi(c.y); h3[4] = bflo(c.z); h3[5] = bfhi(c.z); h3[6] = bflo(c.w); h3[7] = bfhi(c.w);
            }
            bf16_t* dst = xa + (size_t)t0 * 1536 + c0;
#pragma unroll 16
            for (int i = 0; i < 32; ++i) {
                const u32x4 a = *(const u32x4*)(src + (size_t)i * NPROJ);
                float cur[8] = {bflo(a.x), bfhi(a.x), bflo(a.y), bfhi(a.y), bflo(a.z), bfhi(a.z), bflo(a.w), bfhi(a.w)};
                float o[8];
#pragma unroll
                for (int k = 0; k < 8; ++k) { o[k] = silu_fast(bs[k] + w3[k] * cur[k] + w2[k] * h1[k] + w1[k] * h2[k] + w0[k] * h3[k]); h3[k] = h2[k]; h2[k] = h1[k]; h1[k] = cur[k]; }
                u32x4 w; w.x = pk2(o[0], o[1]); w.y = pk2(o[2], o[3]); w.z = pk2(o[4], o[5]); w.w = pk2(o[6], o[7]);
                *(u32x4*)(dst + (size_t)i * 1536) = w;
            }
        } else {
            const int t = (task - 1536) * 64 + lane;
            const u32x4 a = *(const u32x4*)(proj + (size_t)t * NPROJ + C_DT), b = *(const u32x4*)(proj + (size_t)t * NPROJ + C_DT + 8);
            const float raw[16] = {bflo(a.x), bfhi(a.x), bflo(a.y), bfhi(a.y), bflo(a.z), bfhi(a.z), bflo(a.w), bfhi(a.w), bflo(b.x), bfhi(b.x), bflo(b.y), bfhi(b.y), bflo(b.z), bfhi(b.z), bflo(b.w), bfhi(b.w)};
            float* dto = (float*)(p.ws + WS_DT) + (size_t)t * 16; float* cso = (float*)(p.ws + WS_CS) + (size_t)t * 16;
            float dtv[16], csv[16];
#pragma unroll
            for (int hh = 0; hh < 16; ++hh) {
                const float v = raw[hh] + p.dt_bias[hh];
                const float dt = (v > 20.f) ? v : log1pf(__expf(v));
                float c = dt * (-__expf(p.a_log[hh]));
#pragma unroll
                for (int o = 1; o < 64; o <<= 1) { const float u = __shfl_up(c, o); if (lane >= o) c += u; }
                dtv[hh] = dt; csv[hh] = c;
            }
#pragma unroll
            for (int q = 0; q < 4; ++q) { *(f32x4*)(dto + 4 * q) = (f32x4){dtv[4 * q], dtv[4 * q + 1], dtv[4 * q + 2], dtv[4 * q + 3]}; *(f32x4*)(cso + 4 * q) = (f32x4){csv[4 * q], csv[4 * q + 1], csv[4 * q + 2], csv[4 * q + 3]}; }
        }
    }
}
constexpr int P4_ROW = 1152;
__device__ __forceinline__ void fp4_row_load(const Params& p, int row, int lane, f32x4 (&v)[8]) {
    const f32x4* src = (const f32x4*)(((row >= 16384) ? p.v_exp : p.u_exp) + (size_t)(row & 16383) * DM) + lane;
#pragma unroll
    for (int j = 0; j < 8; ++j) v[j] = src[64 * j];
}
__device__ __forceinline__ void fp4_row_store(const Params& p, int row, int lane, const f32x4 (&v)[8]) {
    float mx = 0.f;
#pragma unroll
    for (int j = 0; j < 8; ++j) mx = fmaxf(mx, fmaxf(fmaxf(fabsf(v[j].x), fabsf(v[j].y)), fmaxf(fabsf(v[j].z), fabsf(v[j].w))));
    unsigned sb = f2bf(mx * (1.f / 6.f));
    if (bf2f(sb) * 6.f < mx) sb += 1u;
    if (sb == 0u) sb = 0x3f80u;
    const float inv = 1.f / bf2f(sb);
    unsigned w[4];
#pragma unroll
    for (int q = 0; q < 4; ++q) {
        const f32x4 a = v[2 * q] * inv, b = v[2 * q + 1] * inv;
        unsigned r = 0u;
        r = __builtin_amdgcn_cvt_scalef32_pk_fp4_f32(r, a.x, a.y, 1.0f, 0);
        r = __builtin_amdgcn_cvt_scalef32_pk_fp4_f32(r, a.z, a.w, 1.0f, 1);
        r = __builtin_amdgcn_cvt_scalef32_pk_fp4_f32(r, b.x, b.y, 1.0f, 2);
        r = __builtin_amdgcn_cvt_scalef32_pk_fp4_f32(r, b.z, b.w, 1.0f, 3);
        w[q] = r;
    }
    unsigned char* dst = p.ws + ((row >= 16384) ? WS_V4 : WS_U4) + (size_t)(row & 16383) * P4_ROW;
    *(u32x4*)(dst + lane * 16) = (u32x4){w[0], w[1], w[2], w[3]};
    *(unsigned short*)(dst + 1024 + lane * 2) = (unsigned short)sb;
}
constexpr int SSD_IN = 41472, SSD_BM = 0, SSD_CM = 16384, SSD_XS = 32768, SSD_Z = 36864, SSD_DT = 40960, SSD_CS = 41216, SSD_ST = 3 * SSD_IN, SSD_PART = SSD_ST + 16384, SSD_SYNC = SSD_PART + 4096;
__device__ __forceinline__ void ssd_decay_block(f32x16& cbt, const LAS float* csl, const LAS float* dtl, float cs_l, int sb, int l, int hi, bool diag) {
#pragma unroll
    for (int q = 0; q < 4; ++q) {
        const f32x4 c4 = *(const LAS f32x4*)(csl + 32 * sb + 8 * q + 4 * hi), d4 = *(const LAS f32x4*)(dtl + 32 * sb + 8 * q + 4 * hi);
#pragma unroll
        for (int i = 0; i < 4; ++i) {
            const int s = 32 * sb + 8 * q + 4 * hi + i;
            float e = __expf(cs_l - c4[i]) * d4[i];
            if (diag) e = (s <= l) ? e : 0.f;
            cbt[4 * q + i] *= e;
        }
    }
}
__device__ __forceinline__ void ph_ssd(const Params& p, LAS unsigned char* ldsl, int bid, int wave, int lane) {
    const int b = bid >> 5, h = (bid >> 1) & 15, ph = bid & 1, g = h >> 3;
    const int r32 = lane & 31, hi = lane >> 5;
    const size_t tb0 = (size_t)b * SEQ;
    LAS unsigned* sync = (LAS unsigned*)(ldsl + SSD_SYNC);
    if (threadIdx.x < 16) sync[threadIdx.x] = (threadIdx.x >= 14) ? 0xffffffffu : 0u;
    for (int i = threadIdx.x; i < 8192 / 16; i += NTHR) *(LAS u32x4*)(ldsl + SSD_ST + i * 16) = (u32x4){0u, 0u, 0u, 0u};
    asm volatile("s_waitcnt lgkmcnt(0)" ::: "memory"); __builtin_amdgcn_s_barrier(); asm volatile("" ::: "memory");
    if (wave >= 6) {
        const int cvw = bid * 2 + (wave - 6);
        f32x4 ra[8], rb[8], rc[8], rd[8];
        fp4_row_load(p, cvw, lane, ra); fp4_row_load(p, 512 + cvw, lane, rb); fp4_row_load(p, 1024 + cvw, lane, rc); fp4_row_load(p, 1536 + cvw, lane, rd);
        for (int c = 0; c < 16; ++c) {
            fp4_row_store(p, (4 * c) * 512 + cvw, lane, ra);
            if (c + 1 < 16) fp4_row_load(p, (4 * c + 4) * 512 + cvw, lane, ra);
            fp4_row_store(p, (4 * c + 1) * 512 + cvw, lane, rb);
            if (c + 1 < 16) fp4_row_load(p, (4 * c + 5) * 512 + cvw, lane, rb);
            fp4_row_store(p, (4 * c + 2) * 512 + cvw, lane, rc);
            if (c + 1 < 16) fp4_row_load(p, (4 * c + 6) * 512 + cvw, lane, rc);
            fp4_row_store(p, (4 * c + 3) * 512 + cvw, lane, rd);
            if (c + 1 < 16) fp4_row_load(p, (4 * c + 7) * 512 + cvw, lane, rd);
        }
    } else {
        const bf16_t* xa = (const bf16_t*)(p.ws + WS_XBCA); const bf16_t* proj = (const bf16_t*)(p.ws + WS_PROJ);
        const float dsk = p.d_skip[h];
        const int dq = (wave - 2) & 3;
        const int dr0 = 4 * dq + (lane >> 4);
        const bf16_t* bsrc = xa + (tb0 + dr0) * 1536 + 1024 + g * 128 + (((lane & 15) ^ (dr0 & 15)) * 8);
        const bf16_t* csrc = xa + (tb0 + dr0) * 1536 + 1280 + g * 128 + (((lane & 15) ^ (dr0 & 15)) * 8);
        const bf16_t* xsrc = xa + (tb0 + 16 * dq + (lane >> 2)) * 1536 + h * 64 + ph * 32 + (lane & 3) * 8;
        const bf16_t* zsrc = proj + (tb0 + 16 * dq + (lane >> 2)) * NPROJ + C_Z + h * 64 + ph * 32 + (lane & 3) * 8;
        const float* dsrc = (const float*)(p.ws + ((dq == 0) ? WS_DT : WS_CS)) + (tb0 + lane) * 16 + h;
#define SSD_G16(src, dst) __builtin_amdgcn_global_load_lds((const unsigned*)(src), (LAS unsigned*)(dst), 16, 0, 0)
#define SSD_ISSUE(c, buf) do { if (wave >= 2) { LAS unsigned char* in_ = ldsl + (buf) * SSD_IN; const size_t to_ = (size_t)(c) * 64 * 1536; \
        SSD_G16(bsrc + to_, in_ + SSD_BM + dq * 1024); SSD_G16(bsrc + to_ + 16 * 1536, in_ + SSD_BM + (dq + 4) * 1024); SSD_G16(bsrc + to_ + 32 * 1536, in_ + SSD_BM + (dq + 8) * 1024); SSD_G16(bsrc + to_ + 48 * 1536, in_ + SSD_BM + (dq + 12) * 1024); \
        SSD_G16(csrc + to_, in_ + SSD_CM + dq * 1024); SSD_G16(csrc + to_ + 16 * 1536, in_ + SSD_CM + (dq + 4) * 1024); SSD_G16(csrc + to_ + 32 * 1536, in_ + SSD_CM + (dq + 8) * 1024); SSD_G16(csrc + to_ + 48 * 1536, in_ + SSD_CM + (dq + 12) * 1024); \
        SSD_G16(xsrc + to_, in_ + SSD_XS + dq * 1024); SSD_G16(zsrc + (size_t)(c) * 64 * NPROJ, in_ + SSD_Z + dq * 1024); \
        if (dq < 2) __builtin_amdgcn_global_load_lds((const unsigned*)(dsrc + (size_t)(c) * 64 * 16), (LAS unsigned*)(in_ + ((dq == 0) ? SSD_DT : SSD_CS)), 4, 0, 0); } } while (0)
        f32x16 S;
#pragma unroll
        for (int r = 0; r < 16; ++r) S[r] = 0.f;
        SSD_ISSUE(0, 0); SSD_ISSUE(1, 1);
        const int xfo = ((lane >> 4) & 1) * 32 + (lane & 3) * 8 + (4 * hi + ((lane & 15) >> 2)) * 64;
        for (int c = 0; c < SEQ / 64; ++c) {
            if (wave >= 2) { if (c + 1 >= SEQ / 64) asm volatile("s_waitcnt vmcnt(0)" ::: "memory"); else if (dq < 2) asm volatile("s_waitcnt vmcnt(11)" ::: "memory"); else asm volatile("s_waitcnt vmcnt(10)" ::: "memory"); }
            asm volatile("s_waitcnt lgkmcnt(0)" ::: "memory");
            {
                const unsigned sa = (unsigned)(size_t)(ldsl + SSD_SYNC), tgt = (unsigned)(c + 1);
                asm volatile("ds_write_b32 %0, %1" :: "v"(sa + 32u + 4u * (unsigned)wave), "v"(tgt) : "memory");
                for (;;) { u32x4 a, b_; asm volatile("ds_read_b128 %0, %2 offset:32\n\tds_read_b128 %1, %2 offset:48\n\ts_waitcnt lgkmcnt(0)" : "=&v"(a), "=&v"(b_) : "v"(sa) : "memory");
                    const unsigned m = min(min(min(a.x, a.y), min(a.z, a.w)), min(min(b_.x, b_.y), min(b_.z, b_.w)));
                    if (__builtin_amdgcn_readfirstlane(m) >= tgt) break; __builtin_amdgcn_s_sleep(1); }
            }
            asm volatile("" ::: "memory");
            if (c + 2 < SEQ / 64) SSD_ISSUE(c + 2, (c + 2) % 3);
            const LAS unsigned char* in = ldsl + (c % 3) * SSD_IN;
            const LAS unsigned char* STin = ldsl + SSD_ST + (c & 1) * 8192;
            LAS unsigned char* STout = ldsl + SSD_ST + ((c + 1) & 1) * 8192;
            const LAS float* dtl = (const LAS float*)(in + SSD_DT); const LAS float* csl = (const LAS float*)(in + SSD_CS);
            if (wave < 2) {
                const int lb = wave, l = 32 * lb + r32;
                if (wave == 0) {
                    const int l1 = 32 + r32; const float cs_l1 = csl[l1];
                    f32x16 ca, cb;
#pragma unroll
                    for (int r = 0; r < 16; ++r) { ca[r] = 0.f; cb[r] = 0.f; }
#pragma unroll
                    for (int ks = 0; ks < 8; ks += 2) {
                        ca = __builtin_amdgcn_mfma_f32_32x32x16_bf16(*(const LAS bf16x8*)(in + SSD_BM + r32 * 256 + (((2 * ks + hi) ^ (r32 & 15)) << 4)), *(const LAS bf16x8*)(in + SSD_CM + l1 * 256 + (((2 * ks + hi) ^ (l1 & 15)) << 4)), ca, 0, 0, 0);
                        cb = __builtin_amdgcn_mfma_f32_32x32x16_bf16(*(const LAS bf16x8*)(in + SSD_BM + r32 * 256 + (((2 * ks + 2 + hi) ^ (r32 & 15)) << 4)), *(const LAS bf16x8*)(in + SSD_CM + l1 * 256 + (((2 * ks + 2 + hi) ^ (l1 & 15)) << 4)), cb, 0, 0, 0);
                    }
                    ca += cb;
                    ssd_decay_block(ca, csl, dtl, cs_l1, 0, l1, hi, false);
                    u32x4 w0, w1;
                    w0.x = cvtpk(ca[0], ca[1]); w0.y = cvtpk(ca[2], ca[3]); w0.z = cvtpk(ca[4], ca[5]); w0.w = cvtpk(ca[6], ca[7]);
                    w1.x = cvtpk(ca[8], ca[9]); w1.y = cvtpk(ca[10], ca[11]); w1.z = cvtpk(ca[12], ca[13]); w1.w = cvtpk(ca[14], ca[15]);
                    const unsigned xpa = (unsigned)(size_t)(in + SSD_XS + xfo);
                    f32x16 pa;
#pragma unroll
                    for (int r = 0; r < 16; ++r) pa[r] = 0.f;
                    { s16x4 lo0, hh0, lo1, hh1; TR_PAIR(lo0, hh0, xpa, 0, 512); TR_PAIR(lo1, hh1, xpa, 1024, 512); LDS_WAIT_PIN();
                      pa = __builtin_amdgcn_mfma_f32_32x32x16_bf16((bf16x8){lo0[0], lo0[1], lo0[2], lo0[3], hh0[0], hh0[1], hh0[2], hh0[3]}, __builtin_bit_cast(bf16x8, w0), pa, 0, 0, 0);
                      pa = __builtin_amdgcn_mfma_f32_32x32x16_bf16((bf16x8){lo1[0], lo1[1], lo1[2], lo1[3], hh1[0], hh1[1], hh1[2], hh1[3]}, __builtin_bit_cast(bf16x8, w1), pa, 0, 0, 0); }
                    LAS unsigned char* pp = ldsl + SSD_PART + lane * 64;
#pragma unroll
                    for (int q = 0; q < 4; ++q) *(LAS f32x4*)(pp + q * 16) = (f32x4){pa[4 * q], pa[4 * q + 1], pa[4 * q + 2], pa[4 * q + 3]};
                    asm volatile("s_waitcnt lgkmcnt(0)" ::: "memory");
                    asm volatile("ds_write_b32 %0, %1" :: "v"((unsigned)(size_t)(ldsl + SSD_SYNC) + 4u), "v"((unsigned)(c + 1)) : "memory");
                }
                const float cs_l = csl[l];
                bf16x8 cf[8];
#pragma unroll
                for (int ks = 0; ks < 8; ++ks) cf[ks] = *(const LAS bf16x8*)(in + SSD_CM + l * 256 + (((2 * ks + hi) ^ (l & 15)) << 4));
                f32x16 acc, acc2;
#pragma unroll
                for (int r = 0; r < 16; ++r) { acc[r] = 0.f; acc2[r] = 0.f; }
#pragma unroll
                for (int ks = 0; ks < 8; ks += 2) {
                    acc = __builtin_amdgcn_mfma_f32_32x32x16_bf16(*(const LAS bf16x8*)(STin + (2 * ks + hi) * 512 + r32 * 16), cf[ks], acc, 0, 0, 0);
                    acc2 = __builtin_amdgcn_mfma_f32_32x32x16_bf16(*(const LAS bf16x8*)(STin + (2 * ks + 2 + hi) * 512 + r32 * 16), cf[ks + 1], acc2, 0, 0, 0);
                }
                { const float ecs = __expf(cs_l);
#pragma unroll
                  for (int r = 0; r < 16; ++r) acc[r] = (acc[r] + acc2[r]) * ecs; }
                {
                    f32x16 ca, cb;
#pragma unroll
                    for (int r = 0; r < 16; ++r) { ca[r] = 0.f; cb[r] = 0.f; }
#pragma unroll
                    for (int ks = 0; ks < 8; ks += 2) {
                        ca = __builtin_amdgcn_mfma_f32_32x32x16_bf16(*(const LAS bf16x8*)(in + SSD_BM + l * 256 + (((2 * ks + hi) ^ (l & 15)) << 4)), cf[ks], ca, 0, 0, 0);
                        cb = __builtin_amdgcn_mfma_f32_32x32x16_bf16(*(const LAS bf16x8*)(in + SSD_BM + l * 256 + (((2 * ks + 2 + hi) ^ (l & 15)) << 4)), cf[ks + 1], cb, 0, 0, 0);
                    }
                    ca += cb;
                    ssd_decay_block(ca, csl, dtl, cs_l, lb, l, hi, true);
                    u32x4 w0, w1;
                    w0.x = cvtpk(ca[0], ca[1]); w0.y = cvtpk(ca[2], ca[3]); w0.z = cvtpk(ca[4], ca[5]); w0.w = cvtpk(ca[6], ca[7]);
                    w1.x = cvtpk(ca[8], ca[9]); w1.y = cvtpk(ca[10], ca[11]); w1.z = cvtpk(ca[12], ca[13]); w1.w = cvtpk(ca[14], ca[15]);
                    const unsigned xpa = (unsigned)(size_t)(in + SSD_XS + xfo + (32 * lb) * 64);
                    { s16x4 lo0, hh0, lo1, hh1; TR_PAIR(lo0, hh0, xpa, 0, 512); TR_PAIR(lo1, hh1, xpa, 1024, 512); LDS_WAIT_PIN();
                      acc = __builtin_amdgcn_mfma_f32_32x32x16_bf16((bf16x8){lo0[0], lo0[1], lo0[2], lo0[3], hh0[0], hh0[1], hh0[2], hh0[3]}, __builtin_bit_cast(bf16x8, w0), acc, 0, 0, 0);
                      acc = __builtin_amdgcn_mfma_f32_32x32x16_bf16((bf16x8){lo1[0], lo1[1], lo1[2], lo1[3], hh1[0], hh1[1], hh1[2], hh1[3]}, __builtin_bit_cast(bf16x8, w1), acc, 0, 0, 0); }
                }
                if (wave == 1) {
                    for (;;) { unsigned fl; asm volatile("ds_read_b32 %0, %1 offset:4\n\ts_waitcnt lgkmcnt(0)" : "=&v"(fl) : "v"((unsigned)(size_t)(ldsl + SSD_SYNC)) : "memory");
                        if (__builtin_amdgcn_readfirstlane(fl) >= (unsigned)(c + 1)) break; __builtin_amdgcn_s_sleep(1); }
                    asm volatile("" ::: "memory");
                    const LAS unsigned char* pp = ldsl + SSD_PART + lane * 64;
#pragma unroll
                    for (int q = 0; q < 4; ++q) { const f32x4 v = *(const LAS f32x4*)(pp + q * 16); acc[4 * q] += v[0]; acc[4 * q + 1] += v[1]; acc[4 * q + 2] += v[2]; acc[4 * q + 3] += v[3]; }
                }
                bf16_t* yo = (bf16_t*)(p.ws + WS_YSSD) + (tb0 + (size_t)c * 64 + l) * 1024 + h * 64 + ph * 32 + 4 * hi;
#pragma unroll
                for (int q = 0; q < 4; ++q) {
                    const u32x2 xw = *(const LAS u32x2*)(in + SSD_XS + l * 64 + (8 * q + 4 * hi) * 2), zw = *(const LAS u32x2*)(in + SSD_Z + l * 64 + (8 * q + 4 * hi) * 2);
                    const float y0 = (acc[4 * q + 0] + dsk * bflo(xw.x)) * silu_fast(bflo(zw.x)), y1 = (acc[4 * q + 1] + dsk * bfhi(xw.x)) * silu_fast(bfhi(zw.x));
                    const float y2 = (acc[4 * q + 2] + dsk * bflo(xw.y)) * silu_fast(bflo(zw.y)), y3 = (acc[4 * q + 3] + dsk * bfhi(xw.y)) * silu_fast(bfhi(zw.y));
                    u32x2 o; o.x = pk2(y0, y1); o.y = pk2(y2, y3);
                    *(u32x2*)(yo + 8 * q) = o;
                }
            } else {
                const int nb = wave - 2;
                const float cs63 = csl[63];
                { const float dec = __expf(cs63);
#pragma unroll
                  for (int r = 0; r < 16; ++r) S[r] *= dec; }
                const int brow = 4 * hi + ((lane & 15) >> 2), bch = 4 * nb + 2 * ((lane >> 4) & 1) + ((lane & 3) >> 1);
                const unsigned xpa = (unsigned)(size_t)(in + xfo);
                const unsigned bpa = (unsigned)(size_t)(in + SSD_BM + brow * 256 + ((bch ^ brow) << 4) + (lane & 1) * 8);
                const unsigned bpb = (unsigned)(size_t)(in + SSD_BM + (brow + 8) * 256 + ((bch ^ (brow + 8)) << 4) + (lane & 1) * 8);
#pragma unroll
                for (int ks = 0; ks < 4; ++ks) {
                    s16x4 lo, hh, blo, bhh;
                    TR_PAIR(lo, hh, xpa, SSD_XS + (16 * ks) * 64, 512);
                    asm volatile("ds_read_b64_tr_b16 %0, %1 offset:%c2" : "=&v"(blo) : "v"(bpa), "i"((16 * ks) * 256) : "memory");
                    asm volatile("ds_read_b64_tr_b16 %0, %1 offset:%c2" : "=&v"(bhh) : "v"(bpb), "i"((16 * ks) * 256) : "memory");
                    const f32x4 c0 = *(const LAS f32x4*)(csl + 16 * ks + 4 * hi), c1 = *(const LAS f32x4*)(csl + 16 * ks + 8 + 4 * hi);
                    const f32x4 d0 = *(const LAS f32x4*)(dtl + 16 * ks + 4 * hi), d1 = *(const LAS f32x4*)(dtl + 16 * ks + 8 + 4 * hi);
                    LDS_WAIT_PIN();
                    float xf[8];
#pragma unroll
                    for (int j = 0; j < 4; ++j) { xf[j] = bf2f((unsigned short)lo[j]) * __expf(cs63 - c0[j]) * d0[j]; xf[4 + j] = bf2f((unsigned short)hh[j]) * __expf(cs63 - c1[j]) * d1[j]; }
                    u32x4 aw; aw.x = cvtpk(xf[0], xf[1]); aw.y = cvtpk(xf[2], xf[3]); aw.z = cvtpk(xf[4], xf[5]); aw.w = cvtpk(xf[6], xf[7]);
                    S = __builtin_amdgcn_mfma_f32_32x32x16_bf16(__builtin_bit_cast(bf16x8, aw), (bf16x8){blo[0], blo[1], blo[2], blo[3], bhh[0], bhh[1], bhh[2], bhh[3]}, S, 0, 0, 0);
                }
                const int n = 32 * nb + r32;
#pragma unroll
                for (int r = 0; r < 16; ++r) *(LAS unsigned short*)(STout + (n >> 3) * 512 + crow(r, hi) * 16 + (n & 7) * 2) = (unsigned short)f2bf(S[r]);
            }
        }
#undef SSD_ISSUE
#undef SSD_G16
    }
    asm volatile("s_waitcnt vmcnt(0) lgkmcnt(0)" ::: "memory");
    __builtin_amdgcn_s_barrier(); asm volatile("" ::: "memory");
}
__device__ __forceinline__ void ph_peer4(const Params& p, LAS unsigned char* ldsl, int wave, int lane, int gwave, int gnw) {
    LAS unsigned char* ring = ldsl + wave * 16384;
    const unsigned char* U = (const unsigned char*)(p.ws + WS_U4); const unsigned char* V = (const unsigned char*)(p.ws + WS_V4);
    const int e_lane = (lane >> 2) & 15; const unsigned lane16 = (unsigned)lane * 16u, lanesc = 1024u + (unsigned)(lane >> 1) * 4u;
#define P4_ISSUE(R) do { const int R_ = (R); const int i_ = ((R_ >> 5) << 4) + (R_ & 15); \
        const int e_ = (i_ < 64) ? __builtin_amdgcn_readlane(idx0, i_) : __builtin_amdgcn_readlane(idx1, i_ - 64); \
        const unsigned char* base_ = (((R_ >> 4) & 1) ? V : U) + (size_t)(unsigned)e_ * P4_ROW; \
        LAS unsigned char* dst_ = ring + (R_ & 7) * 1280; \
        __builtin_amdgcn_global_load_lds((const unsigned*)(base_ + lane16), (LAS unsigned*)(dst_), 16, 0, 0); \
        __builtin_amdgcn_global_load_lds((const unsigned*)(base_ + lanesc), (LAS unsigned*)(dst_ + 1024), 4, 0, 0); } while (0)
#define P4_WAIT(n) asm volatile("s_waitcnt vmcnt(" #n ")" ::: "memory")
#define P4_CVT(wd, bs) __builtin_amdgcn_cvt_scalef32_pk_f32_fp4((wd), 1.0f, (bs))
    for (int t = gwave; t < T; t += gnw) {
        const int b = t / SEQ;
        const int idx0 = ((const int*)(p.ws + WS_IDX))[(size_t)t * 128 + lane], idx1 = ((const int*)(p.ws + WS_IDX))[(size_t)t * 128 + 64 + lane];
        float gv0 = ((const float*)(p.ws + WS_GATE))[(size_t)t * 128 + lane], gv1 = ((const float*)(p.ws + WS_GATE))[(size_t)t * 128 + 64 + lane];
        f32x2_t hf[16];
        {
            const float pq = (lane < 32) ? ((const float*)(p.ws + WS_PSQX))[(size_t)t * 32 + lane] : 0.f;
            const float r2 = rsqrtf(wave_sum(pq) * (1.f / DM) + EPS);
            const bf16_t* hp = (const bf16_t*)(p.ws + WS_X1M) + (size_t)t * DM + lane * 4;
            const float* shp = (const float*)(p.ws + WS_MOD) + (size_t)b * 6 * DM + 3 * DM + lane * 4;
#pragma unroll
            for (int j = 0; j < 8; ++j) { const u32x2 a = *(const u32x2*)(hp + j * 256); const f32x4 sh = *(const f32x4*)(shp + j * 256);
                hf[2 * j] = (f32x2_t){bflo(a.x) * r2 + sh[0], bfhi(a.x) * r2 + sh[1]}; hf[2 * j + 1] = (f32x2_t){bflo(a.y) * r2 + sh[2], bfhi(a.y) * r2 + sh[3]}; }
        }
        f32x2_t out[16];
#pragma unroll
        for (int i = 0; i < 16; ++i) out[i] = (f32x2_t){0.f, 0.f};
        asm volatile("" : "+v"(gv0), "+v"(gv1));
        P4_ISSUE(0); P4_ISSUE(1); P4_ISSUE(2); P4_ISSUE(3); P4_ISSUE(4); P4_ISSUE(5); P4_ISSUE(6);
        for (int hh = 0; hh < 8; ++hh) {
            float pd[16];
#pragma unroll
            for (int k = 0; k < 16; ++k) {
                P4_ISSUE(hh * 32 + k + 7); P4_WAIT(14);
                const LAS unsigned char* sl = ring + (k & 7) * 1280;
                const u32x4 w = *(const LAS u32x4*)(sl + lane * 16);
                const unsigned sw = *(const LAS unsigned*)(sl + 1024 + lane * 4);
                const float scl = (lane & 1) ? bfhi(sw) : bflo(sw);
                f32x2_t a2 = (f32x2_t){0.f, 0.f};
                a2 += P4_CVT(w.x, 0) * hf[0]; a2 += P4_CVT(w.x, 1) * hf[1]; a2 += P4_CVT(w.x, 2) * hf[2]; a2 += P4_CVT(w.x, 3) * hf[3];
                a2 += P4_CVT(w.y, 0) * hf[4]; a2 += P4_CVT(w.y, 1) * hf[5]; a2 += P4_CVT(w.y, 2) * hf[6]; a2 += P4_CVT(w.y, 3) * hf[7];
                a2 += P4_CVT(w.z, 0) * hf[8]; a2 += P4_CVT(w.z, 1) * hf[9]; a2 += P4_CVT(w.z, 2) * hf[10]; a2 += P4_CVT(w.z, 3) * hf[11];
                a2 += P4_CVT(w.w, 0) * hf[12]; a2 += P4_CVT(w.w, 1) * hf[13]; a2 += P4_CVT(w.w, 2) * hf[14]; a2 += P4_CVT(w.w, 3) * hf[15];
                float a = (a2.x + a2.y) * scl;
                asm volatile("" : "+v"(a));
                pd[k] = a;
            }
            float q8[8], q4[4], q2[2], q1;
            { const bool hi = (lane & 32) != 0;
#pragma unroll
              for (int i = 0; i < 8; ++i) { const float keep = hi ? pd[i + 8] : pd[i], send = hi ? pd[i] : pd[i + 8]; q8[i] = keep + __shfl_xor(send, 32); } }
            { const bool hi = (lane & 16) != 0;
#pragma unroll
              for (int i = 0; i < 4; ++i) { const float keep = hi ? q8[i + 4] : q8[i], send = hi ? q8[i] : q8[i + 4]; q4[i] = keep + __shfl_xor(send, 16); } }
            { const bool hi = (lane & 8) != 0;
#pragma unroll
              for (int i = 0; i < 2; ++i) { const float keep = hi ? q4[i + 2] : q4[i], send = hi ? q4[i] : q4[i + 2]; q2[i] = keep + __shfl_xor(send, 8); } }
            { const bool hi = (lane & 4) != 0; const float keep = hi ? q2[1] : q2[0], send = hi ? q2[0] : q2[1]; q1 = keep + __shfl_xor(send, 4); }
            q1 += __shfl_xor(q1, 1); q1 += __shfl_xor(q1, 2);
            const float act = 0.5f * q1 * (1.f + erff(q1 * 0.70710678118654752f)) * __shfl((hh < 4) ? gv0 : gv1, (hh & 3) * 16 + e_lane);
#pragma unroll
            for (int k = 0; k < 16; ++k) {
                if (k < 9) { P4_ISSUE(hh * 32 + 16 + k + 7); P4_WAIT(14); }
                else if (hh < 7) { P4_ISSUE(hh * 32 + 16 + k + 7); P4_WAIT(14); }
                else if (k == 9) P4_WAIT(12); else if (k == 10) P4_WAIT(10); else if (k == 11) P4_WAIT(8); else if (k == 12) P4_WAIT(6); else if (k == 13) P4_WAIT(4); else if (k == 14) P4_WAIT(2); else P4_WAIT(0);
                const LAS unsigned char* sl = ring + (k & 7) * 1280;
                const u32x4 w = *(const LAS u32x4*)(sl + lane * 16);
                const unsigned sw = *(const LAS unsigned*)(sl + 1024 + lane * 4);
                const float a = __builtin_bit_cast(float, __builtin_amdgcn_readlane(__builtin_bit_cast(int, act), 4 * k)) * ((lane & 1) ? bfhi(sw) : bflo(sw));
                const f32x2_t aa = (f32x2_t){a, a};
                out[0] += aa * P4_CVT(w.x, 0); out[1] += aa * P4_CVT(w.x, 1); out[2] += aa * P4_CVT(w.x, 2); out[3] += aa * P4_CVT(w.x, 3);
                out[4] += aa * P4_CVT(w.y, 0); out[5] += aa * P4_CVT(w.y, 1); out[6] += aa * P4_CVT(w.y, 2); out[7] += aa * P4_CVT(w.y, 3);
                asm volatile("" : "+v"(out[0]), "+v"(out[1]), "+v"(out[2]), "+v"(out[3]), "+v"(out[4]), "+v"(out[5]), "+v"(out[6]), "+v"(out[7]));
                out[8] += aa * P4_CVT(w.z, 0); out[9] += aa * P4_CVT(w.z, 1); out[10] += aa * P4_CVT(w.z, 2); out[11] += aa * P4_CVT(w.z, 3);
                out[12] += aa * P4_CVT(w.w, 0); out[13] += aa * P4_CVT(w.w, 1); out[14] += aa * P4_CVT(w.w, 2); out[15] += aa * P4_CVT(w.w, 3);
                asm volatile("" : "+v"(out[8]), "+v"(out[9]), "+v"(out[10]), "+v"(out[11]), "+v"(out[12]), "+v"(out[13]), "+v"(out[14]), "+v"(out[15]));
            }
        }
        const float* g2 = (const float*)(p.ws + WS_MOD) + (size_t)b * 6 * DM + 5 * DM; const float* s2 = (const float*)(p.ws + WS_MOD) + (size_t)b * 6 * DM + 4 * DM;
        const bf16_t* xmp = (const bf16_t*)(p.ws + WS_X1M) + (size_t)t * DM;
        float* outp = p.out + (size_t)t * DM;
#pragma unroll
        for (int j = 0; j < 8; ++j) {
            const int c = j * 256 + lane * 4;
            const u32x2 xm = *(const u32x2*)(xmp + c); const f32x4 ga = *(const f32x4*)(g2 + c), sc = *(const f32x4*)(s2 + c);
            *(f32x4*)(outp + c) = (f32x4){bflo(xm.x) / (1.f + sc.x) + ga.x * out[2 * j].x, bfhi(xm.x) / (1.f + sc.y) + ga.y * out[2 * j].y,
                                          bflo(xm.y) / (1.f + sc.z) + ga.z * out[2 * j + 1].x, bfhi(xm.y) / (1.f + sc.w) + ga.w * out[2 * j + 1].y};
        }
    }
#undef P4_ISSUE
#undef P4_WAIT
#undef P4_CVT
}
constexpr int RING_BYTES = 131072, LDSCTL_OFF = 146432, MISC_OFF = LDSCTL_OFF + 320, LDS_BYTES = 147456;
static_assert(SSD_SYNC + 64 <= LDSCTL_OFF, "SSD LDS map");
constexpr int NPH = 13;
#ifndef MK_PER_PHASE
#define MK_PER_PHASE 0
#endif

__global__ void __launch_bounds__(NTHR, 2) mega(Params p) {
    extern __shared__ __attribute__((aligned(16))) unsigned char lds[];
    LAS unsigned char* ldsl = (LAS unsigned char*)lds;
    const int tid = threadIdx.x, lane = tid & 63, wave = __builtin_amdgcn_readfirstlane(tid >> 6);
    const int G = gridDim.x, bid = blockIdx.x;
    unsigned char* ws = p.ws;
    gu32* ctl = (gu32*)(ws + WS_CTL);
    for (int u = tid; u < (LDS_BYTES - LDSCTL_OFF) / 4; u += NTHR) ((LAS unsigned*)(ldsl + LDSCTL_OFF))[u] = 0u;
    __syncthreads();
    volatile LAS unsigned* MISC = (volatile LAS unsigned*)(ldsl + MISC_OFF);
    XcdBarrier bar; bar.bar = (unsigned*)(ctl + CW_BAR); bar.x = 0; bar.st = nullptr;
    if (!MK_PER_PHASE) bar = xcd_barrier_post((unsigned*)(ctl + CW_BAR), MISC + 8);
#define IN(k) (p.ph_lo <= (k) && (k) < p.ph_hi)
#define LN() ({ int l_ = lane; asm volatile("" : "+v"(l_)); l_; })
#define WV() ({ int w_ = wave; asm volatile("" : "+s"(w_)); w_; })
#define SEAM(k) do { if ((k) + 1 < p.ph_hi) xcd_barrier(bar); } while (0)
    const int gtid = bid * NTHR + tid, gn = G * NTHR, gwave = bid * NWAVES + wave, gnw = G * NWAVES;
    float* mod = (float*)(ws + WS_MOD);

    if (IN(0)) {
        if (bid < 96) ph_mod(p, lds, tid, bid);
        else ph_transposes(p, lds, WV(), LN(), (bid - 96) * NWAVES + wave, (G - 96) * NWAVES);
        ph_rope_tab(p, gtid, gn);
        ph_convert(p.sub_keys, (bf16_t*)(ws + WS_SUBK), (size_t)8 * 2 * 128 * 128 / 4, gtid, gn);
        SEAM(0);
    }
    if (IN(1)) { ph_modrows(p.x, (bf16_t*)(ws + WS_H), mod, 0, 1, gwave, gnw, LN()); ph_bias2(p, gwave, gnw, LN()); SEAM(1); }
    if (IN(2)) {
        pg8::Gemm g{(const bf16_t*)(ws + WS_H), (const bf16_t*)(ws + WS_WINT), T, NPROJ, DM, DM}; pg8::StaticOrder S; S.init(T, NPROJ, G, bid);
        pg8::EpiBf16<0> E{(bf16_t*)(ws + WS_PROJ), NPROJ, nullptr, 0, 0, 1.f};
        pg8::gemm_phase<pg8::EpiBf16<0>, pg8::StaticOrder, true, true>(ldsl, g, S, E);
        SEAM(2);
    }
    if (IN(3)) {
        { pg8::Gemm g{(const bf16_t*)(ws + WS_PROJ) + C_CQ, (const bf16_t*)(ws + WS_WUQT), T, NQ, 512, NPROJ}; pg8::StaticOrder S; S.init(T, NQ, G, bid);
          pg8::EpiBf16<0> E{(bf16_t*)(ws + WS_QRAW), NQ, nullptr, 0, 0, 1.f};
          pg8::gemm_phase<pg8::EpiBf16<0>, pg8::StaticOrder, true, true>(ldsl, g, S, E); }
        { pg8::Gemm g{(const bf16_t*)(ws + WS_PROJ) + C_CKV, (const bf16_t*)(ws + WS_WUKVT), T, NKV, 256, NPROJ}; pg8::StaticOrder S; S.init(T, NKV, G, bid);
          pg8::EpiBf16<0> E{(bf16_t*)(ws + WS_KVRAW), NKV, nullptr, 0, 0, 1.f};
          pg8::gemm_phase<pg8::EpiBf16<0>, pg8::StaticOrder, true, true>(ldsl, g, S, E); }
        SEAM(3);
    }
    if (IN(4)) { ph_qkv_post(p, gwave, gnw, LN()); ph_conv(p, gwave, gnw, LN()); SEAM(4); }
    if (IN(5)) { ph_attn(p, ldsl, bid, G, WV(), LN()); ph_ssd(p, ldsl, bid, WV(), LN()); SEAM(5); }
    if (IN(7)) { ph_mixnorm(p, gwave, gnw, LN()); SEAM(7); }
    if (IN(8)) {
        pg8::Gemm g{(const bf16_t*)(ws + WS_MIXIN), (const bf16_t*)(ws + WS_WOUTT), T, DM, DM, DM}; pg8::StaticOrder S; S.init(T, DM, G, bid);
        pg8::EpiX1 E{p.x, mod, (bf16_t*)(ws + WS_X1M), (float*)(ws + WS_PSQX), DM, SEQ};
        pg8::gemm_phase<pg8::EpiX1, pg8::StaticOrder, true, true>(ldsl, g, S, E);
        SEAM(8);
    }
    if (IN(10)) {
        pg8::Gemm g{(const bf16_t*)(ws + WS_X1M), (const bf16_t*)(ws + WS_WQT), T, DM, DM, DM}; pg8::StaticOrder S; S.init(T, DM, G, bid);
        pg8::Unit u0, u1; S.next(0, u0); if (!S.next(1, u1)) u1 = u0;
        LAS float* rt = (LAS float*)(ldsl + RING_BYTES);
        { const int slot = tid >> 8, r = tid & 255, row = (slot ? u1.pm : u0.pm) * 256 + r; const f32x4* pq = (const f32x4*)((const float*)(ws + WS_PSQX) + (size_t)row * 32); float s_ = 0.f;
#pragma unroll
          for (int q = 0; q < 8; ++q) { const f32x4 v = pq[q]; s_ += (v[0] + v[1]) + (v[2] + v[3]); }
          rt[tid] = rsqrtf(s_ * (1.f / DM) + EPS); }
        __syncthreads();
        pg8::EpiScaleBias E{(bf16_t*)(ws + WS_QP), DM, (const float*)(ws + WS_BIAS2), SEQ, rt, u0.pm};
        pg8::gemm_phase<pg8::EpiScaleBias, pg8::StaticOrder, true, true>(ldsl, g, S, E);
        SEAM(10);
    }
    if (IN(11)) { ph_route(p, ldsl, WV(), LN(), gwave, gnw); SEAM(11); }
    if (IN(12)) { ph_peer4(p, ldsl, WV(), LN(), gwave, gnw); }
#undef IN
#undef SEAM
}

extern "C" void kernel_launch(void* const* d_in, const int* in_sizes, int n_in, void* d_out, int out_size, void* d_ws, size_t ws_size, hipStream_t stream) {
    static int grid = 0;
    if (grid == 0) {
        if (n_in != 24 || ws_size < WS_END) { fprintf(stderr, "kernel_launch: unexpected inputs / workspace (%d, %zu)\n", n_in, ws_size); grid = -1; return; }
        if (hipFuncSetAttribute((const void*)mega, hipFuncAttributeMaxDynamicSharedMemorySize, LDS_BYTES) != hipSuccess) { fprintf(stderr, "kernel_launch: hipFuncSetAttribute failed\n"); grid = -1; return; }
        (void)hipGetLastError();
        grid = 256;
    }
    if (grid < 0) return;
    (void)hipMemsetAsync((char*)d_ws + WS_CTL, 0, CTL_ZERO_BYTES, stream);
    Params p{};
    p.x = (const float*)d_in[0]; p.c = (const float*)d_in[1]; p.pos = (const int*)d_in[2]; p.w_ada = (const float*)d_in[3]; p.b_ada = (const float*)d_in[4];
    p.w_in = (const float*)d_in[5]; p.q_a_norm = (const float*)d_in[6]; p.w_uq = (const float*)d_in[7]; p.kv_a_norm = (const float*)d_in[8]; p.w_ukv = (const float*)d_in[9];
    p.q_norm = (const float*)d_in[10]; p.k_norm = (const float*)d_in[11]; p.attn_out_norm = (const float*)d_in[12]; p.conv_w = (const float*)d_in[13]; p.conv_b = (const float*)d_in[14];
    p.dt_bias = (const float*)d_in[15]; p.a_log = (const float*)d_in[16]; p.d_skip = (const float*)d_in[17]; p.ssd_norm = (const float*)d_in[18]; p.w_out = (const float*)d_in[19];
    p.w_query = (const float*)d_in[20]; p.sub_keys = (const float*)d_in[21]; p.u_exp = (const float*)d_in[22]; p.v_exp = (const float*)d_in[23];
    p.out = (float*)d_out; p.ws = (unsigned char*)d_ws;
#if MK_PER_PHASE
    for (int ph = 0; ph < NPH; ++ph) { p.ph_lo = ph; p.ph_hi = ph + 1; hipLaunchKernelGGL(mega, dim3(grid), dim3(NTHR), LDS_BYTES, stream, p); }
#elif defined(PROBE_SEQ)
    { const int seq[] = {PROBE_SEQ}; const int nl = (int)(sizeof(seq) / sizeof(int)) / 2;
      for (int li = 0; li < nl; ++li) { if (li) (void)hipMemsetAsync((char*)d_ws + WS_CTL, 0, CTL_ZERO_BYTES, stream);
          p.ph_lo = seq[2 * li]; p.ph_hi = seq[2 * li + 1]; hipLaunchKernelGGL(mega, dim3(grid), dim3(NTHR), LDS_BYTES, stream, p); } }
#else
    p.ph_lo = 0; p.ph_hi = NPH;
    hipLaunchKernelGGL(mega, dim3(grid), dim3(NTHR), LDS_BYTES, stream, p);
#endif
}
```

```cpp
#include <hip/hip_runtime.h>
#include <cstdint>
#include <cstdio>
#include <cmath>

constexpr int DM = 2048, NB = 8, SEQ = 2048, T = NB * SEQ;
constexpr int IN_COLS = 3408, NPROJ = 3584;
constexpr int C_CQ = 0, C_CKV = 512, C_KR = 768, C_Z = 832, C_XBC = 1856, C_DT = 3392;
constexpr int NQ = 1536, NKV = 2048;
constexpr float EPS = 1e-6f;
constexpr int NTHR = 512, NWAVES = 8;

typedef unsigned short bf16_t;
typedef unsigned u32x4 __attribute__((ext_vector_type(4)));
typedef float f32x4 __attribute__((ext_vector_type(4)));
typedef unsigned u32x2 __attribute__((ext_vector_type(2)));
#define GAS __attribute__((address_space(1)))
#define LAS __attribute__((address_space(3)))
typedef GAS unsigned gu32;
typedef GAS unsigned long long gu64;
#define RLX_AGENT __ATOMIC_RELAXED, __HIP_MEMORY_SCOPE_AGENT

__device__ __forceinline__ unsigned f2bf(float f) { unsigned u = __builtin_bit_cast(unsigned, f); return (u + 0x7fffu + ((u >> 16) & 1u)) >> 16; }
__device__ __forceinline__ float bf2f(unsigned h) { return __builtin_bit_cast(float, h << 16); }
__device__ __forceinline__ unsigned pk2(float lo, float hi) { return f2bf(lo) | (f2bf(hi) << 16); }
__device__ __forceinline__ float bflo(unsigned w) { return __builtin_bit_cast(float, w << 16); }
__device__ __forceinline__ float bfhi(unsigned w) { return __builtin_bit_cast(float, w & 0xffff0000u); }
__device__ __forceinline__ float silu_f(float v) { return v / (1.f + __expf(-v)); }
__device__ __forceinline__ float wave_sum(float v) {
#pragma unroll
    for (int o = 1; o < 64; o <<= 1) v += __shfl_xor(v, o);
    return v;
}

constexpr size_t MiB = 1u << 20;
constexpr size_t WS_CTL = 0, CTL_ZERO_BYTES = 64 * 1024, WS_MOD = 1 * MiB, WS_ROPEC = 2 * MiB, WS_ROPES = 4 * MiB, WS_SUBK = 6 * MiB, WS_WUQT = 7 * MiB, WS_WUKVT = 9 * MiB,
                 WS_WINT = 10 * MiB, WS_WOUTT = 24 * MiB, WS_WQT = 32 * MiB,
                 WS_US = 40 * MiB, WS_VS = 41 * MiB, WS_PSQX = 42 * MiB, WS_BIAS2 = 44 * MiB, WS_PSQA = 45 * MiB, WS_PSQS = 46 * MiB, WS_CS = 50 * MiB, WS_DT = 51 * MiB, WS_IDX = 52 * MiB, WS_GATE = 60 * MiB, WS_U16 = 68 * MiB, WS_V16 = 132 * MiB, WS_U8 = 68 * MiB, WS_V8 = 100 * MiB, WS_MIXRAW = 372 * MiB, WS_U4 = 436 * MiB, WS_V4 = 456 * MiB,
                 WS_K = 68 * MiB, WS_YSSD = 68 * MiB, WS_XBCA = 116 * MiB, WS_ATTN = 164 * MiB,
                 WS_H = 196 * MiB, WS_Q = 196 * MiB, WS_MIXIN = 196 * MiB, WS_H2 = 196 * MiB, WS_X1M = 68 * MiB,
                 WS_PROJ = 260 * MiB, WS_QP = 260 * MiB, WS_QRAW = 372 * MiB, WS_KVRAW = 420 * MiB, WS_V = 484 * MiB, WS_END = 516 * MiB;
constexpr int CW_BAR = 1024;

struct Params {
    const float *x, *c; const int* pos;
    const float *w_ada, *b_ada, *w_in, *q_a_norm, *w_uq, *kv_a_norm, *w_ukv, *q_norm, *k_norm, *attn_out_norm, *conv_w, *conv_b, *dt_bias, *a_log,
        *d_skip, *ssd_norm, *w_out, *w_query, *sub_keys, *u_exp, *v_exp;
    float* out; unsigned char* ws;
    int ph_lo, ph_hi;
};
namespace pg8 {
#define PG8_LAS __attribute__((address_space(3)))
typedef unsigned short bf16_t;
typedef short bf16x8 __attribute__((ext_vector_type(8)));
typedef float f32x4 __attribute__((ext_vector_type(4)));
typedef unsigned u32x4 __attribute__((ext_vector_type(4)));
constexpr int BM = 256, BK = 64, HALF = 128, HTB = HALF * BK * 2  , STAGE_BYTES = 8 * HTB, NXCD = 8, WGM = 8;

__host__ __device__ __forceinline__ int lds_byte(int r, int c) { const int st = (r >> 4) * 2 + (c >> 5), rr = r & 15, cc = c & 31, ob = rr * 64 + cc * 2; return st * 1024 + (ob ^ (((ob >> 9) & 1) << 5)); }
__host__ __device__ __forceinline__ void stage_rc(int b, int& R, int& C) { const int st = b / 1024, sb = b % 1024, swz = sb ^ (((sb >> 9) & 1) << 5); R = (st >> 1) * 16 + swz / 64; C = (st & 1) * 32 + (swz % 64) / 2; }
__host__ __device__ __forceinline__ int perm32(int rho) { const int n = rho >> 4, i = rho & 15; return 8 * (i >> 2) + 4 * n + (i & 3); }

struct Unit { int pm, pn; };
struct Gemm { const bf16_t* A; const bf16_t* Bt; int M, N, K, lda; };

struct StaticOrder {
    int nM, nN, nwg, G, c;
    __host__ __device__ void init(int M, int N, int G_, int c_) { nM = M / BM; nN = N / BM; nwg = nM * nN; G = G_; c = c_; }
    __host__ __device__ bool next(int i, Unit& u) const {
        const long L = (long)i * G + c; if (L >= nwg) return false;
        int wgid = (int)L; { const int q = nwg / NXCD, r = nwg % NXCD, xcd = wgid % NXCD, off = wgid / NXCD; wgid = (xcd < r ? xcd * (q + 1) : r * (q + 1) + (xcd - r) * q) + off; }
        const int nig = WGM * nN, gid = wgid / nig, fm = gid * WGM, gsz = (nM - fm) < WGM ? (nM - fm) : WGM;
        u.pm = fm + ((wgid % nig) % gsz); u.pn = (wgid % nig) / gsz; return true;
    }
    __device__ __forceinline__ void a_ready(const Unit&) const {}
    __device__ __forceinline__ void done(const Unit&) const {}
};

__device__ __forceinline__ unsigned cvt_pk_bf16(float lo, float hi) { unsigned r; asm volatile("v_cvt_pk_bf16_f32 %0, %1, %2" : "=v"(r) : "v"(lo), "v"(hi)); return r; }
typedef float f32x2 __attribute__((ext_vector_type(2)));
__device__ __forceinline__ f32x2 gelu_pk(f32x2 v) {
    const f32x2 av = __builtin_elementwise_abs(v), d = av * 0.2316418882f + 1.0f;
    f32x2 t; t.x = __builtin_amdgcn_rcpf(d.x); t.y = __builtin_amdgcn_rcpf(d.y);
    f32x2 q = t * 0.5307027145f + (-0.7265760135f); q = q * t + 0.7107068705f; q = q * t + (-0.142248368f); q = q * t + 0.127414796f; q = q * t;
    const f32x2 s = (v * v) * (-0.72134752044f);
    f32x2 e; e.x = __builtin_amdgcn_exp2f(s.x); e.y = __builtin_amdgcn_exp2f(s.y);
    const f32x2 m = v * (q * e), r = v - m;
    f32x2 o; o.x = v.x < 0.f ? m.x : r.x; o.y = v.y < 0.f ? m.y : r.y; return o;
}

template <int ACT  > struct EpiBf16 {
    static constexpr bool PERM = true, AFTER_DRAIN = false, KSCALE = false; static_assert(ACT == 0 || ACT == 1, "EpiBf16: ACT is 0 (none) or 1 (gelu_pk)");
    bf16_t* O; int ldc; const float* bias; int split_cols; size_t split_stride; float scale0;
    __device__ __forceinline__ void operator()(const f32x4 (&acc)[2][2][4][2], const Unit& u, int wr, int wc, int fr, int fq) const {
        const int row0 = u.pm * BM + wr * 64 + fr; int colt = u.pn * BM; bf16_t* base = O;
        float sc = 1.f; if (split_cols) { const int t = colt / split_cols; base += (size_t)t * split_stride; colt -= t * split_cols; if (t == 0) sc = scale0; }
        const int col0 = colt + wc * 32 + 8 * fq, bcol0 = u.pn * BM + wc * 32 + 8 * fq;
        f32x4 bv[2][2];
#pragma unroll
        for (int bj = 0; bj < 2; ++bj)
#pragma unroll
            for (int n = 0; n < 2; ++n) bv[bj][n] = bias ? *(const f32x4*)(bias + bcol0 + bj * HALF + 4 * n) : (f32x4){0.f, 0.f, 0.f, 0.f};
#pragma unroll
        for (int ai = 0; ai < 2; ++ai)
#pragma unroll
            for (int m = 0; m < 4; ++m) { bf16_t* rowp = base + (size_t)(row0 + ai * HALF + m * 16) * ldc + col0;
#pragma unroll
                for (int bj = 0; bj < 2; ++bj) { f32x4 v0 = acc[ai][bj][m][0] + bv[bj][0], v1 = acc[ai][bj][m][1] + bv[bj][1];
                    if (ACT == 1) { f32x2 a = gelu_pk((f32x2){v0[0], v0[1]}), b = gelu_pk((f32x2){v0[2], v0[3]}), c = gelu_pk((f32x2){v1[0], v1[1]}), d = gelu_pk((f32x2){v1[2], v1[3]});
                        v0 = (f32x4){a.x, a.y, b.x, b.y}; v1 = (f32x4){c.x, c.y, d.x, d.y}; }
                    v0 = v0 * sc; v1 = v1 * sc; u32x4 w; w.x = cvt_pk_bf16(v0[0], v0[1]); w.y = cvt_pk_bf16(v0[2], v0[3]); w.z = cvt_pk_bf16(v1[0], v1[1]); w.w = cvt_pk_bf16(v1[2], v1[3]);
                    *(u32x4*)(rowp + bj * HALF) = w; } }
    }
};
struct EpiResid {
    static constexpr bool PERM = false, AFTER_DRAIN = false, KSCALE = false;
    const float* resid; float* out; const float* gate; int ldc, rows_per_batch, gate_stride;
    __device__ __forceinline__ void operator()(const f32x4 (&acc)[2][2][4][2], const Unit& u, int wr, int wc, int fr, int fq) const {
        const int col0 = u.pn * BM + wc * 32 + 4 * fq;
        const int b = (u.pm * BM) / rows_per_batch;
        f32x4 gv[2][2];
#pragma unroll
        for (int bj = 0; bj < 2; ++bj)
#pragma unroll
            for (int n = 0; n < 2; ++n) gv[bj][n] = *(const f32x4*)(gate + (size_t)b * gate_stride + col0 + bj * HALF + n * 16);
#pragma unroll
        for (int ai = 0; ai < 2; ++ai)
#pragma unroll
            for (int m = 0; m < 4; ++m) {
                const size_t off = (size_t)(u.pm * BM + ai * HALF + wr * 64 + m * 16 + fr) * ldc + col0;
#pragma unroll
                for (int bj = 0; bj < 2; ++bj)
#pragma unroll
                    for (int n = 0; n < 2; ++n) {
                        const f32x4 bs = *(const f32x4*)(resid + off + bj * HALF + n * 16);
                        *(f32x4*)(out + off + bj * HALF + n * 16) = bs + gv[bj][n] * acc[ai][bj][m][n];
                    }
                if (m & 1) asm volatile("" ::: "memory");
            }
    }
};

struct EpiX1 {
    static constexpr bool PERM = true, AFTER_DRAIN = false, KSCALE = true;
    static constexpr int KS1 = 16, KS2 = 24;
    const float* resid; const float* mod; bf16_t* xm; float* psq; int ldc, rows_per_batch; const PG8_LAS float* kt; int pm0;
    __device__ __forceinline__ void kscale(f32x4 (&acc)[2][2][4][2], const Unit& u, int t, int wr, int fr) const {
        const PG8_LAS float* tab = kt + ((u.pm == pm0) ? 0 : 1024) + ((t == KS1) ? 0 : 1);
#pragma unroll
        for (int ai = 0; ai < 2; ++ai)
#pragma unroll
            for (int m = 0; m < 4; ++m) { const float f = tab[(ai * HALF + wr * 64 + m * 16 + fr) * 4];
#pragma unroll
                for (int bj = 0; bj < 2; ++bj) { acc[ai][bj][m][0] *= f; acc[ai][bj][m][1] *= f; } }
    }
    __device__ __forceinline__ void operator()(const f32x4 (&acc)[2][2][4][2], const Unit& u, int wr, int wc, int fr, int fq) const {
        const int b = (u.pm * BM) / rows_per_batch;
        const float* g1 = mod + (size_t)b * 6 * ldc + 2 * ldc; const float* s2 = mod + (size_t)b * 6 * ldc + 4 * ldc;
        const int col0 = u.pn * BM + wc * 32 + 8 * fq;
        const PG8_LAS float* tab = kt + ((u.pm == pm0) ? 0 : 1024) + 2;
        f32x4 gv[2][2], sv[2][2];
#pragma unroll
        for (int bj = 0; bj < 2; ++bj)
#pragma unroll
            for (int n = 0; n < 2; ++n) { gv[bj][n] = *(const f32x4*)(g1 + col0 + bj * HALF + 4 * n); sv[bj][n] = *(const f32x4*)(s2 + col0 + bj * HALF + 4 * n) + 1.0f; }
#pragma unroll
        for (int ai = 0; ai < 2; ++ai)
#pragma unroll
            for (int m = 0; m < 4; ++m) {
                const int lr = ai * HALF + wr * 64 + m * 16 + fr, row = u.pm * BM + lr; const size_t off = (size_t)row * ldc + col0;
                const float rf = tab[lr * 4];
                float ss = 0.f;
#pragma unroll
                for (int bj = 0; bj < 2; ++bj) {
                    const f32x4 r0 = *(const f32x4*)(resid + off + bj * HALF), r1 = *(const f32x4*)(resid + off + bj * HALF + 4);
                    const f32x4 x0 = r0 + gv[bj][0] * (acc[ai][bj][m][0] * rf), x1 = r1 + gv[bj][1] * (acc[ai][bj][m][1] * rf);
                    ss += (x0[0] * x0[0] + x0[1] * x0[1]) + (x0[2] * x0[2] + x0[3] * x0[3]) + (x1[0] * x1[0] + x1[1] * x1[1]) + (x1[2] * x1[2] + x1[3] * x1[3]);
                    const f32x4 y0 = x0 * sv[bj][0], y1 = x1 * sv[bj][1];
                    u32x4 w; w.x = cvt_pk_bf16(y0[0], y0[1]); w.y = cvt_pk_bf16(y0[2], y0[3]); w.z = cvt_pk_bf16(y1[0], y1[1]); w.w = cvt_pk_bf16(y1[2], y1[3]);
                    *(u32x4*)(xm + off + bj * HALF) = w;
                }
                ss += __shfl_xor(ss, 16); ss += __shfl_xor(ss, 32);
                if (fq == 0) psq[(size_t)row * 32 + u.pn * 4 + wc] = ss;
                if (m & 1) asm volatile("" ::: "memory");
            }
    }
};
struct EpiScaleBias {
    static constexpr bool PERM = true, AFTER_DRAIN = false, KSCALE = false;
    bf16_t* O; int ldc; const float* bias; int rows_per_batch; const PG8_LAS float* rt; int pm0;
    __device__ __forceinline__ void operator()(const f32x4 (&acc)[2][2][4][2], const Unit& u, int wr, int wc, int fr, int fq) const {
        const int b = (u.pm * BM) / rows_per_batch; const float* bp = bias + (size_t)b * ldc;
        const int col0 = u.pn * BM + wc * 32 + 8 * fq;
        const PG8_LAS float* rtu = rt + ((u.pm == pm0) ? 0 : 256);
        f32x4 bv[2][2];
#pragma unroll
        for (int bj = 0; bj < 2; ++bj)
#pragma unroll
            for (int n = 0; n < 2; ++n) bv[bj][n] = *(const f32x4*)(bp + col0 + bj * HALF + 4 * n);
#pragma unroll
        for (int ai = 0; ai < 2; ++ai)
#pragma unroll
            for (int m = 0; m < 4; ++m) {
                const int lr = ai * HALF + wr * 64 + m * 16 + fr; const float rs = rtu[lr];
                bf16_t* rowp = O + (size_t)(u.pm * BM + lr) * ldc + col0;
#pragma unroll
                for (int bj = 0; bj < 2; ++bj) {
                    const f32x4 v0 = acc[ai][bj][m][0] * rs + bv[bj][0], v1 = acc[ai][bj][m][1] * rs + bv[bj][1];
                    u32x4 w; w.x = cvt_pk_bf16(v0[0], v0[1]); w.y = cvt_pk_bf16(v0[2], v0[3]); w.z = cvt_pk_bf16(v1[0], v1[1]); w.w = cvt_pk_bf16(v1[2], v1[3]);
                    *(u32x4*)(rowp + bj * HALF) = w;
                }
            }
    }
};
template <class Epi, class Sched, bool ALIGN_EPI = false, bool SP2 = false>
__device__ __forceinline__ void gemm_phase(PG8_LAS unsigned char* lds, const Gemm g, const Sched& S, const Epi& E) {
    const int tid = threadIdx.x, wid = __builtin_amdgcn_readfirstlane(tid >> 6), lane = tid & 63, wr = wid >> 2, wc = wid & 3, fr = lane & 15, fq = lane >> 4;
    const int K = g.K, nt = K / BK;
    unsigned voffA[2], voffB[2];
#pragma unroll
    for (int i = 0; i < 2; ++i) { int R, C; stage_rc(tid * 16 + i * 8192, R, C); const int Rb = Epi::PERM ? ((R & ~31) + perm32(R & 31)) : R;
        voffA[i] = (unsigned)(R * g.lda + C) * 2u; voffB[i] = (unsigned)(Rb * K + C) * 2u; }
    const size_t kstep = (size_t)(BK * 2);
    const size_t hstep = (size_t)HALF * K * 2;
    const size_t tstep = 2 * hstep; const size_t hstepA = (size_t)HALF * g.lda * 2, tstepA = 2 * hstepA;
    const unsigned ldsw = (unsigned)wid * 1024u;
    const int aoff = lds_byte(wr * 64 + fr, fq * 8), boff = lds_byte(wc * 32 + fr, fq * 8);
#define PG8_SA(b, h) (((b) * 2 + (h)) * HTB)
#define PG8_SB(b, h) ((4 + (b) * 2 + (h)) * HTB)
#define PG8_STAGE(bufoff, gbase, voff) do { _Pragma("unroll") for (int _i = 0; _i < 2; ++_i) \
        __builtin_amdgcn_global_load_lds((const unsigned*)((const char*)(gbase) + (voff)[_i]), (PG8_LAS unsigned*)(lds + (bufoff) + ldsw + _i * 8192), 16, 0, 0); } while (0)
#define PG8_LDA(dst, b, h) do { _Pragma("unroll") for (int m = 0; m < 4; ++m) _Pragma("unroll") for (int k = 0; k < 2; ++k) dst[m][k] = *(const PG8_LAS bf16x8*)(lds + PG8_SA(b, h) + aoff + m * 2048 + k * 1024); } while (0)
#define PG8_LDB(dst, b, h) do { _Pragma("unroll") for (int n = 0; n < 2; ++n) _Pragma("unroll") for (int k = 0; k < 2; ++k) dst[n][k] = *(const PG8_LAS bf16x8*)(lds + PG8_SB(b, h) + boff + n * 2048 + k * 1024); } while (0)
#define PG8_MMA(ai, bj, At, Bt) do { __builtin_amdgcn_s_setprio(1); _Pragma("unroll") for (int m = 0; m < 4; ++m) _Pragma("unroll") for (int n = 0; n < 2; ++n) _Pragma("unroll") for (int k = 0; k < 2; ++k) \
        acc[ai][bj][m][n] = __builtin_amdgcn_mfma_f32_16x16x32_bf16(Bt[n][k], At[m][k], acc[ai][bj][m][n], 0, 0, 0); __builtin_amdgcn_s_setprio(0); } while (0)
#define PG8_WAIT_V(n) asm volatile("s_waitcnt vmcnt(" #n ")" ::: "memory")
#define PG8_WAIT_L(n) asm volatile("s_waitcnt lgkmcnt(" #n ")" ::: "memory")
#define PG8_BAR __builtin_amdgcn_s_barrier()
#define PG8_SCHED __builtin_amdgcn_sched_barrier(0)
    Unit cur, nxt; int ui = 0;
    if (!S.next(0, cur)) return;
    f32x4 acc[2][2][4][2];
#pragma unroll
    for (int a = 0; a < 2; ++a)
#pragma unroll
        for (int b = 0; b < 2; ++b)
#pragma unroll
            for (int m = 0; m < 4; ++m)
#pragma unroll
                for (int n = 0; n < 2; ++n) acc[a][b][m][n] = (f32x4){0.f, 0.f, 0.f, 0.f};
    bf16x8 At[4][2], B0[2][2], B1[2][2];
    const char* cA = (const char*)g.A + (size_t)cur.pm * tstepA; const char* cB = (const char*)g.Bt + (size_t)cur.pn * tstep;
    S.a_ready(cur);
    if constexpr (SP2) {
        PG8_STAGE(PG8_SB(0, 0), cB, voffB); PG8_STAGE(PG8_SB(0, 1), cB + hstep, voffB); PG8_STAGE(PG8_SA(0, 0), cA, voffA); PG8_STAGE(PG8_SA(0, 1), cA + hstepA, voffA);
        if (wr == 1) PG8_BAR;
        PG8_WAIT_V(2); PG8_BAR;
        PG8_STAGE(PG8_SB(1, 0), cB + kstep, voffB); PG8_STAGE(PG8_SA(1, 0), cA + kstep, voffA); PG8_STAGE(PG8_SB(1, 1), cB + hstep + kstep, voffB);
        PG8_WAIT_V(6); PG8_BAR;
    } else {
        PG8_STAGE(PG8_SB(0, 0), cB, voffB); PG8_STAGE(PG8_SA(0, 0), cA, voffA); PG8_STAGE(PG8_SB(0, 1), cB + hstep, voffB); PG8_STAGE(PG8_SA(0, 1), cA + hstepA, voffA);
        if (wr == 1) PG8_BAR;
        PG8_WAIT_V(4); PG8_BAR;
        PG8_STAGE(PG8_SB(1, 0), cB + kstep, voffB); PG8_STAGE(PG8_SA(1, 0), cA + kstep, voffA); PG8_STAGE(PG8_SB(1, 1), cB + hstep + kstep, voffB);
        PG8_WAIT_V(6); PG8_BAR;
    }
    for (;;) {
        const bool has_next = S.next(ui + 1, nxt);
        const char* nA = has_next ? (const char*)g.A + (size_t)nxt.pm * tstepA : cA; const char* nB = has_next ? (const char*)g.Bt + (size_t)nxt.pn * tstep : cB;
        for (int t = 0; t < nt; t += 2) {
            const bool last = (t == nt - 2);
            const char* a1 = cA + (size_t)(t + 1) * kstep;
            const char* a2 = last ? nA : cA + (size_t)(t + 2) * kstep; const char* b2 = last ? nB : cB + (size_t)(t + 2) * kstep;
            const char* a3 = a2 + kstep; const char* b3 = b2 + kstep;
            if (last && has_next) S.a_ready(nxt);
            if constexpr (Epi::KSCALE) { if (t == Epi::KS1 || t == Epi::KS2) E.kscale(acc, cur, t, wr, fr); }
            if constexpr (SP2) {
            PG8_LDB(B0, 0, 0); PG8_LDB(B1, 0, 1); PG8_SCHED; PG8_LDA(At, 0, 0); PG8_STAGE(PG8_SA(1, 1), a1 + hstepA, voffA);
            PG8_WAIT_V(8); PG8_WAIT_L(0); PG8_BAR; PG8_MMA(0, 0, At, B0); PG8_MMA(0, 1, At, B1); PG8_BAR; PG8_SCHED;
            PG8_LDA(At, 0, 1); PG8_STAGE(PG8_SB(0, 0), b2, voffB); PG8_STAGE(PG8_SB(0, 1), b2 + hstep, voffB); PG8_STAGE(PG8_SA(0, 0), a2, voffA);
            PG8_WAIT_V(8); PG8_WAIT_L(0); PG8_BAR; PG8_MMA(1, 0, At, B0); PG8_MMA(1, 1, At, B1); PG8_BAR; PG8_SCHED;
            PG8_LDB(B0, 1, 0); PG8_LDB(B1, 1, 1); PG8_SCHED; PG8_LDA(At, 1, 0); PG8_STAGE(PG8_SA(0, 1), a2 + hstepA, voffA);
            PG8_WAIT_V(8); PG8_WAIT_L(0); PG8_BAR; PG8_MMA(0, 0, At, B0); PG8_MMA(0, 1, At, B1); PG8_BAR; PG8_SCHED;
            PG8_LDA(At, 1, 1); PG8_STAGE(PG8_SB(1, 0), b3, voffB); PG8_STAGE(PG8_SB(1, 1), b3 + hstep, voffB); PG8_STAGE(PG8_SA(1, 0), a3, voffA);
            PG8_WAIT_V(8); PG8_WAIT_L(0); PG8_BAR; PG8_MMA(1, 0, At, B0); PG8_MMA(1, 1, At, B1); PG8_BAR; PG8_SCHED;
            } else {
            PG8_LDB(B0, 0, 0); PG8_SCHED; PG8_LDA(At, 0, 0); PG8_STAGE(PG8_SA(1, 1), a1 + hstepA, voffA);
            PG8_WAIT_L(8); PG8_BAR; PG8_WAIT_L(0); PG8_MMA(0, 0, At, B0); PG8_BAR; PG8_SCHED;
            PG8_LDB(B1, 0, 1); PG8_STAGE(PG8_SB(0, 0), b2, voffB);
            PG8_BAR; PG8_WAIT_L(0); PG8_MMA(0, 1, At, B1); PG8_BAR;
            PG8_LDA(At, 0, 1); PG8_STAGE(PG8_SA(0, 0), a2, voffA);
            PG8_BAR; PG8_WAIT_L(0); PG8_MMA(1, 0, At, B0); PG8_BAR; PG8_SCHED;
            PG8_STAGE(PG8_SB(0, 1), b2 + hstep, voffB);
            PG8_WAIT_V(6); PG8_BAR; PG8_MMA(1, 1, At, B1); PG8_BAR;
            PG8_LDB(B0, 1, 0); PG8_SCHED; PG8_LDA(At, 1, 0); PG8_STAGE(PG8_SA(0, 1), a2 + hstepA, voffA);
            PG8_WAIT_L(8); PG8_BAR; PG8_WAIT_L(0); PG8_MMA(0, 0, At, B0); PG8_BAR; PG8_SCHED;
            PG8_LDB(B1, 1, 1); PG8_STAGE(PG8_SB(1, 0), b3, voffB);
            PG8_BAR; PG8_WAIT_L(0); PG8_MMA(0, 1, At, B1); PG8_BAR;
            PG8_LDA(At, 1, 1); PG8_STAGE(PG8_SA(1, 0), a3, voffA);
            PG8_BAR; PG8_WAIT_L(0); PG8_MMA(1, 0, At, B0); PG8_BAR; PG8_SCHED;
            PG8_STAGE(PG8_SB(1, 1), b3 + hstep, voffB);
            PG8_WAIT_V(6); PG8_BAR; PG8_MMA(1, 1, At, B1); PG8_BAR;
            }
        }
        if constexpr (ALIGN_EPI) { if (wr == 0) PG8_BAR; }
        if constexpr (!Epi::AFTER_DRAIN) { E(acc, cur, wr, wc, fr, fq); S.done(cur); }
        if (!has_next) break;
#pragma unroll
        for (int a = 0; a < 2; ++a)
#pragma unroll
            for (int b = 0; b < 2; ++b)
#pragma unroll
                for (int m = 0; m < 4; ++m)
#pragma unroll
                    for (int n = 0; n < 2; ++n) acc[a][b][m][n] = (f32x4){0.f, 0.f, 0.f, 0.f};
        cur = nxt; cA = nA; cB = nB; ++ui;
        if constexpr (ALIGN_EPI) { if (wr == 1) PG8_BAR; }
    }
    PG8_WAIT_V(0);
    if constexpr (!ALIGN_EPI) { if (wr == 0) PG8_BAR; }
    PG8_BAR;
    if constexpr (Epi::AFTER_DRAIN) { E.fused(acc, cur, wr, wc, fr, fq, lds, wid, lane); S.done(cur); }
#undef PG8_SA
#undef PG8_SB
#undef PG8_STAGE
#undef PG8_LDA
#undef PG8_LDB
#undef PG8_MMA
#undef PG8_WAIT_V
#undef PG8_WAIT_L
#undef PG8_BAR
#undef PG8_SCHED
}
}
#define LDS_WAIT() asm volatile("s_waitcnt lgkmcnt(0)" ::: "memory")
#define XB_TMO      128
#define XB_XCNT(j)  (256  + 64 * (j))
#define XB_XSUB(j)  (1280 + 64 * (j))
#define XB_XGEN(j)  (2304 + 64 * (j))
#define XB_TOP      3328
#define XB_TOPGEN   3392
#define XCD_BAR_WORDS 3456
#define XB_SPIN_CAP (1u << 18)

__device__ __forceinline__ unsigned xb_ld(unsigned* p)              { return __hip_atomic_load(p, __ATOMIC_RELAXED, __HIP_MEMORY_SCOPE_AGENT); }
__device__ __forceinline__ unsigned xb_add(unsigned* p, unsigned v) { return __hip_atomic_fetch_add(p, v, __ATOMIC_RELAXED, __HIP_MEMORY_SCOPE_AGENT); }
__device__ __forceinline__ unsigned xb_xcc_id() { return (unsigned)__builtin_amdgcn_s_getreg((3 << 11) | 20) & 0xFu; }
#define XB_SPIN(cond, bar) do { unsigned _sp = 0; while (cond) { __builtin_amdgcn_s_sleep(1); \
    if ((++_sp & 255u) == 0u) { if (xb_ld(&(bar)[XB_TMO])) break; if (_sp > XB_SPIN_CAP) { atomicAdd(&(bar)[XB_TMO], 1u); break; } } } } while (0)

struct XcdBarrier {
    unsigned* bar; unsigned x;
    volatile LAS unsigned* st;
};

__device__ __forceinline__ XcdBarrier xcd_barrier_post(unsigned* bar, volatile LAS unsigned* st) {
    XcdBarrier b; b.bar = bar; b.x = xb_xcc_id(); b.st = st;
    if (threadIdx.x == 0) (void)xb_add(&bar[XB_XCNT(b.x)], 1u);
    return b;
}
__device__ __forceinline__ void xcd_barrier_complete(unsigned* bar, unsigned x, unsigned& nloc, unsigned& nx) {
    const unsigned G = gridDim.x * gridDim.y * gridDim.z;
    unsigned sum, cnt, mine, sp = 0u;
    for (;;) {
        sum = 0u; cnt = 0u; mine = 0u;
#pragma unroll
        for (unsigned j = 0; j < 16; ++j) { const unsigned c = xb_ld(&bar[XB_XCNT(j)]); sum += c; cnt += (c > 0u) ? 1u : 0u; mine = (j == x) ? c : mine; }
        if (sum == G) break;
        __builtin_amdgcn_s_sleep(1);
        if ((++sp & 255u) == 0u) { if (xb_ld(&bar[XB_TMO])) break; if (sp > XB_SPIN_CAP) { atomicAdd(&bar[XB_TMO], 1u); break; } }
    }
    nloc = mine > 0u ? mine : 1u; nx = cnt > 0u ? cnt : 1u;
}

__device__ __forceinline__ void xcd_barrier(const XcdBarrier& b) {
    asm volatile("s_waitcnt vmcnt(0)" ::: "memory");
    __syncthreads();
    if (threadIdx.x == 0) {
        unsigned* bar = b.bar;
        __builtin_amdgcn_s_waitcnt(0);
        unsigned nloc = b.st[0], nx = b.st[1];
        if (nloc == 0u) { xcd_barrier_complete(bar, b.x, nloc, nx); b.st[0] = nloc; b.st[1] = nx; }
        const unsigned old = xb_add(&bar[XB_XSUB(b.x)], 1u);
        const unsigned gen = old / nloc;
        if (old + 1u == (gen + 1u) * nloc) {
            __builtin_amdgcn_fence(__ATOMIC_RELEASE, "agent");
            asm volatile("s_waitcnt vmcnt(0)" ::: "memory");
            const unsigned og = xb_add(&bar[XB_TOP], 1u);
            const unsigned tg = og / nx;
            if (og + 1u == (tg + 1u) * nx) xb_add(&bar[XB_TOPGEN], 1u);
            else XB_SPIN(xb_ld(&bar[XB_TOPGEN]) == tg, bar);
            __builtin_amdgcn_fence(__ATOMIC_ACQUIRE, "agent");
            xb_add(&bar[XB_XGEN(b.x)], 1u);
            asm volatile("s_waitcnt vmcnt(0)" ::: "memory");
        } else {
            XB_SPIN(xb_ld(&bar[XB_XGEN(b.x)]) == gen, bar);
            __builtin_amdgcn_fence(__ATOMIC_ACQUIRE, "agent");
            asm volatile("s_waitcnt vmcnt(0)" ::: "memory");
        }
    }
    __syncthreads();
}
#define SYNC() __syncthreads()
__device__ __forceinline__ float silu_fast(float v) { return v * __builtin_amdgcn_rcpf(1.f + __expf(-v)); }
__device__ __forceinline__ float sq2(unsigned w) { const float a = bflo(w), b = bfhi(w); return a * a + b * b; }

__device__ __forceinline__ void ph_mod(const Params& p, unsigned char* lds, int tid, int vb) {
    float* cact = (float*)lds; float* red = (float*)(lds + 65536);
    const int lane = tid & 63, wv = tid >> 6, c4 = lane & 31, kh = lane >> 5;
    for (int i = tid; i < NB * DM; i += NTHR) { const int b = i / DM, k = i % DM; cact[k * NB + b] = silu_f(p.c[i]); }
    SYNC();
    const int n = vb * 128 + 4 * c4;
    f32x4 acc[NB];
#pragma unroll
    for (int b = 0; b < NB; ++b) acc[b] = (f32x4){0.f, 0.f, 0.f, 0.f};
    const float* w = p.w_ada + (size_t)(wv * 256 + kh) * (6 * DM) + n;
#pragma unroll 8
    for (int i = 0; i < 128; ++i) {
        const f32x4 wk = *(const f32x4*)(w + (size_t)(2 * i) * (6 * DM));
        const f32x4 ca = *(const f32x4*)(cact + (wv * 256 + 2 * i + kh) * NB), cb = *(const f32x4*)(cact + (wv * 256 + 2 * i + kh) * NB + 4);
        acc[0] += wk * ca.x; acc[1] += wk * ca.y; acc[2] += wk * ca.z; acc[3] += wk * ca.w; acc[4] += wk * cb.x; acc[5] += wk * cb.y; acc[6] += wk * cb.z; acc[7] += wk * cb.w;
    }
#pragma unroll
    for (int b = 0; b < NB; ++b) { acc[b].x += __shfl_xor(acc[b].x, 32); acc[b].y += __shfl_xor(acc[b].y, 32); acc[b].z += __shfl_xor(acc[b].z, 32); acc[b].w += __shfl_xor(acc[b].w, 32); }
    if (lane < 32) {
#pragma unroll
        for (int b = 0; b < NB; ++b) *(f32x4*)(red + (wv * NB + b) * 128 + 4 * c4) = acc[b];
    }
    SYNC();
    for (int o = tid; o < NB * 128; o += NTHR) {
        const int b = o >> 7, col = o & 127;
        float s = p.b_ada[vb * 128 + col];
#pragma unroll
        for (int w8 = 0; w8 < 8; ++w8) s += red[(w8 * NB + b) * 128 + col];
        ((float*)(p.ws + WS_MOD))[b * 6 * DM + vb * 128 + col] = s;
    }
    SYNC();
}
__device__ __forceinline__ void ph_rope_tab(const Params& p, int gtid, int gn) {
    for (int i = gtid; i < T * 32; i += gn) {
        const int t = i >> 5, f = i & 31;
        const float inv = 1.0f / powf(10000.0f, (float)f * (2.0f / 64.0f));
        const float ang = (float)p.pos[t] * inv;
        ((float*)(p.ws + WS_ROPEC))[i] = (float)cos((double)ang);
        ((float*)(p.ws + WS_ROPES))[i] = (float)sin((double)ang);
    }
}
__device__ __forceinline__ void tr_item(const float* W, int K, int N, int Npad, bf16_t* WT, const float* g0, const float* g1, int gs, float* scr, int item, int lane) {
    const int nblk = Npad / 128, kb = item / nblk, nb = item % nblk, k0 = 32 * kb, n0 = 128 * nb;
    const int c4 = lane & 31, kh = lane >> 5, n = n0 + 4 * c4; const bool ok = n < N;
#pragma unroll 8
    for (int i = 0; i < 16; ++i) {
        const int kk = 2 * i + kh, k = k0 + kk;
        f32x4 v = ok ? *(const f32x4*)(W + (size_t)k * N + n) : (f32x4){0.f, 0.f, 0.f, 0.f};
        if (g0) v = v * ((k < gs) ? g0[k] : g1[k - gs]);
        *(f32x4*)(scr + kk * 132 + 4 * c4) = v;
    }
    asm volatile("s_waitcnt lgkmcnt(0)" ::: "memory");
#pragma unroll
    for (int j = 0; j < 8; ++j) {
        const int idx = lane + 64 * j, nn = idx >> 2, ck = idx & 3; const float* sp = scr + (8 * ck) * 132 + nn;
        u32x4 o; o.x = pk2(sp[0 * 132], sp[1 * 132]); o.y = pk2(sp[2 * 132], sp[3 * 132]); o.z = pk2(sp[4 * 132], sp[5 * 132]); o.w = pk2(sp[6 * 132], sp[7 * 132]);
        *(u32x4*)(WT + (size_t)(n0 + nn) * K + k0 + 8 * ck) = o;
    }
    asm volatile("s_waitcnt lgkmcnt(0)" ::: "memory");
}
constexpr int TR_N0 = (DM / 32) * (NPROJ / 128), TR_N1 = (512 / 32) * (NQ / 128), TR_N2 = (256 / 32) * (NKV / 128), TR_N3 = (DM / 32) * (DM / 128), TR_N4 = TR_N3;
constexpr int TR_TOTAL = TR_N0 + TR_N1 + TR_N2 + TR_N3 + TR_N4;
__device__ __forceinline__ void ph_transposes(const Params& p, unsigned char* lds, int wave, int lane, int first, int stride) {
    float* scr = (float*)(lds + wave * 17408);
    for (int it = first; it < TR_TOTAL; it += stride) {
        int r = it;
        if (r < TR_N0) { tr_item(p.w_in, DM, IN_COLS, NPROJ, (bf16_t*)(p.ws + WS_WINT), nullptr, nullptr, 0, scr, r, lane); continue; } r -= TR_N0;
        if (r < TR_N1) { tr_item(p.w_uq, 512, NQ, NQ, (bf16_t*)(p.ws + WS_WUQT), p.q_a_norm, p.q_a_norm, 512, scr, r, lane); continue; } r -= TR_N1;
        if (r < TR_N2) { tr_item(p.w_ukv, 256, NKV, NKV, (bf16_t*)(p.ws + WS_WUKVT), p.kv_a_norm, p.kv_a_norm, 256, scr, r, lane); continue; } r -= TR_N2;
        if (r < TR_N3) { tr_item(p.w_out, DM, DM, DM, (bf16_t*)(p.ws + WS_WOUTT), p.attn_out_norm, p.ssd_norm, 1024, scr, r, lane); continue; } r -= TR_N3;
        tr_item(p.w_query, DM, DM, DM, (bf16_t*)(p.ws + WS_WQT), nullptr, nullptr, 0, scr, r, lane);
    }
}
__device__ __forceinline__ void ph_convert(const float* src, bf16_t* dst, size_t n4, int gtid, int gn) {
    for (size_t i = gtid; i < n4; i += (size_t)gn) {
        const f32x4 v = ((const f32x4*)src)[i];
        uint2 o; o.x = pk2(v.x, v.y); o.y = pk2(v.z, v.w);
        ((uint2*)dst)[i] = o;
    }
}
__device__ __forceinline__ void ph_modrows(const float* in, bf16_t* outp, const float* mod, int sh_idx, int sc_idx, int gwave, int gnw, int lane) {
    for (int row = gwave; row < T; row += gnw) {
        const int b = row / SEQ;
        const f32x4* xr = (const f32x4*)(in + (size_t)row * DM) + lane;
        f32x4 v[8]; float s = 0.f;
#pragma unroll
        for (int j = 0; j < 8; ++j) { v[j] = xr[64 * j]; s += (v[j].x * v[j].x + v[j].y * v[j].y) + (v[j].z * v[j].z + v[j].w * v[j].w); }
        const float r = rsqrtf(wave_sum(s) * (1.f / DM) + EPS);
        const f32x4* sh = (const f32x4*)(mod + (size_t)b * 6 * DM + sh_idx * DM) + lane;
        const f32x4* sc = (const f32x4*)(mod + (size_t)b * 6 * DM + sc_idx * DM) + lane;
        uint2* o = (uint2*)(outp + (size_t)row * DM) + lane;
#pragma unroll
        for (int j = 0; j < 8; ++j) {
            const f32x4 a = sh[64 * j], m = sc[64 * j];
            uint2 w; w.x = pk2(v[j].x * r * (1.f + m.x) + a.x, v[j].y * r * (1.f + m.y) + a.y); w.y = pk2(v[j].z * r * (1.f + m.z) + a.z, v[j].w * r * (1.f + m.w) + a.w);
            o[64 * j] = w;
        }
    }
}
__device__ __forceinline__ void ph_bias2(const Params& p, int gwave, int gnw, int lane) {
    const float* mod = (const float*)(p.ws + WS_MOD);
    for (int n = gwave; n < DM; n += gnw) {
        const bf16_t* wr_ = (const bf16_t*)(p.ws + WS_WQT) + (size_t)n * DM + lane * 8;
        float wv[4][8];
#pragma unroll
        for (int j = 0; j < 4; ++j) { const u32x4 w = *(const u32x4*)(wr_ + j * 512);
            wv[j][0] = bflo(w.x); wv[j][1] = bfhi(w.x); wv[j][2] = bflo(w.y); wv[j][3] = bfhi(w.y); wv[j][4] = bflo(w.z); wv[j][5] = bfhi(w.z); wv[j][6] = bflo(w.w); wv[j][7] = bfhi(w.w); }
#pragma unroll
        for (int b = 0; b < NB; ++b) {
            const float* sh = mod + (size_t)b * 6 * DM + 3 * DM + lane * 8; float a = 0.f;
#pragma unroll
            for (int j = 0; j < 4; ++j) { const f32x4 s0 = *(const f32x4*)(sh + j * 512), s1 = *(const f32x4*)(sh + j * 512 + 4);
                a += (wv[j][0] * s0[0] + wv[j][1] * s0[1]) + (wv[j][2] * s0[2] + wv[j][3] * s0[3]) + (wv[j][4] * s1[0] + wv[j][5] * s1[1]) + (wv[j][6] * s1[2] + wv[j][7] * s1[3]); }
            a = wave_sum(a);
            if (lane == 0) ((float*)(p.ws + WS_BIAS2))[b * DM + n] = a;
        }
    }
}
constexpr float QSCALE = 0.07216878364870322f * 1.4426950408889634f;
__device__ __forceinline__ float ssq8(u32x4 w) { return (sq2(w.x) + sq2(w.y)) + (sq2(w.z) + sq2(w.w)); }
__device__ __forceinline__ u32x4 scale8(u32x4 w, float s, const float (&g)[8]) {
    u32x4 o; o.x = pk2(bflo(w.x) * s * g[0], bfhi(w.x) * s * g[1]); o.y = pk2(bflo(w.y) * s * g[2], bfhi(w.y) * s * g[3]);
    o.z = pk2(bflo(w.z) * s * g[4], bfhi(w.z) * s * g[5]); o.w = pk2(bflo(w.w) * s * g[6], bfhi(w.w) * s * g[7]); return o;
}
__device__ __forceinline__ u32x4 rope8(u32x4 w, u32x4 pw, float s, const float (&go)[8], const float (&gp)[8], f32x4 c0, f32x4 c1, f32x4 s0, f32x4 s1, float sgn) {
    const float a[8] = {bflo(w.x) * s * go[0], bfhi(w.x) * s * go[1], bflo(w.y) * s * go[2], bfhi(w.y) * s * go[3], bflo(w.z) * s * go[4], bfhi(w.z) * s * go[5], bflo(w.w) * s * go[6], bfhi(w.w) * s * go[7]};
    const float b[8] = {bflo(pw.x) * s * gp[0], bfhi(pw.x) * s * gp[1], bflo(pw.y) * s * gp[2], bfhi(pw.y) * s * gp[3], bflo(pw.z) * s * gp[4], bfhi(pw.z) * s * gp[5], bflo(pw.w) * s * gp[6], bfhi(pw.w) * s * gp[7]};
    u32x4 o;
    o.x = pk2(a[0] * c0.x + sgn * b[0] * s0.x, a[1] * c0.y + sgn * b[1] * s0.y); o.y = pk2(a[2] * c0.z + sgn * b[2] * s0.z, a[3] * c0.w + sgn * b[3] * s0.w);
    o.z = pk2(a[4] * c1.x + sgn * b[4] * s1.x, a[5] * c1.y + sgn * b[5] * s1.y); o.w = pk2(a[6] * c1.z + sgn * b[6] * s1.z, a[7] * c1.w + sgn * b[7] * s1.w);
    return o;
}
__device__ __forceinline__ u32x4 shfl_xor4(u32x4 w, int m) { u32x4 o; o.x = __shfl_xor(w.x, m); o.y = __shfl_xor(w.y, m); o.z = __shfl_xor(w.z, m); o.w = __shfl_xor(w.w, m); return o; }
__device__ __forceinline__ void ph_qkv_post(const Params& p, int gwave, int gnw, int lane) {
    unsigned char* ws = p.ws;
    const int g16 = lane >> 4, pos = lane & 15, hr = lane >> 3, rpos = lane & 7, f0 = (rpos & 3) * 8;
    const float sgn = (rpos < 4) ? -1.f : 1.f;
    float gqn[8], gqr[8], gqp[8], gkn[8], gkr[8], gkp[8];
#pragma unroll
    for (int i = 0; i < 8; ++i) { gqn[i] = p.q_norm[pos * 8 + i]; gqr[i] = p.q_norm[128 + rpos * 8 + i]; gqp[i] = p.q_norm[128 + (rpos ^ 4) * 8 + i];
                                  gkn[i] = p.k_norm[pos * 8 + i]; gkr[i] = p.k_norm[128 + rpos * 8 + i]; gkp[i] = p.k_norm[128 + (rpos ^ 4) * 8 + i]; }
    for (int t = gwave; t < T; t += gnw) {
        const bf16_t* proj = (const bf16_t*)(ws + WS_PROJ) + (size_t)t * NPROJ;
        const bf16_t* qraw = (const bf16_t*)(ws + WS_QRAW) + (size_t)t * NQ;
        const bf16_t* kvraw = (const bf16_t*)(ws + WS_KVRAW) + (size_t)t * NKV;
        const u32x4 cq = *(const u32x4*)(proj + C_CQ + lane * 8);
        const u32x4 ck = *(const u32x4*)(proj + C_CKV + (lane & 31) * 8);
        const u32x4 kr = *(const u32x4*)(proj + C_KR + rpos * 8);
        const u32x4 qn0 = *(const u32x4*)(qraw + g16 * 192 + pos * 8), qn1 = *(const u32x4*)(qraw + (4 + g16) * 192 + pos * 8), qr = *(const u32x4*)(qraw + hr * 192 + 128 + rpos * 8);
        const u32x4 kn0 = *(const u32x4*)(kvraw + g16 * 256 + pos * 8), kn1 = *(const u32x4*)(kvraw + (4 + g16) * 256 + pos * 8);
        const u32x4 v0 = *(const u32x4*)(kvraw + g16 * 256 + 128 + pos * 8), v1 = *(const u32x4*)(kvraw + (4 + g16) * 256 + 128 + pos * 8);
        const float* rcp = (const float*)(ws + WS_ROPEC) + (size_t)t * 32 + f0; const float* rsp = (const float*)(ws + WS_ROPES) + (size_t)t * 32 + f0;
        const f32x4 c0 = *(const f32x4*)rcp, c1 = *(const f32x4*)(rcp + 4), s0 = *(const f32x4*)rsp, s1 = *(const f32x4*)(rsp + 4);
        const float rcq = rsqrtf(wave_sum(ssq8(cq)) * (1.f / 512.f) + EPS);
        const float rckv = rsqrtf(wave_sum(lane < 32 ? ssq8(ck) : 0.f) * (1.f / 256.f) + EPS);
        float skr = ssq8(kr), nq0 = ssq8(qn0), nq1 = ssq8(qn1), rqs = ssq8(qr), nk0 = ssq8(kn0), nk1 = ssq8(kn1);
#pragma unroll
        for (int o = 1; o < 8; o <<= 1) { skr += __shfl_xor(skr, o); rqs += __shfl_xor(rqs, o); nq0 += __shfl_xor(nq0, o); nq1 += __shfl_xor(nq1, o); nk0 += __shfl_xor(nk0, o); nk1 += __shfl_xor(nk1, o); }
        nq0 += __shfl_xor(nq0, 8); nq1 += __shfl_xor(nq1, 8); nk0 += __shfl_xor(nk0, 8); nk1 += __shfl_xor(nk1, 8);
        const float rc2 = rcq * rcq, rk2 = rckv * rckv;
        const float tq0 = nq0 + __shfl(rqs, 8 * g16), tq1 = nq1 + __shfl(rqs, 8 * (4 + g16));
        const float tqa = __shfl(nq0, 16 * (hr & 3)), tqb = __shfl(nq1, 16 * (hr & 3));
        const float tqr = rqs + ((hr < 4) ? tqa : tqb);
        const float sq0 = rsqrtf(tq0 * rc2 * (1.f / 192.f) + EPS) * rcq * QSCALE, sq1 = rsqrtf(tq1 * rc2 * (1.f / 192.f) + EPS) * rcq * QSCALE, sqr = rsqrtf(tqr * rc2 * (1.f / 192.f) + EPS) * rcq * QSCALE;
        const float rk0 = rsqrtf((nk0 * rk2 + skr) * (1.f / 192.f) + EPS), rk1 = rsqrtf((nk1 * rk2 + skr) * (1.f / 192.f) + EPS);
        const float rka = __shfl(rk0, 16 * (hr & 3)), rkb = __shfl(rk1, 16 * (hr & 3));
        const float rkr = (hr < 4) ? rka : rkb;
        const u32x4 pqr = shfl_xor4(qr, 4), pkr = shfl_xor4(kr, 4);
        const int b = t / SEQ, sidx = t % SEQ;
        bf16_t* Q0 = (bf16_t*)(ws + WS_Q) + ((size_t)(b * 8 + g16) * SEQ + sidx) * 192; bf16_t* Q1 = Q0 + (size_t)4 * SEQ * 192; bf16_t* Qr = (bf16_t*)(ws + WS_Q) + ((size_t)(b * 8 + hr) * SEQ + sidx) * 192;
        bf16_t* K0 = (bf16_t*)(ws + WS_K) + ((size_t)(b * 8 + g16) * SEQ + sidx) * 192; bf16_t* K1 = K0 + (size_t)4 * SEQ * 192; bf16_t* Kr = (bf16_t*)(ws + WS_K) + ((size_t)(b * 8 + hr) * SEQ + sidx) * 192;
        bf16_t* V0 = (bf16_t*)(ws + WS_V) + ((size_t)(b * 8 + g16) * SEQ + sidx) * 128; bf16_t* V1 = V0 + (size_t)4 * SEQ * 128;
        *(u32x4*)(Q0 + pos * 8) = scale8(qn0, sq0, gqn); *(u32x4*)(Q1 + pos * 8) = scale8(qn1, sq1, gqn);
        *(u32x4*)(Qr + 128 + rpos * 8) = rope8(qr, pqr, sqr, gqr, gqp, c0, c1, s0, s1, sgn);
        *(u32x4*)(K0 + pos * 8) = scale8(kn0, rckv * rk0, gkn); *(u32x4*)(K1 + pos * 8) = scale8(kn1, rckv * rk1, gkn);
        *(u32x4*)(Kr + 128 + rpos * 8) = rope8(kr, pkr, rkr, gkr, gkp, c0, c1, s0, s1, sgn);
        const float one[8] = {1.f, 1.f, 1.f, 1.f, 1.f, 1.f, 1.f, 1.f};
        *(u32x4*)(V0 + pos * 8) = scale8(v0, rckv, one); *(u32x4*)(V1 + pos * 8) = scale8(v1, rckv, one);
    }
}
__device__ __forceinline__ void ph_attn_naive(const Params& p, unsigned char* lds, int tid, int bid, int G) {
    const int lane = tid & 63, wv = tid >> 6;
    float* ps = (float*)lds + wv * SEQ;
    float* qs = (float*)(lds + 65536) + wv * 192;
    for (int it = 0; it < (T * 8) / (G * 8); ++it) {
        const int sb = (it & 1) ? (G - 1 - bid) : bid;
        const int gi = it * (G * 8) + sb * 8 + wv;
        const int bh = gi / SEQ, s = gi % SEQ, b = bh >> 3, h = bh & 7;
        const bf16_t* Q = (const bf16_t*)(p.ws + WS_Q) + (size_t)gi * 192;
        const bf16_t* K = (const bf16_t*)(p.ws + WS_K) + (size_t)bh * SEQ * 192;
        const bf16_t* V = (const bf16_t*)(p.ws + WS_KVRAW) + (size_t)(b * SEQ) * NKV + h * 256 + 128;
        for (int d = lane; d < 192; d += 64) qs[d] = bf2f(Q[d]);
        SYNC();
        float mx = -1e30f;
        for (int k0 = 0; k0 <= s; k0 += 64) {
            const int key = k0 + lane; float sc = -INFINITY;
            if (key <= s) {
                const u32x4* kp = (const u32x4*)(K + (size_t)key * 192); float a = 0.f;
                for (int c = 0; c < 24; ++c) { const u32x4 w = kp[c]; const float* q = &qs[c * 8];
                    a += bflo(w.x) * q[0] + bfhi(w.x) * q[1] + bflo(w.y) * q[2] + bfhi(w.y) * q[3] + bflo(w.z) * q[4] + bfhi(w.z) * q[5] + bflo(w.w) * q[6] + bfhi(w.w) * q[7]; }
                sc = a;
            }
            ps[key] = sc;
            mx = fmaxf(mx, sc);
        }
#pragma unroll
        for (int o = 1; o < 64; o <<= 1) mx = fmaxf(mx, __shfl_xor(mx, o));
        SYNC();
        float sum = 0.f;
        for (int key = lane; key <= s; key += 64) { const float e = exp2f(ps[key] - mx); ps[key] = e; sum += e; }
        sum = wave_sum(sum);
        SYNC();
        float o0 = 0.f, o1 = 0.f;
        for (int key = 0; key <= s; ++key) { const float pr = ps[key]; const unsigned w = *(const unsigned*)(V + (size_t)key * NKV + 2 * lane); o0 += pr * bflo(w); o1 += pr * bfhi(w); }
        const float inv = 1.f / sum; o0 *= inv; o1 *= inv;
        const int t = b * SEQ + s;
        *(unsigned*)((bf16_t*)(p.ws + WS_ATTN) + (size_t)t * 1024 + h * 128 + 2 * lane) = pk2(o0, o1);
        SYNC();
    }
}
__device__ __forceinline__ void ph_conv_naive(const Params& p, int gtid, int gn) {
    const bf16_t* proj = (const bf16_t*)(p.ws + WS_PROJ);
    for (int i = gtid; i < T * 1552; i += gn) {
        const int t = i / 1552, c = i % 1552, s = t % SEQ;
        if (c < 1536) {
            float a = p.conv_b[c];
            for (int k = 0; k < 4; ++k) { const int ss = s - 3 + k; if (ss >= 0) a += p.conv_w[k * 1536 + c] * bf2f(proj[(size_t)(t - 3 + k) * NPROJ + C_XBC + c]); }
            ((bf16_t*)(p.ws + WS_XBCA))[(size_t)t * 1536 + c] = (bf16_t)f2bf(silu_f(a));
        } else {
            const int hh = c - 1536; const float v = bf2f(proj[(size_t)t * NPROJ + C_DT + hh]) + p.dt_bias[hh];
            ((float*)(p.ws + WS_DT))[(size_t)t * 16 + hh] = (v > 20.f) ? v : log1pf(__expf(v));
        }
    }
}
__device__ __forceinline__ void ph_ssd_naive(const Params& p, int vb, int lt) {
    const int b = vb >> 4, h = vb & 15, g = h >> 3, pp = lt >> 2, nq = lt & 3;
    const bf16_t* xa = (const bf16_t*)(p.ws + WS_XBCA); const float* dtp = (const float*)(p.ws + WS_DT);
    const bf16_t* proj = (const bf16_t*)(p.ws + WS_PROJ);
    const float a = -__expf(p.a_log[h]), dsk = p.d_skip[h];
    float st[32];
#pragma unroll
    for (int n = 0; n < 32; ++n) st[n] = 0.f;
    for (int s = 0; s < SEQ; ++s) {
        const size_t t = (size_t)b * SEQ + s;
        const float dt = dtp[t * 16 + h], dA = __expf(dt * a);
        const float xv = bf2f(xa[t * 1536 + h * 64 + pp]);
        const bf16_t* Bp = xa + t * 1536 + 1024 + g * 128 + nq * 32; const bf16_t* Cp = xa + t * 1536 + 1280 + g * 128 + nq * 32;
        float y = 0.f; const float dx = dt * xv;
#pragma unroll
        for (int n = 0; n < 32; ++n) { st[n] = st[n] * dA + dx * bf2f(Bp[n]); y += bf2f(Cp[n]) * st[n]; }
        y += __shfl_xor(y, 1); y += __shfl_xor(y, 2);
        if (nq == 0) {
            const float z = bf2f(proj[t * NPROJ + C_Z + h * 64 + pp]);
            ((bf16_t*)(p.ws + WS_YSSD))[t * 1024 + h * 64 + pp] = (bf16_t)f2bf((y + dsk * xv) * silu_f(z));
        }
    }
}
__device__ __forceinline__ void ph_mixnorm(const Params& p, int gwave, int gnw, int lane) {
    for (int t = gwave; t < T; t += gnw) {
        const uint2* ain = (const uint2*)((const bf16_t*)(p.ws + WS_ATTN) + (size_t)t * 1024); const uint2* yin = (const uint2*)((const bf16_t*)(p.ws + WS_YSSD) + (size_t)t * 1024);
        uint2 a[4], y[4]; float sa = 0.f, s0 = 0.f, s1 = 0.f;
#pragma unroll
        for (int j = 0; j < 4; ++j) { a[j] = ain[lane + 64 * j]; y[j] = yin[lane + 64 * j]; sa += sq2(a[j].x) + sq2(a[j].y); const float q = sq2(y[j].x) + sq2(y[j].y); if (j < 2) s0 += q; else s1 += q; }
        const float ra = rsqrtf(wave_sum(sa) * (1.f / 1024.f) + EPS), r0 = rsqrtf(wave_sum(s0) * (1.f / 512.f) + EPS), r1 = rsqrtf(wave_sum(s1) * (1.f / 512.f) + EPS);
        uint2* o = (uint2*)((bf16_t*)(p.ws + WS_MIXIN) + (size_t)t * DM);
#pragma unroll
        for (int j = 0; j < 4; ++j) {
            uint2 r; r.x = pk2(bflo(a[j].x) * ra, bfhi(a[j].x) * ra); r.y = pk2(bflo(a[j].y) * ra, bfhi(a[j].y) * ra); o[lane + 64 * j] = r;
            const float rr = (j < 2) ? r0 : r1;
            uint2 q; q.x = pk2(bflo(y[j].x) * rr, bfhi(y[j].x) * rr); q.y = pk2(bflo(y[j].y) * rr, bfhi(y[j].y) * rr); o[256 + lane + 64 * j] = q;
        }
    }
}
__device__ __forceinline__ void ph_route_naive(const Params& p, unsigned char* lds, int tid, int bid, int G) {
    const int sub = tid >> 7, lt = tid & 127;
    float* base = (float*)(lds + sub * 4096);
    float* q = base; float* sc = base + 256; float* ts = base + 512; int* ti = (int*)(base + 544); float* cs = base + 576; float* bs = base + 832; int* bi = (int*)(base + 848);
    const bf16_t* sk = (const bf16_t*)(p.ws + WS_SUBK);
    for (int it = 0; it < (T * 8) / (G * 4); ++it) {
        const int vb = it * (G * 4) + bid * 4 + sub, t = vb >> 3, h = vb & 7;
        const bf16_t* qp = (const bf16_t*)(p.ws + WS_QP) + (size_t)t * DM + h * 256;
        q[lt] = bf2f(qp[lt]); q[128 + lt] = bf2f(qp[128 + lt]);
        SYNC();
#pragma unroll
        for (int j = 0; j < 2; ++j) {
            const u32x4* kp = (const u32x4*)(sk + ((size_t)(h * 2 + j) * 128 + lt) * 128); float a = 0.f;
            for (int c = 0; c < 16; ++c) { const u32x4 w = kp[c]; const float* qq = q + j * 128 + c * 8;
                a += bflo(w.x) * qq[0] + bfhi(w.x) * qq[1] + bflo(w.y) * qq[2] + bfhi(w.y) * qq[3] + bflo(w.z) * qq[4] + bfhi(w.z) * qq[5] + bflo(w.w) * qq[6] + bfhi(w.w) * qq[7]; }
            sc[j * 128 + lt] = a;
        }
        SYNC();
#pragma unroll
        for (int j = 0; j < 2; ++j) {
            const float v = sc[j * 128 + lt]; int rank = 0;
            for (int k = 0; k < 128; ++k) { const float o = sc[j * 128 + k]; rank += (o > v || (o == v && k < lt)) ? 1 : 0; }
            if (rank < 16) { ts[j * 16 + rank] = v; ti[j * 16 + rank] = lt; }
        }
        SYNC();
        cs[lt] = ts[lt >> 4] + ts[16 + (lt & 15)]; cs[128 + lt] = ts[8 + (lt >> 4)] + ts[16 + (lt & 15)];
        SYNC();
#pragma unroll
        for (int r = 0; r < 2; ++r) {
            const int ci = lt + 128 * r; const float v = cs[ci]; int rank = 0;
            for (int k = 0; k < 256; ++k) { const float o = cs[k]; rank += (o > v || (o == v && k < ci)) ? 1 : 0; }
            if (rank < 16) { bs[rank] = v; bi[rank] = ti[ci >> 4] * 128 + ti[16 + (ci & 15)]; }
        }
        SYNC();
        if (lt < 16) {
            const float mx = bs[0]; float sum = 0.f;
            for (int k = 0; k < 16; ++k) sum += __expf(bs[k] - mx);
            ((float*)(p.ws + WS_GATE))[(size_t)t * 128 + h * 16 + lt] = __expf(bs[lt] - mx) / sum;
            ((int*)(p.ws + WS_IDX))[(size_t)t * 128 + h * 16 + lt] = bi[lt];
        }
        SYNC();
    }
}
__device__ __forceinline__ void ph_peer_naive(const Params& p, unsigned char* lds, int tid, int bid, int G) {
    const int half = tid >> 8, lt = tid & 255, lane = tid & 63, wv = lt >> 6;
    float* red = (float*)(lds + half * 64);
    const bf16_t* U = (const bf16_t*)(p.ws + WS_U16); const bf16_t* V = (const bf16_t*)(p.ws + WS_V16);
    for (int it = 0; it < T / (G * 2); ++it) {
        const int t = it * (G * 2) + bid * 2 + half, b = t / SEQ;
        const u32x4 hw = *(const u32x4*)((const bf16_t*)(p.ws + WS_H2) + (size_t)t * DM + lt * 8);
        const float h0 = bflo(hw.x), h1 = bfhi(hw.x), h2 = bflo(hw.y), h3 = bfhi(hw.y), h4 = bflo(hw.z), h5 = bfhi(hw.z), h6 = bflo(hw.w), h7 = bfhi(hw.w);
        float o0 = 0.f, o1 = 0.f, o2 = 0.f, o3 = 0.f, o4 = 0.f, o5 = 0.f, o6 = 0.f, o7 = 0.f;
        const int* idx = (const int*)(p.ws + WS_IDX) + (size_t)t * 128; const float* gate = (const float*)(p.ws + WS_GATE) + (size_t)t * 128;
        for (int e = 0; e < 128; ++e) {
            const int ex = idx[e];
            const u32x4 uw = *(const u32x4*)(U + (size_t)ex * DM + lt * 8);
            float d = bflo(uw.x) * h0 + bfhi(uw.x) * h1 + bflo(uw.y) * h2 + bfhi(uw.y) * h3 + bflo(uw.z) * h4 + bfhi(uw.z) * h5 + bflo(uw.w) * h6 + bfhi(uw.w) * h7;
            d = wave_sum(d);
            if (lane == 0) red[wv] = d;
            SYNC();
            const float pre = red[0] + red[1] + red[2] + red[3];
            const float a = 0.5f * pre * (1.f + erff(pre * 0.70710678118654752f)) * gate[e];
            SYNC();
            const u32x4 vw = *(const u32x4*)(V + (size_t)ex * DM + lt * 8);
            o0 += a * bflo(vw.x); o1 += a * bfhi(vw.x); o2 += a * bflo(vw.y); o3 += a * bfhi(vw.y); o4 += a * bflo(vw.z); o5 += a * bfhi(vw.z); o6 += a * bflo(vw.w); o7 += a * bfhi(vw.w);
        }
        const float* g2 = (const float*)(p.ws + WS_MOD) + (size_t)b * 6 * DM + 5 * DM + lt * 8;
        float* outp = p.out + (size_t)t * DM + lt * 8;
        const f32x4 x0 = *(const f32x4*)outp, x1 = *(const f32x4*)(outp + 4), ga = *(const f32x4*)g2, gb = *(const f32x4*)(g2 + 4);
        *(f32x4*)outp = (f32x4){x0.x + ga.x * o0, x0.y + ga.y * o1, x0.z + ga.z * o2, x0.w + ga.w * o3};
        *(f32x4*)(outp + 4) = (f32x4){x1.x + gb.x * o4, x1.y + gb.y * o5, x1.z + gb.z * o6, x1.w + gb.w * o7};
    }
}
typedef __bf16 bf16x2_t __attribute__((ext_vector_type(2)));
__device__ __forceinline__ float dot2bf(unsigned a, unsigned b, float c) { return __builtin_amdgcn_fdot2_f32_bf16(__builtin_bit_cast(bf16x2_t, a), __builtin_bit_cast(bf16x2_t, b), c, false); }
__device__ __forceinline__ void ph_peer(const Params& p, LAS unsigned char* ldsl, int wave, int lane, int gwave, int gnw) {
    LAS unsigned char* ring = ldsl + wave * 16384;
    const bf16_t* U = (const bf16_t*)(p.ws + WS_U16); const bf16_t* V = (const bf16_t*)(p.ws + WS_V16);
    const int e_lane = (lane >> 2) & 15; const unsigned lane16 = (unsigned)lane * 16u;
#define PEER_ISSUE(R) do { const int R_ = (R); const int i_ = ((R_ >> 5) << 4) + (R_ & 15); \
        const int e_ = (i_ < 64) ? __builtin_amdgcn_readlane(idx0, i_) : __builtin_amdgcn_readlane(idx1, i_ - 64); \
        const char* base_ = (const char*)(((R_ >> 4) & 1) ? V : U) + (size_t)(unsigned)e_ * (DM * 2); \
        const unsigned* src_ = (const unsigned*)(base_ + lane16); \
        LAS unsigned* dst_ = (LAS unsigned*)(ring + (R_ & 3) * 4096); \
        __builtin_amdgcn_global_load_lds(src_, dst_, 16, 0, 0); \
        __builtin_amdgcn_global_load_lds(src_, dst_, 16, 1024, 0); \
        __builtin_amdgcn_global_load_lds(src_, dst_, 16, 2048, 0); \
        __builtin_amdgcn_global_load_lds(src_, dst_, 16, 3072, 0); } while (0)
#define PEER_WAIT(n) asm volatile("s_waitcnt vmcnt(" #n ")" ::: "memory")
    for (int t = gwave; t < T; t += gnw) {
        const int b = t / SEQ;
        const int idx0 = ((const int*)(p.ws + WS_IDX))[(size_t)t * 128 + lane], idx1 = ((const int*)(p.ws + WS_IDX))[(size_t)t * 128 + 64 + lane];
        const float g0 = ((const float*)(p.ws + WS_GATE))[(size_t)t * 128 + lane], g1 = ((const float*)(p.ws + WS_GATE))[(size_t)t * 128 + 64 + lane];
        u32x4 hreg[4];
#pragma unroll
        for (int j = 0; j < 4; ++j) hreg[j] = *(const u32x4*)((const bf16_t*)(p.ws + WS_H2) + (size_t)t * DM + j * 512 + lane * 8);
        float out[4][8];
#pragma unroll
        for (int j = 0; j < 4; ++j)
#pragma unroll
            for (int i = 0; i < 8; ++i) out[j][i] = 0.f;
        PEER_ISSUE(0); PEER_ISSUE(1); PEER_ISSUE(2);
        for (int hh = 0; hh < 8; ++hh) {
            float pd[16];
#pragma unroll
            for (int k = 0; k < 16; ++k) {
                PEER_ISSUE(hh * 32 + k + 3); PEER_WAIT(12);
                const LAS unsigned char* sl = ring + (k & 3) * 4096 + lane * 16;
                float a = 0.f;
#pragma unroll
                for (int j = 0; j < 4; ++j) { const u32x4 w = *(const LAS u32x4*)(sl + j * 1024);
                    a = dot2bf(w.x, hreg[j].x, a); a = dot2bf(w.y, hreg[j].y, a); a = dot2bf(w.z, hreg[j].z, a); a = dot2bf(w.w, hreg[j].w, a); }
                asm volatile("" : "+v"(a));
                pd[k] = a;
            }
            float q8[8], q4[4], q2[2], q1;
            { const bool hi = (lane & 32) != 0;
#pragma unroll
              for (int i = 0; i < 8; ++i) { const float keep = hi ? pd[i + 8] : pd[i], send = hi ? pd[i] : pd[i + 8]; q8[i] = keep + __shfl_xor(send, 32); } }
            { const bool hi = (lane & 16) != 0;
#pragma unroll
              for (int i = 0; i < 4; ++i) { const float keep = hi ? q8[i + 4] : q8[i], send = hi ? q8[i] : q8[i + 4]; q4[i] = keep + __shfl_xor(send, 16); } }
            { const bool hi = (lane & 8) != 0;
#pragma unroll
              for (int i = 0; i < 2; ++i) { const float keep = hi ? q4[i + 2] : q4[i], send = hi ? q4[i] : q4[i + 2]; q2[i] = keep + __shfl_xor(send, 8); } }
            { const bool hi = (lane & 4) != 0; const float keep = hi ? q2[1] : q2[0], send = hi ? q2[0] : q2[1]; q1 = keep + __shfl_xor(send, 4); }
            q1 += __shfl_xor(q1, 1); q1 += __shfl_xor(q1, 2);
            const float gsel = (hh < 4) ? g0 : g1;
            const float gate = __shfl(gsel, (hh & 3) * 16 + e_lane);
            const float act = 0.5f * q1 * (1.f + erff(q1 * 0.70710678118654752f)) * gate;
#pragma unroll
            for (int k = 0; k < 16; ++k) {
                if (k < 13) { PEER_ISSUE(hh * 32 + 16 + k + 3); PEER_WAIT(12); }
                else if (hh < 7) { PEER_ISSUE(hh * 32 + 16 + k + 3); PEER_WAIT(12); }
                else if (k == 13) PEER_WAIT(8); else if (k == 14) PEER_WAIT(4); else PEER_WAIT(0);
                const float a = __builtin_bit_cast(float, __builtin_amdgcn_readlane(__builtin_bit_cast(int, act), 4 * k));
                const LAS unsigned char* sl = ring + (k & 3) * 4096 + lane * 16;
#pragma unroll
                for (int j = 0; j < 4; ++j) { const u32x4 w = *(const LAS u32x4*)(sl + j * 1024);
                    out[j][0] += a * bflo(w.x); out[j][1] += a * bfhi(w.x); out[j][2] += a * bflo(w.y); out[j][3] += a * bfhi(w.y);
                    out[j][4] += a * bflo(w.z); out[j][5] += a * bfhi(w.z); out[j][6] += a * bflo(w.w); out[j][7] += a * bfhi(w.w);
                    asm volatile("" : "+v"(out[j][0]), "+v"(out[j][1]), "+v"(out[j][2]), "+v"(out[j][3]), "+v"(out[j][4]), "+v"(out[j][5]), "+v"(out[j][6]), "+v"(out[j][7])); }
            }
        }
        const float* g2 = (const float*)(p.ws + WS_MOD) + (size_t)b * 6 * DM + 5 * DM;
        float* outp = p.out + (size_t)t * DM;
#pragma unroll
        for (int j = 0; j < 4; ++j) {
            const int c = j * 512 + lane * 8;
            const f32x4 x0 = *(const f32x4*)(outp + c), x1 = *(const f32x4*)(outp + c + 4), ga = *(const f32x4*)(g2 + c), gb = *(const f32x4*)(g2 + c + 4);
            *(f32x4*)(outp + c) = (f32x4){x0.x + ga.x * out[j][0], x0.y + ga.y * out[j][1], x0.z + ga.z * out[j][2], x0.w + ga.w * out[j][3]};
            *(f32x4*)(outp + c + 4) = (f32x4){x1.x + gb.x * out[j][4], x1.y + gb.y * out[j][5], x1.z + gb.z * out[j][6], x1.w + gb.w * out[j][7]};
        }
    }
#undef PEER_ISSUE
#undef PEER_WAIT
}
typedef short bf16x8 __attribute__((ext_vector_type(8)));
typedef short s16x4 __attribute__((ext_vector_type(4)));
typedef float f32x16 __attribute__((ext_vector_type(16)));
typedef float f32x2_t __attribute__((ext_vector_type(2)));
__device__ __forceinline__ int crow(int r, int hi) { return (r & 3) + 8 * (r >> 2) + 4 * hi; }
__device__ __forceinline__ unsigned cvtpk(float lo, float hi) { f32x2_t v = {lo, hi}; bf16x2_t b = __builtin_convertvector(v, bf16x2_t); return __builtin_bit_cast(unsigned, b); }
__device__ __forceinline__ s16x4 vtr(const LAS unsigned char* pp) { return __builtin_bit_cast(s16x4, __builtin_amdgcn_ds_read_tr16_b64_v4i16((LAS s16x4*)pp)); }
#define TR_PAIR(lo_, hi_, addr_, off_, hioff_) do { asm volatile("ds_read_b64_tr_b16 %0, %1 offset:%c2" : "=&v"(lo_) : "v"(addr_), "i"(off_) : "memory"); \
        asm volatile("ds_read_b64_tr_b16 %0, %1 offset:%c2" : "=&v"(hi_) : "v"(addr_), "i"((off_) + (hioff_)) : "memory"); } while (0)
#define LDS_WAIT_PIN() do { asm volatile("s_waitcnt lgkmcnt(0)" ::: "memory"); __builtin_amdgcn_sched_barrier(0); } while (0)
constexpr int AT_SLOT = 40960, AT_VOFF = 24576;
__device__ __forceinline__ void attn_unit(const Params& p, LAS unsigned char* ldsl, int bh, int qb, int wave, int lane) {
    const int r32 = lane & 31, hi = lane >> 5, b = bh >> 3, h = bh & 7;
    const bf16_t* Kbh = (const bf16_t*)(p.ws + WS_K) + (size_t)bh * SEQ * 192;
    const bf16_t* Vb = (const bf16_t*)(p.ws + WS_V) + (size_t)bh * SEQ * 128;
    const bf16_t* Qw = (const bf16_t*)(p.ws + WS_Q) + ((size_t)bh * SEQ + qb * 256 + wave * 32 + r32) * 192 + 8 * hi;
    const int NT = (qb * 256 + 256) / 64;
    int koff[3];
#pragma unroll
    for (int i = 0; i < 3; ++i) { const int o = 64 * (wave * 3 + i) + lane, k = o / 24, sl = o - 24 * k; int c = sl - ((k >> 1) & 7); c += (c < 0) ? 24 : 0; koff[i] = k * 192 + c * 8; }
    const int vid = wave * 2;
    const bf16_t* vsrc = Vb + (size_t)(16 * (vid & 3) + (lane >> 2)) * 128 + (vid >> 2) * 32 + (lane & 3) * 8;
#define AT_ISSUE(t, slot) do { const bf16_t* ks_ = Kbh + (size_t)(t) * 64 * 192; LAS unsigned char* sb_ = ldsl + (slot) * AT_SLOT; \
        __builtin_amdgcn_global_load_lds((const unsigned*)(ks_ + koff[0]), (LAS unsigned*)(sb_ + (wave * 3 + 0) * 1024), 16, 0, 0); \
        __builtin_amdgcn_global_load_lds((const unsigned*)(ks_ + koff[1]), (LAS unsigned*)(sb_ + (wave * 3 + 1) * 1024), 16, 0, 0); \
        __builtin_amdgcn_global_load_lds((const unsigned*)(ks_ + koff[2]), (LAS unsigned*)(sb_ + (wave * 3 + 2) * 1024), 16, 0, 0); \
        const bf16_t* vs_ = vsrc + (size_t)(t) * 64 * 128; \
        __builtin_amdgcn_global_load_lds((const unsigned*)(vs_), (LAS unsigned*)(sb_ + AT_VOFF + vid * 1024), 16, 0, 0); \
        __builtin_amdgcn_global_load_lds((const unsigned*)(vs_ + (size_t)16 * 128), (LAS unsigned*)(sb_ + AT_VOFF + (vid + 1) * 1024), 16, 0, 0); } while (0)
    bf16x8 qr[12];
#pragma unroll
    for (int s = 0; s < 12; ++s) qr[s] = *(const bf16x8*)(Qw + 16 * s);
#pragma unroll
    for (int s = 0; s < 12; ++s) asm volatile("" : "+v"(qr[s]));
    AT_ISSUE(0, 0); AT_ISSUE(1, 1);
    f32x16 o[4];
#pragma unroll
    for (int d0 = 0; d0 < 4; ++d0)
#pragma unroll
        for (int r = 0; r < 16; ++r) o[d0][r] = 0.f;
    float m = -1e30f, l = 0.f;
    const int kfo = r32 * 384, kc0 = hi + ((r32 >> 1) & 7);
    const int vfo = AT_VOFF + ((lane >> 4) & 1) * 32 + (lane & 3) * 8 + (4 * hi + ((lane & 15) >> 2)) * 64;
    const int qrel = wave * 32 + r32;
    int slot = 0;
    for (int t = 0; t < NT; ++t) {
        if (t + 1 < NT) asm volatile("s_waitcnt vmcnt(5)" ::: "memory"); else asm volatile("s_waitcnt vmcnt(0)" ::: "memory");
        __builtin_amdgcn_s_barrier(); asm volatile("" ::: "memory");
        if (t + 2 < NT) { const int s2 = (slot == 0) ? 2 : slot - 1; AT_ISSUE(t + 2, s2); }
        const int jb = t - (NT - 4);
        if (!(jb >= 0 && 64 * jb > wave * 32 + 31)) {
            const LAS unsigned char* kp = ldsl + slot * AT_SLOT + kfo;
            int kc = kc0; asm volatile("" : "+v"(kc));
            f32x16 p0, p1;
#pragma unroll
            for (int r = 0; r < 16; ++r) { p0[r] = 0.f; p1[r] = 0.f; }
#pragma unroll
            for (int s = 0; s < 12; ++s) {
                int sl_ = kc + 2 * s; sl_ -= (sl_ >= 24) ? 24 : 0;
                const bf16x8 k0 = *(const LAS bf16x8*)(kp + sl_ * 16), k1 = *(const LAS bf16x8*)(kp + sl_ * 16 + 32 * 384);
                p0 = __builtin_amdgcn_mfma_f32_32x32x16_bf16(k0, qr[s], p0, 0, 0, 0);
                p1 = __builtin_amdgcn_mfma_f32_32x32x16_bf16(k1, qr[s], p1, 0, 0, 0);
            }
            if (jb >= 0 && 64 * jb + 63 > wave * 32) {
#pragma unroll
                for (int r = 0; r < 16; ++r) { const int kv = 64 * jb + crow(r, hi); if (kv > qrel) p0[r] = -INFINITY; if (kv + 32 > qrel) p1[r] = -INFINITY; }
            }
            float rm = fmaxf(p0[0], p1[0]);
#pragma unroll
            for (int r = 1; r < 16; ++r) rm = fmaxf(rm, fmaxf(p0[r], p1[r]));
            rm = fmaxf(rm, __shfl_xor(rm, 32));
            const float mn = fmaxf(m, rm);
            if (__any(mn > m)) {
                const float alpha = __builtin_amdgcn_exp2f(m - mn);
                l *= alpha;
#pragma unroll
                for (int r = 0; r < 16; ++r) { const float ar = __shfl(alpha, crow(r, hi));
#pragma unroll
                    for (int d0 = 0; d0 < 4; ++d0) o[d0][r] *= ar; }
                m = mn;
            }
            float ls = 0.f;
#pragma unroll
            for (int r = 0; r < 16; ++r) { p0[r] = __builtin_amdgcn_exp2f(p0[r] - m); p1[r] = __builtin_amdgcn_exp2f(p1[r] - m); ls += p0[r] + p1[r]; }
            l += ls;
            bf16x8 pa[4];
            { u32x4 w;
              w.x = cvtpk(p0[0], p0[1]); w.y = cvtpk(p0[2], p0[3]); w.z = cvtpk(p0[4], p0[5]); w.w = cvtpk(p0[6], p0[7]); pa[0] = __builtin_bit_cast(bf16x8, w);
              w.x = cvtpk(p0[8], p0[9]); w.y = cvtpk(p0[10], p0[11]); w.z = cvtpk(p0[12], p0[13]); w.w = cvtpk(p0[14], p0[15]); pa[1] = __builtin_bit_cast(bf16x8, w);
              w.x = cvtpk(p1[0], p1[1]); w.y = cvtpk(p1[2], p1[3]); w.z = cvtpk(p1[4], p1[5]); w.w = cvtpk(p1[6], p1[7]); pa[2] = __builtin_bit_cast(bf16x8, w);
              w.x = cvtpk(p1[8], p1[9]); w.y = cvtpk(p1[10], p1[11]); w.z = cvtpk(p1[12], p1[13]); w.w = cvtpk(p1[14], p1[15]); pa[3] = __builtin_bit_cast(bf16x8, w); }
            const unsigned vpa = (unsigned)(size_t)(ldsl + slot * AT_SLOT + vfo);
#pragma unroll
            for (int d0 = 0; d0 < 4; ++d0) {
                s16x4 lo[4], hh[4];
                TR_PAIR(lo[0], hh[0], vpa, d0 * 4096 + 0 * 1024, 512); TR_PAIR(lo[1], hh[1], vpa, d0 * 4096 + 1 * 1024, 512);
                TR_PAIR(lo[2], hh[2], vpa, d0 * 4096 + 2 * 1024, 512); TR_PAIR(lo[3], hh[3], vpa, d0 * 4096 + 3 * 1024, 512);
                LDS_WAIT_PIN();
#pragma unroll
                for (int ks = 0; ks < 4; ++ks)
                    o[d0] = __builtin_amdgcn_mfma_f32_32x32x16_bf16(pa[ks], (bf16x8){lo[ks][0], lo[ks][1], lo[ks][2], lo[ks][3], hh[ks][0], hh[ks][1], hh[ks][2], hh[ks][3]}, o[d0], 0, 0, 0);
            }
        }
        slot = (slot == 2) ? 0 : slot + 1;
    }
    l += __shfl_xor(l, 32);
    const float inv = 1.f / l;
    bf16_t* Ow = (bf16_t*)(p.ws + WS_MIXRAW) + ((size_t)b * SEQ + qb * 256 + wave * 32) * DM + h * 128 + r32;
#pragma unroll
    for (int r = 0; r < 16; ++r) { const float ir = __shfl(inv, crow(r, hi));
#pragma unroll
        for (int d0 = 0; d0 < 4; ++d0) Ow[(size_t)crow(r, hi) * DM + d0 * 32] = (bf16_t)f2bf(o[d0][r] * ir); }
    __builtin_amdgcn_sched_barrier(0);
    float ssr[16];
#pragma unroll
    for (int r = 0; r < 16; ++r) { const float ir = __shfl(inv, crow(r, hi)); const float v0 = o[0][r] * ir, v1 = o[1][r] * ir, v2 = o[2][r] * ir, v3 = o[3][r] * ir; ssr[r] = (v0 * v0 + v1 * v1) + (v2 * v2 + v3 * v3); }
    float q8[8], q4[4], q2[2], q1;
    { const bool bb = (lane & 16) != 0;
#pragma unroll
      for (int i = 0; i < 8; ++i) { const float keep = bb ? ssr[i + 8] : ssr[i], send = bb ? ssr[i] : ssr[i + 8]; q8[i] = keep + __shfl_xor(send, 16); } }
    { const bool bb = (lane & 8) != 0;
#pragma unroll
      for (int i = 0; i < 4; ++i) { const float keep = bb ? q8[i + 4] : q8[i], send = bb ? q8[i] : q8[i + 4]; q4[i] = keep + __shfl_xor(send, 8); } }
    { const bool bb = (lane & 4) != 0;
#pragma unroll
      for (int i = 0; i < 2; ++i) { const float keep = bb ? q4[i + 2] : q4[i], send = bb ? q4[i] : q4[i + 2]; q2[i] = keep + __shfl_xor(send, 4); } }
    { const bool bb = (lane & 2) != 0; const float keep = bb ? q2[1] : q2[0], send = bb ? q2[0] : q2[1]; q1 = keep + __shfl_xor(send, 2); }
    q1 += __shfl_xor(q1, 1);
    { const int rs = ((lane >> 4) & 1) * 8 + ((lane >> 3) & 1) * 4 + ((lane >> 2) & 1) * 2 + ((lane >> 1) & 1);
      if ((lane & 1) == 0) ((float*)(p.ws + WS_PSQA))[((size_t)b * SEQ + qb * 256 + wave * 32 + crow(rs, hi)) * 8 + h] = q1; }
    asm volatile("s_waitcnt lgkmcnt(0)" ::: "memory"); __builtin_amdgcn_s_barrier(); asm volatile("" ::: "memory");
#undef AT_ISSUE
}
__device__ __forceinline__ void ph_attn(const Params& p, LAS unsigned char* ldsl, int bid, int G, int wave, int lane) {
    const int vcu = (bid & 7) * (G >> 3) + (bid >> 3);
    const int bh = vcu >> 2, s = vcu & 3;
    attn_unit(p, ldsl, bh, 7 - s, wave, lane);
    attn_unit(p, ldsl, bh, s, wave, lane);
}
__device__ __forceinline__ int f2sort(float f) { const int u = __builtin_bit_cast(int, f); return u ^ ((u >> 31) & 0x7fffffff); }
__device__ __forceinline__ float sort2f(int k) { return __builtin_bit_cast(float, k ^ ((k >> 31) & 0x7fffffff)); }
#define CE_(a_, b_) do { const int hi_ = max(a_, b_); b_ = min(a_, b_); a_ = hi_; } while (0)
#define INS16(L, x) do { int x_ = (x); _Pragma("unroll") for (int i_ = 0; i_ < 16; ++i_) { const int hi_ = max(L[i_], x_); x_ = min(L[i_], x_); L[i_] = hi_; } } while (0)
#define SORT16(v) do { CE_(v[0], v[13]); CE_(v[1], v[12]); CE_(v[2], v[15]); CE_(v[3], v[14]); CE_(v[4], v[8]); CE_(v[5], v[6]); CE_(v[7], v[11]); CE_(v[9], v[10]); CE_(v[0], v[5]); CE_(v[1], v[7]); CE_(v[2], v[9]); CE_(v[3], v[4]); CE_(v[6], v[13]); CE_(v[8], v[14]); CE_(v[10], v[15]); CE_(v[11], v[12]); CE_(v[0], v[1]); CE_(v[2], v[3]); CE_(v[4], v[5]); CE_(v[6], v[8]); CE_(v[7], v[9]); CE_(v[10], v[11]); CE_(v[12], v[13]); CE_(v[14], v[15]); CE_(v[0], v[2]); CE_(v[1], v[3]); CE_(v[4], v[10]); CE_(v[5], v[11]); CE_(v[6], v[7]); CE_(v[8], v[9]); CE_(v[12], v[14]); CE_(v[13], v[15]); CE_(v[1], v[2]); CE_(v[3], v[12]); CE_(v[4], v[6]); CE_(v[5], v[7]); CE_(v[8], v[10]); CE_(v[9], v[11]); CE_(v[13], v[14]); CE_(v[1], v[4]); CE_(v[2], v[6]); CE_(v[5], v[8]); CE_(v[7], v[10]); CE_(v[9], v[13]); CE_(v[11], v[14]); CE_(v[2], v[4]); CE_(v[3], v[6]); CE_(v[9], v[12]); CE_(v[11], v[13]); CE_(v[3], v[5]); CE_(v[6], v[8]); CE_(v[7], v[9]); CE_(v[10], v[12]); CE_(v[3], v[4]); CE_(v[5], v[6]); CE_(v[7], v[8]); CE_(v[9], v[10]); CE_(v[11], v[12]); CE_(v[6], v[7]); CE_(v[8], v[9]); } while (0)
#define BMERGE16(v) do { CE_(v[0], v[8]); CE_(v[1], v[9]); CE_(v[2], v[10]); CE_(v[3], v[11]); CE_(v[4], v[12]); CE_(v[5], v[13]); CE_(v[6], v[14]); CE_(v[7], v[15]); CE_(v[0], v[4]); CE_(v[1], v[5]); CE_(v[2], v[6]); CE_(v[3], v[7]); CE_(v[8], v[12]); CE_(v[9], v[13]); CE_(v[10], v[14]); CE_(v[11], v[15]); CE_(v[0], v[2]); CE_(v[1], v[3]); CE_(v[4], v[6]); CE_(v[5], v[7]); CE_(v[8], v[10]); CE_(v[9], v[11]); CE_(v[12], v[14]); CE_(v[13], v[15]); CE_(v[0], v[1]); CE_(v[2], v[3]); CE_(v[4], v[5]); CE_(v[6], v[7]); CE_(v[8], v[9]); CE_(v[10], v[11]); CE_(v[12], v[13]); CE_(v[14], v[15]); } while (0)
__device__ __forceinline__ void ph_route(const Params& p, LAS unsigned char* ldsl, int wave, int lane, int gwave, int gnw) {
    const int r32 = lane & 31, hi = lane >> 5;
    const bf16_t* SK = (const bf16_t*)(p.ws + WS_SUBK);
    LAS unsigned char* tab = ldsl + wave * 4096 + lane * 32;
    for (int item = gwave; item < (T / 32) * 8; item += gnw) {
        const int tile = item >> 3, h = item & 7, t0 = tile * 32;
        int hi4 = hi * 4; asm volatile("" : "+v"(hi4));
        int S0[16], S1[16];
#pragma unroll
        for (int j = 0; j < 2; ++j) {
            const bf16_t* qp = (const bf16_t*)(p.ws + WS_QP) + (size_t)(t0 + r32) * DM + h * 256 + j * 128 + 8 * hi;
            asm volatile("" : "+v"(qp));
            bf16x8 bq[8];
#pragma unroll
            for (int s = 0; s < 8; ++s) bq[s] = *(const bf16x8*)(qp + 16 * s);
            int L[16];
#pragma unroll
            for (int kb = 0; kb < 4; ++kb) {
                const bf16_t* ap = SK + ((size_t)(h * 2 + j) * 128 + kb * 32 + r32) * 128 + 8 * hi;
                asm volatile("" : "+v"(ap));
                f32x16 acc;
#pragma unroll
                for (int r = 0; r < 16; ++r) acc[r] = 0.f;
#pragma unroll
                for (int s = 0; s < 8; ++s) acc = __builtin_amdgcn_mfma_f32_32x32x16_bf16(*(const bf16x8*)(ap + 16 * s), bq[s], acc, 0, 0, 0);
                int v[16];
#pragma unroll
                for (int r = 0; r < 16; ++r) v[r] = (f2sort(acc[r]) & ~127) | ((127 - (kb * 32 + (r & 3) + 8 * (r >> 2))) - hi4);
                SORT16(v);
                if (kb == 0) {
#pragma unroll
                    for (int i = 0; i < 16; ++i) L[i] = v[i];
                } else {
#pragma unroll
                    for (int i = 0; i < 16; ++i) L[i] = max(L[i], v[15 - i]);
                    BMERGE16(L);
                }
                __builtin_amdgcn_sched_barrier(0);
            }
            int Y[16];
#pragma unroll
            for (int i = 0; i < 16; ++i) Y[i] = __shfl_xor(L[i], 32);
#pragma unroll
            for (int i = 0; i < 16; ++i) L[i] = max(L[i], Y[15 - i]);
            BMERGE16(L);
#pragma unroll
            for (int i = 0; i < 16; ++i) { if (j == 0) S0[i] = L[i]; else S1[i] = L[i]; }
        }
        float f0[16], f1[16];
        {
            unsigned w0[4], w1[4];
#pragma unroll
            for (int i = 0; i < 16; ++i) { f0[i] = sort2f(S0[i] & ~127); f1[i] = sort2f(S1[i] & ~127); }
#pragma unroll
            for (int q = 0; q < 4; ++q) {
                w0[q] = (unsigned)(127 - (S0[4 * q] & 127)) | ((unsigned)(127 - (S0[4 * q + 1] & 127)) << 8) | ((unsigned)(127 - (S0[4 * q + 2] & 127)) << 16) | ((unsigned)(127 - (S0[4 * q + 3] & 127)) << 24);
                w1[q] = (unsigned)(127 - (S1[4 * q] & 127)) | ((unsigned)(127 - (S1[4 * q + 1] & 127)) << 8) | ((unsigned)(127 - (S1[4 * q + 2] & 127)) << 16) | ((unsigned)(127 - (S1[4 * q + 3] & 127)) << 24);
            }
            *(LAS u32x4*)(tab) = (u32x4){w0[0], w0[1], w0[2], w0[3]};
            *(LAS u32x4*)(tab + 16) = (u32x4){w1[0], w1[1], w1[2], w1[3]};
        }
        int Lv[16];
        Lv[0] = (f2sort(f0[0] + f1[0]) & ~255) | 255;
        Lv[1] = (f2sort(f0[0] + f1[1]) & ~255) | 254;
        Lv[2] = (f2sort(f0[0] + f1[2]) & ~255) | 253;
        Lv[3] = (f2sort(f0[0] + f1[3]) & ~255) | 252;
        Lv[4] = (f2sort(f0[0] + f1[4]) & ~255) | 251;
        Lv[5] = (f2sort(f0[0] + f1[5]) & ~255) | 250;
        Lv[6] = (f2sort(f0[0] + f1[6]) & ~255) | 249;
        Lv[7] = (f2sort(f0[0] + f1[7]) & ~255) | 248;
        Lv[8] = (f2sort(f0[0] + f1[8]) & ~255) | 247;
        Lv[9] = (f2sort(f0[0] + f1[9]) & ~255) | 246;
        Lv[10] = (f2sort(f0[0] + f1[10]) & ~255) | 245;
        Lv[11] = (f2sort(f0[0] + f1[11]) & ~255) | 244;
        Lv[12] = (f2sort(f0[0] + f1[12]) & ~255) | 243;
        Lv[13] = (f2sort(f0[0] + f1[13]) & ~255) | 242;
        Lv[14] = (f2sort(f0[0] + f1[14]) & ~255) | 241;
        Lv[15] = (f2sort(f0[0] + f1[15]) & ~255) | 240;
        { int cv_ = (f2sort(f0[1] + f1[0]) & ~255) | 239; INS16(Lv, cv_); __builtin_amdgcn_sched_barrier(0); }
        { int cv_ = (f2sort(f0[1] + f1[1]) & ~255) | 238; INS16(Lv, cv_); __builtin_amdgcn_sched_barrier(0); }
        { int cv_ = (f2sort(f0[1] + f1[2]) & ~255) | 237; INS16(Lv, cv_); __builtin_amdgcn_sched_barrier(0); }
        { int cv_ = (f2sort(f0[1] + f1[3]) & ~255) | 236; INS16(Lv, cv_); __builtin_amdgcn_sched_barrier(0); }
        { int cv_ = (f2sort(f0[1] + f1[4]) & ~255) | 235; INS16(Lv, cv_); __builtin_amdgcn_sched_barrier(0); }
        { int cv_ = (f2sort(f0[1] + f1[5]) & ~255) | 234; INS16(Lv, cv_); __builtin_amdgcn_sched_barrier(0); }
        { int cv_ = (f2sort(f0[1] + f1[6]) & ~255) | 233; INS16(Lv, cv_); __builtin_amdgcn_sched_barrier(0); }
        { int cv_ = (f2sort(f0[1] + f1[7]) & ~255) | 232; INS16(Lv, cv_); __builtin_amdgcn_sched_barrier(0); }
        { int cv_ = (f2sort(f0[2] + f1[0]) & ~255) | 223; INS16(Lv, cv_); __builtin_amdgcn_sched_barrier(0); }
        { int cv_ = (f2sort(f0[2] + f1[1]) & ~255) | 222; INS16(Lv, cv_); __builtin_amdgcn_sched_barrier(0); }
        { int cv_ = (f2sort(f0[2] + f1[2]) & ~255) | 221; INS16(Lv, cv_); __builtin_amdgcn_sched_barrier(0); }
        { int cv_ = (f2sort(f0[2] + f1[3]) & ~255) | 220; INS16(Lv, cv_); __builtin_amdgcn_sched_barrier(0); }
        { int cv_ = (f2sort(f0[2] + f1[4]) & ~255) | 219; INS16(Lv, cv_); __builtin_amdgcn_sched_barrier(0); }
        { int cv_ = (f2sort(f0[3] + f1[0]) & ~255) | 207; INS16(Lv, cv_); __builtin_amdgcn_sched_barrier(0); }
        { int cv_ = (f2sort(f0[3] + f1[1]) & ~255) | 206; INS16(Lv, cv_); __builtin_amdgcn_sched_barrier(0); }
        { int cv_ = (f2sort(f0[3] + f1[2]) & ~255) | 205; INS16(Lv, cv_); __builtin_amdgcn_sched_barrier(0); }
        { int cv_ = (f2sort(f0[3] + f1[3]) & ~255) | 204; INS16(Lv, cv_); __builtin_amdgcn_sched_barrier(0); }
        { int cv_ = (f2sort(f0[4] + f1[0]) & ~255) | 191; INS16(Lv, cv_); __builtin_amdgcn_sched_barrier(0); }
        { int cv_ = (f2sort(f0[4] + f1[1]) & ~255) | 190; INS16(Lv, cv_); __builtin_amdgcn_sched_barrier(0); }
        { int cv_ = (f2sort(f0[4] + f1[2]) & ~255) | 189; INS16(Lv, cv_); __builtin_amdgcn_sched_barrier(0); }
        { int cv_ = (f2sort(f0[5] + f1[0]) & ~255) | 175; INS16(Lv, cv_); __builtin_amdgcn_sched_barrier(0); }
        { int cv_ = (f2sort(f0[5] + f1[1]) & ~255) | 174; INS16(Lv, cv_); __builtin_amdgcn_sched_barrier(0); }
        { int cv_ = (f2sort(f0[6] + f1[0]) & ~255) | 159; INS16(Lv, cv_); __builtin_amdgcn_sched_barrier(0); }
        { int cv_ = (f2sort(f0[6] + f1[1]) & ~255) | 158; INS16(Lv, cv_); __builtin_amdgcn_sched_barrier(0); }
        { int cv_ = (f2sort(f0[7] + f1[0]) & ~255) | 143; INS16(Lv, cv_); __builtin_amdgcn_sched_barrier(0); }
        { int cv_ = (f2sort(f0[7] + f1[1]) & ~255) | 142; INS16(Lv, cv_); __builtin_amdgcn_sched_barrier(0); }
        { int cv_ = (f2sort(f0[8] + f1[0]) & ~255) | 127; INS16(Lv, cv_); __builtin_amdgcn_sched_barrier(0); }
        { int cv_ = (f2sort(f0[9] + f1[0]) & ~255) | 111; INS16(Lv, cv_); __builtin_amdgcn_sched_barrier(0); }
        { int cv_ = (f2sort(f0[10] + f1[0]) & ~255) | 95; INS16(Lv, cv_); __builtin_amdgcn_sched_barrier(0); }
        { int cv_ = (f2sort(f0[11] + f1[0]) & ~255) | 79; INS16(Lv, cv_); __builtin_amdgcn_sched_barrier(0); }
        { int cv_ = (f2sort(f0[12] + f1[0]) & ~255) | 63; INS16(Lv, cv_); __builtin_amdgcn_sched_barrier(0); }
        { int cv_ = (f2sort(f0[13] + f1[0]) & ~255) | 47; INS16(Lv, cv_); __builtin_amdgcn_sched_barrier(0); }
        { int cv_ = (f2sort(f0[14] + f1[0]) & ~255) | 31; INS16(Lv, cv_); __builtin_amdgcn_sched_barrier(0); }
        { int cv_ = (f2sort(f0[15] + f1[0]) & ~255) | 15; INS16(Lv, cv_); __builtin_amdgcn_sched_barrier(0); }
        float g[16]; float sum = 0.f; const float mx = sort2f(Lv[0] & ~255);
        int Le[16];
#pragma unroll
        for (int i = 0; i < 16; ++i) {
            g[i] = __expf(sort2f(Lv[i] & ~255) - mx); sum += g[i];
            const int pos = 255 - (Lv[i] & 255);
            const int ia = *(const LAS unsigned char*)(tab + (pos >> 4)), ib = *(const LAS unsigned char*)(tab + 16 + (pos & 15));
            Le[i] = ia * 128 + ib;
        }
        const float inv = 1.f / sum;
        if (hi == 0) {
            int* ip = (int*)(p.ws + WS_IDX) + (size_t)(t0 + r32) * 128 + h * 16; float* gp = (float*)(p.ws + WS_GATE) + (size_t)(t0 + r32) * 128 + h * 16;
#pragma unroll
            for (int i = 0; i < 4; ++i) {
                *(u32x4*)(ip + 4 * i) = (u32x4){(unsigned)Le[4 * i], (unsigned)Le[4 * i + 1], (unsigned)Le[4 * i + 2], (unsigned)Le[4 * i + 3]};
                *(f32x4*)(gp + 4 * i) = (f32x4){g[4 * i] * inv, g[4 * i + 1] * inv, g[4 * i + 2] * inv, g[4 * i + 3] * inv};
            }
        }
        asm volatile("s_waitcnt lgkmcnt(0)" ::: "memory");
    }
}
__device__ __forceinline__ void ph_conv(const Params& p, int gwave, int gnw, int lane) {
    const bf16_t* proj = (const bf16_t*)(p.ws + WS_PROJ);
    bf16_t* xa = (bf16_t*)(p.ws + WS_XBCA);
    for (int task = gwave; task < 1536 + 256; task += gnw) {
        if (task < 1536) {
            const int run = task / 3, cg = (task % 3) * 64 + lane, c0 = cg * 8;
            const int t0 = run * 32, s0 = t0 % SEQ;
            float w0[8], w1[8], w2[8], w3[8], bs[8], h1[8], h2[8], h3[8];
#pragma unroll
            for (int i = 0; i < 8; ++i) { w0[i] = p.conv_w[0 * 1536 + c0 + i]; w1[i] = p.conv_w[1 * 1536 + c0 + i]; w2[i] = p.conv_w[2 * 1536 + c0 + i]; w3[i] = p.conv_w[3 * 1536 + c0 + i]; bs[i] = p.conv_b[c0 + i]; h1[i] = 0.f; h2[i] = 0.f; h3[i] = 0.f; }
            const bf16_t* src = proj + (size_t)t0 * NPROJ + C_XBC + c0;
            if (s0 > 0) {
                const u32x4 a = *(const u32x4*)(src - (size_t)1 * NPROJ), b = *(const u32x4*)(src - (size_t)2 * NPROJ), c = *(const u32x4*)(src - (size_t)3 * NPROJ);
                h1[0] = bflo(a.x); h1[1] = bfhi(a.x); h1[2] = bflo(a.y); h1[3] = bfhi(a.y); h1[4] = bflo(a.z); h1[5] = bfhi(a.z); h1[6] = bflo(a.w); h1[7] = bfhi(a.w);
                h2[0] = bflo(b.x); h2[1] = bfhi(b.x); h2[2] = bflo(b.y); h2[3] = bfhi(b.y); h2[4] = bflo(b.z); h2[5] = bfhi(b.z); h2[6] = bflo(b.w); h2[7] = bfhi(b.w);
                h3[0] = bflo(c.x); h3[1] = bfhi(c.x); h3[2] = bflo(c.y); h3[3] = bfhi(c.y); h3[4] = bflo(c.z); h3[5] = bfhi(c.z); h3[6] = bflo(c.w); h3[7] = bfhi(c.w);
            }
            bf16_t* dst = xa + (size_t)t0 * 1536 + c0;
#pragma unroll 16
            for (int i = 0; i < 32; ++i) {
                const u32x4 a = *(const u32x4*)(src + (size_t)i * NPROJ);
                float cur[8] = {bflo(a.x), bfhi(a.x), bflo(a.y), bfhi(a.y), bflo(a.z), bfhi(a.z), bflo(a.w), bfhi(a.w)};
                float o[8];
#pragma unroll
                for (int k = 0; k < 8; ++k) { o[k] = silu_fast(bs[k] + w3[k] * cur[k] + w2[k] * h1[k] + w1[k] * h2[k] + w0[k] * h3[k]); h3[k] = h2[k]; h2[k] = h1[k]; h1[k] = cur[k]; }
                u32x4 w; w.x = pk2(o[0], o[1]); w.y = pk2(o[2], o[3]); w.z = pk2(o[4], o[5]); w.w = pk2(o[6], o[7]);
                *(u32x4*)(dst + (size_t)i * 1536) = w;
            }
        } else {
            const int t = (task - 1536) * 64 + lane;
            const u32x4 a = *(const u32x4*)(proj + (size_t)t * NPROJ + C_DT), b = *(const u32x4*)(proj + (size_t)t * NPROJ + C_DT + 8);
            const float raw[16] = {bflo(a.x), bfhi(a.x), bflo(a.y), bfhi(a.y), bflo(a.z), bfhi(a.z), bflo(a.w), bfhi(a.w), bflo(b.x), bfhi(b.x), bflo(b.y), bfhi(b.y), bflo(b.z), bfhi(b.z), bflo(b.w), bfhi(b.w)};
            float* dto = (float*)(p.ws + WS_DT) + (size_t)t * 16; float* cso = (float*)(p.ws + WS_CS) + (size_t)t * 16;
            float dtv[16], csv[16];
#pragma unroll
            for (int hh = 0; hh < 16; ++hh) {
                const float v = raw[hh] + p.dt_bias[hh];
                const float dt = (v > 20.f) ? v : log1pf(__expf(v));
                float c = dt * (-__expf(p.a_log[hh]));
#pragma unroll
                for (int o = 1; o < 64; o <<= 1) { const float u = __shfl_up(c, o); if (lane >= o) c += u; }
                dtv[hh] = dt; csv[hh] = c;
            }
#pragma unroll
            for (int q = 0; q < 4; ++q) { *(f32x4*)(dto + 4 * q) = (f32x4){dtv[4 * q], dtv[4 * q + 1], dtv[4 * q + 2], dtv[4 * q + 3]}; *(f32x4*)(cso + 4 * q) = (f32x4){csv[4 * q], csv[4 * q + 1], csv[4 * q + 2], csv[4 * q + 3]}; }
        }
    }
}
constexpr int P4_ROW = 1152;
__device__ __forceinline__ void fp4_row_load(const Params& p, int row, int lane, f32x4 (&v)[8]) {
    const f32x4* src = (const f32x4*)(((row >= 16384) ? p.v_exp : p.u_exp) + (size_t)(row & 16383) * DM) + lane;
#pragma unroll
    for (int j = 0; j < 8; ++j) v[j] = src[64 * j];
}
__device__ __forceinline__ void fp4_row_store(const Params& p, int row, int lane, const f32x4 (&v)[8]) {
    float mx = 0.f;
#pragma unroll
    for (int j = 0; j < 8; ++j) mx = fmaxf(mx, fmaxf(fmaxf(fabsf(v[j].x), fabsf(v[j].y)), fmaxf(fabsf(v[j].z), fabsf(v[j].w))));
    unsigned sb = f2bf(mx * (1.f / 6.f));
    if (bf2f(sb) * 6.f < mx) sb += 1u;
    if (sb == 0u) sb = 0x3f80u;
    const float inv = 1.f / bf2f(sb);
    unsigned w[4];
#pragma unroll
    for (int q = 0; q < 4; ++q) {
        const f32x4 a = v[2 * q] * inv, b = v[2 * q + 1] * inv;
        unsigned r = 0u;
        r = __builtin_amdgcn_cvt_scalef32_pk_fp4_f32(r, a.x, a.y, 1.0f, 0);
        r = __builtin_amdgcn_cvt_scalef32_pk_fp4_f32(r, a.z, a.w, 1.0f, 1);
        r = __builtin_amdgcn_cvt_scalef32_pk_fp4_f32(r, b.x, b.y, 1.0f, 2);
        r = __builtin_amdgcn_cvt_scalef32_pk_fp4_f32(r, b.z, b.w, 1.0f, 3);
        w[q] = r;
    }
    unsigned char* dst = p.ws + ((row >= 16384) ? WS_V4 : WS_U4) + (size_t)(row & 16383) * P4_ROW;
    *(u32x4*)(dst + lane * 16) = (u32x4){w[0], w[1], w[2], w[3]};
    *(unsigned short*)(dst + 1024 + lane * 2) = (unsigned short)sb;
}
constexpr int SSD_IN = 41472, SSD_BM = 0, SSD_CM = 16384, SSD_XS = 32768, SSD_Z = 36864, SSD_DT = 40960, SSD_CS = 41216, SSD_ST = 3 * SSD_IN, SSD_PART = SSD_ST + 16384, SSD_SYNC = SSD_PART + 4096;
__device__ __forceinline__ void ssd_decay_block(f32x16& cbt, const LAS float* csl, const LAS float* dtl, float cs_l, int sb, int l, int hi, bool diag) {
#pragma unroll
    for (int q = 0; q < 4; ++q) {
        const f32x4 c4 = *(const LAS f32x4*)(csl + 32 * sb + 8 * q + 4 * hi), d4 = *(const LAS f32x4*)(dtl + 32 * sb + 8 * q + 4 * hi);
#pragma unroll
        for (int i = 0; i < 4; ++i) {
            const int s = 32 * sb + 8 * q + 4 * hi + i;
            float e = __expf(cs_l - c4[i]) * d4[i];
            if (diag) e = (s <= l) ? e : 0.f;
            cbt[4 * q + i] *= e;
        }
    }
}
__device__ __forceinline__ void ph_ssd(const Params& p, LAS unsigned char* ldsl, int bid, int wave, int lane) {
    const int b = bid >> 5, h = (bid >> 1) & 15, ph = bid & 1, g = h >> 3;
    const int r32 = lane & 31, hi = lane >> 5;
    const size_t tb0 = (size_t)b * SEQ;
    LAS unsigned* sync = (LAS unsigned*)(ldsl + SSD_SYNC);
    if (threadIdx.x < 16) sync[threadIdx.x] = (threadIdx.x >= 14) ? 0xffffffffu : 0u;
    for (int i = threadIdx.x; i < 8192 / 16; i += NTHR) *(LAS u32x4*)(ldsl + SSD_ST + i * 16) = (u32x4){0u, 0u, 0u, 0u};
    asm volatile("s_waitcnt lgkmcnt(0)" ::: "memory"); __builtin_amdgcn_s_barrier(); asm volatile("" ::: "memory");
    if (wave >= 6) {
        const int cvw = bid * 2 + (wave - 6);
        f32x4 ra[8], rb[8], rc[8], rd[8];
        fp4_row_load(p, cvw, lane, ra); fp4_row_load(p, 512 + cvw, lane, rb); fp4_row_load(p, 1024 + cvw, lane, rc); fp4_row_load(p, 1536 + cvw, lane, rd);
        for (int c = 0; c < 16; ++c) {
            fp4_row_store(p, (4 * c) * 512 + cvw, lane, ra);
            if (c + 1 < 16) fp4_row_load(p, (4 * c + 4) * 512 + cvw, lane, ra);
            fp4_row_store(p, (4 * c + 1) * 512 + cvw, lane, rb);
            if (c + 1 < 16) fp4_row_load(p, (4 * c + 5) * 512 + cvw, lane, rb);
            fp4_row_store(p, (4 * c + 2) * 512 + cvw, lane, rc);
            if (c + 1 < 16) fp4_row_load(p, (4 * c + 6) * 512 + cvw, lane, rc);
            fp4_row_store(p, (4 * c + 3) * 512 + cvw, lane, rd);
            if (c + 1 < 16) fp4_row_load(p, (4 * c + 7) * 512 + cvw, lane, rd);
        }
    } else {
        const bf16_t* xa = (const bf16_t*)(p.ws + WS_XBCA); const bf16_t* proj = (const bf16_t*)(p.ws + WS_PROJ);
        const float dsk = p.d_skip[h];
        const int dq = (wave - 2) & 3;
        const int dr0 = 4 * dq + (lane >> 4);
        const bf16_t* bsrc = xa + (tb0 + dr0) * 1536 + 1024 + g * 128 + (((lane & 15) ^ (dr0 & 15)) * 8);
        const bf16_t* csrc = xa + (tb0 + dr0) * 1536 + 1280 + g * 128 + (((lane & 15) ^ (dr0 & 15)) * 8);
        const bf16_t* xsrc = xa + (tb0 + 16 * dq + (lane >> 2)) * 1536 + h * 64 + ph * 32 + (lane & 3) * 8;
        const bf16_t* zsrc = proj + (tb0 + 16 * dq + (lane >> 2)) * NPROJ + C_Z + h * 64 + ph * 32 + (lane & 3) * 8;
        const float* dsrc = (const float*)(p.ws + ((dq == 0) ? WS_DT : WS_CS)) + (tb0 + lane) * 16 + h;
#define SSD_G16(src, dst) __builtin_amdgcn_global_load_lds((const unsigned*)(src), (LAS unsigned*)(dst), 16, 0, 0)
#define SSD_ISSUE(c, buf) do { if (wave >= 2) { LAS unsigned char* in_ = ldsl + (buf) * SSD_IN; const size_t to_ = (size_t)(c) * 64 * 1536; \
        SSD_G16(bsrc + to_, in_ + SSD_BM + dq * 1024); SSD_G16(bsrc + to_ + 16 * 1536, in_ + SSD_BM + (dq + 4) * 1024); SSD_G16(bsrc + to_ + 32 * 1536, in_ + SSD_BM + (dq + 8) * 1024); SSD_G16(bsrc + to_ + 48 * 1536, in_ + SSD_BM + (dq + 12) * 1024); \
        SSD_G16(csrc + to_, in_ + SSD_CM + dq * 1024); SSD_G16(csrc + to_ + 16 * 1536, in_ + SSD_CM + (dq + 4) * 1024); SSD_G16(csrc + to_ + 32 * 1536, in_ + SSD_CM + (dq + 8) * 1024); SSD_G16(csrc + to_ + 48 * 1536, in_ + SSD_CM + (dq + 12) * 1024); \
        SSD_G16(xsrc + to_, in_ + SSD_XS + dq * 1024); SSD_G16(zsrc + (size_t)(c) * 64 * NPROJ, in_ + SSD_Z + dq * 1024); \
        if (dq < 2) __builtin_amdgcn_global_load_lds((const unsigned*)(dsrc + (size_t)(c) * 64 * 16), (LAS unsigned*)(in_ + ((dq == 0) ? SSD_DT : SSD_CS)), 4, 0, 0); } } while (0)
        f32x16 S;
#pragma unroll
        for (int r = 0; r < 16; ++r) S[r] = 0.f;
        SSD_ISSUE(0, 0); SSD_ISSUE(1, 1);
        const int xfo = ((lane >> 4) & 1) * 32 + (lane & 3) * 8 + (4 * hi + ((lane & 15) >> 2)) * 64;
        for (int c = 0; c < SEQ / 64; ++c) {
            if (wave >= 2) { if (c + 1 >= SEQ / 64) asm volatile("s_waitcnt vmcnt(0)" ::: "memory"); else if (dq < 2) asm volatile("s_waitcnt vmcnt(11)" ::: "memory"); else asm volatile("s_waitcnt vmcnt(10)" ::: "memory"); }
            asm volatile("s_waitcnt lgkmcnt(0)" ::: "memory");
            {
                const unsigned sa = (unsigned)(size_t)(ldsl + SSD_SYNC), tgt = (unsigned)(c + 1);
                asm volatile("ds_write_b32 %0, %1" :: "v"(sa + 32u + 4u * (unsigned)wave), "v"(tgt) : "memory");
                for (;;) { u32x4 a, b_; asm volatile("ds_read_b128 %0, %2 offset:32\n\tds_read_b128 %1, %2 offset:48\n\ts_waitcnt lgkmcnt(0)" : "=&v"(a), "=&v"(b_) : "v"(sa) : "memory");
                    const unsigned m = min(min(min(a.x, a.y), min(a.z, a.w)), min(min(b_.x, b_.y), min(b_.z, b_.w)));
                    if (__builtin_amdgcn_readfirstlane(m) >= tgt) break; __builtin_amdgcn_s_sleep(1); }
            }
            asm volatile("" ::: "memory");
            if (c + 2 < SEQ / 64) SSD_ISSUE(c + 2, (c + 2) % 3);
            const LAS unsigned char* in = ldsl + (c % 3) * SSD_IN;
            const LAS unsigned char* STin = ldsl + SSD_ST + (c & 1) * 8192;
            LAS unsigned char* STout = ldsl + SSD_ST + ((c + 1) & 1) * 8192;
            const LAS float* dtl = (const LAS float*)(in + SSD_DT); const LAS float* csl = (const LAS float*)(in + SSD_CS);
            if (wave < 2) {
                const int lb = wave, l = 32 * lb + r32;
                if (wave == 0) {
                    const int l1 = 32 + r32; const float cs_l1 = csl[l1];
                    f32x16 ca, cb;
#pragma unroll
                    for (int r = 0; r < 16; ++r) { ca[r] = 0.f; cb[r] = 0.f; }
#pragma unroll
                    for (int ks = 0; ks < 8; ks += 2) {
                        ca = __builtin_amdgcn_mfma_f32_32x32x16_bf16(*(const LAS bf16x8*)(in + SSD_BM + r32 * 256 + (((2 * ks + hi) ^ (r32 & 15)) << 4)), *(const LAS bf16x8*)(in + SSD_CM + l1 * 256 + (((2 * ks + hi) ^ (l1 & 15)) << 4)), ca, 0, 0, 0);
                        cb = __builtin_amdgcn_mfma_f32_32x32x16_bf16(*(const LAS bf16x8*)(in + SSD_BM + r32 * 256 + (((2 * ks + 2 + hi) ^ (r32 & 15)) << 4)), *(const LAS bf16x8*)(in + SSD_CM + l1 * 256 + (((2 * ks + 2 + hi) ^ (l1 & 15)) << 4)), cb, 0, 0, 0);
                    }
                    ca += cb;
                    ssd_decay_block(ca, csl, dtl, cs_l1, 0, l1, hi, false);
                    u32x4 w0, w1;
                    w0.x = cvtpk(ca[0], ca[1]); w0.y = cvtpk(ca[2], ca[3]); w0.z = cvtpk(ca[4], ca[5]); w0.w = cvtpk(ca[6], ca[7]);
                    w1.x = cvtpk(ca[8], ca[9]); w1.y = cvtpk(ca[10], ca[11]); w1.z = cvtpk(ca[12], ca[13]); w1.w = cvtpk(ca[14], ca[15]);
                    const unsigned xpa = (unsigned)(size_t)(in + SSD_XS + xfo);
                    f32x16 pa;
#pragma unroll
                    for (int r = 0; r < 16; ++r) pa[r] = 0.f;
                    { s16x4 lo0, hh0, lo1, hh1; TR_PAIR(lo0, hh0, xpa, 0, 512); TR_PAIR(lo1, hh1, xpa, 1024, 512); LDS_WAIT_PIN();
                      pa = __builtin_amdgcn_mfma_f32_32x32x16_bf16((bf16x8){lo0[0], lo0[1], lo0[2], lo0[3], hh0[0], hh0[1], hh0[2], hh0[3]}, __builtin_bit_cast(bf16x8, w0), pa, 0, 0, 0);
                      pa = __builtin_amdgcn_mfma_f32_32x32x16_bf16((bf16x8){lo1[0], lo1[1], lo1[2], lo1[3], hh1[0], hh1[1], hh1[2], hh1[3]}, __builtin_bit_cast(bf16x8, w1), pa, 0, 0, 0); }
                    LAS unsigned char* pp = ldsl + SSD_PART + lane * 64;
#pragma unroll
                    for (int q = 0; q < 4; ++q) *(LAS f32x4*)(pp + q * 16) = (f32x4){pa[4 * q], pa[4 * q + 1], pa[4 * q + 2], pa[4 * q + 3]};
                    asm volatile("s_waitcnt lgkmcnt(0)" ::: "memory");
                    asm volatile("ds_write_b32 %0, %1" :: "v"((unsigned)(size_t)(ldsl + SSD_SYNC) + 4u), "v"((unsigned)(c + 1)) : "memory");
                }
                const float cs_l = csl[l];
                bf16x8 cf[8];
#pragma unroll
                for (int ks = 0; ks < 8; ++ks) cf[ks] = *(const LAS bf16x8*)(in + SSD_CM + l * 256 + (((2 * ks + hi) ^ (l & 15)) << 4));
                f32x16 acc, acc2;
#pragma unroll
                for (int r = 0; r < 16; ++r) { acc[r] = 0.f; acc2[r] = 0.f; }
#pragma unroll
                for (int ks = 0; ks < 8; ks += 2) {
                    acc = __builtin_amdgcn_mfma_f32_32x32x16_bf16(*(const LAS bf16x8*)(STin + (2 * ks + hi) * 512 + r32 * 16), cf[ks], acc, 0, 0, 0);
                    acc2 = __builtin_amdgcn_mfma_f32_32x32x16_bf16(*(const LAS bf16x8*)(STin + (2 * ks + 2 + hi) * 512 + r32 * 16), cf[ks + 1], acc2, 0, 0, 0);
                }
                { const float ecs = __expf(cs_l);
#pragma unroll
                  for (int r = 0; r < 16; ++r) acc[r] = (acc[r] + acc2[r]) * ecs; }
                {
                    f32x16 ca, cb;
#pragma unroll
                    for (int r = 0; r < 16; ++r) { ca[r] = 0.f; cb[r] = 0.f; }
#pragma unroll
                    for (int ks = 0; ks < 8; ks += 2) {
                        ca = __builtin_amdgcn_mfma_f32_32x32x16_bf16(*(const LAS bf16x8*)(in + SSD_BM + l * 256 + (((2 * ks + hi) ^ (l & 15)) << 4)), cf[ks], ca, 0, 0, 0);
                        cb = __builtin_amdgcn_mfma_f32_32x32x16_bf16(*(const LAS bf16x8*)(in + SSD_BM + l * 256 + (((2 * ks + 2 + hi) ^ (l & 15)) << 4)), cf[ks + 1], cb, 0, 0, 0);
                    }
                    ca += cb;
                    ssd_decay_block(ca, csl, dtl, cs_l, lb, l, hi, true);
                    u32x4 w0, w1;
                    w0.x = cvtpk(ca[0], ca[1]); w0.y = cvtpk(ca[2], ca[3]); w0.z = cvtpk(ca[4], ca[5]); w0.w = cvtpk(ca[6], ca[7]);
                    w1.x = cvtpk(ca[8], ca[9]); w1.y = cvtpk(ca[10], ca[11]); w1.z = cvtpk(ca[12], ca[13]); w1.w = cvtpk(ca[14], ca[15]);
                    const unsigned xpa = (unsigned)(size_t)(in + SSD_XS + xfo + (32 * lb) * 64);
                    { s16x4 lo0, hh0, lo1, hh1; TR_PAIR(lo0, hh0, xpa, 0, 512); TR_PAIR(lo1, hh1, xpa, 1024, 512); LDS_WAIT_PIN();
                      acc = __builtin_amdgcn_mfma_f32_32x32x16_bf16((bf16x8){lo0[0], lo0[1], lo0[2], lo0[3], hh0[0], hh0[1], hh0[2], hh0[3]}, __builtin_bit_cast(bf16x8, w0), acc, 0, 0, 0);
                      acc = __builtin_amdgcn_mfma_f32_32x32x16_bf16((bf16x8){lo1[0], lo1[1], lo1[2], lo1[3], hh1[0], hh1[1], hh1[2], hh1[3]}, __builtin_bit_cast(bf16x8, w1), acc, 0, 0, 0); }
                }
                if (wave == 1) {
                    for (;;) { unsigned fl; asm volatile("ds_read_b32 %0, %1 offset:4\n\ts_waitcnt lgkmcnt(0)" : "=&v"(fl) : "v"((unsigned)(size_t)(ldsl + SSD_SYNC)) : "memory");
                        if (__builtin_amdgcn_readfirstlane(fl) >= (unsigned)(c + 1)) break; __builtin_amdgcn_s_sleep(1); }
                    asm volatile("" ::: "memory");
                    const LAS unsigned char* pp = ldsl + SSD_PART + lane * 64;
#pragma unroll
                    for (int q = 0; q < 4; ++q) { const f32x4 v = *(const LAS f32x4*)(pp + q * 16); acc[4 * q] += v[0]; acc[4 * q + 1] += v[1]; acc[4 * q + 2] += v[2]; acc[4 * q + 3] += v[3]; }
                }
                bf16_t* yo = (bf16_t*)(p.ws + WS_MIXRAW) + (tb0 + (size_t)c * 64 + l) * DM + 1024 + h * 64 + ph * 32 + 4 * hi;
                float yss = 0.f;
#pragma unroll
                for (int q = 0; q < 4; ++q) {
                    const u32x2 xw = *(const LAS u32x2*)(in + SSD_XS + l * 64 + (8 * q + 4 * hi) * 2), zw = *(const LAS u32x2*)(in + SSD_Z + l * 64 + (8 * q + 4 * hi) * 2);
                    const float y0 = (acc[4 * q + 0] + dsk * bflo(xw.x)) * silu_fast(bflo(zw.x)), y1 = (acc[4 * q + 1] + dsk * bfhi(xw.x)) * silu_fast(bfhi(zw.x));
                    const float y2 = (acc[4 * q + 2] + dsk * bflo(xw.y)) * silu_fast(bflo(zw.y)), y3 = (acc[4 * q + 3] + dsk * bfhi(xw.y)) * silu_fast(bfhi(zw.y));
                    yss += (y0 * y0 + y1 * y1) + (y2 * y2 + y3 * y3);
                    u32x2 o; o.x = pk2(y0, y1); o.y = pk2(y2, y3);
                    *(u32x2*)(yo + 8 * q) = o;
                }
                yss += __shfl_xor(yss, 32);
                if (hi == 0) ((float*)(p.ws + WS_PSQS))[(tb0 + (size_t)c * 64 + l) * 32 + h * 2 + ph] = yss;
            } else {
                const int nb = wave - 2;
                const float cs63 = csl[63];
                { const float dec = __expf(cs63);
#pragma unroll
                  for (int r = 0; r < 16; ++r) S[r] *= dec; }
                const int brow = 4 * hi + ((lane & 15) >> 2), bch = 4 * nb + 2 * ((lane >> 4) & 1) + ((lane & 3) >> 1);
                const unsigned xpa = (unsigned)(size_t)(in + xfo);
                const unsigned bpa = (unsigned)(size_t)(in + SSD_BM + brow * 256 + ((bch ^ brow) << 4) + (lane & 1) * 8);
                const unsigned bpb = (unsigned)(size_t)(in + SSD_BM + (brow + 8) * 256 + ((bch ^ (brow + 8)) << 4) + (lane & 1) * 8);
#pragma unroll
                for (int ks = 0; ks < 4; ++ks) {
                    s16x4 lo, hh, blo, bhh;
                    TR_PAIR(lo, hh, xpa, SSD_XS + (16 * ks) * 64, 512);
                    asm volatile("ds_read_b64_tr_b16 %0, %1 offset:%c2" : "=&v"(blo) : "v"(bpa), "i"((16 * ks) * 256) : "memory");
                    asm volatile("ds_read_b64_tr_b16 %0, %1 offset:%c2" : "=&v"(bhh) : "v"(bpb), "i"((16 * ks) * 256) : "memory");
                    const f32x4 c0 = *(const LAS f32x4*)(csl + 16 * ks + 4 * hi), c1 = *(const LAS f32x4*)(csl + 16 * ks + 8 + 4 * hi);
                    const f32x4 d0 = *(const LAS f32x4*)(dtl + 16 * ks + 4 * hi), d1 = *(const LAS f32x4*)(dtl + 16 * ks + 8 + 4 * hi);
                    LDS_WAIT_PIN();
                    float xf[8];
#pragma unroll
                    for (int j = 0; j < 4; ++j) { xf[j] = bf2f((unsigned short)lo[j]) * __expf(cs63 - c0[j]) * d0[j]; xf[4 + j] = bf2f((unsigned short)hh[j]) * __expf(cs63 - c1[j]) * d1[j]; }
                    u32x4 aw; aw.x = cvtpk(xf[0], xf[1]); aw.y = cvtpk(xf[2], xf[3]); aw.z = cvtpk(xf[4], xf[5]); aw.w = cvtpk(xf[6], xf[7]);
                    S = __builtin_amdgcn_mfma_f32_32x32x16_bf16(__builtin_bit_cast(bf16x8, aw), (bf16x8){blo[0], blo[1], blo[2], blo[3], bhh[0], bhh[1], bhh[2], bhh[3]}, S, 0, 0, 0);
                }
                const int n = 32 * nb + r32;
#pragma unroll
                for (int r = 0; r < 16; ++r) *(LAS unsigned short*)(STout + (n >> 3) * 512 + crow(r, hi) * 16 + (n & 7) * 2) = (unsigned short)f2bf(S[r]);
            }
        }
#undef SSD_ISSUE
#undef SSD_G16
    }
    asm volatile("s_waitcnt vmcnt(0) lgkmcnt(0)" ::: "memory");
    __builtin_amdgcn_s_barrier(); asm volatile("" ::: "memory");
}
__device__ __forceinline__ void ph_peer4(const Params& p, LAS unsigned char* ldsl, int wave, int lane, int gwave, int gnw) {
    LAS unsigned char* ring = ldsl + wave * 16384;
    const unsigned char* U = (const unsigned char*)(p.ws + WS_U4); const unsigned char* V = (const unsigned char*)(p.ws + WS_V4);
    const int e_lane = (lane >> 2) & 15; const unsigned lane16 = (unsigned)lane * 16u, lanesc = 1024u + (unsigned)(lane >> 1) * 4u;
#define P4_ISSUE(R) do { const int R_ = (R); const int i_ = ((R_ >> 5) << 4) + (R_ & 15); \
        const int e_ = (i_ < 64) ? __builtin_amdgcn_readlane(idx0, i_) : __builtin_amdgcn_readlane(idx1, i_ - 64); \
        const unsigned char* base_ = (((R_ >> 4) & 1) ? V : U) + (size_t)(unsigned)e_ * P4_ROW; \
        LAS unsigned char* dst_ = ring + (R_ & 7) * 1280; \
        __builtin_amdgcn_global_load_lds((const unsigned*)(base_ + lane16), (LAS unsigned*)(dst_), 16, 0, 0); \
        __builtin_amdgcn_global_load_lds((const unsigned*)(base_ + lanesc), (LAS unsigned*)(dst_ + 1024), 4, 0, 0); } while (0)
#define P4_WAIT(n) asm volatile("s_waitcnt vmcnt(" #n ")" ::: "memory")
#define P4_CVT(wd, bs) __builtin_amdgcn_cvt_scalef32_pk_f32_fp4((wd), 1.0f, (bs))
    for (int t = gwave; t < T; t += gnw) {
        const int b = t / SEQ;
        const int idx0 = ((const int*)(p.ws + WS_IDX))[(size_t)t * 128 + lane], idx1 = ((const int*)(p.ws + WS_IDX))[(size_t)t * 128 + 64 + lane];
        float gv0 = ((const float*)(p.ws + WS_GATE))[(size_t)t * 128 + lane], gv1 = ((const float*)(p.ws + WS_GATE))[(size_t)t * 128 + 64 + lane];
        f32x2_t hf[16];
        {
            const float pq = (lane < 32) ? ((const float*)(p.ws + WS_PSQX))[(size_t)t * 32 + lane] : 0.f;
            const float r2 = rsqrtf(wave_sum(pq) * (1.f / DM) + EPS);
            const bf16_t* hp = (const bf16_t*)(p.ws + WS_X1M) + (size_t)t * DM + lane * 4;
            const float* shp = (const float*)(p.ws + WS_MOD) + (size_t)b * 6 * DM + 3 * DM + lane * 4;
#pragma unroll
            for (int j = 0; j < 8; ++j) { const u32x2 a = *(const u32x2*)(hp + j * 256); const f32x4 sh = *(const f32x4*)(shp + j * 256);
                hf[2 * j] = (f32x2_t){bflo(a.x) * r2 + sh[0], bfhi(a.x) * r2 + sh[1]}; hf[2 * j + 1] = (f32x2_t){bflo(a.y) * r2 + sh[2], bfhi(a.y) * r2 + sh[3]}; }
        }
        f32x2_t out[16];
#pragma unroll
        for (int i = 0; i < 16; ++i) out[i] = (f32x2_t){0.f, 0.f};
        asm volatile("" : "+v"(gv0), "+v"(gv1));
        P4_ISSUE(0); P4_ISSUE(1); P4_ISSUE(2); P4_ISSUE(3); P4_ISSUE(4); P4_ISSUE(5); P4_ISSUE(6);
        for (int hh = 0; hh < 8; ++hh) {
            float pd[16];
#pragma unroll
            for (int k = 0; k < 16; ++k) {
                P4_ISSUE(hh * 32 + k + 7); P4_WAIT(14);
                const LAS unsigned char* sl = ring + (k & 7) * 1280;
                const u32x4 w = *(const LAS u32x4*)(sl + lane * 16);
                const unsigned sw = *(const LAS unsigned*)(sl + 1024 + lane * 4);
                const float scl = (lane & 1) ? bfhi(sw) : bflo(sw);
                f32x2_t a2 = (f32x2_t){0.f, 0.f};
                a2 += P4_CVT(w.x, 0) * hf[0]; a2 += P4_CVT(w.x, 1) * hf[1]; a2 += P4_CVT(w.x, 2) * hf[2]; a2 += P4_CVT(w.x, 3) * hf[3];
                a2 += P4_CVT(w.y, 0) * hf[4]; a2 += P4_CVT(w.y, 1) * hf[5]; a2 += P4_CVT(w.y, 2) * hf[6]; a2 += P4_CVT(w.y, 3) * hf[7];
                a2 += P4_CVT(w.z, 0) * hf[8]; a2 += P4_CVT(w.z, 1) * hf[9]; a2 += P4_CVT(w.z, 2) * hf[10]; a2 += P4_CVT(w.z, 3) * hf[11];
                a2 += P4_CVT(w.w, 0) * hf[12]; a2 += P4_CVT(w.w, 1) * hf[13]; a2 += P4_CVT(w.w, 2) * hf[14]; a2 += P4_CVT(w.w, 3) * hf[15];
                float a = (a2.x + a2.y) * scl;
                asm volatile("" : "+v"(a));
                pd[k] = a;
            }
            float q8[8], q4[4], q2[2], q1;
            { const bool hi = (lane & 32) != 0;
#pragma unroll
              for (int i = 0; i < 8; ++i) { const float keep = hi ? pd[i + 8] : pd[i], send = hi ? pd[i] : pd[i + 8]; q8[i] = keep + __shfl_xor(send, 32); } }
            { const bool hi = (lane & 16) != 0;
#pragma unroll
              for (int i = 0; i < 4; ++i) { const float keep = hi ? q8[i + 4] : q8[i], send = hi ? q8[i] : q8[i + 4]; q4[i] = keep + __shfl_xor(send, 16); } }
            { const bool hi = (lane & 8) != 0;
#pragma unroll
              for (int i = 0; i < 2; ++i) { const float keep = hi ? q4[i + 2] : q4[i], send = hi ? q4[i] : q4[i + 2]; q2[i] = keep + __shfl_xor(send, 8); } }
            { const bool hi = (lane & 4) != 0; const float keep = hi ? q2[1] : q2[0], send = hi ? q2[0] : q2[1]; q1 = keep + __shfl_xor(send, 4); }
            q1 += __shfl_xor(q1, 1); q1 += __shfl_xor(q1, 2);
            const float act = 0.5f * q1 * (1.f + erff(q1 * 0.70710678118654752f)) * __shfl((hh < 4) ? gv0 : gv1, (hh & 3) * 16 + e_lane);
#pragma unroll
            for (int k = 0; k < 16; ++k) {
                if (k < 9) { P4_ISSUE(hh * 32 + 16 + k + 7); P4_WAIT(14); }
                else if (hh < 7) { P4_ISSUE(hh * 32 + 16 + k + 7); P4_WAIT(14); }
                else if (k == 9) P4_WAIT(12); else if (k == 10) P4_WAIT(10); else if (k == 11) P4_WAIT(8); else if (k == 12) P4_WAIT(6); else if (k == 13) P4_WAIT(4); else if (k == 14) P4_WAIT(2); else P4_WAIT(0);
                const LAS unsigned char* sl = ring + (k & 7) * 1280;
                const u32x4 w = *(const LAS u32x4*)(sl + lane * 16);
                const unsigned sw = *(const LAS unsigned*)(sl + 1024 + lane * 4);
                const float a = __builtin_bit_cast(float, __builtin_amdgcn_readlane(__builtin_bit_cast(int, act), 4 * k)) * ((lane & 1) ? bfhi(sw) : bflo(sw));
                const f32x2_t aa = (f32x2_t){a, a};
                out[0] += aa * P4_CVT(w.x, 0); out[1] += aa * P4_CVT(w.x, 1); out[2] += aa * P4_CVT(w.x, 2); out[3] += aa * P4_CVT(w.x, 3);
                out[4] += aa * P4_CVT(w.y, 0); out[5] += aa * P4_CVT(w.y, 1); out[6] += aa * P4_CVT(w.y, 2); out[7] += aa * P4_CVT(w.y, 3);
                asm volatile("" : "+v"(out[0]), "+v"(out[1]), "+v"(out[2]), "+v"(out[3]), "+v"(out[4]), "+v"(out[5]), "+v"(out[6]), "+v"(out[7]));
                out[8] += aa * P4_CVT(w.z, 0); out[9] += aa * P4_CVT(w.z, 1); out[10] += aa * P4_CVT(w.z, 2); out[11] += aa * P4_CVT(w.z, 3);
                out[12] += aa * P4_CVT(w.w, 0); out[13] += aa * P4_CVT(w.w, 1); out[14] += aa * P4_CVT(w.w, 2); out[15] += aa * P4_CVT(w.w, 3);
                asm volatile("" : "+v"(out[8]), "+v"(out[9]), "+v"(out[10]), "+v"(out[11]), "+v"(out[12]), "+v"(out[13]), "+v"(out[14]), "+v"(out[15]));
            }
        }
        const float* g2 = (const float*)(p.ws + WS_MOD) + (size_t)b * 6 * DM + 5 * DM; const float* s2 = (const float*)(p.ws + WS_MOD) + (size_t)b * 6 * DM + 4 * DM;
        const bf16_t* xmp = (const bf16_t*)(p.ws + WS_X1M) + (size_t)t * DM;
        float* outp = p.out + (size_t)t * DM;
#pragma unroll
        for (int j = 0; j < 8; ++j) {
            const int c = j * 256 + lane * 4;
            const u32x2 xm = *(const u32x2*)(xmp + c); const f32x4 ga = *(const f32x4*)(g2 + c), sc = *(const f32x4*)(s2 + c);
            *(f32x4*)(outp + c) = (f32x4){bflo(xm.x) / (1.f + sc.x) + ga.x * out[2 * j].x, bfhi(xm.x) / (1.f + sc.y) + ga.y * out[2 * j].y,
                                          bflo(xm.y) / (1.f + sc.z) + ga.z * out[2 * j + 1].x, bfhi(xm.y) / (1.f + sc.w) + ga.w * out[2 * j + 1].y};
        }
    }
#undef P4_ISSUE
#undef P4_WAIT
#undef P4_CVT
}
constexpr int RING_BYTES = 131072, LDSCTL_OFF = 146432, MISC_OFF = LDSCTL_OFF + 320, LDS_BYTES = 147456;
static_assert(SSD_SYNC + 64 <= LDSCTL_OFF, "SSD LDS map");
constexpr int NPH = 13;
#ifndef MK_PER_PHASE
#define MK_PER_PHASE 0
#endif

__global__ void __launch_bounds__(NTHR, 2) mega(Params p) {
    extern __shared__ __attribute__((aligned(16))) unsigned char lds[];
    LAS unsigned char* ldsl = (LAS unsigned char*)lds;
    const int tid = threadIdx.x, lane = tid & 63, wave = __builtin_amdgcn_readfirstlane(tid >> 6);
    const int G = gridDim.x, bid = blockIdx.x;
    unsigned char* ws = p.ws;
    gu32* ctl = (gu32*)(ws + WS_CTL);
    for (int u = tid; u < (LDS_BYTES - LDSCTL_OFF) / 4; u += NTHR) ((LAS unsigned*)(ldsl + LDSCTL_OFF))[u] = 0u;
    __syncthreads();
    volatile LAS unsigned* MISC = (volatile LAS unsigned*)(ldsl + MISC_OFF);
    XcdBarrier bar; bar.bar = (unsigned*)(ctl + CW_BAR); bar.x = 0; bar.st = nullptr;
    if (!MK_PER_PHASE) bar = xcd_barrier_post((unsigned*)(ctl + CW_BAR), MISC + 8);
#define IN(k) (p.ph_lo <= (k) && (k) < p.ph_hi)
#define LN() ({ int l_ = lane; asm volatile("" : "+v"(l_)); l_; })
#define WV() ({ int w_ = wave; asm volatile("" : "+s"(w_)); w_; })
#define SEAM(k) do { if ((k) + 1 < p.ph_hi) xcd_barrier(bar); } while (0)
    const int gtid = bid * NTHR + tid, gn = G * NTHR, gwave = bid * NWAVES + wave, gnw = G * NWAVES;
    float* mod = (float*)(ws + WS_MOD);

    if (IN(0)) {
        if (bid < 96) ph_mod(p, lds, tid, bid);
        else ph_transposes(p, lds, WV(), LN(), (bid - 96) * NWAVES + wave, (G - 96) * NWAVES);
        ph_rope_tab(p, gtid, gn);
        ph_convert(p.sub_keys, (bf16_t*)(ws + WS_SUBK), (size_t)8 * 2 * 128 * 128 / 4, gtid, gn);
        SEAM(0);
    }
    if (IN(1)) { ph_modrows(p.x, (bf16_t*)(ws + WS_H), mod, 0, 1, gwave, gnw, LN()); ph_bias2(p, gwave, gnw, LN()); SEAM(1); }
    if (IN(2)) {
        pg8::Gemm g{(const bf16_t*)(ws + WS_H), (const bf16_t*)(ws + WS_WINT), T, NPROJ, DM, DM}; pg8::StaticOrder S; S.init(T, NPROJ, G, bid);
        pg8::EpiBf16<0> E{(bf16_t*)(ws + WS_PROJ), NPROJ, nullptr, 0, 0, 1.f};
        pg8::gemm_phase<pg8::EpiBf16<0>, pg8::StaticOrder, true, true>(ldsl, g, S, E);
        SEAM(2);
    }
    if (IN(3)) {
        { pg8::Gemm g{(const bf16_t*)(ws + WS_PROJ) + C_CQ, (const bf16_t*)(ws + WS_WUQT), T, NQ, 512, NPROJ}; pg8::StaticOrder S; S.init(T, NQ, G, bid);
          pg8::EpiBf16<0> E{(bf16_t*)(ws + WS_QRAW), NQ, nullptr, 0, 0, 1.f};
          pg8::gemm_phase<pg8::EpiBf16<0>, pg8::StaticOrder, true, true>(ldsl, g, S, E); }
        { pg8::Gemm g{(const bf16_t*)(ws + WS_PROJ) + C_CKV, (const bf16_t*)(ws + WS_WUKVT), T, NKV, 256, NPROJ}; pg8::StaticOrder S; S.init(T, NKV, G, bid);
          pg8::EpiBf16<0> E{(bf16_t*)(ws + WS_KVRAW), NKV, nullptr, 0, 0, 1.f};
          pg8::gemm_phase<pg8::EpiBf16<0>, pg8::StaticOrder, true, true>(ldsl, g, S, E); }
        SEAM(3);
    }
    if (IN(4)) { ph_qkv_post(p, gwave, gnw, LN()); ph_conv(p, gwave, gnw, LN()); SEAM(4); }
    if (IN(5)) { ph_attn(p, ldsl, bid, G, WV(), LN()); ph_ssd(p, ldsl, bid, WV(), LN()); SEAM(5); }
    if (IN(8)) {
        pg8::Gemm g{(const bf16_t*)(ws + WS_MIXRAW), (const bf16_t*)(ws + WS_WOUTT), T, DM, DM, DM}; pg8::StaticOrder S; S.init(T, DM, G, bid);
        pg8::Unit u0, u1; S.next(0, u0); if (!S.next(1, u1)) u1 = u0;
        LAS float* kt = (LAS float*)(ldsl + RING_BYTES);
        { const int slot = tid >> 8, r = tid & 255, row = (slot ? u1.pm : u0.pm) * 256 + r;
          const f32x4* pa = (const f32x4*)((const float*)(ws + WS_PSQA) + (size_t)row * 8); const f32x4* ps = (const f32x4*)((const float*)(ws + WS_PSQS) + (size_t)row * 32);
          const f32x4 a0 = pa[0], a1 = pa[1]; float sa = ((a0[0] + a0[1]) + (a0[2] + a0[3])) + ((a1[0] + a1[1]) + (a1[2] + a1[3])), s0 = 0.f, s1 = 0.f;
#pragma unroll
          for (int q = 0; q < 4; ++q) { const f32x4 v = ps[q], w = ps[4 + q]; s0 += (v[0] + v[1]) + (v[2] + v[3]); s1 += (w[0] + w[1]) + (w[2] + w[3]); }
          const float ra = rsqrtf(sa * (1.f / 1024.f) + EPS), r0 = rsqrtf(s0 * (1.f / 512.f) + EPS), r1 = rsqrtf(s1 * (1.f / 512.f) + EPS);
          kt[tid * 4 + 0] = ra / r0; kt[tid * 4 + 1] = r0 / r1; kt[tid * 4 + 2] = r1; kt[tid * 4 + 3] = 0.f; }
        __syncthreads();
        pg8::EpiX1 E{p.x, mod, (bf16_t*)(ws + WS_X1M), (float*)(ws + WS_PSQX), DM, SEQ, kt, u0.pm};
        pg8::gemm_phase<pg8::EpiX1, pg8::StaticOrder, true, true>(ldsl, g, S, E);
        SEAM(8);
    }
    if (IN(10)) {
        pg8::Gemm g{(const bf16_t*)(ws + WS_X1M), (const bf16_t*)(ws + WS_WQT), T, DM, DM, DM}; pg8::StaticOrder S; S.init(T, DM, G, bid);
        pg8::Unit u0, u1; S.next(0, u0); if (!S.next(1, u1)) u1 = u0;
        LAS float* rt = (LAS float*)(ldsl + RING_BYTES);
        { const int slot = tid >> 8, r = tid & 255, row = (slot ? u1.pm : u0.pm) * 256 + r; const f32x4* pq = (const f32x4*)((const float*)(ws + WS_PSQX) + (size_t)row * 32); float s_ = 0.f;
#pragma unroll
          for (int q = 0; q < 8; ++q) { const f32x4 v = pq[q]; s_ += (v[0] + v[1]) + (v[2] + v[3]); }
          rt[tid] = rsqrtf(s_ * (1.f / DM) + EPS); }
        __syncthreads();
        pg8::EpiScaleBias E{(bf16_t*)(ws + WS_QP), DM, (const float*)(ws + WS_BIAS2), SEQ, rt, u0.pm};
        pg8::gemm_phase<pg8::EpiScaleBias, pg8::StaticOrder, true, true>(ldsl, g, S, E);
        SEAM(10);
    }
    if (IN(11)) { ph_route(p, ldsl, WV(), LN(), gwave, gnw); SEAM(11); }
    if (IN(12)) { ph_peer4(p, ldsl, WV(), LN(), gwave, gnw); }
#undef IN
#undef SEAM
}

extern "C" void kernel_launch(void* const* d_in, const int* in_sizes, int n_in, void* d_out, int out_size, void* d_ws, size_t ws_size, hipStream_t stream) {
    static int grid = 0;
    if (grid == 0) {
        if (n_in != 24 || ws_size < WS_END) { fprintf(stderr, "kernel_launch: unexpected inputs / workspace (%d, %zu)\n", n_in, ws_size); grid = -1; return; }
        if (hipFuncSetAttribute((const void*)mega, hipFuncAttributeMaxDynamicSharedMemorySize, LDS_BYTES) != hipSuccess) { fprintf(stderr, "kernel_launch: hipFuncSetAttribute failed\n"); grid = -1; return; }
        (void)hipGetLastError();
        grid = 256;
    }
    if (grid < 0) return;
    (void)hipMemsetAsync((char*)d_ws + WS_CTL, 0, CTL_ZERO_BYTES, stream);
    Params p{};
    p.x = (const float*)d_in[0]; p.c = (const float*)d_in[1]; p.pos = (const int*)d_in[2]; p.w_ada = (const float*)d_in[3]; p.b_ada = (const float*)d_in[4];
    p.w_in = (const float*)d_in[5]; p.q_a_norm = (const float*)d_in[6]; p.w_uq = (const float*)d_in[7]; p.kv_a_norm = (const float*)d_in[8]; p.w_ukv = (const float*)d_in[9];
    p.q_norm = (const float*)d_in[10]; p.k_norm = (const float*)d_in[11]; p.attn_out_norm = (const float*)d_in[12]; p.conv_w = (const float*)d_in[13]; p.conv_b = (const float*)d_in[14];
    p.dt_bias = (const float*)d_in[15]; p.a_log = (const float*)d_in[16]; p.d_skip = (const float*)d_in[17]; p.ssd_norm = (const float*)d_in[18]; p.w_out = (const float*)d_in[19];
    p.w_query = (const float*)d_in[20]; p.sub_keys = (const float*)d_in[21]; p.u_exp = (const float*)d_in[22]; p.v_exp = (const float*)d_in[23];
    p.out = (float*)d_out; p.ws = (unsigned char*)d_ws;
#if MK_PER_PHASE
    for (int ph = 0; ph < NPH; ++ph) { p.ph_lo = ph; p.ph_hi = ph + 1; hipLaunchKernelGGL(mega, dim3(grid), dim3(NTHR), LDS_BYTES, stream, p); }
#elif defined(PROBE_SEQ)
    { const int seq[] = {PROBE_SEQ}; const int nl = (int)(sizeof(seq) / sizeof(int)) / 2;
      for (int li = 0; li < nl; ++li) { if (li) (void)hipMemsetAsync((char*)d_ws + WS_CTL, 0, CTL_ZERO_BYTES, stream);
          p.ph_lo = seq[2 * li]; p.ph_hi = seq[2 * li + 1]; hipLaunchKernelGGL(mega, dim3(grid), dim3(NTHR), LDS_BYTES, stream, p); } }
#else
    p.ph_lo = 0; p.ph_hi = NPH;
    hipLaunchKernelGGL(mega, dim3(grid), dim3(NTHR), LDS_BYTES, stream, p);
#endif
}
```

```cpp
#include <hip/hip_runtime.h>
#include <cstdint>
#include <cstdio>
#include <cmath>

constexpr int DM = 2048, NB = 8, SEQ = 2048, T = NB * SEQ;
constexpr int IN_COLS = 3408, NPROJ = 3584;
constexpr int C_CQ = 0, C_CKV = 512, C_KR = 768, C_Z = 832, C_XBC = 1856, C_DT = 3392;
constexpr int NQ = 1536, NKV = 2048;
constexpr float EPS = 1e-6f;
constexpr int NTHR = 512, NWAVES = 8;

typedef unsigned short bf16_t;
typedef unsigned u32x4 __attribute__((ext_vector_type(4)));
typedef float f32x4 __attribute__((ext_vector_type(4)));
typedef unsigned u32x2 __attribute__((ext_vector_type(2)));
#define GAS __attribute__((address_space(1)))
#define LAS __attribute__((address_space(3)))
typedef GAS unsigned gu32;
typedef GAS unsigned long long gu64;
#define RLX_AGENT __ATOMIC_RELAXED, __HIP_MEMORY_SCOPE_AGENT

__device__ __forceinline__ unsigned f2bf(float f) { unsigned u = __builtin_bit_cast(unsigned, f); return (u + 0x7fffu + ((u >> 16) & 1u)) >> 16; }
__device__ __forceinline__ float bf2f(unsigned h) { return __builtin_bit_cast(float, h << 16); }
__device__ __forceinline__ unsigned pk2(float lo, float hi) { return f2bf(lo) | (f2bf(hi) << 16); }
__device__ __forceinline__ float bflo(unsigned w) { return __builtin_bit_cast(float, w << 16); }
__device__ __forceinline__ float bfhi(unsigned w) { return __builtin_bit_cast(float, w & 0xffff0000u); }
__device__ __forceinline__ float silu_f(float v) { return v / (1.f + __expf(-v)); }
__device__ __forceinline__ float wave_sum(float v) {
#pragma unroll
    for (int o = 1; o < 64; o <<= 1) v += __shfl_xor(v, o);
    return v;
}

constexpr size_t MiB = 1u << 20;
constexpr size_t WS_CTL = 0, CTL_ZERO_BYTES = 64 * 1024, WS_MOD = 1 * MiB, WS_ROPEC = 2 * MiB, WS_ROPES = 4 * MiB, WS_SUBK = 6 * MiB, WS_WUQT = 7 * MiB, WS_WUKVT = 9 * MiB,
                 WS_WINT = 10 * MiB, WS_WOUTT = 24 * MiB, WS_WQT = 32 * MiB,
                 WS_US = 40 * MiB, WS_VS = 41 * MiB, WS_PSQX = 42 * MiB, WS_BIAS2 = 44 * MiB, WS_PSQA = 45 * MiB, WS_PSQS = 46 * MiB, WS_CS = 50 * MiB, WS_DT = 51 * MiB, WS_IDX = 52 * MiB, WS_GATE = 60 * MiB, WS_U16 = 68 * MiB, WS_V16 = 132 * MiB, WS_U8 = 68 * MiB, WS_V8 = 100 * MiB, WS_MIXRAW = 372 * MiB, WS_U4 = 436 * MiB, WS_V4 = 456 * MiB,
                 WS_K = 68 * MiB, WS_YSSD = 68 * MiB, WS_XBCA = 116 * MiB, WS_ATTN = 164 * MiB,
                 WS_H = 196 * MiB, WS_Q = 196 * MiB, WS_MIXIN = 196 * MiB, WS_H2 = 196 * MiB, WS_X1M = 68 * MiB,
                 WS_PROJ = 260 * MiB, WS_QP = 260 * MiB, WS_QRAW = 372 * MiB, WS_KVRAW = 420 * MiB, WS_V = 484 * MiB, WS_END = 516 * MiB;
constexpr int CW_BAR = 1024;

struct Params {
    const float *x, *c; const int* pos;
    const float *w_ada, *b_ada, *w_in, *q_a_norm, *w_uq, *kv_a_norm, *w_ukv, *q_norm, *k_norm, *attn_out_norm, *conv_w, *conv_b, *dt_bias, *a_log,
        *d_skip, *ssd_norm, *w_out, *w_query, *sub_keys, *u_exp, *v_exp;
    float* out; unsigned char* ws;
    int ph_lo, ph_hi;
};
namespace pg8 {
#define PG8_LAS __attribute__((address_space(3)))
typedef unsigned short bf16_t;
typedef short bf16x8 __attribute__((ext_vector_type(8)));
typedef float f32x4 __attribute__((ext_vector_type(4)));
typedef unsigned u32x4 __attribute__((ext_vector_type(4)));
constexpr int BM = 256, BK = 64, HALF = 128, HTB = HALF * BK * 2  , STAGE_BYTES = 8 * HTB, NXCD = 8, WGM = 8;

__host__ __device__ __forceinline__ int lds_byte(int r, int c) { const int st = (r >> 4) * 2 + (c >> 5), rr = r & 15, cc = c & 31, ob = rr * 64 + cc * 2; return st * 1024 + (ob ^ (((ob >> 9) & 1) << 5)); }
__host__ __device__ __forceinline__ void stage_rc(int b, int& R, int& C) { const int st = b / 1024, sb = b % 1024, swz = sb ^ (((sb >> 9) & 1) << 5); R = (st >> 1) * 16 + swz / 64; C = (st & 1) * 32 + (swz % 64) / 2; }
__host__ __device__ __forceinline__ int perm32(int rho) { const int n = rho >> 4, i = rho & 15; return 8 * (i >> 2) + 4 * n + (i & 3); }

struct Unit { int pm, pn; };
struct Gemm { const bf16_t* A; const bf16_t* Bt; int M, N, K, lda; };

struct StaticOrder {
    int nM, nN, nwg, G, c;
    __host__ __device__ void init(int M, int N, int G_, int c_) { nM = M / BM; nN = N / BM; nwg = nM * nN; G = G_; c = c_; }
    __host__ __device__ bool next(int i, Unit& u) const {
        const long L = (long)i * G + c; if (L >= nwg) return false;
        int wgid = (int)L; { const int q = nwg / NXCD, r = nwg % NXCD, xcd = wgid % NXCD, off = wgid / NXCD; wgid = (xcd < r ? xcd * (q + 1) : r * (q + 1) + (xcd - r) * q) + off; }
        const int nig = WGM * nN, gid = wgid / nig, fm = gid * WGM, gsz = (nM - fm) < WGM ? (nM - fm) : WGM;
        u.pm = fm + ((wgid % nig) % gsz); u.pn = (wgid % nig) / gsz; return true;
    }
    __device__ __forceinline__ void a_ready(const Unit&) const {}
    __device__ __forceinline__ void done(const Unit&) const {}
};

__device__ __forceinline__ unsigned cvt_pk_bf16(float lo, float hi) { unsigned r; asm volatile("v_cvt_pk_bf16_f32 %0, %1, %2" : "=v"(r) : "v"(lo), "v"(hi)); return r; }
typedef float f32x2 __attribute__((ext_vector_type(2)));
__device__ __forceinline__ f32x2 gelu_pk(f32x2 v) {
    const f32x2 av = __builtin_elementwise_abs(v), d = av * 0.2316418882f + 1.0f;
    f32x2 t; t.x = __builtin_amdgcn_rcpf(d.x); t.y = __builtin_amdgcn_rcpf(d.y);
    f32x2 q = t * 0.5307027145f + (-0.7265760135f); q = q * t + 0.7107068705f; q = q * t + (-0.142248368f); q = q * t + 0.127414796f; q = q * t;
    const f32x2 s = (v * v) * (-0.72134752044f);
    f32x2 e; e.x = __builtin_amdgcn_exp2f(s.x); e.y = __builtin_amdgcn_exp2f(s.y);
    const f32x2 m = v * (q * e), r = v - m;
    f32x2 o; o.x = v.x < 0.f ? m.x : r.x; o.y = v.y < 0.f ? m.y : r.y; return o;
}

template <int ACT  > struct EpiBf16 {
    static constexpr bool PERM = true, AFTER_DRAIN = false, KSCALE = false; static_assert(ACT == 0 || ACT == 1, "EpiBf16: ACT is 0 (none) or 1 (gelu_pk)");
    bf16_t* O; int ldc; const float* bias; int split_cols; size_t split_stride; float scale0;
    __device__ __forceinline__ void operator()(const f32x4 (&acc)[2][2][4][2], const Unit& u, int wr, int wc, int fr, int fq) const {
        const int row0 = u.pm * BM + wr * 64 + fr; int colt = u.pn * BM; bf16_t* base = O;
        float sc = 1.f; if (split_cols) { const int t = colt / split_cols; base += (size_t)t * split_stride; colt -= t * split_cols; if (t == 0) sc = scale0; }
        const int col0 = colt + wc * 32 + 8 * fq, bcol0 = u.pn * BM + wc * 32 + 8 * fq;
        f32x4 bv[2][2];
#pragma unroll
        for (int bj = 0; bj < 2; ++bj)
#pragma unroll
            for (int n = 0; n < 2; ++n) bv[bj][n] = bias ? *(const f32x4*)(bias + bcol0 + bj * HALF + 4 * n) : (f32x4){0.f, 0.f, 0.f, 0.f};
#pragma unroll
        for (int ai = 0; ai < 2; ++ai)
#pragma unroll
            for (int m = 0; m < 4; ++m) { bf16_t* rowp = base + (size_t)(row0 + ai * HALF + m * 16) * ldc + col0;
#pragma unroll
                for (int bj = 0; bj < 2; ++bj) { f32x4 v0 = acc[ai][bj][m][0] + bv[bj][0], v1 = acc[ai][bj][m][1] + bv[bj][1];
                    if (ACT == 1) { f32x2 a = gelu_pk((f32x2){v0[0], v0[1]}), b = gelu_pk((f32x2){v0[2], v0[3]}), c = gelu_pk((f32x2){v1[0], v1[1]}), d = gelu_pk((f32x2){v1[2], v1[3]});
                        v0 = (f32x4){a.x, a.y, b.x, b.y}; v1 = (f32x4){c.x, c.y, d.x, d.y}; }
                    v0 = v0 * sc; v1 = v1 * sc; u32x4 w; w.x = cvt_pk_bf16(v0[0], v0[1]); w.y = cvt_pk_bf16(v0[2], v0[3]); w.z = cvt_pk_bf16(v1[0], v1[1]); w.w = cvt_pk_bf16(v1[2], v1[3]);
                    *(u32x4*)(rowp + bj * HALF) = w; } }
    }
};
struct EpiResid {
    static constexpr bool PERM = false, AFTER_DRAIN = false, KSCALE = false;
    const float* resid; float* out; const float* gate; int ldc, rows_per_batch, gate_stride;
    __device__ __forceinline__ void operator()(const f32x4 (&acc)[2][2][4][2], const Unit& u, int wr, int wc, int fr, int fq) const {
        const int col0 = u.pn * BM + wc * 32 + 4 * fq;
        const int b = (u.pm * BM) / rows_per_batch;
        f32x4 gv[2][2];
#pragma unroll
        for (int bj = 0; bj < 2; ++bj)
#pragma unroll
            for (int n = 0; n < 2; ++n) gv[bj][n] = *(const f32x4*)(gate + (size_t)b * gate_stride + col0 + bj * HALF + n * 16);
#pragma unroll
        for (int ai = 0; ai < 2; ++ai)
#pragma unroll
            for (int m = 0; m < 4; ++m) {
                const size_t off = (size_t)(u.pm * BM + ai * HALF + wr * 64 + m * 16 + fr) * ldc + col0;
#pragma unroll
                for (int bj = 0; bj < 2; ++bj)
#pragma unroll
                    for (int n = 0; n < 2; ++n) {
                        const f32x4 bs = *(const f32x4*)(resid + off + bj * HALF + n * 16);
                        *(f32x4*)(out + off + bj * HALF + n * 16) = bs + gv[bj][n] * acc[ai][bj][m][n];
                    }
                if (m & 1) asm volatile("" ::: "memory");
            }
    }
};

struct EpiX1 {
    static constexpr bool PERM = true, AFTER_DRAIN = false, KSCALE = true;
    static constexpr int KS1 = 16, KS2 = 24;
    const float* resid; const float* mod; bf16_t* xm; float* psq; int ldc, rows_per_batch; const PG8_LAS float* kt; int pm0;
    __device__ __forceinline__ void kscale(f32x4 (&acc)[2][2][4][2], const Unit& u, int t, int wr, int fr) const {
        const PG8_LAS float* tab = kt + ((u.pm == pm0) ? 0 : 1024) + ((t == KS1) ? 0 : 1);
#pragma unroll
        for (int ai = 0; ai < 2; ++ai)
#pragma unroll
            for (int m = 0; m < 4; ++m) { const float f = tab[(ai * HALF + wr * 64 + m * 16 + fr) * 4];
#pragma unroll
                for (int bj = 0; bj < 2; ++bj) { acc[ai][bj][m][0] *= f; acc[ai][bj][m][1] *= f; } }
    }
    __device__ __forceinline__ void operator()(const f32x4 (&acc)[2][2][4][2], const Unit& u, int wr, int wc, int fr, int fq) const {
        const int b = (u.pm * BM) / rows_per_batch;
        const float* g1 = mod + (size_t)b * 6 * ldc + 2 * ldc; const float* s2 = mod + (size_t)b * 6 * ldc + 4 * ldc;
        const int col0 = u.pn * BM + wc * 32 + 8 * fq;
        const PG8_LAS float* tab = kt + ((u.pm == pm0) ? 0 : 1024) + 2;
        f32x4 gv[2][2], sv[2][2];
#pragma unroll
        for (int bj = 0; bj < 2; ++bj)
#pragma unroll
            for (int n = 0; n < 2; ++n) { gv[bj][n] = *(const f32x4*)(g1 + col0 + bj * HALF + 4 * n); sv[bj][n] = *(const f32x4*)(s2 + col0 + bj * HALF + 4 * n) + 1.0f; }
#pragma unroll
        for (int ai = 0; ai < 2; ++ai)
#pragma unroll
            for (int m = 0; m < 4; ++m) {
                const int lr = ai * HALF + wr * 64 + m * 16 + fr, row = u.pm * BM + lr; const size_t off = (size_t)row * ldc + col0;
                const float rf = tab[lr * 4];
                float ss = 0.f;
#pragma unroll
                for (int bj = 0; bj < 2; ++bj) {
                    const f32x4 r0 = *(const f32x4*)(resid + off + bj * HALF), r1 = *(const f32x4*)(resid + off + bj * HALF + 4);
                    const f32x4 x0 = r0 + gv[bj][0] * (acc[ai][bj][m][0] * rf), x1 = r1 + gv[bj][1] * (acc[ai][bj][m][1] * rf);
                    ss += (x0[0] * x0[0] + x0[1] * x0[1]) + (x0[2] * x0[2] + x0[3] * x0[3]) + (x1[0] * x1[0] + x1[1] * x1[1]) + (x1[2] * x1[2] + x1[3] * x1[3]);
                    const f32x4 y0 = x0 * sv[bj][0], y1 = x1 * sv[bj][1];
                    u32x4 w; w.x = cvt_pk_bf16(y0[0], y0[1]); w.y = cvt_pk_bf16(y0[2], y0[3]); w.z = cvt_pk_bf16(y1[0], y1[1]); w.w = cvt_pk_bf16(y1[2], y1[3]);
                    *(u32x4*)(xm + off + bj * HALF) = w;
                }
                ss += __shfl_xor(ss, 16); ss += __shfl_xor(ss, 32);
                if (fq == 0) psq[(size_t)row * 32 + u.pn * 4 + wc] = ss;
                if (m & 1) asm volatile("" ::: "memory");
            }
    }
};
struct EpiScaleBias {
    static constexpr bool PERM = true, AFTER_DRAIN = false, KSCALE = false;
    bf16_t* O; int ldc; const float* bias; int rows_per_batch; const PG8_LAS float* rt; int pm0;
    __device__ __forceinline__ void operator()(const f32x4 (&acc)[2][2][4][2], const Unit& u, int wr, int wc, int fr, int fq) const {
        const int b = (u.pm * BM) / rows_per_batch; const float* bp = bias + (size_t)b * ldc;
        const int col0 = u.pn * BM + wc * 32 + 8 * fq;
        const PG8_LAS float* rtu = rt + ((u.pm == pm0) ? 0 : 256);
        f32x4 bv[2][2];
#pragma unroll
        for (int bj = 0; bj < 2; ++bj)
#pragma unroll
            for (int n = 0; n < 2; ++n) bv[bj][n] = *(const f32x4*)(bp + col0 + bj * HALF + 4 * n);
#pragma unroll
        for (int ai = 0; ai < 2; ++ai)
#pragma unroll
            for (int m = 0; m < 4; ++m) {
                const int lr = ai * HALF + wr * 64 + m * 16 + fr; const float rs = rtu[lr];
                bf16_t* rowp = O + (size_t)(u.pm * BM + lr) * ldc + col0;
#pragma unroll
                for (int bj = 0; bj < 2; ++bj) {
                    const f32x4 v0 = acc[ai][bj][m][0] * rs + bv[bj][0], v1 = acc[ai][bj][m][1] * rs + bv[bj][1];
                    u32x4 w; w.x = cvt_pk_bf16(v0[0], v0[1]); w.y = cvt_pk_bf16(v0[2], v0[3]); w.z = cvt_pk_bf16(v1[0], v1[1]); w.w = cvt_pk_bf16(v1[2], v1[3]);
                    *(u32x4*)(rowp + bj * HALF) = w;
                }
            }
    }
};
template <class Epi, class Sched, bool ALIGN_EPI = false, bool SP2 = false>
__device__ __forceinline__ void gemm_phase(PG8_LAS unsigned char* lds, const Gemm g, const Sched& S, const Epi& E) {
    const int tid = threadIdx.x, wid = __builtin_amdgcn_readfirstlane(tid >> 6), lane = tid & 63, wr = wid >> 2, wc = wid & 3, fr = lane & 15, fq = lane >> 4;
    const int K = g.K, nt = K / BK;
    unsigned voffA[2], voffB[2];
#pragma unroll
    for (int i = 0; i < 2; ++i) { int R, C; stage_rc(tid * 16 + i * 8192, R, C); const int Rb = Epi::PERM ? ((R & ~31) + perm32(R & 31)) : R;
        voffA[i] = (unsigned)(R * g.lda + C) * 2u; voffB[i] = (unsigned)(Rb * K + C) * 2u; }
    const size_t kstep = (size_t)(BK * 2);
    const size_t hstep = (size_t)HALF * K * 2;
    const size_t tstep = 2 * hstep; const size_t hstepA = (size_t)HALF * g.lda * 2, tstepA = 2 * hstepA;
    const unsigned ldsw = (unsigned)wid * 1024u;
    const int aoff = lds_byte(wr * 64 + fr, fq * 8), boff = lds_byte(wc * 32 + fr, fq * 8);
#define PG8_SA(b, h) (((b) * 2 + (h)) * HTB)
#define PG8_SB(b, h) ((4 + (b) * 2 + (h)) * HTB)
#define PG8_STAGE(bufoff, gbase, voff) do { _Pragma("unroll") for (int _i = 0; _i < 2; ++_i) \
        __builtin_amdgcn_global_load_lds((const unsigned*)((const char*)(gbase) + (voff)[_i]), (PG8_LAS unsigned*)(lds + (bufoff) + ldsw + _i * 8192), 16, 0, 0); } while (0)
#define PG8_LDA(dst, b, h) do { _Pragma("unroll") for (int m = 0; m < 4; ++m) _Pragma("unroll") for (int k = 0; k < 2; ++k) dst[m][k] = *(const PG8_LAS bf16x8*)(lds + PG8_SA(b, h) + aoff + m * 2048 + k * 1024); } while (0)
#define PG8_LDB(dst, b, h) do { _Pragma("unroll") for (int n = 0; n < 2; ++n) _Pragma("unroll") for (int k = 0; k < 2; ++k) dst[n][k] = *(const PG8_LAS bf16x8*)(lds + PG8_SB(b, h) + boff + n * 2048 + k * 1024); } while (0)
#define PG8_MMA(ai, bj, At, Bt) do { __builtin_amdgcn_s_setprio(1); _Pragma("unroll") for (int m = 0; m < 4; ++m) _Pragma("unroll") for (int n = 0; n < 2; ++n) _Pragma("unroll") for (int k = 0; k < 2; ++k) \
        acc[ai][bj][m][n] = __builtin_amdgcn_mfma_f32_16x16x32_bf16(Bt[n][k], At[m][k], acc[ai][bj][m][n], 0, 0, 0); __builtin_amdgcn_s_setprio(0); } while (0)
#define PG8_WAIT_V(n) asm volatile("s_waitcnt vmcnt(" #n ")" ::: "memory")
#define PG8_WAIT_L(n) asm volatile("s_waitcnt lgkmcnt(" #n ")" ::: "memory")
#define PG8_BAR __builtin_amdgcn_s_barrier()
#define PG8_SCHED __builtin_amdgcn_sched_barrier(0)
    Unit cur, nxt; int ui = 0;
    if (!S.next(0, cur)) return;
    f32x4 acc[2][2][4][2];
#pragma unroll
    for (int a = 0; a < 2; ++a)
#pragma unroll
        for (int b = 0; b < 2; ++b)
#pragma unroll
            for (int m = 0; m < 4; ++m)
#pragma unroll
                for (int n = 0; n < 2; ++n) acc[a][b][m][n] = (f32x4){0.f, 0.f, 0.f, 0.f};
    bf16x8 At[4][2], B0[2][2], B1[2][2];
    const char* cA = (const char*)g.A + (size_t)cur.pm * tstepA; const char* cB = (const char*)g.Bt + (size_t)cur.pn * tstep;
    S.a_ready(cur);
    if constexpr (SP2) {
        PG8_STAGE(PG8_SB(0, 0), cB, voffB); PG8_STAGE(PG8_SB(0, 1), cB + hstep, voffB); PG8_STAGE(PG8_SA(0, 0), cA, voffA); PG8_STAGE(PG8_SA(0, 1), cA + hstepA, voffA);
        if (wr == 1) PG8_BAR;
        PG8_WAIT_V(2); PG8_BAR;
        PG8_STAGE(PG8_SB(1, 0), cB + kstep, voffB); PG8_STAGE(PG8_SA(1, 0), cA + kstep, voffA); PG8_STAGE(PG8_SB(1, 1), cB + hstep + kstep, voffB);
        PG8_WAIT_V(6); PG8_BAR;
    } else {
        PG8_STAGE(PG8_SB(0, 0), cB, voffB); PG8_STAGE(PG8_SA(0, 0), cA, voffA); PG8_STAGE(PG8_SB(0, 1), cB + hstep, voffB); PG8_STAGE(PG8_SA(0, 1), cA + hstepA, voffA);
        if (wr == 1) PG8_BAR;
        PG8_WAIT_V(4); PG8_BAR;
        PG8_STAGE(PG8_SB(1, 0), cB + kstep, voffB); PG8_STAGE(PG8_SA(1, 0), cA + kstep, voffA); PG8_STAGE(PG8_SB(1, 1), cB + hstep + kstep, voffB);
        PG8_WAIT_V(6); PG8_BAR;
    }
    for (;;) {
        const bool has_next = S.next(ui + 1, nxt);
        const char* nA = has_next ? (const char*)g.A + (size_t)nxt.pm * tstepA : cA; const char* nB = has_next ? (const char*)g.Bt + (size_t)nxt.pn * tstep : cB;
        for (int t = 0; t < nt; t += 2) {
            const bool last = (t == nt - 2);
            const char* a1 = cA + (size_t)(t + 1) * kstep;
            const char* a2 = last ? nA : cA + (size_t)(t + 2) * kstep; const char* b2 = last ? nB : cB + (size_t)(t + 2) * kstep;
            const char* a3 = a2 + kstep; const char* b3 = b2 + kstep;
            if (last && has_next) S.a_ready(nxt);
            if constexpr (Epi::KSCALE) { if (t == Epi::KS1 || t == Epi::KS2) E.kscale(acc, cur, t, wr, fr); }
            if constexpr (SP2) {
            PG8_LDB(B0, 0, 0); PG8_LDB(B1, 0, 1); PG8_SCHED; PG8_LDA(At, 0, 0); PG8_STAGE(PG8_SA(1, 1), a1 + hstepA, voffA);
            PG8_WAIT_V(8); PG8_WAIT_L(0); PG8_BAR; PG8_MMA(0, 0, At, B0); PG8_MMA(0, 1, At, B1); PG8_BAR; PG8_SCHED;
            PG8_LDA(At, 0, 1); PG8_STAGE(PG8_SB(0, 0), b2, voffB); PG8_STAGE(PG8_SB(0, 1), b2 + hstep, voffB); PG8_STAGE(PG8_SA(0, 0), a2, voffA);
            PG8_WAIT_V(8); PG8_WAIT_L(0); PG8_BAR; PG8_MMA(1, 0, At, B0); PG8_MMA(1, 1, At, B1); PG8_BAR; PG8_SCHED;
            PG8_LDB(B0, 1, 0); PG8_LDB(B1, 1, 1); PG8_SCHED; PG8_LDA(At, 1, 0); PG8_STAGE(PG8_SA(0, 1), a2 + hstepA, voffA);
            PG8_WAIT_V(8); PG8_WAIT_L(0); PG8_BAR; PG8_MMA(0, 0, At, B0); PG8_MMA(0, 1, At, B1); PG8_BAR; PG8_SCHED;
            PG8_LDA(At, 1, 1); PG8_STAGE(PG8_SB(1, 0), b3, voffB); PG8_STAGE(PG8_SB(1, 1), b3 + hstep, voffB); PG8_STAGE(PG8_SA(1, 0), a3, voffA);
            PG8_WAIT_V(8); PG8_WAIT_L(0); PG8_BAR; PG8_MMA(1, 0, At, B0); PG8_MMA(1, 1, At, B1); PG8_BAR; PG8_SCHED;
            } else {
            PG8_LDB(B0, 0, 0); PG8_SCHED; PG8_LDA(At, 0, 0); PG8_STAGE(PG8_SA(1, 1), a1 + hstepA, voffA);
            PG8_WAIT_L(8); PG8_BAR; PG8_WAIT_L(0); PG8_MMA(0, 0, At, B0); PG8_BAR; PG8_SCHED;
            PG8_LDB(B1, 0, 1); PG8_STAGE(PG8_SB(0, 0), b2, voffB);
            PG8_BAR; PG8_WAIT_L(0); PG8_MMA(0, 1, At, B1); PG8_BAR;
            PG8_LDA(At, 0, 1); PG8_STAGE(PG8_SA(0, 0), a2, voffA);
            PG8_BAR; PG8_WAIT_L(0); PG8_MMA(1, 0, At, B0); PG8_BAR; PG8_SCHED;
            PG8_STAGE(PG8_SB(0, 1), b2 + hstep, voffB);
            PG8_WAIT_V(6); PG8_BAR; PG8_MMA(1, 1, At, B1); PG8_BAR;
            PG8_LDB(B0, 1, 0); PG8_SCHED; PG8_LDA(At, 1, 0); PG8_STAGE(PG8_SA(0, 1), a2 + hstepA, voffA);
            PG8_WAIT_L(8); PG8_BAR; PG8_WAIT_L(0); PG8_MMA(0, 0, At, B0); PG8_BAR; PG8_SCHED;
            PG8_LDB(B1, 1, 1); PG8_STAGE(PG8_SB(1, 0), b3, voffB);
            PG8_BAR; PG8_WAIT_L(0); PG8_MMA(0, 1, At, B1); PG8_BAR;
            PG8_LDA(At, 1, 1); PG8_STAGE(PG8_SA(1, 0), a3, voffA);
            PG8_BAR; PG8_WAIT_L(0); PG8_MMA(1, 0, At, B0); PG8_BAR; PG8_SCHED;
            PG8_STAGE(PG8_SB(1, 1), b3 + hstep, voffB);
            PG8_WAIT_V(6); PG8_BAR; PG8_MMA(1, 1, At, B1); PG8_BAR;
            }
        }
        if constexpr (ALIGN_EPI) { if (wr == 0) PG8_BAR; }
        if constexpr (!Epi::AFTER_DRAIN) { E(acc, cur, wr, wc, fr, fq); S.done(cur); }
        if (!has_next) break;
#pragma unroll
        for (int a = 0; a < 2; ++a)
#pragma unroll
            for (int b = 0; b < 2; ++b)
#pragma unroll
                for (int m = 0; m < 4; ++m)
#pragma unroll
                    for (int n = 0; n < 2; ++n) acc[a][b][m][n] = (f32x4){0.f, 0.f, 0.f, 0.f};
        cur = nxt; cA = nA; cB = nB; ++ui;
        if constexpr (ALIGN_EPI) { if (wr == 1) PG8_BAR; }
    }
    PG8_WAIT_V(0);
    if constexpr (!ALIGN_EPI) { if (wr == 0) PG8_BAR; }
    PG8_BAR;
    if constexpr (Epi::AFTER_DRAIN) { E.fused(acc, cur, wr, wc, fr, fq, lds, wid, lane); S.done(cur); }
#undef PG8_SA
#undef PG8_SB
#undef PG8_STAGE
#undef PG8_LDA
#undef PG8_LDB
#undef PG8_MMA
#undef PG8_WAIT_V
#undef PG8_WAIT_L
#undef PG8_BAR
#undef PG8_SCHED
}
}
#define LDS_WAIT() asm volatile("s_waitcnt lgkmcnt(0)" ::: "memory")
#define XB_TMO      128
#define XB_XCNT(j)  (256  + 64 * (j))
#define XB_XSUB(j)  (1280 + 64 * (j))
#define XB_XGEN(j)  (2304 + 64 * (j))
#define XB_TOP      3328
#define XB_TOPGEN   3392
#define XCD_BAR_WORDS 3456
#define XB_SPIN_CAP (1u << 18)

__device__ __forceinline__ unsigned xb_ld(unsigned* p)              { return __hip_atomic_load(p, __ATOMIC_RELAXED, __HIP_MEMORY_SCOPE_AGENT); }
__device__ __forceinline__ unsigned xb_add(unsigned* p, unsigned v) { return __hip_atomic_fetch_add(p, v, __ATOMIC_RELAXED, __HIP_MEMORY_SCOPE_AGENT); }
__device__ __forceinline__ unsigned xb_xcc_id() { return (unsigned)__builtin_amdgcn_s_getreg((3 << 11) | 20) & 0xFu; }
#define XB_SPIN(cond, bar) do { unsigned _sp = 0; while (cond) { __builtin_amdgcn_s_sleep(1); \
    if ((++_sp & 255u) == 0u) { if (xb_ld(&(bar)[XB_TMO])) break; if (_sp > XB_SPIN_CAP) { atomicAdd(&(bar)[XB_TMO], 1u); break; } } } } while (0)

struct XcdBarrier {
    unsigned* bar; unsigned x;
    volatile LAS unsigned* st;
};

__device__ __forceinline__ XcdBarrier xcd_barrier_post(unsigned* bar, volatile LAS unsigned* st) {
    XcdBarrier b; b.bar = bar; b.x = xb_xcc_id(); b.st = st;
    if (threadIdx.x == 0) (void)xb_add(&bar[XB_XCNT(b.x)], 1u);
    return b;
}
__device__ __forceinline__ void xcd_barrier_complete(unsigned* bar, unsigned x, unsigned& nloc, unsigned& nx) {
    const unsigned G = gridDim.x * gridDim.y * gridDim.z;
    unsigned sum, cnt, mine, sp = 0u;
    for (;;) {
        sum = 0u; cnt = 0u; mine = 0u;
#pragma unroll
        for (unsigned j = 0; j < 16; ++j) { const unsigned c = xb_ld(&bar[XB_XCNT(j)]); sum += c; cnt += (c > 0u) ? 1u : 0u; mine = (j == x) ? c : mine; }
        if (sum == G) break;
        __builtin_amdgcn_s_sleep(1);
        if ((++sp & 255u) == 0u) { if (xb_ld(&bar[XB_TMO])) break; if (sp > XB_SPIN_CAP) { atomicAdd(&bar[XB_TMO], 1u); break; } }
    }
    nloc = mine > 0u ? mine : 1u; nx = cnt > 0u ? cnt : 1u;
}

__device__ __forceinline__ void xcd_barrier(const XcdBarrier& b) {
    asm volatile("s_waitcnt vmcnt(0)" ::: "memory");
    __syncthreads();
    if (threadIdx.x == 0) {
        unsigned* bar = b.bar;
        __builtin_amdgcn_s_waitcnt(0);
        unsigned nloc = b.st[0], nx = b.st[1];
        if (nloc == 0u) { xcd_barrier_complete(bar, b.x, nloc, nx); b.st[0] = nloc; b.st[1] = nx; }
        const unsigned old = xb_add(&bar[XB_XSUB(b.x)], 1u);
        const unsigned gen = old / nloc;
        if (old + 1u == (gen + 1u) * nloc) {
            __builtin_amdgcn_fence(__ATOMIC_RELEASE, "agent");
            asm volatile("s_waitcnt vmcnt(0)" ::: "memory");
            const unsigned og = xb_add(&bar[XB_TOP], 1u);
            const unsigned tg = og / nx;
            if (og + 1u == (tg + 1u) * nx) xb_add(&bar[XB_TOPGEN], 1u);
            else XB_SPIN(xb_ld(&bar[XB_TOPGEN]) == tg, bar);
            __builtin_amdgcn_fence(__ATOMIC_ACQUIRE, "agent");
            xb_add(&bar[XB_XGEN(b.x)], 1u);
            asm volatile("s_waitcnt vmcnt(0)" ::: "memory");
        } else {
            XB_SPIN(xb_ld(&bar[XB_XGEN(b.x)]) == gen, bar);
            __builtin_amdgcn_fence(__ATOMIC_ACQUIRE, "agent");
            asm volatile("s_waitcnt vmcnt(0)" ::: "memory");
        }
    }
    __syncthreads();
}
#define SYNC() __syncthreads()
__device__ __forceinline__ float silu_fast(float v) { return v * __builtin_amdgcn_rcpf(1.f + __expf(-v)); }
__device__ __forceinline__ float sq2(unsigned w) { const float a = bflo(w), b = bfhi(w); return a * a + b * b; }

__device__ __forceinline__ void ph_mod(const Params& p, unsigned char* lds, int tid, int vb) {
    float* cact = (float*)lds; float* red = (float*)(lds + 65536);
    const int lane = tid & 63, wv = tid >> 6, c4 = lane & 31, kh = lane >> 5;
    for (int i = tid; i < NB * DM; i += NTHR) { const int b = i / DM, k = i % DM; cact[k * NB + b] = silu_f(p.c[i]); }
    SYNC();
    const int n = vb * 128 + 4 * c4;
    f32x4 acc[NB];
#pragma unroll
    for (int b = 0; b < NB; ++b) acc[b] = (f32x4){0.f, 0.f, 0.f, 0.f};
    const float* w = p.w_ada + (size_t)(wv * 256 + kh) * (6 * DM) + n;
#pragma unroll 8
    for (int i = 0; i < 128; ++i) {
        const f32x4 wk = *(const f32x4*)(w + (size_t)(2 * i) * (6 * DM));
        const f32x4 ca = *(const f32x4*)(cact + (wv * 256 + 2 * i + kh) * NB), cb = *(const f32x4*)(cact + (wv * 256 + 2 * i + kh) * NB + 4);
        acc[0] += wk * ca.x; acc[1] += wk * ca.y; acc[2] += wk * ca.z; acc[3] += wk * ca.w; acc[4] += wk * cb.x; acc[5] += wk * cb.y; acc[6] += wk * cb.z; acc[7] += wk * cb.w;
    }
#pragma unroll
    for (int b = 0; b < NB; ++b) { acc[b].x += __shfl_xor(acc[b].x, 32); acc[b].y += __shfl_xor(acc[b].y, 32); acc[b].z += __shfl_xor(acc[b].z, 32); acc[b].w += __shfl_xor(acc[b].w, 32); }
    if (lane < 32) {
#pragma unroll
        for (int b = 0; b < NB; ++b) *(f32x4*)(red + (wv * NB + b) * 128 + 4 * c4) = acc[b];
    }
    SYNC();
    for (int o = tid; o < NB * 128; o += NTHR) {
        const int b = o >> 7, col = o & 127;
        float s = p.b_ada[vb * 128 + col];
#pragma unroll
        for (int w8 = 0; w8 < 8; ++w8) s += red[(w8 * NB + b) * 128 + col];
        ((float*)(p.ws + WS_MOD))[b * 6 * DM + vb * 128 + col] = s;
    }
    SYNC();
}
__device__ __forceinline__ void ph_rope_tab(const Params& p, int gtid, int gn) {
    for (int i = gtid; i < T * 32; i += gn) {
        const int t = i >> 5, f = i & 31;
        const float inv = 1.0f / powf(10000.0f, (float)f * (2.0f / 64.0f));
        const float ang = (float)p.pos[t] * inv;
        ((float*)(p.ws + WS_ROPEC))[i] = (float)cos((double)ang);
        ((float*)(p.ws + WS_ROPES))[i] = (float)sin((double)ang);
    }
}
__device__ __forceinline__ void tr_item(const float* W, int K, int N, int Npad, bf16_t* WT, const float* g0, const float* g1, int gs, float* scr, int item, int lane) {
    const int nblk = Npad / 128, kb = item / nblk, nb = item % nblk, k0 = 32 * kb, n0 = 128 * nb;
    const int c4 = lane & 31, kh = lane >> 5, n = n0 + 4 * c4; const bool ok = n < N;
#pragma unroll 8
    for (int i = 0; i < 16; ++i) {
        const int kk = 2 * i + kh, k = k0 + kk;
        f32x4 v = ok ? *(const f32x4*)(W + (size_t)k * N + n) : (f32x4){0.f, 0.f, 0.f, 0.f};
        if (g0) v = v * ((k < gs) ? g0[k] : g1[k - gs]);
        *(f32x4*)(scr + kk * 132 + 4 * c4) = v;
    }
    asm volatile("s_waitcnt lgkmcnt(0)" ::: "memory");
#pragma unroll
    for (int j = 0; j < 8; ++j) {
        const int idx = lane + 64 * j, nn = idx >> 2, ck = idx & 3; const float* sp = scr + (8 * ck) * 132 + nn;
        u32x4 o; o.x = pk2(sp[0 * 132], sp[1 * 132]); o.y = pk2(sp[2 * 132], sp[3 * 132]); o.z = pk2(sp[4 * 132], sp[5 * 132]); o.w = pk2(sp[6 * 132], sp[7 * 132]);
        *(u32x4*)(WT + (size_t)(n0 + nn) * K + k0 + 8 * ck) = o;
    }
    asm volatile("s_waitcnt lgkmcnt(0)" ::: "memory");
}
constexpr int TR_N0 = (DM / 32) * (NPROJ / 128), TR_N1 = (512 / 32) * (NQ / 128), TR_N2 = (256 / 32) * (NKV / 128), TR_N3 = (DM / 32) * (DM / 128), TR_N4 = TR_N3;
constexpr int TR_TOTAL = TR_N0 + TR_N1 + TR_N2 + TR_N3 + TR_N4;
__device__ __forceinline__ void ph_transposes(const Params& p, unsigned char* lds, int wave, int lane, int first, int stride) {
    float* scr = (float*)(lds + wave * 17408);
    for (int it = first; it < TR_TOTAL; it += stride) {
        int r = it;
        if (r < TR_N0) { tr_item(p.w_in, DM, IN_COLS, NPROJ, (bf16_t*)(p.ws + WS_WINT), nullptr, nullptr, 0, scr, r, lane); continue; } r -= TR_N0;
        if (r < TR_N1) { tr_item(p.w_uq, 512, NQ, NQ, (bf16_t*)(p.ws + WS_WUQT), p.q_a_norm, p.q_a_norm, 512, scr, r, lane); continue; } r -= TR_N1;
        if (r < TR_N2) { tr_item(p.w_ukv, 256, NKV, NKV, (bf16_t*)(p.ws + WS_WUKVT), p.kv_a_norm, p.kv_a_norm, 256, scr, r, lane); continue; } r -= TR_N2;
        if (r < TR_N3) { tr_item(p.w_out, DM, DM, DM, (bf16_t*)(p.ws + WS_WOUTT), p.attn_out_norm, p.ssd_norm, 1024, scr, r, lane); continue; } r -= TR_N3;
        tr_item(p.w_query, DM, DM, DM, (bf16_t*)(p.ws + WS_WQT), nullptr, nullptr, 0, scr, r, lane);
    }
}
__device__ __forceinline__ void ph_convert(const float* src, bf16_t* dst, size_t n4, int gtid, int gn) {
    for (size_t i = gtid; i < n4; i += (size_t)gn) {
        const f32x4 v = ((const f32x4*)src)[i];
        uint2 o; o.x = pk2(v.x, v.y); o.y = pk2(v.z, v.w);
        ((uint2*)dst)[i] = o;
    }
}
__device__ __forceinline__ void ph_modrows(const float* in, bf16_t* outp, const float* mod, int sh_idx, int sc_idx, int gwave, int gnw, int lane) {
    for (int row = gwave; row < T; row += gnw) {
        const int b = row / SEQ;
        const f32x4* xr = (const f32x4*)(in + (size_t)row * DM) + lane;
        f32x4 v[8]; float s = 0.f;
#pragma unroll
        for (int j = 0; j < 8; ++j) { v[j] = xr[64 * j]; s += (v[j].x * v[j].x + v[j].y * v[j].y) + (v[j].z * v[j].z + v[j].w * v[j].w); }
        const float r = rsqrtf(wave_sum(s) * (1.f / DM) + EPS);
        const f32x4* sh = (const f32x4*)(mod + (size_t)b * 6 * DM + sh_idx * DM) + lane;
        const f32x4* sc = (const f32x4*)(mod + (size_t)b * 6 * DM + sc_idx * DM) + lane;
        uint2* o = (uint2*)(outp + (size_t)row * DM) + lane;
#pragma unroll
        for (int j = 0; j < 8; ++j) {
            const f32x4 a = sh[64 * j], m = sc[64 * j];
            uint2 w; w.x = pk2(v[j].x * r * (1.f + m.x) + a.x, v[j].y * r * (1.f + m.y) + a.y); w.y = pk2(v[j].z * r * (1.f + m.z) + a.z, v[j].w * r * (1.f + m.w) + a.w);
            o[64 * j] = w;
        }
    }
}
__device__ __forceinline__ void ph_bias2(const Params& p, int gwave, int gnw, int lane) {
    const float* mod = (const float*)(p.ws + WS_MOD);
    for (int n = gwave; n < DM; n += gnw) {
        const bf16_t* wr_ = (const bf16_t*)(p.ws + WS_WQT) + (size_t)n * DM + lane * 8;
        float wv[4][8];
#pragma unroll
        for (int j = 0; j < 4; ++j) { const u32x4 w = *(const u32x4*)(wr_ + j * 512);
            wv[j][0] = bflo(w.x); wv[j][1] = bfhi(w.x); wv[j][2] = bflo(w.y); wv[j][3] = bfhi(w.y); wv[j][4] = bflo(w.z); wv[j][5] = bfhi(w.z); wv[j][6] = bflo(w.w); wv[j][7] = bfhi(w.w); }
#pragma unroll
        for (int b = 0; b < NB; ++b) {
            const float* sh = mod + (size_t)b * 6 * DM + 3 * DM + lane * 8; float a = 0.f;
#pragma unroll
            for (int j = 0; j < 4; ++j) { const f32x4 s0 = *(const f32x4*)(sh + j * 512), s1 = *(const f32x4*)(sh + j * 512 + 4);
                a += (wv[j][0] * s0[0] + wv[j][1] * s0[1]) + (wv[j][2] * s0[2] + wv[j][3] * s0[3]) + (wv[j][4] * s1[0] + wv[j][5] * s1[1]) + (wv[j][6] * s1[2] + wv[j][7] * s1[3]); }
            a = wave_sum(a);
            if (lane == 0) ((float*)(p.ws + WS_BIAS2))[b * DM + n] = a;
        }
    }
}
constexpr float QSCALE = 0.07216878364870322f * 1.4426950408889634f;
__device__ __forceinline__ float ssq8(u32x4 w) { return (sq2(w.x) + sq2(w.y)) + (sq2(w.z) + sq2(w.w)); }
__device__ __forceinline__ u32x4 scale8(u32x4 w, float s, const float (&g)[8]) {
    u32x4 o; o.x = pk2(bflo(w.x) * s * g[0], bfhi(w.x) * s * g[1]); o.y = pk2(bflo(w.y) * s * g[2], bfhi(w.y) * s * g[3]);
    o.z = pk2(bflo(w.z) * s * g[4], bfhi(w.z) * s * g[5]); o.w = pk2(bflo(w.w) * s * g[6], bfhi(w.w) * s * g[7]); return o;
}
__device__ __forceinline__ u32x4 rope8(u32x4 w, u32x4 pw, float s, const float (&go)[8], const float (&gp)[8], f32x4 c0, f32x4 c1, f32x4 s0, f32x4 s1, float sgn) {
    const float a[8] = {bflo(w.x) * s * go[0], bfhi(w.x) * s * go[1], bflo(w.y) * s * go[2], bfhi(w.y) * s * go[3], bflo(w.z) * s * go[4], bfhi(w.z) * s * go[5], bflo(w.w) * s * go[6], bfhi(w.w) * s * go[7]};
    const float b[8] = {bflo(pw.x) * s * gp[0], bfhi(pw.x) * s * gp[1], bflo(pw.y) * s * gp[2], bfhi(pw.y) * s * gp[3], bflo(pw.z) * s * gp[4], bfhi(pw.z) * s * gp[5], bflo(pw.w) * s * gp[6], bfhi(pw.w) * s * gp[7]};
    u32x4 o;
    o.x = pk2(a[0] * c0.x + sgn * b[0] * s0.x, a[1] * c0.y + sgn * b[1] * s0.y); o.y = pk2(a[2] * c0.z + sgn * b[2] * s0.z, a[3] * c0.w + sgn * b[3] * s0.w);
    o.z = pk2(a[4] * c1.x + sgn * b[4] * s1.x, a[5] * c1.y + sgn * b[5] * s1.y); o.w = pk2(a[6] * c1.z + sgn * b[6] * s1.z, a[7] * c1.w + sgn * b[7] * s1.w);
    return o;
}
__device__ __forceinline__ u32x4 shfl_xor4(u32x4 w, int m) { u32x4 o; o.x = __shfl_xor(w.x, m); o.y = __shfl_xor(w.y, m); o.z = __shfl_xor(w.z, m); o.w = __shfl_xor(w.w, m); return o; }
__device__ __forceinline__ void ph_qkv_post(const Params& p, int gwave, int gnw, int lane) {
    unsigned char* ws = p.ws;
    const int g16 = lane >> 4, pos = lane & 15, hr = lane >> 3, rpos = lane & 7, f0 = (rpos & 3) * 8;
    const float sgn = (rpos < 4) ? -1.f : 1.f;
    float gqn[8], gqr[8], gqp[8], gkn[8], gkr[8], gkp[8];
#pragma unroll
    for (int i = 0; i < 8; ++i) { gqn[i] = p.q_norm[pos * 8 + i]; gqr[i] = p.q_norm[128 + rpos * 8 + i]; gqp[i] = p.q_norm[128 + (rpos ^ 4) * 8 + i];
                                  gkn[i] = p.k_norm[pos * 8 + i]; gkr[i] = p.k_norm[128 + rpos * 8 + i]; gkp[i] = p.k_norm[128 + (rpos ^ 4) * 8 + i]; }
    for (int t = gwave; t < T; t += gnw) {
        const bf16_t* proj = (const bf16_t*)(ws + WS_PROJ) + (size_t)t * NPROJ;
        const bf16_t* qraw = (const bf16_t*)(ws + WS_QRAW) + (size_t)t * NQ;
        const bf16_t* kvraw = (const bf16_t*)(ws + WS_KVRAW) + (size_t)t * NKV;
        const u32x4 cq = *(const u32x4*)(proj + C_CQ + lane * 8);
        const u32x4 ck = *(const u32x4*)(proj + C_CKV + (lane & 31) * 8);
        const u32x4 kr = *(const u32x4*)(proj + C_KR + rpos * 8);
        const u32x4 qn0 = *(const u32x4*)(qraw + g16 * 192 + pos * 8), qn1 = *(const u32x4*)(qraw + (4 + g16) * 192 + pos * 8), qr = *(const u32x4*)(qraw + hr * 192 + 128 + rpos * 8);
        const u32x4 kn0 = *(const u32x4*)(kvraw + g16 * 256 + pos * 8), kn1 = *(const u32x4*)(kvraw + (4 + g16) * 256 + pos * 8);
        const u32x4 v0 = *(const u32x4*)(kvraw + g16 * 256 + 128 + pos * 8), v1 = *(const u32x4*)(kvraw + (4 + g16) * 256 + 128 + pos * 8);
        const float* rcp = (const float*)(ws + WS_ROPEC) + (size_t)t * 32 + f0; const float* rsp = (const float*)(ws + WS_ROPES) + (size_t)t * 32 + f0;
        const f32x4 c0 = *(const f32x4*)rcp, c1 = *(const f32x4*)(rcp + 4), s0 = *(const f32x4*)rsp, s1 = *(const f32x4*)(rsp + 4);
        const float rcq = rsqrtf(wave_sum(ssq8(cq)) * (1.f / 512.f) + EPS);
        const float rckv = rsqrtf(wave_sum(lane < 32 ? ssq8(ck) : 0.f) * (1.f / 256.f) + EPS);
        float skr = ssq8(kr), nq0 = ssq8(qn0), nq1 = ssq8(qn1), rqs = ssq8(qr), nk0 = ssq8(kn0), nk1 = ssq8(kn1);
#pragma unroll
        for (int o = 1; o < 8; o <<= 1) { skr += __shfl_xor(skr, o); rqs += __shfl_xor(rqs, o); nq0 += __shfl_xor(nq0, o); nq1 += __shfl_xor(nq1, o); nk0 += __shfl_xor(nk0, o); nk1 += __shfl_xor(nk1, o); }
        nq0 += __shfl_xor(nq0, 8); nq1 += __shfl_xor(nq1, 8); nk0 += __shfl_xor(nk0, 8); nk1 += __shfl_xor(nk1, 8);
        const float rc2 = rcq * rcq, rk2 = rckv * rckv;
        const float tq0 = nq0 + __shfl(rqs, 8 * g16), tq1 = nq1 + __shfl(rqs, 8 * (4 + g16));
        const float tqa = __shfl(nq0, 16 * (hr & 3)), tqb = __shfl(nq1, 16 * (hr & 3));
        const float tqr = rqs + ((hr < 4) ? tqa : tqb);
        const float sq0 = rsqrtf(tq0 * rc2 * (1.f / 192.f) + EPS) * rcq * QSCALE, sq1 = rsqrtf(tq1 * rc2 * (1.f / 192.f) + EPS) * rcq * QSCALE, sqr = rsqrtf(tqr * rc2 * (1.f / 192.f) + EPS) * rcq * QSCALE;
        const float rk0 = rsqrtf((nk0 * rk2 + skr) * (1.f / 192.f) + EPS), rk1 = rsqrtf((nk1 * rk2 + skr) * (1.f / 192.f) + EPS);
        const float rka = __shfl(rk0, 16 * (hr & 3)), rkb = __shfl(rk1, 16 * (hr & 3));
        const float rkr = (hr < 4) ? rka : rkb;
        const u32x4 pqr = shfl_xor4(qr, 4), pkr = shfl_xor4(kr, 4);
        const int b = t / SEQ, sidx = t % SEQ;
        bf16_t* Q0 = (bf16_t*)(ws + WS_Q) + ((size_t)(b * 8 + g16) * SEQ + sidx) * 192; bf16_t* Q1 = Q0 + (size_t)4 * SEQ * 192; bf16_t* Qr = (bf16_t*)(ws + WS_Q) + ((size_t)(b * 8 + hr) * SEQ + sidx) * 192;
        bf16_t* K0 = (bf16_t*)(ws + WS_K) + ((size_t)(b * 8 + g16) * SEQ + sidx) * 192; bf16_t* K1 = K0 + (size_t)4 * SEQ * 192; bf16_t* Kr = (bf16_t*)(ws + WS_K) + ((size_t)(b * 8 + hr) * SEQ + sidx) * 192;
        bf16_t* V0 = (bf16_t*)(ws + WS_V) + ((size_t)(b * 8 + g16) * SEQ + sidx) * 128; bf16_t* V1 = V0 + (size_t)4 * SEQ * 128;
        *(u32x4*)(Q0 + pos * 8) = scale8(qn0, sq0, gqn); *(u32x4*)(Q1 + pos * 8) = scale8(qn1, sq1, gqn);
        *(u32x4*)(Qr + 128 + rpos * 8) = rope8(qr, pqr, sqr, gqr, gqp, c0, c1, s0, s1, sgn);
        *(u32x4*)(K0 + pos * 8) = scale8(kn0, rckv * rk0, gkn); *(u32x4*)(K1 + pos * 8) = scale8(kn1, rckv * rk1, gkn);
        *(u32x4*)(Kr + 128 + rpos * 8) = rope8(kr, pkr, rkr, gkr, gkp, c0, c1, s0, s1, sgn);
        const float one[8] = {1.f, 1.f, 1.f, 1.f, 1.f, 1.f, 1.f, 1.f};
        *(u32x4*)(V0 + pos * 8) = scale8(v0, rckv, one); *(u32x4*)(V1 + pos * 8) = scale8(v1, rckv, one);
    }
}
__device__ __forceinline__ void ph_attn_naive(const Params& p, unsigned char* lds, int tid, int bid, int G) {
    const int lane = tid & 63, wv = tid >> 6;
    float* ps = (float*)lds + wv * SEQ;
    float* qs = (float*)(lds + 65536) + wv * 192;
    for (int it = 0; it < (T * 8) / (G * 8); ++it) {
        const int sb = (it & 1) ? (G - 1 - bid) : bid;
        const int gi = it * (G * 8) + sb * 8 + wv;
        const int bh = gi / SEQ, s = gi % SEQ, b = bh >> 3, h = bh & 7;
        const bf16_t* Q = (const bf16_t*)(p.ws + WS_Q) + (size_t)gi * 192;
        const bf16_t* K = (const bf16_t*)(p.ws + WS_K) + (size_t)bh * SEQ * 192;
        const bf16_t* V = (const bf16_t*)(p.ws + WS_KVRAW) + (size_t)(b * SEQ) * NKV + h * 256 + 128;
        for (int d = lane; d < 192; d += 64) qs[d] = bf2f(Q[d]);
        SYNC();
        float mx = -1e30f;
        for (int k0 = 0; k0 <= s; k0 += 64) {
            const int key = k0 + lane; float sc = -INFINITY;
            if (key <= s) {
                const u32x4* kp = (const u32x4*)(K + (size_t)key * 192); float a = 0.f;
                for (int c = 0; c < 24; ++c) { const u32x4 w = kp[c]; const float* q = &qs[c * 8];
                    a += bflo(w.x) * q[0] + bfhi(w.x) * q[1] + bflo(w.y) * q[2] + bfhi(w.y) * q[3] + bflo(w.z) * q[4] + bfhi(w.z) * q[5] + bflo(w.w) * q[6] + bfhi(w.w) * q[7]; }
                sc = a;
            }
            ps[key] = sc;
            mx = fmaxf(mx, sc);
        }
#pragma unroll
        for (int o = 1; o < 64; o <<= 1) mx = fmaxf(mx, __shfl_xor(mx, o));
        SYNC();
        float sum = 0.f;
        for (int key = lane; key <= s; key += 64) { const float e = exp2f(ps[key] - mx); ps[key] = e; sum += e; }
        sum = wave_sum(sum);
        SYNC();
        float o0 = 0.f, o1 = 0.f;
        for (int key = 0; key <= s; ++key) { const float pr = ps[key]; const unsigned w = *(const unsigned*)(V + (size_t)key * NKV + 2 * lane); o0 += pr * bflo(w); o1 += pr * bfhi(w); }
        const float inv = 1.f / sum; o0 *= inv; o1 *= inv;
        const int t = b * SEQ + s;
        *(unsigned*)((bf16_t*)(p.ws + WS_ATTN) + (size_t)t * 1024 + h * 128 + 2 * lane) = pk2(o0, o1);
        SYNC();
    }
}
__device__ __forceinline__ void ph_conv_naive(const Params& p, int gtid, int gn) {
    const bf16_t* proj = (const bf16_t*)(p.ws + WS_PROJ);
    for (int i = gtid; i < T * 1552; i += gn) {
        const int t = i / 1552, c = i % 1552, s = t % SEQ;
        if (c < 1536) {
            float a = p.conv_b[c];
            for (int k = 0; k < 4; ++k) { const int ss = s - 3 + k; if (ss >= 0) a += p.conv_w[k * 1536 + c] * bf2f(proj[(size_t)(t - 3 + k) * NPROJ + C_XBC + c]); }
            ((bf16_t*)(p.ws + WS_XBCA))[(size_t)t * 1536 + c] = (bf16_t)f2bf(silu_f(a));
        } else {
            const int hh = c - 1536; const float v = bf2f(proj[(size_t)t * NPROJ + C_DT + hh]) + p.dt_bias[hh];
            ((float*)(p.ws + WS_DT))[(size_t)t * 16 + hh] = (v > 20.f) ? v : log1pf(__expf(v));
        }
    }
}
__device__ __forceinline__ void ph_ssd_naive(const Params& p, int vb, int lt) {
    const int b = vb >> 4, h = vb & 15, g = h >> 3, pp = lt >> 2, nq = lt & 3;
    const bf16_t* xa = (const bf16_t*)(p.ws + WS_XBCA); const float* dtp = (const float*)(p.ws + WS_DT);
    const bf16_t* proj = (const bf16_t*)(p.ws + WS_PROJ);
    const float a = -__expf(p.a_log[h]), dsk = p.d_skip[h];
    float st[32];
#pragma unroll
    for (int n = 0; n < 32; ++n) st[n] = 0.f;
    for (int s = 0; s < SEQ; ++s) {
        const size_t t = (size_t)b * SEQ + s;
        const float dt = dtp[t * 16 + h], dA = __expf(dt * a);
        const float xv = bf2f(xa[t * 1536 + h * 64 + pp]);
        const bf16_t* Bp = xa + t * 1536 + 1024 + g * 128 + nq * 32; const bf16_t* Cp = xa + t * 1536 + 1280 + g * 128 + nq * 32;
        float y = 0.f; const float dx = dt * xv;
#pragma unroll
        for (int n = 0; n < 32; ++n) { st[n] = st[n] * dA + dx * bf2f(Bp[n]); y += bf2f(Cp[n]) * st[n]; }
        y += __shfl_xor(y, 1); y += __shfl_xor(y, 2);
        if (nq == 0) {
            const float z = bf2f(proj[t * NPROJ + C_Z + h * 64 + pp]);
            ((bf16_t*)(p.ws + WS_YSSD))[t * 1024 + h * 64 + pp] = (bf16_t)f2bf((y + dsk * xv) * silu_f(z));
        }
    }
}
__device__ __forceinline__ void ph_mixnorm(const Params& p, int gwave, int gnw, int lane) {
    for (int t = gwave; t < T; t += gnw) {
        const uint2* ain = (const uint2*)((const bf16_t*)(p.ws + WS_ATTN) + (size_t)t * 1024); const uint2* yin = (const uint2*)((const bf16_t*)(p.ws + WS_YSSD) + (size_t)t * 1024);
        uint2 a[4], y[4]; float sa = 0.f, s0 = 0.f, s1 = 0.f;
#pragma unroll
        for (int j = 0; j < 4; ++j) { a[j] = ain[lane + 64 * j]; y[j] = yin[lane + 64 * j]; sa += sq2(a[j].x) + sq2(a[j].y); const float q = sq2(y[j].x) + sq2(y[j].y); if (j < 2) s0 += q; else s1 += q; }
        const float ra = rsqrtf(wave_sum(sa) * (1.f / 1024.f) + EPS), r0 = rsqrtf(wave_sum(s0) * (1.f / 512.f) + EPS), r1 = rsqrtf(wave_sum(s1) * (1.f / 512.f) + EPS);
        uint2* o = (uint2*)((bf16_t*)(p.ws + WS_MIXIN) + (size_t)t * DM);
#pragma unroll
        for (int j = 0; j < 4; ++j) {
            uint2 r; r.x = pk2(bflo(a[j].x) * ra, bfhi(a[j].x) * ra); r.y = pk2(bflo(a[j].y) * ra, bfhi(a[j].y) * ra); o[lane + 64 * j] = r;
            const float rr = (j < 2) ? r0 : r1;
            uint2 q; q.x = pk2(bflo(y[j].x) * rr, bfhi(y[j].x) * rr); q.y = pk2(bflo(y[j].y) * rr, bfhi(y[j].y) * rr); o[256 + lane + 64 * j] = q;
        }
    }
}
__device__ __forceinline__ void ph_route_naive(const Params& p, unsigned char* lds, int tid, int bid, int G) {
    const int sub = tid >> 7, lt = tid & 127;
    float* base = (float*)(lds + sub * 4096);
    float* q = base; float* sc = base + 256; float* ts = base + 512; int* ti = (int*)(base + 544); float* cs = base + 576; float* bs = base + 832; int* bi = (int*)(base + 848);
    const bf16_t* sk = (const bf16_t*)(p.ws + WS_SUBK);
    for (int it = 0; it < (T * 8) / (G * 4); ++it) {
        const int vb = it * (G * 4) + bid * 4 + sub, t = vb >> 3, h = vb & 7;
        const bf16_t* qp = (const bf16_t*)(p.ws + WS_QP) + (size_t)t * DM + h * 256;
        q[lt] = bf2f(qp[lt]); q[128 + lt] = bf2f(qp[128 + lt]);
        SYNC();
#pragma unroll
        for (int j = 0; j < 2; ++j) {
            const u32x4* kp = (const u32x4*)(sk + ((size_t)(h * 2 + j) * 128 + lt) * 128); float a = 0.f;
            for (int c = 0; c < 16; ++c) { const u32x4 w = kp[c]; const float* qq = q + j * 128 + c * 8;
                a += bflo(w.x) * qq[0] + bfhi(w.x) * qq[1] + bflo(w.y) * qq[2] + bfhi(w.y) * qq[3] + bflo(w.z) * qq[4] + bfhi(w.z) * qq[5] + bflo(w.w) * qq[6] + bfhi(w.w) * qq[7]; }
            sc[j * 128 + lt] = a;
        }
        SYNC();
#pragma unroll
        for (int j = 0; j < 2; ++j) {
            const float v = sc[j * 128 + lt]; int rank = 0;
            for (int k = 0; k < 128; ++k) { const float o = sc[j * 128 + k]; rank += (o > v || (o == v && k < lt)) ? 1 : 0; }
            if (rank < 16) { ts[j * 16 + rank] = v; ti[j * 16 + rank] = lt; }
        }
        SYNC();
        cs[lt] = ts[lt >> 4] + ts[16 + (lt & 15)]; cs[128 + lt] = ts[8 + (lt >> 4)] + ts[16 + (lt & 15)];
        SYNC();
#pragma unroll
        for (int r = 0; r < 2; ++r) {
            const int ci = lt + 128 * r; const float v = cs[ci]; int rank = 0;
            for (int k = 0; k < 256; ++k) { const float o = cs[k]; rank += (o > v || (o == v && k < ci)) ? 1 : 0; }
            if (rank < 16) { bs[rank] = v; bi[rank] = ti[ci >> 4] * 128 + ti[16 + (ci & 15)]; }
        }
        SYNC();
        if (lt < 16) {
            const float mx = bs[0]; float sum = 0.f;
            for (int k = 0; k < 16; ++k) sum += __expf(bs[k] - mx);
            ((float*)(p.ws + WS_GATE))[(size_t)t * 128 + h * 16 + lt] = __expf(bs[lt] - mx) / sum;
            ((int*)(p.ws + WS_IDX))[(size_t)t * 128 + h * 16 + lt] = bi[lt];
        }
        SYNC();
    }
}
__device__ __forceinline__ void ph_peer_naive(const Params& p, unsigned char* lds, int tid, int bid, int G) {
    const int half = tid >> 8, lt = tid & 255, lane = tid & 63, wv = lt >> 6;
    float* red = (float*)(lds + half * 64);
    const bf16_t* U = (const bf16_t*)(p.ws + WS_U16); const bf16_t* V = (const bf16_t*)(p.ws + WS_V16);
    for (int it = 0; it < T / (G * 2); ++it) {
        const int t = it * (G * 2) + bid * 2 + half, b = t / SEQ;
        const u32x4 hw = *(const u32x4*)((const bf16_t*)(p.ws + WS_H2) + (size_t)t * DM + lt * 8);
        const float h0 = bflo(hw.x), h1 = bfhi(hw.x), h2 = bflo(hw.y), h3 = bfhi(hw.y), h4 = bflo(hw.z), h5 = bfhi(hw.z), h6 = bflo(hw.w), h7 = bfhi(hw.w);
        float o0 = 0.f, o1 = 0.f, o2 = 0.f, o3 = 0.f, o4 = 0.f, o5 = 0.f, o6 = 0.f, o7 = 0.f;
        const int* idx = (const int*)(p.ws + WS_IDX) + (size_t)t * 128; const float* gate = (const float*)(p.ws + WS_GATE) + (size_t)t * 128;
        for (int e = 0; e < 128; ++e) {
            const int ex = idx[e];
            const u32x4 uw = *(const u32x4*)(U + (size_t)ex * DM + lt * 8);
            float d = bflo(uw.x) * h0 + bfhi(uw.x) * h1 + bflo(uw.y) * h2 + bfhi(uw.y) * h3 + bflo(uw.z) * h4 + bfhi(uw.z) * h5 + bflo(uw.w) * h6 + bfhi(uw.w) * h7;
            d = wave_sum(d);
            if (lane == 0) red[wv] = d;
            SYNC();
            const float pre = red[0] + red[1] + red[2] + red[3];
            const float a = 0.5f * pre * (1.f + erff(pre * 0.70710678118654752f)) * gate[e];
            SYNC();
            const u32x4 vw = *(const u32x4*)(V + (size_t)ex * DM + lt * 8);
            o0 += a * bflo(vw.x); o1 += a * bfhi(vw.x); o2 += a * bflo(vw.y); o3 += a * bfhi(vw.y); o4 += a * bflo(vw.z); o5 += a * bfhi(vw.z); o6 += a * bflo(vw.w); o7 += a * bfhi(vw.w);
        }
        const float* g2 = (const float*)(p.ws + WS_MOD) + (size_t)b * 6 * DM + 5 * DM + lt * 8;
        float* outp = p.out + (size_t)t * DM + lt * 8;
        const f32x4 x0 = *(const f32x4*)outp, x1 = *(const f32x4*)(outp + 4), ga = *(const f32x4*)g2, gb = *(const f32x4*)(g2 + 4);
        *(f32x4*)outp = (f32x4){x0.x + ga.x * o0, x0.y + ga.y * o1, x0.z + ga.z * o2, x0.w + ga.w * o3};
        *(f32x4*)(outp + 4) = (f32x4){x1.x + gb.x * o4, x1.y + gb.y * o5, x1.z + gb.z * o6, x1.w + gb.w * o7};
    }
}
typedef __bf16 bf16x2_t __attribute__((ext_vector_type(2)));
__device__ __forceinline__ float dot2bf(unsigned a, unsigned b, float c) { return __builtin_amdgcn_fdot2_f32_bf16(__builtin_bit_cast(bf16x2_t, a), __builtin_bit_cast(bf16x2_t, b), c, false); }
__device__ __forceinline__ void ph_peer(const Params& p, LAS unsigned char* ldsl, int wave, int lane, int gwave, int gnw) {
    LAS unsigned char* ring = ldsl + wave * 16384;
    const bf16_t* U = (const bf16_t*)(p.ws + WS_U16); const bf16_t* V = (const bf16_t*)(p.ws + WS_V16);
    const int e_lane = (lane >> 2) & 15; const unsigned lane16 = (unsigned)lane * 16u;
#define PEER_ISSUE(R) do { const int R_ = (R); const int i_ = ((R_ >> 5) << 4) + (R_ & 15); \
        const int e_ = (i_ < 64) ? __builtin_amdgcn_readlane(idx0, i_) : __builtin_amdgcn_readlane(idx1, i_ - 64); \
        const char* base_ = (const char*)(((R_ >> 4) & 1) ? V : U) + (size_t)(unsigned)e_ * (DM * 2); \
        const unsigned* src_ = (const unsigned*)(base_ + lane16); \
        LAS unsigned* dst_ = (LAS unsigned*)(ring + (R_ & 3) * 4096); \
        __builtin_amdgcn_global_load_lds(src_, dst_, 16, 0, 0); \
        __builtin_amdgcn_global_load_lds(src_, dst_, 16, 1024, 0); \
        __builtin_amdgcn_global_load_lds(src_, dst_, 16, 2048, 0); \
        __builtin_amdgcn_global_load_lds(src_, dst_, 16, 3072, 0); } while (0)
#define PEER_WAIT(n) asm volatile("s_waitcnt vmcnt(" #n ")" ::: "memory")
    for (int t = gwave; t < T; t += gnw) {
        const int b = t / SEQ;
        const int idx0 = ((const int*)(p.ws + WS_IDX))[(size_t)t * 128 + lane], idx1 = ((const int*)(p.ws + WS_IDX))[(size_t)t * 128 + 64 + lane];
        const float g0 = ((const float*)(p.ws + WS_GATE))[(size_t)t * 128 + lane], g1 = ((const float*)(p.ws + WS_GATE))[(size_t)t * 128 + 64 + lane];
        u32x4 hreg[4];
#pragma unroll
        for (int j = 0; j < 4; ++j) hreg[j] = *(const u32x4*)((const bf16_t*)(p.ws + WS_H2) + (size_t)t * DM + j * 512 + lane * 8);
        float out[4][8];
#pragma unroll
        for (int j = 0; j < 4; ++j)
#pragma unroll
            for (int i = 0; i < 8; ++i) out[j][i] = 0.f;
        PEER_ISSUE(0); PEER_ISSUE(1); PEER_ISSUE(2);
        for (int hh = 0; hh < 8; ++hh) {
            float pd[16];
#pragma unroll
            for (int k = 0; k < 16; ++k) {
                PEER_ISSUE(hh * 32 + k + 3); PEER_WAIT(12);
                const LAS unsigned char* sl = ring + (k & 3) * 4096 + lane * 16;
                float a = 0.f;
#pragma unroll
                for (int j = 0; j < 4; ++j) { const u32x4 w = *(const LAS u32x4*)(sl + j * 1024);
                    a = dot2bf(w.x, hreg[j].x, a); a = dot2bf(w.y, hreg[j].y, a); a = dot2bf(w.z, hreg[j].z, a); a = dot2bf(w.w, hreg[j].w, a); }
                asm volatile("" : "+v"(a));
                pd[k] = a;
            }
            float q8[8], q4[4], q2[2], q1;
            { const bool hi = (lane & 32) != 0;
#pragma unroll
              for (int i = 0; i < 8; ++i) { const float keep = hi ? pd[i + 8] : pd[i], send = hi ? pd[i] : pd[i + 8]; q8[i] = keep + __shfl_xor(send, 32); } }
            { const bool hi = (lane & 16) != 0;
#pragma unroll
              for (int i = 0; i < 4; ++i) { const float keep = hi ? q8[i + 4] : q8[i], send = hi ? q8[i] : q8[i + 4]; q4[i] = keep + __shfl_xor(send, 16); } }
            { const bool hi = (lane & 8) != 0;
#pragma unroll
              for (int i = 0; i < 2; ++i) { const float keep = hi ? q4[i + 2] : q4[i], send = hi ? q4[i] : q4[i + 2]; q2[i] = keep + __shfl_xor(send, 8); } }
            { const bool hi = (lane & 4) != 0; const float keep = hi ? q2[1] : q2[0], send = hi ? q2[0] : q2[1]; q1 = keep + __shfl_xor(send, 4); }
            q1 += __shfl_xor(q1, 1); q1 += __shfl_xor(q1, 2);
            const float gsel = (hh < 4) ? g0 : g1;
            const float gate = __shfl(gsel, (hh & 3) * 16 + e_lane);
            const float act = 0.5f * q1 * (1.f + erff(q1 * 0.70710678118654752f)) * gate;
#pragma unroll
            for (int k = 0; k < 16; ++k) {
                if (k < 13) { PEER_ISSUE(hh * 32 + 16 + k + 3); PEER_WAIT(12); }
                else if (hh < 7) { PEER_ISSUE(hh * 32 + 16 + k + 3); PEER_WAIT(12); }
                else if (k == 13) PEER_WAIT(8); else if (k == 14) PEER_WAIT(4); else PEER_WAIT(0);
                const float a = __builtin_bit_cast(float, __builtin_amdgcn_readlane(__builtin_bit_cast(int, act), 4 * k));
                const LAS unsigned char* sl = ring + (k & 3) * 4096 + lane * 16;
#pragma unroll
                for (int j = 0; j < 4; ++j) { const u32x4 w = *(const LAS u32x4*)(sl + j * 1024);
                    out[j][0] += a * bflo(w.x); out[j][1] += a * bfhi(w.x); out[j][2] += a * bflo(w.y); out[j][3] += a * bfhi(w.y);
                    out[j][4] += a * bflo(w.z); out[j][5] += a * bfhi(w.z); out[j][6] += a * bflo(w.w); out[j][7] += a * bfhi(w.w);
                    asm volatile("" : "+v"(out[j][0]), "+v"(out[j][1]), "+v"(out[j][2]), "+v"(out[j][3]), "+v"(out[j][4]), "+v"(out[j][5]), "+v"(out[j][6]), "+v"(out[j][7])); }
            }
        }
        const float* g2 = (const float*)(p.ws + WS_MOD) + (size_t)b * 6 * DM + 5 * DM;
        float* outp = p.out + (size_t)t * DM;
#pragma unroll
        for (int j = 0; j < 4; ++j) {
            const int c = j * 512 + lane * 8;
            const f32x4 x0 = *(const f32x4*)(outp + c), x1 = *(const f32x4*)(outp + c + 4), ga = *(const f32x4*)(g2 + c), gb = *(const f32x4*)(g2 + c + 4);
            *(f32x4*)(outp + c) = (f32x4){x0.x + ga.x * out[j][0], x0.y + ga.y * out[j][1], x0.z + ga.z * out[j][2], x0.w + ga.w * out[j][3]};
            *(f32x4*)(outp + c + 4) = (f32x4){x1.x + gb.x * out[j][4], x1.y + gb.y * out[j][5], x1.z + gb.z * out[j][6], x1.w + gb.w * out[j][7]};
        }
    }
#undef PEER_ISSUE
#undef PEER_WAIT
}
typedef short bf16x8 __attribute__((ext_vector_type(8)));
typedef short s16x4 __attribute__((ext_vector_type(4)));
typedef float f32x16 __attribute__((ext_vector_type(16)));
typedef float f32x2_t __attribute__((ext_vector_type(2)));
__device__ __forceinline__ int crow(int r, int hi) { return (r & 3) + 8 * (r >> 2) + 4 * hi; }
__device__ __forceinline__ unsigned cvtpk(float lo, float hi) { f32x2_t v = {lo, hi}; bf16x2_t b = __builtin_convertvector(v, bf16x2_t); return __builtin_bit_cast(unsigned, b); }
__device__ __forceinline__ s16x4 vtr(const LAS unsigned char* pp) { return __builtin_bit_cast(s16x4, __builtin_amdgcn_ds_read_tr16_b64_v4i16((LAS s16x4*)pp)); }
#define TR_PAIR(lo_, hi_, addr_, off_, hioff_) do { asm volatile("ds_read_b64_tr_b16 %0, %1 offset:%c2" : "=&v"(lo_) : "v"(addr_), "i"(off_) : "memory"); \
        asm volatile("ds_read_b64_tr_b16 %0, %1 offset:%c2" : "=&v"(hi_) : "v"(addr_), "i"((off_) + (hioff_)) : "memory"); } while (0)
#define LDS_WAIT_PIN() do { asm volatile("s_waitcnt lgkmcnt(0)" ::: "memory"); __builtin_amdgcn_sched_barrier(0); } while (0)
constexpr int AT_SLOT = 40960, AT_VOFF = 24576;
__device__ __forceinline__ void attn_unit(const Params& p, LAS unsigned char* ldsl, int bh, int qb, int wave, int lane) {
    const int r32 = lane & 31, hi = lane >> 5, b = bh >> 3, h = bh & 7;
    const bf16_t* Kbh = (const bf16_t*)(p.ws + WS_K) + (size_t)bh * SEQ * 192;
    const bf16_t* Vb = (const bf16_t*)(p.ws + WS_V) + (size_t)bh * SEQ * 128;
    const bf16_t* Qw = (const bf16_t*)(p.ws + WS_Q) + ((size_t)bh * SEQ + qb * 256 + wave * 32 + r32) * 192 + 8 * hi;
    const int NT = (qb * 256 + 256) / 64;
    int koff[3];
#pragma unroll
    for (int i = 0; i < 3; ++i) { const int o = 64 * (wave * 3 + i) + lane, k = o / 24, sl = o - 24 * k; int c = sl - ((k >> 1) & 7); c += (c < 0) ? 24 : 0; koff[i] = k * 192 + c * 8; }
    const int vid = wave * 2;
    const bf16_t* vsrc = Vb + (size_t)(16 * (vid & 3) + (lane >> 2)) * 128 + (vid >> 2) * 32 + (lane & 3) * 8;
#define AT_ISSUE(t, slot) do { const bf16_t* ks_ = Kbh + (size_t)(t) * 64 * 192; LAS unsigned char* sb_ = ldsl + (slot) * AT_SLOT; \
        __builtin_amdgcn_global_load_lds((const unsigned*)(ks_ + koff[0]), (LAS unsigned*)(sb_ + (wave * 3 + 0) * 1024), 16, 0, 0); \
        __builtin_amdgcn_global_load_lds((const unsigned*)(ks_ + koff[1]), (LAS unsigned*)(sb_ + (wave * 3 + 1) * 1024), 16, 0, 0); \
        __builtin_amdgcn_global_load_lds((const unsigned*)(ks_ + koff[2]), (LAS unsigned*)(sb_ + (wave * 3 + 2) * 1024), 16, 0, 0); \
        const bf16_t* vs_ = vsrc + (size_t)(t) * 64 * 128; \
        __builtin_amdgcn_global_load_lds((const unsigned*)(vs_), (LAS unsigned*)(sb_ + AT_VOFF + vid * 1024), 16, 0, 0); \
        __builtin_amdgcn_global_load_lds((const unsigned*)(vs_ + (size_t)16 * 128), (LAS unsigned*)(sb_ + AT_VOFF + (vid + 1) * 1024), 16, 0, 0); } while (0)
    bf16x8 qr[12];
#pragma unroll
    for (int s = 0; s < 12; ++s) qr[s] = *(const bf16x8*)(Qw + 16 * s);
#pragma unroll
    for (int s = 0; s < 12; ++s) asm volatile("" : "+v"(qr[s]));
    AT_ISSUE(0, 0); AT_ISSUE(1, 1);
    f32x16 o[4];
#pragma unroll
    for (int d0 = 0; d0 < 4; ++d0)
#pragma unroll
        for (int r = 0; r < 16; ++r) o[d0][r] = 0.f;
    float m = -1e30f, l = 0.f;
    const int kfo = r32 * 384, kc0 = hi + ((r32 >> 1) & 7);
    const int vfo = AT_VOFF + ((lane >> 4) & 1) * 32 + (lane & 3) * 8 + (4 * hi + ((lane & 15) >> 2)) * 64;
    const int qrel = wave * 32 + r32;
    int slot = 0;
    for (int t = 0; t < NT; ++t) {
        if (t + 1 < NT) asm volatile("s_waitcnt vmcnt(5)" ::: "memory"); else asm volatile("s_waitcnt vmcnt(0)" ::: "memory");
        __builtin_amdgcn_s_barrier(); asm volatile("" ::: "memory");
        if (t + 2 < NT) { const int s2 = (slot == 0) ? 2 : slot - 1; AT_ISSUE(t + 2, s2); }
        const int jb = t - (NT - 4);
        if (!(jb >= 0 && 64 * jb > wave * 32 + 31)) {
            const LAS unsigned char* kp = ldsl + slot * AT_SLOT + kfo;
            int kc = kc0; asm volatile("" : "+v"(kc));
            f32x16 p0, p1;
#pragma unroll
            for (int r = 0; r < 16; ++r) { p0[r] = 0.f; p1[r] = 0.f; }
#pragma unroll
            for (int s = 0; s < 12; ++s) {
                int sl_ = kc + 2 * s; sl_ -= (sl_ >= 24) ? 24 : 0;
                const bf16x8 k0 = *(const LAS bf16x8*)(kp + sl_ * 16), k1 = *(const LAS bf16x8*)(kp + sl_ * 16 + 32 * 384);
                p0 = __builtin_amdgcn_mfma_f32_32x32x16_bf16(k0, qr[s], p0, 0, 0, 0);
                p1 = __builtin_amdgcn_mfma_f32_32x32x16_bf16(k1, qr[s], p1, 0, 0, 0);
            }
            if (jb >= 0 && 64 * jb + 63 > wave * 32) {
#pragma unroll
                for (int r = 0; r < 16; ++r) { const int kv = 64 * jb + crow(r, hi); if (kv > qrel) p0[r] = -INFINITY; if (kv + 32 > qrel) p1[r] = -INFINITY; }
            }
            float rm = fmaxf(p0[0], p1[0]);
#pragma unroll
            for (int r = 1; r < 16; ++r) rm = fmaxf(rm, fmaxf(p0[r], p1[r]));
            rm = fmaxf(rm, __shfl_xor(rm, 32));
            const float mn = fmaxf(m, rm);
            if (__any(mn > m)) {
                const float alpha = __builtin_amdgcn_exp2f(m - mn);
                l *= alpha;
#pragma unroll
                for (int r = 0; r < 16; ++r) { const float ar = __shfl(alpha, crow(r, hi));
#pragma unroll
                    for (int d0 = 0; d0 < 4; ++d0) o[d0][r] *= ar; }
                m = mn;
            }
            float ls = 0.f;
#pragma unroll
            for (int r = 0; r < 16; ++r) { p0[r] = __builtin_amdgcn_exp2f(p0[r] - m); p1[r] = __builtin_amdgcn_exp2f(p1[r] - m); ls += p0[r] + p1[r]; }
            l += ls;
            bf16x8 pa[4];
            { u32x4 w;
              w.x = cvtpk(p0[0], p0[1]); w.y = cvtpk(p0[2], p0[3]); w.z = cvtpk(p0[4], p0[5]); w.w = cvtpk(p0[6], p0[7]); pa[0] = __builtin_bit_cast(bf16x8, w);
              w.x = cvtpk(p0[8], p0[9]); w.y = cvtpk(p0[10], p0[11]); w.z = cvtpk(p0[12], p0[13]); w.w = cvtpk(p0[14], p0[15]); pa[1] = __builtin_bit_cast(bf16x8, w);
              w.x = cvtpk(p1[0], p1[1]); w.y = cvtpk(p1[2], p1[3]); w.z = cvtpk(p1[4], p1[5]); w.w = cvtpk(p1[6], p1[7]); pa[2] = __builtin_bit_cast(bf16x8, w);
              w.x = cvtpk(p1[8], p1[9]); w.y = cvtpk(p1[10], p1[11]); w.z = cvtpk(p1[12], p1[13]); w.w = cvtpk(p1[14], p1[15]); pa[3] = __builtin_bit_cast(bf16x8, w); }
            const unsigned vpa = (unsigned)(size_t)(ldsl + slot * AT_SLOT + vfo);
#pragma unroll
            for (int d0 = 0; d0 < 4; ++d0) {
                s16x4 lo[4], hh[4];
                TR_PAIR(lo[0], hh[0], vpa, d0 * 4096 + 0 * 1024, 512); TR_PAIR(lo[1], hh[1], vpa, d0 * 4096 + 1 * 1024, 512);
                TR_PAIR(lo[2], hh[2], vpa, d0 * 4096 + 2 * 1024, 512); TR_PAIR(lo[3], hh[3], vpa, d0 * 4096 + 3 * 1024, 512);
                LDS_WAIT_PIN();
#pragma unroll
                for (int ks = 0; ks < 4; ++ks)
                    o[d0] = __builtin_amdgcn_mfma_f32_32x32x16_bf16(pa[ks], (bf16x8){lo[ks][0], lo[ks][1], lo[ks][2], lo[ks][3], hh[ks][0], hh[ks][1], hh[ks][2], hh[ks][3]}, o[d0], 0, 0, 0);
            }
        }
        slot = (slot == 2) ? 0 : slot + 1;
    }
    l += __shfl_xor(l, 32);
    const float inv = 1.f / l;
    bf16_t* Ow = (bf16_t*)(p.ws + WS_MIXRAW) + ((size_t)b * SEQ + qb * 256 + wave * 32) * DM + h * 128 + r32;
#pragma unroll
    for (int r = 0; r < 16; ++r) { const float ir = __shfl(inv, crow(r, hi));
#pragma unroll
        for (int d0 = 0; d0 < 4; ++d0) Ow[(size_t)crow(r, hi) * DM + d0 * 32] = (bf16_t)f2bf(o[d0][r] * ir); }
    __builtin_amdgcn_sched_barrier(0);
    float ssr[16];
#pragma unroll
    for (int r = 0; r < 16; ++r) { const float ir = __shfl(inv, crow(r, hi)); const float v0 = o[0][r] * ir, v1 = o[1][r] * ir, v2 = o[2][r] * ir, v3 = o[3][r] * ir; ssr[r] = (v0 * v0 + v1 * v1) + (v2 * v2 + v3 * v3); }
    float q8[8], q4[4], q2[2], q1;
    { const bool bb = (lane & 16) != 0;
#pragma unroll
      for (int i = 0; i < 8; ++i) { const float keep = bb ? ssr[i + 8] : ssr[i], send = bb ? ssr[i] : ssr[i + 8]; q8[i] = keep + __shfl_xor(send, 16); } }
    { const bool bb = (lane & 8) != 0;
#pragma unroll
      for (int i = 0; i < 4; ++i) { const float keep = bb ? q8[i + 4] : q8[i], send = bb ? q8[i] : q8[i + 4]; q4[i] = keep + __shfl_xor(send, 8); } }
    { const bool bb = (lane & 4) != 0;
#pragma unroll
      for (int i = 0; i < 2; ++i) { const float keep = bb ? q4[i + 2] : q4[i], send = bb ? q4[i] : q4[i + 2]; q2[i] = keep + __shfl_xor(send, 4); } }
    { const bool bb = (lane & 2) != 0; const float keep = bb ? q2[1] : q2[0], send = bb ? q2[0] : q2[1]; q1 = keep + __shfl_xor(send, 2); }
    q1 += __shfl_xor(q1, 1);
    { const int rs = ((lane >> 4) & 1) * 8 + ((lane >> 3) & 1) * 4 + ((lane >> 2) & 1) * 2 + ((lane >> 1) & 1);
      if ((lane & 1) == 0) ((float*)(p.ws + WS_PSQA))[((size_t)b * SEQ + qb * 256 + wave * 32 + crow(rs, hi)) * 8 + h] = q1; }
    asm volatile("s_waitcnt lgkmcnt(0)" ::: "memory"); __builtin_amdgcn_s_barrier(); asm volatile("" ::: "memory");
#undef AT_ISSUE
}
__device__ __forceinline__ void ph_attn(const Params& p, LAS unsigned char* ldsl, int bid, int G, int wave, int lane) {
    const int vcu = (bid & 7) * (G >> 3) + (bid >> 3);
    const int bh = vcu >> 2, s = vcu & 3;
    attn_unit(p, ldsl, bh, 7 - s, wave, lane);
    attn_unit(p, ldsl, bh, s, wave, lane);
}
__device__ __forceinline__ int f2sort(float f) { const int u = __builtin_bit_cast(int, f); return u ^ ((u >> 31) & 0x7fffffff); }
__device__ __forceinline__ float sort2f(int k) { return __builtin_bit_cast(float, k ^ ((k >> 31) & 0x7fffffff)); }
#define CE_(a_, b_) do { const int hi_ = max(a_, b_); b_ = min(a_, b_); a_ = hi_; } while (0)
#define INS16(L, x) do { int x_ = (x); _Pragma("unroll") for (int i_ = 0; i_ < 16; ++i_) { const int hi_ = max(L[i_], x_); x_ = min(L[i_], x_); L[i_] = hi_; } } while (0)
#define SORT16(v) do { CE_(v[0], v[13]); CE_(v[1], v[12]); CE_(v[2], v[15]); CE_(v[3], v[14]); CE_(v[4], v[8]); CE_(v[5], v[6]); CE_(v[7], v[11]); CE_(v[9], v[10]); CE_(v[0], v[5]); CE_(v[1], v[7]); CE_(v[2], v[9]); CE_(v[3], v[4]); CE_(v[6], v[13]); CE_(v[8], v[14]); CE_(v[10], v[15]); CE_(v[11], v[12]); CE_(v[0], v[1]); CE_(v[2], v[3]); CE_(v[4], v[5]); CE_(v[6], v[8]); CE_(v[7], v[9]); CE_(v[10], v[11]); CE_(v[12], v[13]); CE_(v[14], v[15]); CE_(v[0], v[2]); CE_(v[1], v[3]); CE_(v[4], v[10]); CE_(v[5], v[11]); CE_(v[6], v[7]); CE_(v[8], v[9]); CE_(v[12], v[14]); CE_(v[13], v[15]); CE_(v[1], v[2]); CE_(v[3], v[12]); CE_(v[4], v[6]); CE_(v[5], v[7]); CE_(v[8], v[10]); CE_(v[9], v[11]); CE_(v[13], v[14]); CE_(v[1], v[4]); CE_(v[2], v[6]); CE_(v[5], v[8]); CE_(v[7], v[10]); CE_(v[9], v[13]); CE_(v[11], v[14]); CE_(v[2], v[4]); CE_(v[3], v[6]); CE_(v[9], v[12]); CE_(v[11], v[13]); CE_(v[3], v[5]); CE_(v[6], v[8]); CE_(v[7], v[9]); CE_(v[10], v[12]); CE_(v[3], v[4]); CE_(v[5], v[6]); CE_(v[7], v[8]); CE_(v[9], v[10]); CE_(v[11], v[12]); CE_(v[6], v[7]); CE_(v[8], v[9]); } while (0)
#define BMERGE16(v) do { CE_(v[0], v[8]); CE_(v[1], v[9]); CE_(v[2], v[10]); CE_(v[3], v[11]); CE_(v[4], v[12]); CE_(v[5], v[13]); CE_(v[6], v[14]); CE_(v[7], v[15]); CE_(v[0], v[4]); CE_(v[1], v[5]); CE_(v[2], v[6]); CE_(v[3], v[7]); CE_(v[8], v[12]); CE_(v[9], v[13]); CE_(v[10], v[14]); CE_(v[11], v[15]); CE_(v[0], v[2]); CE_(v[1], v[3]); CE_(v[4], v[6]); CE_(v[5], v[7]); CE_(v[8], v[10]); CE_(v[9], v[11]); CE_(v[12], v[14]); CE_(v[13], v[15]); CE_(v[0], v[1]); CE_(v[2], v[3]); CE_(v[4], v[5]); CE_(v[6], v[7]); CE_(v[8], v[9]); CE_(v[10], v[11]); CE_(v[12], v[13]); CE_(v[14], v[15]); } while (0)
__device__ __forceinline__ void ph_route(const Params& p, LAS unsigned char* ldsl, int wave, int lane, int gwave, int gnw) {
    const int r32 = lane & 31, hi = lane >> 5;
    const bf16_t* SK = (const bf16_t*)(p.ws + WS_SUBK);
    LAS unsigned char* tab = ldsl + wave * 4096 + lane * 32;
    for (int item = gwave; item < (T / 32) * 8; item += gnw) {
        const int tile = item >> 3, h = item & 7, t0 = tile * 32;
        int hi4 = hi * 4; asm volatile("" : "+v"(hi4));
        int S0[16], S1[16];
#pragma unroll
        for (int j = 0; j < 2; ++j) {
            const bf16_t* qp = (const bf16_t*)(p.ws + WS_QP) + (size_t)(t0 + r32) * DM + h * 256 + j * 128 + 8 * hi;
            asm volatile("" : "+v"(qp));
            bf16x8 bq[8];
#pragma unroll
            for (int s = 0; s < 8; ++s) bq[s] = *(const bf16x8*)(qp + 16 * s);
            int L[16];
#pragma unroll
            for (int kb = 0; kb < 4; ++kb) {
                const bf16_t* ap = SK + ((size_t)(h * 2 + j) * 128 + kb * 32 + r32) * 128 + 8 * hi;
                asm volatile("" : "+v"(ap));
                f32x16 acc;
#pragma unroll
                for (int r = 0; r < 16; ++r) acc[r] = 0.f;
#pragma unroll
                for (int s = 0; s < 8; ++s) acc = __builtin_amdgcn_mfma_f32_32x32x16_bf16(*(const bf16x8*)(ap + 16 * s), bq[s], acc, 0, 0, 0);
                int v[16];
#pragma unroll
                for (int r = 0; r < 16; ++r) v[r] = (f2sort(acc[r]) & ~127) | ((127 - (kb * 32 + (r & 3) + 8 * (r >> 2))) - hi4);
                SORT16(v);
                if (kb == 0) {
#pragma unroll
                    for (int i = 0; i < 16; ++i) L[i] = v[i];
                } else {
#pragma unroll
                    for (int i = 0; i < 16; ++i) L[i] = max(L[i], v[15 - i]);
                    BMERGE16(L);
                }
                __builtin_amdgcn_sched_barrier(0);
            }
            int Y[16];
#pragma unroll
            for (int i = 0; i < 16; ++i) Y[i] = __shfl_xor(L[i], 32);
#pragma unroll
            for (int i = 0; i < 16; ++i) L[i] = max(L[i], Y[15 - i]);
            BMERGE16(L);
#pragma unroll
            for (int i = 0; i < 16; ++i) { if (j == 0) S0[i] = L[i]; else S1[i] = L[i]; }
        }
        float f0[16], f1[16];
        {
            unsigned w0[4], w1[4];
#pragma unroll
            for (int i = 0; i < 16; ++i) { f0[i] = sort2f(S0[i] & ~127); f1[i] = sort2f(S1[i] & ~127); }
#pragma unroll
            for (int q = 0; q < 4; ++q) {
                w0[q] = (unsigned)(127 - (S0[4 * q] & 127)) | ((unsigned)(127 - (S0[4 * q + 1] & 127)) << 8) | ((unsigned)(127 - (S0[4 * q + 2] & 127)) << 16) | ((unsigned)(127 - (S0[4 * q + 3] & 127)) << 24);
                w1[q] = (unsigned)(127 - (S1[4 * q] & 127)) | ((unsigned)(127 - (S1[4 * q + 1] & 127)) << 8) | ((unsigned)(127 - (S1[4 * q + 2] & 127)) << 16) | ((unsigned)(127 - (S1[4 * q + 3] & 127)) << 24);
            }
            *(LAS u32x4*)(tab) = (u32x4){w0[0], w0[1], w0[2], w0[3]};
            *(LAS u32x4*)(tab + 16) = (u32x4){w1[0], w1[1], w1[2], w1[3]};
        }
        int Lv[16];
        Lv[0] = (f2sort(f0[0] + f1[0]) & ~255) | 255;
        Lv[1] = (f2sort(f0[0] + f1[1]) & ~255) | 254;
        Lv[2] = (f2sort(f0[0] + f1[2]) & ~255) | 253;
        Lv[3] = (f2sort(f0[0] + f1[3]) & ~255) | 252;
        Lv[4] = (f2sort(f0[0] + f1[4]) & ~255) | 251;
        Lv[5] = (f2sort(f0[0] + f1[5]) & ~255) | 250;
        Lv[6] = (f2sort(f0[0] + f1[6]) & ~255) | 249;
        Lv[7] = (f2sort(f0[0] + f1[7]) & ~255) | 248;
        Lv[8] = (f2sort(f0[0] + f1[8]) & ~255) | 247;
        Lv[9] = (f2sort(f0[0] + f1[9]) & ~255) | 246;
        Lv[10] = (f2sort(f0[0] + f1[10]) & ~255) | 245;
        Lv[11] = (f2sort(f0[0] + f1[11]) & ~255) | 244;
        Lv[12] = (f2sort(f0[0] + f1[12]) & ~255) | 243;
        Lv[13] = (f2sort(f0[0] + f1[13]) & ~255) | 242;
        Lv[14] = (f2sort(f0[0] + f1[14]) & ~255) | 241;
        Lv[15] = (f2sort(f0[0] + f1[15]) & ~255) | 240;
        { int cv_ = (f2sort(f0[1] + f1[0]) & ~255) | 239; INS16(Lv, cv_); __builtin_amdgcn_sched_barrier(0); }
        { int cv_ = (f2sort(f0[1] + f1[1]) & ~255) | 238; INS16(Lv, cv_); __builtin_amdgcn_sched_barrier(0); }
        { int cv_ = (f2sort(f0[1] + f1[2]) & ~255) | 237; INS16(Lv, cv_); __builtin_amdgcn_sched_barrier(0); }
        { int cv_ = (f2sort(f0[1] + f1[3]) & ~255) | 236; INS16(Lv, cv_); __builtin_amdgcn_sched_barrier(0); }
        { int cv_ = (f2sort(f0[1] + f1[4]) & ~255) | 235; INS16(Lv, cv_); __builtin_amdgcn_sched_barrier(0); }
        { int cv_ = (f2sort(f0[1] + f1[5]) & ~255) | 234; INS16(Lv, cv_); __builtin_amdgcn_sched_barrier(0); }
        { int cv_ = (f2sort(f0[1] + f1[6]) & ~255) | 233; INS16(Lv, cv_); __builtin_amdgcn_sched_barrier(0); }
        { int cv_ = (f2sort(f0[1] + f1[7]) & ~255) | 232; INS16(Lv, cv_); __builtin_amdgcn_sched_barrier(0); }
        { int cv_ = (f2sort(f0[2] + f1[0]) & ~255) | 223; INS16(Lv, cv_); __builtin_amdgcn_sched_barrier(0); }
        { int cv_ = (f2sort(f0[2] + f1[1]) & ~255) | 222; INS16(Lv, cv_); __builtin_amdgcn_sched_barrier(0); }
        { int cv_ = (f2sort(f0[2] + f1[2]) & ~255) | 221; INS16(Lv, cv_); __builtin_amdgcn_sched_barrier(0); }
        { int cv_ = (f2sort(f0[2] + f1[3]) & ~255) | 220; INS16(Lv, cv_); __builtin_amdgcn_sched_barrier(0); }
        { int cv_ = (f2sort(f0[2] + f1[4]) & ~255) | 219; INS16(Lv, cv_); __builtin_amdgcn_sched_barrier(0); }
        { int cv_ = (f2sort(f0[3] + f1[0]) & ~255) | 207; INS16(Lv, cv_); __builtin_amdgcn_sched_barrier(0); }
        { int cv_ = (f2sort(f0[3] + f1[1]) & ~255) | 206; INS16(Lv, cv_); __builtin_amdgcn_sched_barrier(0); }
        { int cv_ = (f2sort(f0[3] + f1[2]) & ~255) | 205; INS16(Lv, cv_); __builtin_amdgcn_sched_barrier(0); }
        { int cv_ = (f2sort(f0[3] + f1[3]) & ~255) | 204; INS16(Lv, cv_); __builtin_amdgcn_sched_barrier(0); }
        { int cv_ = (f2sort(f0[4] + f1[0]) & ~255) | 191; INS16(Lv, cv_); __builtin_amdgcn_sched_barrier(0); }
        { int cv_ = (f2sort(f0[4] + f1[1]) & ~255) | 190; INS16(Lv, cv_); __builtin_amdgcn_sched_barrier(0); }
        { int cv_ = (f2sort(f0[4] + f1[2]) & ~255) | 189; INS16(Lv, cv_); __builtin_amdgcn_sched_barrier(0); }
        { int cv_ = (f2sort(f0[5] + f1[0]) & ~255) | 175; INS16(Lv, cv_); __builtin_amdgcn_sched_barrier(0); }
        { int cv_ = (f2sort(f0[5] + f1[1]) & ~255) | 174; INS16(Lv, cv_); __builtin_amdgcn_sched_barrier(0); }
        { int cv_ = (f2sort(f0[6] + f1[0]) & ~255) | 159; INS16(Lv, cv_); __builtin_amdgcn_sched_barrier(0); }
        { int cv_ = (f2sort(f0[6] + f1[1]) & ~255) | 158; INS16(Lv, cv_); __builtin_amdgcn_sched_barrier(0); }
        { int cv_ = (f2sort(f0[7] + f1[0]) & ~255) | 143; INS16(Lv, cv_); __builtin_amdgcn_sched_barrier(0); }
        { int cv_ = (f2sort(f0[7] + f1[1]) & ~255) | 142; INS16(Lv, cv_); __builtin_amdgcn_sched_barrier(0); }
        { int cv_ = (f2sort(f0[8] + f1[0]) & ~255) | 127; INS16(Lv, cv_); __builtin_amdgcn_sched_barrier(0); }
        { int cv_ = (f2sort(f0[9] + f1[0]) & ~255) | 111; INS16(Lv, cv_); __builtin_amdgcn_sched_barrier(0); }
        { int cv_ = (f2sort(f0[10] + f1[0]) & ~255) | 95; INS16(Lv, cv_); __builtin_amdgcn_sched_barrier(0); }
        { int cv_ = (f2sort(f0[11] + f1[0]) & ~255) | 79; INS16(Lv, cv_); __builtin_amdgcn_sched_barrier(0); }
        { int cv_ = (f2sort(f0[12] + f1[0]) & ~255) | 63; INS16(Lv, cv_); __builtin_amdgcn_sched_barrier(0); }
        { int cv_ = (f2sort(f0[13] + f1[0]) & ~255) | 47; INS16(Lv, cv_); __builtin_amdgcn_sched_barrier(0); }
        { int cv_ = (f2sort(f0[14] + f1[0]) & ~255) | 31; INS16(Lv, cv_); __builtin_amdgcn_sched_barrier(0); }
        { int cv_ = (f2sort(f0[15] + f1[0]) & ~255) | 15; INS16(Lv, cv_); __builtin_amdgcn_sched_barrier(0); }
        float g[16]; float sum = 0.f; const float mx = sort2f(Lv[0] & ~255);
        int Le[16];
#pragma unroll
        for (int i = 0; i < 16; ++i) {
            g[i] = __expf(sort2f(Lv[i] & ~255) - mx); sum += g[i];
            const int pos = 255 - (Lv[i] & 255);
            const int ia = *(const LAS unsigned char*)(tab + (pos >> 4)), ib = *(const LAS unsigned char*)(tab + 16 + (pos & 15));
            Le[i] = ia * 128 + ib;
        }
        const float inv = 1.f / sum;
        if (hi == 0) {
            int* ip = (int*)(p.ws + WS_IDX) + (size_t)(t0 + r32) * 128 + h * 16; float* gp = (float*)(p.ws + WS_GATE) + (size_t)(t0 + r32) * 128 + h * 16;
#pragma unroll
            for (int i = 0; i < 4; ++i) {
                *(u32x4*)(ip + 4 * i) = (u32x4){(unsigned)Le[4 * i], (unsigned)Le[4 * i + 1], (unsigned)Le[4 * i + 2], (unsigned)Le[4 * i + 3]};
                *(f32x4*)(gp + 4 * i) = (f32x4){g[4 * i] * inv, g[4 * i + 1] * inv, g[4 * i + 2] * inv, g[4 * i + 3] * inv};
            }
        }
        asm volatile("s_waitcnt lgkmcnt(0)" ::: "memory");
    }
}
__device__ __forceinline__ void ph_conv(const Params& p, int gwave, int gnw, int lane) {
    const bf16_t* proj = (const bf16_t*)(p.ws + WS_PROJ);
    bf16_t* xa = (bf16_t*)(p.ws + WS_XBCA);
    for (int task = gwave; task < 1536 + 256; task += gnw) {
        if (task < 1536) {
            const int run = task / 3, cg = (task % 3) * 64 + lane, c0 = cg * 8;
            const int t0 = run * 32, s0 = t0 % SEQ;
            float w0[8], w1[8], w2[8], w3[8], bs[8], h1[8], h2[8], h3[8];
#pragma unroll
            for (int i = 0; i < 8; ++i) { w0[i] = p.conv_w[0 * 1536 + c0 + i]; w1[i] = p.conv_w[1 * 1536 + c0 + i]; w2[i] = p.conv_w[2 * 1536 + c0 + i]; w3[i] = p.conv_w[3 * 1536 + c0 + i]; bs[i] = p.conv_b[c0 + i]; h1[i] = 0.f; h2[i] = 0.f; h3[i] = 0.f; }
            const bf16_t* src = proj + (size_t)t0 * NPROJ + C_XBC + c0;
            if (s0 > 0) {
                const u32x4 a = *(const u32x4*)(src - (size_t)1 * NPROJ), b = *(const u32x4*)(src - (size_t)2 * NPROJ), c = *(const u32x4*)(src - (size_t)3 * NPROJ);
                h1[0] = bflo(a.x); h1[1] = bfhi(a.x); h1[2] = bflo(a.y); h1[3] = bfhi(a.y); h1[4] = bflo(a.z); h1[5] = bfhi(a.z); h1[6] = bflo(a.w); h1[7] = bfhi(a.w);
                h2[0] = bflo(b.x); h2[1] = bfhi(b.x); h2[2] = bflo(b.y); h2[3] = bfhi(b.y); h2[4] = bflo(b.z); h2[5] = bfhi(b.z); h2[6] = bflo(b.w); h2[7] = bfhi(b.w);
                h3[0] = bflo(c.x); h3[1] = bfhi(c.x); h3[2] = bflo(c.y); h3[3] = bfhi(c.y); h3[4] = bflo(c.z); h3[5] = bfhi(c.z); h3[6] = bflo(c.w); h3[7] = bfhi(c.w);
            }
            bf16_t* dst = xa + (size_t)t0 * 1536 + c0;
#pragma unroll 16
            for (int i = 0; i < 32; ++i) {
                const u32x4 a = *(const u32x4*)(src + (size_t)i * NPROJ);
                float cur[8] = {bflo(a.x), bfhi(a.x), bflo(a.y), bfhi(a.y), bflo(a.z), bfhi(a.z), bflo(a.w), bfhi(a.w)};
                float o[8];
#pragma unroll
                for (int k = 0; k < 8; ++k) { o[k] = silu_fast(bs[k] + w3[k] * cur[k] + w2[k] * h1[k] + w1[k] * h2[k] + w0[k] * h3[k]); h3[k] = h2[k]; h2[k] = h1[k]; h1[k] = cur[k]; }
                u32x4 w; w.x = pk2(o[0], o[1]); w.y = pk2(o[2], o[3]); w.z = pk2(o[4], o[5]); w.w = pk2(o[6], o[7]);
                *(u32x4*)(dst + (size_t)i * 1536) = w;
            }
        } else {
            const int t = (task - 1536) * 64 + lane;
            const u32x4 a = *(const u32x4*)(proj + (size_t)t * NPROJ + C_DT), b = *(const u32x4*)(proj + (size_t)t * NPROJ + C_DT + 8);
            const float raw[16] = {bflo(a.x), bfhi(a.x), bflo(a.y), bfhi(a.y), bflo(a.z), bfhi(a.z), bflo(a.w), bfhi(a.w), bflo(b.x), bfhi(b.x), bflo(b.y), bfhi(b.y), bflo(b.z), bfhi(b.z), bflo(b.w), bfhi(b.w)};
            float* dto = (float*)(p.ws + WS_DT) + (size_t)t * 16; float* cso = (float*)(p.ws + WS_CS) + (size_t)t * 16;
            float dtv[16], csv[16];
#pragma unroll
            for (int hh = 0; hh < 16; ++hh) {
                const float v = raw[hh] + p.dt_bias[hh];
                const float dt = (v > 20.f) ? v : log1pf(__expf(v));
                float c = dt * (-__expf(p.a_log[hh]));
#pragma unroll
                for (int o = 1; o < 64; o <<= 1) { const float u = __shfl_up(c, o); if (lane >= o) c += u; }
                dtv[hh] = dt; csv[hh] = c;
            }
#pragma unroll
            for (int q = 0; q < 4; ++q) { *(f32x4*)(dto + 4 * q) = (f32x4){dtv[4 * q], dtv[4 * q + 1], dtv[4 * q + 2], dtv[4 * q + 3]}; *(f32x4*)(cso + 4 * q) = (f32x4){csv[4 * q], csv[4 * q + 1], csv[4 * q + 2], csv[4 * q + 3]}; }
        }
    }
}
constexpr int P4_ROW = 1152;
__device__ __forceinline__ void fp4_row_load(const Params& p, int row, int lane, f32x4 (&v)[8]) {
    const f32x4* src = (const f32x4*)(((row >= 16384) ? p.v_exp : p.u_exp) + (size_t)(row & 16383) * DM) + lane;
#pragma unroll
    for (int j = 0; j < 8; ++j) v[j] = src[64 * j];
}
__device__ __forceinline__ void fp4_row_store(const Params& p, int row, int lane, const f32x4 (&v)[8]) {
    float mx = 0.f;
#pragma unroll
    for (int j = 0; j < 8; ++j) mx = fmaxf(mx, fmaxf(fmaxf(fabsf(v[j].x), fabsf(v[j].y)), fmaxf(fabsf(v[j].z), fabsf(v[j].w))));
    unsigned sb = f2bf(mx * (1.f / 6.f));
    if (bf2f(sb) * 6.f < mx) sb += 1u;
    if (sb == 0u) sb = 0x3f80u;
    const float inv = 1.f / bf2f(sb);
    unsigned w[4];
#pragma unroll
    for (int q = 0; q < 4; ++q) {
        const f32x4 a = v[2 * q] * inv, b = v[2 * q + 1] * inv;
        unsigned r = 0u;
        r = __builtin_amdgcn_cvt_scalef32_pk_fp4_f32(r, a.x, a.y, 1.0f, 0);
        r = __builtin_amdgcn_cvt_scalef32_pk_fp4_f32(r, a.z, a.w, 1.0f, 1);
        r = __builtin_amdgcn_cvt_scalef32_pk_fp4_f32(r, b.x, b.y, 1.0f, 2);
        r = __builtin_amdgcn_cvt_scalef32_pk_fp4_f32(r, b.z, b.w, 1.0f, 3);
        w[q] = r;
    }
    unsigned char* dst = p.ws + ((row >= 16384) ? WS_V4 : WS_U4) + (size_t)(row & 16383) * P4_ROW;
    *(u32x4*)(dst + lane * 16) = (u32x4){w[0], w[1], w[2], w[3]};
    *(unsigned short*)(dst + 1024 + lane * 2) = (unsigned short)sb;
}
constexpr int SSD_IN = 41472, SSD_BM = 0, SSD_CM = 16384, SSD_XS = 32768, SSD_Z = 36864, SSD_DT = 40960, SSD_CS = 41216, SSD_ST = 3 * SSD_IN, SSD_PART = SSD_ST + 16384, SSD_SYNC = SSD_PART + 4096;
__device__ __forceinline__ void ssd_decay_block(f32x16& cbt, const f32x4 (&c4)[4], const f32x4 (&d4)[4], float cs_l, int sb, int l, int hi, bool diag) {
#pragma unroll
    for (int q = 0; q < 4; ++q) {
#pragma unroll
        for (int i = 0; i < 4; ++i) {
            const int s = 32 * sb + 8 * q + 4 * hi + i;
            float e = __expf(cs_l - c4[q][i]) * d4[q][i];
            if (diag) e = (s <= l) ? e : 0.f;
            cbt[4 * q + i] *= e;
        }
    }
}
__device__ __forceinline__ void ph_ssd(const Params& p, LAS unsigned char* ldsl, int bid, int wave, int lane) {
    const int b = bid >> 5, h = (bid >> 1) & 15, ph = bid & 1, g = h >> 3;
    const int r32 = lane & 31, hi = lane >> 5;
    const size_t tb0 = (size_t)b * SEQ;
    LAS unsigned* sync = (LAS unsigned*)(ldsl + SSD_SYNC);
    if (threadIdx.x < 16) sync[threadIdx.x] = (threadIdx.x >= 14) ? 0xffffffffu : 0u;
    for (int i = threadIdx.x; i < 8192 / 16; i += NTHR) *(LAS u32x4*)(ldsl + SSD_ST + i * 16) = (u32x4){0u, 0u, 0u, 0u};
    asm volatile("s_waitcnt lgkmcnt(0)" ::: "memory"); __builtin_amdgcn_s_barrier(); asm volatile("" ::: "memory");
    if (wave >= 6) {
        const int cvw = bid * 2 + (wave - 6);
        f32x4 ra[8], rb[8], rc[8], rd[8];
        fp4_row_load(p, cvw, lane, ra); fp4_row_load(p, 512 + cvw, lane, rb); fp4_row_load(p, 1024 + cvw, lane, rc); fp4_row_load(p, 1536 + cvw, lane, rd);
        for (int c = 0; c < 16; ++c) {
            fp4_row_store(p, (4 * c) * 512 + cvw, lane, ra);
            if (c + 1 < 16) fp4_row_load(p, (4 * c + 4) * 512 + cvw, lane, ra);
            fp4_row_store(p, (4 * c + 1) * 512 + cvw, lane, rb);
            if (c + 1 < 16) fp4_row_load(p, (4 * c + 5) * 512 + cvw, lane, rb);
            fp4_row_store(p, (4 * c + 2) * 512 + cvw, lane, rc);
            if (c + 1 < 16) fp4_row_load(p, (4 * c + 6) * 512 + cvw, lane, rc);
            fp4_row_store(p, (4 * c + 3) * 512 + cvw, lane, rd);
            if (c + 1 < 16) fp4_row_load(p, (4 * c + 7) * 512 + cvw, lane, rd);
        }
    } else {
        const bf16_t* xa = (const bf16_t*)(p.ws + WS_XBCA); const bf16_t* proj = (const bf16_t*)(p.ws + WS_PROJ);
        const float dsk = p.d_skip[h];
        const int dq = (wave - 2) & 3;
        const int dr0 = 4 * dq + (lane >> 4);
        const bf16_t* bsrc = xa + (tb0 + dr0) * 1536 + 1024 + g * 128 + (((lane & 15) ^ (dr0 & 15)) * 8);
        const bf16_t* csrc = xa + (tb0 + dr0) * 1536 + 1280 + g * 128 + (((lane & 15) ^ (dr0 & 15)) * 8);
        const bf16_t* xsrc = xa + (tb0 + 16 * dq + (lane >> 2)) * 1536 + h * 64 + ph * 32 + (lane & 3) * 8;
        const bf16_t* zsrc = proj + (tb0 + 16 * dq + (lane >> 2)) * NPROJ + C_Z + h * 64 + ph * 32 + (lane & 3) * 8;
        const float* dsrc = (const float*)(p.ws + ((dq == 0) ? WS_DT : WS_CS)) + (tb0 + lane) * 16 + h;
#define SSD_G16(src, dst) __builtin_amdgcn_global_load_lds((const unsigned*)(src), (LAS unsigned*)(dst), 16, 0, 0)
#define SSD_ISSUE(c, buf) do { if (wave >= 2) { LAS unsigned char* in_ = ldsl + (buf) * SSD_IN; const size_t to_ = (size_t)(c) * 64 * 1536; \
        SSD_G16(bsrc + to_, in_ + SSD_BM + dq * 1024); SSD_G16(bsrc + to_ + 16 * 1536, in_ + SSD_BM + (dq + 4) * 1024); SSD_G16(bsrc + to_ + 32 * 1536, in_ + SSD_BM + (dq + 8) * 1024); SSD_G16(bsrc + to_ + 48 * 1536, in_ + SSD_BM + (dq + 12) * 1024); \
        SSD_G16(csrc + to_, in_ + SSD_CM + dq * 1024); SSD_G16(csrc + to_ + 16 * 1536, in_ + SSD_CM + (dq + 4) * 1024); SSD_G16(csrc + to_ + 32 * 1536, in_ + SSD_CM + (dq + 8) * 1024); SSD_G16(csrc + to_ + 48 * 1536, in_ + SSD_CM + (dq + 12) * 1024); \
        SSD_G16(xsrc + to_, in_ + SSD_XS + dq * 1024); SSD_G16(zsrc + (size_t)(c) * 64 * NPROJ, in_ + SSD_Z + dq * 1024); \
        if (dq < 2) __builtin_amdgcn_global_load_lds((const unsigned*)(dsrc + (size_t)(c) * 64 * 16), (LAS unsigned*)(in_ + ((dq == 0) ? SSD_DT : SSD_CS)), 4, 0, 0); } } while (0)
        f32x16 S;
#pragma unroll
        for (int r = 0; r < 16; ++r) S[r] = 0.f;
        SSD_ISSUE(0, 0); SSD_ISSUE(1, 1);
        const int xfo = ((lane >> 4) & 1) * 32 + (lane & 3) * 8 + (4 * hi + ((lane & 15) >> 2)) * 64;
        for (int c = 0; c < SEQ / 64; ++c) {
            if (wave >= 2) { if (c + 1 >= SEQ / 64) asm volatile("s_waitcnt vmcnt(0)" ::: "memory"); else if (dq < 2) asm volatile("s_waitcnt vmcnt(11)" ::: "memory"); else asm volatile("s_waitcnt vmcnt(10)" ::: "memory"); }
            asm volatile("s_waitcnt lgkmcnt(0)" ::: "memory");
            {
                const unsigned sa = (unsigned)(size_t)(ldsl + SSD_SYNC), tgt = (unsigned)(c + 1);
                asm volatile("ds_write_b32 %0, %1" :: "v"(sa + 32u + 4u * (unsigned)wave), "v"(tgt) : "memory");
                for (;;) { u32x4 a, b_; asm volatile("ds_read_b128 %0, %2 offset:32\n\tds_read_b128 %1, %2 offset:48\n\ts_waitcnt lgkmcnt(0)" : "=&v"(a), "=&v"(b_) : "v"(sa) : "memory");
                    const unsigned m = min(min(min(a.x, a.y), min(a.z, a.w)), min(min(b_.x, b_.y), min(b_.z, b_.w)));
                    if (__builtin_amdgcn_readfirstlane(m) >= tgt) break; __builtin_amdgcn_s_sleep(1); }
            }
            asm volatile("" ::: "memory");
            if (c + 2 < SEQ / 64) SSD_ISSUE(c + 2, (c + 2) % 3);
            const LAS unsigned char* in = ldsl + (c % 3) * SSD_IN;
            const LAS unsigned char* STin = ldsl + SSD_ST + (c & 1) * 8192;
            LAS unsigned char* STout = ldsl + SSD_ST + ((c + 1) & 1) * 8192;
            const LAS float* dtl = (const LAS float*)(in + SSD_DT); const LAS float* csl = (const LAS float*)(in + SSD_CS);
            if (wave < 2) {
                const int lb = wave, l = 32 * lb + r32;
                const unsigned xpa = (unsigned)(size_t)(in + SSD_XS + xfo + (32 * lb) * 64);
                s16x4 lo0, hh0, lo1, hh1; TR_PAIR(lo0, hh0, xpa, 0, 512); TR_PAIR(lo1, hh1, xpa, 1024, 512);
                const int l1 = 32 + r32;
                const float cs_l = csl[l], cs_l1 = csl[l1];
                bf16x8 cf[8], bdf[8], cf1[8]; f32x4 c4[4], d4[4];
#pragma unroll
                for (int ks = 0; ks < 8; ++ks) {
                    cf[ks] = *(const LAS bf16x8*)(in + SSD_CM + l * 256 + (((2 * ks + hi) ^ (l & 15)) << 4));
                    bdf[ks] = *(const LAS bf16x8*)(in + SSD_BM + l * 256 + (((2 * ks + hi) ^ (l & 15)) << 4));
                    if (wave == 0) cf1[ks] = *(const LAS bf16x8*)(in + SSD_CM + l1 * 256 + (((2 * ks + hi) ^ (l1 & 15)) << 4));
                }
                LDS_WAIT_PIN();
#pragma unroll
                for (int q = 0; q < 4; ++q) { c4[q] = *(const LAS f32x4*)(csl + 32 * lb + 8 * q + 4 * hi); d4[q] = *(const LAS f32x4*)(dtl + 32 * lb + 8 * q + 4 * hi); }
                const bf16x8 xf0 = (bf16x8){lo0[0], lo0[1], lo0[2], lo0[3], hh0[0], hh0[1], hh0[2], hh0[3]}, xf1 = (bf16x8){lo1[0], lo1[1], lo1[2], lo1[3], hh1[0], hh1[1], hh1[2], hh1[3]};
                if (wave == 0) {
                    f32x16 ca, cb;
#pragma unroll
                    for (int r = 0; r < 16; ++r) { ca[r] = 0.f; cb[r] = 0.f; }
#pragma unroll
                    for (int ks = 0; ks < 8; ks += 2) { ca = __builtin_amdgcn_mfma_f32_32x32x16_bf16(bdf[ks], cf1[ks], ca, 0, 0, 0); cb = __builtin_amdgcn_mfma_f32_32x32x16_bf16(bdf[ks + 1], cf1[ks + 1], cb, 0, 0, 0); }
                    ca += cb;
                    ssd_decay_block(ca, c4, d4, cs_l1, 0, l1, hi, false);
                    u32x4 w0, w1;
                    w0.x = cvtpk(ca[0], ca[1]); w0.y = cvtpk(ca[2], ca[3]); w0.z = cvtpk(ca[4], ca[5]); w0.w = cvtpk(ca[6], ca[7]);
                    w1.x = cvtpk(ca[8], ca[9]); w1.y = cvtpk(ca[10], ca[11]); w1.z = cvtpk(ca[12], ca[13]); w1.w = cvtpk(ca[14], ca[15]);
                    f32x16 pa;
#pragma unroll
                    for (int r = 0; r < 16; ++r) pa[r] = 0.f;
                    pa = __builtin_amdgcn_mfma_f32_32x32x16_bf16(xf0, __builtin_bit_cast(bf16x8, w0), pa, 0, 0, 0);
                    pa = __builtin_amdgcn_mfma_f32_32x32x16_bf16(xf1, __builtin_bit_cast(bf16x8, w1), pa, 0, 0, 0);
                    LAS unsigned char* pp = ldsl + SSD_PART + lane * 64;
#pragma unroll
                    for (int q = 0; q < 4; ++q) *(LAS f32x4*)(pp + q * 16) = (f32x4){pa[4 * q], pa[4 * q + 1], pa[4 * q + 2], pa[4 * q + 3]};
                    asm volatile("s_waitcnt lgkmcnt(0)" ::: "memory");
                    asm volatile("ds_write_b32 %0, %1" :: "v"((unsigned)(size_t)(ldsl + SSD_SYNC) + 4u), "v"((unsigned)(c + 1)) : "memory");
                }
                f32x16 acc;
                {
                    f32x16 ca, cb;
#pragma unroll
                    for (int r = 0; r < 16; ++r) { ca[r] = 0.f; cb[r] = 0.f; acc[r] = 0.f; }
#pragma unroll
                    for (int ks = 0; ks < 8; ks += 2) { ca = __builtin_amdgcn_mfma_f32_32x32x16_bf16(bdf[ks], cf[ks], ca, 0, 0, 0); cb = __builtin_amdgcn_mfma_f32_32x32x16_bf16(bdf[ks + 1], cf[ks + 1], cb, 0, 0, 0); }
                    ca += cb;
                    ssd_decay_block(ca, c4, d4, cs_l, lb, l, hi, true);
                    u32x4 w0, w1;
                    w0.x = cvtpk(ca[0], ca[1]); w0.y = cvtpk(ca[2], ca[3]); w0.z = cvtpk(ca[4], ca[5]); w0.w = cvtpk(ca[6], ca[7]);
                    w1.x = cvtpk(ca[8], ca[9]); w1.y = cvtpk(ca[10], ca[11]); w1.z = cvtpk(ca[12], ca[13]); w1.w = cvtpk(ca[14], ca[15]);
                    acc = __builtin_amdgcn_mfma_f32_32x32x16_bf16(xf0, __builtin_bit_cast(bf16x8, w0), acc, 0, 0, 0);
                    acc = __builtin_amdgcn_mfma_f32_32x32x16_bf16(xf1, __builtin_bit_cast(bf16x8, w1), acc, 0, 0, 0);
                }
                {
                    f32x16 ya, yb;
#pragma unroll
                    for (int r = 0; r < 16; ++r) { ya[r] = 0.f; yb[r] = 0.f; }
#pragma unroll
                    for (int ks = 0; ks < 8; ks += 2) { ya = __builtin_amdgcn_mfma_f32_32x32x16_bf16(*(const LAS bf16x8*)(STin + (2 * ks + hi) * 512 + r32 * 16), cf[ks], ya, 0, 0, 0); yb = __builtin_amdgcn_mfma_f32_32x32x16_bf16(*(const LAS bf16x8*)(STin + (2 * ks + 2 + hi) * 512 + r32 * 16), cf[ks + 1], yb, 0, 0, 0); }
                    const float ecs = __expf(cs_l);
#pragma unroll
                    for (int r = 0; r < 16; ++r) acc[r] += (ya[r] + yb[r]) * ecs;
                }
                if (wave == 1) {
                    for (;;) { unsigned fl; asm volatile("ds_read_b32 %0, %1 offset:4\n\ts_waitcnt lgkmcnt(0)" : "=&v"(fl) : "v"((unsigned)(size_t)(ldsl + SSD_SYNC)) : "memory");
                        if (__builtin_amdgcn_readfirstlane(fl) >= (unsigned)(c + 1)) break; __builtin_amdgcn_s_sleep(1); }
                    asm volatile("" ::: "memory");
                    const LAS unsigned char* pp = ldsl + SSD_PART + lane * 64;
#pragma unroll
                    for (int q = 0; q < 4; ++q) { const f32x4 v = *(const LAS f32x4*)(pp + q * 16); acc[4 * q] += v[0]; acc[4 * q + 1] += v[1]; acc[4 * q + 2] += v[2]; acc[4 * q + 3] += v[3]; }
                }
                bf16_t* yo = (bf16_t*)(p.ws + WS_MIXRAW) + (tb0 + (size_t)c * 64 + l) * DM + 1024 + h * 64 + ph * 32 + 4 * hi;
                float yss = 0.f;
#pragma unroll
                for (int q = 0; q < 4; ++q) {
                    const u32x2 xw = *(const LAS u32x2*)(in + SSD_XS + l * 64 + (8 * q + 4 * hi) * 2), zw = *(const LAS u32x2*)(in + SSD_Z + l * 64 + (8 * q + 4 * hi) * 2);
                    const float y0 = (acc[4 * q + 0] + dsk * bflo(xw.x)) * silu_fast(bflo(zw.x)), y1 = (acc[4 * q + 1] + dsk * bfhi(xw.x)) * silu_fast(bfhi(zw.x));
                    const float y2 = (acc[4 * q + 2] + dsk * bflo(xw.y)) * silu_fast(bflo(zw.y)), y3 = (acc[4 * q + 3] + dsk * bfhi(xw.y)) * silu_fast(bfhi(zw.y));
                    yss += (y0 * y0 + y1 * y1) + (y2 * y2 + y3 * y3);
                    u32x2 o; o.x = pk2(y0, y1); o.y = pk2(y2, y3);
                    *(u32x2*)(yo + 8 * q) = o;
                }
                yss += __shfl_xor(yss, 32);
                if (hi == 0) ((float*)(p.ws + WS_PSQS))[(tb0 + (size_t)c * 64 + l) * 32 + h * 2 + ph] = yss;
            } else {
                const int nb = wave - 2;
                const float cs63 = csl[63];
                { const float dec = __expf(cs63);
#pragma unroll
                  for (int r = 0; r < 16; ++r) S[r] *= dec; }
                const int brow = 4 * hi + ((lane & 15) >> 2), bch = 4 * nb + 2 * ((lane >> 4) & 1) + ((lane & 3) >> 1);
                const unsigned xpa = (unsigned)(size_t)(in + xfo);
                const unsigned bpa = (unsigned)(size_t)(in + SSD_BM + brow * 256 + ((bch ^ brow) << 4) + (lane & 1) * 8);
                const unsigned bpb = (unsigned)(size_t)(in + SSD_BM + (brow + 8) * 256 + ((bch ^ (brow + 8)) << 4) + (lane & 1) * 8);
                s16x4 lo[4], hh[4], blo[4], bhh[4]; f32x4 c0[4], c1[4], d0[4], d1[4];
                TR_PAIR(lo[0], hh[0], xpa, SSD_XS + 0 * 1024, 512); TR_PAIR(lo[1], hh[1], xpa, SSD_XS + 1 * 1024, 512); TR_PAIR(lo[2], hh[2], xpa, SSD_XS + 2 * 1024, 512); TR_PAIR(lo[3], hh[3], xpa, SSD_XS + 3 * 1024, 512);
                asm volatile("ds_read_b64_tr_b16 %0, %1 offset:%c2" : "=&v"(blo[0]) : "v"(bpa), "i"(0 * 4096) : "memory"); asm volatile("ds_read_b64_tr_b16 %0, %1 offset:%c2" : "=&v"(bhh[0]) : "v"(bpb), "i"(0 * 4096) : "memory");
                asm volatile("ds_read_b64_tr_b16 %0, %1 offset:%c2" : "=&v"(blo[1]) : "v"(bpa), "i"(1 * 4096) : "memory"); asm volatile("ds_read_b64_tr_b16 %0, %1 offset:%c2" : "=&v"(bhh[1]) : "v"(bpb), "i"(1 * 4096) : "memory");
                asm volatile("ds_read_b64_tr_b16 %0, %1 offset:%c2" : "=&v"(blo[2]) : "v"(bpa), "i"(2 * 4096) : "memory"); asm volatile("ds_read_b64_tr_b16 %0, %1 offset:%c2" : "=&v"(bhh[2]) : "v"(bpb), "i"(2 * 4096) : "memory");
                asm volatile("ds_read_b64_tr_b16 %0, %1 offset:%c2" : "=&v"(blo[3]) : "v"(bpa), "i"(3 * 4096) : "memory"); asm volatile("ds_read_b64_tr_b16 %0, %1 offset:%c2" : "=&v"(bhh[3]) : "v"(bpb), "i"(3 * 4096) : "memory");
#pragma unroll
                for (int ks = 0; ks < 4; ++ks) { c0[ks] = *(const LAS f32x4*)(csl + 16 * ks + 4 * hi); c1[ks] = *(const LAS f32x4*)(csl + 16 * ks + 8 + 4 * hi);
                                                 d0[ks] = *(const LAS f32x4*)(dtl + 16 * ks + 4 * hi); d1[ks] = *(const LAS f32x4*)(dtl + 16 * ks + 8 + 4 * hi); }
                LDS_WAIT_PIN();
                u32x4 aw[4];
#pragma unroll
                for (int ks = 0; ks < 4; ++ks) {
                    float xf[8];
#pragma unroll
                    for (int j = 0; j < 4; ++j) { xf[j] = bf2f((unsigned short)lo[ks][j]) * __expf(cs63 - c0[ks][j]) * d0[ks][j]; xf[4 + j] = bf2f((unsigned short)hh[ks][j]) * __expf(cs63 - c1[ks][j]) * d1[ks][j]; }
                    aw[ks].x = cvtpk(xf[0], xf[1]); aw[ks].y = cvtpk(xf[2], xf[3]); aw[ks].z = cvtpk(xf[4], xf[5]); aw[ks].w = cvtpk(xf[6], xf[7]);
                }
#pragma unroll
                for (int ks = 0; ks < 4; ++ks)
                    S = __builtin_amdgcn_mfma_f32_32x32x16_bf16(__builtin_bit_cast(bf16x8, aw[ks]), (bf16x8){blo[ks][0], blo[ks][1], blo[ks][2], blo[ks][3], bhh[ks][0], bhh[ks][1], bhh[ks][2], bhh[ks][3]}, S, 0, 0, 0);
                const int n = 32 * nb + r32;
#pragma unroll
                for (int r = 0; r < 16; ++r) *(LAS unsigned short*)(STout + (n >> 3) * 512 + crow(r, hi) * 16 + (n & 7) * 2) = (unsigned short)f2bf(S[r]);
            }
        }
#undef SSD_ISSUE
#undef SSD_G16
    }
    asm volatile("s_waitcnt vmcnt(0) lgkmcnt(0)" ::: "memory");
    __builtin_amdgcn_s_barrier(); asm volatile("" ::: "memory");
}
__device__ __forceinline__ void ph_peer4(const Params& p, LAS unsigned char* ldsl, int wave, int lane, int gwave, int gnw) {
    LAS unsigned char* ring = ldsl + wave * 16384;
    const unsigned char* U = (const unsigned char*)(p.ws + WS_U4); const unsigned char* V = (const unsigned char*)(p.ws + WS_V4);
    const int e_lane = (lane >> 2) & 15; const unsigned lane16 = (unsigned)lane * 16u, lanesc = 1024u + (unsigned)(lane >> 1) * 4u;
#define P4_ISSUE(R) do { const int R_ = (R); const int i_ = ((R_ >> 5) << 4) + (R_ & 15); \
        const int e_ = (i_ < 64) ? __builtin_amdgcn_readlane(idx0, i_) : __builtin_amdgcn_readlane(idx1, i_ - 64); \
        const unsigned char* base_ = (((R_ >> 4) & 1) ? V : U) + (size_t)(unsigned)e_ * P4_ROW; \
        LAS unsigned char* dst_ = ring + (R_ & 7) * 1280; \
        __builtin_amdgcn_global_load_lds((const unsigned*)(base_ + lane16), (LAS unsigned*)(dst_), 16, 0, 0); \
        __builtin_amdgcn_global_load_lds((const unsigned*)(base_ + lanesc), (LAS unsigned*)(dst_ + 1024), 4, 0, 0); } while (0)
#define P4_WAIT(n) asm volatile("s_waitcnt vmcnt(" #n ")" ::: "memory")
#define P4_CVT(wd, bs) __builtin_amdgcn_cvt_scalef32_pk_f32_fp4((wd), 1.0f, (bs))
    for (int t = gwave; t < T; t += gnw) {
        const int b = t / SEQ;
        const int idx0 = ((const int*)(p.ws + WS_IDX))[(size_t)t * 128 + lane], idx1 = ((const int*)(p.ws + WS_IDX))[(size_t)t * 128 + 64 + lane];
        float gv0 = ((const float*)(p.ws + WS_GATE))[(size_t)t * 128 + lane], gv1 = ((const float*)(p.ws + WS_GATE))[(size_t)t * 128 + 64 + lane];
        f32x2_t hf[16];
        {
            const float pq = (lane < 32) ? ((const float*)(p.ws + WS_PSQX))[(size_t)t * 32 + lane] : 0.f;
            const float r2 = rsqrtf(wave_sum(pq) * (1.f / DM) + EPS);
            const bf16_t* hp = (const bf16_t*)(p.ws + WS_X1M) + (size_t)t * DM + lane * 4;
            const float* shp = (const float*)(p.ws + WS_MOD) + (size_t)b * 6 * DM + 3 * DM + lane * 4;
#pragma unroll
            for (int j = 0; j < 8; ++j) { const u32x2 a = *(const u32x2*)(hp + j * 256); const f32x4 sh = *(const f32x4*)(shp + j * 256);
                hf[2 * j] = (f32x2_t){bflo(a.x) * r2 + sh[0], bfhi(a.x) * r2 + sh[1]}; hf[2 * j + 1] = (f32x2_t){bflo(a.y) * r2 + sh[2], bfhi(a.y) * r2 + sh[3]}; }
        }
        f32x2_t out[16];
#pragma unroll
        for (int i = 0; i < 16; ++i) out[i] = (f32x2_t){0.f, 0.f};
        asm volatile("" : "+v"(gv0), "+v"(gv1));
        P4_ISSUE(0); P4_ISSUE(1); P4_ISSUE(2); P4_ISSUE(3); P4_ISSUE(4); P4_ISSUE(5); P4_ISSUE(6);
        for (int hh = 0; hh < 8; ++hh) {
            float pd[16];
#pragma unroll
            for (int k = 0; k < 16; ++k) {
                P4_ISSUE(hh * 32 + k + 7); P4_WAIT(14);
                const LAS unsigned char* sl = ring + (k & 7) * 1280;
                const u32x4 w = *(const LAS u32x4*)(sl + lane * 16);
                const unsigned sw = *(const LAS unsigned*)(sl + 1024 + lane * 4);
                const float scl = (lane & 1) ? bfhi(sw) : bflo(sw);
                f32x2_t a2 = (f32x2_t){0.f, 0.f};
                a2 += P4_CVT(w.x, 0) * hf[0]; a2 += P4_CVT(w.x, 1) * hf[1]; a2 += P4_CVT(w.x, 2) * hf[2]; a2 += P4_CVT(w.x, 3) * hf[3];
                a2 += P4_CVT(w.y, 0) * hf[4]; a2 += P4_CVT(w.y, 1) * hf[5]; a2 += P4_CVT(w.y, 2) * hf[6]; a2 += P4_CVT(w.y, 3) * hf[7];
                a2 += P4_CVT(w.z, 0) * hf[8]; a2 += P4_CVT(w.z, 1) * hf[9]; a2 += P4_CVT(w.z, 2) * hf[10]; a2 += P4_CVT(w.z, 3) * hf[11];
                a2 += P4_CVT(w.w, 0) * hf[12]; a2 += P4_CVT(w.w, 1) * hf[13]; a2 += P4_CVT(w.w, 2) * hf[14]; a2 += P4_CVT(w.w, 3) * hf[15];
                float a = (a2.x + a2.y) * scl;
                asm volatile("" : "+v"(a));
                pd[k] = a;
            }
            float q8[8], q4[4], q2[2], q1;
            { const bool hi = (lane & 32) != 0;
#pragma unroll
              for (int i = 0; i < 8; ++i) { const float keep = hi ? pd[i + 8] : pd[i], send = hi ? pd[i] : pd[i + 8]; q8[i] = keep + __shfl_xor(send, 32); } }
            { const bool hi = (lane & 16) != 0;
#pragma unroll
              for (int i = 0; i < 4; ++i) { const float keep = hi ? q8[i + 4] : q8[i], send = hi ? q8[i] : q8[i + 4]; q4[i] = keep + __shfl_xor(send, 16); } }
            { const bool hi = (lane & 8) != 0;
#pragma unroll
              for (int i = 0; i < 2; ++i) { const float keep = hi ? q4[i + 2] : q4[i], send = hi ? q4[i] : q4[i + 2]; q2[i] = keep + __shfl_xor(send, 8); } }
            { const bool hi = (lane & 4) != 0; const float keep = hi ? q2[1] : q2[0], send = hi ? q2[0] : q2[1]; q1 = keep + __shfl_xor(send, 4); }
            q1 += __shfl_xor(q1, 1); q1 += __shfl_xor(q1, 2);
            const float act = 0.5f * q1 * (1.f + erff(q1 * 0.70710678118654752f)) * __shfl((hh < 4) ? gv0 : gv1, (hh & 3) * 16 + e_lane);
#pragma unroll
            for (int k = 0; k < 16; ++k) {
                if (k < 9) { P4_ISSUE(hh * 32 + 16 + k + 7); P4_WAIT(14); }
                else if (hh < 7) { P4_ISSUE(hh * 32 + 16 + k + 7); P4_WAIT(14); }
                else if (k == 9) P4_WAIT(12); else if (k == 10) P4_WAIT(10); else if (k == 11) P4_WAIT(8); else if (k == 12) P4_WAIT(6); else if (k == 13) P4_WAIT(4); else if (k == 14) P4_WAIT(2); else P4_WAIT(0);
                const LAS unsigned char* sl = ring + (k & 7) * 1280;
                const u32x4 w = *(const LAS u32x4*)(sl + lane * 16);
                const unsigned sw = *(const LAS unsigned*)(sl + 1024 + lane * 4);
                const float a = __builtin_bit_cast(float, __builtin_amdgcn_readlane(__builtin_bit_cast(int, act), 4 * k)) * ((lane & 1) ? bfhi(sw) : bflo(sw));
                const f32x2_t aa = (f32x2_t){a, a};
                out[0] += aa * P4_CVT(w.x, 0); out[1] += aa * P4_CVT(w.x, 1); out[2] += aa * P4_CVT(w.x, 2); out[3] += aa * P4_CVT(w.x, 3);
                out[4] += aa * P4_CVT(w.y, 0); out[5] += aa * P4_CVT(w.y, 1); out[6] += aa * P4_CVT(w.y, 2); out[7] += aa * P4_CVT(w.y, 3);
                asm volatile("" : "+v"(out[0]), "+v"(out[1]), "+v"(out[2]), "+v"(out[3]), "+v"(out[4]), "+v"(out[5]), "+v"(out[6]), "+v"(out[7]));
                out[8] += aa * P4_CVT(w.z, 0); out[9] += aa * P4_CVT(w.z, 1); out[10] += aa * P4_CVT(w.z, 2); out[11] += aa * P4_CVT(w.z, 3);
                out[12] += aa * P4_CVT(w.w, 0); out[13] += aa * P4_CVT(w.w, 1); out[14] += aa * P4_CVT(w.w, 2); out[15] += aa * P4_CVT(w.w, 3);
                asm volatile("" : "+v"(out[8]), "+v"(out[9]), "+v"(out[10]), "+v"(out[11]), "+v"(out[12]), "+v"(out[13]), "+v"(out[14]), "+v"(out[15]));
            }
        }
        const float* g2 = (const float*)(p.ws + WS_MOD) + (size_t)b * 6 * DM + 5 * DM; const float* s2 = (const float*)(p.ws + WS_MOD) + (size_t)b * 6 * DM + 4 * DM;
        const bf16_t* xmp = (const bf16_t*)(p.ws + WS_X1M) + (size_t)t * DM;
        float* outp = p.out + (size_t)t * DM;
#pragma unroll
        for (int j = 0; j < 8; ++j) {
            const int c = j * 256 + lane * 4;
            const u32x2 xm = *(const u32x2*)(xmp + c); const f32x4 ga = *(const f32x4*)(g2 + c), sc = *(const f32x4*)(s2 + c);
            *(f32x4*)(outp + c) = (f32x4){bflo(xm.x) / (1.f + sc.x) + ga.x * out[2 * j].x, bfhi(xm.x) / (1.f + sc.y) + ga.y * out[2 * j].y,
                                          bflo(xm.y) / (1.f + sc.z) + ga.z * out[2 * j + 1].x, bfhi(xm.y) / (1.f + sc.w) + ga.w * out[2 * j + 1].y};
        }
    }
#undef P4_ISSUE
#undef P4_WAIT
#undef P4_CVT
}
constexpr int RING_BYTES = 131072, LDSCTL_OFF = 146432, MISC_OFF = LDSCTL_OFF + 320, LDS_BYTES = 147456;
static_assert(SSD_SYNC + 64 <= LDSCTL_OFF, "SSD LDS map");
constexpr int NPH = 13;
#ifndef MK_PER_PHASE
#define MK_PER_PHASE 0
#endif

__global__ void __launch_bounds__(NTHR, 2) mega(Params p) {
    extern __shared__ __attribute__((aligned(16))) unsigned char lds[];
    LAS unsigned char* ldsl = (LAS unsigned char*)lds;
    const int tid = threadIdx.x, lane = tid & 63, wave = __builtin_amdgcn_readfirstlane(tid >> 6);
    const int G = gridDim.x, bid = blockIdx.x;
    unsigned char* ws = p.ws;
    gu32* ctl = (gu32*)(ws + WS_CTL);
    for (int u = tid; u < (LDS_BYTES - LDSCTL_OFF) / 4; u += NTHR) ((LAS unsigned*)(ldsl + LDSCTL_OFF))[u] = 0u;
    __syncthreads();
    volatile LAS unsigned* MISC = (volatile LAS unsigned*)(ldsl + MISC_OFF);
    XcdBarrier bar; bar.bar = (unsigned*)(ctl + CW_BAR); bar.x = 0; bar.st = nullptr;
    if (!MK_PER_PHASE) bar = xcd_barrier_post((unsigned*)(ctl + CW_BAR), MISC + 8);
#define IN(k) (p.ph_lo <= (k) && (k) < p.ph_hi)
#define LN() ({ int l_ = lane; asm volatile("" : "+v"(l_)); l_; })
#define WV() ({ int w_ = wave; asm volatile("" : "+s"(w_)); w_; })
#define SEAM(k) do { if ((k) + 1 < p.ph_hi) xcd_barrier(bar); } while (0)
    const int gtid = bid * NTHR + tid, gn = G * NTHR, gwave = bid * NWAVES + wave, gnw = G * NWAVES;
    float* mod = (float*)(ws + WS_MOD);

    if (IN(0)) {
        if (bid < 96) ph_mod(p, lds, tid, bid);
        else ph_transposes(p, lds, WV(), LN(), (bid - 96) * NWAVES + wave, (G - 96) * NWAVES);
        ph_rope_tab(p, gtid, gn);
        ph_convert(p.sub_keys, (bf16_t*)(ws + WS_SUBK), (size_t)8 * 2 * 128 * 128 / 4, gtid, gn);
        SEAM(0);
    }
    if (IN(1)) { ph_modrows(p.x, (bf16_t*)(ws + WS_H), mod, 0, 1, gwave, gnw, LN()); ph_bias2(p, gwave, gnw, LN()); SEAM(1); }
    if (IN(2)) {
        pg8::Gemm g{(const bf16_t*)(ws + WS_H), (const bf16_t*)(ws + WS_WINT), T, NPROJ, DM, DM}; pg8::StaticOrder S; S.init(T, NPROJ, G, bid);
        pg8::EpiBf16<0> E{(bf16_t*)(ws + WS_PROJ), NPROJ, nullptr, 0, 0, 1.f};
        pg8::gemm_phase<pg8::EpiBf16<0>, pg8::StaticOrder, true, true>(ldsl, g, S, E);
        SEAM(2);
    }
    if (IN(3)) {
        { pg8::Gemm g{(const bf16_t*)(ws + WS_PROJ) + C_CQ, (const bf16_t*)(ws + WS_WUQT), T, NQ, 512, NPROJ}; pg8::StaticOrder S; S.init(T, NQ, G, bid);
          pg8::EpiBf16<0> E{(bf16_t*)(ws + WS_QRAW), NQ, nullptr, 0, 0, 1.f};
          pg8::gemm_phase<pg8::EpiBf16<0>, pg8::StaticOrder, true, true>(ldsl, g, S, E); }
        { pg8::Gemm g{(const bf16_t*)(ws + WS_PROJ) + C_CKV, (const bf16_t*)(ws + WS_WUKVT), T, NKV, 256, NPROJ}; pg8::StaticOrder S; S.init(T, NKV, G, bid);
          pg8::EpiBf16<0> E{(bf16_t*)(ws + WS_KVRAW), NKV, nullptr, 0, 0, 1.f};
          pg8::gemm_phase<pg8::EpiBf16<0>, pg8::StaticOrder, true, true>(ldsl, g, S, E); }
        SEAM(3);
    }
    if (IN(4)) { ph_qkv_post(p, gwave, gnw, LN()); ph_conv(p, gwave, gnw, LN()); SEAM(4); }
    if (IN(5)) { ph_attn(p, ldsl, bid, G, WV(), LN()); ph_ssd(p, ldsl, bid, WV(), LN()); SEAM(5); }
    if (IN(8)) {
        pg8::Gemm g{(const bf16_t*)(ws + WS_MIXRAW), (const bf16_t*)(ws + WS_WOUTT), T, DM, DM, DM}; pg8::StaticOrder S; S.init(T, DM, G, bid);
        pg8::Unit u0, u1; S.next(0, u0); if (!S.next(1, u1)) u1 = u0;
        LAS float* kt = (LAS float*)(ldsl + RING_BYTES);
        { const int slot = tid >> 8, r = tid & 255, row = (slot ? u1.pm : u0.pm) * 256 + r;
          const f32x4* pa = (const f32x4*)((const float*)(ws + WS_PSQA) + (size_t)row * 8); const f32x4* ps = (const f32x4*)((const float*)(ws + WS_PSQS) + (size_t)row * 32);
          const f32x4 a0 = pa[0], a1 = pa[1]; float sa = ((a0[0] + a0[1]) + (a0[2] + a0[3])) + ((a1[0] + a1[1]) + (a1[2] + a1[3])), s0 = 0.f, s1 = 0.f;
#pragma unroll
          for (int q = 0; q < 4; ++q) { const f32x4 v = ps[q], w = ps[4 + q]; s0 += (v[0] + v[1]) + (v[2] + v[3]); s1 += (w[0] + w[1]) + (w[2] + w[3]); }
          const float ra = rsqrtf(sa * (1.f / 1024.f) + EPS), r0 = rsqrtf(s0 * (1.f / 512.f) + EPS), r1 = rsqrtf(s1 * (1.f / 512.f) + EPS);
          kt[tid * 4 + 0] = ra / r0; kt[tid * 4 + 1] = r0 / r1; kt[tid * 4 + 2] = r1; kt[tid * 4 + 3] = 0.f; }
        __syncthreads();
        pg8::EpiX1 E{p.x, mod, (bf16_t*)(ws + WS_X1M), (float*)(ws + WS_PSQX), DM, SEQ, kt, u0.pm};
        pg8::gemm_phase<pg8::EpiX1, pg8::StaticOrder, true, true>(ldsl, g, S, E);
        SEAM(8);
    }
    if (IN(10)) {
        pg8::Gemm g{(const bf16_t*)(ws + WS_X1M), (const bf16_t*)(ws + WS_WQT), T, DM, DM, DM}; pg8::StaticOrder S; S.init(T, DM, G, bid);
        pg8::Unit u0, u1; S.next(0, u0); if (!S.next(1, u1)) u1 = u0;
        LAS float* rt = (LAS float*)(ldsl + RING_BYTES);
        { const int slot = tid >> 8, r = tid & 255, row = (slot ? u1.pm : u0.pm) * 256 + r; const f32x4* pq = (const f32x4*)((const float*)(ws + WS_PSQX) + (size_t)row * 32); float s_ = 0.f;
#pragma unroll
          for (int q = 0; q < 8; ++q) { const f32x4 v = pq[q]; s_ += (v[0] + v[1]) + (v[2] + v[3]); }
          rt[tid] = rsqrtf(s_ * (1.f / DM) + EPS); }
        __syncthreads();
        pg8::EpiScaleBias E{(bf16_t*)(ws + WS_QP), DM, (const float*)(ws + WS_BIAS2), SEQ, rt, u0.pm};
        pg8::gemm_phase<pg8::EpiScaleBias, pg8::StaticOrder, true, true>(ldsl, g, S, E);
        SEAM(10);
    }
    if (IN(11)) { ph_route(p, ldsl, WV(), LN(), gwave, gnw); SEAM(11); }
    if (IN(12)) { ph_peer4(p, ldsl, WV(), LN(), gwave, gnw); }
#undef IN
#undef SEAM
}

extern "C" void kernel_launch(void* const* d_in, const int* in_sizes, int n_in, void* d_out, int out_size, void* d_ws, size_t ws_size, hipStream_t stream) {
    static int grid = 0;
    if (grid == 0) {
        if (n_in != 24 || ws_size < WS_END) { fprintf(stderr, "kernel_launch: unexpected inputs / workspace (%d, %zu)\n", n_in, ws_size); grid = -1; return; }
        if (hipFuncSetAttribute((const void*)mega, hipFuncAttributeMaxDynamicSharedMemorySize, LDS_BYTES) != hipSuccess) { fprintf(stderr, "kernel_launch: hipFuncSetAttribute failed\n"); grid = -1; return; }
        (void)hipGetLastError();
        grid = 256;
    }
    if (grid < 0) return;
    (void)hipMemsetAsync((char*)d_ws + WS_CTL, 0, CTL_ZERO_BYTES, stream);
    Params p{};
    p.x = (const float*)d_in[0]; p.c = (const float*)d_in[1]; p.pos = (const int*)d_in[2]; p.w_ada = (const float*)d_in[3]; p.b_ada = (const float*)d_in[4];
    p.w_in = (const float*)d_in[5]; p.q_a_norm = (const float*)d_in[6]; p.w_uq = (const float*)d_in[7]; p.kv_a_norm = (const float*)d_in[8]; p.w_ukv = (const float*)d_in[9];
    p.q_norm = (const float*)d_in[10]; p.k_norm = (const float*)d_in[11]; p.attn_out_norm = (const float*)d_in[12]; p.conv_w = (const float*)d_in[13]; p.conv_b = (const float*)d_in[14];
    p.dt_bias = (const float*)d_in[15]; p.a_log = (const float*)d_in[16]; p.d_skip = (const float*)d_in[17]; p.ssd_norm = (const float*)d_in[18]; p.w_out = (const float*)d_in[19];
    p.w_query = (const float*)d_in[20]; p.sub_keys = (const float*)d_in[21]; p.u_exp = (const float*)d_in[22]; p.v_exp = (const float*)d_in[23];
    p.out = (float*)d_out; p.ws = (unsigned char*)d_ws;
#if MK_PER_PHASE
    for (int ph = 0; ph < NPH; ++ph) { p.ph_lo = ph; p.ph_hi = ph + 1; hipLaunchKernelGGL(mega, dim3(grid), dim3(NTHR), LDS_BYTES, stream, p); }
#elif defined(PROBE_SEQ)
    { const int seq[] = {PROBE_SEQ}; const int nl = (int)(sizeof(seq) / sizeof(int)) / 2;
      for (int li = 0; li < nl; ++li) { if (li) (void)hipMemsetAsync((char*)d_ws + WS_CTL, 0, CTL_ZERO_BYTES, stream);
          p.ph_lo = seq[2 * li]; p.ph_hi = seq[2 * li + 1]; hipLaunchKernelGGL(mega, dim3(grid), dim3(NTHR), LDS_BYTES, stream, p); } }
#else
    p.ph_lo = 0; p.ph_hi = NPH;
    hipLaunchKernelGGL(mega, dim3(grid), dim3(NTHR), LDS_BYTES, stream, p);
#endif
}
```

```cpp
#include <hip/hip_runtime.h>
#include <cstdint>
#include <cstdio>
#include <cmath>

constexpr int DM = 2048, NB = 8, SEQ = 2048, T = NB * SEQ;
constexpr int IN_COLS = 3408, NPROJ = 3584;
constexpr int C_CQ = 0, C_CKV = 512, C_KR = 768, C_Z = 832, C_XBC = 1856, C_DT = 3392;
constexpr int NQ = 1536, NKV = 2048;
constexpr float EPS = 1e-6f;
constexpr int NTHR = 512, NWAVES = 8;

typedef unsigned short bf16_t;
typedef unsigned u32x4 __attribute__((ext_vector_type(4)));
typedef float f32x4 __attribute__((ext_vector_type(4)));
typedef unsigned u32x2 __attribute__((ext_vector_type(2)));
#define GAS __attribute__((address_space(1)))
#define LAS __attribute__((address_space(3)))
typedef GAS unsigned gu32;
typedef GAS unsigned long long gu64;
#define RLX_AGENT __ATOMIC_RELAXED, __HIP_MEMORY_SCOPE_AGENT

__device__ __forceinline__ unsigned f2bf(float f) { unsigned u = __builtin_bit_cast(unsigned, f); return (u + 0x7fffu + ((u >> 16) & 1u)) >> 16; }
__device__ __forceinline__ float bf2f(unsigned h) { return __builtin_bit_cast(float, h << 16); }
__device__ __forceinline__ unsigned pk2(float lo, float hi) { return f2bf(lo) | (f2bf(hi) << 16); }
__device__ __forceinline__ float bflo(unsigned w) { return __builtin_bit_cast(float, w << 16); }
__device__ __forceinline__ float bfhi(unsigned w) { return __builtin_bit_cast(float, w & 0xffff0000u); }
__device__ __forceinline__ float silu_f(float v) { return v / (1.f + __expf(-v)); }
__device__ __forceinline__ float wave_sum(float v) {
#pragma unroll
    for (int o = 1; o < 64; o <<= 1) v += __shfl_xor(v, o);
    return v;
}

constexpr size_t MiB = 1u << 20;
constexpr size_t WS_CTL = 0, CTL_ZERO_BYTES = 64 * 1024, WS_MOD = 1 * MiB, WS_ROPEC = 2 * MiB, WS_ROPES = 4 * MiB, WS_SUBK = 6 * MiB, WS_WUQT = 7 * MiB, WS_WUKVT = 9 * MiB,
                 WS_WINT = 10 * MiB, WS_WOUTT = 24 * MiB, WS_WQT = 32 * MiB,
                 WS_US = 40 * MiB, WS_VS = 41 * MiB, WS_PSQX = 42 * MiB, WS_BIAS2 = 44 * MiB, WS_PSQA = 45 * MiB, WS_PSQS = 46 * MiB, WS_CS = 50 * MiB, WS_DT = 51 * MiB, WS_IDX = 52 * MiB, WS_GATE = 60 * MiB, WS_U16 = 68 * MiB, WS_V16 = 132 * MiB, WS_U8 = 68 * MiB, WS_V8 = 100 * MiB, WS_MIXRAW = 372 * MiB, WS_U4 = 436 * MiB, WS_V4 = 456 * MiB,
                 WS_K = 68 * MiB, WS_YSSD = 68 * MiB, WS_XBCA = 116 * MiB, WS_ATTN = 164 * MiB,
                 WS_H = 196 * MiB, WS_Q = 196 * MiB, WS_MIXIN = 196 * MiB, WS_H2 = 196 * MiB, WS_X1M = 68 * MiB,
                 WS_PROJ = 260 * MiB, WS_QP = 260 * MiB, WS_QRAW = 372 * MiB, WS_KVRAW = 420 * MiB, WS_V = 484 * MiB, WS_END = 516 * MiB;
constexpr int CW_BAR = 1024;

struct Params {
    const float *x, *c; const int* pos;
    const float *w_ada, *b_ada, *w_in, *q_a_norm, *w_uq, *kv_a_norm, *w_ukv, *q_norm, *k_norm, *attn_out_norm, *conv_w, *conv_b, *dt_bias, *a_log,
        *d_skip, *ssd_norm, *w_out, *w_query, *sub_keys, *u_exp, *v_exp;
    float* out; unsigned char* ws;
    int ph_lo, ph_hi;
};
namespace pg8 {
#define PG8_LAS __attribute__((address_space(3)))
typedef unsigned short bf16_t;
typedef short bf16x8 __attribute__((ext_vector_type(8)));
typedef float f32x4 __attribute__((ext_vector_type(4)));
typedef unsigned u32x4 __attribute__((ext_vector_type(4)));
constexpr int BM = 256, BK = 64, HALF = 128, HTB = HALF * BK * 2  , STAGE_BYTES = 8 * HTB, NXCD = 8, WGM = 8;

__host__ __device__ __forceinline__ int lds_byte(int r, int c) { const int st = (r >> 4) * 2 + (c >> 5), rr = r & 15, cc = c & 31, ob = rr * 64 + cc * 2; return st * 1024 + (ob ^ (((ob >> 9) & 1) << 5)); }
__host__ __device__ __forceinline__ void stage_rc(int b, int& R, int& C) { const int st = b / 1024, sb = b % 1024, swz = sb ^ (((sb >> 9) & 1) << 5); R = (st >> 1) * 16 + swz / 64; C = (st & 1) * 32 + (swz % 64) / 2; }
__host__ __device__ __forceinline__ int perm32(int rho) { const int n = rho >> 4, i = rho & 15; return 8 * (i >> 2) + 4 * n + (i & 3); }

struct Unit { int pm, pn; };
struct Gemm { const bf16_t* A; const bf16_t* Bt; int M, N, K, lda; };

struct StaticOrder {
    int nM, nN, nwg, G, c;
    __host__ __device__ void init(int M, int N, int G_, int c_) { nM = M / BM; nN = N / BM; nwg = nM * nN; G = G_; c = c_; }
    __host__ __device__ bool next(int i, Unit& u) const {
        const long L = (long)i * G + c; if (L >= nwg) return false;
        int wgid = (int)L; { const int q = nwg / NXCD, r = nwg % NXCD, xcd = wgid % NXCD, off = wgid / NXCD; wgid = (xcd < r ? xcd * (q + 1) : r * (q + 1) + (xcd - r) * q) + off; }
        const int nig = WGM * nN, gid = wgid / nig, fm = gid * WGM, gsz = (nM - fm) < WGM ? (nM - fm) : WGM;
        u.pm = fm + ((wgid % nig) % gsz); u.pn = (wgid % nig) / gsz; return true;
    }
    __device__ __forceinline__ void a_ready(const Unit&) const {}
    __device__ __forceinline__ void done(const Unit&) const {}
};

__device__ __forceinline__ unsigned cvt_pk_bf16(float lo, float hi) { unsigned r; asm volatile("v_cvt_pk_bf16_f32 %0, %1, %2" : "=v"(r) : "v"(lo), "v"(hi)); return r; }
typedef float f32x2 __attribute__((ext_vector_type(2)));
__device__ __forceinline__ f32x2 gelu_pk(f32x2 v) {
    const f32x2 av = __builtin_elementwise_abs(v), d = av * 0.2316418882f + 1.0f;
    f32x2 t; t.x = __builtin_amdgcn_rcpf(d.x); t.y = __builtin_amdgcn_rcpf(d.y);
    f32x2 q = t * 0.5307027145f + (-0.7265760135f); q = q * t + 0.7107068705f; q = q * t + (-0.142248368f); q = q * t + 0.127414796f; q = q * t;
    const f32x2 s = (v * v) * (-0.72134752044f);
    f32x2 e; e.x = __builtin_amdgcn_exp2f(s.x); e.y = __builtin_amdgcn_exp2f(s.y);
    const f32x2 m = v * (q * e), r = v - m;
    f32x2 o; o.x = v.x < 0.f ? m.x : r.x; o.y = v.y < 0.f ? m.y : r.y; return o;
}

template <int ACT  > struct EpiBf16 {
    static constexpr bool PERM = true, AFTER_DRAIN = false, KSCALE = false; static_assert(ACT == 0 || ACT == 1, "EpiBf16: ACT is 0 (none) or 1 (gelu_pk)");
    bf16_t* O; int ldc; const float* bias; int split_cols; size_t split_stride; float scale0;
    __device__ __forceinline__ void operator()(const f32x4 (&acc)[2][2][4][2], const Unit& u, int wr, int wc, int fr, int fq) const {
        const int row0 = u.pm * BM + wr * 64 + fr; int colt = u.pn * BM; bf16_t* base = O;
        float sc = 1.f; if (split_cols) { const int t = colt / split_cols; base += (size_t)t * split_stride; colt -= t * split_cols; if (t == 0) sc = scale0; }
        const int col0 = colt + wc * 32 + 8 * fq, bcol0 = u.pn * BM + wc * 32 + 8 * fq;
        f32x4 bv[2][2];
#pragma unroll
        for (int bj = 0; bj < 2; ++bj)
#pragma unroll
            for (int n = 0; n < 2; ++n) bv[bj][n] = bias ? *(const f32x4*)(bias + bcol0 + bj * HALF + 4 * n) : (f32x4){0.f, 0.f, 0.f, 0.f};
#pragma unroll
        for (int ai = 0; ai < 2; ++ai)
#pragma unroll
            for (int m = 0; m < 4; ++m) { bf16_t* rowp = base + (size_t)(row0 + ai * HALF + m * 16) * ldc + col0;
#pragma unroll
                for (int bj = 0; bj < 2; ++bj) { f32x4 v0 = acc[ai][bj][m][0] + bv[bj][0], v1 = acc[ai][bj][m][1] + bv[bj][1];
                    if (ACT == 1) { f32x2 a = gelu_pk((f32x2){v0[0], v0[1]}), b = gelu_pk((f32x2){v0[2], v0[3]}), c = gelu_pk((f32x2){v1[0], v1[1]}), d = gelu_pk((f32x2){v1[2], v1[3]});
                        v0 = (f32x4){a.x, a.y, b.x, b.y}; v1 = (f32x4){c.x, c.y, d.x, d.y}; }
                    v0 = v0 * sc; v1 = v1 * sc; u32x4 w; w.x = cvt_pk_bf16(v0[0], v0[1]); w.y = cvt_pk_bf16(v0[2], v0[3]); w.z = cvt_pk_bf16(v1[0], v1[1]); w.w = cvt_pk_bf16(v1[2], v1[3]);
                    *(u32x4*)(rowp + bj * HALF) = w; } }
    }
};
struct EpiResid {
    static constexpr bool PERM = false, AFTER_DRAIN = false, KSCALE = false;
    const float* resid; float* out; const float* gate; int ldc, rows_per_batch, gate_stride;
    __device__ __forceinline__ void operator()(const f32x4 (&acc)[2][2][4][2], const Unit& u, int wr, int wc, int fr, int fq) const {
        const int col0 = u.pn * BM + wc * 32 + 4 * fq;
        const int b = (u.pm * BM) / rows_per_batch;
        f32x4 gv[2][2];
#pragma unroll
        for (int bj = 0; bj < 2; ++bj)
#pragma unroll
            for (int n = 0; n < 2; ++n) gv[bj][n] = *(const f32x4*)(gate + (size_t)b * gate_stride + col0 + bj * HALF + n * 16);
#pragma unroll
        for (int ai = 0; ai < 2; ++ai)
#pragma unroll
            for (int m = 0; m < 4; ++m) {
                const size_t off = (size_t)(u.pm * BM + ai * HALF + wr * 64 + m * 16 + fr) * ldc + col0;
#pragma unroll
                for (int bj = 0; bj < 2; ++bj)
#pragma unroll
                    for (int n = 0; n < 2; ++n) {
                        const f32x4 bs = *(const f32x4*)(resid + off + bj * HALF + n * 16);
                        *(f32x4*)(out + off + bj * HALF + n * 16) = bs + gv[bj][n] * acc[ai][bj][m][n];
                    }
                if (m & 1) asm volatile("" ::: "memory");
            }
    }
};

struct EpiX1 {
    static constexpr bool PERM = true, AFTER_DRAIN = false, KSCALE = true;
    static constexpr int KS1 = 16, KS2 = 24;
    const float* resid; const float* mod; bf16_t* xm; float* psq; int ldc, rows_per_batch; const PG8_LAS float* kt; int pm0;
    __device__ __forceinline__ void kscale(f32x4 (&acc)[2][2][4][2], const Unit& u, int t, int wr, int fr) const {
        const PG8_LAS float* tab = kt + ((u.pm == pm0) ? 0 : 1024) + ((t == KS1) ? 0 : 1);
#pragma unroll
        for (int ai = 0; ai < 2; ++ai)
#pragma unroll
            for (int m = 0; m < 4; ++m) { const float f = tab[(ai * HALF + wr * 64 + m * 16 + fr) * 4];
#pragma unroll
                for (int bj = 0; bj < 2; ++bj) { acc[ai][bj][m][0] *= f; acc[ai][bj][m][1] *= f; } }
    }
    __device__ __forceinline__ void operator()(const f32x4 (&acc)[2][2][4][2], const Unit& u, int wr, int wc, int fr, int fq) const {
        const int b = (u.pm * BM) / rows_per_batch;
        const float* g1 = mod + (size_t)b * 6 * ldc + 2 * ldc; const float* s2 = mod + (size_t)b * 6 * ldc + 4 * ldc;
        const int col0 = u.pn * BM + wc * 32 + 8 * fq;
        const PG8_LAS float* tab = kt + ((u.pm == pm0) ? 0 : 1024) + 2;
        f32x4 gv[2][2], sv[2][2];
#pragma unroll
        for (int bj = 0; bj < 2; ++bj)
#pragma unroll
            for (int n = 0; n < 2; ++n) { gv[bj][n] = *(const f32x4*)(g1 + col0 + bj * HALF + 4 * n); sv[bj][n] = *(const f32x4*)(s2 + col0 + bj * HALF + 4 * n) + 1.0f; }
#pragma unroll
        for (int ai = 0; ai < 2; ++ai)
#pragma unroll
            for (int m = 0; m < 4; ++m) {
                const int lr = ai * HALF + wr * 64 + m * 16 + fr, row = u.pm * BM + lr; const size_t off = (size_t)row * ldc + col0;
                const float rf = tab[lr * 4];
                float ss = 0.f;
#pragma unroll
                for (int bj = 0; bj < 2; ++bj) {
                    const f32x4 r0 = *(const f32x4*)(resid + off + bj * HALF), r1 = *(const f32x4*)(resid + off + bj * HALF + 4);
                    const f32x4 x0 = r0 + gv[bj][0] * (acc[ai][bj][m][0] * rf), x1 = r1 + gv[bj][1] * (acc[ai][bj][m][1] * rf);
                    ss += (x0[0] * x0[0] + x0[1] * x0[1]) + (x0[2] * x0[2] + x0[3] * x0[3]) + (x1[0] * x1[0] + x1[1] * x1[1]) + (x1[2] * x1[2] + x1[3] * x1[3]);
                    const f32x4 y0 = x0 * sv[bj][0], y1 = x1 * sv[bj][1];
                    u32x4 w; w.x = cvt_pk_bf16(y0[0], y0[1]); w.y = cvt_pk_bf16(y0[2], y0[3]); w.z = cvt_pk_bf16(y1[0], y1[1]); w.w = cvt_pk_bf16(y1[2], y1[3]);
                    *(u32x4*)(xm + off + bj * HALF) = w;
                }
                ss += __shfl_xor(ss, 16); ss += __shfl_xor(ss, 32);
                if (fq == 0) psq[(size_t)row * 32 + u.pn * 4 + wc] = ss;
                if (m & 1) asm volatile("" ::: "memory");
            }
    }
};
struct EpiScaleBias {
    static constexpr bool PERM = true, AFTER_DRAIN = false, KSCALE = false;
    bf16_t* O; int ldc; const float* bias; int rows_per_batch; const PG8_LAS float* rt; int pm0;
    __device__ __forceinline__ void operator()(const f32x4 (&acc)[2][2][4][2], const Unit& u, int wr, int wc, int fr, int fq) const {
        const int b = (u.pm * BM) / rows_per_batch; const float* bp = bias + (size_t)b * ldc;
        const int col0 = u.pn * BM + wc * 32 + 8 * fq;
        const PG8_LAS float* rtu = rt + ((u.pm == pm0) ? 0 : 256);
        f32x4 bv[2][2];
#pragma unroll
        for (int bj = 0; bj < 2; ++bj)
#pragma unroll
            for (int n = 0; n < 2; ++n) bv[bj][n] = *(const f32x4*)(bp + col0 + bj * HALF + 4 * n);
#pragma unroll
        for (int ai = 0; ai < 2; ++ai)
#pragma unroll
            for (int m = 0; m < 4; ++m) {
                const int lr = ai * HALF + wr * 64 + m * 16 + fr; const float rs = rtu[lr];
                bf16_t* rowp = O + (size_t)(u.pm * BM + lr) * ldc + col0;
#pragma unroll
                for (int bj = 0; bj < 2; ++bj) {
                    const f32x4 v0 = acc[ai][bj][m][0] * rs + bv[bj][0], v1 = acc[ai][bj][m][1] * rs + bv[bj][1];
                    u32x4 w; w.x = cvt_pk_bf16(v0[0], v0[1]); w.y = cvt_pk_bf16(v0[2], v0[3]); w.z = cvt_pk_bf16(v1[0], v1[1]); w.w = cvt_pk_bf16(v1[2], v1[3]);
                    *(u32x4*)(rowp + bj * HALF) = w;
                }
            }
    }
};
template <class Epi, class Sched, bool ALIGN_EPI = false, bool SP2 = false>
__device__ __forceinline__ void gemm_phase(PG8_LAS unsigned char* lds, const Gemm g, const Sched& S, const Epi& E) {
    const int tid = threadIdx.x, wid = __builtin_amdgcn_readfirstlane(tid >> 6), lane = tid & 63, wr = wid >> 2, wc = wid & 3, fr = lane & 15, fq = lane >> 4;
    const int K = g.K, nt = K / BK;
    unsigned voffA[2], voffB[2];
#pragma unroll
    for (int i = 0; i < 2; ++i) { int R, C; stage_rc(tid * 16 + i * 8192, R, C); const int Rb = Epi::PERM ? ((R & ~31) + perm32(R & 31)) : R;
        voffA[i] = (unsigned)(R * g.lda + C) * 2u; voffB[i] = (unsigned)(Rb * K + C) * 2u; }
    const size_t kstep = (size_t)(BK * 2);
    const size_t hstep = (size_t)HALF * K * 2;
    const size_t tstep = 2 * hstep; const size_t hstepA = (size_t)HALF * g.lda * 2, tstepA = 2 * hstepA;
    const unsigned ldsw = (unsigned)wid * 1024u;
    const int aoff = lds_byte(wr * 64 + fr, fq * 8), boff = lds_byte(wc * 32 + fr, fq * 8);
#define PG8_SA(b, h) (((b) * 2 + (h)) * HTB)
#define PG8_SB(b, h) ((4 + (b) * 2 + (h)) * HTB)
#define PG8_STAGE(bufoff, gbase, voff) do { _Pragma("unroll") for (int _i = 0; _i < 2; ++_i) \
        __builtin_amdgcn_global_load_lds((const unsigned*)((const char*)(gbase) + (voff)[_i]), (PG8_LAS unsigned*)(lds + (bufoff) + ldsw + _i * 8192), 16, 0, 0); } while (0)
#define PG8_LDA(dst, b, h) do { _Pragma("unroll") for (int m = 0; m < 4; ++m) _Pragma("unroll") for (int k = 0; k < 2; ++k) dst[m][k] = *(const PG8_LAS bf16x8*)(lds + PG8_SA(b, h) + aoff + m * 2048 + k * 1024); } while (0)
#define PG8_LDB(dst, b, h) do { _Pragma("unroll") for (int n = 0; n < 2; ++n) _Pragma("unroll") for (int k = 0; k < 2; ++k) dst[n][k] = *(const PG8_LAS bf16x8*)(lds + PG8_SB(b, h) + boff + n * 2048 + k * 1024); } while (0)
#define PG8_MMA(ai, bj, At, Bt) do { __builtin_amdgcn_s_setprio(1); _Pragma("unroll") for (int m = 0; m < 4; ++m) _Pragma("unroll") for (int n = 0; n < 2; ++n) _Pragma("unroll") for (int k = 0; k < 2; ++k) \
        acc[ai][bj][m][n] = __builtin_amdgcn_mfma_f32_16x16x32_bf16(Bt[n][k], At[m][k], acc[ai][bj][m][n], 0, 0, 0); __builtin_amdgcn_s_setprio(0); } while (0)
#define PG8_WAIT_V(n) asm volatile("s_waitcnt vmcnt(" #n ")" ::: "memory")
#define PG8_WAIT_L(n) asm volatile("s_waitcnt lgkmcnt(" #n ")" ::: "memory")
#define PG8_BAR __builtin_amdgcn_s_barrier()
#define PG8_SCHED __builtin_amdgcn_sched_barrier(0)
    Unit cur, nxt; int ui = 0;
    if (!S.next(0, cur)) return;
    f32x4 acc[2][2][4][2];
#pragma unroll
    for (int a = 0; a < 2; ++a)
#pragma unroll
        for (int b = 0; b < 2; ++b)
#pragma unroll
            for (int m = 0; m < 4; ++m)
#pragma unroll
                for (int n = 0; n < 2; ++n) acc[a][b][m][n] = (f32x4){0.f, 0.f, 0.f, 0.f};
    bf16x8 At[4][2], B0[2][2], B1[2][2];
    const char* cA = (const char*)g.A + (size_t)cur.pm * tstepA; const char* cB = (const char*)g.Bt + (size_t)cur.pn * tstep;
    S.a_ready(cur);
    if constexpr (SP2) {
        PG8_STAGE(PG8_SB(0, 0), cB, voffB); PG8_STAGE(PG8_SB(0, 1), cB + hstep, voffB); PG8_STAGE(PG8_SA(0, 0), cA, voffA); PG8_STAGE(PG8_SA(0, 1), cA + hstepA, voffA);
        if (wr == 1) PG8_BAR;
        PG8_WAIT_V(2); PG8_BAR;
        PG8_STAGE(PG8_SB(1, 0), cB + kstep, voffB); PG8_STAGE(PG8_SA(1, 0), cA + kstep, voffA); PG8_STAGE(PG8_SB(1, 1), cB + hstep + kstep, voffB);
        PG8_WAIT_V(6); PG8_BAR;
    } else {
        PG8_STAGE(PG8_SB(0, 0), cB, voffB); PG8_STAGE(PG8_SA(0, 0), cA, voffA); PG8_STAGE(PG8_SB(0, 1), cB + hstep, voffB); PG8_STAGE(PG8_SA(0, 1), cA + hstepA, voffA);
        if (wr == 1) PG8_BAR;
        PG8_WAIT_V(4); PG8_BAR;
        PG8_STAGE(PG8_SB(1, 0), cB + kstep, voffB); PG8_STAGE(PG8_SA(1, 0), cA + kstep, voffA); PG8_STAGE(PG8_SB(1, 1), cB + hstep + kstep, voffB);
        PG8_WAIT_V(6); PG8_BAR;
    }
    for (;;) {
        const bool has_next = S.next(ui + 1, nxt);
        const char* nA = has_next ? (const char*)g.A + (size_t)nxt.pm * tstepA : cA; const char* nB = has_next ? (const char*)g.Bt + (size_t)nxt.pn * tstep : cB;
        for (int t = 0; t < nt; t += 2) {
            const bool last = (t == nt - 2);
            const char* a1 = cA + (size_t)(t + 1) * kstep;
            const char* a2 = last ? nA : cA + (size_t)(t + 2) * kstep; const char* b2 = last ? nB : cB + (size_t)(t + 2) * kstep;
            const char* a3 = a2 + kstep; const char* b3 = b2 + kstep;
            if (last && has_next) S.a_ready(nxt);
            if constexpr (Epi::KSCALE) { if (t == Epi::KS1 || t == Epi::KS2) E.kscale(acc, cur, t, wr, fr); }
            if constexpr (SP2) {
            PG8_LDB(B0, 0, 0); PG8_LDB(B1, 0, 1); PG8_SCHED; PG8_LDA(At, 0, 0); PG8_STAGE(PG8_SA(1, 1), a1 + hstepA, voffA);
            PG8_WAIT_V(8); PG8_WAIT_L(0); PG8_BAR; PG8_MMA(0, 0, At, B0); PG8_MMA(0, 1, At, B1); PG8_BAR; PG8_SCHED;
            PG8_LDA(At, 0, 1); PG8_STAGE(PG8_SB(0, 0), b2, voffB); PG8_STAGE(PG8_SB(0, 1), b2 + hstep, voffB); PG8_STAGE(PG8_SA(0, 0), a2, voffA);
            PG8_WAIT_V(8); PG8_WAIT_L(0); PG8_BAR; PG8_MMA(1, 0, At, B0); PG8_MMA(1, 1, At, B1); PG8_BAR; PG8_SCHED;
            PG8_LDB(B0, 1, 0); PG8_LDB(B1, 1, 1); PG8_SCHED; PG8_LDA(At, 1, 0); PG8_STAGE(PG8_SA(0, 1), a2 + hstepA, voffA);
            PG8_WAIT_V(8); PG8_WAIT_L(0); PG8_BAR; PG8_MMA(0, 0, At, B0); PG8_MMA(0, 1, At, B1); PG8_BAR; PG8_SCHED;
            PG8_LDA(At, 1, 1); PG8_STAGE(PG8_SB(1, 0), b3, voffB); PG8_STAGE(PG8_SB(1, 1), b3 + hstep, voffB); PG8_STAGE(PG8_SA(1, 0), a3, voffA);
            PG8_WAIT_V(8); PG8_WAIT_L(0); PG8_BAR; PG8_MMA(1, 0, At, B0); PG8_MMA(1, 1, At, B1); PG8_BAR; PG8_SCHED;
            } else {
            PG8_LDB(B0, 0, 0); PG8_SCHED; PG8_LDA(At, 0, 0); PG8_STAGE(PG8_SA(1, 1), a1 + hstepA, voffA);
            PG8_WAIT_L(8); PG8_BAR; PG8_WAIT_L(0); PG8_MMA(0, 0, At, B0); PG8_BAR; PG8_SCHED;
            PG8_LDB(B1, 0, 1); PG8_STAGE(PG8_SB(0, 0), b2, voffB);
            PG8_BAR; PG8_WAIT_L(0); PG8_MMA(0, 1, At, B1); PG8_BAR;
            PG8_LDA(At, 0, 1); PG8_STAGE(PG8_SA(0, 0), a2, voffA);
            PG8_BAR; PG8_WAIT_L(0); PG8_MMA(1, 0, At, B0); PG8_BAR; PG8_SCHED;
            PG8_STAGE(PG8_SB(0, 1), b2 + hstep, voffB);
            PG8_WAIT_V(6); PG8_BAR; PG8_MMA(1, 1, At, B1); PG8_BAR;
            PG8_LDB(B0, 1, 0); PG8_SCHED; PG8_LDA(At, 1, 0); PG8_STAGE(PG8_SA(0, 1), a2 + hstepA, voffA);
            PG8_WAIT_L(8); PG8_BAR; PG8_WAIT_L(0); PG8_MMA(0, 0, At, B0); PG8_BAR; PG8_SCHED;
            PG8_LDB(B1, 1, 1); PG8_STAGE(PG8_SB(1, 0), b3, voffB);
            PG8_BAR; PG8_WAIT_L(0); PG8_MMA(0, 1, At, B1); PG8_BAR;
            PG8_LDA(At, 1, 1); PG8_STAGE(PG8_SA(1, 0), a3, voffA);
            PG8_BAR; PG8_WAIT_L(0); PG8_MMA(1, 0, At, B0); PG8_BAR; PG8_SCHED;
            PG8_STAGE(PG8_SB(1, 1), b3 + hstep, voffB);
            PG8_WAIT_V(6); PG8_BAR; PG8_MMA(1, 1, At, B1); PG8_BAR;
            }
        }
        if constexpr (ALIGN_EPI) { if (wr == 0) PG8_BAR; }
        if constexpr (!Epi::AFTER_DRAIN) { E(acc, cur, wr, wc, fr, fq); S.done(cur); }
        if (!has_next) break;
#pragma unroll
        for (int a = 0; a < 2; ++a)
#pragma unroll
            for (int b = 0; b < 2; ++b)
#pragma unroll
                for (int m = 0; m < 4; ++m)
#pragma unroll
                    for (int n = 0; n < 2; ++n) acc[a][b][m][n] = (f32x4){0.f, 0.f, 0.f, 0.f};
        cur = nxt; cA = nA; cB = nB; ++ui;
        if constexpr (ALIGN_EPI) { if (wr == 1) PG8_BAR; }
    }
    PG8_WAIT_V(0);
    if constexpr (!ALIGN_EPI) { if (wr == 0) PG8_BAR; }
    PG8_BAR;
    if constexpr (Epi::AFTER_DRAIN) { E.fused(acc, cur, wr, wc, fr, fq, lds, wid, lane); S.done(cur); }
#undef PG8_SA
#undef PG8_SB
#undef PG8_STAGE
#undef PG8_LDA
#undef PG8_LDB
#undef PG8_MMA
#undef PG8_WAIT_V
#undef PG8_WAIT_L
#undef PG8_BAR
#undef PG8_SCHED
}
}
#define LDS_WAIT() asm volatile("s_waitcnt lgkmcnt(0)" ::: "memory")
#define XB_TMO      128
#define XB_XCNT(j)  (256  + 64 * (j))
#define XB_XSUB(j)  (1280 + 64 * (j))
#define XB_XGEN(j)  (2304 + 64 * (j))
#define XB_TOP      3328
#define XB_TOPGEN   3392
#define XCD_BAR_WORDS 3456
#define XB_SPIN_CAP (1u << 18)

__device__ __forceinline__ unsigned xb_ld(unsigned* p)              { return __hip_atomic_load(p, __ATOMIC_RELAXED, __HIP_MEMORY_SCOPE_AGENT); }
__device__ __forceinline__ unsigned xb_add(unsigned* p, unsigned v) { return __hip_atomic_fetch_add(p, v, __ATOMIC_RELAXED, __HIP_MEMORY_SCOPE_AGENT); }
__device__ __forceinline__ unsigned xb_xcc_id() { return (unsigned)__builtin_amdgcn_s_getreg((3 << 11) | 20) & 0xFu; }
#define XB_SPIN(cond, bar) do { unsigned _sp = 0; while (cond) { __builtin_amdgcn_s_sleep(1); \
    if ((++_sp & 255u) == 0u) { if (xb_ld(&(bar)[XB_TMO])) break; if (_sp > XB_SPIN_CAP) { atomicAdd(&(bar)[XB_TMO], 1u); break; } } } } while (0)

struct XcdBarrier {
    unsigned* bar; unsigned x;
    volatile LAS unsigned* st;
};

__device__ __forceinline__ XcdBarrier xcd_barrier_post(unsigned* bar, volatile LAS unsigned* st) {
    XcdBarrier b; b.bar = bar; b.x = xb_xcc_id(); b.st = st;
    if (threadIdx.x == 0) (void)xb_add(&bar[XB_XCNT(b.x)], 1u);
    return b;
}
__device__ __forceinline__ void xcd_barrier_complete(unsigned* bar, unsigned x, unsigned& nloc, unsigned& nx) {
    const unsigned G = gridDim.x * gridDim.y * gridDim.z;
    unsigned sum, cnt, mine, sp = 0u;
    for (;;) {
        sum = 0u; cnt = 0u; mine = 0u;
#pragma unroll
        for (unsigned j = 0; j < 16; ++j) { const unsigned c = xb_ld(&bar[XB_XCNT(j)]); sum += c; cnt += (c > 0u) ? 1u : 0u; mine = (j == x) ? c : mine; }
        if (sum == G) break;
        __builtin_amdgcn_s_sleep(1);
        if ((++sp & 255u) == 0u) { if (xb_ld(&bar[XB_TMO])) break; if (sp > XB_SPIN_CAP) { atomicAdd(&bar[XB_TMO], 1u); break; } }
    }
    nloc = mine > 0u ? mine : 1u; nx = cnt > 0u ? cnt : 1u;
}

__device__ __forceinline__ void xcd_barrier(const XcdBarrier& b) {
    asm volatile("s_waitcnt vmcnt(0)" ::: "memory");
    __syncthreads();
    if (threadIdx.x == 0) {
        unsigned* bar = b.bar;
        __builtin_amdgcn_s_waitcnt(0);
        unsigned nloc = b.st[0], nx = b.st[1];
        if (nloc == 0u) { xcd_barrier_complete(bar, b.x, nloc, nx); b.st[0] = nloc; b.st[1] = nx; }
        const unsigned old = xb_add(&bar[XB_XSUB(b.x)], 1u);
        const unsigned gen = old / nloc;
        if (old + 1u == (gen + 1u) * nloc) {
            __builtin_amdgcn_fence(__ATOMIC_RELEASE, "agent");
            asm volatile("s_waitcnt vmcnt(0)" ::: "memory");
            const unsigned og = xb_add(&bar[XB_TOP], 1u);
            const unsigned tg = og / nx;
            if (og + 1u == (tg + 1u) * nx) xb_add(&bar[XB_TOPGEN], 1u);
            else XB_SPIN(xb_ld(&bar[XB_TOPGEN]) == tg, bar);
            __builtin_amdgcn_fence(__ATOMIC_ACQUIRE, "agent");
            xb_add(&bar[XB_XGEN(b.x)], 1u);
            asm volatile("s_waitcnt vmcnt(0)" ::: "memory");
        } else {
            XB_SPIN(xb_ld(&bar[XB_XGEN(b.x)]) == gen, bar);
            __builtin_amdgcn_fence(__ATOMIC_ACQUIRE, "agent");
            asm volatile("s_waitcnt vmcnt(0)" ::: "memory");
        }
    }
    __syncthreads();
}
#define SYNC() __syncthreads()
__device__ __forceinline__ float silu_fast(float v) { return v * __builtin_amdgcn_rcpf(1.f + __expf(-v)); }
__device__ __forceinline__ float sq2(unsigned w) { const float a = bflo(w), b = bfhi(w); return a * a + b * b; }

__device__ __forceinline__ void ph_mod(const Params& p, unsigned char* lds, int tid, int vb) {
    float* cact = (float*)lds; float* red = (float*)(lds + 65536);
    const int lane = tid & 63, wv = tid >> 6, c4 = lane & 31, kh = lane >> 5;
    for (int i = tid; i < NB * DM; i += NTHR) { const int b = i / DM, k = i % DM; cact[k * NB + b] = silu_f(p.c[i]); }
    SYNC();
    const int n = vb * 128 + 4 * c4;
    f32x4 acc[NB];
#pragma unroll
    for (int b = 0; b < NB; ++b) acc[b] = (f32x4){0.f, 0.f, 0.f, 0.f};
    const float* w = p.w_ada + (size_t)(wv * 256 + kh) * (6 * DM) + n;
#pragma unroll 8
    for (int i = 0; i < 128; ++i) {
        const f32x4 wk = *(const f32x4*)(w + (size_t)(2 * i) * (6 * DM));
        const f32x4 ca = *(const f32x4*)(cact + (wv * 256 + 2 * i + kh) * NB), cb = *(const f32x4*)(cact + (wv * 256 + 2 * i + kh) * NB + 4);
        acc[0] += wk * ca.x; acc[1] += wk * ca.y; acc[2] += wk * ca.z; acc[3] += wk * ca.w; acc[4] += wk * cb.x; acc[5] += wk * cb.y; acc[6] += wk * cb.z; acc[7] += wk * cb.w;
    }
#pragma unroll
    for (int b = 0; b < NB; ++b) { acc[b].x += __shfl_xor(acc[b].x, 32); acc[b].y += __shfl_xor(acc[b].y, 32); acc[b].z += __shfl_xor(acc[b].z, 32); acc[b].w += __shfl_xor(acc[b].w, 32); }
    if (lane < 32) {
#pragma unroll
        for (int b = 0; b < NB; ++b) *(f32x4*)(red + (wv * NB + b) * 128 + 4 * c4) = acc[b];
    }
    SYNC();
    for (int o = tid; o < NB * 128; o += NTHR) {
        const int b = o >> 7, col = o & 127;
        float s = p.b_ada[vb * 128 + col];
#pragma unroll
        for (int w8 = 0; w8 < 8; ++w8) s += red[(w8 * NB + b) * 128 + col];
        ((float*)(p.ws + WS_MOD))[b * 6 * DM + vb * 128 + col] = s;
    }
    SYNC();
}
__device__ __forceinline__ void ph_rope_tab(const Params& p, int gtid, int gn) {
    for (int i = gtid; i < T * 32; i += gn) {
        const int t = i >> 5, f = i & 31;
        const float inv = 1.0f / powf(10000.0f, (float)f * (2.0f / 64.0f));
        const float ang = (float)p.pos[t] * inv;
        ((float*)(p.ws + WS_ROPEC))[i] = (float)cos((double)ang);
        ((float*)(p.ws + WS_ROPES))[i] = (float)sin((double)ang);
    }
}
__device__ __forceinline__ void tr_item(const float* W, int K, int N, int Npad, bf16_t* WT, const float* g0, const float* g1, int gs, float* scr, int item, int lane) {
    const int nblk = Npad / 128, kb = item / nblk, nb = item % nblk, k0 = 32 * kb, n0 = 128 * nb;
    const int c4 = lane & 31, kh = lane >> 5, n = n0 + 4 * c4; const bool ok = n < N;
#pragma unroll 8
    for (int i = 0; i < 16; ++i) {
        const int kk = 2 * i + kh, k = k0 + kk;
        f32x4 v = ok ? *(const f32x4*)(W + (size_t)k * N + n) : (f32x4){0.f, 0.f, 0.f, 0.f};
        if (g0) v = v * ((k < gs) ? g0[k] : g1[k - gs]);
        *(f32x4*)(scr + kk * 132 + 4 * c4) = v;
    }
    asm volatile("s_waitcnt lgkmcnt(0)" ::: "memory");
#pragma unroll
    for (int j = 0; j < 8; ++j) {
        const int idx = lane + 64 * j, nn = idx >> 2, ck = idx & 3; const float* sp = scr + (8 * ck) * 132 + nn;
        u32x4 o; o.x = pk2(sp[0 * 132], sp[1 * 132]); o.y = pk2(sp[2 * 132], sp[3 * 132]); o.z = pk2(sp[4 * 132], sp[5 * 132]); o.w = pk2(sp[6 * 132], sp[7 * 132]);
        *(u32x4*)(WT + (size_t)(n0 + nn) * K + k0 + 8 * ck) = o;
    }
    asm volatile("s_waitcnt lgkmcnt(0)" ::: "memory");
}
constexpr int TR_N0 = (DM / 32) * (NPROJ / 128), TR_N1 = (512 / 32) * (NQ / 128), TR_N2 = (256 / 32) * (NKV / 128), TR_N3 = (DM / 32) * (DM / 128), TR_N4 = TR_N3;
constexpr int TR_TOTAL = TR_N0 + TR_N1 + TR_N2 + TR_N3 + TR_N4;
__device__ __forceinline__ void ph_transposes(const Params& p, unsigned char* lds, int wave, int lane, int first, int stride) {
    float* scr = (float*)(lds + wave * 17408);
    for (int it = first; it < TR_TOTAL; it += stride) {
        int r = it;
        if (r < TR_N0) { tr_item(p.w_in, DM, IN_COLS, NPROJ, (bf16_t*)(p.ws + WS_WINT), nullptr, nullptr, 0, scr, r, lane); continue; } r -= TR_N0;
        if (r < TR_N1) { tr_item(p.w_uq, 512, NQ, NQ, (bf16_t*)(p.ws + WS_WUQT), p.q_a_norm, p.q_a_norm, 512, scr, r, lane); continue; } r -= TR_N1;
        if (r < TR_N2) { tr_item(p.w_ukv, 256, NKV, NKV, (bf16_t*)(p.ws + WS_WUKVT), p.kv_a_norm, p.kv_a_norm, 256, scr, r, lane); continue; } r -= TR_N2;
        if (r < TR_N3) { tr_item(p.w_out, DM, DM, DM, (bf16_t*)(p.ws + WS_WOUTT), p.attn_out_norm, p.ssd_norm, 1024, scr, r, lane); continue; } r -= TR_N3;
        tr_item(p.w_query, DM, DM, DM, (bf16_t*)(p.ws + WS_WQT), nullptr, nullptr, 0, scr, r, lane);
    }
}
__device__ __forceinline__ void ph_convert(const float* src, bf16_t* dst, size_t n4, int gtid, int gn) {
    for (size_t i = gtid; i < n4; i += (size_t)gn) {
        const f32x4 v = ((const f32x4*)src)[i];
        uint2 o; o.x = pk2(v.x, v.y); o.y = pk2(v.z, v.w);
        ((uint2*)dst)[i] = o;
    }
}
__device__ __forceinline__ void ph_modrows(const float* in, bf16_t* outp, const float* mod, int sh_idx, int sc_idx, int gwave, int gnw, int lane) {
    for (int row = gwave; row < T; row += gnw) {
        const int b = row / SEQ;
        const f32x4* xr = (const f32x4*)(in + (size_t)row * DM) + lane;
        f32x4 v[8]; float s = 0.f;
#pragma unroll
        for (int j = 0; j < 8; ++j) { v[j] = xr[64 * j]; s += (v[j].x * v[j].x + v[j].y * v[j].y) + (v[j].z * v[j].z + v[j].w * v[j].w); }
        const float r = rsqrtf(wave_sum(s) * (1.f / DM) + EPS);
        const f32x4* sh = (const f32x4*)(mod + (size_t)b * 6 * DM + sh_idx * DM) + lane;
        const f32x4* sc = (const f32x4*)(mod + (size_t)b * 6 * DM + sc_idx * DM) + lane;
        uint2* o = (uint2*)(outp + (size_t)row * DM) + lane;
#pragma unroll
        for (int j = 0; j < 8; ++j) {
            const f32x4 a = sh[64 * j], m = sc[64 * j];
            uint2 w; w.x = pk2(v[j].x * r * (1.f + m.x) + a.x, v[j].y * r * (1.f + m.y) + a.y); w.y = pk2(v[j].z * r * (1.f + m.z) + a.z, v[j].w * r * (1.f + m.w) + a.w);
            o[64 * j] = w;
        }
    }
}
__device__ __forceinline__ void ph_bias2(const Params& p, int gwave, int gnw, int lane) {
    const float* mod = (const float*)(p.ws + WS_MOD);
    for (int n = gwave; n < DM; n += gnw) {
        const bf16_t* wr_ = (const bf16_t*)(p.ws + WS_WQT) + (size_t)n * DM + lane * 8;
        float wv[4][8];
#pragma unroll
        for (int j = 0; j < 4; ++j) { const u32x4 w = *(const u32x4*)(wr_ + j * 512);
            wv[j][0] = bflo(w.x); wv[j][1] = bfhi(w.x); wv[j][2] = bflo(w.y); wv[j][3] = bfhi(w.y); wv[j][4] = bflo(w.z); wv[j][5] = bfhi(w.z); wv[j][6] = bflo(w.w); wv[j][7] = bfhi(w.w); }
#pragma unroll
        for (int b = 0; b < NB; ++b) {
            const float* sh = mod + (size_t)b * 6 * DM + 3 * DM + lane * 8; float a = 0.f;
#pragma unroll
            for (int j = 0; j < 4; ++j) { const f32x4 s0 = *(const f32x4*)(sh + j * 512), s1 = *(const f32x4*)(sh + j * 512 + 4);
                a += (wv[j][0] * s0[0] + wv[j][1] * s0[1]) + (wv[j][2] * s0[2] + wv[j][3] * s0[3]) + (wv[j][4] * s1[0] + wv[j][5] * s1[1]) + (wv[j][6] * s1[2] + wv[j][7] * s1[3]); }
            a = wave_sum(a);
            if (lane == 0) ((float*)(p.ws + WS_BIAS2))[b * DM + n] = a;
        }
    }
}
constexpr float QSCALE = 0.07216878364870322f * 1.4426950408889634f;
__device__ __forceinline__ float ssq8(u32x4 w) { return (sq2(w.x) + sq2(w.y)) + (sq2(w.z) + sq2(w.w)); }
__device__ __forceinline__ u32x4 scale8(u32x4 w, float s, const float (&g)[8]) {
    u32x4 o; o.x = pk2(bflo(w.x) * s * g[0], bfhi(w.x) * s * g[1]); o.y = pk2(bflo(w.y) * s * g[2], bfhi(w.y) * s * g[3]);
    o.z = pk2(bflo(w.z) * s * g[4], bfhi(w.z) * s * g[5]); o.w = pk2(bflo(w.w) * s * g[6], bfhi(w.w) * s * g[7]); return o;
}
__device__ __forceinline__ u32x4 rope8(u32x4 w, u32x4 pw, float s, const float (&go)[8], const float (&gp)[8], f32x4 c0, f32x4 c1, f32x4 s0, f32x4 s1, float sgn) {
    const float a[8] = {bflo(w.x) * s * go[0], bfhi(w.x) * s * go[1], bflo(w.y) * s * go[2], bfhi(w.y) * s * go[3], bflo(w.z) * s * go[4], bfhi(w.z) * s * go[5], bflo(w.w) * s * go[6], bfhi(w.w) * s * go[7]};
    const float b[8] = {bflo(pw.x) * s * gp[0], bfhi(pw.x) * s * gp[1], bflo(pw.y) * s * gp[2], bfhi(pw.y) * s * gp[3], bflo(pw.z) * s * gp[4], bfhi(pw.z) * s * gp[5], bflo(pw.w) * s * gp[6], bfhi(pw.w) * s * gp[7]};
    u32x4 o;
    o.x = pk2(a[0] * c0.x + sgn * b[0] * s0.x, a[1] * c0.y + sgn * b[1] * s0.y); o.y = pk2(a[2] * c0.z + sgn * b[2] * s0.z, a[3] * c0.w + sgn * b[3] * s0.w);
    o.z = pk2(a[4] * c1.x + sgn * b[4] * s1.x, a[5] * c1.y + sgn * b[5] * s1.y); o.w = pk2(a[6] * c1.z + sgn * b[6] * s1.z, a[7] * c1.w + sgn * b[7] * s1.w);
    return o;
}
__device__ __forceinline__ u32x4 shfl_xor4(u32x4 w, int m) { u32x4 o; o.x = __shfl_xor(w.x, m); o.y = __shfl_xor(w.y, m); o.z = __shfl_xor(w.z, m); o.w = __shfl_xor(w.w, m); return o; }
__device__ __forceinline__ void ph_qkv_post(const Params& p, int gwave, int gnw, int lane) {
    unsigned char* ws = p.ws;
    const int g16 = lane >> 4, pos = lane & 15, hr = lane >> 3, rpos = lane & 7, f0 = (rpos & 3) * 8;
    const float sgn = (rpos < 4) ? -1.f : 1.f;
    float gqn[8], gqr[8], gqp[8], gkn[8], gkr[8], gkp[8];
#pragma unroll
    for (int i = 0; i < 8; ++i) { gqn[i] = p.q_norm[pos * 8 + i]; gqr[i] = p.q_norm[128 + rpos * 8 + i]; gqp[i] = p.q_norm[128 + (rpos ^ 4) * 8 + i];
                                  gkn[i] = p.k_norm[pos * 8 + i]; gkr[i] = p.k_norm[128 + rpos * 8 + i]; gkp[i] = p.k_norm[128 + (rpos ^ 4) * 8 + i]; }
    for (int t = gwave; t < T; t += gnw) {
        const bf16_t* proj = (const bf16_t*)(ws + WS_PROJ) + (size_t)t * NPROJ;
        const bf16_t* qraw = (const bf16_t*)(ws + WS_QRAW) + (size_t)t * NQ;
        const bf16_t* kvraw = (const bf16_t*)(ws + WS_KVRAW) + (size_t)t * NKV;
        const u32x4 cq = *(const u32x4*)(proj + C_CQ + lane * 8);
        const u32x4 ck = *(const u32x4*)(proj + C_CKV + (lane & 31) * 8);
        const u32x4 kr = *(const u32x4*)(proj + C_KR + rpos * 8);
        const u32x4 qn0 = *(const u32x4*)(qraw + g16 * 192 + pos * 8), qn1 = *(const u32x4*)(qraw + (4 + g16) * 192 + pos * 8), qr = *(const u32x4*)(qraw + hr * 192 + 128 + rpos * 8);
        const u32x4 kn0 = *(const u32x4*)(kvraw + g16 * 256 + pos * 8), kn1 = *(const u32x4*)(kvraw + (4 + g16) * 256 + pos * 8);
        const u32x4 v0 = *(const u32x4*)(kvraw + g16 * 256 + 128 + pos * 8), v1 = *(const u32x4*)(kvraw + (4 + g16) * 256 + 128 + pos * 8);
        const float* rcp = (const float*)(ws + WS_ROPEC) + (size_t)t * 32 + f0; const float* rsp = (const float*)(ws + WS_ROPES) + (size_t)t * 32 + f0;
        const f32x4 c0 = *(const f32x4*)rcp, c1 = *(const f32x4*)(rcp + 4), s0 = *(const f32x4*)rsp, s1 = *(const f32x4*)(rsp + 4);
        const float rcq = rsqrtf(wave_sum(ssq8(cq)) * (1.f / 512.f) + EPS);
        const float rckv = rsqrtf(wave_sum(lane < 32 ? ssq8(ck) : 0.f) * (1.f / 256.f) + EPS);
        float skr = ssq8(kr), nq0 = ssq8(qn0), nq1 = ssq8(qn1), rqs = ssq8(qr), nk0 = ssq8(kn0), nk1 = ssq8(kn1);
#pragma unroll
        for (int o = 1; o < 8; o <<= 1) { skr += __shfl_xor(skr, o); rqs += __shfl_xor(rqs, o); nq0 += __shfl_xor(nq0, o); nq1 += __shfl_xor(nq1, o); nk0 += __shfl_xor(nk0, o); nk1 += __shfl_xor(nk1, o); }
        nq0 += __shfl_xor(nq0, 8); nq1 += __shfl_xor(nq1, 8); nk0 += __shfl_xor(nk0, 8); nk1 += __shfl_xor(nk1, 8);
        const float rc2 = rcq * rcq, rk2 = rckv * rckv;
        const float tq0 = nq0 + __shfl(rqs, 8 * g16), tq1 = nq1 + __shfl(rqs, 8 * (4 + g16));
        const float tqa = __shfl(nq0, 16 * (hr & 3)), tqb = __shfl(nq1, 16 * (hr & 3));
        const float tqr = rqs + ((hr < 4) ? tqa : tqb);
        const float sq0 = rsqrtf(tq0 * rc2 * (1.f / 192.f) + EPS) * rcq * QSCALE, sq1 = rsqrtf(tq1 * rc2 * (1.f / 192.f) + EPS) * rcq * QSCALE, sqr = rsqrtf(tqr * rc2 * (1.f / 192.f) + EPS) * rcq * QSCALE;
        const float rk0 = rsqrtf((nk0 * rk2 + skr) * (1.f / 192.f) + EPS), rk1 = rsqrtf((nk1 * rk2 + skr) * (1.f / 192.f) + EPS);
        const float rka = __shfl(rk0, 16 * (hr & 3)), rkb = __shfl(rk1, 16 * (hr & 3));
        const float rkr = (hr < 4) ? rka : rkb;
        const u32x4 pqr = shfl_xor4(qr, 4), pkr = shfl_xor4(kr, 4);
        const int b = t / SEQ, sidx = t % SEQ;
        bf16_t* Q0 = (bf16_t*)(ws + WS_Q) + ((size_t)(b * 8 + g16) * SEQ + sidx) * 192; bf16_t* Q1 = Q0 + (size_t)4 * SEQ * 192; bf16_t* Qr = (bf16_t*)(ws + WS_Q) + ((size_t)(b * 8 + hr) * SEQ + sidx) * 192;
        bf16_t* K0 = (bf16_t*)(ws + WS_K) + ((size_t)(b * 8 + g16) * SEQ + sidx) * 192; bf16_t* K1 = K0 + (size_t)4 * SEQ * 192; bf16_t* Kr = (bf16_t*)(ws + WS_K) + ((size_t)(b * 8 + hr) * SEQ + sidx) * 192;
        bf16_t* V0 = (bf16_t*)(ws + WS_V) + ((size_t)(b * 8 + g16) * SEQ + sidx) * 128; bf16_t* V1 = V0 + (size_t)4 * SEQ * 128;
        *(u32x4*)(Q0 + pos * 8) = scale8(qn0, sq0, gqn); *(u32x4*)(Q1 + pos * 8) = scale8(qn1, sq1, gqn);
        *(u32x4*)(Qr + 128 + rpos * 8) = rope8(qr, pqr, sqr, gqr, gqp, c0, c1, s0, s1, sgn);
        *(u32x4*)(K0 + pos * 8) = scale8(kn0, rckv * rk0, gkn); *(u32x4*)(K1 + pos * 8) = scale8(kn1, rckv * rk1, gkn);
        *(u32x4*)(Kr + 128 + rpos * 8) = rope8(kr, pkr, rkr, gkr, gkp, c0, c1, s0, s1, sgn);
        const float one[8] = {1.f, 1.f, 1.f, 1.f, 1.f, 1.f, 1.f, 1.f};
        *(u32x4*)(V0 + pos * 8) = scale8(v0, rckv, one); *(u32x4*)(V1 + pos * 8) = scale8(v1, rckv, one);
    }
}
__device__ __forceinline__ void ph_attn_naive(const Params& p, unsigned char* lds, int tid, int bid, int G) {
    const int lane = tid & 63, wv = tid >> 6;
    float* ps = (float*)lds + wv * SEQ;
    float* qs = (float*)(lds + 65536) + wv * 192;
    for (int it = 0; it < (T * 8) / (G * 8); ++it) {
        const int sb = (it & 1) ? (G - 1 - bid) : bid;
        const int gi = it * (G * 8) + sb * 8 + wv;
        const int bh = gi / SEQ, s = gi % SEQ, b = bh >> 3, h = bh & 7;
        const bf16_t* Q = (const bf16_t*)(p.ws + WS_Q) + (size_t)gi * 192;
        const bf16_t* K = (const bf16_t*)(p.ws + WS_K) + (size_t)bh * SEQ * 192;
        const bf16_t* V = (const bf16_t*)(p.ws + WS_KVRAW) + (size_t)(b * SEQ) * NKV + h * 256 + 128;
        for (int d = lane; d < 192; d += 64) qs[d] = bf2f(Q[d]);
        SYNC();
        float mx = -1e30f;
        for (int k0 = 0; k0 <= s; k0 += 64) {
            const int key = k0 + lane; float sc = -INFINITY;
            if (key <= s) {
                const u32x4* kp = (const u32x4*)(K + (size_t)key * 192); float a = 0.f;
                for (int c = 0; c < 24; ++c) { const u32x4 w = kp[c]; const float* q = &qs[c * 8];
                    a += bflo(w.x) * q[0] + bfhi(w.x) * q[1] + bflo(w.y) * q[2] + bfhi(w.y) * q[3] + bflo(w.z) * q[4] + bfhi(w.z) * q[5] + bflo(w.w) * q[6] + bfhi(w.w) * q[7]; }
                sc = a;
            }
            ps[key] = sc;
            mx = fmaxf(mx, sc);
        }
#pragma unroll
        for (int o = 1; o < 64; o <<= 1) mx = fmaxf(mx, __shfl_xor(mx, o));
        SYNC();
        float sum = 0.f;
        for (int key = lane; key <= s; key += 64) { const float e = exp2f(ps[key] - mx); ps[key] = e; sum += e; }
        sum = wave_sum(sum);
        SYNC();
        float o0 = 0.f, o1 = 0.f;
        for (int key = 0; key <= s; ++key) { const float pr = ps[key]; const unsigned w = *(const unsigned*)(V + (size_t)key * NKV + 2 * lane); o0 += pr * bflo(w); o1 += pr * bfhi(w); }
        const float inv = 1.f / sum; o0 *= inv; o1 *= inv;
        const int t = b * SEQ + s;
        *(unsigned*)((bf16_t*)(p.ws + WS_ATTN) + (size_t)t * 1024 + h * 128 + 2 * lane) = pk2(o0, o1);
        SYNC();
    }
}
__device__ __forceinline__ void ph_conv_naive(const Params& p, int gtid, int gn) {
    const bf16_t* proj = (const bf16_t*)(p.ws + WS_PROJ);
    for (int i = gtid; i < T * 1552; i += gn) {
        const int t = i / 1552, c = i % 1552, s = t % SEQ;
        if (c < 1536) {
            float a = p.conv_b[c];
            for (int k = 0; k < 4; ++k) { const int ss = s - 3 + k; if (ss >= 0) a += p.conv_w[k * 1536 + c] * bf2f(proj[(size_t)(t - 3 + k) * NPROJ + C_XBC + c]); }
            ((bf16_t*)(p.ws + WS_XBCA))[(size_t)t * 1536 + c] = (bf16_t)f2bf(silu_f(a));
        } else {
            const int hh = c - 1536; const float v = bf2f(proj[(size_t)t * NPROJ + C_DT + hh]) + p.dt_bias[hh];
            ((float*)(p.ws + WS_DT))[(size_t)t * 16 + hh] = (v > 20.f) ? v : log1pf(__expf(v));
        }
    }
}
__device__ __forceinline__ void ph_ssd_naive(const Params& p, int vb, int lt) {
    const int b = vb >> 4, h = vb & 15, g = h >> 3, pp = lt >> 2, nq = lt & 3;
    const bf16_t* xa = (const bf16_t*)(p.ws + WS_XBCA); const float* dtp = (const float*)(p.ws + WS_DT);
    const bf16_t* proj = (const bf16_t*)(p.ws + WS_PROJ);
    const float a = -__expf(p.a_log[h]), dsk = p.d_skip[h];
    float st[32];
#pragma unroll
    for (int n = 0; n < 32; ++n) st[n] = 0.f;
    for (int s = 0; s < SEQ; ++s) {
        const size_t t = (size_t)b * SEQ + s;
        const float dt = dtp[t * 16 + h], dA = __expf(dt * a);
        const float xv = bf2f(xa[t * 1536 + h * 64 + pp]);
        const bf16_t* Bp = xa + t * 1536 + 1024 + g * 128 + nq * 32; const bf16_t* Cp = xa + t * 1536 + 1280 + g * 128 + nq * 32;
        float y = 0.f; const float dx = dt * xv;
#pragma unroll
        for (int n = 0; n < 32; ++n) { st[n] = st[n] * dA + dx * bf2f(Bp[n]); y += bf2f(Cp[n]) * st[n]; }
        y += __shfl_xor(y, 1); y += __shfl_xor(y, 2);
        if (nq == 0) {
            const float z = bf2f(proj[t * NPROJ + C_Z + h * 64 + pp]);
            ((bf16_t*)(p.ws + WS_YSSD))[t * 1024 + h * 64 + pp] = (bf16_t)f2bf((y + dsk * xv) * silu_f(z));
        }
    }
}
__device__ __forceinline__ void ph_mixnorm(const Params& p, int gwave, int gnw, int lane) {
    for (int t = gwave; t < T; t += gnw) {
        const uint2* ain = (const uint2*)((const bf16_t*)(p.ws + WS_ATTN) + (size_t)t * 1024); const uint2* yin = (const uint2*)((const bf16_t*)(p.ws + WS_YSSD) + (size_t)t * 1024);
        uint2 a[4], y[4]; float sa = 0.f, s0 = 0.f, s1 = 0.f;
#pragma unroll
        for (int j = 0; j < 4; ++j) { a[j] = ain[lane + 64 * j]; y[j] = yin[lane + 64 * j]; sa += sq2(a[j].x) + sq2(a[j].y); const float q = sq2(y[j].x) + sq2(y[j].y); if (j < 2) s0 += q; else s1 += q; }
        const float ra = rsqrtf(wave_sum(sa) * (1.f / 1024.f) + EPS), r0 = rsqrtf(wave_sum(s0) * (1.f / 512.f) + EPS), r1 = rsqrtf(wave_sum(s1) * (1.f / 512.f) + EPS);
        uint2* o = (uint2*)((bf16_t*)(p.ws + WS_MIXIN) + (size_t)t * DM);
#pragma unroll
        for (int j = 0; j < 4; ++j) {
            uint2 r; r.x = pk2(bflo(a[j].x) * ra, bfhi(a[j].x) * ra); r.y = pk2(bflo(a[j].y) * ra, bfhi(a[j].y) * ra); o[lane + 64 * j] = r;
            const float rr = (j < 2) ? r0 : r1;
            uint2 q; q.x = pk2(bflo(y[j].x) * rr, bfhi(y[j].x) * rr); q.y = pk2(bflo(y[j].y) * rr, bfhi(y[j].y) * rr); o[256 + lane + 64 * j] = q;
        }
    }
}
__device__ __forceinline__ void ph_route_naive(const Params& p, unsigned char* lds, int tid, int bid, int G) {
    const int sub = tid >> 7, lt = tid & 127;
    float* base = (float*)(lds + sub * 4096);
    float* q = base; float* sc = base + 256; float* ts = base + 512; int* ti = (int*)(base + 544); float* cs = base + 576; float* bs = base + 832; int* bi = (int*)(base + 848);
    const bf16_t* sk = (const bf16_t*)(p.ws + WS_SUBK);
    for (int it = 0; it < (T * 8) / (G * 4); ++it) {
        const int vb = it * (G * 4) + bid * 4 + sub, t = vb >> 3, h = vb & 7;
        const bf16_t* qp = (const bf16_t*)(p.ws + WS_QP) + (size_t)t * DM + h * 256;
        q[lt] = bf2f(qp[lt]); q[128 + lt] = bf2f(qp[128 + lt]);
        SYNC();
#pragma unroll
        for (int j = 0; j < 2; ++j) {
            const u32x4* kp = (const u32x4*)(sk + ((size_t)(h * 2 + j) * 128 + lt) * 128); float a = 0.f;
            for (int c = 0; c < 16; ++c) { const u32x4 w = kp[c]; const float* qq = q + j * 128 + c * 8;
                a += bflo(w.x) * qq[0] + bfhi(w.x) * qq[1] + bflo(w.y) * qq[2] + bfhi(w.y) * qq[3] + bflo(w.z) * qq[4] + bfhi(w.z) * qq[5] + bflo(w.w) * qq[6] + bfhi(w.w) * qq[7]; }
            sc[j * 128 + lt] = a;
        }
        SYNC();
#pragma unroll
        for (int j = 0; j < 2; ++j) {
            const float v = sc[j * 128 + lt]; int rank = 0;
            for (int k = 0; k < 128; ++k) { const float o = sc[j * 128 + k]; rank += (o > v || (o == v && k < lt)) ? 1 : 0; }
            if (rank < 16) { ts[j * 16 + rank] = v; ti[j * 16 + rank] = lt; }
        }
        SYNC();
        cs[lt] = ts[lt >> 4] + ts[16 + (lt & 15)]; cs[128 + lt] = ts[8 + (lt >> 4)] + ts[16 + (lt & 15)];
        SYNC();
#pragma unroll
        for (int r = 0; r < 2; ++r) {
            const int ci = lt + 128 * r; const float v = cs[ci]; int rank = 0;
            for (int k = 0; k < 256; ++k) { const float o = cs[k]; rank += (o > v || (o == v && k < ci)) ? 1 : 0; }
            if (rank < 16) { bs[rank] = v; bi[rank] = ti[ci >> 4] * 128 + ti[16 + (ci & 15)]; }
        }
        SYNC();
        if (lt < 16) {
            const float mx = bs[0]; float sum = 0.f;
            for (int k = 0; k < 16; ++k) sum += __expf(bs[k] - mx);
            ((float*)(p.ws + WS_GATE))[(size_t)t * 128 + h * 16 + lt] = __expf(bs[lt] - mx) / sum;
            ((int*)(p.ws + WS_IDX))[(size_t)t * 128 + h * 16 + lt] = bi[lt];
        }
        SYNC();
    }
}
__device__ __forceinline__ void ph_peer_naive(const Params& p, unsigned char* lds, int tid, int bid, int G) {
    const int half = tid >> 8, lt = tid & 255, lane = tid & 63, wv = lt >> 6;
    float* red = (float*)(lds + half * 64);
    const bf16_t* U = (const bf16_t*)(p.ws + WS_U16); const bf16_t* V = (const bf16_t*)(p.ws + WS_V16);
    for (int it = 0; it < T / (G * 2); ++it) {
        const int t = it * (G * 2) + bid * 2 + half, b = t / SEQ;
        const u32x4 hw = *(const u32x4*)((const bf16_t*)(p.ws + WS_H2) + (size_t)t * DM + lt * 8);
        const float h0 = bflo(hw.x), h1 = bfhi(hw.x), h2 = bflo(hw.y), h3 = bfhi(hw.y), h4 = bflo(hw.z), h5 = bfhi(hw.z), h6 = bflo(hw.w), h7 = bfhi(hw.w);
        float o0 = 0.f, o1 = 0.f, o2 = 0.f, o3 = 0.f, o4 = 0.f, o5 = 0.f, o6 = 0.f, o7 = 0.f;
        const int* idx = (const int*)(p.ws + WS_IDX) + (size_t)t * 128; const float* gate = (const float*)(p.ws + WS_GATE) + (size_t)t * 128;
        for (int e = 0; e < 128; ++e) {
            const int ex = idx[e];
            const u32x4 uw = *(const u32x4*)(U + (size_t)ex * DM + lt * 8);
            float d = bflo(uw.x) * h0 + bfhi(uw.x) * h1 + bflo(uw.y) * h2 + bfhi(uw.y) * h3 + bflo(uw.z) * h4 + bfhi(uw.z) * h5 + bflo(uw.w) * h6 + bfhi(uw.w) * h7;
            d = wave_sum(d);
            if (lane == 0) red[wv] = d;
            SYNC();
            const float pre = red[0] + red[1] + red[2] + red[3];
            const float a = 0.5f * pre * (1.f + erff(pre * 0.70710678118654752f)) * gate[e];
            SYNC();
            const u32x4 vw = *(const u32x4*)(V + (size_t)ex * DM + lt * 8);
            o0 += a * bflo(vw.x); o1 += a * bfhi(vw.x); o2 += a * bflo(vw.y); o3 += a * bfhi(vw.y); o4 += a * bflo(vw.z); o5 += a * bfhi(vw.z); o6 += a * bflo(vw.w); o7 += a * bfhi(vw.w);
        }
        const float* g2 = (const float*)(p.ws + WS_MOD) + (size_t)b * 6 * DM + 5 * DM + lt * 8;
        float* outp = p.out + (size_t)t * DM + lt * 8;
        const f32x4 x0 = *(const f32x4*)outp, x1 = *(const f32x4*)(outp + 4), ga = *(const f32x4*)g2, gb = *(const f32x4*)(g2 + 4);
        *(f32x4*)outp = (f32x4){x0.x + ga.x * o0, x0.y + ga.y * o1, x0.z + ga.z * o2, x0.w + ga.w * o3};
        *(f32x4*)(outp + 4) = (f32x4){x1.x + gb.x * o4, x1.y + gb.y * o5, x1.z + gb.z * o6, x1.w + gb.w * o7};
    }
}
typedef __bf16 bf16x2_t __attribute__((ext_vector_type(2)));
__device__ __forceinline__ float dot2bf(unsigned a, unsigned b, float c) { return __builtin_amdgcn_fdot2_f32_bf16(__builtin_bit_cast(bf16x2_t, a), __builtin_bit_cast(bf16x2_t, b), c, false); }
__device__ __forceinline__ void ph_peer(const Params& p, LAS unsigned char* ldsl, int wave, int lane, int gwave, int gnw) {
    LAS unsigned char* ring = ldsl + wave * 16384;
    const bf16_t* U = (const bf16_t*)(p.ws + WS_U16); const bf16_t* V = (const bf16_t*)(p.ws + WS_V16);
    const int e_lane = (lane >> 2) & 15; const unsigned lane16 = (unsigned)lane * 16u;
#define PEER_ISSUE(R) do { const int R_ = (R); const int i_ = ((R_ >> 5) << 4) + (R_ & 15); \
        const int e_ = (i_ < 64) ? __builtin_amdgcn_readlane(idx0, i_) : __builtin_amdgcn_readlane(idx1, i_ - 64); \
        const char* base_ = (const char*)(((R_ >> 4) & 1) ? V : U) + (size_t)(unsigned)e_ * (DM * 2); \
        const unsigned* src_ = (const unsigned*)(base_ + lane16); \
        LAS unsigned* dst_ = (LAS unsigned*)(ring + (R_ & 3) * 4096); \
        __builtin_amdgcn_global_load_lds(src_, dst_, 16, 0, 0); \
        __builtin_amdgcn_global_load_lds(src_, dst_, 16, 1024, 0); \
        __builtin_amdgcn_global_load_lds(src_, dst_, 16, 2048, 0); \
        __builtin_amdgcn_global_load_lds(src_, dst_, 16, 3072, 0); } while (0)
#define PEER_WAIT(n) asm volatile("s_waitcnt vmcnt(" #n ")" ::: "memory")
    for (int t = gwave; t < T; t += gnw) {
        const int b = t / SEQ;
        const int idx0 = ((const int*)(p.ws + WS_IDX))[(size_t)t * 128 + lane], idx1 = ((const int*)(p.ws + WS_IDX))[(size_t)t * 128 + 64 + lane];
        const float g0 = ((const float*)(p.ws + WS_GATE))[(size_t)t * 128 + lane], g1 = ((const float*)(p.ws + WS_GATE))[(size_t)t * 128 + 64 + lane];
        u32x4 hreg[4];
#pragma unroll
        for (int j = 0; j < 4; ++j) hreg[j] = *(const u32x4*)((const bf16_t*)(p.ws + WS_H2) + (size_t)t * DM + j * 512 + lane * 8);
        float out[4][8];
#pragma unroll
        for (int j = 0; j < 4; ++j)
#pragma unroll
            for (int i = 0; i < 8; ++i) out[j][i] = 0.f;
        PEER_ISSUE(0); PEER_ISSUE(1); PEER_ISSUE(2);
        for (int hh = 0; hh < 8; ++hh) {
            float pd[16];
#pragma unroll
            for (int k = 0; k < 16; ++k) {
                PEER_ISSUE(hh * 32 + k + 3); PEER_WAIT(12);
                const LAS unsigned char* sl = ring + (k & 3) * 4096 + lane * 16;
                float a = 0.f;
#pragma unroll
                for (int j = 0; j < 4; ++j) { const u32x4 w = *(const LAS u32x4*)(sl + j * 1024);
                    a = dot2bf(w.x, hreg[j].x, a); a = dot2bf(w.y, hreg[j].y, a); a = dot2bf(w.z, hreg[j].z, a); a = dot2bf(w.w, hreg[j].w, a); }
                asm volatile("" : "+v"(a));
                pd[k] = a;
            }
            float q8[8], q4[4], q2[2], q1;
            { const bool hi = (lane & 32) != 0;
#pragma unroll
              for (int i = 0; i < 8; ++i) { const float keep = hi ? pd[i + 8] : pd[i], send = hi ? pd[i] : pd[i + 8]; q8[i] = keep + __shfl_xor(send, 32); } }
            { const bool hi = (lane & 16) != 0;
#pragma unroll
              for (int i = 0; i < 4; ++i) { const float keep = hi ? q8[i + 4] : q8[i], send = hi ? q8[i] : q8[i + 4]; q4[i] = keep + __shfl_xor(send, 16); } }
            { const bool hi = (lane & 8) != 0;
#pragma unroll
              for (int i = 0; i < 2; ++i) { const float keep = hi ? q4[i + 2] : q4[i], send = hi ? q4[i] : q4[i + 2]; q2[i] = keep + __shfl_xor(send, 8); } }
            { const bool hi = (lane & 4) != 0; const float keep = hi ? q2[1] : q2[0], send = hi ? q2[0] : q2[1]; q1 = keep + __shfl_xor(send, 4); }
            q1 += __shfl_xor(q1, 1); q1 += __shfl_xor(q1, 2);
            const float gsel = (hh < 4) ? g0 : g1;
            const float gate = __shfl(gsel, (hh & 3) * 16 + e_lane);
            const float act = 0.5f * q1 * (1.f + erff(q1 * 0.70710678118654752f)) * gate;
#pragma unroll
            for (int k = 0; k < 16; ++k) {
                if (k < 13) { PEER_ISSUE(hh * 32 + 16 + k + 3); PEER_WAIT(12); }
                else if (hh < 7) { PEER_ISSUE(hh * 32 + 16 + k + 3); PEER_WAIT(12); }
                else if (k == 13) PEER_WAIT(8); else if (k == 14) PEER_WAIT(4); else PEER_WAIT(0);
                const float a = __builtin_bit_cast(float, __builtin_amdgcn_readlane(__builtin_bit_cast(int, act), 4 * k));
                const LAS unsigned char* sl = ring + (k & 3) * 4096 + lane * 16;
#pragma unroll
                for (int j = 0; j < 4; ++j) { const u32x4 w = *(const LAS u32x4*)(sl + j * 1024);
                    out[j][0] += a * bflo(w.x); out[j][1] += a * bfhi(w.x); out[j][2] += a * bflo(w.y); out[j][3] += a * bfhi(w.y);
                    out[j][4] += a * bflo(w.z); out[j][5] += a * bfhi(w.z); out[j][6] += a * bflo(w.w); out[j][7] += a * bfhi(w.w);
                    asm volatile("" : "+v"(out[j][0]), "+v"(out[j][1]), "+v"(out[j][2]), "+v"(out[j][3]), "+v"(out[j][4]), "+v"(out[j][5]), "+v"(out[j][6]), "+v"(out[j][7])); }
            }
        }
        const float* g2 = (const float*)(p.ws + WS_MOD) + (size_t)b * 6 * DM + 5 * DM;
        float* outp = p.out + (size_t)t * DM;
#pragma unroll
        for (int j = 0; j < 4; ++j) {
            const int c = j * 512 + lane * 8;
            const f32x4 x0 = *(const f32x4*)(outp + c), x1 = *(const f32x4*)(outp + c + 4), ga = *(const f32x4*)(g2 + c), gb = *(const f32x4*)(g2 + c + 4);
            *(f32x4*)(outp + c) = (f32x4){x0.x + ga.x * out[j][0], x0.y + ga.y * out[j][1], x0.z + ga.z * out[j][2], x0.w + ga.w * out[j][3]};
            *(f32x4*)(outp + c + 4) = (f32x4){x1.x + gb.x * out[j][4], x1.y + gb.y * out[j][5], x1.z + gb.z * out[j][6], x1.w + gb.w * out[j][7]};
        }
    }
#undef PEER_ISSUE
#undef PEER_WAIT
}
typedef short bf16x8 __attribute__((ext_vector_type(8)));
typedef short s16x4 __attribute__((ext_vector_type(4)));
typedef float f32x16 __attribute__((ext_vector_type(16)));
typedef float f32x2_t __attribute__((ext_vector_type(2)));
__device__ __forceinline__ int crow(int r, int hi) { return (r & 3) + 8 * (r >> 2) + 4 * hi; }
__device__ __forceinline__ unsigned cvtpk(float lo, float hi) { f32x2_t v = {lo, hi}; bf16x2_t b = __builtin_convertvector(v, bf16x2_t); return __builtin_bit_cast(unsigned, b); }
__device__ __forceinline__ s16x4 vtr(const LAS unsigned char* pp) { return __builtin_bit_cast(s16x4, __builtin_amdgcn_ds_read_tr16_b64_v4i16((LAS s16x4*)pp)); }
#define TR_PAIR(lo_, hi_, addr_, off_, hioff_) do { asm volatile("ds_read_b64_tr_b16 %0, %1 offset:%c2" : "=&v"(lo_) : "v"(addr_), "i"(off_) : "memory"); \
        asm volatile("ds_read_b64_tr_b16 %0, %1 offset:%c2" : "=&v"(hi_) : "v"(addr_), "i"((off_) + (hioff_)) : "memory"); } while (0)
#define LDS_WAIT_PIN() do { asm volatile("s_waitcnt lgkmcnt(0)" ::: "memory"); __builtin_amdgcn_sched_barrier(0); } while (0)
constexpr int AT_SLOT = 40960, AT_VOFF = 24576;
__device__ __forceinline__ void attn_unit(const Params& p, LAS unsigned char* ldsl, int bh, int qb, int wave, int lane) {
    const int r32 = lane & 31, hi = lane >> 5, b = bh >> 3, h = bh & 7;
    const bf16_t* Kbh = (const bf16_t*)(p.ws + WS_K) + (size_t)bh * SEQ * 192;
    const bf16_t* Vb = (const bf16_t*)(p.ws + WS_V) + (size_t)bh * SEQ * 128;
    const bf16_t* Qw = (const bf16_t*)(p.ws + WS_Q) + ((size_t)bh * SEQ + qb * 256 + wave * 32 + r32) * 192 + 8 * hi;
    const int NT = (qb * 256 + 256) / 64;
    int koff[3];
#pragma unroll
    for (int i = 0; i < 3; ++i) { const int o = 64 * (wave * 3 + i) + lane, k = o / 24, sl = o - 24 * k; int c = sl - ((k >> 1) & 7); c += (c < 0) ? 24 : 0; koff[i] = k * 192 + c * 8; }
    const int vid = wave * 2;
    const bf16_t* vsrc = Vb + (size_t)(16 * (vid & 3) + (lane >> 2)) * 128 + (vid >> 2) * 32 + (lane & 3) * 8;
#define AT_ISSUE(t, slot) do { const bf16_t* ks_ = Kbh + (size_t)(t) * 64 * 192; LAS unsigned char* sb_ = ldsl + (slot) * AT_SLOT; \
        __builtin_amdgcn_global_load_lds((const unsigned*)(ks_ + koff[0]), (LAS unsigned*)(sb_ + (wave * 3 + 0) * 1024), 16, 0, 0); \
        __builtin_amdgcn_global_load_lds((const unsigned*)(ks_ + koff[1]), (LAS unsigned*)(sb_ + (wave * 3 + 1) * 1024), 16, 0, 0); \
        __builtin_amdgcn_global_load_lds((const unsigned*)(ks_ + koff[2]), (LAS unsigned*)(sb_ + (wave * 3 + 2) * 1024), 16, 0, 0); \
        const bf16_t* vs_ = vsrc + (size_t)(t) * 64 * 128; \
        __builtin_amdgcn_global_load_lds((const unsigned*)(vs_), (LAS unsigned*)(sb_ + AT_VOFF + vid * 1024), 16, 0, 0); \
        __builtin_amdgcn_global_load_lds((const unsigned*)(vs_ + (size_t)16 * 128), (LAS unsigned*)(sb_ + AT_VOFF + (vid + 1) * 1024), 16, 0, 0); } while (0)
    bf16x8 qr[12];
#pragma unroll
    for (int s = 0; s < 12; ++s) qr[s] = *(const bf16x8*)(Qw + 16 * s);
#pragma unroll
    for (int s = 0; s < 12; ++s) asm volatile("" : "+v"(qr[s]));
    AT_ISSUE(0, 0); AT_ISSUE(1, 1);
    f32x16 o[4];
#pragma unroll
    for (int d0 = 0; d0 < 4; ++d0)
#pragma unroll
        for (int r = 0; r < 16; ++r) o[d0][r] = 0.f;
    float m = -1e30f, l = 0.f;
    const int kfo = r32 * 384, kc0 = hi + ((r32 >> 1) & 7);
    const int vfo = AT_VOFF + ((lane >> 4) & 1) * 32 + (lane & 3) * 8 + (4 * hi + ((lane & 15) >> 2)) * 64;
    const int qrel = wave * 32 + r32;
    int slot = 0;
    for (int t = 0; t < NT; ++t) {
        if (t + 1 < NT) asm volatile("s_waitcnt vmcnt(5)" ::: "memory"); else asm volatile("s_waitcnt vmcnt(0)" ::: "memory");
        __builtin_amdgcn_s_barrier(); asm volatile("" ::: "memory");
        if (t + 2 < NT) { const int s2 = (slot == 0) ? 2 : slot - 1; AT_ISSUE(t + 2, s2); }
        const int jb = t - (NT - 4);
        if (!(jb >= 0 && 64 * jb > wave * 32 + 31)) {
            const LAS unsigned char* kp = ldsl + slot * AT_SLOT + kfo;
            int kc = kc0; asm volatile("" : "+v"(kc));
            f32x16 p0, p1;
#pragma unroll
            for (int r = 0; r < 16; ++r) { p0[r] = 0.f; p1[r] = 0.f; }
#pragma unroll
            for (int s = 0; s < 12; ++s) {
                int sl_ = kc + 2 * s; sl_ -= (sl_ >= 24) ? 24 : 0;
                const bf16x8 k0 = *(const LAS bf16x8*)(kp + sl_ * 16), k1 = *(const LAS bf16x8*)(kp + sl_ * 16 + 32 * 384);
                p0 = __builtin_amdgcn_mfma_f32_32x32x16_bf16(k0, qr[s], p0, 0, 0, 0);
                p1 = __builtin_amdgcn_mfma_f32_32x32x16_bf16(k1, qr[s], p1, 0, 0, 0);
            }
            if (jb >= 0 && 64 * jb + 63 > wave * 32) {
#pragma unroll
                for (int r = 0; r < 16; ++r) { const int kv = 64 * jb + crow(r, hi); if (kv > qrel) p0[r] = -INFINITY; if (kv + 32 > qrel) p1[r] = -INFINITY; }
            }
            float rm = fmaxf(p0[0], p1[0]);
#pragma unroll
            for (int r = 1; r < 16; ++r) rm = fmaxf(rm, fmaxf(p0[r], p1[r]));
            rm = fmaxf(rm, __shfl_xor(rm, 32));
            const float mn = fmaxf(m, rm);
            if (__any(mn > m)) {
                const float alpha = __builtin_amdgcn_exp2f(m - mn);
                l *= alpha;
#pragma unroll
                for (int r = 0; r < 16; ++r) { const float ar = __shfl(alpha, crow(r, hi));
#pragma unroll
                    for (int d0 = 0; d0 < 4; ++d0) o[d0][r] *= ar; }
                m = mn;
            }
            float ls = 0.f;
#pragma unroll
            for (int r = 0; r < 16; ++r) { p0[r] = __builtin_amdgcn_exp2f(p0[r] - m); p1[r] = __builtin_amdgcn_exp2f(p1[r] - m); ls += p0[r] + p1[r]; }
            l += ls;
            bf16x8 pa[4];
            { u32x4 w;
              w.x = cvtpk(p0[0], p0[1]); w.y = cvtpk(p0[2], p0[3]); w.z = cvtpk(p0[4], p0[5]); w.w = cvtpk(p0[6], p0[7]); pa[0] = __builtin_bit_cast(bf16x8, w);
              w.x = cvtpk(p0[8], p0[9]); w.y = cvtpk(p0[10], p0[11]); w.z = cvtpk(p0[12], p0[13]); w.w = cvtpk(p0[14], p0[15]); pa[1] = __builtin_bit_cast(bf16x8, w);
              w.x = cvtpk(p1[0], p1[1]); w.y = cvtpk(p1[2], p1[3]); w.z = cvtpk(p1[4], p1[5]); w.w = cvtpk(p1[6], p1[7]); pa[2] = __builtin_bit_cast(bf16x8, w);
              w.x = cvtpk(p1[8], p1[9]); w.y = cvtpk(p1[10], p1[11]); w.z = cvtpk(p1[12], p1[13]); w.w = cvtpk(p1[14], p1[15]); pa[3] = __builtin_bit_cast(bf16x8, w); }
            const unsigned vpa = (unsigned)(size_t)(ldsl + slot * AT_SLOT + vfo);
#pragma unroll
            for (int d0 = 0; d0 < 4; ++d0) {
                s16x4 lo[4], hh[4];
                TR_PAIR(lo[0], hh[0], vpa, d0 * 4096 + 0 * 1024, 512); TR_PAIR(lo[1], hh[1], vpa, d0 * 4096 + 1 * 1024, 512);
                TR_PAIR(lo[2], hh[2], vpa, d0 * 4096 + 2 * 1024, 512); TR_PAIR(lo[3], hh[3], vpa, d0 * 4096 + 3 * 1024, 512);
                LDS_WAIT_PIN();
#pragma unroll
                for (int ks = 0; ks < 4; ++ks)
                    o[d0] = __builtin_amdgcn_mfma_f32_32x32x16_bf16(pa[ks], (bf16x8){lo[ks][0], lo[ks][1], lo[ks][2], lo[ks][3], hh[ks][0], hh[ks][1], hh[ks][2], hh[ks][3]}, o[d0], 0, 0, 0);
            }
        }
        slot = (slot == 2) ? 0 : slot + 1;
    }
    l += __shfl_xor(l, 32);
    const float inv = 1.f / l;
    bf16_t* Ow = (bf16_t*)(p.ws + WS_MIXRAW) + ((size_t)b * SEQ + qb * 256 + wave * 32) * DM + h * 128 + r32;
#pragma unroll
    for (int r = 0; r < 16; ++r) { const float ir = __shfl(inv, crow(r, hi));
#pragma unroll
        for (int d0 = 0; d0 < 4; ++d0) Ow[(size_t)crow(r, hi) * DM + d0 * 32] = (bf16_t)f2bf(o[d0][r] * ir); }
    __builtin_amdgcn_sched_barrier(0);
    float ssr[16];
#pragma unroll
    for (int r = 0; r < 16; ++r) { const float ir = __shfl(inv, crow(r, hi)); const float v0 = o[0][r] * ir, v1 = o[1][r] * ir, v2 = o[2][r] * ir, v3 = o[3][r] * ir; ssr[r] = (v0 * v0 + v1 * v1) + (v2 * v2 + v3 * v3); }
    float q8[8], q4[4], q2[2], q1;
    { const bool bb = (lane & 16) != 0;
#pragma unroll
      for (int i = 0; i < 8; ++i) { const float keep = bb ? ssr[i + 8] : ssr[i], send = bb ? ssr[i] : ssr[i + 8]; q8[i] = keep + __shfl_xor(send, 16); } }
    { const bool bb = (lane & 8) != 0;
#pragma unroll
      for (int i = 0; i < 4; ++i) { const float keep = bb ? q8[i + 4] : q8[i], send = bb ? q8[i] : q8[i + 4]; q4[i] = keep + __shfl_xor(send, 8); } }
    { const bool bb = (lane & 4) != 0;
#pragma unroll
      for (int i = 0; i < 2; ++i) { const float keep = bb ? q4[i + 2] : q4[i], send = bb ? q4[i] : q4[i + 2]; q2[i] = keep + __shfl_xor(send, 4); } }
    { const bool bb = (lane & 2) != 0; const float keep = bb ? q2[1] : q2[0], send = bb ? q2[0] : q2[1]; q1 = keep + __shfl_xor(send, 2); }
    q1 += __shfl_xor(q1, 1);
    { const int rs = ((lane >> 4) & 1) * 8 + ((lane >> 3) & 1) * 4 + ((lane >> 2) & 1) * 2 + ((lane >> 1) & 1);
      if ((lane & 1) == 0) ((float*)(p.ws + WS_PSQA))[((size_t)b * SEQ + qb * 256 + wave * 32 + crow(rs, hi)) * 8 + h] = q1; }
    asm volatile("s_waitcnt lgkmcnt(0)" ::: "memory"); __builtin_amdgcn_s_barrier(); asm volatile("" ::: "memory");
#undef AT_ISSUE
}
__device__ __forceinline__ void ph_attn(const Params& p, LAS unsigned char* ldsl, int bid, int G, int wave, int lane) {
    const int vcu = (bid & 7) * (G >> 3) + (bid >> 3);
    const int bh = vcu >> 2, s = vcu & 3;
    attn_unit(p, ldsl, bh, 7 - s, wave, lane);
    attn_unit(p, ldsl, bh, s, wave, lane);
}
__device__ __forceinline__ int f2sort(float f) { const int u = __builtin_bit_cast(int, f); return u ^ ((u >> 31) & 0x7fffffff); }
__device__ __forceinline__ float sort2f(int k) { return __builtin_bit_cast(float, k ^ ((k >> 31) & 0x7fffffff)); }
#define CE_(a_, b_) do { const int hi_ = max(a_, b_); b_ = min(a_, b_); a_ = hi_; } while (0)
#define INS16(L, x) do { int x_ = (x); _Pragma("unroll") for (int i_ = 0; i_ < 16; ++i_) { const int hi_ = max(L[i_], x_); x_ = min(L[i_], x_); L[i_] = hi_; } } while (0)
#define SORT16(v) do { CE_(v[0], v[13]); CE_(v[1], v[12]); CE_(v[2], v[15]); CE_(v[3], v[14]); CE_(v[4], v[8]); CE_(v[5], v[6]); CE_(v[7], v[11]); CE_(v[9], v[10]); CE_(v[0], v[5]); CE_(v[1], v[7]); CE_(v[2], v[9]); CE_(v[3], v[4]); CE_(v[6], v[13]); CE_(v[8], v[14]); CE_(v[10], v[15]); CE_(v[11], v[12]); CE_(v[0], v[1]); CE_(v[2], v[3]); CE_(v[4], v[5]); CE_(v[6], v[8]); CE_(v[7], v[9]); CE_(v[10], v[11]); CE_(v[12], v[13]); CE_(v[14], v[15]); CE_(v[0], v[2]); CE_(v[1], v[3]); CE_(v[4], v[10]); CE_(v[5], v[11]); CE_(v[6], v[7]); CE_(v[8], v[9]); CE_(v[12], v[14]); CE_(v[13], v[15]); CE_(v[1], v[2]); CE_(v[3], v[12]); CE_(v[4], v[6]); CE_(v[5], v[7]); CE_(v[8], v[10]); CE_(v[9], v[11]); CE_(v[13], v[14]); CE_(v[1], v[4]); CE_(v[2], v[6]); CE_(v[5], v[8]); CE_(v[7], v[10]); CE_(v[9], v[13]); CE_(v[11], v[14]); CE_(v[2], v[4]); CE_(v[3], v[6]); CE_(v[9], v[12]); CE_(v[11], v[13]); CE_(v[3], v[5]); CE_(v[6], v[8]); CE_(v[7], v[9]); CE_(v[10], v[12]); CE_(v[3], v[4]); CE_(v[5], v[6]); CE_(v[7], v[8]); CE_(v[9], v[10]); CE_(v[11], v[12]); CE_(v[6], v[7]); CE_(v[8], v[9]); } while (0)
#define BMERGE16(v) do { CE_(v[0], v[8]); CE_(v[1], v[9]); CE_(v[2], v[10]); CE_(v[3], v[11]); CE_(v[4], v[12]); CE_(v[5], v[13]); CE_(v[6], v[14]); CE_(v[7], v[15]); CE_(v[0], v[4]); CE_(v[1], v[5]); CE_(v[2], v[6]); CE_(v[3], v[7]); CE_(v[8], v[12]); CE_(v[9], v[13]); CE_(v[10], v[14]); CE_(v[11], v[15]); CE_(v[0], v[2]); CE_(v[1], v[3]); CE_(v[4], v[6]); CE_(v[5], v[7]); CE_(v[8], v[10]); CE_(v[9], v[11]); CE_(v[12], v[14]); CE_(v[13], v[15]); CE_(v[0], v[1]); CE_(v[2], v[3]); CE_(v[4], v[5]); CE_(v[6], v[7]); CE_(v[8], v[9]); CE_(v[10], v[11]); CE_(v[12], v[13]); CE_(v[14], v[15]); } while (0)
__device__ __forceinline__ void ph_route(const Params& p, LAS unsigned char* ldsl, int wave, int lane, int gwave, int gnw) {
    const int r32 = lane & 31, hi = lane >> 5;
    const bf16_t* SK = (const bf16_t*)(p.ws + WS_SUBK);
    LAS unsigned char* tab = ldsl + wave * 4096 + lane * 32;
    for (int item = gwave; item < (T / 32) * 8; item += gnw) {
        const int tile = item >> 3, h = item & 7, t0 = tile * 32;
        int hi4 = hi * 4; asm volatile("" : "+v"(hi4));
        int S0[16], S1[16];
#pragma unroll
        for (int j = 0; j < 2; ++j) {
            const bf16_t* qp = (const bf16_t*)(p.ws + WS_QP) + (size_t)(t0 + r32) * DM + h * 256 + j * 128 + 8 * hi;
            asm volatile("" : "+v"(qp));
            bf16x8 bq[8];
#pragma unroll
            for (int s = 0; s < 8; ++s) bq[s] = *(const bf16x8*)(qp + 16 * s);
            int L[16];
#pragma unroll
            for (int kb = 0; kb < 4; ++kb) {
                const bf16_t* ap = SK + ((size_t)(h * 2 + j) * 128 + kb * 32 + r32) * 128 + 8 * hi;
                asm volatile("" : "+v"(ap));
                f32x16 acc;
#pragma unroll
                for (int r = 0; r < 16; ++r) acc[r] = 0.f;
#pragma unroll
                for (int s = 0; s < 8; ++s) acc = __builtin_amdgcn_mfma_f32_32x32x16_bf16(*(const bf16x8*)(ap + 16 * s), bq[s], acc, 0, 0, 0);
                int v[16];
#pragma unroll
                for (int r = 0; r < 16; ++r) v[r] = (f2sort(acc[r]) & ~127) | ((127 - (kb * 32 + (r & 3) + 8 * (r >> 2))) - hi4);
                SORT16(v);
                if (kb == 0) {
#pragma unroll
                    for (int i = 0; i < 16; ++i) L[i] = v[i];
                } else {
#pragma unroll
                    for (int i = 0; i < 16; ++i) L[i] = max(L[i], v[15 - i]);
                    BMERGE16(L);
                }
                __builtin_amdgcn_sched_barrier(0);
            }
            int Y[16];
#pragma unroll
            for (int i = 0; i < 16; ++i) Y[i] = __shfl_xor(L[i], 32);
#pragma unroll
            for (int i = 0; i < 16; ++i) L[i] = max(L[i], Y[15 - i]);
            BMERGE16(L);
#pragma unroll
            for (int i = 0; i < 16; ++i) { if (j == 0) S0[i] = L[i]; else S1[i] = L[i]; }
        }
        float f0[16], f1[16];
        {
            unsigned w0[4], w1[4];
#pragma unroll
            for (int i = 0; i < 16; ++i) { f0[i] = sort2f(S0[i] & ~127); f1[i] = sort2f(S1[i] & ~127); }
#pragma unroll
            for (int q = 0; q < 4; ++q) {
                w0[q] = (unsigned)(127 - (S0[4 * q] & 127)) | ((unsigned)(127 - (S0[4 * q + 1] & 127)) << 8) | ((unsigned)(127 - (S0[4 * q + 2] & 127)) << 16) | ((unsigned)(127 - (S0[4 * q + 3] & 127)) << 24);
                w1[q] = (unsigned)(127 - (S1[4 * q] & 127)) | ((unsigned)(127 - (S1[4 * q + 1] & 127)) << 8) | ((unsigned)(127 - (S1[4 * q + 2] & 127)) << 16) | ((unsigned)(127 - (S1[4 * q + 3] & 127)) << 24);
            }
            *(LAS u32x4*)(tab) = (u32x4){w0[0], w0[1], w0[2], w0[3]};
            *(LAS u32x4*)(tab + 16) = (u32x4){w1[0], w1[1], w1[2], w1[3]};
        }
        int Lv[16];
        Lv[0] = (f2sort(f0[0] + f1[0]) & ~255) | 255;
        Lv[1] = (f2sort(f0[0] + f1[1]) & ~255) | 254;
        Lv[2] = (f2sort(f0[0] + f1[2]) & ~255) | 253;
        Lv[3] = (f2sort(f0[0] + f1[3]) & ~255) | 252;
        Lv[4] = (f2sort(f0[0] + f1[4]) & ~255) | 251;
        Lv[5] = (f2sort(f0[0] + f1[5]) & ~255) | 250;
        Lv[6] = (f2sort(f0[0] + f1[6]) & ~255) | 249;
        Lv[7] = (f2sort(f0[0] + f1[7]) & ~255) | 248;
        Lv[8] = (f2sort(f0[0] + f1[8]) & ~255) | 247;
        Lv[9] = (f2sort(f0[0] + f1[9]) & ~255) | 246;
        Lv[10] = (f2sort(f0[0] + f1[10]) & ~255) | 245;
        Lv[11] = (f2sort(f0[0] + f1[11]) & ~255) | 244;
        Lv[12] = (f2sort(f0[0] + f1[12]) & ~255) | 243;
        Lv[13] = (f2sort(f0[0] + f1[13]) & ~255) | 242;
        Lv[14] = (f2sort(f0[0] + f1[14]) & ~255) | 241;
        Lv[15] = (f2sort(f0[0] + f1[15]) & ~255) | 240;
        { int cv_ = (f2sort(f0[1] + f1[0]) & ~255) | 239; INS16(Lv, cv_); __builtin_amdgcn_sched_barrier(0); }
        { int cv_ = (f2sort(f0[1] + f1[1]) & ~255) | 238; INS16(Lv, cv_); __builtin_amdgcn_sched_barrier(0); }
        { int cv_ = (f2sort(f0[1] + f1[2]) & ~255) | 237; INS16(Lv, cv_); __builtin_amdgcn_sched_barrier(0); }
        { int cv_ = (f2sort(f0[1] + f1[3]) & ~255) | 236; INS16(Lv, cv_); __builtin_amdgcn_sched_barrier(0); }
        { int cv_ = (f2sort(f0[1] + f1[4]) & ~255) | 235; INS16(Lv, cv_); __builtin_amdgcn_sched_barrier(0); }
        { int cv_ = (f2sort(f0[1] + f1[5]) & ~255) | 234; INS16(Lv, cv_); __builtin_amdgcn_sched_barrier(0); }
        { int cv_ = (f2sort(f0[1] + f1[6]) & ~255) | 233; INS16(Lv, cv_); __builtin_amdgcn_sched_barrier(0); }
        { int cv_ = (f2sort(f0[1] + f1[7]) & ~255) | 232; INS16(Lv, cv_); __builtin_amdgcn_sched_barrier(0); }
        { int cv_ = (f2sort(f0[2] + f1[0]) & ~255) | 223; INS16(Lv, cv_); __builtin_amdgcn_sched_barrier(0); }
        { int cv_ = (f2sort(f0[2] + f1[1]) & ~255) | 222; INS16(Lv, cv_); __builtin_amdgcn_sched_barrier(0); }
        { int cv_ = (f2sort(f0[2] + f1[2]) & ~255) | 221; INS16(Lv, cv_); __builtin_amdgcn_sched_barrier(0); }
        { int cv_ = (f2sort(f0[2] + f1[3]) & ~255) | 220; INS16(Lv, cv_); __builtin_amdgcn_sched_barrier(0); }
        { int cv_ = (f2sort(f0[2] + f1[4]) & ~255) | 219; INS16(Lv, cv_); __builtin_amdgcn_sched_barrier(0); }
        { int cv_ = (f2sort(f0[3] + f1[0]) & ~255) | 207; INS16(Lv, cv_); __builtin_amdgcn_sched_barrier(0); }
        { int cv_ = (f2sort(f0[3] + f1[1]) & ~255) | 206; INS16(Lv, cv_); __builtin_amdgcn_sched_barrier(0); }
        { int cv_ = (f2sort(f0[3] + f1[2]) & ~255) | 205; INS16(Lv, cv_); __builtin_amdgcn_sched_barrier(0); }
        { int cv_ = (f2sort(f0[3] + f1[3]) & ~255) | 204; INS16(Lv, cv_); __builtin_amdgcn_sched_barrier(0); }
        { int cv_ = (f2sort(f0[4] + f1[0]) & ~255) | 191; INS16(Lv, cv_); __builtin_amdgcn_sched_barrier(0); }
        { int cv_ = (f2sort(f0[4] + f1[1]) & ~255) | 190; INS16(Lv, cv_); __builtin_amdgcn_sched_barrier(0); }
        { int cv_ = (f2sort(f0[4] + f1[2]) & ~255) | 189; INS16(Lv, cv_); __builtin_amdgcn_sched_barrier(0); }
        { int cv_ = (f2sort(f0[5] + f1[0]) & ~255) | 175; INS16(Lv, cv_); __builtin_amdgcn_sched_barrier(0); }
        { int cv_ = (f2sort(f0[5] + f1[1]) & ~255) | 174; INS16(Lv, cv_); __builtin_amdgcn_sched_barrier(0); }
        { int cv_ = (f2sort(f0[6] + f1[0]) & ~255) | 159; INS16(Lv, cv_); __builtin_amdgcn_sched_barrier(0); }
        { int cv_ = (f2sort(f0[6] + f1[1]) & ~255) | 158; INS16(Lv, cv_); __builtin_amdgcn_sched_barrier(0); }
        { int cv_ = (f2sort(f0[7] + f1[0]) & ~255) | 143; INS16(Lv, cv_); __builtin_amdgcn_sched_barrier(0); }
        { int cv_ = (f2sort(f0[7] + f1[1]) & ~255) | 142; INS16(Lv, cv_); __builtin_amdgcn_sched_barrier(0); }
        { int cv_ = (f2sort(f0[8] + f1[0]) & ~255) | 127; INS16(Lv, cv_); __builtin_amdgcn_sched_barrier(0); }
        { int cv_ = (f2sort(f0[9] + f1[0]) & ~255) | 111; INS16(Lv, cv_); __builtin_amdgcn_sched_barrier(0); }
        { int cv_ = (f2sort(f0[10] + f1[0]) & ~255) | 95; INS16(Lv, cv_); __builtin_amdgcn_sched_barrier(0); }
        { int cv_ = (f2sort(f0[11] + f1[0]) & ~255) | 79; INS16(Lv, cv_); __builtin_amdgcn_sched_barrier(0); }
        { int cv_ = (f2sort(f0[12] + f1[0]) & ~255) | 63; INS16(Lv, cv_); __builtin_amdgcn_sched_barrier(0); }
        { int cv_ = (f2sort(f0[13] + f1[0]) & ~255) | 47; INS16(Lv, cv_); __builtin_amdgcn_sched_barrier(0); }
        { int cv_ = (f2sort(f0[14] + f1[0]) & ~255) | 31; INS16(Lv, cv_); __builtin_amdgcn_sched_barrier(0); }
        { int cv_ = (f2sort(f0[15] + f1[0]) & ~255) | 15; INS16(Lv, cv_); __builtin_amdgcn_sched_barrier(0); }
        float g[16]; float sum = 0.f; const float mx = sort2f(Lv[0] & ~255);
        int Le[16];
#pragma unroll
        for (int i = 0; i < 16; ++i) {
            g[i] = __expf(sort2f(Lv[i] & ~255) - mx); sum += g[i];
            const int pos = 255 - (Lv[i] & 255);
            const int ia = *(const LAS unsigned char*)(tab + (pos >> 4)), ib = *(const LAS unsigned char*)(tab + 16 + (pos & 15));
            Le[i] = ia * 128 + ib;
        }
        const float inv = 1.f / sum;
        if (hi == 0) {
            int* ip = (int*)(p.ws + WS_IDX) + (size_t)(t0 + r32) * 128 + h * 16; float* gp = (float*)(p.ws + WS_GATE) + (size_t)(t0 + r32) * 128 + h * 16;
#pragma unroll
            for (int i = 0; i < 4; ++i) {
                *(u32x4*)(ip + 4 * i) = (u32x4){(unsigned)Le[4 * i], (unsigned)Le[4 * i + 1], (unsigned)Le[4 * i + 2], (unsigned)Le[4 * i + 3]};
                *(f32x4*)(gp + 4 * i) = (f32x4){g[4 * i] * inv, g[4 * i + 1] * inv, g[4 * i + 2] * inv, g[4 * i + 3] * inv};
            }
        }
        asm volatile("s_waitcnt lgkmcnt(0)" ::: "memory");
    }
}
__device__ __forceinline__ void ph_conv(const Params& p, int gwave, int gnw, int lane) {
    const bf16_t* proj = (const bf16_t*)(p.ws + WS_PROJ);
    bf16_t* xa = (bf16_t*)(p.ws + WS_XBCA);
    for (int task = gwave; task < 1536 + 256; task += gnw) {
        if (task < 1536) {
            const int run = task / 3, cg = (task % 3) * 64 + lane, c0 = cg * 8;
            const int t0 = run * 32, s0 = t0 % SEQ;
            float w0[8], w1[8], w2[8], w3[8], bs[8], h1[8], h2[8], h3[8];
#pragma unroll
            for (int i = 0; i < 8; ++i) { w0[i] = p.conv_w[0 * 1536 + c0 + i]; w1[i] = p.conv_w[1 * 1536 + c0 + i]; w2[i] = p.conv_w[2 * 1536 + c0 + i]; w3[i] = p.conv_w[3 * 1536 + c0 + i]; bs[i] = p.conv_b[c0 + i]; h1[i] = 0.f; h2[i] = 0.f; h3[i] = 0.f; }
            const bf16_t* src = proj + (size_t)t0 * NPROJ + C_XBC + c0;
            if (s0 > 0) {
                const u32x4 a = *(const u32x4*)(src - (size_t)1 * NPROJ), b = *(const u32x4*)(src - (size_t)2 * NPROJ), c = *(const u32x4*)(src - (size_t)3 * NPROJ);
                h1[0] = bflo(a.x); h1[1] = bfhi(a.x); h1[2] = bflo(a.y); h1[3] = bfhi(a.y); h1[4] = bflo(a.z); h1[5] = bfhi(a.z); h1[6] = bflo(a.w); h1[7] = bfhi(a.w);
                h2[0] = bflo(b.x); h2[1] = bfhi(b.x); h2[2] = bflo(b.y); h2[3] = bfhi(b.y); h2[4] = bflo(b.z); h2[5] = bfhi(b.z); h2[6] = bflo(b.w); h2[7] = bfhi(b.w);
                h3[0] = bflo(c.x); h3[1] = bfhi(c.x); h3[2] = bflo(c.y); h3[3] = bfhi(c.y); h3[4] = bflo(c.z); h3[5] = bfhi(c.z); h3[6] = bflo(c.w); h3[7] = bfhi(c.w);
            }
            bf16_t* dst = xa + (size_t)t0 * 1536 + c0;
#pragma unroll 16
            for (int i = 0; i < 32; ++i) {
                const u32x4 a = *(const u32x4*)(src + (size_t)i * NPROJ);
                float cur[8] = {bflo(a.x), bfhi(a.x), bflo(a.y), bfhi(a.y), bflo(a.z), bfhi(a.z), bflo(a.w), bfhi(a.w)};
                float o[8];
#pragma unroll
                for (int k = 0; k < 8; ++k) { o[k] = silu_fast(bs[k] + w3[k] * cur[k] + w2[k] * h1[k] + w1[k] * h2[k] + w0[k] * h3[k]); h3[k] = h2[k]; h2[k] = h1[k]; h1[k] = cur[k]; }
                u32x4 w; w.x = pk2(o[0], o[1]); w.y = pk2(o[2], o[3]); w.z = pk2(o[4], o[5]); w.w = pk2(o[6], o[7]);
                *(u32x4*)(dst + (size_t)i * 1536) = w;
            }
        } else {
            const int t = (task - 1536) * 64 + lane;
            const u32x4 a = *(const u32x4*)(proj + (size_t)t * NPROJ + C_DT), b = *(const u32x4*)(proj + (size_t)t * NPROJ + C_DT + 8);
            const float raw[16] = {bflo(a.x), bfhi(a.x), bflo(a.y), bfhi(a.y), bflo(a.z), bfhi(a.z), bflo(a.w), bfhi(a.w), bflo(b.x), bfhi(b.x), bflo(b.y), bfhi(b.y), bflo(b.z), bfhi(b.z), bflo(b.w), bfhi(b.w)};
            float* dto = (float*)(p.ws + WS_DT) + (size_t)t * 16; float* cso = (float*)(p.ws + WS_CS) + (size_t)t * 16;
            float dtv[16], csv[16];
#pragma unroll
            for (int hh = 0; hh < 16; ++hh) {
                const float v = raw[hh] + p.dt_bias[hh];
                const float dt = (v > 20.f) ? v : log1pf(__expf(v));
                float c = dt * (-__expf(p.a_log[hh]));
#pragma unroll
                for (int o = 1; o < 64; o <<= 1) { const float u = __shfl_up(c, o); if (lane >= o) c += u; }
                dtv[hh] = dt; csv[hh] = c;
            }
#pragma unroll
            for (int q = 0; q < 4; ++q) { *(f32x4*)(dto + 4 * q) = (f32x4){dtv[4 * q], dtv[4 * q + 1], dtv[4 * q + 2], dtv[4 * q + 3]}; *(f32x4*)(cso + 4 * q) = (f32x4){csv[4 * q], csv[4 * q + 1], csv[4 * q + 2], csv[4 * q + 3]}; }
        }
    }
}
constexpr int P4_ROW = 1152;
__device__ __forceinline__ void fp4_row_load(const Params& p, int row, int lane, f32x4 (&v)[8]) {
    const f32x4* src = (const f32x4*)(((row >= 16384) ? p.v_exp : p.u_exp) + (size_t)(row & 16383) * DM) + lane;
#pragma unroll
    for (int j = 0; j < 8; ++j) v[j] = src[64 * j];
}
__device__ __forceinline__ void fp4_row_store(const Params& p, int row, int lane, const f32x4 (&v)[8]) {
    float mx = 0.f;
#pragma unroll
    for (int j = 0; j < 8; ++j) mx = fmaxf(mx, fmaxf(fmaxf(fabsf(v[j].x), fabsf(v[j].y)), fmaxf(fabsf(v[j].z), fabsf(v[j].w))));
    unsigned sb = f2bf(mx * (1.f / 6.f));
    if (bf2f(sb) * 6.f < mx) sb += 1u;
    if (sb == 0u) sb = 0x3f80u;
    const float inv = 1.f / bf2f(sb);
    unsigned w[4];
#pragma unroll
    for (int q = 0; q < 4; ++q) {
        const f32x4 a = v[2 * q] * inv, b = v[2 * q + 1] * inv;
        unsigned r = 0u;
        r = __builtin_amdgcn_cvt_scalef32_pk_fp4_f32(r, a.x, a.y, 1.0f, 0);
        r = __builtin_amdgcn_cvt_scalef32_pk_fp4_f32(r, a.z, a.w, 1.0f, 1);
        r = __builtin_amdgcn_cvt_scalef32_pk_fp4_f32(r, b.x, b.y, 1.0f, 2);
        r = __builtin_amdgcn_cvt_scalef32_pk_fp4_f32(r, b.z, b.w, 1.0f, 3);
        w[q] = r;
    }
    unsigned char* dst = p.ws + ((row >= 16384) ? WS_V4 : WS_U4) + (size_t)(row & 16383) * P4_ROW;
    *(u32x4*)(dst + lane * 16) = (u32x4){w[0], w[1], w[2], w[3]};
    *(unsigned short*)(dst + 1024 + lane * 2) = (unsigned short)sb;
}
constexpr int SSD_IN = 41472, SSD_BM = 0, SSD_CM = 16384, SSD_XS = 32768, SSD_Z = 36864, SSD_DT = 40960, SSD_CS = 41216, SSD_ST = 3 * SSD_IN, SSD_PART = SSD_ST + 16384, SSD_SYNC = SSD_PART + 4096;
__device__ __forceinline__ void ssd_decay_block(f32x16& cbt, const f32x4 (&c4)[4], const f32x4 (&d4)[4], float cs_l, int sb, int l, int hi, bool diag) {
#pragma unroll
    for (int q = 0; q < 4; ++q) {
#pragma unroll
        for (int i = 0; i < 4; ++i) {
            const int s = 32 * sb + 8 * q + 4 * hi + i;
            float e = __expf(cs_l - c4[q][i]) * d4[q][i];
            if (diag) e = (s <= l) ? e : 0.f;
            cbt[4 * q + i] *= e;
        }
    }
}
__device__ __forceinline__ void ph_ssd(const Params& p, LAS unsigned char* ldsl, int bid, int wave, int lane) {
    const int b = bid >> 5, h = (bid >> 1) & 15, ph = bid & 1, g = h >> 3;
    const int r32 = lane & 31, hi = lane >> 5;
    const size_t tb0 = (size_t)b * SEQ;
    LAS unsigned* sync = (LAS unsigned*)(ldsl + SSD_SYNC);
    if (threadIdx.x < 16) sync[threadIdx.x] = (threadIdx.x >= 14) ? 0xffffffffu : 0u;
    for (int i = threadIdx.x; i < 8192 / 16; i += NTHR) *(LAS u32x4*)(ldsl + SSD_ST + i * 16) = (u32x4){0u, 0u, 0u, 0u};
    asm volatile("s_waitcnt lgkmcnt(0)" ::: "memory"); __builtin_amdgcn_s_barrier(); asm volatile("" ::: "memory");
    if (wave >= 6) {
        const int cvw = bid * 2 + (wave - 6);
        f32x4 ra[8], rb[8], rc[8], rd[8];
        fp4_row_load(p, cvw, lane, ra); fp4_row_load(p, 512 + cvw, lane, rb); fp4_row_load(p, 1024 + cvw, lane, rc); fp4_row_load(p, 1536 + cvw, lane, rd);
        for (int c = 0; c < 16; ++c) {
            fp4_row_store(p, (4 * c) * 512 + cvw, lane, ra);
            if (c + 1 < 16) fp4_row_load(p, (4 * c + 4) * 512 + cvw, lane, ra);
            fp4_row_store(p, (4 * c + 1) * 512 + cvw, lane, rb);
            if (c + 1 < 16) fp4_row_load(p, (4 * c + 5) * 512 + cvw, lane, rb);
            fp4_row_store(p, (4 * c + 2) * 512 + cvw, lane, rc);
            if (c + 1 < 16) fp4_row_load(p, (4 * c + 6) * 512 + cvw, lane, rc);
            fp4_row_store(p, (4 * c + 3) * 512 + cvw, lane, rd);
            if (c + 1 < 16) fp4_row_load(p, (4 * c + 7) * 512 + cvw, lane, rd);
        }
    } else {
        const bf16_t* xa = (const bf16_t*)(p.ws + WS_XBCA); const bf16_t* proj = (const bf16_t*)(p.ws + WS_PROJ);
        const float dsk = p.d_skip[h];
        const int dq = (wave - 2) & 3;
        const int dr0 = 4 * dq + (lane >> 4);
        const bf16_t* bsrc = xa + (tb0 + dr0) * 1536 + 1024 + g * 128 + (((lane & 15) ^ (dr0 & 15)) * 8);
        const bf16_t* csrc = xa + (tb0 + dr0) * 1536 + 1280 + g * 128 + (((lane & 15) ^ (dr0 & 15)) * 8);
        const bf16_t* xsrc = xa + (tb0 + 16 * dq + (lane >> 2)) * 1536 + h * 64 + ph * 32 + (lane & 3) * 8;
        const bf16_t* zsrc = proj + (tb0 + 16 * dq + (lane >> 2)) * NPROJ + C_Z + h * 64 + ph * 32 + (lane & 3) * 8;
        const float* dsrc = (const float*)(p.ws + ((dq == 0) ? WS_DT : WS_CS)) + (tb0 + lane) * 16 + h;
#define SSD_G16(src, dst) __builtin_amdgcn_global_load_lds((const unsigned*)(src), (LAS unsigned*)(dst), 16, 0, 0)
#define SSD_ISSUE(c, buf) do { if (wave >= 2) { LAS unsigned char* in_ = ldsl + (buf) * SSD_IN; const size_t to_ = (size_t)(c) * 64 * 1536; \
        SSD_G16(bsrc + to_, in_ + SSD_BM + dq * 1024); SSD_G16(bsrc + to_ + 16 * 1536, in_ + SSD_BM + (dq + 4) * 1024); SSD_G16(bsrc + to_ + 32 * 1536, in_ + SSD_BM + (dq + 8) * 1024); SSD_G16(bsrc + to_ + 48 * 1536, in_ + SSD_BM + (dq + 12) * 1024); \
        SSD_G16(csrc + to_, in_ + SSD_CM + dq * 1024); SSD_G16(csrc + to_ + 16 * 1536, in_ + SSD_CM + (dq + 4) * 1024); SSD_G16(csrc + to_ + 32 * 1536, in_ + SSD_CM + (dq + 8) * 1024); SSD_G16(csrc + to_ + 48 * 1536, in_ + SSD_CM + (dq + 12) * 1024); \
        SSD_G16(xsrc + to_, in_ + SSD_XS + dq * 1024); SSD_G16(zsrc + (size_t)(c) * 64 * NPROJ, in_ + SSD_Z + dq * 1024); \
        if (dq < 2) __builtin_amdgcn_global_load_lds((const unsigned*)(dsrc + (size_t)(c) * 64 * 16), (LAS unsigned*)(in_ + ((dq == 0) ? SSD_DT : SSD_CS)), 4, 0, 0); } } while (0)
        f32x16 S;
#pragma unroll
        for (int r = 0; r < 16; ++r) S[r] = 0.f;
        SSD_ISSUE(0, 0); SSD_ISSUE(1, 1);
        const int xfo = ((lane >> 4) & 1) * 32 + (lane & 3) * 8 + (4 * hi + ((lane & 15) >> 2)) * 64;
        for (int c = 0; c < SEQ / 64; ++c) {
            if (wave >= 2) { if (c + 1 >= SEQ / 64) asm volatile("s_waitcnt vmcnt(0)" ::: "memory"); else if (dq < 2) asm volatile("s_waitcnt vmcnt(11)" ::: "memory"); else asm volatile("s_waitcnt vmcnt(10)" ::: "memory"); }
            asm volatile("s_waitcnt lgkmcnt(0)" ::: "memory");
            {
                const unsigned sa = (unsigned)(size_t)(ldsl + SSD_SYNC), tgt = (unsigned)(c + 1);
                asm volatile("ds_write_b32 %0, %1" :: "v"(sa + 32u + 4u * (unsigned)wave), "v"(tgt) : "memory");
                for (;;) { u32x4 a, b_; asm volatile("ds_read_b128 %0, %2 offset:32\n\tds_read_b128 %1, %2 offset:48\n\ts_waitcnt lgkmcnt(0)" : "=&v"(a), "=&v"(b_) : "v"(sa) : "memory");
                    const unsigned m = min(min(min(a.x, a.y), min(a.z, a.w)), min(min(b_.x, b_.y), min(b_.z, b_.w)));
                    if (__builtin_amdgcn_readfirstlane(m) >= tgt) break; __builtin_amdgcn_s_sleep(1); }
            }
            asm volatile("" ::: "memory");
            if (c + 2 < SEQ / 64) SSD_ISSUE(c + 2, (c + 2) % 3);
            const LAS unsigned char* in = ldsl + (c % 3) * SSD_IN;
            const LAS unsigned char* STin = ldsl + SSD_ST + (c & 1) * 8192;
            LAS unsigned char* STout = ldsl + SSD_ST + ((c + 1) & 1) * 8192;
            const LAS float* dtl = (const LAS float*)(in + SSD_DT); const LAS float* csl = (const LAS float*)(in + SSD_CS);
            if (wave < 2) {
                const int lb = wave, l = 32 * lb + r32;
                const unsigned xpa = (unsigned)(size_t)(in + SSD_XS + xfo + (32 * lb) * 64);
                s16x4 lo0, hh0, lo1, hh1; TR_PAIR(lo0, hh0, xpa, 0, 512); TR_PAIR(lo1, hh1, xpa, 1024, 512);
                const int l1 = 32 + r32;
                const float cs_l = csl[l], cs_l1 = csl[l1];
                bf16x8 cf[8], bdf[8], cf1[8]; f32x4 c4[4], d4[4];
#pragma unroll
                for (int ks = 0; ks < 8; ++ks) {
                    cf[ks] = *(const LAS bf16x8*)(in + SSD_CM + l * 256 + (((2 * ks + hi) ^ (l & 15)) << 4));
                    bdf[ks] = *(const LAS bf16x8*)(in + SSD_BM + l * 256 + (((2 * ks + hi) ^ (l & 15)) << 4));
                    if (wave == 0) cf1[ks] = *(const LAS bf16x8*)(in + SSD_CM + l1 * 256 + (((2 * ks + hi) ^ (l1 & 15)) << 4));
                }
                LDS_WAIT_PIN();
#pragma unroll
                for (int q = 0; q < 4; ++q) { c4[q] = *(const LAS f32x4*)(csl + 32 * lb + 8 * q + 4 * hi); d4[q] = *(const LAS f32x4*)(dtl + 32 * lb + 8 * q + 4 * hi); }
                const bf16x8 xf0 = (bf16x8){lo0[0], lo0[1], lo0[2], lo0[3], hh0[0], hh0[1], hh0[2], hh0[3]}, xf1 = (bf16x8){lo1[0], lo1[1], lo1[2], lo1[3], hh1[0], hh1[1], hh1[2], hh1[3]};
                if (wave == 0) {
                    f32x16 ca, cb;
#pragma unroll
                    for (int r = 0; r < 16; ++r) { ca[r] = 0.f; cb[r] = 0.f; }
#pragma unroll
                    for (int ks = 0; ks < 8; ks += 2) { ca = __builtin_amdgcn_mfma_f32_32x32x16_bf16(bdf[ks], cf1[ks], ca, 0, 0, 0); cb = __builtin_amdgcn_mfma_f32_32x32x16_bf16(bdf[ks + 1], cf1[ks + 1], cb, 0, 0, 0); }
                    ca += cb;
                    ssd_decay_block(ca, c4, d4, cs_l1, 0, l1, hi, false);
                    u32x4 w0, w1;
                    w0.x = cvtpk(ca[0], ca[1]); w0.y = cvtpk(ca[2], ca[3]); w0.z = cvtpk(ca[4], ca[5]); w0.w = cvtpk(ca[6], ca[7]);
                    w1.x = cvtpk(ca[8], ca[9]); w1.y = cvtpk(ca[10], ca[11]); w1.z = cvtpk(ca[12], ca[13]); w1.w = cvtpk(ca[14], ca[15]);
                    f32x16 pa;
#pragma unroll
                    for (int r = 0; r < 16; ++r) pa[r] = 0.f;
                    pa = __builtin_amdgcn_mfma_f32_32x32x16_bf16(xf0, __builtin_bit_cast(bf16x8, w0), pa, 0, 0, 0);
                    pa = __builtin_amdgcn_mfma_f32_32x32x16_bf16(xf1, __builtin_bit_cast(bf16x8, w1), pa, 0, 0, 0);
                    LAS unsigned char* pp = ldsl + SSD_PART + lane * 64;
#pragma unroll
                    for (int q = 0; q < 4; ++q) *(LAS f32x4*)(pp + q * 16) = (f32x4){pa[4 * q], pa[4 * q + 1], pa[4 * q + 2], pa[4 * q + 3]};
                    asm volatile("s_waitcnt lgkmcnt(0)" ::: "memory");
                    asm volatile("ds_write_b32 %0, %1" :: "v"((unsigned)(size_t)(ldsl + SSD_SYNC) + 4u), "v"((unsigned)(c + 1)) : "memory");
                }
                f32x16 acc;
                {
                    f32x16 ca, cb;
#pragma unroll
                    for (int r = 0; r < 16; ++r) { ca[r] = 0.f; cb[r] = 0.f; acc[r] = 0.f; }
#pragma unroll
                    for (int ks = 0; ks < 8; ks += 2) { ca = __builtin_amdgcn_mfma_f32_32x32x16_bf16(bdf[ks], cf[ks], ca, 0, 0, 0); cb = __builtin_amdgcn_mfma_f32_32x32x16_bf16(bdf[ks + 1], cf[ks + 1], cb, 0, 0, 0); }
                    ca += cb;
                    ssd_decay_block(ca, c4, d4, cs_l, lb, l, hi, true);
                    u32x4 w0, w1;
                    w0.x = cvtpk(ca[0], ca[1]); w0.y = cvtpk(ca[2], ca[3]); w0.z = cvtpk(ca[4], ca[5]); w0.w = cvtpk(ca[6], ca[7]);
                    w1.x = cvtpk(ca[8], ca[9]); w1.y = cvtpk(ca[10], ca[11]); w1.z = cvtpk(ca[12], ca[13]); w1.w = cvtpk(ca[14], ca[15]);
                    acc = __builtin_amdgcn_mfma_f32_32x32x16_bf16(xf0, __builtin_bit_cast(bf16x8, w0), acc, 0, 0, 0);
                    acc = __builtin_amdgcn_mfma_f32_32x32x16_bf16(xf1, __builtin_bit_cast(bf16x8, w1), acc, 0, 0, 0);
                }
                {
                    f32x16 ya, yb;
#pragma unroll
                    for (int r = 0; r < 16; ++r) { ya[r] = 0.f; yb[r] = 0.f; }
#pragma unroll
                    for (int ks = 0; ks < 8; ks += 2) { ya = __builtin_amdgcn_mfma_f32_32x32x16_bf16(*(const LAS bf16x8*)(STin + (2 * ks + hi) * 512 + r32 * 16), cf[ks], ya, 0, 0, 0); yb = __builtin_amdgcn_mfma_f32_32x32x16_bf16(*(const LAS bf16x8*)(STin + (2 * ks + 2 + hi) * 512 + r32 * 16), cf[ks + 1], yb, 0, 0, 0); }
                    const float ecs = __expf(cs_l);
#pragma unroll
                    for (int r = 0; r < 16; ++r) acc[r] += (ya[r] + yb[r]) * ecs;
                }
                if (wave == 1) {
                    for (;;) { unsigned fl; asm volatile("ds_read_b32 %0, %1 offset:4\n\ts_waitcnt lgkmcnt(0)" : "=&v"(fl) : "v"((unsigned)(size_t)(ldsl + SSD_SYNC)) : "memory");
                        if (__builtin_amdgcn_readfirstlane(fl) >= (unsigned)(c + 1)) break; __builtin_amdgcn_s_sleep(1); }
                    asm volatile("" ::: "memory");
                    const LAS unsigned char* pp = ldsl + SSD_PART + lane * 64;
#pragma unroll
                    for (int q = 0; q < 4; ++q) { const f32x4 v = *(const LAS f32x4*)(pp + q * 16); acc[4 * q] += v[0]; acc[4 * q + 1] += v[1]; acc[4 * q + 2] += v[2]; acc[4 * q + 3] += v[3]; }
                }
                float yss = 0.f;
                {
                    LAS unsigned char* zrow = (LAS unsigned char*)(ldsl + (c % 3) * SSD_IN + SSD_Z) + l * 64 + 8 * hi;
                    u32x2 xw[4], zw[4];
#pragma unroll
                    for (int q = 0; q < 4; ++q) { xw[q] = *(const LAS u32x2*)(in + SSD_XS + l * 64 + (8 * q + 4 * hi) * 2); zw[q] = *(const LAS u32x2*)(zrow + 16 * q); }
#pragma unroll
                    for (int q = 0; q < 4; ++q) {
                        const float y0 = (acc[4 * q + 0] + dsk * bflo(xw[q].x)) * silu_fast(bflo(zw[q].x)), y1 = (acc[4 * q + 1] + dsk * bfhi(xw[q].x)) * silu_fast(bfhi(zw[q].x));
                        const float y2 = (acc[4 * q + 2] + dsk * bflo(xw[q].y)) * silu_fast(bflo(zw[q].y)), y3 = (acc[4 * q + 3] + dsk * bfhi(xw[q].y)) * silu_fast(bfhi(zw[q].y));
                        yss += (y0 * y0 + y1 * y1) + (y2 * y2 + y3 * y3);
                        u32x2 o; o.x = pk2(y0, y1); o.y = pk2(y2, y3);
                        *(LAS u32x2*)(zrow + 16 * q) = o;
                    }
                    asm volatile("s_waitcnt lgkmcnt(0)" ::: "memory");
                    const LAS unsigned char* zt = (const LAS unsigned char*)(ldsl + (c % 3) * SSD_IN + SSD_Z) + (32 * lb + (lane >> 2)) * 64 + (lane & 3) * 16;
                    bf16_t* yo = (bf16_t*)(p.ws + WS_MIXRAW) + (tb0 + (size_t)c * 64 + 32 * lb + (lane >> 2)) * DM + 1024 + h * 64 + ph * 32 + (lane & 3) * 8;
                    const u32x4 o0 = *(const LAS u32x4*)(zt), o1 = *(const LAS u32x4*)(zt + 16 * 64);
                    *(u32x4*)(yo) = o0; *(u32x4*)(yo + (size_t)16 * DM) = o1;
                }
                yss += __shfl_xor(yss, 32);
                if (hi == 0) ((float*)(p.ws + WS_PSQS))[(tb0 + (size_t)c * 64 + l) * 32 + h * 2 + ph] = yss;
            } else {
                const int nb = wave - 2;
                const float cs63 = csl[63];
                { const float dec = __expf(cs63);
#pragma unroll
                  for (int r = 0; r < 16; ++r) S[r] *= dec; }
                const int brow = 4 * hi + ((lane & 15) >> 2), bch = 4 * nb + 2 * ((lane >> 4) & 1) + ((lane & 3) >> 1);
                const unsigned xpa = (unsigned)(size_t)(in + xfo);
                const unsigned bpa = (unsigned)(size_t)(in + SSD_BM + brow * 256 + ((bch ^ brow) << 4) + (lane & 1) * 8);
                const unsigned bpb = (unsigned)(size_t)(in + SSD_BM + (brow + 8) * 256 + ((bch ^ (brow + 8)) << 4) + (lane & 1) * 8);
                s16x4 lo[4], hh[4], blo[4], bhh[4]; f32x4 c0[4], c1[4], d0[4], d1[4];
                TR_PAIR(lo[0], hh[0], xpa, SSD_XS + 0 * 1024, 512); TR_PAIR(lo[1], hh[1], xpa, SSD_XS + 1 * 1024, 512); TR_PAIR(lo[2], hh[2], xpa, SSD_XS + 2 * 1024, 512); TR_PAIR(lo[3], hh[3], xpa, SSD_XS + 3 * 1024, 512);
                asm volatile("ds_read_b64_tr_b16 %0, %1 offset:%c2" : "=&v"(blo[0]) : "v"(bpa), "i"(0 * 4096) : "memory"); asm volatile("ds_read_b64_tr_b16 %0, %1 offset:%c2" : "=&v"(bhh[0]) : "v"(bpb), "i"(0 * 4096) : "memory");
                asm volatile("ds_read_b64_tr_b16 %0, %1 offset:%c2" : "=&v"(blo[1]) : "v"(bpa), "i"(1 * 4096) : "memory"); asm volatile("ds_read_b64_tr_b16 %0, %1 offset:%c2" : "=&v"(bhh[1]) : "v"(bpb), "i"(1 * 4096) : "memory");
                asm volatile("ds_read_b64_tr_b16 %0, %1 offset:%c2" : "=&v"(blo[2]) : "v"(bpa), "i"(2 * 4096) : "memory"); asm volatile("ds_read_b64_tr_b16 %0, %1 offset:%c2" : "=&v"(bhh[2]) : "v"(bpb), "i"(2 * 4096) : "memory");
                asm volatile("ds_read_b64_tr_b16 %0, %1 offset:%c2" : "=&v"(blo[3]) : "v"(bpa), "i"(3 * 4096) : "memory"); asm volatile("ds_read_b64_tr_b16 %0, %1 offset:%c2" : "=&v"(bhh[3]) : "v"(bpb), "i"(3 * 4096) : "memory");
#pragma unroll
                for (int ks = 0; ks < 4; ++ks) { c0[ks] = *(const LAS f32x4*)(csl + 16 * ks + 4 * hi); c1[ks] = *(const LAS f32x4*)(csl + 16 * ks + 8 + 4 * hi);
                                                 d0[ks] = *(const LAS f32x4*)(dtl + 16 * ks + 4 * hi); d1[ks] = *(const LAS f32x4*)(dtl + 16 * ks + 8 + 4 * hi); }
                LDS_WAIT_PIN();
                u32x4 aw[4];
#pragma unroll
                for (int ks = 0; ks < 4; ++ks) {
                    float xf[8];
#pragma unroll
                    for (int j = 0; j < 4; ++j) { xf[j] = bf2f((unsigned short)lo[ks][j]) * __expf(cs63 - c0[ks][j]) * d0[ks][j]; xf[4 + j] = bf2f((unsigned short)hh[ks][j]) * __expf(cs63 - c1[ks][j]) * d1[ks][j]; }
                    aw[ks].x = cvtpk(xf[0], xf[1]); aw[ks].y = cvtpk(xf[2], xf[3]); aw[ks].z = cvtpk(xf[4], xf[5]); aw[ks].w = cvtpk(xf[6], xf[7]);
                }
#pragma unroll
                for (int ks = 0; ks < 4; ++ks)
                    S = __builtin_amdgcn_mfma_f32_32x32x16_bf16(__builtin_bit_cast(bf16x8, aw[ks]), (bf16x8){blo[ks][0], blo[ks][1], blo[ks][2], blo[ks][3], bhh[ks][0], bhh[ks][1], bhh[ks][2], bhh[ks][3]}, S, 0, 0, 0);
                const int n = 32 * nb + r32;
#pragma unroll
                for (int r = 0; r < 16; ++r) *(LAS unsigned short*)(STout + (n >> 3) * 512 + crow(r, hi) * 16 + (n & 7) * 2) = (unsigned short)f2bf(S[r]);
            }
        }
#undef SSD_ISSUE
#undef SSD_G16
    }
    asm volatile("s_waitcnt vmcnt(0) lgkmcnt(0)" ::: "memory");
    __builtin_amdgcn_s_barrier(); asm volatile("" ::: "memory");
}
__device__ __forceinline__ void ph_peer4(const Params& p, LAS unsigned char* ldsl, int wave, int lane, int gwave, int gnw) {
    LAS unsigned char* ring = ldsl + wave * 16384;
    const unsigned char* U = (const unsigned char*)(p.ws + WS_U4); const unsigned char* V = (const unsigned char*)(p.ws + WS_V4);
    const int e_lane = (lane >> 2) & 15; const unsigned lane16 = (unsigned)lane * 16u, lanesc = 1024u + (unsigned)(lane >> 1) * 4u;
#define P4_ISSUE(R) do { const int R_ = (R); const int i_ = ((R_ >> 5) << 4) + (R_ & 15); \
        const int e_ = (i_ < 64) ? __builtin_amdgcn_readlane(idx0, i_) : __builtin_amdgcn_readlane(idx1, i_ - 64); \
        const unsigned char* base_ = (((R_ >> 4) & 1) ? V : U) + (size_t)(unsigned)e_ * P4_ROW; \
        LAS unsigned char* dst_ = ring + (R_ & 7) * 1280; \
        __builtin_amdgcn_global_load_lds((const unsigned*)(base_ + lane16), (LAS unsigned*)(dst_), 16, 0, 0); \
        __builtin_amdgcn_global_load_lds((const unsigned*)(base_ + lanesc), (LAS unsigned*)(dst_ + 1024), 4, 0, 0); } while (0)
#define P4_WAIT(n) asm volatile("s_waitcnt vmcnt(" #n ")" ::: "memory")
#define P4_CVT(wd, bs) __builtin_amdgcn_cvt_scalef32_pk_f32_fp4((wd), 1.0f, (bs))
    for (int t = gwave; t < T; t += gnw) {
        const int b = t / SEQ;
        const int idx0 = ((const int*)(p.ws + WS_IDX))[(size_t)t * 128 + lane], idx1 = ((const int*)(p.ws + WS_IDX))[(size_t)t * 128 + 64 + lane];
        float gv0 = ((const float*)(p.ws + WS_GATE))[(size_t)t * 128 + lane], gv1 = ((const float*)(p.ws + WS_GATE))[(size_t)t * 128 + 64 + lane];
        f32x2_t hf[16];
        {
            const float pq = (lane < 32) ? ((const float*)(p.ws + WS_PSQX))[(size_t)t * 32 + lane] : 0.f;
            const float r2 = rsqrtf(wave_sum(pq) * (1.f / DM) + EPS);
            const bf16_t* hp = (const bf16_t*)(p.ws + WS_X1M) + (size_t)t * DM + lane * 4;
            const float* shp = (const float*)(p.ws + WS_MOD) + (size_t)b * 6 * DM + 3 * DM + lane * 4;
#pragma unroll
            for (int j = 0; j < 8; ++j) { const u32x2 a = *(const u32x2*)(hp + j * 256); const f32x4 sh = *(const f32x4*)(shp + j * 256);
                hf[2 * j] = (f32x2_t){bflo(a.x) * r2 + sh[0], bfhi(a.x) * r2 + sh[1]}; hf[2 * j + 1] = (f32x2_t){bflo(a.y) * r2 + sh[2], bfhi(a.y) * r2 + sh[3]}; }
        }
        f32x2_t out[16];
#pragma unroll
        for (int i = 0; i < 16; ++i) out[i] = (f32x2_t){0.f, 0.f};
        asm volatile("" : "+v"(gv0), "+v"(gv1));
        P4_ISSUE(0); P4_ISSUE(1); P4_ISSUE(2); P4_ISSUE(3); P4_ISSUE(4); P4_ISSUE(5); P4_ISSUE(6);
        for (int hh = 0; hh < 8; ++hh) {
            float pd[16];
#pragma unroll
            for (int k = 0; k < 16; ++k) {
                P4_ISSUE(hh * 32 + k + 7); P4_WAIT(14);
                const LAS unsigned char* sl = ring + (k & 7) * 1280;
                const u32x4 w = *(const LAS u32x4*)(sl + lane * 16);
                const unsigned sw = *(const LAS unsigned*)(sl + 1024 + lane * 4);
                const float scl = (lane & 1) ? bfhi(sw) : bflo(sw);
                f32x2_t a2 = (f32x2_t){0.f, 0.f};
                a2 += P4_CVT(w.x, 0) * hf[0]; a2 += P4_CVT(w.x, 1) * hf[1]; a2 += P4_CVT(w.x, 2) * hf[2]; a2 += P4_CVT(w.x, 3) * hf[3];
                a2 += P4_CVT(w.y, 0) * hf[4]; a2 += P4_CVT(w.y, 1) * hf[5]; a2 += P4_CVT(w.y, 2) * hf[6]; a2 += P4_CVT(w.y, 3) * hf[7];
                a2 += P4_CVT(w.z, 0) * hf[8]; a2 += P4_CVT(w.z, 1) * hf[9]; a2 += P4_CVT(w.z, 2) * hf[10]; a2 += P4_CVT(w.z, 3) * hf[11];
                a2 += P4_CVT(w.w, 0) * hf[12]; a2 += P4_CVT(w.w, 1) * hf[13]; a2 += P4_CVT(w.w, 2) * hf[14]; a2 += P4_CVT(w.w, 3) * hf[15];
                float a = (a2.x + a2.y) * scl;
                asm volatile("" : "+v"(a));
                pd[k] = a;
            }
            float q8[8], q4[4], q2[2], q1;
            { const bool hi = (lane & 32) != 0;
#pragma unroll
              for (int i = 0; i < 8; ++i) { const float keep = hi ? pd[i + 8] : pd[i], send = hi ? pd[i] : pd[i + 8]; q8[i] = keep + __shfl_xor(send, 32); } }
            { const bool hi = (lane & 16) != 0;
#pragma unroll
              for (int i = 0; i < 4; ++i) { const float keep = hi ? q8[i + 4] : q8[i], send = hi ? q8[i] : q8[i + 4]; q4[i] = keep + __shfl_xor(send, 16); } }
            { const bool hi = (lane & 8) != 0;
#pragma unroll
              for (int i = 0; i < 2; ++i) { const float keep = hi ? q4[i + 2] : q4[i], send = hi ? q4[i] : q4[i + 2]; q2[i] = keep + __shfl_xor(send, 8); } }
            { const bool hi = (lane & 4) != 0; const float keep = hi ? q2[1] : q2[0], send = hi ? q2[0] : q2[1]; q1 = keep + __shfl_xor(send, 4); }
            q1 += __shfl_xor(q1, 1); q1 += __shfl_xor(q1, 2);
            const float act = 0.5f * q1 * (1.f + erff(q1 * 0.70710678118654752f)) * __shfl((hh < 4) ? gv0 : gv1, (hh & 3) * 16 + e_lane);
#pragma unroll
            for (int k = 0; k < 16; ++k) {
                if (k < 9) { P4_ISSUE(hh * 32 + 16 + k + 7); P4_WAIT(14); }
                else if (hh < 7) { P4_ISSUE(hh * 32 + 16 + k + 7); P4_WAIT(14); }
                else if (k == 9) P4_WAIT(12); else if (k == 10) P4_WAIT(10); else if (k == 11) P4_WAIT(8); else if (k == 12) P4_WAIT(6); else if (k == 13) P4_WAIT(4); else if (k == 14) P4_WAIT(2); else P4_WAIT(0);
                const LAS unsigned char* sl = ring + (k & 7) * 1280;
                const u32x4 w = *(const LAS u32x4*)(sl + lane * 16);
                const unsigned sw = *(const LAS unsigned*)(sl + 1024 + lane * 4);
                const float a = __builtin_bit_cast(float, __builtin_amdgcn_readlane(__builtin_bit_cast(int, act), 4 * k)) * ((lane & 1) ? bfhi(sw) : bflo(sw));
                const f32x2_t aa = (f32x2_t){a, a};
                out[0] += aa * P4_CVT(w.x, 0); out[1] += aa * P4_CVT(w.x, 1); out[2] += aa * P4_CVT(w.x, 2); out[3] += aa * P4_CVT(w.x, 3);
                out[4] += aa * P4_CVT(w.y, 0); out[5] += aa * P4_CVT(w.y, 1); out[6] += aa * P4_CVT(w.y, 2); out[7] += aa * P4_CVT(w.y, 3);
                asm volatile("" : "+v"(out[0]), "+v"(out[1]), "+v"(out[2]), "+v"(out[3]), "+v"(out[4]), "+v"(out[5]), "+v"(out[6]), "+v"(out[7]));
                out[8] += aa * P4_CVT(w.z, 0); out[9] += aa * P4_CVT(w.z, 1); out[10] += aa * P4_CVT(w.z, 2); out[11] += aa * P4_CVT(w.z, 3);
                out[12] += aa * P4_CVT(w.w, 0); out[13] += aa * P4_CVT(w.w, 1); out[14] += aa * P4_CVT(w.w, 2); out[15] += aa * P4_CVT(w.w, 3);
                asm volatile("" : "+v"(out[8]), "+v"(out[9]), "+v"(out[10]), "+v"(out[11]), "+v"(out[12]), "+v"(out[13]), "+v"(out[14]), "+v"(out[15]));
            }
        }
        const float* g2 = (const float*)(p.ws + WS_MOD) + (size_t)b * 6 * DM + 5 * DM; const float* s2 = (const float*)(p.ws + WS_MOD) + (size_t)b * 6 * DM + 4 * DM;
        const bf16_t* xmp = (const bf16_t*)(p.ws + WS_X1M) + (size_t)t * DM;
        float* outp = p.out + (size_t)t * DM;
#pragma unroll
        for (int j = 0; j < 8; ++j) {
            const int c = j * 256 + lane * 4;
            const u32x2 xm = *(const u32x2*)(xmp + c); const f32x4 ga = *(const f32x4*)(g2 + c), sc = *(const f32x4*)(s2 + c);
            *(f32x4*)(outp + c) = (f32x4){bflo(xm.x) / (1.f + sc.x) + ga.x * out[2 * j].x, bfhi(xm.x) / (1.f + sc.y) + ga.y * out[2 * j].y,
                                          bflo(xm.y) / (1.f + sc.z) + ga.z * out[2 * j + 1].x, bfhi(xm.y) / (1.f + sc.w) + ga.w * out[2 * j + 1].y};
        }
    }
#undef P4_ISSUE
#undef P4_WAIT
#undef P4_CVT
}
constexpr int RING_BYTES = 131072, LDSCTL_OFF = 146432, MISC_OFF = LDSCTL_OFF + 320, LDS_BYTES = 147456;
static_assert(SSD_SYNC + 64 <= LDSCTL_OFF, "SSD LDS map");
constexpr int NPH = 13;
#ifndef MK_PER_PHASE
#define MK_PER_PHASE 0
#endif

__global__ void __launch_bounds__(NTHR, 2) mega(Params p) {
    extern __shared__ __attribute__((aligned(16))) unsigned char lds[];
    LAS unsigned char* ldsl = (LAS unsigned char*)lds;
    const int tid = threadIdx.x, lane = tid & 63, wave = __builtin_amdgcn_readfirstlane(tid >> 6);
    const int G = gridDim.x, bid = blockIdx.x;
    unsigned char* ws = p.ws;
    gu32* ctl = (gu32*)(ws + WS_CTL);
    for (int u = tid; u < (LDS_BYTES - LDSCTL_OFF) / 4; u += NTHR) ((LAS unsigned*)(ldsl + LDSCTL_OFF))[u] = 0u;
    __syncthreads();
    volatile LAS unsigned* MISC = (volatile LAS unsigned*)(ldsl + MISC_OFF);
    XcdBarrier bar; bar.bar = (unsigned*)(ctl + CW_BAR); bar.x = 0; bar.st = nullptr;
    if (!MK_PER_PHASE) bar = xcd_barrier_post((unsigned*)(ctl + CW_BAR), MISC + 8);
#define IN(k) (p.ph_lo <= (k) && (k) < p.ph_hi)
#define LN() ({ int l_ = lane; asm volatile("" : "+v"(l_)); l_; })
#define WV() ({ int w_ = wave; asm volatile("" : "+s"(w_)); w_; })
#define SEAM(k) do { if ((k) + 1 < p.ph_hi) xcd_barrier(bar); } while (0)
    const int gtid = bid * NTHR + tid, gn = G * NTHR, gwave = bid * NWAVES + wave, gnw = G * NWAVES;
    float* mod = (float*)(ws + WS_MOD);

    if (IN(0)) {
        if (bid < 96) ph_mod(p, lds, tid, bid);
        else ph_transposes(p, lds, WV(), LN(), (bid - 96) * NWAVES + wave, (G - 96) * NWAVES);
        ph_rope_tab(p, gtid, gn);
        ph_convert(p.sub_keys, (bf16_t*)(ws + WS_SUBK), (size_t)8 * 2 * 128 * 128 / 4, gtid, gn);
        SEAM(0);
    }
    if (IN(1)) { ph_modrows(p.x, (bf16_t*)(ws + WS_H), mod, 0, 1, gwave, gnw, LN()); ph_bias2(p, gwave, gnw, LN()); SEAM(1); }
    if (IN(2)) {
        pg8::Gemm g{(const bf16_t*)(ws + WS_H), (const bf16_t*)(ws + WS_WINT), T, NPROJ, DM, DM}; pg8::StaticOrder S; S.init(T, NPROJ, G, bid);
        pg8::EpiBf16<0> E{(bf16_t*)(ws + WS_PROJ), NPROJ, nullptr, 0, 0, 1.f};
        pg8::gemm_phase<pg8::EpiBf16<0>, pg8::StaticOrder, true, true>(ldsl, g, S, E);
        SEAM(2);
    }
    if (IN(3)) {
        { pg8::Gemm g{(const bf16_t*)(ws + WS_PROJ) + C_CQ, (const bf16_t*)(ws + WS_WUQT), T, NQ, 512, NPROJ}; pg8::StaticOrder S; S.init(T, NQ, G, bid);
          pg8::EpiBf16<0> E{(bf16_t*)(ws + WS_QRAW), NQ, nullptr, 0, 0, 1.f};
          pg8::gemm_phase<pg8::EpiBf16<0>, pg8::StaticOrder, true, true>(ldsl, g, S, E); }
        { pg8::Gemm g{(const bf16_t*)(ws + WS_PROJ) + C_CKV, (const bf16_t*)(ws + WS_WUKVT), T, NKV, 256, NPROJ}; pg8::StaticOrder S; S.init(T, NKV, G, bid);
          pg8::EpiBf16<0> E{(bf16_t*)(ws + WS_KVRAW), NKV, nullptr, 0, 0, 1.f};
          pg8::gemm_phase<pg8::EpiBf16<0>, pg8::StaticOrder, true, true>(ldsl, g, S, E); }
        SEAM(3);
    }
    if (IN(4)) { ph_qkv_post(p, gwave, gnw, LN()); ph_conv(p, gwave, gnw, LN()); SEAM(4); }
    if (IN(5)) { ph_attn(p, ldsl, bid, G, WV(), LN()); ph_ssd(p, ldsl, bid, WV(), LN()); SEAM(5); }
    if (IN(8)) {
        pg8::Gemm g{(const bf16_t*)(ws + WS_MIXRAW), (const bf16_t*)(ws + WS_WOUTT), T, DM, DM, DM}; pg8::StaticOrder S; S.init(T, DM, G, bid);
        pg8::Unit u0, u1; S.next(0, u0); if (!S.next(1, u1)) u1 = u0;
        LAS float* kt = (LAS float*)(ldsl + RING_BYTES);
        { const int slot = tid >> 8, r = tid & 255, row = (slot ? u1.pm : u0.pm) * 256 + r;
          const f32x4* pa = (const f32x4*)((const float*)(ws + WS_PSQA) + (size_t)row * 8); const f32x4* ps = (const f32x4*)((const float*)(ws + WS_PSQS) + (size_t)row * 32);
          const f32x4 a0 = pa[0], a1 = pa[1]; float sa = ((a0[0] + a0[1]) + (a0[2] + a0[3])) + ((a1[0] + a1[1]) + (a1[2] + a1[3])), s0 = 0.f, s1 = 0.f;
#pragma unroll
          for (int q = 0; q < 4; ++q) { const f32x4 v = ps[q], w = ps[4 + q]; s0 += (v[0] + v[1]) + (v[2] + v[3]); s1 += (w[0] + w[1]) + (w[2] + w[3]); }
          const float ra = rsqrtf(sa * (1.f / 1024.f) + EPS), r0 = rsqrtf(s0 * (1.f / 512.f) + EPS), r1 = rsqrtf(s1 * (1.f / 512.f) + EPS);
          kt[tid * 4 + 0] = ra / r0; kt[tid * 4 + 1] = r0 / r1; kt[tid * 4 + 2] = r1; kt[tid * 4 + 3] = 0.f; }
        __syncthreads();
        pg8::EpiX1 E{p.x, mod, (bf16_t*)(ws + WS_X1M), (float*)(ws + WS_PSQX), DM, SEQ, kt, u0.pm};
        pg8::gemm_phase<pg8::EpiX1, pg8::StaticOrder, true, true>(ldsl, g, S, E);
        SEAM(8);
    }
    if (IN(10)) {
        pg8::Gemm g{(const bf16_t*)(ws + WS_X1M), (const bf16_t*)(ws + WS_WQT), T, DM, DM, DM}; pg8::StaticOrder S; S.init(T, DM, G, bid);
        pg8::Unit u0, u1; S.next(0, u0); if (!S.next(1, u1)) u1 = u0;
        LAS float* rt = (LAS float*)(ldsl + RING_BYTES);
        { const int slot = tid >> 8, r = tid & 255, row = (slot ? u1.pm : u0.pm) * 256 + r; const f32x4* pq = (const f32x4*)((const float*)(ws + WS_PSQX) + (size_t)row * 32); float s_ = 0.f;
#pragma unroll
          for (int q = 0; q < 8; ++q) { const f32x4 v = pq[q]; s_ += (v[0] + v[1]) + (v[2] + v[3]); }
          rt[tid] = rsqrtf(s_ * (1.f / DM) + EPS); }
        __syncthreads();
        pg8::EpiScaleBias E{(bf16_t*)(ws + WS_QP), DM, (const float*)(ws + WS_BIAS2), SEQ, rt, u0.pm};
        pg8::gemm_phase<pg8::EpiScaleBias, pg8::StaticOrder, true, true>(ldsl, g, S, E);
        SEAM(10);
    }
    if (IN(11)) { ph_route(p, ldsl, WV(), LN(), gwave, gnw); SEAM(11); }
    if (IN(12)) { ph_peer4(p, ldsl, WV(), LN(), gwave, gnw); }
#undef IN
#undef SEAM
}

extern "C" void kernel_launch(void* const* d_in, const int* in_sizes, int n_in, void* d_out, int out_size, void* d_ws, size_t ws_size, hipStream_t stream) {
    static int grid = 0;
    if (grid == 0) {
        if (n_in != 24 || ws_size < WS_END) { fprintf(stderr, "kernel_launch: unexpected inputs / workspace (%d, %zu)\n", n_in, ws_size); grid = -1; return; }
        if (hipFuncSetAttribute((const void*)mega, hipFuncAttributeMaxDynamicSharedMemorySize, LDS_BYTES) != hipSuccess) { fprintf(stderr, "kernel_launch: hipFuncSetAttribute failed\n"); grid = -1; return; }
        (void)hipGetLastError();
        grid = 256;
    }
    if (grid < 0) return;
    (void)hipMemsetAsync((char*)d_ws + WS_CTL, 0, CTL_ZERO_BYTES, stream);
    Params p{};
    p.x = (const float*)d_in[0]; p.c = (const float*)d_in[1]; p.pos = (const int*)d_in[2]; p.w_ada = (const float*)d_in[3]; p.b_ada = (const float*)d_in[4];
    p.w_in = (const float*)d_in[5]; p.q_a_norm = (const float*)d_in[6]; p.w_uq = (const float*)d_in[7]; p.kv_a_norm = (const float*)d_in[8]; p.w_ukv = (const float*)d_in[9];
    p.q_norm = (const float*)d_in[10]; p.k_norm = (const float*)d_in[11]; p.attn_out_norm = (const float*)d_in[12]; p.conv_w = (const float*)d_in[13]; p.conv_b = (const float*)d_in[14];
    p.dt_bias = (const float*)d_in[15]; p.a_log = (const float*)d_in[16]; p.d_skip = (const float*)d_in[17]; p.ssd_norm = (const float*)d_in[18]; p.w_out = (const float*)d_in[19];
    p.w_query = (const float*)d_in[20]; p.sub_keys = (const float*)d_in[21]; p.u_exp = (const float*)d_in[22]; p.v_exp = (const float*)d_in[23];
    p.out = (float*)d_out; p.ws = (unsigned char*)d_ws;
#if MK_PER_PHASE
    for (int ph = 0; ph < NPH; ++ph) { p.ph_lo = ph; p.ph_hi = ph + 1; hipLaunchKernelGGL(mega, dim3(grid), dim3(NTHR), LDS_BYTES, stream, p); }
#elif defined(PROBE_SEQ)
    { const int seq[] = {PROBE_SEQ}; const int nl = (int)(sizeof(seq) / sizeof(int)) / 2;
      for (int li = 0; li < nl; ++li) { if (li) (void)hipMemsetAsync((char*)d_ws + WS_CTL, 0, CTL_ZERO_BYTES, stream);
          p.ph_lo = seq[2 * li]; p.ph_hi = seq[2 * li + 1]; hipLaunchKernelGGL(mega, dim3(grid), dim3(NTHR), LDS_BYTES, stream, p); } }
#else
    p.ph_lo = 0; p.ph_hi = NPH;
    hipLaunchKernelGGL(mega, dim3(grid), dim3(NTHR), LDS_BYTES, stream, p);
#endif
}
```

```cpp
#include <hip/hip_runtime.h>
#include <cstdint>
#include <cstdio>
#include <cmath>

constexpr int DM = 2048, NB = 8, SEQ = 2048, T = NB * SEQ;
constexpr int IN_COLS = 3408, NPROJ = 3584;
constexpr int C_CQ = 0, C_CKV = 512, C_KR = 768, C_Z = 832, C_XBC = 1856, C_DT = 3392;
constexpr int NQ = 1536, NKV = 2048;
constexpr float EPS = 1e-6f;
constexpr int NTHR = 512, NWAVES = 8;

typedef unsigned short bf16_t;
typedef unsigned u32x4 __attribute__((ext_vector_type(4)));
typedef float f32x4 __attribute__((ext_vector_type(4)));
typedef unsigned u32x2 __attribute__((ext_vector_type(2)));
#define GAS __attribute__((address_space(1)))
#define LAS __attribute__((address_space(3)))
typedef GAS unsigned gu32;
typedef GAS unsigned long long gu64;
#define RLX_AGENT __ATOMIC_RELAXED, __HIP_MEMORY_SCOPE_AGENT

__device__ __forceinline__ unsigned f2bf(float f) { unsigned u = __builtin_bit_cast(unsigned, f); return (u + 0x7fffu + ((u >> 16) & 1u)) >> 16; }
__device__ __forceinline__ float bf2f(unsigned h) { return __builtin_bit_cast(float, h << 16); }
__device__ __forceinline__ unsigned pk2(float lo, float hi) { return f2bf(lo) | (f2bf(hi) << 16); }
__device__ __forceinline__ float bflo(unsigned w) { return __builtin_bit_cast(float, w << 16); }
__device__ __forceinline__ float bfhi(unsigned w) { return __builtin_bit_cast(float, w & 0xffff0000u); }
__device__ __forceinline__ float silu_f(float v) { return v / (1.f + __expf(-v)); }
__device__ __forceinline__ float wave_sum(float v) {
#pragma unroll
    for (int o = 1; o < 64; o <<= 1) v += __shfl_xor(v, o);
    return v;
}

constexpr size_t MiB = 1u << 20;
constexpr size_t WS_CTL = 0, CTL_ZERO_BYTES = 64 * 1024, WS_MOD = 1 * MiB, WS_ROPEC = 2 * MiB, WS_ROPES = 4 * MiB, WS_SUBK = 6 * MiB, WS_WUQT = 7 * MiB, WS_WUKVT = 9 * MiB,
                 WS_WINT = 10 * MiB, WS_WOUTT = 24 * MiB, WS_WQT = 32 * MiB,
                 WS_US = 40 * MiB, WS_VS = 41 * MiB, WS_PSQX = 42 * MiB, WS_BIAS2 = 44 * MiB, WS_PSQA = 45 * MiB, WS_PSQS = 46 * MiB, WS_CS = 50 * MiB, WS_DT = 51 * MiB, WS_IDX = 52 * MiB, WS_GATE = 60 * MiB, WS_U16 = 68 * MiB, WS_V16 = 132 * MiB, WS_U8 = 68 * MiB, WS_V8 = 100 * MiB, WS_MIXRAW = 372 * MiB, WS_U4D = 436 * MiB, WS_U4S = 452 * MiB, WS_V4D = 456 * MiB, WS_V4S = 472 * MiB, WS_PART = 196 * MiB,
                 WS_K = 68 * MiB, WS_YSSD = 68 * MiB, WS_XBCA = 116 * MiB, WS_ATTN = 164 * MiB,
                 WS_H = 196 * MiB, WS_Q = 196 * MiB, WS_MIXIN = 196 * MiB, WS_H2 = 196 * MiB, WS_X1M = 68 * MiB,
                 WS_PROJ = 260 * MiB, WS_QP = 260 * MiB, WS_QRAW = 372 * MiB, WS_KVRAW = 420 * MiB, WS_V = 484 * MiB, WS_END = 516 * MiB;
constexpr int CW_BAR = 1024;

struct Params {
    const float *x, *c; const int* pos;
    const float *w_ada, *b_ada, *w_in, *q_a_norm, *w_uq, *kv_a_norm, *w_ukv, *q_norm, *k_norm, *attn_out_norm, *conv_w, *conv_b, *dt_bias, *a_log,
        *d_skip, *ssd_norm, *w_out, *w_query, *sub_keys, *u_exp, *v_exp;
    float* out; unsigned char* ws;
    int ph_lo, ph_hi;
#ifdef PROBE_EMASK
    int emask;
#endif
};
namespace pg8 {
#define PG8_LAS __attribute__((address_space(3)))
typedef unsigned short bf16_t;
typedef short bf16x8 __attribute__((ext_vector_type(8)));
typedef float f32x4 __attribute__((ext_vector_type(4)));
typedef unsigned u32x4 __attribute__((ext_vector_type(4)));
constexpr int BM = 256, BK = 64, HALF = 128, HTB = HALF * BK * 2  , STAGE_BYTES = 8 * HTB, NXCD = 8, WGM = 32;

__host__ __device__ __forceinline__ int lds_byte(int r, int c) { const int st = (r >> 4) * 2 + (c >> 5), rr = r & 15, cc = c & 31, ob = rr * 64 + cc * 2; return st * 1024 + (ob ^ (((ob >> 9) & 1) << 5)); }
__host__ __device__ __forceinline__ void stage_rc(int b, int& R, int& C) { const int st = b / 1024, sb = b % 1024, swz = sb ^ (((sb >> 9) & 1) << 5); R = (st >> 1) * 16 + swz / 64; C = (st & 1) * 32 + (swz % 64) / 2; }
__host__ __device__ __forceinline__ int perm32(int rho) { const int n = rho >> 4, i = rho & 15; return 8 * (i >> 2) + 4 * n + (i & 3); }

struct Unit { int pm, pn; };
struct Gemm { const bf16_t* A; const bf16_t* Bt; int M, N, K, lda; };

struct StaticOrder {
    int nM, nN, nwg, G, c;
    __host__ __device__ void init(int M, int N, int G_, int c_) { nM = M / BM; nN = N / BM; nwg = nM * nN; G = G_; c = c_; }
    __host__ __device__ bool next(int i, Unit& u) const {
        const long L = (long)i * G + c; if (L >= nwg) return false;
        int wgid = (int)L; { const int q = nwg / NXCD, r = nwg % NXCD, xcd = wgid % NXCD, off = wgid / NXCD; wgid = (xcd < r ? xcd * (q + 1) : r * (q + 1) + (xcd - r) * q) + off; }
        const int nig = WGM * nN, gid = wgid / nig, fm = gid * WGM, gsz = (nM - fm) < WGM ? (nM - fm) : WGM;
        u.pm = fm + ((wgid % nig) % gsz); u.pn = (wgid % nig) / gsz; return true;
    }
    __device__ __forceinline__ void a_ready(const Unit&) const {}
    __device__ __forceinline__ void done(const Unit&) const {}
};

struct SkewOrder : StaticOrder {
    __host__ __device__ bool next(int i, Unit& u) const {
        const int h = G / 2; long L;
        if (c < h) { if (i > 0) return false; L = c; } else { if (i > 2) return false; L = h + 3L * (c - h) + i; }
        if (L >= nwg) return false;
        int wgid = (int)L; { const int q = nwg / NXCD, r = nwg % NXCD, xcd = wgid % NXCD, off = wgid / NXCD; wgid = (xcd < r ? xcd * (q + 1) : r * (q + 1) + (xcd - r) * q) + off; }
        const int nig = WGM * nN, gid = wgid / nig, fm = gid * WGM, gsz = (nM - fm) < WGM ? (nM - fm) : WGM;
        u.pm = fm + ((wgid % nig) % gsz); u.pn = (wgid % nig) / gsz; return true;
    }
};

__device__ __forceinline__ unsigned cvt_pk_bf16(float lo, float hi) { unsigned r; asm volatile("v_cvt_pk_bf16_f32 %0, %1, %2" : "=v"(r) : "v"(lo), "v"(hi)); return r; }
typedef float f32x2 __attribute__((ext_vector_type(2)));
__device__ __forceinline__ f32x2 gelu_pk(f32x2 v) {
    const f32x2 av = __builtin_elementwise_abs(v), d = av * 0.2316418882f + 1.0f;
    f32x2 t; t.x = __builtin_amdgcn_rcpf(d.x); t.y = __builtin_amdgcn_rcpf(d.y);
    f32x2 q = t * 0.5307027145f + (-0.7265760135f); q = q * t + 0.7107068705f; q = q * t + (-0.142248368f); q = q * t + 0.127414796f; q = q * t;
    const f32x2 s = (v * v) * (-0.72134752044f);
    f32x2 e; e.x = __builtin_amdgcn_exp2f(s.x); e.y = __builtin_amdgcn_exp2f(s.y);
    const f32x2 m = v * (q * e), r = v - m;
    f32x2 o; o.x = v.x < 0.f ? m.x : r.x; o.y = v.y < 0.f ? m.y : r.y; return o;
}

template <int ACT  > struct EpiBf16 {
    static constexpr bool PERM = true, AFTER_DRAIN = false, KSCALE = false; static_assert(ACT == 0 || ACT == 1, "EpiBf16: ACT is 0 (none) or 1 (gelu_pk)");
    bf16_t* O; int ldc; const float* bias; int split_cols; size_t split_stride; float scale0;
    __device__ __forceinline__ void operator()(const f32x4 (&acc)[2][2][4][2], const Unit& u, int wr, int wc, int fr, int fq) const {
        const int row0 = u.pm * BM + wr * 64 + fr; int colt = u.pn * BM; bf16_t* base = O;
        float sc = 1.f; if (split_cols) { const int t = colt / split_cols; base += (size_t)t * split_stride; colt -= t * split_cols; if (t == 0) sc = scale0; }
        const int col0 = colt + wc * 32 + 8 * fq, bcol0 = u.pn * BM + wc * 32 + 8 * fq;
        f32x4 bv[2][2];
#pragma unroll
        for (int bj = 0; bj < 2; ++bj)
#pragma unroll
            for (int n = 0; n < 2; ++n) bv[bj][n] = bias ? *(const f32x4*)(bias + bcol0 + bj * HALF + 4 * n) : (f32x4){0.f, 0.f, 0.f, 0.f};
#pragma unroll
        for (int ai = 0; ai < 2; ++ai)
#pragma unroll
            for (int m = 0; m < 4; ++m) { bf16_t* rowp = base + (size_t)(row0 + ai * HALF + m * 16) * ldc + col0;
#pragma unroll
                for (int bj = 0; bj < 2; ++bj) { f32x4 v0 = acc[ai][bj][m][0] + bv[bj][0], v1 = acc[ai][bj][m][1] + bv[bj][1];
                    if (ACT == 1) { f32x2 a = gelu_pk((f32x2){v0[0], v0[1]}), b = gelu_pk((f32x2){v0[2], v0[3]}), c = gelu_pk((f32x2){v1[0], v1[1]}), d = gelu_pk((f32x2){v1[2], v1[3]});
                        v0 = (f32x4){a.x, a.y, b.x, b.y}; v1 = (f32x4){c.x, c.y, d.x, d.y}; }
                    v0 = v0 * sc; v1 = v1 * sc; u32x4 w; w.x = cvt_pk_bf16(v0[0], v0[1]); w.y = cvt_pk_bf16(v0[2], v0[3]); w.z = cvt_pk_bf16(v1[0], v1[1]); w.w = cvt_pk_bf16(v1[2], v1[3]);
                    *(u32x4*)(rowp + bj * HALF) = w; } }
    }
};
struct EpiResid {
    static constexpr bool PERM = false, AFTER_DRAIN = false, KSCALE = false;
    const float* resid; float* out; const float* gate; int ldc, rows_per_batch, gate_stride;
    __device__ __forceinline__ void operator()(const f32x4 (&acc)[2][2][4][2], const Unit& u, int wr, int wc, int fr, int fq) const {
        const int col0 = u.pn * BM + wc * 32 + 4 * fq;
        const int b = (u.pm * BM) / rows_per_batch;
        f32x4 gv[2][2];
#pragma unroll
        for (int bj = 0; bj < 2; ++bj)
#pragma unroll
            for (int n = 0; n < 2; ++n) gv[bj][n] = *(const f32x4*)(gate + (size_t)b * gate_stride + col0 + bj * HALF + n * 16);
#pragma unroll
        for (int ai = 0; ai < 2; ++ai)
#pragma unroll
            for (int m = 0; m < 4; ++m) {
                const size_t off = (size_t)(u.pm * BM + ai * HALF + wr * 64 + m * 16 + fr) * ldc + col0;
#pragma unroll
                for (int bj = 0; bj < 2; ++bj)
#pragma unroll
                    for (int n = 0; n < 2; ++n) {
                        const f32x4 bs = *(const f32x4*)(resid + off + bj * HALF + n * 16);
                        *(f32x4*)(out + off + bj * HALF + n * 16) = bs + gv[bj][n] * acc[ai][bj][m][n];
                    }
                if (m & 1) asm volatile("" ::: "memory");
            }
    }
};

struct EpiX1 {
    static constexpr bool PERM = true, AFTER_DRAIN = false, KSCALE = true;
    static constexpr int KS1 = 16, KS2 = 24;
    const float* resid; const float* mod; bf16_t* xm; float* psq; int ldc, rows_per_batch; const PG8_LAS float* kt; int pm0;
    __device__ __forceinline__ void kscale(f32x4 (&acc)[2][2][4][2], const Unit& u, int t, int wr, int fr) const {
        const PG8_LAS float* tab = kt + ((u.pm == pm0) ? 0 : 1024) + ((t == KS1) ? 0 : 1);
#pragma unroll
        for (int ai = 0; ai < 2; ++ai)
#pragma unroll
            for (int m = 0; m < 4; ++m) { const float f = tab[(ai * HALF + wr * 64 + m * 16 + fr) * 4];
#pragma unroll
                for (int bj = 0; bj < 2; ++bj) { acc[ai][bj][m][0] *= f; acc[ai][bj][m][1] *= f; } }
    }
    __device__ __forceinline__ void operator()(const f32x4 (&acc)[2][2][4][2], const Unit& u, int wr, int wc, int fr, int fq) const {
        const int b = (u.pm * BM) / rows_per_batch;
        const float* g1 = mod + (size_t)b * 6 * ldc + 2 * ldc; const float* s2 = mod + (size_t)b * 6 * ldc + 4 * ldc;
        const int col0 = u.pn * BM + wc * 32 + 8 * fq;
        const PG8_LAS float* tab = kt + ((u.pm == pm0) ? 0 : 1024) + 2;
        f32x4 gv[2][2], sv[2][2];
#pragma unroll
        for (int bj = 0; bj < 2; ++bj)
#pragma unroll
            for (int n = 0; n < 2; ++n) { gv[bj][n] = *(const f32x4*)(g1 + col0 + bj * HALF + 4 * n); sv[bj][n] = *(const f32x4*)(s2 + col0 + bj * HALF + 4 * n) + 1.0f; }
#pragma unroll
        for (int ai = 0; ai < 2; ++ai)
#pragma unroll
            for (int m = 0; m < 4; ++m) {
                const int lr = ai * HALF + wr * 64 + m * 16 + fr, row = u.pm * BM + lr; const size_t off = (size_t)row * ldc + col0;
                const float rf = tab[lr * 4];
                float ss = 0.f;
#pragma unroll
                for (int bj = 0; bj < 2; ++bj) {
                    const f32x4 r0 = *(const f32x4*)(resid + off + bj * HALF), r1 = *(const f32x4*)(resid + off + bj * HALF + 4);
                    const f32x4 x0 = r0 + gv[bj][0] * (acc[ai][bj][m][0] * rf), x1 = r1 + gv[bj][1] * (acc[ai][bj][m][1] * rf);
                    ss += (x0[0] * x0[0] + x0[1] * x0[1]) + (x0[2] * x0[2] + x0[3] * x0[3]) + (x1[0] * x1[0] + x1[1] * x1[1]) + (x1[2] * x1[2] + x1[3] * x1[3]);
                    const f32x4 y0 = x0 * sv[bj][0], y1 = x1 * sv[bj][1];
                    u32x4 w; w.x = cvt_pk_bf16(y0[0], y0[1]); w.y = cvt_pk_bf16(y0[2], y0[3]); w.z = cvt_pk_bf16(y1[0], y1[1]); w.w = cvt_pk_bf16(y1[2], y1[3]);
                    *(u32x4*)(xm + off + bj * HALF) = w;
                }
                ss += __shfl_xor(ss, 16); ss += __shfl_xor(ss, 32);
                if (fq == 0) psq[(size_t)row * 32 + u.pn * 4 + wc] = ss;
                if (m & 1) asm volatile("" ::: "memory");
            }
    }
};
struct EpiScaleBias {
    static constexpr bool PERM = true, AFTER_DRAIN = false, KSCALE = false;
    bf16_t* O; int ldc; const float* bias; int rows_per_batch; const PG8_LAS float* rt; int pm0;
    __device__ __forceinline__ void operator()(const f32x4 (&acc)[2][2][4][2], const Unit& u, int wr, int wc, int fr, int fq) const {
        const int b = (u.pm * BM) / rows_per_batch; const float* bp = bias + (size_t)b * ldc;
        const int col0 = u.pn * BM + wc * 32 + 8 * fq;
        const PG8_LAS float* rtu = rt + ((u.pm == pm0) ? 0 : 256);
        f32x4 bv[2][2];
#pragma unroll
        for (int bj = 0; bj < 2; ++bj)
#pragma unroll
            for (int n = 0; n < 2; ++n) bv[bj][n] = *(const f32x4*)(bp + col0 + bj * HALF + 4 * n);
#pragma unroll
        for (int ai = 0; ai < 2; ++ai)
#pragma unroll
            for (int m = 0; m < 4; ++m) {
                const int lr = ai * HALF + wr * 64 + m * 16 + fr; const float rs = rtu[lr];
                bf16_t* rowp = O + (size_t)(u.pm * BM + lr) * ldc + col0;
#pragma unroll
                for (int bj = 0; bj < 2; ++bj) {
                    const f32x4 v0 = acc[ai][bj][m][0] * rs + bv[bj][0], v1 = acc[ai][bj][m][1] * rs + bv[bj][1];
                    u32x4 w; w.x = cvt_pk_bf16(v0[0], v0[1]); w.y = cvt_pk_bf16(v0[2], v0[3]); w.z = cvt_pk_bf16(v1[0], v1[1]); w.w = cvt_pk_bf16(v1[2], v1[3]);
                    *(u32x4*)(rowp + bj * HALF) = w;
                }
            }
    }
};
template <class Epi, class Sched, bool ALIGN_EPI = false, bool SP2 = false>
__device__ __forceinline__ void gemm_phase(PG8_LAS unsigned char* lds, const Gemm g, const Sched& S, const Epi& E) {
    const int tid = threadIdx.x, wid = __builtin_amdgcn_readfirstlane(tid >> 6), lane = tid & 63, wr = wid >> 2, wc = wid & 3, fr = lane & 15, fq = lane >> 4;
    const int K = g.K, nt = K / BK;
    unsigned voffA[2], voffB[2];
#pragma unroll
    for (int i = 0; i < 2; ++i) { int R, C; stage_rc(tid * 16 + i * 8192, R, C); const int Rb = Epi::PERM ? ((R & ~31) + perm32(R & 31)) : R;
        voffA[i] = (unsigned)(R * g.lda + C) * 2u; voffB[i] = (unsigned)(Rb * K + C) * 2u; }
    const size_t kstep = (size_t)(BK * 2);
    const size_t hstep = (size_t)HALF * K * 2;
    const size_t tstep = 2 * hstep; const size_t hstepA = (size_t)HALF * g.lda * 2, tstepA = 2 * hstepA;
    const unsigned ldsw = (unsigned)wid * 1024u;
    const int aoff = lds_byte(wr * 64 + fr, fq * 8), boff = lds_byte(wc * 32 + fr, fq * 8);
#define PG8_SA(b, h) (((b) * 2 + (h)) * HTB)
#define PG8_SB(b, h) ((4 + (b) * 2 + (h)) * HTB)
#define PG8_STAGE(bufoff, gbase, voff) do { _Pragma("unroll") for (int _i = 0; _i < 2; ++_i) \
        __builtin_amdgcn_global_load_lds((const unsigned*)((const char*)(gbase) + (voff)[_i]), (PG8_LAS unsigned*)(lds + (bufoff) + ldsw + _i * 8192), 16, 0, 0); } while (0)
#define PG8_LDA(dst, b, h) do { _Pragma("unroll") for (int m = 0; m < 4; ++m) _Pragma("unroll") for (int k = 0; k < 2; ++k) dst[m][k] = *(const PG8_LAS bf16x8*)(lds + PG8_SA(b, h) + aoff + m * 2048 + k * 1024); } while (0)
#define PG8_LDB(dst, b, h) do { _Pragma("unroll") for (int n = 0; n < 2; ++n) _Pragma("unroll") for (int k = 0; k < 2; ++k) dst[n][k] = *(const PG8_LAS bf16x8*)(lds + PG8_SB(b, h) + boff + n * 2048 + k * 1024); } while (0)
#define PG8_MMA(ai, bj, At, Bt) do { __builtin_amdgcn_s_setprio(1); _Pragma("unroll") for (int m = 0; m < 4; ++m) _Pragma("unroll") for (int n = 0; n < 2; ++n) _Pragma("unroll") for (int k = 0; k < 2; ++k) \
        acc[ai][bj][m][n] = __builtin_amdgcn_mfma_f32_16x16x32_bf16(Bt[n][k], At[m][k], acc[ai][bj][m][n], 0, 0, 0); __builtin_amdgcn_s_setprio(0); } while (0)
#define PG8_WAIT_V(n) asm volatile("s_waitcnt vmcnt(" #n ")" ::: "memory")
#define PG8_WAIT_L(n) asm volatile("s_waitcnt lgkmcnt(" #n ")" ::: "memory")
#define PG8_BAR __builtin_amdgcn_s_barrier()
#define PG8_SCHED __builtin_amdgcn_sched_barrier(0)
    Unit cur, nxt; int ui = 0;
    if (!S.next(0, cur)) return;
    f32x4 acc[2][2][4][2];
#pragma unroll
    for (int a = 0; a < 2; ++a)
#pragma unroll
        for (int b = 0; b < 2; ++b)
#pragma unroll
            for (int m = 0; m < 4; ++m)
#pragma unroll
                for (int n = 0; n < 2; ++n) acc[a][b][m][n] = (f32x4){0.f, 0.f, 0.f, 0.f};
    bf16x8 At[4][2], B0[2][2], B1[2][2];
    const char* cA = (const char*)g.A + (size_t)cur.pm * tstepA; const char* cB = (const char*)g.Bt + (size_t)cur.pn * tstep;
    S.a_ready(cur);
    if constexpr (SP2) {
        PG8_STAGE(PG8_SB(0, 0), cB, voffB); PG8_STAGE(PG8_SB(0, 1), cB + hstep, voffB); PG8_STAGE(PG8_SA(0, 0), cA, voffA); PG8_STAGE(PG8_SA(0, 1), cA + hstepA, voffA);
        if (wr == 1) PG8_BAR;
        PG8_WAIT_V(2); PG8_BAR;
        PG8_STAGE(PG8_SB(1, 0), cB + kstep, voffB); PG8_STAGE(PG8_SA(1, 0), cA + kstep, voffA); PG8_STAGE(PG8_SB(1, 1), cB + hstep + kstep, voffB);
        PG8_WAIT_V(6); PG8_BAR;
    } else {
        PG8_STAGE(PG8_SB(0, 0), cB, voffB); PG8_STAGE(PG8_SA(0, 0), cA, voffA); PG8_STAGE(PG8_SB(0, 1), cB + hstep, voffB); PG8_STAGE(PG8_SA(0, 1), cA + hstepA, voffA);
        if (wr == 1) PG8_BAR;
        PG8_WAIT_V(4); PG8_BAR;
        PG8_STAGE(PG8_SB(1, 0), cB + kstep, voffB); PG8_STAGE(PG8_SA(1, 0), cA + kstep, voffA); PG8_STAGE(PG8_SB(1, 1), cB + hstep + kstep, voffB);
        PG8_WAIT_V(6); PG8_BAR;
    }
    for (;;) {
        const bool has_next = S.next(ui + 1, nxt);
        const char* nA = has_next ? (const char*)g.A + (size_t)nxt.pm * tstepA : cA; const char* nB = has_next ? (const char*)g.Bt + (size_t)nxt.pn * tstep : cB;
        for (int t = 0; t < nt; t += 2) {
            const bool last = (t == nt - 2);
            const char* a1 = cA + (size_t)(t + 1) * kstep;
            const char* a2 = last ? nA : cA + (size_t)(t + 2) * kstep; const char* b2 = last ? nB : cB + (size_t)(t + 2) * kstep;
            const char* a3 = a2 + kstep; const char* b3 = b2 + kstep;
            if (last && has_next) S.a_ready(nxt);
            if constexpr (Epi::KSCALE) { if (t == Epi::KS1 || t == Epi::KS2) E.kscale(acc, cur, t, wr, fr); }
            if constexpr (SP2) {
            PG8_LDB(B0, 0, 0); PG8_LDB(B1, 0, 1); PG8_SCHED; PG8_LDA(At, 0, 0); PG8_STAGE(PG8_SA(1, 1), a1 + hstepA, voffA);
            PG8_WAIT_V(8); PG8_WAIT_L(0); PG8_BAR; PG8_MMA(0, 0, At, B0); PG8_MMA(0, 1, At, B1); PG8_BAR; PG8_SCHED;
            PG8_LDA(At, 0, 1); PG8_STAGE(PG8_SB(0, 0), b2, voffB); PG8_STAGE(PG8_SB(0, 1), b2 + hstep, voffB); PG8_STAGE(PG8_SA(0, 0), a2, voffA);
            PG8_WAIT_V(8); PG8_WAIT_L(0); PG8_BAR; PG8_MMA(1, 0, At, B0); PG8_MMA(1, 1, At, B1); PG8_BAR; PG8_SCHED;
            PG8_LDB(B0, 1, 0); PG8_LDB(B1, 1, 1); PG8_SCHED; PG8_LDA(At, 1, 0); PG8_STAGE(PG8_SA(0, 1), a2 + hstepA, voffA);
            PG8_WAIT_V(8); PG8_WAIT_L(0); PG8_BAR; PG8_MMA(0, 0, At, B0); PG8_MMA(0, 1, At, B1); PG8_BAR; PG8_SCHED;
            PG8_LDA(At, 1, 1); PG8_STAGE(PG8_SB(1, 0), b3, voffB); PG8_STAGE(PG8_SB(1, 1), b3 + hstep, voffB); PG8_STAGE(PG8_SA(1, 0), a3, voffA);
            PG8_WAIT_V(8); PG8_WAIT_L(0); PG8_BAR; PG8_MMA(1, 0, At, B0); PG8_MMA(1, 1, At, B1); PG8_BAR; PG8_SCHED;
            } else {
            PG8_LDB(B0, 0, 0); PG8_SCHED; PG8_LDA(At, 0, 0); PG8_STAGE(PG8_SA(1, 1), a1 + hstepA, voffA);
            PG8_WAIT_L(8); PG8_BAR; PG8_WAIT_L(0); PG8_MMA(0, 0, At, B0); PG8_BAR; PG8_SCHED;
            PG8_LDB(B1, 0, 1); PG8_STAGE(PG8_SB(0, 0), b2, voffB);
            PG8_BAR; PG8_WAIT_L(0); PG8_MMA(0, 1, At, B1); PG8_BAR;
            PG8_LDA(At, 0, 1); PG8_STAGE(PG8_SA(0, 0), a2, voffA);
            PG8_BAR; PG8_WAIT_L(0); PG8_MMA(1, 0, At, B0); PG8_BAR; PG8_SCHED;
            PG8_STAGE(PG8_SB(0, 1), b2 + hstep, voffB);
            PG8_WAIT_V(6); PG8_BAR; PG8_MMA(1, 1, At, B1); PG8_BAR;
            PG8_LDB(B0, 1, 0); PG8_SCHED; PG8_LDA(At, 1, 0); PG8_STAGE(PG8_SA(0, 1), a2 + hstepA, voffA);
            PG8_WAIT_L(8); PG8_BAR; PG8_WAIT_L(0); PG8_MMA(0, 0, At, B0); PG8_BAR; PG8_SCHED;
            PG8_LDB(B1, 1, 1); PG8_STAGE(PG8_SB(1, 0), b3, voffB);
            PG8_BAR; PG8_WAIT_L(0); PG8_MMA(0, 1, At, B1); PG8_BAR;
            PG8_LDA(At, 1, 1); PG8_STAGE(PG8_SA(1, 0), a3, voffA);
            PG8_BAR; PG8_WAIT_L(0); PG8_MMA(1, 0, At, B0); PG8_BAR; PG8_SCHED;
            PG8_STAGE(PG8_SB(1, 1), b3 + hstep, voffB);
            PG8_WAIT_V(6); PG8_BAR; PG8_MMA(1, 1, At, B1); PG8_BAR;
            }
        }
        if constexpr (ALIGN_EPI) { if (wr == 0) PG8_BAR; }
        if constexpr (!Epi::AFTER_DRAIN) { E(acc, cur, wr, wc, fr, fq); S.done(cur); }
        if (!has_next) break;
#pragma unroll
        for (int a = 0; a < 2; ++a)
#pragma unroll
            for (int b = 0; b < 2; ++b)
#pragma unroll
                for (int m = 0; m < 4; ++m)
#pragma unroll
                    for (int n = 0; n < 2; ++n) acc[a][b][m][n] = (f32x4){0.f, 0.f, 0.f, 0.f};
        cur = nxt; cA = nA; cB = nB; ++ui;
        if constexpr (ALIGN_EPI) { if (wr == 1) PG8_BAR; }
    }
    PG8_WAIT_V(0);
    if constexpr (!ALIGN_EPI) { if (wr == 0) PG8_BAR; }
    PG8_BAR;
    if constexpr (Epi::AFTER_DRAIN) { E.fused(acc, cur, wr, wc, fr, fq, lds, wid, lane); S.done(cur); }
#undef PG8_SA
#undef PG8_SB
#undef PG8_STAGE
#undef PG8_LDA
#undef PG8_LDB
#undef PG8_MMA
#undef PG8_WAIT_V
#undef PG8_WAIT_L
#undef PG8_BAR
#undef PG8_SCHED
}
}
#define LDS_WAIT() asm volatile("s_waitcnt lgkmcnt(0)" ::: "memory")
#define XB_TMO      128
#define XB_XCNT(j)  (256  + 64 * (j))
#define XB_XSUB(j)  (1280 + 64 * (j))
#define XB_XGEN(j)  (2304 + 64 * (j))
#define XB_TOP      3328
#define XB_TOPGEN   3392
#define XCD_BAR_WORDS 3456
#define XB_SPIN_CAP (1u << 18)

__device__ __forceinline__ unsigned xb_ld(unsigned* p)              { return __hip_atomic_load(p, __ATOMIC_RELAXED, __HIP_MEMORY_SCOPE_AGENT); }
__device__ __forceinline__ unsigned xb_add(unsigned* p, unsigned v) { return __hip_atomic_fetch_add(p, v, __ATOMIC_RELAXED, __HIP_MEMORY_SCOPE_AGENT); }
__device__ __forceinline__ unsigned xb_xcc_id() { return (unsigned)__builtin_amdgcn_s_getreg((3 << 11) | 20) & 0xFu; }
#define XB_SPIN(cond, bar) do { unsigned _sp = 0; while (cond) { __builtin_amdgcn_s_sleep(1); \
    if ((++_sp & 255u) == 0u) { if (xb_ld(&(bar)[XB_TMO])) break; if (_sp > XB_SPIN_CAP) { atomicAdd(&(bar)[XB_TMO], 1u); break; } } } } while (0)

struct XcdBarrier {
    unsigned* bar; unsigned x;
    volatile LAS unsigned* st;
};

__device__ __forceinline__ XcdBarrier xcd_barrier_post(unsigned* bar, volatile LAS unsigned* st) {
    XcdBarrier b; b.bar = bar; b.x = xb_xcc_id(); b.st = st;
    if (threadIdx.x == 0) (void)xb_add(&bar[XB_XCNT(b.x)], 1u);
    return b;
}
__device__ __forceinline__ void xcd_barrier_complete(unsigned* bar, unsigned x, unsigned& nloc, unsigned& nx) {
    const unsigned G = gridDim.x * gridDim.y * gridDim.z;
    unsigned sum, cnt, mine, sp = 0u;
    for (;;) {
        sum = 0u; cnt = 0u; mine = 0u;
#pragma unroll
        for (unsigned j = 0; j < 16; ++j) { const unsigned c = xb_ld(&bar[XB_XCNT(j)]); sum += c; cnt += (c > 0u) ? 1u : 0u; mine = (j == x) ? c : mine; }
        if (sum == G) break;
        __builtin_amdgcn_s_sleep(1);
        if ((++sp & 255u) == 0u) { if (xb_ld(&bar[XB_TMO])) break; if (sp > XB_SPIN_CAP) { atomicAdd(&bar[XB_TMO], 1u); break; } }
    }
    nloc = mine > 0u ? mine : 1u; nx = cnt > 0u ? cnt : 1u;
}

__device__ __forceinline__ void xcd_barrier(const XcdBarrier& b) {
    asm volatile("s_waitcnt vmcnt(0)" ::: "memory");
    __syncthreads();
    if (threadIdx.x == 0) {
        unsigned* bar = b.bar;
        __builtin_amdgcn_s_waitcnt(0);
        unsigned nloc = b.st[0], nx = b.st[1];
        if (nloc == 0u) { xcd_barrier_complete(bar, b.x, nloc, nx); b.st[0] = nloc; b.st[1] = nx; }
        const unsigned old = xb_add(&bar[XB_XSUB(b.x)], 1u);
        const unsigned gen = old / nloc;
        if (old + 1u == (gen + 1u) * nloc) {
            __builtin_amdgcn_fence(__ATOMIC_RELEASE, "agent");
            asm volatile("s_waitcnt vmcnt(0)" ::: "memory");
            const unsigned og = xb_add(&bar[XB_TOP], 1u);
            const unsigned tg = og / nx;
            if (og + 1u == (tg + 1u) * nx) xb_add(&bar[XB_TOPGEN], 1u);
            else XB_SPIN(xb_ld(&bar[XB_TOPGEN]) == tg, bar);
            __builtin_amdgcn_fence(__ATOMIC_ACQUIRE, "agent");
            xb_add(&bar[XB_XGEN(b.x)], 1u);
            asm volatile("s_waitcnt vmcnt(0)" ::: "memory");
        } else {
            XB_SPIN(xb_ld(&bar[XB_XGEN(b.x)]) == gen, bar);
            __builtin_amdgcn_fence(__ATOMIC_ACQUIRE, "agent");
            asm volatile("s_waitcnt vmcnt(0)" ::: "memory");
        }
    }
    __syncthreads();
}
#define SYNC() __syncthreads()
__device__ __forceinline__ float silu_fast(float v) { return v * __builtin_amdgcn_rcpf(1.f + __expf(-v)); }
__device__ __forceinline__ float sq2(unsigned w) { const float a = bflo(w), b = bfhi(w); return a * a + b * b; }

__device__ __forceinline__ void ph_mod(const Params& p, unsigned char* lds, int tid, int vb) {
    float* cact = (float*)lds; float* red = (float*)(lds + 65536);
    const int lane = tid & 63, wv = tid >> 6, c4 = lane & 31, kh = lane >> 5;
    for (int i = tid; i < NB * DM; i += NTHR) { const int b = i / DM, k = i % DM; cact[k * NB + b] = silu_f(p.c[i]); }
    SYNC();
    const int n = vb * 128 + 4 * c4;
    f32x4 acc[NB];
#pragma unroll
    for (int b = 0; b < NB; ++b) acc[b] = (f32x4){0.f, 0.f, 0.f, 0.f};
    const float* w = p.w_ada + (size_t)(wv * 256 + kh) * (6 * DM) + n;
#pragma unroll 8
    for (int i = 0; i < 128; ++i) {
        const f32x4 wk = *(const f32x4*)(w + (size_t)(2 * i) * (6 * DM));
        const f32x4 ca = *(const f32x4*)(cact + (wv * 256 + 2 * i + kh) * NB), cb = *(const f32x4*)(cact + (wv * 256 + 2 * i + kh) * NB + 4);
        acc[0] += wk * ca.x; acc[1] += wk * ca.y; acc[2] += wk * ca.z; acc[3] += wk * ca.w; acc[4] += wk * cb.x; acc[5] += wk * cb.y; acc[6] += wk * cb.z; acc[7] += wk * cb.w;
    }
#pragma unroll
    for (int b = 0; b < NB; ++b) { acc[b].x += __shfl_xor(acc[b].x, 32); acc[b].y += __shfl_xor(acc[b].y, 32); acc[b].z += __shfl_xor(acc[b].z, 32); acc[b].w += __shfl_xor(acc[b].w, 32); }
    if (lane < 32) {
#pragma unroll
        for (int b = 0; b < NB; ++b) *(f32x4*)(red + (wv * NB + b) * 128 + 4 * c4) = acc[b];
    }
    SYNC();
    for (int o = tid; o < NB * 128; o += NTHR) {
        const int b = o >> 7, col = o & 127;
        float s = p.b_ada[vb * 128 + col];
#pragma unroll
        for (int w8 = 0; w8 < 8; ++w8) s += red[(w8 * NB + b) * 128 + col];
        ((float*)(p.ws + WS_MOD))[b * 6 * DM + vb * 128 + col] = s;
    }
    SYNC();
}
__device__ __forceinline__ void ph_rope_tab(const Params& p, int gtid, int gn) {
    for (int i = gtid; i < T * 32; i += gn) {
        const int t = i >> 5, f = i & 31;
        const float inv = 1.0f / powf(10000.0f, (float)f * (2.0f / 64.0f));
        const float ang = (float)p.pos[t] * inv;
        ((float*)(p.ws + WS_ROPEC))[i] = (float)cos((double)ang);
        ((float*)(p.ws + WS_ROPES))[i] = (float)sin((double)ang);
    }
}
__device__ __forceinline__ void tr_item(const float* W, int K, int N, int Npad, bf16_t* WT, const float* g0, const float* g1, int gs, float* scr, int item, int lane) {
    const int nblk = Npad / 128, kb = item / nblk, nb = item % nblk, k0 = 32 * kb, n0 = 128 * nb;
    const int c4 = lane & 31, kh = lane >> 5, n = n0 + 4 * c4; const bool ok = n < N;
#pragma unroll 8
    for (int i = 0; i < 16; ++i) {
        const int kk = 2 * i + kh, k = k0 + kk;
        f32x4 v = ok ? *(const f32x4*)(W + (size_t)k * N + n) : (f32x4){0.f, 0.f, 0.f, 0.f};
        if (g0) v = v * ((k < gs) ? g0[k] : g1[k - gs]);
        *(f32x4*)(scr + kk * 132 + 4 * c4) = v;
    }
    asm volatile("s_waitcnt lgkmcnt(0)" ::: "memory");
#pragma unroll
    for (int j = 0; j < 8; ++j) {
        const int idx = lane + 64 * j, nn = idx >> 2, ck = idx & 3; const float* sp = scr + (8 * ck) * 132 + nn;
        u32x4 o; o.x = pk2(sp[0 * 132], sp[1 * 132]); o.y = pk2(sp[2 * 132], sp[3 * 132]); o.z = pk2(sp[4 * 132], sp[5 * 132]); o.w = pk2(sp[6 * 132], sp[7 * 132]);
        *(u32x4*)(WT + (size_t)(n0 + nn) * K + k0 + 8 * ck) = o;
    }
    asm volatile("s_waitcnt lgkmcnt(0)" ::: "memory");
}
constexpr int TR_N0 = (DM / 32) * (NPROJ / 128), TR_N1 = (512 / 32) * (NQ / 128), TR_N2 = (256 / 32) * (NKV / 128), TR_N3 = (DM / 32) * (DM / 128), TR_N4 = TR_N3;
constexpr int TR_TOTAL = TR_N0 + TR_N1 + TR_N2 + TR_N3 + TR_N4;
__device__ __forceinline__ void ph_transposes(const Params& p, unsigned char* lds, int wave, int lane, int first, int stride) {
    float* scr = (float*)(lds + wave * 17408);
    for (int it = first; it < TR_TOTAL; it += stride) {
        int r = it;
        if (r < TR_N0) { tr_item(p.w_in, DM, IN_COLS, NPROJ, (bf16_t*)(p.ws + WS_WINT), nullptr, nullptr, 0, scr, r, lane); continue; } r -= TR_N0;
        if (r < TR_N1) { tr_item(p.w_uq, 512, NQ, NQ, (bf16_t*)(p.ws + WS_WUQT), p.q_a_norm, p.q_a_norm, 512, scr, r, lane); continue; } r -= TR_N1;
        if (r < TR_N2) { tr_item(p.w_ukv, 256, NKV, NKV, (bf16_t*)(p.ws + WS_WUKVT), p.kv_a_norm, p.kv_a_norm, 256, scr, r, lane); continue; } r -= TR_N2;
        if (r < TR_N3) { tr_item(p.w_out, DM, DM, DM, (bf16_t*)(p.ws + WS_WOUTT), p.attn_out_norm, p.ssd_norm, 1024, scr, r, lane); continue; } r -= TR_N3;
        tr_item(p.w_query, DM, DM, DM, (bf16_t*)(p.ws + WS_WQT), nullptr, nullptr, 0, scr, r, lane);
    }
}
__device__ __forceinline__ void ph_convert(const float* src, bf16_t* dst, size_t n4, int gtid, int gn) {
    for (size_t i = gtid; i < n4; i += (size_t)gn) {
        const f32x4 v = ((const f32x4*)src)[i];
        uint2 o; o.x = pk2(v.x, v.y); o.y = pk2(v.z, v.w);
        ((uint2*)dst)[i] = o;
    }
}
__device__ __forceinline__ void ph_modrows(const float* in, bf16_t* outp, const float* mod, int sh_idx, int sc_idx, int gwave, int gnw, int lane) {
    for (int row = gwave; row < T; row += gnw) {
        const int b = row / SEQ;
        const f32x4* xr = (const f32x4*)(in + (size_t)row * DM) + lane;
        f32x4 v[8]; float s = 0.f;
#pragma unroll
        for (int j = 0; j < 8; ++j) { v[j] = xr[64 * j]; s += (v[j].x * v[j].x + v[j].y * v[j].y) + (v[j].z * v[j].z + v[j].w * v[j].w); }
        const float r = rsqrtf(wave_sum(s) * (1.f / DM) + EPS);
        const f32x4* sh = (const f32x4*)(mod + (size_t)b * 6 * DM + sh_idx * DM) + lane;
        const f32x4* sc = (const f32x4*)(mod + (size_t)b * 6 * DM + sc_idx * DM) + lane;
        uint2* o = (uint2*)(outp + (size_t)row * DM) + lane;
#pragma unroll
        for (int j = 0; j < 8; ++j) {
            const f32x4 a = sh[64 * j], m = sc[64 * j];
            uint2 w; w.x = pk2(v[j].x * r * (1.f + m.x) + a.x, v[j].y * r * (1.f + m.y) + a.y); w.y = pk2(v[j].z * r * (1.f + m.z) + a.z, v[j].w * r * (1.f + m.w) + a.w);
            o[64 * j] = w;
        }
    }
}
__device__ __forceinline__ void ph_bias2(const Params& p, int gwave, int gnw, int lane) {
    const float* mod = (const float*)(p.ws + WS_MOD);
    for (int n = gwave; n < DM; n += gnw) {
        const bf16_t* wr_ = (const bf16_t*)(p.ws + WS_WQT) + (size_t)n * DM + lane * 8;
        float wv[4][8];
#pragma unroll
        for (int j = 0; j < 4; ++j) { const u32x4 w = *(const u32x4*)(wr_ + j * 512);
            wv[j][0] = bflo(w.x); wv[j][1] = bfhi(w.x); wv[j][2] = bflo(w.y); wv[j][3] = bfhi(w.y); wv[j][4] = bflo(w.z); wv[j][5] = bfhi(w.z); wv[j][6] = bflo(w.w); wv[j][7] = bfhi(w.w); }
#pragma unroll
        for (int b = 0; b < NB; ++b) {
            const float* sh = mod + (size_t)b * 6 * DM + 3 * DM + lane * 8; float a = 0.f;
#pragma unroll
            for (int j = 0; j < 4; ++j) { const f32x4 s0 = *(const f32x4*)(sh + j * 512), s1 = *(const f32x4*)(sh + j * 512 + 4);
                a += (wv[j][0] * s0[0] + wv[j][1] * s0[1]) + (wv[j][2] * s0[2] + wv[j][3] * s0[3]) + (wv[j][4] * s1[0] + wv[j][5] * s1[1]) + (wv[j][6] * s1[2] + wv[j][7] * s1[3]); }
            a = wave_sum(a);
            if (lane == 0) ((float*)(p.ws + WS_BIAS2))[b * DM + n] = a;
        }
    }
}
constexpr float QSCALE = 0.07216878364870322f * 1.4426950408889634f;
__device__ __forceinline__ float ssq8(u32x4 w) { return (sq2(w.x) + sq2(w.y)) + (sq2(w.z) + sq2(w.w)); }
__device__ __forceinline__ u32x4 scale8(u32x4 w, float s, const float (&g)[8]) {
    u32x4 o; o.x = pk2(bflo(w.x) * s * g[0], bfhi(w.x) * s * g[1]); o.y = pk2(bflo(w.y) * s * g[2], bfhi(w.y) * s * g[3]);
    o.z = pk2(bflo(w.z) * s * g[4], bfhi(w.z) * s * g[5]); o.w = pk2(bflo(w.w) * s * g[6], bfhi(w.w) * s * g[7]); return o;
}
__device__ __forceinline__ u32x4 rope8(u32x4 w, u32x4 pw, float s, const float (&go)[8], const float (&gp)[8], f32x4 c0, f32x4 c1, f32x4 s0, f32x4 s1, float sgn) {
    const float a[8] = {bflo(w.x) * s * go[0], bfhi(w.x) * s * go[1], bflo(w.y) * s * go[2], bfhi(w.y) * s * go[3], bflo(w.z) * s * go[4], bfhi(w.z) * s * go[5], bflo(w.w) * s * go[6], bfhi(w.w) * s * go[7]};
    const float b[8] = {bflo(pw.x) * s * gp[0], bfhi(pw.x) * s * gp[1], bflo(pw.y) * s * gp[2], bfhi(pw.y) * s * gp[3], bflo(pw.z) * s * gp[4], bfhi(pw.z) * s * gp[5], bflo(pw.w) * s * gp[6], bfhi(pw.w) * s * gp[7]};
    u32x4 o;
    o.x = pk2(a[0] * c0.x + sgn * b[0] * s0.x, a[1] * c0.y + sgn * b[1] * s0.y); o.y = pk2(a[2] * c0.z + sgn * b[2] * s0.z, a[3] * c0.w + sgn * b[3] * s0.w);
    o.z = pk2(a[4] * c1.x + sgn * b[4] * s1.x, a[5] * c1.y + sgn * b[5] * s1.y); o.w = pk2(a[6] * c1.z + sgn * b[6] * s1.z, a[7] * c1.w + sgn * b[7] * s1.w);
    return o;
}
__device__ __forceinline__ u32x4 shfl_xor4(u32x4 w, int m) { u32x4 o; o.x = __shfl_xor(w.x, m); o.y = __shfl_xor(w.y, m); o.z = __shfl_xor(w.z, m); o.w = __shfl_xor(w.w, m); return o; }
__device__ __forceinline__ void ph_qkv_post(const Params& p, int gwave, int gnw, int lane) {
    unsigned char* ws = p.ws;
    const int g16 = lane >> 4, pos = lane & 15, hr = lane >> 3, rpos = lane & 7, f0 = (rpos & 3) * 8;
    const float sgn = (rpos < 4) ? -1.f : 1.f;
    float gqn[8], gqr[8], gqp[8], gkn[8], gkr[8], gkp[8];
#pragma unroll
    for (int i = 0; i < 8; ++i) { gqn[i] = p.q_norm[pos * 8 + i]; gqr[i] = p.q_norm[128 + rpos * 8 + i]; gqp[i] = p.q_norm[128 + (rpos ^ 4) * 8 + i];
                                  gkn[i] = p.k_norm[pos * 8 + i]; gkr[i] = p.k_norm[128 + rpos * 8 + i]; gkp[i] = p.k_norm[128 + (rpos ^ 4) * 8 + i]; }
    for (int t = gwave; t < T; t += gnw) {
        const bf16_t* proj = (const bf16_t*)(ws + WS_PROJ) + (size_t)t * NPROJ;
        const bf16_t* qraw = (const bf16_t*)(ws + WS_QRAW) + (size_t)t * NQ;
        const bf16_t* kvraw = (const bf16_t*)(ws + WS_KVRAW) + (size_t)t * NKV;
        const u32x4 cq = *(const u32x4*)(proj + C_CQ + lane * 8);
        const u32x4 ck = *(const u32x4*)(proj + C_CKV + (lane & 31) * 8);
        const u32x4 kr = *(const u32x4*)(proj + C_KR + rpos * 8);
        const u32x4 qn0 = *(const u32x4*)(qraw + g16 * 192 + pos * 8), qn1 = *(const u32x4*)(qraw + (4 + g16) * 192 + pos * 8), qr = *(const u32x4*)(qraw + hr * 192 + 128 + rpos * 8);
        const u32x4 kn0 = *(const u32x4*)(kvraw + g16 * 256 + pos * 8), kn1 = *(const u32x4*)(kvraw + (4 + g16) * 256 + pos * 8);
        const u32x4 v0 = *(const u32x4*)(kvraw + g16 * 256 + 128 + pos * 8), v1 = *(const u32x4*)(kvraw + (4 + g16) * 256 + 128 + pos * 8);
        const float* rcp = (const float*)(ws + WS_ROPEC) + (size_t)t * 32 + f0; const float* rsp = (const float*)(ws + WS_ROPES) + (size_t)t * 32 + f0;
        const f32x4 c0 = *(const f32x4*)rcp, c1 = *(const f32x4*)(rcp + 4), s0 = *(const f32x4*)rsp, s1 = *(const f32x4*)(rsp + 4);
        const float rcq = rsqrtf(wave_sum(ssq8(cq)) * (1.f / 512.f) + EPS);
        const float rckv = rsqrtf(wave_sum(lane < 32 ? ssq8(ck) : 0.f) * (1.f / 256.f) + EPS);
        float skr = ssq8(kr), nq0 = ssq8(qn0), nq1 = ssq8(qn1), rqs = ssq8(qr), nk0 = ssq8(kn0), nk1 = ssq8(kn1);
#pragma unroll
        for (int o = 1; o < 8; o <<= 1) { skr += __shfl_xor(skr, o); rqs += __shfl_xor(rqs, o); nq0 += __shfl_xor(nq0, o); nq1 += __shfl_xor(nq1, o); nk0 += __shfl_xor(nk0, o); nk1 += __shfl_xor(nk1, o); }
        nq0 += __shfl_xor(nq0, 8); nq1 += __shfl_xor(nq1, 8); nk0 += __shfl_xor(nk0, 8); nk1 += __shfl_xor(nk1, 8);
        const float rc2 = rcq * rcq, rk2 = rckv * rckv;
        const float tq0 = nq0 + __shfl(rqs, 8 * g16), tq1 = nq1 + __shfl(rqs, 8 * (4 + g16));
        const float tqa = __shfl(nq0, 16 * (hr & 3)), tqb = __shfl(nq1, 16 * (hr & 3));
        const float tqr = rqs + ((hr < 4) ? tqa : tqb);
        const float sq0 = rsqrtf(tq0 * rc2 * (1.f / 192.f) + EPS) * rcq * QSCALE, sq1 = rsqrtf(tq1 * rc2 * (1.f / 192.f) + EPS) * rcq * QSCALE, sqr = rsqrtf(tqr * rc2 * (1.f / 192.f) + EPS) * rcq * QSCALE;
        const float rk0 = rsqrtf((nk0 * rk2 + skr) * (1.f / 192.f) + EPS), rk1 = rsqrtf((nk1 * rk2 + skr) * (1.f / 192.f) + EPS);
        const float rka = __shfl(rk0, 16 * (hr & 3)), rkb = __shfl(rk1, 16 * (hr & 3));
        const float rkr = (hr < 4) ? rka : rkb;
        const u32x4 pqr = shfl_xor4(qr, 4), pkr = shfl_xor4(kr, 4);
        const int b = t / SEQ, sidx = t % SEQ;
        bf16_t* Q0 = (bf16_t*)(ws + WS_Q) + ((size_t)(b * 8 + g16) * SEQ + sidx) * 192; bf16_t* Q1 = Q0 + (size_t)4 * SEQ * 192; bf16_t* Qr = (bf16_t*)(ws + WS_Q) + ((size_t)(b * 8 + hr) * SEQ + sidx) * 192;
        bf16_t* K0 = (bf16_t*)(ws + WS_K) + ((size_t)(b * 8 + g16) * SEQ + sidx) * 192; bf16_t* K1 = K0 + (size_t)4 * SEQ * 192; bf16_t* Kr = (bf16_t*)(ws + WS_K) + ((size_t)(b * 8 + hr) * SEQ + sidx) * 192;
        bf16_t* V0 = (bf16_t*)(ws + WS_V) + ((size_t)(b * 8 + g16) * SEQ + sidx) * 128; bf16_t* V1 = V0 + (size_t)4 * SEQ * 128;
        *(u32x4*)(Q0 + pos * 8) = scale8(qn0, sq0, gqn); *(u32x4*)(Q1 + pos * 8) = scale8(qn1, sq1, gqn);
        *(u32x4*)(Qr + 128 + rpos * 8) = rope8(qr, pqr, sqr, gqr, gqp, c0, c1, s0, s1, sgn);
        *(u32x4*)(K0 + pos * 8) = scale8(kn0, rckv * rk0, gkn); *(u32x4*)(K1 + pos * 8) = scale8(kn1, rckv * rk1, gkn);
        *(u32x4*)(Kr + 128 + rpos * 8) = rope8(kr, pkr, rkr, gkr, gkp, c0, c1, s0, s1, sgn);
        const float one[8] = {1.f, 1.f, 1.f, 1.f, 1.f, 1.f, 1.f, 1.f};
        *(u32x4*)(V0 + pos * 8) = scale8(v0, rckv, one); *(u32x4*)(V1 + pos * 8) = scale8(v1, rckv, one);
    }
}
__device__ __forceinline__ void ph_attn_naive(const Params& p, unsigned char* lds, int tid, int bid, int G) {
    const int lane = tid & 63, wv = tid >> 6;
    float* ps = (float*)lds + wv * SEQ;
    float* qs = (float*)(lds + 65536) + wv * 192;
    for (int it = 0; it < (T * 8) / (G * 8); ++it) {
        const int sb = (it & 1) ? (G - 1 - bid) : bid;
        const int gi = it * (G * 8) + sb * 8 + wv;
        const int bh = gi / SEQ, s = gi % SEQ, b = bh >> 3, h = bh & 7;
        const bf16_t* Q = (const bf16_t*)(p.ws + WS_Q) + (size_t)gi * 192;
        const bf16_t* K = (const bf16_t*)(p.ws + WS_K) + (size_t)bh * SEQ * 192;
        const bf16_t* V = (const bf16_t*)(p.ws + WS_KVRAW) + (size_t)(b * SEQ) * NKV + h * 256 + 128;
        for (int d = lane; d < 192; d += 64) qs[d] = bf2f(Q[d]);
        SYNC();
        float mx = -1e30f;
        for (int k0 = 0; k0 <= s; k0 += 64) {
            const int key = k0 + lane; float sc = -INFINITY;
            if (key <= s) {
                const u32x4* kp = (const u32x4*)(K + (size_t)key * 192); float a = 0.f;
                for (int c = 0; c < 24; ++c) { const u32x4 w = kp[c]; const float* q = &qs[c * 8];
                    a += bflo(w.x) * q[0] + bfhi(w.x) * q[1] + bflo(w.y) * q[2] + bfhi(w.y) * q[3] + bflo(w.z) * q[4] + bfhi(w.z) * q[5] + bflo(w.w) * q[6] + bfhi(w.w) * q[7]; }
                sc = a;
            }
            ps[key] = sc;
            mx = fmaxf(mx, sc);
        }
#pragma unroll
        for (int o = 1; o < 64; o <<= 1) mx = fmaxf(mx, __shfl_xor(mx, o));
        SYNC();
        float sum = 0.f;
        for (int key = lane; key <= s; key += 64) { const float e = exp2f(ps[key] - mx); ps[key] = e; sum += e; }
        sum = wave_sum(sum);
        SYNC();
        float o0 = 0.f, o1 = 0.f;
        for (int key = 0; key <= s; ++key) { const float pr = ps[key]; const unsigned w = *(const unsigned*)(V + (size_t)key * NKV + 2 * lane); o0 += pr * bflo(w); o1 += pr * bfhi(w); }
        const float inv = 1.f / sum; o0 *= inv; o1 *= inv;
        const int t = b * SEQ + s;
        *(unsigned*)((bf16_t*)(p.ws + WS_ATTN) + (size_t)t * 1024 + h * 128 + 2 * lane) = pk2(o0, o1);
        SYNC();
    }
}
__device__ __forceinline__ void ph_conv_naive(const Params& p, int gtid, int gn) {
    const bf16_t* proj = (const bf16_t*)(p.ws + WS_PROJ);
    for (int i = gtid; i < T * 1552; i += gn) {
        const int t = i / 1552, c = i % 1552, s = t % SEQ;
        if (c < 1536) {
            float a = p.conv_b[c];
            for (int k = 0; k < 4; ++k) { const int ss = s - 3 + k; if (ss >= 0) a += p.conv_w[k * 1536 + c] * bf2f(proj[(size_t)(t - 3 + k) * NPROJ + C_XBC + c]); }
            ((bf16_t*)(p.ws + WS_XBCA))[(size_t)t * 1536 + c] = (bf16_t)f2bf(silu_f(a));
        } else {
            const int hh = c - 1536; const float v = bf2f(proj[(size_t)t * NPROJ + C_DT + hh]) + p.dt_bias[hh];
            ((float*)(p.ws + WS_DT))[(size_t)t * 16 + hh] = (v > 20.f) ? v : log1pf(__expf(v));
        }
    }
}
__device__ __forceinline__ void ph_ssd_naive(const Params& p, int vb, int lt) {
    const int b = vb >> 4, h = vb & 15, g = h >> 3, pp = lt >> 2, nq = lt & 3;
    const bf16_t* xa = (const bf16_t*)(p.ws + WS_XBCA); const float* dtp = (const float*)(p.ws + WS_DT);
    const bf16_t* proj = (const bf16_t*)(p.ws + WS_PROJ);
    const float a = -__expf(p.a_log[h]), dsk = p.d_skip[h];
    float st[32];
#pragma unroll
    for (int n = 0; n < 32; ++n) st[n] = 0.f;
    for (int s = 0; s < SEQ; ++s) {
        const size_t t = (size_t)b * SEQ + s;
        const float dt = dtp[t * 16 + h], dA = __expf(dt * a);
        const float xv = bf2f(xa[t * 1536 + h * 64 + pp]);
        const bf16_t* Bp = xa + t * 1536 + 1024 + g * 128 + nq * 32; const bf16_t* Cp = xa + t * 1536 + 1280 + g * 128 + nq * 32;
        float y = 0.f; const float dx = dt * xv;
#pragma unroll
        for (int n = 0; n < 32; ++n) { st[n] = st[n] * dA + dx * bf2f(Bp[n]); y += bf2f(Cp[n]) * st[n]; }
        y += __shfl_xor(y, 1); y += __shfl_xor(y, 2);
        if (nq == 0) {
            const float z = bf2f(proj[t * NPROJ + C_Z + h * 64 + pp]);
            ((bf16_t*)(p.ws + WS_YSSD))[t * 1024 + h * 64 + pp] = (bf16_t)f2bf((y + dsk * xv) * silu_f(z));
        }
    }
}
__device__ __forceinline__ void ph_mixnorm(const Params& p, int gwave, int gnw, int lane) {
    for (int t = gwave; t < T; t += gnw) {
        const uint2* ain = (const uint2*)((const bf16_t*)(p.ws + WS_ATTN) + (size_t)t * 1024); const uint2* yin = (const uint2*)((const bf16_t*)(p.ws + WS_YSSD) + (size_t)t * 1024);
        uint2 a[4], y[4]; float sa = 0.f, s0 = 0.f, s1 = 0.f;
#pragma unroll
        for (int j = 0; j < 4; ++j) { a[j] = ain[lane + 64 * j]; y[j] = yin[lane + 64 * j]; sa += sq2(a[j].x) + sq2(a[j].y); const float q = sq2(y[j].x) + sq2(y[j].y); if (j < 2) s0 += q; else s1 += q; }
        const float ra = rsqrtf(wave_sum(sa) * (1.f / 1024.f) + EPS), r0 = rsqrtf(wave_sum(s0) * (1.f / 512.f) + EPS), r1 = rsqrtf(wave_sum(s1) * (1.f / 512.f) + EPS);
        uint2* o = (uint2*)((bf16_t*)(p.ws + WS_MIXIN) + (size_t)t * DM);
#pragma unroll
        for (int j = 0; j < 4; ++j) {
            uint2 r; r.x = pk2(bflo(a[j].x) * ra, bfhi(a[j].x) * ra); r.y = pk2(bflo(a[j].y) * ra, bfhi(a[j].y) * ra); o[lane + 64 * j] = r;
            const float rr = (j < 2) ? r0 : r1;
            uint2 q; q.x = pk2(bflo(y[j].x) * rr, bfhi(y[j].x) * rr); q.y = pk2(bflo(y[j].y) * rr, bfhi(y[j].y) * rr); o[256 + lane + 64 * j] = q;
        }
    }
}
__device__ __forceinline__ void ph_route_naive(const Params& p, unsigned char* lds, int tid, int bid, int G) {
    const int sub = tid >> 7, lt = tid & 127;
    float* base = (float*)(lds + sub * 4096);
    float* q = base; float* sc = base + 256; float* ts = base + 512; int* ti = (int*)(base + 544); float* cs = base + 576; float* bs = base + 832; int* bi = (int*)(base + 848);
    const bf16_t* sk = (const bf16_t*)(p.ws + WS_SUBK);
    for (int it = 0; it < (T * 8) / (G * 4); ++it) {
        const int vb = it * (G * 4) + bid * 4 + sub, t = vb >> 3, h = vb & 7;
        const bf16_t* qp = (const bf16_t*)(p.ws + WS_QP) + (size_t)t * DM + h * 256;
        q[lt] = bf2f(qp[lt]); q[128 + lt] = bf2f(qp[128 + lt]);
        SYNC();
#pragma unroll
        for (int j = 0; j < 2; ++j) {
            const u32x4* kp = (const u32x4*)(sk + ((size_t)(h * 2 + j) * 128 + lt) * 128); float a = 0.f;
            for (int c = 0; c < 16; ++c) { const u32x4 w = kp[c]; const float* qq = q + j * 128 + c * 8;
                a += bflo(w.x) * qq[0] + bfhi(w.x) * qq[1] + bflo(w.y) * qq[2] + bfhi(w.y) * qq[3] + bflo(w.z) * qq[4] + bfhi(w.z) * qq[5] + bflo(w.w) * qq[6] + bfhi(w.w) * qq[7]; }
            sc[j * 128 + lt] = a;
        }
        SYNC();
#pragma unroll
        for (int j = 0; j < 2; ++j) {
            const float v = sc[j * 128 + lt]; int rank = 0;
            for (int k = 0; k < 128; ++k) { const float o = sc[j * 128 + k]; rank += (o > v || (o == v && k < lt)) ? 1 : 0; }
            if (rank < 16) { ts[j * 16 + rank] = v; ti[j * 16 + rank] = lt; }
        }
        SYNC();
        cs[lt] = ts[lt >> 4] + ts[16 + (lt & 15)]; cs[128 + lt] = ts[8 + (lt >> 4)] + ts[16 + (lt & 15)];
        SYNC();
#pragma unroll
        for (int r = 0; r < 2; ++r) {
            const int ci = lt + 128 * r; const float v = cs[ci]; int rank = 0;
            for (int k = 0; k < 256; ++k) { const float o = cs[k]; rank += (o > v || (o == v && k < ci)) ? 1 : 0; }
            if (rank < 16) { bs[rank] = v; bi[rank] = ti[ci >> 4] * 128 + ti[16 + (ci & 15)]; }
        }
        SYNC();
        if (lt < 16) {
            const float mx = bs[0]; float sum = 0.f;
            for (int k = 0; k < 16; ++k) sum += __expf(bs[k] - mx);
            ((float*)(p.ws + WS_GATE))[(size_t)t * 128 + h * 16 + lt] = __expf(bs[lt] - mx) / sum;
            ((int*)(p.ws + WS_IDX))[(size_t)t * 128 + h * 16 + lt] = bi[lt];
        }
        SYNC();
    }
}
__device__ __forceinline__ void ph_peer_naive(const Params& p, unsigned char* lds, int tid, int bid, int G) {
    const int half = tid >> 8, lt = tid & 255, lane = tid & 63, wv = lt >> 6;
    float* red = (float*)(lds + half * 64);
    const bf16_t* U = (const bf16_t*)(p.ws + WS_U16); const bf16_t* V = (const bf16_t*)(p.ws + WS_V16);
    for (int it = 0; it < T / (G * 2); ++it) {
        const int t = it * (G * 2) + bid * 2 + half, b = t / SEQ;
        const u32x4 hw = *(const u32x4*)((const bf16_t*)(p.ws + WS_H2) + (size_t)t * DM + lt * 8);
        const float h0 = bflo(hw.x), h1 = bfhi(hw.x), h2 = bflo(hw.y), h3 = bfhi(hw.y), h4 = bflo(hw.z), h5 = bfhi(hw.z), h6 = bflo(hw.w), h7 = bfhi(hw.w);
        float o0 = 0.f, o1 = 0.f, o2 = 0.f, o3 = 0.f, o4 = 0.f, o5 = 0.f, o6 = 0.f, o7 = 0.f;
        const int* idx = (const int*)(p.ws + WS_IDX) + (size_t)t * 128; const float* gate = (const float*)(p.ws + WS_GATE) + (size_t)t * 128;
        for (int e = 0; e < 128; ++e) {
            const int ex = idx[e];
            const u32x4 uw = *(const u32x4*)(U + (size_t)ex * DM + lt * 8);
            float d = bflo(uw.x) * h0 + bfhi(uw.x) * h1 + bflo(uw.y) * h2 + bfhi(uw.y) * h3 + bflo(uw.z) * h4 + bfhi(uw.z) * h5 + bflo(uw.w) * h6 + bfhi(uw.w) * h7;
            d = wave_sum(d);
            if (lane == 0) red[wv] = d;
            SYNC();
            const float pre = red[0] + red[1] + red[2] + red[3];
            const float a = 0.5f * pre * (1.f + erff(pre * 0.70710678118654752f)) * gate[e];
            SYNC();
            const u32x4 vw = *(const u32x4*)(V + (size_t)ex * DM + lt * 8);
            o0 += a * bflo(vw.x); o1 += a * bfhi(vw.x); o2 += a * bflo(vw.y); o3 += a * bfhi(vw.y); o4 += a * bflo(vw.z); o5 += a * bfhi(vw.z); o6 += a * bflo(vw.w); o7 += a * bfhi(vw.w);
        }
        const float* g2 = (const float*)(p.ws + WS_MOD) + (size_t)b * 6 * DM + 5 * DM + lt * 8;
        float* outp = p.out + (size_t)t * DM + lt * 8;
        const f32x4 x0 = *(const f32x4*)outp, x1 = *(const f32x4*)(outp + 4), ga = *(const f32x4*)g2, gb = *(const f32x4*)(g2 + 4);
        *(f32x4*)outp = (f32x4){x0.x + ga.x * o0, x0.y + ga.y * o1, x0.z + ga.z * o2, x0.w + ga.w * o3};
        *(f32x4*)(outp + 4) = (f32x4){x1.x + gb.x * o4, x1.y + gb.y * o5, x1.z + gb.z * o6, x1.w + gb.w * o7};
    }
}
typedef __bf16 bf16x2_t __attribute__((ext_vector_type(2)));
__device__ __forceinline__ float dot2bf(unsigned a, unsigned b, float c) { return __builtin_amdgcn_fdot2_f32_bf16(__builtin_bit_cast(bf16x2_t, a), __builtin_bit_cast(bf16x2_t, b), c, false); }
__device__ __forceinline__ void ph_peer(const Params& p, LAS unsigned char* ldsl, int wave, int lane, int gwave, int gnw) {
    LAS unsigned char* ring = ldsl + wave * 16384;
    const bf16_t* U = (const bf16_t*)(p.ws + WS_U16); const bf16_t* V = (const bf16_t*)(p.ws + WS_V16);
    const int e_lane = (lane >> 2) & 15; const unsigned lane16 = (unsigned)lane * 16u;
#define PEER_ISSUE(R) do { const int R_ = (R); const int i_ = ((R_ >> 5) << 4) + (R_ & 15); \
        const int e_ = (i_ < 64) ? __builtin_amdgcn_readlane(idx0, i_) : __builtin_amdgcn_readlane(idx1, i_ - 64); \
        const char* base_ = (const char*)(((R_ >> 4) & 1) ? V : U) + (size_t)(unsigned)e_ * (DM * 2); \
        const unsigned* src_ = (const unsigned*)(base_ + lane16); \
        LAS unsigned* dst_ = (LAS unsigned*)(ring + (R_ & 3) * 4096); \
        __builtin_amdgcn_global_load_lds(src_, dst_, 16, 0, 0); \
        __builtin_amdgcn_global_load_lds(src_, dst_, 16, 1024, 0); \
        __builtin_amdgcn_global_load_lds(src_, dst_, 16, 2048, 0); \
        __builtin_amdgcn_global_load_lds(src_, dst_, 16, 3072, 0); } while (0)
#define PEER_WAIT(n) asm volatile("s_waitcnt vmcnt(" #n ")" ::: "memory")
    for (int t = gwave; t < T; t += gnw) {
        const int b = t / SEQ;
        const int idx0 = ((const int*)(p.ws + WS_IDX))[(size_t)t * 128 + lane], idx1 = ((const int*)(p.ws + WS_IDX))[(size_t)t * 128 + 64 + lane];
        const float g0 = ((const float*)(p.ws + WS_GATE))[(size_t)t * 128 + lane], g1 = ((const float*)(p.ws + WS_GATE))[(size_t)t * 128 + 64 + lane];
        u32x4 hreg[4];
#pragma unroll
        for (int j = 0; j < 4; ++j) hreg[j] = *(const u32x4*)((const bf16_t*)(p.ws + WS_H2) + (size_t)t * DM + j * 512 + lane * 8);
        float out[4][8];
#pragma unroll
        for (int j = 0; j < 4; ++j)
#pragma unroll
            for (int i = 0; i < 8; ++i) out[j][i] = 0.f;
        PEER_ISSUE(0); PEER_ISSUE(1); PEER_ISSUE(2);
        for (int hh = 0; hh < 8; ++hh) {
            float pd[16];
#pragma unroll
            for (int k = 0; k < 16; ++k) {
                PEER_ISSUE(hh * 32 + k + 3); PEER_WAIT(12);
                const LAS unsigned char* sl = ring + (k & 3) * 4096 + lane * 16;
                float a = 0.f;
#pragma unroll
                for (int j = 0; j < 4; ++j) { const u32x4 w = *(const LAS u32x4*)(sl + j * 1024);
                    a = dot2bf(w.x, hreg[j].x, a); a = dot2bf(w.y, hreg[j].y, a); a = dot2bf(w.z, hreg[j].z, a); a = dot2bf(w.w, hreg[j].w, a); }
                asm volatile("" : "+v"(a));
                pd[k] = a;
            }
            float q8[8], q4[4], q2[2], q1;
            { const bool hi = (lane & 32) != 0;
#pragma unroll
              for (int i = 0; i < 8; ++i) { const float keep = hi ? pd[i + 8] : pd[i], send = hi ? pd[i] : pd[i + 8]; q8[i] = keep + __shfl_xor(send, 32); } }
            { const bool hi = (lane & 16) != 0;
#pragma unroll
              for (int i = 0; i < 4; ++i) { const float keep = hi ? q8[i + 4] : q8[i], send = hi ? q8[i] : q8[i + 4]; q4[i] = keep + __shfl_xor(send, 16); } }
            { const bool hi = (lane & 8) != 0;
#pragma unroll
              for (int i = 0; i < 2; ++i) { const float keep = hi ? q4[i + 2] : q4[i], send = hi ? q4[i] : q4[i + 2]; q2[i] = keep + __shfl_xor(send, 8); } }
            { const bool hi = (lane & 4) != 0; const float keep = hi ? q2[1] : q2[0], send = hi ? q2[0] : q2[1]; q1 = keep + __shfl_xor(send, 4); }
            q1 += __shfl_xor(q1, 1); q1 += __shfl_xor(q1, 2);
            const float gsel = (hh < 4) ? g0 : g1;
            const float gate = __shfl(gsel, (hh & 3) * 16 + e_lane);
            const float act = 0.5f * q1 * (1.f + erff(q1 * 0.70710678118654752f)) * gate;
#pragma unroll
            for (int k = 0; k < 16; ++k) {
                if (k < 13) { PEER_ISSUE(hh * 32 + 16 + k + 3); PEER_WAIT(12); }
                else if (hh < 7) { PEER_ISSUE(hh * 32 + 16 + k + 3); PEER_WAIT(12); }
                else if (k == 13) PEER_WAIT(8); else if (k == 14) PEER_WAIT(4); else PEER_WAIT(0);
                const float a = __builtin_bit_cast(float, __builtin_amdgcn_readlane(__builtin_bit_cast(int, act), 4 * k));
                const LAS unsigned char* sl = ring + (k & 3) * 4096 + lane * 16;
#pragma unroll
                for (int j = 0; j < 4; ++j) { const u32x4 w = *(const LAS u32x4*)(sl + j * 1024);
                    out[j][0] += a * bflo(w.x); out[j][1] += a * bfhi(w.x); out[j][2] += a * bflo(w.y); out[j][3] += a * bfhi(w.y);
                    out[j][4] += a * bflo(w.z); out[j][5] += a * bfhi(w.z); out[j][6] += a * bflo(w.w); out[j][7] += a * bfhi(w.w);
                    asm volatile("" : "+v"(out[j][0]), "+v"(out[j][1]), "+v"(out[j][2]), "+v"(out[j][3]), "+v"(out[j][4]), "+v"(out[j][5]), "+v"(out[j][6]), "+v"(out[j][7])); }
            }
        }
        const float* g2 = (const float*)(p.ws + WS_MOD) + (size_t)b * 6 * DM + 5 * DM;
        float* outp = p.out + (size_t)t * DM;
#pragma unroll
        for (int j = 0; j < 4; ++j) {
            const int c = j * 512 + lane * 8;
            const f32x4 x0 = *(const f32x4*)(outp + c), x1 = *(const f32x4*)(outp + c + 4), ga = *(const f32x4*)(g2 + c), gb = *(const f32x4*)(g2 + c + 4);
            *(f32x4*)(outp + c) = (f32x4){x0.x + ga.x * out[j][0], x0.y + ga.y * out[j][1], x0.z + ga.z * out[j][2], x0.w + ga.w * out[j][3]};
            *(f32x4*)(outp + c + 4) = (f32x4){x1.x + gb.x * out[j][4], x1.y + gb.y * out[j][5], x1.z + gb.z * out[j][6], x1.w + gb.w * out[j][7]};
        }
    }
#undef PEER_ISSUE
#undef PEER_WAIT
}
typedef short bf16x8 __attribute__((ext_vector_type(8)));
typedef short s16x4 __attribute__((ext_vector_type(4)));
typedef float f32x16 __attribute__((ext_vector_type(16)));
typedef float f32x2_t __attribute__((ext_vector_type(2)));
__device__ __forceinline__ int crow(int r, int hi) { return (r & 3) + 8 * (r >> 2) + 4 * hi; }
__device__ __forceinline__ unsigned cvtpk(float lo, float hi) { f32x2_t v = {lo, hi}; bf16x2_t b = __builtin_convertvector(v, bf16x2_t); return __builtin_bit_cast(unsigned, b); }
__device__ __forceinline__ s16x4 vtr(const LAS unsigned char* pp) { return __builtin_bit_cast(s16x4, __builtin_amdgcn_ds_read_tr16_b64_v4i16((LAS s16x4*)pp)); }
#define TR_PAIR(lo_, hi_, addr_, off_, hioff_) do { asm volatile("ds_read_b64_tr_b16 %0, %1 offset:%c2" : "=&v"(lo_) : "v"(addr_), "i"(off_) : "memory"); \
        asm volatile("ds_read_b64_tr_b16 %0, %1 offset:%c2" : "=&v"(hi_) : "v"(addr_), "i"((off_) + (hioff_)) : "memory"); } while (0)
#define LDS_WAIT_PIN() do { asm volatile("s_waitcnt lgkmcnt(0)" ::: "memory"); __builtin_amdgcn_sched_barrier(0); } while (0)
constexpr int AT_SLOT = 40960, AT_VOFF = 24576;
__device__ __forceinline__ void attn_unit(const Params& p, LAS unsigned char* ldsl, int bh, int qb, int wave, int lane) {
    const int r32 = lane & 31, hi = lane >> 5, b = bh >> 3, h = bh & 7;
    const bf16_t* Kbh = (const bf16_t*)(p.ws + WS_K) + (size_t)bh * SEQ * 192;
    const bf16_t* Vb = (const bf16_t*)(p.ws + WS_V) + (size_t)bh * SEQ * 128;
    const bf16_t* Qw = (const bf16_t*)(p.ws + WS_Q) + ((size_t)bh * SEQ + qb * 256 + wave * 32 + r32) * 192 + 8 * hi;
    const int NT = (qb * 256 + 256) / 64;
    int koff[3];
#pragma unroll
    for (int i = 0; i < 3; ++i) { const int o = 64 * (wave * 3 + i) + lane, k = o / 24, sl = o - 24 * k; int c = sl - ((k >> 1) & 7); c += (c < 0) ? 24 : 0; koff[i] = k * 192 + c * 8; }
    const int vid = wave * 2;
    const bf16_t* vsrc = Vb + (size_t)(16 * (vid & 3) + (lane >> 2)) * 128 + (vid >> 2) * 32 + (lane & 3) * 8;
#define AT_ISSUE(t, slot) do { const bf16_t* ks_ = Kbh + (size_t)(t) * 64 * 192; LAS unsigned char* sb_ = ldsl + (slot) * AT_SLOT; \
        __builtin_amdgcn_global_load_lds((const unsigned*)(ks_ + koff[0]), (LAS unsigned*)(sb_ + (wave * 3 + 0) * 1024), 16, 0, 0); \
        __builtin_amdgcn_global_load_lds((const unsigned*)(ks_ + koff[1]), (LAS unsigned*)(sb_ + (wave * 3 + 1) * 1024), 16, 0, 0); \
        __builtin_amdgcn_global_load_lds((const unsigned*)(ks_ + koff[2]), (LAS unsigned*)(sb_ + (wave * 3 + 2) * 1024), 16, 0, 0); \
        const bf16_t* vs_ = vsrc + (size_t)(t) * 64 * 128; \
        __builtin_amdgcn_global_load_lds((const unsigned*)(vs_), (LAS unsigned*)(sb_ + AT_VOFF + vid * 1024), 16, 0, 0); \
        __builtin_amdgcn_global_load_lds((const unsigned*)(vs_ + (size_t)16 * 128), (LAS unsigned*)(sb_ + AT_VOFF + (vid + 1) * 1024), 16, 0, 0); } while (0)
    bf16x8 qr[12];
#pragma unroll
    for (int s = 0; s < 12; ++s) qr[s] = *(const bf16x8*)(Qw + 16 * s);
#pragma unroll
    for (int s = 0; s < 12; ++s) asm volatile("" : "+v"(qr[s]));
    AT_ISSUE(0, 0); AT_ISSUE(1, 1);
    f32x16 o[4];
#pragma unroll
    for (int d0 = 0; d0 < 4; ++d0)
#pragma unroll
        for (int r = 0; r < 16; ++r) o[d0][r] = 0.f;
    float m = -1e30f, l = 0.f;
    const int kfo = r32 * 384, kc0 = hi + ((r32 >> 1) & 7);
    const int vfo = AT_VOFF + ((lane >> 4) & 1) * 32 + (lane & 3) * 8 + (4 * hi + ((lane & 15) >> 2)) * 64;
    const int qrel = wave * 32 + r32;
    int slot = 0;
    for (int t = 0; t < NT; ++t) {
        if (t + 1 < NT) asm volatile("s_waitcnt vmcnt(5)" ::: "memory"); else asm volatile("s_waitcnt vmcnt(0)" ::: "memory");
        __builtin_amdgcn_s_barrier(); asm volatile("" ::: "memory");
        if (t + 2 < NT) { const int s2 = (slot == 0) ? 2 : slot - 1; AT_ISSUE(t + 2, s2); }
        const int jb = t - (NT - 4);
        if (!(jb >= 0 && 64 * jb > wave * 32 + 31)) {
            const LAS unsigned char* kp = ldsl + slot * AT_SLOT + kfo;
            int kc = kc0; asm volatile("" : "+v"(kc));
            f32x16 p0, p1;
#pragma unroll
            for (int r = 0; r < 16; ++r) { p0[r] = 0.f; p1[r] = 0.f; }
#pragma unroll
            for (int s = 0; s < 12; ++s) {
                int sl_ = kc + 2 * s; sl_ -= (sl_ >= 24) ? 24 : 0;
                const bf16x8 k0 = *(const LAS bf16x8*)(kp + sl_ * 16), k1 = *(const LAS bf16x8*)(kp + sl_ * 16 + 32 * 384);
                p0 = __builtin_amdgcn_mfma_f32_32x32x16_bf16(k0, qr[s], p0, 0, 0, 0);
                p1 = __builtin_amdgcn_mfma_f32_32x32x16_bf16(k1, qr[s], p1, 0, 0, 0);
            }
            if (jb >= 0 && 64 * jb + 63 > wave * 32) {
#pragma unroll
                for (int r = 0; r < 16; ++r) { const int kv = 64 * jb + crow(r, hi); if (kv > qrel) p0[r] = -INFINITY; if (kv + 32 > qrel) p1[r] = -INFINITY; }
            }
            float rm = fmaxf(p0[0], p1[0]);
#pragma unroll
            for (int r = 1; r < 16; ++r) rm = fmaxf(rm, fmaxf(p0[r], p1[r]));
            rm = fmaxf(rm, __shfl_xor(rm, 32));
            const float mn = fmaxf(m, rm);
            if (__any(mn > m)) {
                const float alpha = __builtin_amdgcn_exp2f(m - mn);
                l *= alpha;
#pragma unroll
                for (int r = 0; r < 16; ++r) { const float ar = __shfl(alpha, crow(r, hi));
#pragma unroll
                    for (int d0 = 0; d0 < 4; ++d0) o[d0][r] *= ar; }
                m = mn;
            }
            float ls = 0.f;
#pragma unroll
            for (int r = 0; r < 16; ++r) { p0[r] = __builtin_amdgcn_exp2f(p0[r] - m); p1[r] = __builtin_amdgcn_exp2f(p1[r] - m); ls += p0[r] + p1[r]; }
            l += ls;
            bf16x8 pa[4];
            { u32x4 w;
              w.x = cvtpk(p0[0], p0[1]); w.y = cvtpk(p0[2], p0[3]); w.z = cvtpk(p0[4], p0[5]); w.w = cvtpk(p0[6], p0[7]); pa[0] = __builtin_bit_cast(bf16x8, w);
              w.x = cvtpk(p0[8], p0[9]); w.y = cvtpk(p0[10], p0[11]); w.z = cvtpk(p0[12], p0[13]); w.w = cvtpk(p0[14], p0[15]); pa[1] = __builtin_bit_cast(bf16x8, w);
              w.x = cvtpk(p1[0], p1[1]); w.y = cvtpk(p1[2], p1[3]); w.z = cvtpk(p1[4], p1[5]); w.w = cvtpk(p1[6], p1[7]); pa[2] = __builtin_bit_cast(bf16x8, w);
              w.x = cvtpk(p1[8], p1[9]); w.y = cvtpk(p1[10], p1[11]); w.z = cvtpk(p1[12], p1[13]); w.w = cvtpk(p1[14], p1[15]); pa[3] = __builtin_bit_cast(bf16x8, w); }
            const unsigned vpa = (unsigned)(size_t)(ldsl + slot * AT_SLOT + vfo);
#pragma unroll
            for (int d0 = 0; d0 < 4; ++d0) {
                s16x4 lo[4], hh[4];
                TR_PAIR(lo[0], hh[0], vpa, d0 * 4096 + 0 * 1024, 512); TR_PAIR(lo[1], hh[1], vpa, d0 * 4096 + 1 * 1024, 512);
                TR_PAIR(lo[2], hh[2], vpa, d0 * 4096 + 2 * 1024, 512); TR_PAIR(lo[3], hh[3], vpa, d0 * 4096 + 3 * 1024, 512);
                LDS_WAIT_PIN();
#pragma unroll
                for (int ks = 0; ks < 4; ++ks)
                    o[d0] = __builtin_amdgcn_mfma_f32_32x32x16_bf16(pa[ks], (bf16x8){lo[ks][0], lo[ks][1], lo[ks][2], lo[ks][3], hh[ks][0], hh[ks][1], hh[ks][2], hh[ks][3]}, o[d0], 0, 0, 0);
            }
        }
        slot = (slot == 2) ? 0 : slot + 1;
    }
    l += __shfl_xor(l, 32);
    const float inv = 1.f / l;
    bf16_t* Ow = (bf16_t*)(p.ws + WS_MIXRAW) + ((size_t)b * SEQ + qb * 256 + wave * 32) * DM + h * 128 + r32;
#pragma unroll
    for (int r = 0; r < 16; ++r) { const float ir = __shfl(inv, crow(r, hi));
#pragma unroll
        for (int d0 = 0; d0 < 4; ++d0) Ow[(size_t)crow(r, hi) * DM + d0 * 32] = (bf16_t)f2bf(o[d0][r] * ir); }
    __builtin_amdgcn_sched_barrier(0);
    float ssr[16];
#pragma unroll
    for (int r = 0; r < 16; ++r) { const float ir = __shfl(inv, crow(r, hi)); const float v0 = o[0][r] * ir, v1 = o[1][r] * ir, v2 = o[2][r] * ir, v3 = o[3][r] * ir; ssr[r] = (v0 * v0 + v1 * v1) + (v2 * v2 + v3 * v3); }
    float q8[8], q4[4], q2[2], q1;
    { const bool bb = (lane & 16) != 0;
#pragma unroll
      for (int i = 0; i < 8; ++i) { const float keep = bb ? ssr[i + 8] : ssr[i], send = bb ? ssr[i] : ssr[i + 8]; q8[i] = keep + __shfl_xor(send, 16); } }
    { const bool bb = (lane & 8) != 0;
#pragma unroll
      for (int i = 0; i < 4; ++i) { const float keep = bb ? q8[i + 4] : q8[i], send = bb ? q8[i] : q8[i + 4]; q4[i] = keep + __shfl_xor(send, 8); } }
    { const bool bb = (lane & 4) != 0;
#pragma unroll
      for (int i = 0; i < 2; ++i) { const float keep = bb ? q4[i + 2] : q4[i], send = bb ? q4[i] : q4[i + 2]; q2[i] = keep + __shfl_xor(send, 4); } }
    { const bool bb = (lane & 2) != 0; const float keep = bb ? q2[1] : q2[0], send = bb ? q2[0] : q2[1]; q1 = keep + __shfl_xor(send, 2); }
    q1 += __shfl_xor(q1, 1);
    { const int rs = ((lane >> 4) & 1) * 8 + ((lane >> 3) & 1) * 4 + ((lane >> 2) & 1) * 2 + ((lane >> 1) & 1);
      if ((lane & 1) == 0) ((float*)(p.ws + WS_PSQA))[((size_t)b * SEQ + qb * 256 + wave * 32 + crow(rs, hi)) * 8 + h] = q1; }
    asm volatile("s_waitcnt lgkmcnt(0)" ::: "memory"); __builtin_amdgcn_s_barrier(); asm volatile("" ::: "memory");
#undef AT_ISSUE
}
__device__ __forceinline__ void ph_attn(const Params& p, LAS unsigned char* ldsl, int bid, int G, int wave, int lane) {
    const int vcu = (bid & 7) * (G >> 3) + (bid >> 3);
    const int bh = vcu >> 2, s = vcu & 3;
    attn_unit(p, ldsl, bh, 7 - s, wave, lane);
    attn_unit(p, ldsl, bh, s, wave, lane);
}
__device__ __forceinline__ int f2sort(float f) { const int u = __builtin_bit_cast(int, f); return u ^ ((u >> 31) & 0x7fffffff); }
__device__ __forceinline__ float sort2f(int k) { return __builtin_bit_cast(float, k ^ ((k >> 31) & 0x7fffffff)); }
#define CE_(a_, b_) do { const int hi_ = max(a_, b_); b_ = min(a_, b_); a_ = hi_; } while (0)
#define INS16(L, x) do { int x_ = (x); _Pragma("unroll") for (int i_ = 0; i_ < 16; ++i_) { const int hi_ = max(L[i_], x_); x_ = min(L[i_], x_); L[i_] = hi_; } } while (0)
#define SORT16(v) do { CE_(v[0], v[13]); CE_(v[1], v[12]); CE_(v[2], v[15]); CE_(v[3], v[14]); CE_(v[4], v[8]); CE_(v[5], v[6]); CE_(v[7], v[11]); CE_(v[9], v[10]); CE_(v[0], v[5]); CE_(v[1], v[7]); CE_(v[2], v[9]); CE_(v[3], v[4]); CE_(v[6], v[13]); CE_(v[8], v[14]); CE_(v[10], v[15]); CE_(v[11], v[12]); CE_(v[0], v[1]); CE_(v[2], v[3]); CE_(v[4], v[5]); CE_(v[6], v[8]); CE_(v[7], v[9]); CE_(v[10], v[11]); CE_(v[12], v[13]); CE_(v[14], v[15]); CE_(v[0], v[2]); CE_(v[1], v[3]); CE_(v[4], v[10]); CE_(v[5], v[11]); CE_(v[6], v[7]); CE_(v[8], v[9]); CE_(v[12], v[14]); CE_(v[13], v[15]); CE_(v[1], v[2]); CE_(v[3], v[12]); CE_(v[4], v[6]); CE_(v[5], v[7]); CE_(v[8], v[10]); CE_(v[9], v[11]); CE_(v[13], v[14]); CE_(v[1], v[4]); CE_(v[2], v[6]); CE_(v[5], v[8]); CE_(v[7], v[10]); CE_(v[9], v[13]); CE_(v[11], v[14]); CE_(v[2], v[4]); CE_(v[3], v[6]); CE_(v[9], v[12]); CE_(v[11], v[13]); CE_(v[3], v[5]); CE_(v[6], v[8]); CE_(v[7], v[9]); CE_(v[10], v[12]); CE_(v[3], v[4]); CE_(v[5], v[6]); CE_(v[7], v[8]); CE_(v[9], v[10]); CE_(v[11], v[12]); CE_(v[6], v[7]); CE_(v[8], v[9]); } while (0)
#define BMERGE16(v) do { CE_(v[0], v[8]); CE_(v[1], v[9]); CE_(v[2], v[10]); CE_(v[3], v[11]); CE_(v[4], v[12]); CE_(v[5], v[13]); CE_(v[6], v[14]); CE_(v[7], v[15]); CE_(v[0], v[4]); CE_(v[1], v[5]); CE_(v[2], v[6]); CE_(v[3], v[7]); CE_(v[8], v[12]); CE_(v[9], v[13]); CE_(v[10], v[14]); CE_(v[11], v[15]); CE_(v[0], v[2]); CE_(v[1], v[3]); CE_(v[4], v[6]); CE_(v[5], v[7]); CE_(v[8], v[10]); CE_(v[9], v[11]); CE_(v[12], v[14]); CE_(v[13], v[15]); CE_(v[0], v[1]); CE_(v[2], v[3]); CE_(v[4], v[5]); CE_(v[6], v[7]); CE_(v[8], v[9]); CE_(v[10], v[11]); CE_(v[12], v[13]); CE_(v[14], v[15]); } while (0)
__device__ __forceinline__ void ph_route(const Params& p, LAS unsigned char* ldsl, int wave, int lane, int gwave, int gnw) {
    const int r32 = lane & 31, hi = lane >> 5;
    const bf16_t* SK = (const bf16_t*)(p.ws + WS_SUBK);
    LAS unsigned char* tab = ldsl + wave * 4096 + lane * 32;
    for (int item = gwave; item < (T / 32) * 8; item += gnw) {
        const int tile = item >> 3, h = item & 7, t0 = tile * 32;
        int hi4 = hi * 4; asm volatile("" : "+v"(hi4));
        int S0[16], S1[16];
#pragma unroll
        for (int j = 0; j < 2; ++j) {
            const bf16_t* qp = (const bf16_t*)(p.ws + WS_QP) + (size_t)(t0 + r32) * DM + h * 256 + j * 128 + 8 * hi;
            asm volatile("" : "+v"(qp));
            bf16x8 bq[8];
#pragma unroll
            for (int s = 0; s < 8; ++s) bq[s] = *(const bf16x8*)(qp + 16 * s);
            int L[16];
#pragma unroll
            for (int kb = 0; kb < 4; ++kb) {
                const bf16_t* ap = SK + ((size_t)(h * 2 + j) * 128 + kb * 32 + r32) * 128 + 8 * hi;
                asm volatile("" : "+v"(ap));
                f32x16 acc;
#pragma unroll
                for (int r = 0; r < 16; ++r) acc[r] = 0.f;
#pragma unroll
                for (int s = 0; s < 8; ++s) acc = __builtin_amdgcn_mfma_f32_32x32x16_bf16(*(const bf16x8*)(ap + 16 * s), bq[s], acc, 0, 0, 0);
                int v[16];
#pragma unroll
                for (int r = 0; r < 16; ++r) v[r] = (f2sort(acc[r]) & ~127) | ((127 - (kb * 32 + (r & 3) + 8 * (r >> 2))) - hi4);
                SORT16(v);
                if (kb == 0) {
#pragma unroll
                    for (int i = 0; i < 16; ++i) L[i] = v[i];
                } else {
#pragma unroll
                    for (int i = 0; i < 16; ++i) L[i] = max(L[i], v[15 - i]);
                    BMERGE16(L);
                }
                __builtin_amdgcn_sched_barrier(0);
            }
            int Y[16];
#pragma unroll
            for (int i = 0; i < 16; ++i) Y[i] = __shfl_xor(L[i], 32);
#pragma unroll
            for (int i = 0; i < 16; ++i) L[i] = max(L[i], Y[15 - i]);
            BMERGE16(L);
#pragma unroll
            for (int i = 0; i < 16; ++i) { if (j == 0) S0[i] = L[i]; else S1[i] = L[i]; }
        }
        float f0[16], f1[16];
        {
            unsigned w0[4], w1[4];
#pragma unroll
            for (int i = 0; i < 16; ++i) { f0[i] = sort2f(S0[i] & ~127); f1[i] = sort2f(S1[i] & ~127); }
#pragma unroll
            for (int q = 0; q < 4; ++q) {
                w0[q] = (unsigned)(127 - (S0[4 * q] & 127)) | ((unsigned)(127 - (S0[4 * q + 1] & 127)) << 8) | ((unsigned)(127 - (S0[4 * q + 2] & 127)) << 16) | ((unsigned)(127 - (S0[4 * q + 3] & 127)) << 24);
                w1[q] = (unsigned)(127 - (S1[4 * q] & 127)) | ((unsigned)(127 - (S1[4 * q + 1] & 127)) << 8) | ((unsigned)(127 - (S1[4 * q + 2] & 127)) << 16) | ((unsigned)(127 - (S1[4 * q + 3] & 127)) << 24);
            }
            *(LAS u32x4*)(tab) = (u32x4){w0[0], w0[1], w0[2], w0[3]};
            *(LAS u32x4*)(tab + 16) = (u32x4){w1[0], w1[1], w1[2], w1[3]};
        }
        int Lv[16];
        Lv[0] = (f2sort(f0[0] + f1[0]) & ~255) | 255;
        Lv[1] = (f2sort(f0[0] + f1[1]) & ~255) | 254;
        Lv[2] = (f2sort(f0[0] + f1[2]) & ~255) | 253;
        Lv[3] = (f2sort(f0[0] + f1[3]) & ~255) | 252;
        Lv[4] = (f2sort(f0[0] + f1[4]) & ~255) | 251;
        Lv[5] = (f2sort(f0[0] + f1[5]) & ~255) | 250;
        Lv[6] = (f2sort(f0[0] + f1[6]) & ~255) | 249;
        Lv[7] = (f2sort(f0[0] + f1[7]) & ~255) | 248;
        Lv[8] = (f2sort(f0[0] + f1[8]) & ~255) | 247;
        Lv[9] = (f2sort(f0[0] + f1[9]) & ~255) | 246;
        Lv[10] = (f2sort(f0[0] + f1[10]) & ~255) | 245;
        Lv[11] = (f2sort(f0[0] + f1[11]) & ~255) | 244;
        Lv[12] = (f2sort(f0[0] + f1[12]) & ~255) | 243;
        Lv[13] = (f2sort(f0[0] + f1[13]) & ~255) | 242;
        Lv[14] = (f2sort(f0[0] + f1[14]) & ~255) | 241;
        Lv[15] = (f2sort(f0[0] + f1[15]) & ~255) | 240;
        { int cv_ = (f2sort(f0[1] + f1[0]) & ~255) | 239; INS16(Lv, cv_); __builtin_amdgcn_sched_barrier(0); }
        { int cv_ = (f2sort(f0[1] + f1[1]) & ~255) | 238; INS16(Lv, cv_); __builtin_amdgcn_sched_barrier(0); }
        { int cv_ = (f2sort(f0[1] + f1[2]) & ~255) | 237; INS16(Lv, cv_); __builtin_amdgcn_sched_barrier(0); }
        { int cv_ = (f2sort(f0[1] + f1[3]) & ~255) | 236; INS16(Lv, cv_); __builtin_amdgcn_sched_barrier(0); }
        { int cv_ = (f2sort(f0[1] + f1[4]) & ~255) | 235; INS16(Lv, cv_); __builtin_amdgcn_sched_barrier(0); }
        { int cv_ = (f2sort(f0[1] + f1[5]) & ~255) | 234; INS16(Lv, cv_); __builtin_amdgcn_sched_barrier(0); }
        { int cv_ = (f2sort(f0[1] + f1[6]) & ~255) | 233; INS16(Lv, cv_); __builtin_amdgcn_sched_barrier(0); }
        { int cv_ = (f2sort(f0[1] + f1[7]) & ~255) | 232; INS16(Lv, cv_); __builtin_amdgcn_sched_barrier(0); }
        { int cv_ = (f2sort(f0[2] + f1[0]) & ~255) | 223; INS16(Lv, cv_); __builtin_amdgcn_sched_barrier(0); }
        { int cv_ = (f2sort(f0[2] + f1[1]) & ~255) | 222; INS16(Lv, cv_); __builtin_amdgcn_sched_barrier(0); }
        { int cv_ = (f2sort(f0[2] + f1[2]) & ~255) | 221; INS16(Lv, cv_); __builtin_amdgcn_sched_barrier(0); }
        { int cv_ = (f2sort(f0[2] + f1[3]) & ~255) | 220; INS16(Lv, cv_); __builtin_amdgcn_sched_barrier(0); }
        { int cv_ = (f2sort(f0[2] + f1[4]) & ~255) | 219; INS16(Lv, cv_); __builtin_amdgcn_sched_barrier(0); }
        { int cv_ = (f2sort(f0[3] + f1[0]) & ~255) | 207; INS16(Lv, cv_); __builtin_amdgcn_sched_barrier(0); }
        { int cv_ = (f2sort(f0[3] + f1[1]) & ~255) | 206; INS16(Lv, cv_); __builtin_amdgcn_sched_barrier(0); }
        { int cv_ = (f2sort(f0[3] + f1[2]) & ~255) | 205; INS16(Lv, cv_); __builtin_amdgcn_sched_barrier(0); }
        { int cv_ = (f2sort(f0[3] + f1[3]) & ~255) | 204; INS16(Lv, cv_); __builtin_amdgcn_sched_barrier(0); }
        { int cv_ = (f2sort(f0[4] + f1[0]) & ~255) | 191; INS16(Lv, cv_); __builtin_amdgcn_sched_barrier(0); }
        { int cv_ = (f2sort(f0[4] + f1[1]) & ~255) | 190; INS16(Lv, cv_); __builtin_amdgcn_sched_barrier(0); }
        { int cv_ = (f2sort(f0[4] + f1[2]) & ~255) | 189; INS16(Lv, cv_); __builtin_amdgcn_sched_barrier(0); }
        { int cv_ = (f2sort(f0[5] + f1[0]) & ~255) | 175; INS16(Lv, cv_); __builtin_amdgcn_sched_barrier(0); }
        { int cv_ = (f2sort(f0[5] + f1[1]) & ~255) | 174; INS16(Lv, cv_); __builtin_amdgcn_sched_barrier(0); }
        { int cv_ = (f2sort(f0[6] + f1[0]) & ~255) | 159; INS16(Lv, cv_); __builtin_amdgcn_sched_barrier(0); }
        { int cv_ = (f2sort(f0[6] + f1[1]) & ~255) | 158; INS16(Lv, cv_); __builtin_amdgcn_sched_barrier(0); }
        { int cv_ = (f2sort(f0[7] + f1[0]) & ~255) | 143; INS16(Lv, cv_); __builtin_amdgcn_sched_barrier(0); }
        { int cv_ = (f2sort(f0[7] + f1[1]) & ~255) | 142; INS16(Lv, cv_); __builtin_amdgcn_sched_barrier(0); }
        { int cv_ = (f2sort(f0[8] + f1[0]) & ~255) | 127; INS16(Lv, cv_); __builtin_amdgcn_sched_barrier(0); }
        { int cv_ = (f2sort(f0[9] + f1[0]) & ~255) | 111; INS16(Lv, cv_); __builtin_amdgcn_sched_barrier(0); }
        { int cv_ = (f2sort(f0[10] + f1[0]) & ~255) | 95; INS16(Lv, cv_); __builtin_amdgcn_sched_barrier(0); }
        { int cv_ = (f2sort(f0[11] + f1[0]) & ~255) | 79; INS16(Lv, cv_); __builtin_amdgcn_sched_barrier(0); }
        { int cv_ = (f2sort(f0[12] + f1[0]) & ~255) | 63; INS16(Lv, cv_); __builtin_amdgcn_sched_barrier(0); }
        { int cv_ = (f2sort(f0[13] + f1[0]) & ~255) | 47; INS16(Lv, cv_); __builtin_amdgcn_sched_barrier(0); }
        { int cv_ = (f2sort(f0[14] + f1[0]) & ~255) | 31; INS16(Lv, cv_); __builtin_amdgcn_sched_barrier(0); }
        { int cv_ = (f2sort(f0[15] + f1[0]) & ~255) | 15; INS16(Lv, cv_); __builtin_amdgcn_sched_barrier(0); }
        float g[16]; float sum = 0.f; const float mx = sort2f(Lv[0] & ~255);
        int Le[16];
#pragma unroll
        for (int i = 0; i < 16; ++i) {
            g[i] = __expf(sort2f(Lv[i] & ~255) - mx); sum += g[i];
            const int pos = 255 - (Lv[i] & 255);
            const int ia = *(const LAS unsigned char*)(tab + (pos >> 4)), ib = *(const LAS unsigned char*)(tab + 16 + (pos & 15));
            Le[i] = ia * 128 + ib;
        }
        const float inv = 1.f / sum;
        if (hi == 0) {
            int* ip = (int*)(p.ws + WS_IDX) + (size_t)(t0 + r32) * 128 + h * 16; float* gp = (float*)(p.ws + WS_GATE) + (size_t)(t0 + r32) * 128 + h * 16;
#pragma unroll
            for (int i = 0; i < 4; ++i) {
                *(u32x4*)(ip + 4 * i) = (u32x4){(unsigned)Le[4 * i], (unsigned)Le[4 * i + 1], (unsigned)Le[4 * i + 2], (unsigned)Le[4 * i + 3]};
                *(f32x4*)(gp + 4 * i) = (f32x4){g[4 * i] * inv, g[4 * i + 1] * inv, g[4 * i + 2] * inv, g[4 * i + 3] * inv};
            }
        }
        asm volatile("s_waitcnt lgkmcnt(0)" ::: "memory");
    }
}
__device__ __forceinline__ void ph_conv(const Params& p, int gwave, int gnw, int lane) {
    const bf16_t* proj = (const bf16_t*)(p.ws + WS_PROJ);
    bf16_t* xa = (bf16_t*)(p.ws + WS_XBCA);
    for (int task = gwave; task < 1536 + 256; task += gnw) {
        if (task < 1536) {
            const int run = task / 3, cg = (task % 3) * 64 + lane, c0 = cg * 8;
            const int t0 = run * 32, s0 = t0 % SEQ;
            float w0[8], w1[8], w2[8], w3[8], bs[8], h1[8], h2[8], h3[8];
#pragma unroll
            for (int i = 0; i < 8; ++i) { w0[i] = p.conv_w[0 * 1536 + c0 + i]; w1[i] = p.conv_w[1 * 1536 + c0 + i]; w2[i] = p.conv_w[2 * 1536 + c0 + i]; w3[i] = p.conv_w[3 * 1536 + c0 + i]; bs[i] = p.conv_b[c0 + i]; h1[i] = 0.f; h2[i] = 0.f; h3[i] = 0.f; }
            const bf16_t* src = proj + (size_t)t0 * NPROJ + C_XBC + c0;
            if (s0 > 0) {
                const u32x4 a = *(const u32x4*)(src - (size_t)1 * NPROJ), b = *(const u32x4*)(src - (size_t)2 * NPROJ), c = *(const u32x4*)(src - (size_t)3 * NPROJ);
                h1[0] = bflo(a.x); h1[1] = bfhi(a.x); h1[2] = bflo(a.y); h1[3] = bfhi(a.y); h1[4] = bflo(a.z); h1[5] = bfhi(a.z); h1[6] = bflo(a.w); h1[7] = bfhi(a.w);
                h2[0] = bflo(b.x); h2[1] = bfhi(b.x); h2[2] = bflo(b.y); h2[3] = bfhi(b.y); h2[4] = bflo(b.z); h2[5] = bfhi(b.z); h2[6] = bflo(b.w); h2[7] = bfhi(b.w);
                h3[0] = bflo(c.x); h3[1] = bfhi(c.x); h3[2] = bflo(c.y); h3[3] = bfhi(c.y); h3[4] = bflo(c.z); h3[5] = bfhi(c.z); h3[6] = bflo(c.w); h3[7] = bfhi(c.w);
            }
            bf16_t* dst = xa + (size_t)t0 * 1536 + c0;
#pragma unroll 16
            for (int i = 0; i < 32; ++i) {
                const u32x4 a = *(const u32x4*)(src + (size_t)i * NPROJ);
                float cur[8] = {bflo(a.x), bfhi(a.x), bflo(a.y), bfhi(a.y), bflo(a.z), bfhi(a.z), bflo(a.w), bfhi(a.w)};
                float o[8];
#pragma unroll
                for (int k = 0; k < 8; ++k) { o[k] = silu_fast(bs[k] + w3[k] * cur[k] + w2[k] * h1[k] + w1[k] * h2[k] + w0[k] * h3[k]); h3[k] = h2[k]; h2[k] = h1[k]; h1[k] = cur[k]; }
                u32x4 w; w.x = pk2(o[0], o[1]); w.y = pk2(o[2], o[3]); w.z = pk2(o[4], o[5]); w.w = pk2(o[6], o[7]);
                *(u32x4*)(dst + (size_t)i * 1536) = w;
            }
        } else {
            const int t = (task - 1536) * 64 + lane;
            const u32x4 a = *(const u32x4*)(proj + (size_t)t * NPROJ + C_DT), b = *(const u32x4*)(proj + (size_t)t * NPROJ + C_DT + 8);
            const float raw[16] = {bflo(a.x), bfhi(a.x), bflo(a.y), bfhi(a.y), bflo(a.z), bfhi(a.z), bflo(a.w), bfhi(a.w), bflo(b.x), bfhi(b.x), bflo(b.y), bfhi(b.y), bflo(b.z), bfhi(b.z), bflo(b.w), bfhi(b.w)};
            float* dto = (float*)(p.ws + WS_DT) + (size_t)t * 16; float* cso = (float*)(p.ws + WS_CS) + (size_t)t * 16;
            float dtv[16], csv[16];
#pragma unroll
            for (int hh = 0; hh < 16; ++hh) {
                const float v = raw[hh] + p.dt_bias[hh];
                const float dt = (v > 20.f) ? v : log1pf(__expf(v));
                float c = dt * (-__expf(p.a_log[hh]));
#pragma unroll
                for (int o = 1; o < 64; o <<= 1) { const float u = __shfl_up(c, o); if (lane >= o) c += u; }
                dtv[hh] = dt; csv[hh] = c;
            }
#pragma unroll
            for (int q = 0; q < 4; ++q) { *(f32x4*)(dto + 4 * q) = (f32x4){dtv[4 * q], dtv[4 * q + 1], dtv[4 * q + 2], dtv[4 * q + 3]}; *(f32x4*)(cso + 4 * q) = (f32x4){csv[4 * q], csv[4 * q + 1], csv[4 * q + 2], csv[4 * q + 3]}; }
        }
    }
}
constexpr int P4_ROW = 1152;
__device__ __forceinline__ void fp4_row_load(const Params& p, int row, int lane, f32x4 (&v)[8]) {
    const f32x4* src = (const f32x4*)(((row >= 16384) ? p.v_exp : p.u_exp) + (size_t)(row & 16383) * DM) + lane;
#pragma unroll
    for (int j = 0; j < 8; ++j) v[j] = src[64 * j];
}
__device__ __forceinline__ void fp4_row_store(const Params& p, int row, int lane, const f32x4 (&v)[8]) {
    float mx = 0.f;
#pragma unroll
    for (int j = 0; j < 8; ++j) mx = fmaxf(mx, fmaxf(fmaxf(fabsf(v[j].x), fabsf(v[j].y)), fmaxf(fabsf(v[j].z), fabsf(v[j].w))));
    unsigned sb = (__builtin_bit_cast(unsigned, mx * (1.f / 6.f)) + 0x000fffffu) >> 20;
    if ((float)__builtin_bit_cast(float, sb << 20) * 6.f < mx) sb += 1u;
    sb = min(max(sb, 825u), 824u + 255u) - 824u;
    const float inv = 1.f / __builtin_bit_cast(float, (sb + 824u) << 20);
    unsigned w[4];
#pragma unroll
    for (int q = 0; q < 4; ++q) {
        const f32x4 a = v[2 * q] * inv, b = v[2 * q + 1] * inv;
        unsigned r = 0u;
        r = __builtin_amdgcn_cvt_scalef32_pk_fp4_f32(r, a.x, a.y, 1.0f, 0);
        r = __builtin_amdgcn_cvt_scalef32_pk_fp4_f32(r, a.z, a.w, 1.0f, 1);
        r = __builtin_amdgcn_cvt_scalef32_pk_fp4_f32(r, b.x, b.y, 1.0f, 2);
        r = __builtin_amdgcn_cvt_scalef32_pk_fp4_f32(r, b.z, b.w, 1.0f, 3);
        w[q] = r;
    }
    const size_t e = (size_t)(row & 16383), x = (size_t)(lane >> 3);
    *(u32x4*)(p.ws + ((row >= 16384) ? WS_V4D : WS_U4D) + x * ((size_t)16384 * 128) + e * 128 + (lane & 7) * 16) = (u32x4){w[0], w[1], w[2], w[3]};
    *(unsigned char*)(p.ws + ((row >= 16384) ? WS_V4S : WS_U4S) + x * ((size_t)16384 * 8) + e * 8 + (lane & 7)) = (unsigned char)sb;
}
constexpr int SSD_IN = 41472, SSD_BM = 0, SSD_CM = 16384, SSD_XS = 32768, SSD_Z = 36864, SSD_DT = 40960, SSD_CS = 41216, SSD_ST = 3 * SSD_IN, SSD_PART = SSD_ST + 16384, SSD_SYNC = SSD_PART + 4096;
__device__ __forceinline__ void ssd_decay_block(f32x16& cbt, const f32x4 (&c4)[4], const f32x4 (&d4)[4], float cs_l, int sb, int l, int hi, bool diag) {
#pragma unroll
    for (int q = 0; q < 4; ++q) {
#pragma unroll
        for (int i = 0; i < 4; ++i) {
            const int s = 32 * sb + 8 * q + 4 * hi + i;
            float e = __expf(cs_l - c4[q][i]) * d4[q][i];
            if (diag) e = (s <= l) ? e : 0.f;
            cbt[4 * q + i] *= e;
        }
    }
}
__device__ __forceinline__ void ph_ssd(const Params& p, LAS unsigned char* ldsl, int bid, int wave, int lane) {
    const int b = bid >> 5, h = (bid >> 1) & 15, ph = bid & 1, g = h >> 3;
    const int r32 = lane & 31, hi = lane >> 5;
    const size_t tb0 = (size_t)b * SEQ;
    LAS unsigned* sync = (LAS unsigned*)(ldsl + SSD_SYNC);
    if (threadIdx.x < 16) sync[threadIdx.x] = (threadIdx.x >= 14) ? 0xffffffffu : 0u;
    for (int i = threadIdx.x; i < 8192 / 16; i += NTHR) *(LAS u32x4*)(ldsl + SSD_ST + i * 16) = (u32x4){0u, 0u, 0u, 0u};
    asm volatile("s_waitcnt lgkmcnt(0)" ::: "memory"); __builtin_amdgcn_s_barrier(); asm volatile("" ::: "memory");
    if (wave >= 6) {
        const int cvw = bid * 2 + (wave - 6);
        f32x4 ra[8], rb[8], rc[8], rd[8];
        fp4_row_load(p, cvw, lane, ra); fp4_row_load(p, 512 + cvw, lane, rb); fp4_row_load(p, 1024 + cvw, lane, rc); fp4_row_load(p, 1536 + cvw, lane, rd);
        for (int c = 0; c < 16; ++c) {
            fp4_row_store(p, (4 * c) * 512 + cvw, lane, ra);
            if (c + 1 < 16) fp4_row_load(p, (4 * c + 4) * 512 + cvw, lane, ra);
            fp4_row_store(p, (4 * c + 1) * 512 + cvw, lane, rb);
            if (c + 1 < 16) fp4_row_load(p, (4 * c + 5) * 512 + cvw, lane, rb);
            fp4_row_store(p, (4 * c + 2) * 512 + cvw, lane, rc);
            if (c + 1 < 16) fp4_row_load(p, (4 * c + 6) * 512 + cvw, lane, rc);
            fp4_row_store(p, (4 * c + 3) * 512 + cvw, lane, rd);
            if (c + 1 < 16) fp4_row_load(p, (4 * c + 7) * 512 + cvw, lane, rd);
        }
    } else {
        const bf16_t* xa = (const bf16_t*)(p.ws + WS_XBCA); const bf16_t* proj = (const bf16_t*)(p.ws + WS_PROJ);
        const float dsk = p.d_skip[h];
        const int dq = (wave - 2) & 3;
        const int dr0 = 4 * dq + (lane >> 4);
        const bf16_t* bsrc = xa + (tb0 + dr0) * 1536 + 1024 + g * 128 + (((lane & 15) ^ (dr0 & 15)) * 8);
        const bf16_t* csrc = xa + (tb0 + dr0) * 1536 + 1280 + g * 128 + (((lane & 15) ^ (dr0 & 15)) * 8);
        const bf16_t* xsrc = xa + (tb0 + 16 * dq + (lane >> 2)) * 1536 + h * 64 + ph * 32 + (lane & 3) * 8;
        const bf16_t* zsrc = proj + (tb0 + 16 * dq + (lane >> 2)) * NPROJ + C_Z + h * 64 + ph * 32 + (lane & 3) * 8;
        const float* dsrc = (const float*)(p.ws + ((dq == 0) ? WS_DT : WS_CS)) + (tb0 + lane) * 16 + h;
#define SSD_G16(src, dst) __builtin_amdgcn_global_load_lds((const unsigned*)(src), (LAS unsigned*)(dst), 16, 0, 0)
#define SSD_ISSUE(c, buf) do { if (wave >= 2) { LAS unsigned char* in_ = ldsl + (buf) * SSD_IN; const size_t to_ = (size_t)(c) * 64 * 1536; \
        SSD_G16(bsrc + to_, in_ + SSD_BM + dq * 1024); SSD_G16(bsrc + to_ + 16 * 1536, in_ + SSD_BM + (dq + 4) * 1024); SSD_G16(bsrc + to_ + 32 * 1536, in_ + SSD_BM + (dq + 8) * 1024); SSD_G16(bsrc + to_ + 48 * 1536, in_ + SSD_BM + (dq + 12) * 1024); \
        SSD_G16(csrc + to_, in_ + SSD_CM + dq * 1024); SSD_G16(csrc + to_ + 16 * 1536, in_ + SSD_CM + (dq + 4) * 1024); SSD_G16(csrc + to_ + 32 * 1536, in_ + SSD_CM + (dq + 8) * 1024); SSD_G16(csrc + to_ + 48 * 1536, in_ + SSD_CM + (dq + 12) * 1024); \
        SSD_G16(xsrc + to_, in_ + SSD_XS + dq * 1024); SSD_G16(zsrc + (size_t)(c) * 64 * NPROJ, in_ + SSD_Z + dq * 1024); \
        if (dq < 2) __builtin_amdgcn_global_load_lds((const unsigned*)(dsrc + (size_t)(c) * 64 * 16), (LAS unsigned*)(in_ + ((dq == 0) ? SSD_DT : SSD_CS)), 4, 0, 0); } } while (0)
        f32x16 S;
#pragma unroll
        for (int r = 0; r < 16; ++r) S[r] = 0.f;
        SSD_ISSUE(0, 0); SSD_ISSUE(1, 1);
        const int xfo = ((lane >> 4) & 1) * 32 + (lane & 3) * 8 + (4 * hi + ((lane & 15) >> 2)) * 64;
        for (int c = 0; c < SEQ / 64; ++c) {
            if (wave >= 2) { if (c + 1 >= SEQ / 64) asm volatile("s_waitcnt vmcnt(0)" ::: "memory"); else if (dq < 2) asm volatile("s_waitcnt vmcnt(11)" ::: "memory"); else asm volatile("s_waitcnt vmcnt(10)" ::: "memory"); }
            asm volatile("s_waitcnt lgkmcnt(0)" ::: "memory");
            {
                const unsigned sa = (unsigned)(size_t)(ldsl + SSD_SYNC), tgt = (unsigned)(c + 1);
                asm volatile("ds_write_b32 %0, %1" :: "v"(sa + 32u + 4u * (unsigned)wave), "v"(tgt) : "memory");
                for (;;) { u32x4 a, b_; asm volatile("ds_read_b128 %0, %2 offset:32\n\tds_read_b128 %1, %2 offset:48\n\ts_waitcnt lgkmcnt(0)" : "=&v"(a), "=&v"(b_) : "v"(sa) : "memory");
                    const unsigned m = min(min(min(a.x, a.y), min(a.z, a.w)), min(min(b_.x, b_.y), min(b_.z, b_.w)));
                    if (__builtin_amdgcn_readfirstlane(m) >= tgt) break; __builtin_amdgcn_s_sleep(1); }
            }
            asm volatile("" ::: "memory");
            if (c + 2 < SEQ / 64) SSD_ISSUE(c + 2, (c + 2) % 3);
            const LAS unsigned char* in = ldsl + (c % 3) * SSD_IN;
            const LAS unsigned char* STin = ldsl + SSD_ST + (c & 1) * 8192;
            LAS unsigned char* STout = ldsl + SSD_ST + ((c + 1) & 1) * 8192;
            const LAS float* dtl = (const LAS float*)(in + SSD_DT); const LAS float* csl = (const LAS float*)(in + SSD_CS);
            if (wave < 2) {
                const int lb = wave, l = 32 * lb + r32;
                const unsigned xpa = (unsigned)(size_t)(in + SSD_XS + xfo + (32 * lb) * 64);
                s16x4 lo0, hh0, lo1, hh1; TR_PAIR(lo0, hh0, xpa, 0, 512); TR_PAIR(lo1, hh1, xpa, 1024, 512);
                const int l1 = 32 + r32;
                const float cs_l = csl[l], cs_l1 = csl[l1];
                bf16x8 cf[8], bdf[8], cf1[8]; f32x4 c4[4], d4[4];
#pragma unroll
                for (int ks = 0; ks < 8; ++ks) {
                    cf[ks] = *(const LAS bf16x8*)(in + SSD_CM + l * 256 + (((2 * ks + hi) ^ (l & 15)) << 4));
                    bdf[ks] = *(const LAS bf16x8*)(in + SSD_BM + l * 256 + (((2 * ks + hi) ^ (l & 15)) << 4));
                    if (wave == 0) cf1[ks] = *(const LAS bf16x8*)(in + SSD_CM + l1 * 256 + (((2 * ks + hi) ^ (l1 & 15)) << 4));
                }
                LDS_WAIT_PIN();
#pragma unroll
                for (int q = 0; q < 4; ++q) { c4[q] = *(const LAS f32x4*)(csl + 32 * lb + 8 * q + 4 * hi); d4[q] = *(const LAS f32x4*)(dtl + 32 * lb + 8 * q + 4 * hi); }
                const bf16x8 xf0 = (bf16x8){lo0[0], lo0[1], lo0[2], lo0[3], hh0[0], hh0[1], hh0[2], hh0[3]}, xf1 = (bf16x8){lo1[0], lo1[1], lo1[2], lo1[3], hh1[0], hh1[1], hh1[2], hh1[3]};
                if (wave == 0) {
                    f32x16 ca, cb;
#pragma unroll
                    for (int r = 0; r < 16; ++r) { ca[r] = 0.f; cb[r] = 0.f; }
#pragma unroll
                    for (int ks = 0; ks < 8; ks += 2) { ca = __builtin_amdgcn_mfma_f32_32x32x16_bf16(bdf[ks], cf1[ks], ca, 0, 0, 0); cb = __builtin_amdgcn_mfma_f32_32x32x16_bf16(bdf[ks + 1], cf1[ks + 1], cb, 0, 0, 0); }
                    ca += cb;
                    ssd_decay_block(ca, c4, d4, cs_l1, 0, l1, hi, false);
                    u32x4 w0, w1;
                    w0.x = cvtpk(ca[0], ca[1]); w0.y = cvtpk(ca[2], ca[3]); w0.z = cvtpk(ca[4], ca[5]); w0.w = cvtpk(ca[6], ca[7]);
                    w1.x = cvtpk(ca[8], ca[9]); w1.y = cvtpk(ca[10], ca[11]); w1.z = cvtpk(ca[12], ca[13]); w1.w = cvtpk(ca[14], ca[15]);
                    f32x16 pa;
#pragma unroll
                    for (int r = 0; r < 16; ++r) pa[r] = 0.f;
                    pa = __builtin_amdgcn_mfma_f32_32x32x16_bf16(xf0, __builtin_bit_cast(bf16x8, w0), pa, 0, 0, 0);
                    pa = __builtin_amdgcn_mfma_f32_32x32x16_bf16(xf1, __builtin_bit_cast(bf16x8, w1), pa, 0, 0, 0);
                    LAS unsigned char* pp = ldsl + SSD_PART + lane * 64;
#pragma unroll
                    for (int q = 0; q < 4; ++q) *(LAS f32x4*)(pp + q * 16) = (f32x4){pa[4 * q], pa[4 * q + 1], pa[4 * q + 2], pa[4 * q + 3]};
                    asm volatile("s_waitcnt lgkmcnt(0)" ::: "memory");
                    asm volatile("ds_write_b32 %0, %1" :: "v"((unsigned)(size_t)(ldsl + SSD_SYNC) + 4u), "v"((unsigned)(c + 1)) : "memory");
                }
                f32x16 acc;
                {
                    f32x16 ca, cb;
#pragma unroll
                    for (int r = 0; r < 16; ++r) { ca[r] = 0.f; cb[r] = 0.f; acc[r] = 0.f; }
#pragma unroll
                    for (int ks = 0; ks < 8; ks += 2) { ca = __builtin_amdgcn_mfma_f32_32x32x16_bf16(bdf[ks], cf[ks], ca, 0, 0, 0); cb = __builtin_amdgcn_mfma_f32_32x32x16_bf16(bdf[ks + 1], cf[ks + 1], cb, 0, 0, 0); }
                    ca += cb;
                    ssd_decay_block(ca, c4, d4, cs_l, lb, l, hi, true);
                    u32x4 w0, w1;
                    w0.x = cvtpk(ca[0], ca[1]); w0.y = cvtpk(ca[2], ca[3]); w0.z = cvtpk(ca[4], ca[5]); w0.w = cvtpk(ca[6], ca[7]);
                    w1.x = cvtpk(ca[8], ca[9]); w1.y = cvtpk(ca[10], ca[11]); w1.z = cvtpk(ca[12], ca[13]); w1.w = cvtpk(ca[14], ca[15]);
                    acc = __builtin_amdgcn_mfma_f32_32x32x16_bf16(xf0, __builtin_bit_cast(bf16x8, w0), acc, 0, 0, 0);
                    acc = __builtin_amdgcn_mfma_f32_32x32x16_bf16(xf1, __builtin_bit_cast(bf16x8, w1), acc, 0, 0, 0);
                }
                {
                    f32x16 ya, yb;
#pragma unroll
                    for (int r = 0; r < 16; ++r) { ya[r] = 0.f; yb[r] = 0.f; }
#pragma unroll
                    for (int ks = 0; ks < 8; ks += 2) { ya = __builtin_amdgcn_mfma_f32_32x32x16_bf16(*(const LAS bf16x8*)(STin + (2 * ks + hi) * 512 + r32 * 16), cf[ks], ya, 0, 0, 0); yb = __builtin_amdgcn_mfma_f32_32x32x16_bf16(*(const LAS bf16x8*)(STin + (2 * ks + 2 + hi) * 512 + r32 * 16), cf[ks + 1], yb, 0, 0, 0); }
                    const float ecs = __expf(cs_l);
#pragma unroll
                    for (int r = 0; r < 16; ++r) acc[r] += (ya[r] + yb[r]) * ecs;
                }
                if (wave == 1) {
                    for (;;) { unsigned fl; asm volatile("ds_read_b32 %0, %1 offset:4\n\ts_waitcnt lgkmcnt(0)" : "=&v"(fl) : "v"((unsigned)(size_t)(ldsl + SSD_SYNC)) : "memory");
                        if (__builtin_amdgcn_readfirstlane(fl) >= (unsigned)(c + 1)) break; __builtin_amdgcn_s_sleep(1); }
                    asm volatile("" ::: "memory");
                    const LAS unsigned char* pp = ldsl + SSD_PART + lane * 64;
#pragma unroll
                    for (int q = 0; q < 4; ++q) { const f32x4 v = *(const LAS f32x4*)(pp + q * 16); acc[4 * q] += v[0]; acc[4 * q + 1] += v[1]; acc[4 * q + 2] += v[2]; acc[4 * q + 3] += v[3]; }
                }
                float yss = 0.f;
                {
                    LAS unsigned char* zrow = (LAS unsigned char*)(ldsl + (c % 3) * SSD_IN + SSD_Z) + l * 64 + 8 * hi;
                    u32x2 xw[4], zw[4];
#pragma unroll
                    for (int q = 0; q < 4; ++q) { xw[q] = *(const LAS u32x2*)(in + SSD_XS + l * 64 + (8 * q + 4 * hi) * 2); zw[q] = *(const LAS u32x2*)(zrow + 16 * q); }
#pragma unroll
                    for (int q = 0; q < 4; ++q) {
                        const float y0 = (acc[4 * q + 0] + dsk * bflo(xw[q].x)) * silu_fast(bflo(zw[q].x)), y1 = (acc[4 * q + 1] + dsk * bfhi(xw[q].x)) * silu_fast(bfhi(zw[q].x));
                        const float y2 = (acc[4 * q + 2] + dsk * bflo(xw[q].y)) * silu_fast(bflo(zw[q].y)), y3 = (acc[4 * q + 3] + dsk * bfhi(xw[q].y)) * silu_fast(bfhi(zw[q].y));
                        yss += (y0 * y0 + y1 * y1) + (y2 * y2 + y3 * y3);
                        u32x2 o; o.x = pk2(y0, y1); o.y = pk2(y2, y3);
                        *(LAS u32x2*)(zrow + 16 * q) = o;
                    }
                    asm volatile("s_waitcnt lgkmcnt(0)" ::: "memory");
                    const LAS unsigned char* zt = (const LAS unsigned char*)(ldsl + (c % 3) * SSD_IN + SSD_Z) + (32 * lb + (lane >> 2)) * 64 + (lane & 3) * 16;
                    bf16_t* yo = (bf16_t*)(p.ws + WS_MIXRAW) + (tb0 + (size_t)c * 64 + 32 * lb + (lane >> 2)) * DM + 1024 + h * 64 + ph * 32 + (lane & 3) * 8;
                    const u32x4 o0 = *(const LAS u32x4*)(zt), o1 = *(const LAS u32x4*)(zt + 16 * 64);
                    *(u32x4*)(yo) = o0; *(u32x4*)(yo + (size_t)16 * DM) = o1;
                }
                yss += __shfl_xor(yss, 32);
                if (hi == 0) ((float*)(p.ws + WS_PSQS))[(tb0 + (size_t)c * 64 + l) * 32 + h * 2 + ph] = yss;
            } else {
                const int nb = wave - 2;
                const float cs63 = csl[63];
                { const float dec = __expf(cs63);
#pragma unroll
                  for (int r = 0; r < 16; ++r) S[r] *= dec; }
                const int brow = 4 * hi + ((lane & 15) >> 2), bch = 4 * nb + 2 * ((lane >> 4) & 1) + ((lane & 3) >> 1);
                const unsigned xpa = (unsigned)(size_t)(in + xfo);
                const unsigned bpa = (unsigned)(size_t)(in + SSD_BM + brow * 256 + ((bch ^ brow) << 4) + (lane & 1) * 8);
                const unsigned bpb = (unsigned)(size_t)(in + SSD_BM + (brow + 8) * 256 + ((bch ^ (brow + 8)) << 4) + (lane & 1) * 8);
                s16x4 lo[4], hh[4], blo[4], bhh[4]; f32x4 c0[4], c1[4], d0[4], d1[4];
                TR_PAIR(lo[0], hh[0], xpa, SSD_XS + 0 * 1024, 512); TR_PAIR(lo[1], hh[1], xpa, SSD_XS + 1 * 1024, 512); TR_PAIR(lo[2], hh[2], xpa, SSD_XS + 2 * 1024, 512); TR_PAIR(lo[3], hh[3], xpa, SSD_XS + 3 * 1024, 512);
                asm volatile("ds_read_b64_tr_b16 %0, %1 offset:%c2" : "=&v"(blo[0]) : "v"(bpa), "i"(0 * 4096) : "memory"); asm volatile("ds_read_b64_tr_b16 %0, %1 offset:%c2" : "=&v"(bhh[0]) : "v"(bpb), "i"(0 * 4096) : "memory");
                asm volatile("ds_read_b64_tr_b16 %0, %1 offset:%c2" : "=&v"(blo[1]) : "v"(bpa), "i"(1 * 4096) : "memory"); asm volatile("ds_read_b64_tr_b16 %0, %1 offset:%c2" : "=&v"(bhh[1]) : "v"(bpb), "i"(1 * 4096) : "memory");
                asm volatile("ds_read_b64_tr_b16 %0, %1 offset:%c2" : "=&v"(blo[2]) : "v"(bpa), "i"(2 * 4096) : "memory"); asm volatile("ds_read_b64_tr_b16 %0, %1 offset:%c2" : "=&v"(bhh[2]) : "v"(bpb), "i"(2 * 4096) : "memory");
                asm volatile("ds_read_b64_tr_b16 %0, %1 offset:%c2" : "=&v"(blo[3]) : "v"(bpa), "i"(3 * 4096) : "memory"); asm volatile("ds_read_b64_tr_b16 %0, %1 offset:%c2" : "=&v"(bhh[3]) : "v"(bpb), "i"(3 * 4096) : "memory");
#pragma unroll
                for (int ks = 0; ks < 4; ++ks) { c0[ks] = *(const LAS f32x4*)(csl + 16 * ks + 4 * hi); c1[ks] = *(const LAS f32x4*)(csl + 16 * ks + 8 + 4 * hi);
                                                 d0[ks] = *(const LAS f32x4*)(dtl + 16 * ks + 4 * hi); d1[ks] = *(const LAS f32x4*)(dtl + 16 * ks + 8 + 4 * hi); }
                LDS_WAIT_PIN();
                u32x4 aw[4];
#pragma unroll
                for (int ks = 0; ks < 4; ++ks) {
                    float xf[8];
#pragma unroll
                    for (int j = 0; j < 4; ++j) { xf[j] = bf2f((unsigned short)lo[ks][j]) * __expf(cs63 - c0[ks][j]) * d0[ks][j]; xf[4 + j] = bf2f((unsigned short)hh[ks][j]) * __expf(cs63 - c1[ks][j]) * d1[ks][j]; }
                    aw[ks].x = cvtpk(xf[0], xf[1]); aw[ks].y = cvtpk(xf[2], xf[3]); aw[ks].z = cvtpk(xf[4], xf[5]); aw[ks].w = cvtpk(xf[6], xf[7]);
                }
#pragma unroll
                for (int ks = 0; ks < 4; ++ks)
                    S = __builtin_amdgcn_mfma_f32_32x32x16_bf16(__builtin_bit_cast(bf16x8, aw[ks]), (bf16x8){blo[ks][0], blo[ks][1], blo[ks][2], blo[ks][3], bhh[ks][0], bhh[ks][1], bhh[ks][2], bhh[ks][3]}, S, 0, 0, 0);
                const int n = 32 * nb + r32;
#pragma unroll
                for (int r = 0; r < 16; ++r) *(LAS unsigned short*)(STout + (n >> 3) * 512 + crow(r, hi) * 16 + (n & 7) * 2) = (unsigned short)f2bf(S[r]);
            }
        }
#undef SSD_ISSUE
#undef SSD_G16
    }
    asm volatile("s_waitcnt vmcnt(0) lgkmcnt(0)" ::: "memory");
    __builtin_amdgcn_s_barrier(); asm volatile("" ::: "memory");
}
constexpr size_t P5_DSL = (size_t)16384 * 128, P5_SSL = (size_t)16384 * 8;
constexpr int PD = 4;
template <int CTRL> __device__ __forceinline__ float dpp_xadd(float v) { return v + __builtin_bit_cast(float, __builtin_amdgcn_update_dpp(0, __builtin_bit_cast(int, v), CTRL, 0xf, 0xf, false)); }
#define P5_CVT(wd, bs) __builtin_amdgcn_cvt_scalef32_pk_f32_fp4((wd), 1.0f, (bs))
#define P5_LOAD16(dst, src) do { const u32x4* s_ = (const u32x4*)(src); const u32x4 a_ = s_[0], b_ = s_[1], c_ = s_[2], d_ = s_[3]; \
        dst[0] = a_.x; dst[1] = a_.y; dst[2] = a_.z; dst[3] = a_.w; dst[4] = b_.x; dst[5] = b_.y; dst[6] = b_.z; dst[7] = b_.w; \
        dst[8] = c_.x; dst[9] = c_.y; dst[10] = c_.z; dst[11] = c_.w; dst[12] = d_.x; dst[13] = d_.y; dst[14] = d_.z; dst[15] = d_.w; } while (0)
#define P5_ISSUE(slot, e) do { if constexpr (PV == 8) { const size_t e_ = (size_t)((unsigned)__builtin_amdgcn_readfirstlane((int)(e)) & 2047u); wq[slot] = *(const u32x4*)(TD + (e_ << 10) + g * 128 + q16); } \
        else if constexpr (PV == 2) { } else { wq[slot] = *(const u32x4*)(TD + (size_t)(((unsigned)(e) << 7) + q16)); } } while (0)
#define P5_SCB(e) ((unsigned)SC[(e) * 8u])
#define P5_SCALE(code) __builtin_bit_cast(float, ((code) << 20) + 0x33800000u)
#define P5_TABLE(off) do { const u32x4* src_ = (const u32x4*)(p.ws + (off) + (size_t)x * P5_SSL); \
        int k0_ = wave * 64 + lane; asm volatile("" : "+v"(k0_)); \
        for (int k_ = k0_; k_ < (int)(P5_SSL / 16); k_ += NTHR) ((LAS u32x4*)ldsl)[k_] = src_[k_]; __syncthreads(); } while (0)
template <int PV> __device__ __forceinline__ void ph_peer_u(const Params& p, LAS unsigned char* ldsl, int bid, int wave, int lane) {
    const int x = bid & 7, r = (bid >> 3) * NWAVES + wave, g = lane >> 3, q = lane & 7, colb = 32 * x + 4 * q;
    const unsigned char* TD = p.ws + WS_U4D + (size_t)x * P5_DSL; const unsigned q16 = q * 16; const LAS unsigned char* SC = ldsl + q;
    P5_TABLE(WS_U4S);
    const unsigned* IDX = (const unsigned*)(p.ws + WS_IDX) + g * 16; const bf16_t* XM = (const bf16_t*)(p.ws + WS_X1M) + colb; const float* PSQ = (const float*)(p.ws + WS_PSQX) + (lane & 31);
    float* PART = (float*)(p.ws + WS_PART) + (size_t)x * 128 + g * 16;
    unsigned ec[16], en[16]; u32x4 wq[PD]; unsigned sb; f32x2_t hf[16]; f32x4 sh[8]; u32x2 xn[8]; float pqn;
    {
        P5_LOAD16(ec, IDX + (size_t)r * 128);
        const float* shp = (const float*)(p.ws + WS_MOD) + 3 * DM + colb;
#pragma unroll
        for (int j = 0; j < 8; ++j) sh[j] = *(const f32x4*)(shp + j * 256);
        float pq = PSQ[(size_t)r * 32]; pq = dpp_xadd<0xB1>(pq); pq = dpp_xadd<0x4E>(pq); pq = dpp_xadd<0x141>(pq); pq = dpp_xadd<0x140>(pq); pq += __shfl_xor(pq, 16);
        const float r2 = rsqrtf(pq * (1.f / DM) + EPS);
#pragma unroll
        for (int j = 0; j < 8; ++j) { const u32x2 a = *(const u32x2*)(XM + (size_t)r * DM + j * 256);
            hf[2 * j] = (f32x2_t){bflo(a.x) * r2 + sh[j][0], bfhi(a.x) * r2 + sh[j][1]}; hf[2 * j + 1] = (f32x2_t){bflo(a.y) * r2 + sh[j][2], bfhi(a.y) * r2 + sh[j][3]}; }
#pragma unroll
        for (int i = 0; i < PD; ++i) P5_ISSUE(i, ec[i]);
        sb = P5_SCB(ec[0]);
    }
    auto tok = [&](unsigned (&ec)[16], unsigned (&en)[16], const int n) __attribute__((always_inline)) {
        const int t = r + 256 * n, tn = r + 256 * min(n + 1, 63);
        P5_LOAD16(en, IDX + (size_t)tn * 128);
#pragma unroll
        for (int j = 0; j < 8; ++j) xn[j] = *(const u32x2*)(XM + (size_t)tn * DM + j * 256);
        pqn = PSQ[(size_t)tn * 32];
        if (((n + 1) & 7) == 0 && n < 63) {
            const float* shp = (const float*)(p.ws + WS_MOD) + (size_t)((n + 1) >> 3) * 6 * DM + 3 * DM + colb;
#pragma unroll
            for (int j = 0; j < 8; ++j) sh[j] = *(const f32x4*)(shp + j * 256);
        }
        float sp[16];
#pragma unroll
        for (int i = 0; i < 16; ++i) {
            __builtin_amdgcn_sched_barrier(0);
            const u32x4 w = wq[i % PD];
            if (i + PD < 16) P5_ISSUE(i % PD, ec[(i + PD) & 15]); else P5_ISSUE(i % PD, en[(i + PD) & 15]);
            const unsigned sbn = P5_SCB((i < 15) ? ec[(i + 1) & 15] : en[0]);
            const float scl = P5_SCALE(sb); sb = sbn;
            f32x2_t a2 = (f32x2_t){0.f, 0.f}, b2 = (f32x2_t){0.f, 0.f};
            a2 += P5_CVT(w.x, 0) * hf[0]; b2 += P5_CVT(w.x, 1) * hf[1]; a2 += P5_CVT(w.x, 2) * hf[2]; b2 += P5_CVT(w.x, 3) * hf[3];
            a2 += P5_CVT(w.y, 0) * hf[4]; b2 += P5_CVT(w.y, 1) * hf[5]; a2 += P5_CVT(w.y, 2) * hf[6]; b2 += P5_CVT(w.y, 3) * hf[7];
            a2 += P5_CVT(w.z, 0) * hf[8]; b2 += P5_CVT(w.z, 1) * hf[9]; a2 += P5_CVT(w.z, 2) * hf[10]; b2 += P5_CVT(w.z, 3) * hf[11];
            a2 += P5_CVT(w.w, 0) * hf[12]; b2 += P5_CVT(w.w, 1) * hf[13]; a2 += P5_CVT(w.w, 2) * hf[14]; b2 += P5_CVT(w.w, 3) * hf[15];
            a2 += b2;
            float a = (a2.x + a2.y) * scl;
            asm volatile("" : "+v"(a));
            sp[i] = a;
        }
        {
            float r8[8], r4[4], r2[2];
            { const bool hi = (q & 4) != 0;
#pragma unroll
              for (int k = 0; k < 8; ++k) { const float keep = hi ? sp[k + 8] : sp[k], send = hi ? sp[k] : sp[k + 8]; r8[k] = keep + __builtin_bit_cast(float, __builtin_amdgcn_update_dpp(0, __builtin_bit_cast(int, send), 0x141, 0xf, 0xf, false)); } }
            { const bool hi = (q & 2) != 0;
#pragma unroll
              for (int k = 0; k < 4; ++k) { const float keep = hi ? r8[k + 4] : r8[k], send = hi ? r8[k] : r8[k + 4]; r4[k] = keep + __builtin_bit_cast(float, __builtin_amdgcn_update_dpp(0, __builtin_bit_cast(int, send), 0x4E, 0xf, 0xf, false)); } }
            { const bool hi = (q & 1) != 0;
#pragma unroll
              for (int k = 0; k < 2; ++k) { const float keep = hi ? r4[k + 2] : r4[k], send = hi ? r4[k] : r4[k + 2]; r2[k] = keep + __builtin_bit_cast(float, __builtin_amdgcn_update_dpp(0, __builtin_bit_cast(int, send), 0xB1, 0xf, 0xf, false)); } }
            *(f32x2_t*)(PART + (size_t)t * 1024 + 2 * q) = (f32x2_t){r2[0], r2[1]};
        }
        { float pq = pqn; pq = dpp_xadd<0xB1>(pq); pq = dpp_xadd<0x4E>(pq); pq = dpp_xadd<0x141>(pq); pq = dpp_xadd<0x140>(pq); pq += __shfl_xor(pq, 16);
          const float r2 = rsqrtf(pq * (1.f / DM) + EPS);
#pragma unroll
          for (int j = 0; j < 8; ++j) { const u32x2 a = xn[j];
              hf[2 * j] = (f32x2_t){bflo(a.x) * r2 + sh[j][0], bfhi(a.x) * r2 + sh[j][1]}; hf[2 * j + 1] = (f32x2_t){bflo(a.y) * r2 + sh[j][2], bfhi(a.y) * r2 + sh[j][3]}; }
        }
    };
    for (int n = 0; n < 64; n += 2) { tok(ec, en, n); tok(en, ec, n + 1); }
}
__device__ __forceinline__ void ph_peer_s(const Params& p, int gwave, int gnw, int lane) {
    for (int t = gwave; t < T; t += gnw) {
        const float* pp = (const float*)(p.ws + WS_PART) + (size_t)t * 1024 + lane * 2; float* gp = (float*)(p.ws + WS_GATE) + (size_t)t * 128 + lane * 2;
        f32x2_t s = *(const f32x2_t*)pp;
#pragma unroll
        for (int x = 1; x < 8; ++x) s += *(const f32x2_t*)(pp + x * 128);
        const f32x2_t gt = *(const f32x2_t*)gp;
        *(f32x2_t*)gp = (f32x2_t){0.5f * s.x * (1.f + erff(s.x * 0.70710678118654752f)) * gt.x, 0.5f * s.y * (1.f + erff(s.y * 0.70710678118654752f)) * gt.y};
    }
}
template <int PV> __device__ __forceinline__ void ph_peer_v(const Params& p, LAS unsigned char* ldsl, int bid, int wave, int lane) {
    const int x = bid & 7, r = (bid >> 3) * NWAVES + wave, g = lane >> 3, q = lane & 7, col = 256 * g + 32 * x + 4 * q;
    const unsigned char* TD = p.ws + WS_V4D + (size_t)x * P5_DSL; const unsigned q16 = q * 16; const LAS unsigned char* SC = ldsl + q;
    P5_TABLE(WS_V4S);
    const unsigned* IDX = (const unsigned*)(p.ws + WS_IDX) + g * 16; const unsigned* CF = (const unsigned*)(p.ws + WS_GATE) + g * 16;
    unsigned ec[16], en[16], cc[16], cn[16]; u32x4 wq[PD]; unsigned sb;
    if constexpr (PV == 2) {
#pragma unroll
        for (int i = 0; i < PD; ++i) { wq[i] = (u32x4){0x12345678u + lane, 0x9abcdef0u, 0x13572468u, 0x2468ace0u}; asm volatile("" : "+v"(wq[i])); } }
    P5_LOAD16(ec, IDX + (size_t)r * 128); P5_LOAD16(cc, CF + (size_t)r * 128);
#pragma unroll
    for (int i = 0; i < PD; ++i) P5_ISSUE(i, ec[i]);
    sb = P5_SCB(ec[0]);
    auto tok = [&](unsigned (&ec)[16], unsigned (&en)[16], unsigned (&cc)[16], unsigned (&cn)[16], const int n) __attribute__((always_inline)) {
        const int t = r + 256 * n, tn = r + 256 * min(n + 1, 63), b = n >> 3;
        P5_LOAD16(en, IDX + (size_t)tn * 128); P5_LOAD16(cn, CF + (size_t)tn * 128);
        const u32x2 xm = *(const u32x2*)((const bf16_t*)(p.ws + WS_X1M) + (size_t)t * DM + col);
        const f32x4 ga = *(const f32x4*)((const float*)(p.ws + WS_MOD) + (size_t)b * 6 * DM + 5 * DM + col), sc = *(const f32x4*)((const float*)(p.ws + WS_MOD) + (size_t)b * 6 * DM + 4 * DM + col);
        f32x2_t out[16];
#pragma unroll
        for (int i = 0; i < 16; ++i) {
            __builtin_amdgcn_sched_barrier(0);
            u32x4 w = wq[i % PD]; if constexpr (PV == 2) asm volatile("" : "+v"(w));
            if (i + PD < 16) P5_ISSUE(i % PD, ec[(i + PD) & 15]); else P5_ISSUE(i % PD, en[(i + PD) & 15]);
            const unsigned sbn = P5_SCB((i < 15) ? ec[(i + 1) & 15] : en[0]);
            const float a = __builtin_bit_cast(float, cc[i]) * P5_SCALE(sb); sb = sbn;
            f32x2_t aa = (f32x2_t){a, a}; asm volatile("" : "+v"(aa));
            if (i == 0) {
                out[0] = aa * P5_CVT(w.x, 0); out[1] = aa * P5_CVT(w.x, 1); out[2] = aa * P5_CVT(w.x, 2); out[3] = aa * P5_CVT(w.x, 3);
                out[4] = aa * P5_CVT(w.y, 0); out[5] = aa * P5_CVT(w.y, 1); out[6] = aa * P5_CVT(w.y, 2); out[7] = aa * P5_CVT(w.y, 3);
                out[8] = aa * P5_CVT(w.z, 0); out[9] = aa * P5_CVT(w.z, 1); out[10] = aa * P5_CVT(w.z, 2); out[11] = aa * P5_CVT(w.z, 3);
                out[12] = aa * P5_CVT(w.w, 0); out[13] = aa * P5_CVT(w.w, 1); out[14] = aa * P5_CVT(w.w, 2); out[15] = aa * P5_CVT(w.w, 3);
            } else {
            out[0] += aa * P5_CVT(w.x, 0); out[1] += aa * P5_CVT(w.x, 1); out[2] += aa * P5_CVT(w.x, 2); out[3] += aa * P5_CVT(w.x, 3);
            out[4] += aa * P5_CVT(w.y, 0); out[5] += aa * P5_CVT(w.y, 1); out[6] += aa * P5_CVT(w.y, 2); out[7] += aa * P5_CVT(w.y, 3);
            asm volatile("" : "+v"(out[0]), "+v"(out[1]), "+v"(out[2]), "+v"(out[3]), "+v"(out[4]), "+v"(out[5]), "+v"(out[6]), "+v"(out[7]));
            out[8] += aa * P5_CVT(w.z, 0); out[9] += aa * P5_CVT(w.z, 1); out[10] += aa * P5_CVT(w.z, 2); out[11] += aa * P5_CVT(w.z, 3);
            out[12] += aa * P5_CVT(w.w, 0); out[13] += aa * P5_CVT(w.w, 1); out[14] += aa * P5_CVT(w.w, 2); out[15] += aa * P5_CVT(w.w, 3);
            asm volatile("" : "+v"(out[8]), "+v"(out[9]), "+v"(out[10]), "+v"(out[11]), "+v"(out[12]), "+v"(out[13]), "+v"(out[14]), "+v"(out[15]));
            }
        }
        f32x2_t o8[8], o4[4], o2[2];
#define P5_SW(fn, a_, b_, d_) do { float x_ = a_, y_ = b_; asm volatile("s_nop 1\n\t" fn " %0, %1" : "+v"(x_), "+v"(y_)); d_ = x_ + y_; } while (0)
#pragma unroll
        for (int k = 0; k < 8; ++k) { P5_SW("v_permlane32_swap_b32", out[k].x, out[k + 8].x, o8[k].x); P5_SW("v_permlane32_swap_b32", out[k].y, out[k + 8].y, o8[k].y); }
#pragma unroll
        for (int k = 0; k < 4; ++k) { P5_SW("v_permlane16_swap_b32", o8[k].x, o8[k + 4].x, o4[k].x); P5_SW("v_permlane16_swap_b32", o8[k].y, o8[k + 4].y, o4[k].y); }
#undef P5_SW
        { const bool hi = (lane & 8) != 0;
#pragma unroll
          for (int k = 0; k < 2; ++k) { const f32x2_t keep = hi ? o4[k + 2] : o4[k], send = hi ? o4[k] : o4[k + 2]; o2[k] = keep + (f32x2_t){__shfl_xor(send.x, 8), __shfl_xor(send.y, 8)}; } }
        *(f32x4*)(p.out + (size_t)t * DM + col) = (f32x4){bflo(xm.x) * __builtin_amdgcn_rcpf(1.f + sc.x) + ga.x * o2[0].x, bfhi(xm.x) * __builtin_amdgcn_rcpf(1.f + sc.y) + ga.y * o2[0].y,
                                                          bflo(xm.y) * __builtin_amdgcn_rcpf(1.f + sc.z) + ga.z * o2[1].x, bfhi(xm.y) * __builtin_amdgcn_rcpf(1.f + sc.w) + ga.w * o2[1].y};
    };
    for (int n = 0; n < 64; n += 2) { tok(ec, en, cc, cn, n); tok(en, ec, cn, cc, n + 1); }
}
#undef P5_CVT
#undef P5_LOAD16
#undef P5_ISSUE
#undef P5_SCB
#undef P5_SCALE
#undef P5_TABLE
constexpr int RING_BYTES = 131072, LDSCTL_OFF = 146432, MISC_OFF = LDSCTL_OFF + 320, LDS_BYTES = 147456;
static_assert(SSD_SYNC + 64 <= LDSCTL_OFF, "SSD LDS map");
constexpr int NPH = 15;
#ifndef MK_PER_PHASE
#define MK_PER_PHASE 0
#endif

__global__ void __launch_bounds__(NTHR, 2) mega(Params p) {
    extern __shared__ __attribute__((aligned(16))) unsigned char lds[];
    LAS unsigned char* ldsl = (LAS unsigned char*)lds;
    const int tid = threadIdx.x, lane = tid & 63, wave = __builtin_amdgcn_readfirstlane(tid >> 6);
    const int G = gridDim.x, bid = blockIdx.x;
    unsigned char* ws = p.ws;
    gu32* ctl = (gu32*)(ws + WS_CTL);
    for (int u = tid; u < (LDS_BYTES - LDSCTL_OFF) / 4; u += NTHR) ((LAS unsigned*)(ldsl + LDSCTL_OFF))[u] = 0u;
    __syncthreads();
    volatile LAS unsigned* MISC = (volatile LAS unsigned*)(ldsl + MISC_OFF);
    XcdBarrier bar; bar.bar = (unsigned*)(ctl + CW_BAR); bar.x = 0; bar.st = nullptr;
    if (!MK_PER_PHASE) bar = xcd_barrier_post((unsigned*)(ctl + CW_BAR), MISC + 8);
#define IN(k) (p.ph_lo <= (k) && (k) < p.ph_hi)
#define LN() ({ int l_ = lane; asm volatile("" : "+v"(l_)); l_; })
#define WV() ({ int w_ = wave; asm volatile("" : "+s"(w_)); w_; })
#define SEAM(k) do { if ((k) + 1 < p.ph_hi) xcd_barrier(bar); } while (0)
    const int gtid = bid * NTHR + tid, gn = G * NTHR, gwave = bid * NWAVES + wave, gnw = G * NWAVES;
    float* mod = (float*)(ws + WS_MOD);

    if (IN(0)) {
        if (bid < 96) ph_mod(p, lds, tid, bid);
        else ph_transposes(p, lds, WV(), LN(), (bid - 96) * NWAVES + wave, (G - 96) * NWAVES);
        ph_rope_tab(p, gtid, gn);
        ph_convert(p.sub_keys, (bf16_t*)(ws + WS_SUBK), (size_t)8 * 2 * 128 * 128 / 4, gtid, gn);
        SEAM(0);
    }
    if (IN(1)) { ph_modrows(p.x, (bf16_t*)(ws + WS_H), mod, 0, 1, gwave, gnw, LN()); ph_bias2(p, gwave, gnw, LN()); SEAM(1); }
    if (IN(2)) {
        pg8::Gemm g{(const bf16_t*)(ws + WS_H), (const bf16_t*)(ws + WS_WINT), T, NPROJ, DM, DM}; pg8::StaticOrder S; S.init(T, NPROJ, G, bid);
        pg8::EpiBf16<0> E{(bf16_t*)(ws + WS_PROJ), NPROJ, nullptr, 0, 0, 1.f};
        pg8::gemm_phase<pg8::EpiBf16<0>, pg8::StaticOrder, true, true>(ldsl, g, S, E);
        SEAM(2);
    }
    if (IN(3)) {
        { pg8::Gemm g{(const bf16_t*)(ws + WS_PROJ) + C_CQ, (const bf16_t*)(ws + WS_WUQT), T, NQ, 512, NPROJ}; pg8::StaticOrder S; S.init(T, NQ, G, bid);
          pg8::EpiBf16<0> E{(bf16_t*)(ws + WS_QRAW), NQ, nullptr, 0, 0, 1.f};
          pg8::gemm_phase<pg8::EpiBf16<0>, pg8::StaticOrder, true, true>(ldsl, g, S, E); }
        { pg8::Gemm g{(const bf16_t*)(ws + WS_PROJ) + C_CKV, (const bf16_t*)(ws + WS_WUKVT), T, NKV, 256, NPROJ}; pg8::SkewOrder S; S.init(T, NKV, G, bid);
          pg8::EpiBf16<0> E{(bf16_t*)(ws + WS_KVRAW), NKV, nullptr, 0, 0, 1.f};
          pg8::gemm_phase<pg8::EpiBf16<0>, pg8::SkewOrder, true, true>(ldsl, g, S, E); }
        SEAM(3);
    }
    if (IN(4)) { ph_qkv_post(p, gwave, gnw, LN()); ph_conv(p, gwave, gnw, LN()); SEAM(4); }
    if (IN(5)) { ph_attn(p, ldsl, bid, G, WV(), LN()); ph_ssd(p, ldsl, bid, WV(), LN()); SEAM(5); }
    if (IN(8)) {
        pg8::Gemm g{(const bf16_t*)(ws + WS_MIXRAW), (const bf16_t*)(ws + WS_WOUTT), T, DM, DM, DM}; pg8::StaticOrder S; S.init(T, DM, G, bid);
        pg8::Unit u0, u1; S.next(0, u0); if (!S.next(1, u1)) u1 = u0;
        LAS float* kt = (LAS float*)(ldsl + RING_BYTES);
        { const int slot = tid >> 8, r = tid & 255, row = (slot ? u1.pm : u0.pm) * 256 + r;
          const f32x4* pa = (const f32x4*)((const float*)(ws + WS_PSQA) + (size_t)row * 8); const f32x4* ps = (const f32x4*)((const float*)(ws + WS_PSQS) + (size_t)row * 32);
          const f32x4 a0 = pa[0], a1 = pa[1]; float sa = ((a0[0] + a0[1]) + (a0[2] + a0[3])) + ((a1[0] + a1[1]) + (a1[2] + a1[3])), s0 = 0.f, s1 = 0.f;
#pragma unroll
          for (int q = 0; q < 4; ++q) { const f32x4 v = ps[q], w = ps[4 + q]; s0 += (v[0] + v[1]) + (v[2] + v[3]); s1 += (w[0] + w[1]) + (w[2] + w[3]); }
          const float ra = rsqrtf(sa * (1.f / 1024.f) + EPS), r0 = rsqrtf(s0 * (1.f / 512.f) + EPS), r1 = rsqrtf(s1 * (1.f / 512.f) + EPS);
          kt[tid * 4 + 0] = ra / r0; kt[tid * 4 + 1] = r0 / r1; kt[tid * 4 + 2] = r1; kt[tid * 4 + 3] = 0.f; }
        __syncthreads();
        pg8::EpiX1 E{p.x, mod, (bf16_t*)(ws + WS_X1M), (float*)(ws + WS_PSQX), DM, SEQ, kt, u0.pm};
        pg8::gemm_phase<pg8::EpiX1, pg8::StaticOrder, true, true>(ldsl, g, S, E);
        SEAM(8);
    }
    if (IN(10)) {
        pg8::Gemm g{(const bf16_t*)(ws + WS_X1M), (const bf16_t*)(ws + WS_WQT), T, DM, DM, DM}; pg8::StaticOrder S; S.init(T, DM, G, bid);
        pg8::Unit u0, u1; S.next(0, u0); if (!S.next(1, u1)) u1 = u0;
        LAS float* rt = (LAS float*)(ldsl + RING_BYTES);
        { const int slot = tid >> 8, r = tid & 255, row = (slot ? u1.pm : u0.pm) * 256 + r; const f32x4* pq = (const f32x4*)((const float*)(ws + WS_PSQX) + (size_t)row * 32); float s_ = 0.f;
#pragma unroll
          for (int q = 0; q < 8; ++q) { const f32x4 v = pq[q]; s_ += (v[0] + v[1]) + (v[2] + v[3]); }
          rt[tid] = rsqrtf(s_ * (1.f / DM) + EPS); }
        __syncthreads();
        pg8::EpiScaleBias E{(bf16_t*)(ws + WS_QP), DM, (const float*)(ws + WS_BIAS2), SEQ, rt, u0.pm};
        pg8::gemm_phase<pg8::EpiScaleBias, pg8::StaticOrder, true, true>(ldsl, g, S, E);
        SEAM(10);
    }
    if (IN(11)) { ph_route(p, ldsl, WV(), LN(), gwave, gnw); SEAM(11); }
    if (IN(12)) { ph_peer_u<0>(p, ldsl, bid, WV(), LN()); SEAM(12); }
    if (IN(13)) { ph_peer_s(p, gwave, gnw, LN()); SEAM(13); }
#ifdef PROBE_EMASK
    if (IN(14)) { if (p.emask == 2) ph_peer_v<2>(p, ldsl, bid, WV(), LN()); else if (p.emask == 8) ph_peer_v<8>(p, ldsl, bid, WV(), LN()); else ph_peer_v<0>(p, ldsl, bid, WV(), LN()); }
#else
    if (IN(14)) { ph_peer_v<0>(p, ldsl, bid, WV(), LN()); }
#endif
#ifdef PROBE_VALU
    if (IN(14)) {
        f32x2_t a0 = {1.f, 2.f}, a1 = a0, a2 = a0, a3 = a0; unsigned w = (unsigned)lane * 0x9E3779B9u; f32x2_t m = {1.0001f, 0.9999f};
        asm volatile("" : "+v"(w), "+v"(m));
        for (int i = 0; i < 400; ++i) {
#if PROBE_VALU == 1
#define PV4 "v_cvt_scalef32_pk_f32_fp4 %0, %4, 1.0\n v_cvt_scalef32_pk_f32_fp4 %1, %4, 1.0 op_sel:[1,0,0]\n v_cvt_scalef32_pk_f32_fp4 %2, %4, 1.0 op_sel:[0,1,0]\n v_cvt_scalef32_pk_f32_fp4 %3, %4, 1.0 op_sel:[1,1,0]\n"
            asm volatile(PV4 PV4 PV4 PV4 PV4 PV4 PV4 PV4 PV4 PV4 PV4 PV4 PV4 PV4 PV4 PV4 : "=&v"(a0), "=&v"(a1), "=&v"(a2), "=&v"(a3) : "v"(w));
#elif PROBE_VALU == 2
#define PV4 "v_pk_fma_f32 %0, %0, %4, %4\n v_pk_fma_f32 %1, %1, %4, %4\n v_pk_fma_f32 %2, %2, %4, %4\n v_pk_fma_f32 %3, %3, %4, %4\n"
            asm volatile(PV4 PV4 PV4 PV4 PV4 PV4 PV4 PV4 PV4 PV4 PV4 PV4 PV4 PV4 PV4 PV4 : "+v"(a0), "+v"(a1), "+v"(a2), "+v"(a3) : "v"(m));
#elif PROBE_VALU == 4
#define PV4 "v_pk_fma_f32 %0, %4, %5, %0\n v_pk_fma_f32 %1, %5, %6, %1\n v_pk_fma_f32 %2, %6, %4, %2\n v_pk_fma_f32 %3, %4, %6, %3\n"
            { f32x2_t m1 = m * 1.5f, m2 = m * 0.25f; asm volatile("" : "+v"(m1), "+v"(m2));
              asm volatile(PV4 PV4 PV4 PV4 PV4 PV4 PV4 PV4 PV4 PV4 PV4 PV4 PV4 PV4 PV4 PV4 : "+v"(a0), "+v"(a1), "+v"(a2), "+v"(a3) : "v"(m), "v"(m1), "v"(m2)); }
#elif PROBE_VALU == 5
#define PV4 "v_cvt_scalef32_pk_f32_fp4 %1, %4, 1.0\n v_pk_fma_f32 %0, %5, %1, %0\n v_cvt_scalef32_pk_f32_fp4 %1, %4, 1.0 op_sel:[1,0,0]\n v_pk_fma_f32 %0, %6, %1, %0\n"
            { f32x2_t m1 = m * 1.5f, m2 = m * 0.25f; asm volatile("" : "+v"(m1), "+v"(m2));
              asm volatile(PV4 PV4 PV4 PV4 PV4 PV4 PV4 PV4 PV4 PV4 PV4 PV4 PV4 PV4 PV4 PV4 : "+v"(a0), "=&v"(a1) : "v"(a2), "v"(a3), "v"(w), "v"(m1), "v"(m2)); }
#elif PROBE_VALU == 6
#define PV4 "v_cvt_scalef32_pk_f32_fp4 %1, %4, 1.0\n v_pk_fma_f32 %0, %5, %1, %0 op_sel_hi:[0,1,1]\n v_cvt_scalef32_pk_f32_fp4 %1, %4, 1.0 op_sel:[1,0,0]\n v_pk_fma_f32 %2, %5, %1, %2 op_sel_hi:[0,1,1]\n"
            { f32x2_t m1 = m * 1.5f; asm volatile("" : "+v"(m1));
              asm volatile(PV4 PV4 PV4 PV4 PV4 PV4 PV4 PV4 PV4 PV4 PV4 PV4 PV4 PV4 PV4 PV4 : "+v"(a0), "=&v"(a1), "+v"(a2) : "v"(a3), "v"(w), "v"(m1)); }
#else
#define PV4 "v_fma_f32 %0, %0, %4, %4\n v_fma_f32 %1, %1, %4, %4\n v_fma_f32 %2, %2, %4, %4\n v_fma_f32 %3, %3, %4, %4\n"
            { float b0 = a0.x, b1 = a1.x, b2 = a2.x, b3 = a3.x, mm = m.x;
              asm volatile(PV4 PV4 PV4 PV4 PV4 PV4 PV4 PV4 PV4 PV4 PV4 PV4 PV4 PV4 PV4 PV4 : "+v"(b0), "+v"(b1), "+v"(b2), "+v"(b3) : "v"(mm)); a0.x = b0; a1.x = b1; a2.x = b2; a3.x = b3; }
#endif
        }
    }
#endif
#undef IN
#undef SEAM
}

extern "C" void kernel_launch(void* const* d_in, const int* in_sizes, int n_in, void* d_out, int out_size, void* d_ws, size_t ws_size, hipStream_t stream) {
    static int grid = 0;
    if (grid == 0) {
        if (n_in != 24 || ws_size < WS_END) { fprintf(stderr, "kernel_launch: unexpected inputs / workspace (%d, %zu)\n", n_in, ws_size); grid = -1; return; }
        if (hipFuncSetAttribute((const void*)mega, hipFuncAttributeMaxDynamicSharedMemorySize, LDS_BYTES) != hipSuccess) { fprintf(stderr, "kernel_launch: hipFuncSetAttribute failed\n"); grid = -1; return; }
        (void)hipGetLastError();
        grid = 256;
    }
    if (grid < 0) return;
    (void)hipMemsetAsync((char*)d_ws + WS_CTL, 0, CTL_ZERO_BYTES, stream);
    Params p{};
    p.x = (const float*)d_in[0]; p.c = (const float*)d_in[1]; p.pos = (const int*)d_in[2]; p.w_ada = (const float*)d_in[3]; p.b_ada = (const float*)d_in[4];
    p.w_in = (const float*)d_in[5]; p.q_a_norm = (const float*)d_in[6]; p.w_uq = (const float*)d_in[7]; p.kv_a_norm = (const float*)d_in[8]; p.w_ukv = (const float*)d_in[9];
    p.q_norm = (const float*)d_in[10]; p.k_norm = (const float*)d_in[11]; p.attn_out_norm = (const float*)d_in[12]; p.conv_w = (const float*)d_in[13]; p.conv_b = (const float*)d_in[14];
    p.dt_bias = (const float*)d_in[15]; p.a_log = (const float*)d_in[16]; p.d_skip = (const float*)d_in[17]; p.ssd_norm = (const float*)d_in[18]; p.w_out = (const float*)d_in[19];
    p.w_query = (const float*)d_in[20]; p.sub_keys = (const float*)d_in[21]; p.u_exp = (const float*)d_in[22]; p.v_exp = (const float*)d_in[23];
    p.out = (float*)d_out; p.ws = (unsigned char*)d_ws;
#if MK_PER_PHASE
    for (int ph = 0; ph < NPH; ++ph) { p.ph_lo = ph; p.ph_hi = ph + 1; hipLaunchKernelGGL(mega, dim3(grid), dim3(NTHR), LDS_BYTES, stream, p); }
#elif defined(PROBE_SEQ)
    { const int seq[] = {PROBE_SEQ}; const int nl = (int)(sizeof(seq) / sizeof(int)) / 2;
      for (int li = 0; li < nl; ++li) { if (li) (void)hipMemsetAsync((char*)d_ws + WS_CTL, 0, CTL_ZERO_BYTES, stream);
          p.ph_lo = seq[2 * li]; p.ph_hi = seq[2 * li + 1];
#ifdef PROBE_EMASK
          p.emask = (li == 1) ? (PROBE_EMASK) : 0;
#endif
          hipLaunchKernelGGL(mega, dim3(grid), dim3(NTHR), LDS_BYTES, stream, p); } }
#else
    p.ph_lo = 0; p.ph_hi = NPH;
    hipLaunchKernelGGL(mega, dim3(grid), dim3(NTHR), LDS_BYTES, stream, p);
#endif
}
```

```cpp
#include <hip/hip_runtime.h>
#include <cstdint>
#include <cstdio>
#include <cmath>

constexpr int DM = 2048, NB = 8, SEQ = 2048, T = NB * SEQ;
constexpr int IN_COLS = 3408, NPROJ = 3584;
constexpr int C_CQ = 0, C_CKV = 512, C_KR = 768, C_Z = 832, C_XBC = 1856, C_DT = 3392;
constexpr int NQ = 1536, NKV = 2048;
constexpr float EPS = 1e-6f;
constexpr int NTHR = 512, NWAVES = 8;

typedef unsigned short bf16_t;
typedef unsigned u32x4 __attribute__((ext_vector_type(4)));
typedef float f32x4 __attribute__((ext_vector_type(4)));
typedef unsigned u32x2 __attribute__((ext_vector_type(2)));
#define GAS __attribute__((address_space(1)))
#define LAS __attribute__((address_space(3)))
typedef GAS unsigned gu32;
typedef GAS unsigned long long gu64;
#define RLX_AGENT __ATOMIC_RELAXED, __HIP_MEMORY_SCOPE_AGENT

__device__ __forceinline__ unsigned f2bf(float f) { unsigned u = __builtin_bit_cast(unsigned, f); return (u + 0x7fffu + ((u >> 16) & 1u)) >> 16; }
__device__ __forceinline__ float bf2f(unsigned h) { return __builtin_bit_cast(float, h << 16); }
__device__ __forceinline__ unsigned pk2(float lo, float hi) { return f2bf(lo) | (f2bf(hi) << 16); }
__device__ __forceinline__ float bflo(unsigned w) { return __builtin_bit_cast(float, w << 16); }
__device__ __forceinline__ float bfhi(unsigned w) { return __builtin_bit_cast(float, w & 0xffff0000u); }
__device__ __forceinline__ float silu_f(float v) { return v / (1.f + __expf(-v)); }
__device__ __forceinline__ float wave_sum(float v) {
#pragma unroll
    for (int o = 1; o < 64; o <<= 1) v += __shfl_xor(v, o);
    return v;
}

constexpr size_t MiB = 1u << 20;
constexpr size_t WS_CTL = 0, CTL_ZERO_BYTES = 64 * 1024, WS_MOD = 1 * MiB, WS_ROPEC = 2 * MiB, WS_ROPES = 4 * MiB, WS_SUBK = 6 * MiB, WS_WUQT = 7 * MiB, WS_WUKVT = 9 * MiB,
                 WS_WINT = 10 * MiB, WS_WOUTT = 24 * MiB, WS_WQT = 32 * MiB,
                 WS_US = 40 * MiB, WS_VS = 41 * MiB, WS_PSQX = 42 * MiB, WS_BIAS2 = 44 * MiB, WS_PSQA = 45 * MiB, WS_PSQS = 46 * MiB, WS_CS = 50 * MiB, WS_DT = 51 * MiB, WS_IDX = 52 * MiB, WS_GATE = 60 * MiB, WS_U16 = 68 * MiB, WS_V16 = 132 * MiB, WS_U8 = 68 * MiB, WS_V8 = 100 * MiB, WS_MIXRAW = 372 * MiB, WS_U4D = 436 * MiB, WS_U4S = 452 * MiB, WS_V4D = 456 * MiB, WS_V4S = 472 * MiB, WS_PART = 196 * MiB,
                 WS_K = 68 * MiB, WS_YSSD = 68 * MiB, WS_XBCA = 116 * MiB, WS_ATTN = 164 * MiB,
                 WS_H = 196 * MiB, WS_Q = 196 * MiB, WS_MIXIN = 196 * MiB, WS_H2 = 196 * MiB, WS_X1M = 68 * MiB,
                 WS_PROJ = 260 * MiB, WS_QP = 260 * MiB, WS_QRAW = 372 * MiB, WS_KVRAW = 420 * MiB, WS_V = 484 * MiB, WS_END = 516 * MiB;
constexpr int CW_BAR = 1024;

struct Params {
    const float *x, *c; const int* pos;
    const float *w_ada, *b_ada, *w_in, *q_a_norm, *w_uq, *kv_a_norm, *w_ukv, *q_norm, *k_norm, *attn_out_norm, *conv_w, *conv_b, *dt_bias, *a_log,
        *d_skip, *ssd_norm, *w_out, *w_query, *sub_keys, *u_exp, *v_exp;
    float* out; unsigned char* ws;
    int ph_lo, ph_hi;
#ifdef PROBE_EMASK
    int emask;
#endif
};
namespace pg8 {
#define PG8_LAS __attribute__((address_space(3)))
typedef unsigned short bf16_t;
typedef short bf16x8 __attribute__((ext_vector_type(8)));
typedef float f32x4 __attribute__((ext_vector_type(4)));
typedef unsigned u32x4 __attribute__((ext_vector_type(4)));
constexpr int BM = 256, BK = 64, HALF = 128, HTB = HALF * BK * 2  , STAGE_BYTES = 8 * HTB, NXCD = 8, WGM = 16;

__host__ __device__ __forceinline__ int lds_byte(int r, int c) { const int st = (r >> 4) * 2 + (c >> 5), rr = r & 15, cc = c & 31, ob = rr * 64 + cc * 2; return st * 1024 + (ob ^ (((ob >> 9) & 1) << 5)); }
__host__ __device__ __forceinline__ void stage_rc(int b, int& R, int& C) { const int st = b / 1024, sb = b % 1024, swz = sb ^ (((sb >> 9) & 1) << 5); R = (st >> 1) * 16 + swz / 64; C = (st & 1) * 32 + (swz % 64) / 2; }
__host__ __device__ __forceinline__ int perm32(int rho) { const int n = rho >> 4, i = rho & 15; return 8 * (i >> 2) + 4 * n + (i & 3); }

struct Unit { int pm, pn; };
struct Gemm { const bf16_t* A; const bf16_t* Bt; int M, N, K, lda; };

struct StaticOrder {
    int nM, nN, nwg, G, c;
    __host__ __device__ void init(int M, int N, int G_, int c_) { nM = M / BM; nN = N / BM; nwg = nM * nN; G = G_; c = c_; }
    __host__ __device__ bool next(int i, Unit& u) const {
        const long L = (long)i * G + c; if (L >= nwg) return false;
        int wgid = (int)L;
        const int nig = WGM * nN, gid = wgid / nig, fm = gid * WGM, gsz = (nM - fm) < WGM ? (nM - fm) : WGM;
        u.pm = fm + ((wgid % nig) % gsz); u.pn = (wgid % nig) / gsz; return true;
    }
    __device__ __forceinline__ void a_ready(const Unit&) const {}
    __device__ __forceinline__ void done(const Unit&) const {}
};

struct SkewOrder : StaticOrder {
    __host__ __device__ bool next(int i, Unit& u) const {
        const int h = G / 2; long L;
        if (c < h) { if (i > 0) return false; L = c; } else { if (i > 2) return false; L = h + 3L * (c - h) + i; }
        if (L >= nwg) return false;
        int wgid = (int)L;
        const int nig = WGM * nN, gid = wgid / nig, fm = gid * WGM, gsz = (nM - fm) < WGM ? (nM - fm) : WGM;
        u.pm = fm + ((wgid % nig) % gsz); u.pn = (wgid % nig) / gsz; return true;
    }
};

__device__ __forceinline__ unsigned cvt_pk_bf16(float lo, float hi) { unsigned r; asm volatile("v_cvt_pk_bf16_f32 %0, %1, %2" : "=v"(r) : "v"(lo), "v"(hi)); return r; }
typedef float f32x2 __attribute__((ext_vector_type(2)));
__device__ __forceinline__ f32x2 gelu_pk(f32x2 v) {
    const f32x2 av = __builtin_elementwise_abs(v), d = av * 0.2316418882f + 1.0f;
    f32x2 t; t.x = __builtin_amdgcn_rcpf(d.x); t.y = __builtin_amdgcn_rcpf(d.y);
    f32x2 q = t * 0.5307027145f + (-0.7265760135f); q = q * t + 0.7107068705f; q = q * t + (-0.142248368f); q = q * t + 0.127414796f; q = q * t;
    const f32x2 s = (v * v) * (-0.72134752044f);
    f32x2 e; e.x = __builtin_amdgcn_exp2f(s.x); e.y = __builtin_amdgcn_exp2f(s.y);
    const f32x2 m = v * (q * e), r = v - m;
    f32x2 o; o.x = v.x < 0.f ? m.x : r.x; o.y = v.y < 0.f ? m.y : r.y; return o;
}

template <int ACT  > struct EpiBf16 {
    static constexpr bool PERM = true, AFTER_DRAIN = false, KSCALE = false; static_assert(ACT == 0 || ACT == 1, "EpiBf16: ACT is 0 (none) or 1 (gelu_pk)");
    bf16_t* O; int ldc; const float* bias; int split_cols; size_t split_stride; float scale0;
    __device__ __forceinline__ void operator()(const f32x4 (&acc)[2][2][4][2], const Unit& u, int wr, int wc, int fr, int fq) const {
        const int row0 = u.pm * BM + wr * 64 + fr; int colt = u.pn * BM; bf16_t* base = O;
        float sc = 1.f; if (split_cols) { const int t = colt / split_cols; base += (size_t)t * split_stride; colt -= t * split_cols; if (t == 0) sc = scale0; }
        const int col0 = colt + wc * 32 + 8 * fq, bcol0 = u.pn * BM + wc * 32 + 8 * fq;
        f32x4 bv[2][2];
#pragma unroll
        for (int bj = 0; bj < 2; ++bj)
#pragma unroll
            for (int n = 0; n < 2; ++n) bv[bj][n] = bias ? *(const f32x4*)(bias + bcol0 + bj * HALF + 4 * n) : (f32x4){0.f, 0.f, 0.f, 0.f};
#pragma unroll
        for (int ai = 0; ai < 2; ++ai)
#pragma unroll
            for (int m = 0; m < 4; ++m) { bf16_t* rowp = base + (size_t)(row0 + ai * HALF + m * 16) * ldc + col0;
#pragma unroll
                for (int bj = 0; bj < 2; ++bj) { f32x4 v0 = acc[ai][bj][m][0] + bv[bj][0], v1 = acc[ai][bj][m][1] + bv[bj][1];
                    if (ACT == 1) { f32x2 a = gelu_pk((f32x2){v0[0], v0[1]}), b = gelu_pk((f32x2){v0[2], v0[3]}), c = gelu_pk((f32x2){v1[0], v1[1]}), d = gelu_pk((f32x2){v1[2], v1[3]});
                        v0 = (f32x4){a.x, a.y, b.x, b.y}; v1 = (f32x4){c.x, c.y, d.x, d.y}; }
                    v0 = v0 * sc; v1 = v1 * sc; u32x4 w; w.x = cvt_pk_bf16(v0[0], v0[1]); w.y = cvt_pk_bf16(v0[2], v0[3]); w.z = cvt_pk_bf16(v1[0], v1[1]); w.w = cvt_pk_bf16(v1[2], v1[3]);
                    *(u32x4*)(rowp + bj * HALF) = w; } }
    }
};
struct EpiResid {
    static constexpr bool PERM = false, AFTER_DRAIN = false, KSCALE = false;
    const float* resid; float* out; const float* gate; int ldc, rows_per_batch, gate_stride;
    __device__ __forceinline__ void operator()(const f32x4 (&acc)[2][2][4][2], const Unit& u, int wr, int wc, int fr, int fq) const {
        const int col0 = u.pn * BM + wc * 32 + 4 * fq;
        const int b = (u.pm * BM) / rows_per_batch;
        f32x4 gv[2][2];
#pragma unroll
        for (int bj = 0; bj < 2; ++bj)
#pragma unroll
            for (int n = 0; n < 2; ++n) gv[bj][n] = *(const f32x4*)(gate + (size_t)b * gate_stride + col0 + bj * HALF + n * 16);
#pragma unroll
        for (int ai = 0; ai < 2; ++ai)
#pragma unroll
            for (int m = 0; m < 4; ++m) {
                const size_t off = (size_t)(u.pm * BM + ai * HALF + wr * 64 + m * 16 + fr) * ldc + col0;
#pragma unroll
                for (int bj = 0; bj < 2; ++bj)
#pragma unroll
                    for (int n = 0; n < 2; ++n) {
                        const f32x4 bs = *(const f32x4*)(resid + off + bj * HALF + n * 16);
                        *(f32x4*)(out + off + bj * HALF + n * 16) = bs + gv[bj][n] * acc[ai][bj][m][n];
                    }
                if (m & 1) asm volatile("" ::: "memory");
            }
    }
};

struct EpiX1 {
    static constexpr bool PERM = true, AFTER_DRAIN = false, KSCALE = true;
    static constexpr int KS1 = 16, KS2 = 24;
    const float* resid; const float* mod; bf16_t* xm; float* psq; int ldc, rows_per_batch; const PG8_LAS float* kt; int pm0;
    __device__ __forceinline__ void kscale(f32x4 (&acc)[2][2][4][2], const Unit& u, int t, int wr, int fr) const {
        const PG8_LAS float* tab = kt + ((u.pm == pm0) ? 0 : 1024) + ((t == KS1) ? 0 : 1);
#pragma unroll
        for (int ai = 0; ai < 2; ++ai)
#pragma unroll
            for (int m = 0; m < 4; ++m) { const float f = tab[(ai * HALF + wr * 64 + m * 16 + fr) * 4];
#pragma unroll
                for (int bj = 0; bj < 2; ++bj) { acc[ai][bj][m][0] *= f; acc[ai][bj][m][1] *= f; } }
    }
    __device__ __forceinline__ void operator()(const f32x4 (&acc)[2][2][4][2], const Unit& u, int wr, int wc, int fr, int fq) const {
        const int b = (u.pm * BM) / rows_per_batch;
        const float* g1 = mod + (size_t)b * 6 * ldc + 2 * ldc; const float* s2 = mod + (size_t)b * 6 * ldc + 4 * ldc;
        const int col0 = u.pn * BM + wc * 32 + 8 * fq;
        const PG8_LAS float* tab = kt + ((u.pm == pm0) ? 0 : 1024) + 2;
        f32x4 gv[2][2], sv[2][2];
#pragma unroll
        for (int bj = 0; bj < 2; ++bj)
#pragma unroll
            for (int n = 0; n < 2; ++n) { gv[bj][n] = *(const f32x4*)(g1 + col0 + bj * HALF + 4 * n); sv[bj][n] = *(const f32x4*)(s2 + col0 + bj * HALF + 4 * n) + 1.0f; }
#pragma unroll
        for (int ai = 0; ai < 2; ++ai)
#pragma unroll
            for (int m = 0; m < 4; ++m) {
                const int lr = ai * HALF + wr * 64 + m * 16 + fr, row = u.pm * BM + lr; const size_t off = (size_t)row * ldc + col0;
                const float rf = tab[lr * 4];
                float ss = 0.f;
#pragma unroll
                for (int bj = 0; bj < 2; ++bj) {
                    const f32x4 r0 = *(const f32x4*)(resid + off + bj * HALF), r1 = *(const f32x4*)(resid + off + bj * HALF + 4);
                    const f32x4 x0 = r0 + gv[bj][0] * (acc[ai][bj][m][0] * rf), x1 = r1 + gv[bj][1] * (acc[ai][bj][m][1] * rf);
                    ss += (x0[0] * x0[0] + x0[1] * x0[1]) + (x0[2] * x0[2] + x0[3] * x0[3]) + (x1[0] * x1[0] + x1[1] * x1[1]) + (x1[2] * x1[2] + x1[3] * x1[3]);
                    const f32x4 y0 = x0 * sv[bj][0], y1 = x1 * sv[bj][1];
                    u32x4 w; w.x = cvt_pk_bf16(y0[0], y0[1]); w.y = cvt_pk_bf16(y0[2], y0[3]); w.z = cvt_pk_bf16(y1[0], y1[1]); w.w = cvt_pk_bf16(y1[2], y1[3]);
                    *(u32x4*)(xm + off + bj * HALF) = w;
                }
                ss += __shfl_xor(ss, 16); ss += __shfl_xor(ss, 32);
                if (fq == 0) psq[(size_t)row * 32 + u.pn * 4 + wc] = ss;
                if (m & 1) asm volatile("" ::: "memory");
            }
    }
};
struct EpiScaleBias {
    static constexpr bool PERM = true, AFTER_DRAIN = false, KSCALE = false;
    bf16_t* O; int ldc; const float* bias; int rows_per_batch; const PG8_LAS float* rt; int pm0;
    __device__ __forceinline__ void operator()(const f32x4 (&acc)[2][2][4][2], const Unit& u, int wr, int wc, int fr, int fq) const {
        const int b = (u.pm * BM) / rows_per_batch; const float* bp = bias + (size_t)b * ldc;
        const int col0 = u.pn * BM + wc * 32 + 8 * fq;
        const PG8_LAS float* rtu = rt + ((u.pm == pm0) ? 0 : 256);
        f32x4 bv[2][2];
#pragma unroll
        for (int bj = 0; bj < 2; ++bj)
#pragma unroll
            for (int n = 0; n < 2; ++n) bv[bj][n] = *(const f32x4*)(bp + col0 + bj * HALF + 4 * n);
#pragma unroll
        for (int ai = 0; ai < 2; ++ai)
#pragma unroll
            for (int m = 0; m < 4; ++m) {
                const int lr = ai * HALF + wr * 64 + m * 16 + fr; const float rs = rtu[lr];
                bf16_t* rowp = O + (size_t)(u.pm * BM + lr) * ldc + col0;
#pragma unroll
                for (int bj = 0; bj < 2; ++bj) {
                    const f32x4 v0 = acc[ai][bj][m][0] * rs + bv[bj][0], v1 = acc[ai][bj][m][1] * rs + bv[bj][1];
                    u32x4 w; w.x = cvt_pk_bf16(v0[0], v0[1]); w.y = cvt_pk_bf16(v0[2], v0[3]); w.z = cvt_pk_bf16(v1[0], v1[1]); w.w = cvt_pk_bf16(v1[2], v1[3]);
                    *(u32x4*)(rowp + bj * HALF) = w;
                }
            }
    }
};
template <class Epi, class Sched, bool ALIGN_EPI = false, bool SP2 = false>
__device__ __forceinline__ void gemm_phase(PG8_LAS unsigned char* lds, const Gemm g, const Sched& S, const Epi& E) {
    const int tid = threadIdx.x, wid = __builtin_amdgcn_readfirstlane(tid >> 6), lane = tid & 63, wr = wid >> 2, wc = wid & 3, fr = lane & 15, fq = lane >> 4;
    const int K = g.K, nt = K / BK;
    unsigned voffA[2], voffB[2];
#pragma unroll
    for (int i = 0; i < 2; ++i) { int R, C; stage_rc(tid * 16 + i * 8192, R, C); const int Rb = Epi::PERM ? ((R & ~31) + perm32(R & 31)) : R;
        voffA[i] = (unsigned)(R * g.lda + C) * 2u; voffB[i] = (unsigned)(Rb * K + C) * 2u; }
    const size_t kstep = (size_t)(BK * 2);
    const size_t hstep = (size_t)HALF * K * 2;
    const size_t tstep = 2 * hstep; const size_t hstepA = (size_t)HALF * g.lda * 2, tstepA = 2 * hstepA;
    const unsigned ldsw = (unsigned)wid * 1024u;
    const int aoff = lds_byte(wr * 64 + fr, fq * 8), boff = lds_byte(wc * 32 + fr, fq * 8);
#define PG8_SA(b, h) (((b) * 2 + (h)) * HTB)
#define PG8_SB(b, h) ((4 + (b) * 2 + (h)) * HTB)
#define PG8_STAGE(bufoff, gbase, voff) do { _Pragma("unroll") for (int _i = 0; _i < 2; ++_i) \
        __builtin_amdgcn_global_load_lds((const unsigned*)((const char*)(gbase) + (voff)[_i]), (PG8_LAS unsigned*)(lds + (bufoff) + ldsw + _i * 8192), 16, 0, 0); } while (0)
#define PG8_LDA(dst, b, h) do { _Pragma("unroll") for (int m = 0; m < 4; ++m) _Pragma("unroll") for (int k = 0; k < 2; ++k) dst[m][k] = *(const PG8_LAS bf16x8*)(lds + PG8_SA(b, h) + aoff + m * 2048 + k * 1024); } while (0)
#define PG8_LDB(dst, b, h) do { _Pragma("unroll") for (int n = 0; n < 2; ++n) _Pragma("unroll") for (int k = 0; k < 2; ++k) dst[n][k] = *(const PG8_LAS bf16x8*)(lds + PG8_SB(b, h) + boff + n * 2048 + k * 1024); } while (0)
#define PG8_MMA(ai, bj, At, Bt) do { __builtin_amdgcn_s_setprio(1); _Pragma("unroll") for (int m = 0; m < 4; ++m) _Pragma("unroll") for (int n = 0; n < 2; ++n) _Pragma("unroll") for (int k = 0; k < 2; ++k) \
        acc[ai][bj][m][n] = __builtin_amdgcn_mfma_f32_16x16x32_bf16(Bt[n][k], At[m][k], acc[ai][bj][m][n], 0, 0, 0); __builtin_amdgcn_s_setprio(0); } while (0)
#define PG8_WAIT_V(n) asm volatile("s_waitcnt vmcnt(" #n ")" ::: "memory")
#define PG8_WAIT_L(n) asm volatile("s_waitcnt lgkmcnt(" #n ")" ::: "memory")
#define PG8_BAR __builtin_amdgcn_s_barrier()
#define PG8_SCHED __builtin_amdgcn_sched_barrier(0)
    Unit cur, nxt; int ui = 0;
    if (!S.next(0, cur)) return;
    f32x4 acc[2][2][4][2];
#pragma unroll
    for (int a = 0; a < 2; ++a)
#pragma unroll
        for (int b = 0; b < 2; ++b)
#pragma unroll
            for (int m = 0; m < 4; ++m)
#pragma unroll
                for (int n = 0; n < 2; ++n) acc[a][b][m][n] = (f32x4){0.f, 0.f, 0.f, 0.f};
    bf16x8 At[4][2], B0[2][2], B1[2][2];
    const char* cA = (const char*)g.A + (size_t)cur.pm * tstepA; const char* cB = (const char*)g.Bt + (size_t)cur.pn * tstep;
    S.a_ready(cur);
    if constexpr (SP2) {
        PG8_STAGE(PG8_SB(0, 0), cB, voffB); PG8_STAGE(PG8_SB(0, 1), cB + hstep, voffB); PG8_STAGE(PG8_SA(0, 0), cA, voffA); PG8_STAGE(PG8_SA(0, 1), cA + hstepA, voffA);
        if (wr == 1) PG8_BAR;
        PG8_WAIT_V(2); PG8_BAR;
        PG8_STAGE(PG8_SB(1, 0), cB + kstep, voffB); PG8_STAGE(PG8_SA(1, 0), cA + kstep, voffA); PG8_STAGE(PG8_SB(1, 1), cB + hstep + kstep, voffB);
        PG8_WAIT_V(6); PG8_BAR;
    } else {
        PG8_STAGE(PG8_SB(0, 0), cB, voffB); PG8_STAGE(PG8_SA(0, 0), cA, voffA); PG8_STAGE(PG8_SB(0, 1), cB + hstep, voffB); PG8_STAGE(PG8_SA(0, 1), cA + hstepA, voffA);
        if (wr == 1) PG8_BAR;
        PG8_WAIT_V(4); PG8_BAR;
        PG8_STAGE(PG8_SB(1, 0), cB + kstep, voffB); PG8_STAGE(PG8_SA(1, 0), cA + kstep, voffA); PG8_STAGE(PG8_SB(1, 1), cB + hstep + kstep, voffB);
        PG8_WAIT_V(6); PG8_BAR;
    }
    for (;;) {
        const bool has_next = S.next(ui + 1, nxt);
        const char* nA = has_next ? (const char*)g.A + (size_t)nxt.pm * tstepA : cA; const char* nB = has_next ? (const char*)g.Bt + (size_t)nxt.pn * tstep : cB;
        for (int t = 0; t < nt; t += 2) {
            const bool last = (t == nt - 2);
            const char* a1 = cA + (size_t)(t + 1) * kstep;
            const char* a2 = last ? nA : cA + (size_t)(t + 2) * kstep; const char* b2 = last ? nB : cB + (size_t)(t + 2) * kstep;
            const char* a3 = a2 + kstep; const char* b3 = b2 + kstep;
            if (last && has_next) S.a_ready(nxt);
            if constexpr (Epi::KSCALE) { if (t == Epi::KS1 || t == Epi::KS2) E.kscale(acc, cur, t, wr, fr); }
            if constexpr (SP2) {
            PG8_LDB(B0, 0, 0); PG8_LDB(B1, 0, 1); PG8_SCHED; PG8_LDA(At, 0, 0); PG8_STAGE(PG8_SA(1, 1), a1 + hstepA, voffA);
            PG8_WAIT_V(8); PG8_WAIT_L(0); PG8_BAR; PG8_MMA(0, 0, At, B0); PG8_MMA(0, 1, At, B1); PG8_BAR; PG8_SCHED;
            PG8_LDA(At, 0, 1); PG8_STAGE(PG8_SB(0, 0), b2, voffB); PG8_STAGE(PG8_SB(0, 1), b2 + hstep, voffB); PG8_STAGE(PG8_SA(0, 0), a2, voffA);
            PG8_WAIT_V(8); PG8_WAIT_L(0); PG8_BAR; PG8_MMA(1, 0, At, B0); PG8_MMA(1, 1, At, B1); PG8_BAR; PG8_SCHED;
            PG8_LDB(B0, 1, 0); PG8_LDB(B1, 1, 1); PG8_SCHED; PG8_LDA(At, 1, 0); PG8_STAGE(PG8_SA(0, 1), a2 + hstepA, voffA);
            PG8_WAIT_V(8); PG8_WAIT_L(0); PG8_BAR; PG8_MMA(0, 0, At, B0); PG8_MMA(0, 1, At, B1); PG8_BAR; PG8_SCHED;
            PG8_LDA(At, 1, 1); PG8_STAGE(PG8_SB(1, 0), b3, voffB); PG8_STAGE(PG8_SB(1, 1), b3 + hstep, voffB); PG8_STAGE(PG8_SA(1, 0), a3, voffA);
            PG8_WAIT_V(8); PG8_WAIT_L(0); PG8_BAR; PG8_MMA(1, 0, At, B0); PG8_MMA(1, 1, At, B1); PG8_BAR; PG8_SCHED;
            } else {
            PG8_LDB(B0, 0, 0); PG8_SCHED; PG8_LDA(At, 0, 0); PG8_STAGE(PG8_SA(1, 1), a1 + hstepA, voffA);
            PG8_WAIT_L(8); PG8_BAR; PG8_WAIT_L(0); PG8_MMA(0, 0, At, B0); PG8_BAR; PG8_SCHED;
            PG8_LDB(B1, 0, 1); PG8_STAGE(PG8_SB(0, 0), b2, voffB);
            PG8_BAR; PG8_WAIT_L(0); PG8_MMA(0, 1, At, B1); PG8_BAR;
            PG8_LDA(At, 0, 1); PG8_STAGE(PG8_SA(0, 0), a2, voffA);
            PG8_BAR; PG8_WAIT_L(0); PG8_MMA(1, 0, At, B0); PG8_BAR; PG8_SCHED;
            PG8_STAGE(PG8_SB(0, 1), b2 + hstep, voffB);
            PG8_WAIT_V(6); PG8_BAR; PG8_MMA(1, 1, At, B1); PG8_BAR;
            PG8_LDB(B0, 1, 0); PG8_SCHED; PG8_LDA(At, 1, 0); PG8_STAGE(PG8_SA(0, 1), a2 + hstepA, voffA);
            PG8_WAIT_L(8); PG8_BAR; PG8_WAIT_L(0); PG8_MMA(0, 0, At, B0); PG8_BAR; PG8_SCHED;
            PG8_LDB(B1, 1, 1); PG8_STAGE(PG8_SB(1, 0), b3, voffB);
            PG8_BAR; PG8_WAIT_L(0); PG8_MMA(0, 1, At, B1); PG8_BAR;
            PG8_LDA(At, 1, 1); PG8_STAGE(PG8_SA(1, 0), a3, voffA);
            PG8_BAR; PG8_WAIT_L(0); PG8_MMA(1, 0, At, B0); PG8_BAR; PG8_SCHED;
            PG8_STAGE(PG8_SB(1, 1), b3 + hstep, voffB);
            PG8_WAIT_V(6); PG8_BAR; PG8_MMA(1, 1, At, B1); PG8_BAR;
            }
        }
        if constexpr (ALIGN_EPI) { if (wr == 0) PG8_BAR; }
        if constexpr (!Epi::AFTER_DRAIN) { E(acc, cur, wr, wc, fr, fq); S.done(cur); }
        if (!has_next) break;
#pragma unroll
        for (int a = 0; a < 2; ++a)
#pragma unroll
            for (int b = 0; b < 2; ++b)
#pragma unroll
                for (int m = 0; m < 4; ++m)
#pragma unroll
                    for (int n = 0; n < 2; ++n) acc[a][b][m][n] = (f32x4){0.f, 0.f, 0.f, 0.f};
        cur = nxt; cA = nA; cB = nB; ++ui;
        if constexpr (ALIGN_EPI) { if (wr == 1) PG8_BAR; }
    }
    PG8_WAIT_V(0);
    if constexpr (!ALIGN_EPI) { if (wr == 0) PG8_BAR; }
    PG8_BAR;
    if constexpr (Epi::AFTER_DRAIN) { E.fused(acc, cur, wr, wc, fr, fq, lds, wid, lane); S.done(cur); }
#undef PG8_SA
#undef PG8_SB
#undef PG8_STAGE
#undef PG8_LDA
#undef PG8_LDB
#undef PG8_MMA
#undef PG8_WAIT_V
#undef PG8_WAIT_L
#undef PG8_BAR
#undef PG8_SCHED
}
}
#define LDS_WAIT() asm volatile("s_waitcnt lgkmcnt(0)" ::: "memory")
#define XB_TMO      128
#define XB_XCNT(j)  (256  + 64 * (j))
#define XB_XSUB(j)  (1280 + 64 * (j))
#define XB_XGEN(j)  (2304 + 64 * (j))
#define XB_TOP      3328
#define XB_TOPGEN   3392
#define XCD_BAR_WORDS 3456
#define XB_SPIN_CAP (1u << 18)

__device__ __forceinline__ unsigned xb_ld(unsigned* p)              { return __hip_atomic_load(p, __ATOMIC_RELAXED, __HIP_MEMORY_SCOPE_AGENT); }
__device__ __forceinline__ unsigned xb_add(unsigned* p, unsigned v) { return __hip_atomic_fetch_add(p, v, __ATOMIC_RELAXED, __HIP_MEMORY_SCOPE_AGENT); }
__device__ __forceinline__ unsigned xb_xcc_id() { return (unsigned)__builtin_amdgcn_s_getreg((3 << 11) | 20) & 0xFu; }
#define XB_SPIN(cond, bar) do { unsigned _sp = 0; while (cond) { __builtin_amdgcn_s_sleep(1); \
    if ((++_sp & 255u) == 0u) { if (xb_ld(&(bar)[XB_TMO])) break; if (_sp > XB_SPIN_CAP) { atomicAdd(&(bar)[XB_TMO], 1u); break; } } } } while (0)

struct XcdBarrier {
    unsigned* bar; unsigned x;
    volatile LAS unsigned* st;
};

__device__ __forceinline__ XcdBarrier xcd_barrier_post(unsigned* bar, volatile LAS unsigned* st) {
    XcdBarrier b; b.bar = bar; b.x = xb_xcc_id(); b.st = st;
    if (threadIdx.x == 0) (void)xb_add(&bar[XB_XCNT(b.x)], 1u);
    return b;
}
__device__ __forceinline__ void xcd_barrier_complete(unsigned* bar, unsigned x, unsigned& nloc, unsigned& nx) {
    const unsigned G = gridDim.x * gridDim.y * gridDim.z;
    unsigned sum, cnt, mine, sp = 0u;
    for (;;) {
        sum = 0u; cnt = 0u; mine = 0u;
#pragma unroll
        for (unsigned j = 0; j < 16; ++j) { const unsigned c = xb_ld(&bar[XB_XCNT(j)]); sum += c; cnt += (c > 0u) ? 1u : 0u; mine = (j == x) ? c : mine; }
        if (sum == G) break;
        __builtin_amdgcn_s_sleep(1);
        if ((++sp & 255u) == 0u) { if (xb_ld(&bar[XB_TMO])) break; if (sp > XB_SPIN_CAP) { atomicAdd(&bar[XB_TMO], 1u); break; } }
    }
    nloc = mine > 0u ? mine : 1u; nx = cnt > 0u ? cnt : 1u;
}

__device__ __forceinline__ void xcd_barrier(const XcdBarrier& b) {
    asm volatile("s_waitcnt vmcnt(0)" ::: "memory");
    __syncthreads();
    if (threadIdx.x == 0) {
        unsigned* bar = b.bar;
        __builtin_amdgcn_s_waitcnt(0);
        unsigned nloc = b.st[0], nx = b.st[1];
        if (nloc == 0u) { xcd_barrier_complete(bar, b.x, nloc, nx); b.st[0] = nloc; b.st[1] = nx; }
        const unsigned old = xb_add(&bar[XB_XSUB(b.x)], 1u);
        const unsigned gen = old / nloc;
        if (old + 1u == (gen + 1u) * nloc) {
            __builtin_amdgcn_fence(__ATOMIC_RELEASE, "agent");
            asm volatile("s_waitcnt vmcnt(0)" ::: "memory");
            const unsigned og = xb_add(&bar[XB_TOP], 1u);
            const unsigned tg = og / nx;
            if (og + 1u == (tg + 1u) * nx) xb_add(&bar[XB_TOPGEN], 1u);
            else XB_SPIN(xb_ld(&bar[XB_TOPGEN]) == tg, bar);
            __builtin_amdgcn_fence(__ATOMIC_ACQUIRE, "agent");
            xb_add(&bar[XB_XGEN(b.x)], 1u);
            asm volatile("s_waitcnt vmcnt(0)" ::: "memory");
        } else {
            XB_SPIN(xb_ld(&bar[XB_XGEN(b.x)]) == gen, bar);
            __builtin_amdgcn_fence(__ATOMIC_ACQUIRE, "agent");
            asm volatile("s_waitcnt vmcnt(0)" ::: "memory");
        }
    }
    __syncthreads();
}
#define SYNC() __syncthreads()
__device__ __forceinline__ float silu_fast(float v) { return v * __builtin_amdgcn_rcpf(1.f + __expf(-v)); }
__device__ __forceinline__ float sq2(unsigned w) { const float a = bflo(w), b = bfhi(w); return a * a + b * b; }

__device__ __forceinline__ void ph_mod(const Params& p, unsigned char* lds, int tid, int vb) {
    float* cact = (float*)lds; float* red = (float*)(lds + 65536);
    const int lane = tid & 63, wv = tid >> 6, c4 = lane & 31, kh = lane >> 5;
    for (int i = tid; i < NB * DM; i += NTHR) { const int b = i / DM, k = i % DM; cact[k * NB + b] = silu_f(p.c[i]); }
    SYNC();
    const int n = vb * 128 + 4 * c4;
    f32x4 acc[NB];
#pragma unroll
    for (int b = 0; b < NB; ++b) acc[b] = (f32x4){0.f, 0.f, 0.f, 0.f};
    const float* w = p.w_ada + (size_t)(wv * 256 + kh) * (6 * DM) + n;
#pragma unroll 8
    for (int i = 0; i < 128; ++i) {
        const f32x4 wk = *(const f32x4*)(w + (size_t)(2 * i) * (6 * DM));
        const f32x4 ca = *(const f32x4*)(cact + (wv * 256 + 2 * i + kh) * NB), cb = *(const f32x4*)(cact + (wv * 256 + 2 * i + kh) * NB + 4);
        acc[0] += wk * ca.x; acc[1] += wk * ca.y; acc[2] += wk * ca.z; acc[3] += wk * ca.w; acc[4] += wk * cb.x; acc[5] += wk * cb.y; acc[6] += wk * cb.z; acc[7] += wk * cb.w;
    }
#pragma unroll
    for (int b = 0; b < NB; ++b) { acc[b].x += __shfl_xor(acc[b].x, 32); acc[b].y += __shfl_xor(acc[b].y, 32); acc[b].z += __shfl_xor(acc[b].z, 32); acc[b].w += __shfl_xor(acc[b].w, 32); }
    if (lane < 32) {
#pragma unroll
        for (int b = 0; b < NB; ++b) *(f32x4*)(red + (wv * NB + b) * 128 + 4 * c4) = acc[b];
    }
    SYNC();
    for (int o = tid; o < NB * 128; o += NTHR) {
        const int b = o >> 7, col = o & 127;
        float s = p.b_ada[vb * 128 + col];
#pragma unroll
        for (int w8 = 0; w8 < 8; ++w8) s += red[(w8 * NB + b) * 128 + col];
        ((float*)(p.ws + WS_MOD))[b * 6 * DM + vb * 128 + col] = s;
    }
    SYNC();
}
__device__ __forceinline__ void ph_rope_tab(const Params& p, int gtid, int gn) {
    for (int i = gtid; i < T * 32; i += gn) {
        const int t = i >> 5, f = i & 31;
        const float inv = 1.0f / powf(10000.0f, (float)f * (2.0f / 64.0f));
        const float ang = (float)p.pos[t] * inv;
        ((float*)(p.ws + WS_ROPEC))[i] = (float)cos((double)ang);
        ((float*)(p.ws + WS_ROPES))[i] = (float)sin((double)ang);
    }
}
__device__ __forceinline__ void tr_item(const float* W, int K, int N, int Npad, bf16_t* WT, const float* g0, const float* g1, int gs, float* scr, int item, int lane) {
    const int nblk = Npad / 128, kb = item / nblk, nb = item % nblk, k0 = 32 * kb, n0 = 128 * nb;
    const int c4 = lane & 31, kh = lane >> 5, n = n0 + 4 * c4; const bool ok = n < N;
#pragma unroll 8
    for (int i = 0; i < 16; ++i) {
        const int kk = 2 * i + kh, k = k0 + kk;
        f32x4 v = ok ? *(const f32x4*)(W + (size_t)k * N + n) : (f32x4){0.f, 0.f, 0.f, 0.f};
        if (g0) v = v * ((k < gs) ? g0[k] : g1[k - gs]);
        *(f32x4*)(scr + kk * 132 + 4 * c4) = v;
    }
    asm volatile("s_waitcnt lgkmcnt(0)" ::: "memory");
#pragma unroll
    for (int j = 0; j < 8; ++j) {
        const int idx = lane + 64 * j, nn = idx >> 2, ck = idx & 3; const float* sp = scr + (8 * ck) * 132 + nn;
        u32x4 o; o.x = pk2(sp[0 * 132], sp[1 * 132]); o.y = pk2(sp[2 * 132], sp[3 * 132]); o.z = pk2(sp[4 * 132], sp[5 * 132]); o.w = pk2(sp[6 * 132], sp[7 * 132]);
        *(u32x4*)(WT + (size_t)(n0 + nn) * K + k0 + 8 * ck) = o;
    }
    asm volatile("s_waitcnt lgkmcnt(0)" ::: "memory");
}
constexpr int TR_N0 = (DM / 32) * (NPROJ / 128), TR_N1 = (512 / 32) * (NQ / 128), TR_N2 = (256 / 32) * (NKV / 128), TR_N3 = (DM / 32) * (DM / 128), TR_N4 = TR_N3;
constexpr int TR_TOTAL = TR_N0 + TR_N1 + TR_N2 + TR_N3 + TR_N4;
__device__ __forceinline__ void ph_transposes(const Params& p, unsigned char* lds, int wave, int lane, int first, int stride) {
    float* scr = (float*)(lds + wave * 17408);
    for (int it = first; it < TR_TOTAL; it += stride) {
        int r = it;
        if (r < TR_N0) { tr_item(p.w_in, DM, IN_COLS, NPROJ, (bf16_t*)(p.ws + WS_WINT), nullptr, nullptr, 0, scr, r, lane); continue; } r -= TR_N0;
        if (r < TR_N1) { tr_item(p.w_uq, 512, NQ, NQ, (bf16_t*)(p.ws + WS_WUQT), p.q_a_norm, p.q_a_norm, 512, scr, r, lane); continue; } r -= TR_N1;
        if (r < TR_N2) { tr_item(p.w_ukv, 256, NKV, NKV, (bf16_t*)(p.ws + WS_WUKVT), p.kv_a_norm, p.kv_a_norm, 256, scr, r, lane); continue; } r -= TR_N2;
        if (r < TR_N3) { tr_item(p.w_out, DM, DM, DM, (bf16_t*)(p.ws + WS_WOUTT), p.attn_out_norm, p.ssd_norm, 1024, scr, r, lane); continue; } r -= TR_N3;
        tr_item(p.w_query, DM, DM, DM, (bf16_t*)(p.ws + WS_WQT), nullptr, nullptr, 0, scr, r, lane);
    }
}
__device__ __forceinline__ void ph_convert(const float* src, bf16_t* dst, size_t n4, int gtid, int gn) {
    for (size_t i = gtid; i < n4; i += (size_t)gn) {
        const f32x4 v = ((const f32x4*)src)[i];
        uint2 o; o.x = pk2(v.x, v.y); o.y = pk2(v.z, v.w);
        ((uint2*)dst)[i] = o;
    }
}
__device__ __forceinline__ void ph_modrows(const float* in, bf16_t* outp, const float* mod, int sh_idx, int sc_idx, int gwave, int gnw, int lane) {
    for (int row = gwave; row < T; row += gnw) {
        const int b = row / SEQ;
        const f32x4* xr = (const f32x4*)(in + (size_t)row * DM) + lane;
        f32x4 v[8]; float s = 0.f;
#pragma unroll
        for (int j = 0; j < 8; ++j) { v[j] = xr[64 * j]; s += (v[j].x * v[j].x + v[j].y * v[j].y) + (v[j].z * v[j].z + v[j].w * v[j].w); }
        const float r = rsqrtf(wave_sum(s) * (1.f / DM) + EPS);
        const f32x4* sh = (const f32x4*)(mod + (size_t)b * 6 * DM + sh_idx * DM) + lane;
        const f32x4* sc = (const f32x4*)(mod + (size_t)b * 6 * DM + sc_idx * DM) + lane;
        uint2* o = (uint2*)(outp + (size_t)row * DM) + lane;
#pragma unroll
        for (int j = 0; j < 8; ++j) {
            const f32x4 a = sh[64 * j], m = sc[64 * j];
            uint2 w; w.x = pk2(v[j].x * r * (1.f + m.x) + a.x, v[j].y * r * (1.f + m.y) + a.y); w.y = pk2(v[j].z * r * (1.f + m.z) + a.z, v[j].w * r * (1.f + m.w) + a.w);
            o[64 * j] = w;
        }
    }
}
__device__ __forceinline__ void ph_bias2(const Params& p, int gwave, int gnw, int lane) {
    const float* mod = (const float*)(p.ws + WS_MOD);
    for (int n = gwave; n < DM; n += gnw) {
        const bf16_t* wr_ = (const bf16_t*)(p.ws + WS_WQT) + (size_t)n * DM + lane * 8;
        float wv[4][8];
#pragma unroll
        for (int j = 0; j < 4; ++j) { const u32x4 w = *(const u32x4*)(wr_ + j * 512);
            wv[j][0] = bflo(w.x); wv[j][1] = bfhi(w.x); wv[j][2] = bflo(w.y); wv[j][3] = bfhi(w.y); wv[j][4] = bflo(w.z); wv[j][5] = bfhi(w.z); wv[j][6] = bflo(w.w); wv[j][7] = bfhi(w.w); }
#pragma unroll
        for (int b = 0; b < NB; ++b) {
            const float* sh = mod + (size_t)b * 6 * DM + 3 * DM + lane * 8; float a = 0.f;
#pragma unroll
            for (int j = 0; j < 4; ++j) { const f32x4 s0 = *(const f32x4*)(sh + j * 512), s1 = *(const f32x4*)(sh + j * 512 + 4);
                a += (wv[j][0] * s0[0] + wv[j][1] * s0[1]) + (wv[j][2] * s0[2] + wv[j][3] * s0[3]) + (wv[j][4] * s1[0] + wv[j][5] * s1[1]) + (wv[j][6] * s1[2] + wv[j][7] * s1[3]); }
            a = wave_sum(a);
            if (lane == 0) ((float*)(p.ws + WS_BIAS2))[b * DM + n] = a;
        }
    }
}
constexpr float QSCALE = 0.07216878364870322f * 1.4426950408889634f;
__device__ __forceinline__ float ssq8(u32x4 w) { return (sq2(w.x) + sq2(w.y)) + (sq2(w.z) + sq2(w.w)); }
__device__ __forceinline__ u32x4 scale8(u32x4 w, float s, const float (&g)[8]) {
    u32x4 o; o.x = pk2(bflo(w.x) * s * g[0], bfhi(w.x) * s * g[1]); o.y = pk2(bflo(w.y) * s * g[2], bfhi(w.y) * s * g[3]);
    o.z = pk2(bflo(w.z) * s * g[4], bfhi(w.z) * s * g[5]); o.w = pk2(bflo(w.w) * s * g[6], bfhi(w.w) * s * g[7]); return o;
}
__device__ __forceinline__ u32x4 rope8(u32x4 w, u32x4 pw, float s, const float (&go)[8], const float (&gp)[8], f32x4 c0, f32x4 c1, f32x4 s0, f32x4 s1, float sgn) {
    const float a[8] = {bflo(w.x) * s * go[0], bfhi(w.x) * s * go[1], bflo(w.y) * s * go[2], bfhi(w.y) * s * go[3], bflo(w.z) * s * go[4], bfhi(w.z) * s * go[5], bflo(w.w) * s * go[6], bfhi(w.w) * s * go[7]};
    const float b[8] = {bflo(pw.x) * s * gp[0], bfhi(pw.x) * s * gp[1], bflo(pw.y) * s * gp[2], bfhi(pw.y) * s * gp[3], bflo(pw.z) * s * gp[4], bfhi(pw.z) * s * gp[5], bflo(pw.w) * s * gp[6], bfhi(pw.w) * s * gp[7]};
    u32x4 o;
    o.x = pk2(a[0] * c0.x + sgn * b[0] * s0.x, a[1] * c0.y + sgn * b[1] * s0.y); o.y = pk2(a[2] * c0.z + sgn * b[2] * s0.z, a[3] * c0.w + sgn * b[3] * s0.w);
    o.z = pk2(a[4] * c1.x + sgn * b[4] * s1.x, a[5] * c1.y + sgn * b[5] * s1.y); o.w = pk2(a[6] * c1.z + sgn * b[6] * s1.z, a[7] * c1.w + sgn * b[7] * s1.w);
    return o;
}
__device__ __forceinline__ u32x4 shfl_xor4(u32x4 w, int m) { u32x4 o; o.x = __shfl_xor(w.x, m); o.y = __shfl_xor(w.y, m); o.z = __shfl_xor(w.z, m); o.w = __shfl_xor(w.w, m); return o; }
__device__ __forceinline__ void ph_qkv_post(const Params& p, int gwave, int gnw, int lane) {
    unsigned char* ws = p.ws;
    const int g16 = lane >> 4, pos = lane & 15, hr = lane >> 3, rpos = lane & 7, f0 = (rpos & 3) * 8;
    const float sgn = (rpos < 4) ? -1.f : 1.f;
    float gqn[8], gqr[8], gqp[8], gkn[8], gkr[8], gkp[8];
#pragma unroll
    for (int i = 0; i < 8; ++i) { gqn[i] = p.q_norm[pos * 8 + i]; gqr[i] = p.q_norm[128 + rpos * 8 + i]; gqp[i] = p.q_norm[128 + (rpos ^ 4) * 8 + i];
                                  gkn[i] = p.k_norm[pos * 8 + i]; gkr[i] = p.k_norm[128 + rpos * 8 + i]; gkp[i] = p.k_norm[128 + (rpos ^ 4) * 8 + i]; }
    for (int t = gwave; t < T; t += gnw) {
        const bf16_t* proj = (const bf16_t*)(ws + WS_PROJ) + (size_t)t * NPROJ;
        const bf16_t* qraw = (const bf16_t*)(ws + WS_QRAW) + (size_t)t * NQ;
        const bf16_t* kvraw = (const bf16_t*)(ws + WS_KVRAW) + (size_t)t * NKV;
        const u32x4 cq = *(const u32x4*)(proj + C_CQ + lane * 8);
        const u32x4 ck = *(const u32x4*)(proj + C_CKV + (lane & 31) * 8);
        const u32x4 kr = *(const u32x4*)(proj + C_KR + rpos * 8);
        const u32x4 qn0 = *(const u32x4*)(qraw + g16 * 192 + pos * 8), qn1 = *(const u32x4*)(qraw + (4 + g16) * 192 + pos * 8), qr = *(const u32x4*)(qraw + hr * 192 + 128 + rpos * 8);
        const u32x4 kn0 = *(const u32x4*)(kvraw + g16 * 256 + pos * 8), kn1 = *(const u32x4*)(kvraw + (4 + g16) * 256 + pos * 8);
        const u32x4 v0 = *(const u32x4*)(kvraw + g16 * 256 + 128 + pos * 8), v1 = *(const u32x4*)(kvraw + (4 + g16) * 256 + 128 + pos * 8);
        const float* rcp = (const float*)(ws + WS_ROPEC) + (size_t)t * 32 + f0; const float* rsp = (const float*)(ws + WS_ROPES) + (size_t)t * 32 + f0;
        const f32x4 c0 = *(const f32x4*)rcp, c1 = *(const f32x4*)(rcp + 4), s0 = *(const f32x4*)rsp, s1 = *(const f32x4*)(rsp + 4);
        const float rcq = rsqrtf(wave_sum(ssq8(cq)) * (1.f / 512.f) + EPS);
        const float rckv = rsqrtf(wave_sum(lane < 32 ? ssq8(ck) : 0.f) * (1.f / 256.f) + EPS);
        float skr = ssq8(kr), nq0 = ssq8(qn0), nq1 = ssq8(qn1), rqs = ssq8(qr), nk0 = ssq8(kn0), nk1 = ssq8(kn1);
#pragma unroll
        for (int o = 1; o < 8; o <<= 1) { skr += __shfl_xor(skr, o); rqs += __shfl_xor(rqs, o); nq0 += __shfl_xor(nq0, o); nq1 += __shfl_xor(nq1, o); nk0 += __shfl_xor(nk0, o); nk1 += __shfl_xor(nk1, o); }
        nq0 += __shfl_xor(nq0, 8); nq1 += __shfl_xor(nq1, 8); nk0 += __shfl_xor(nk0, 8); nk1 += __shfl_xor(nk1, 8);
        const float rc2 = rcq * rcq, rk2 = rckv * rckv;
        const float tq0 = nq0 + __shfl(rqs, 8 * g16), tq1 = nq1 + __shfl(rqs, 8 * (4 + g16));
        const float tqa = __shfl(nq0, 16 * (hr & 3)), tqb = __shfl(nq1, 16 * (hr & 3));
        const float tqr = rqs + ((hr < 4) ? tqa : tqb);
        const float sq0 = rsqrtf(tq0 * rc2 * (1.f / 192.f) + EPS) * rcq * QSCALE, sq1 = rsqrtf(tq1 * rc2 * (1.f / 192.f) + EPS) * rcq * QSCALE, sqr = rsqrtf(tqr * rc2 * (1.f / 192.f) + EPS) * rcq * QSCALE;
        const float rk0 = rsqrtf((nk0 * rk2 + skr) * (1.f / 192.f) + EPS), rk1 = rsqrtf((nk1 * rk2 + skr) * (1.f / 192.f) + EPS);
        const float rka = __shfl(rk0, 16 * (hr & 3)), rkb = __shfl(rk1, 16 * (hr & 3));
        const float rkr = (hr < 4) ? rka : rkb;
        const u32x4 pqr = shfl_xor4(qr, 4), pkr = shfl_xor4(kr, 4);
        const int b = t / SEQ, sidx = t % SEQ;
        bf16_t* Q0 = (bf16_t*)(ws + WS_Q) + ((size_t)(b * 8 + g16) * SEQ + sidx) * 192; bf16_t* Q1 = Q0 + (size_t)4 * SEQ * 192; bf16_t* Qr = (bf16_t*)(ws + WS_Q) + ((size_t)(b * 8 + hr) * SEQ + sidx) * 192;
        bf16_t* K0 = (bf16_t*)(ws + WS_K) + ((size_t)(b * 8 + g16) * SEQ + sidx) * 192; bf16_t* K1 = K0 + (size_t)4 * SEQ * 192; bf16_t* Kr = (bf16_t*)(ws + WS_K) + ((size_t)(b * 8 + hr) * SEQ + sidx) * 192;
        bf16_t* V0 = (bf16_t*)(ws + WS_V) + ((size_t)(b * 8 + g16) * SEQ + sidx) * 128; bf16_t* V1 = V0 + (size_t)4 * SEQ * 128;
        *(u32x4*)(Q0 + pos * 8) = scale8(qn0, sq0, gqn); *(u32x4*)(Q1 + pos * 8) = scale8(qn1, sq1, gqn);
        *(u32x4*)(Qr + 128 + rpos * 8) = rope8(qr, pqr, sqr, gqr, gqp, c0, c1, s0, s1, sgn);
        *(u32x4*)(K0 + pos * 8) = scale8(kn0, rckv * rk0, gkn); *(u32x4*)(K1 + pos * 8) = scale8(kn1, rckv * rk1, gkn);
        *(u32x4*)(Kr + 128 + rpos * 8) = rope8(kr, pkr, rkr, gkr, gkp, c0, c1, s0, s1, sgn);
        const float one[8] = {1.f, 1.f, 1.f, 1.f, 1.f, 1.f, 1.f, 1.f};
        *(u32x4*)(V0 + pos * 8) = scale8(v0, rckv, one); *(u32x4*)(V1 + pos * 8) = scale8(v1, rckv, one);
    }
}
__device__ __forceinline__ void ph_attn_naive(const Params& p, unsigned char* lds, int tid, int bid, int G) {
    const int lane = tid & 63, wv = tid >> 6;
    float* ps = (float*)lds + wv * SEQ;
    float* qs = (float*)(lds + 65536) + wv * 192;
    for (int it = 0; it < (T * 8) / (G * 8); ++it) {
        const int sb = (it & 1) ? (G - 1 - bid) : bid;
        const int gi = it * (G * 8) + sb * 8 + wv;
        const int bh = gi / SEQ, s = gi % SEQ, b = bh >> 3, h = bh & 7;
        const bf16_t* Q = (const bf16_t*)(p.ws + WS_Q) + (size_t)gi * 192;
        const bf16_t* K = (const bf16_t*)(p.ws + WS_K) + (size_t)bh * SEQ * 192;
        const bf16_t* V = (const bf16_t*)(p.ws + WS_KVRAW) + (size_t)(b * SEQ) * NKV + h * 256 + 128;
        for (int d = lane; d < 192; d += 64) qs[d] = bf2f(Q[d]);
        SYNC();
        float mx = -1e30f;
        for (int k0 = 0; k0 <= s; k0 += 64) {
            const int key = k0 + lane; float sc = -INFINITY;
            if (key <= s) {
                const u32x4* kp = (const u32x4*)(K + (size_t)key * 192); float a = 0.f;
                for (int c = 0; c < 24; ++c) { const u32x4 w = kp[c]; const float* q = &qs[c * 8];
                    a += bflo(w.x) * q[0] + bfhi(w.x) * q[1] + bflo(w.y) * q[2] + bfhi(w.y) * q[3] + bflo(w.z) * q[4] + bfhi(w.z) * q[5] + bflo(w.w) * q[6] + bfhi(w.w) * q[7]; }
                sc = a;
            }
            ps[key] = sc;
            mx = fmaxf(mx, sc);
        }
#pragma unroll
        for (int o = 1; o < 64; o <<= 1) mx = fmaxf(mx, __shfl_xor(mx, o));
        SYNC();
        float sum = 0.f;
        for (int key = lane; key <= s; key += 64) { const float e = exp2f(ps[key] - mx); ps[key] = e; sum += e; }
        sum = wave_sum(sum);
        SYNC();
        float o0 = 0.f, o1 = 0.f;
        for (int key = 0; key <= s; ++key) { const float pr = ps[key]; const unsigned w = *(const unsigned*)(V + (size_t)key * NKV + 2 * lane); o0 += pr * bflo(w); o1 += pr * bfhi(w); }
        const float inv = 1.f / sum; o0 *= inv; o1 *= inv;
        const int t = b * SEQ + s;
        *(unsigned*)((bf16_t*)(p.ws + WS_ATTN) + (size_t)t * 1024 + h * 128 + 2 * lane) = pk2(o0, o1);
        SYNC();
    }
}
__device__ __forceinline__ void ph_conv_naive(const Params& p, int gtid, int gn) {
    const bf16_t* proj = (const bf16_t*)(p.ws + WS_PROJ);
    for (int i = gtid; i < T * 1552; i += gn) {
        const int t = i / 1552, c = i % 1552, s = t % SEQ;
        if (c < 1536) {
            float a = p.conv_b[c];
            for (int k = 0; k < 4; ++k) { const int ss = s - 3 + k; if (ss >= 0) a += p.conv_w[k * 1536 + c] * bf2f(proj[(size_t)(t - 3 + k) * NPROJ + C_XBC + c]); }
            ((bf16_t*)(p.ws + WS_XBCA))[(size_t)t * 1536 + c] = (bf16_t)f2bf(silu_f(a));
        } else {
            const int hh = c - 1536; const float v = bf2f(proj[(size_t)t * NPROJ + C_DT + hh]) + p.dt_bias[hh];
            ((float*)(p.ws + WS_DT))[(size_t)t * 16 + hh] = (v > 20.f) ? v : log1pf(__expf(v));
        }
    }
}
__device__ __forceinline__ void ph_ssd_naive(const Params& p, int vb, int lt) {
    const int b = vb >> 4, h = vb & 15, g = h >> 3, pp = lt >> 2, nq = lt & 3;
    const bf16_t* xa = (const bf16_t*)(p.ws + WS_XBCA); const float* dtp = (const float*)(p.ws + WS_DT);
    const bf16_t* proj = (const bf16_t*)(p.ws + WS_PROJ);
    const float a = -__expf(p.a_log[h]), dsk = p.d_skip[h];
    float st[32];
#pragma unroll
    for (int n = 0; n < 32; ++n) st[n] = 0.f;
    for (int s = 0; s < SEQ; ++s) {
        const size_t t = (size_t)b * SEQ + s;
        const float dt = dtp[t * 16 + h], dA = __expf(dt * a);
        const float xv = bf2f(xa[t * 1536 + h * 64 + pp]);
        const bf16_t* Bp = xa + t * 1536 + 1024 + g * 128 + nq * 32; const bf16_t* Cp = xa + t * 1536 + 1280 + g * 128 + nq * 32;
        float y = 0.f; const float dx = dt * xv;
#pragma unroll
        for (int n = 0; n < 32; ++n) { st[n] = st[n] * dA + dx * bf2f(Bp[n]); y += bf2f(Cp[n]) * st[n]; }
        y += __shfl_xor(y, 1); y += __shfl_xor(y, 2);
        if (nq == 0) {
            const float z = bf2f(proj[t * NPROJ + C_Z + h * 64 + pp]);
            ((bf16_t*)(p.ws + WS_YSSD))[t * 1024 + h * 64 + pp] = (bf16_t)f2bf((y + dsk * xv) * silu_f(z));
        }
    }
}
__device__ __forceinline__ void ph_mixnorm(const Params& p, int gwave, int gnw, int lane) {
    for (int t = gwave; t < T; t += gnw) {
        const uint2* ain = (const uint2*)((const bf16_t*)(p.ws + WS_ATTN) + (size_t)t * 1024); const uint2* yin = (const uint2*)((const bf16_t*)(p.ws + WS_YSSD) + (size_t)t * 1024);
        uint2 a[4], y[4]; float sa = 0.f, s0 = 0.f, s1 = 0.f;
#pragma unroll
        for (int j = 0; j < 4; ++j) { a[j] = ain[lane + 64 * j]; y[j] = yin[lane + 64 * j]; sa += sq2(a[j].x) + sq2(a[j].y); const float q = sq2(y[j].x) + sq2(y[j].y); if (j < 2) s0 += q; else s1 += q; }
        const float ra = rsqrtf(wave_sum(sa) * (1.f / 1024.f) + EPS), r0 = rsqrtf(wave_sum(s0) * (1.f / 512.f) + EPS), r1 = rsqrtf(wave_sum(s1) * (1.f / 512.f) + EPS);
        uint2* o = (uint2*)((bf16_t*)(p.ws + WS_MIXIN) + (size_t)t * DM);
#pragma unroll
        for (int j = 0; j < 4; ++j) {
            uint2 r; r.x = pk2(bflo(a[j].x) * ra, bfhi(a[j].x) * ra); r.y = pk2(bflo(a[j].y) * ra, bfhi(a[j].y) * ra); o[lane + 64 * j] = r;
            const float rr = (j < 2) ? r0 : r1;
            uint2 q; q.x = pk2(bflo(y[j].x) * rr, bfhi(y[j].x) * rr); q.y = pk2(bflo(y[j].y) * rr, bfhi(y[j].y) * rr); o[256 + lane + 64 * j] = q;
        }
    }
}
__device__ __forceinline__ void ph_route_naive(const Params& p, unsigned char* lds, int tid, int bid, int G) {
    const int sub = tid >> 7, lt = tid & 127;
    float* base = (float*)(lds + sub * 4096);
    float* q = base; float* sc = base + 256; float* ts = base + 512; int* ti = (int*)(base + 544); float* cs = base + 576; float* bs = base + 832; int* bi = (int*)(base + 848);
    const bf16_t* sk = (const bf16_t*)(p.ws + WS_SUBK);
    for (int it = 0; it < (T * 8) / (G * 4); ++it) {
        const int vb = it * (G * 4) + bid * 4 + sub, t = vb >> 3, h = vb & 7;
        const bf16_t* qp = (const bf16_t*)(p.ws + WS_QP) + (size_t)t * DM + h * 256;
        q[lt] = bf2f(qp[lt]); q[128 + lt] = bf2f(qp[128 + lt]);
        SYNC();
#pragma unroll
        for (int j = 0; j < 2; ++j) {
            const u32x4* kp = (const u32x4*)(sk + ((size_t)(h * 2 + j) * 128 + lt) * 128); float a = 0.f;
            for (int c = 0; c < 16; ++c) { const u32x4 w = kp[c]; const float* qq = q + j * 128 + c * 8;
                a += bflo(w.x) * qq[0] + bfhi(w.x) * qq[1] + bflo(w.y) * qq[2] + bfhi(w.y) * qq[3] + bflo(w.z) * qq[4] + bfhi(w.z) * qq[5] + bflo(w.w) * qq[6] + bfhi(w.w) * qq[7]; }
            sc[j * 128 + lt] = a;
        }
        SYNC();
#pragma unroll
        for (int j = 0; j < 2; ++j) {
            const float v = sc[j * 128 + lt]; int rank = 0;
            for (int k = 0; k < 128; ++k) { const float o = sc[j * 128 + k]; rank += (o > v || (o == v && k < lt)) ? 1 : 0; }
            if (rank < 16) { ts[j * 16 + rank] = v; ti[j * 16 + rank] = lt; }
        }
        SYNC();
        cs[lt] = ts[lt >> 4] + ts[16 + (lt & 15)]; cs[128 + lt] = ts[8 + (lt >> 4)] + ts[16 + (lt & 15)];
        SYNC();
#pragma unroll
        for (int r = 0; r < 2; ++r) {
            const int ci = lt + 128 * r; const float v = cs[ci]; int rank = 0;
            for (int k = 0; k < 256; ++k) { const float o = cs[k]; rank += (o > v || (o == v && k < ci)) ? 1 : 0; }
            if (rank < 16) { bs[rank] = v; bi[rank] = ti[ci >> 4] * 128 + ti[16 + (ci & 15)]; }
        }
        SYNC();
        if (lt < 16) {
            const float mx = bs[0]; float sum = 0.f;
            for (int k = 0; k < 16; ++k) sum += __expf(bs[k] - mx);
            ((float*)(p.ws + WS_GATE))[(size_t)t * 128 + h * 16 + lt] = __expf(bs[lt] - mx) / sum;
            ((int*)(p.ws + WS_IDX))[(size_t)t * 128 + h * 16 + lt] = bi[lt];
        }
        SYNC();
    }
}
__device__ __forceinline__ void ph_peer_naive(const Params& p, unsigned char* lds, int tid, int bid, int G) {
    const int half = tid >> 8, lt = tid & 255, lane = tid & 63, wv = lt >> 6;
    float* red = (float*)(lds + half * 64);
    const bf16_t* U = (const bf16_t*)(p.ws + WS_U16); const bf16_t* V = (const bf16_t*)(p.ws + WS_V16);
    for (int it = 0; it < T / (G * 2); ++it) {
        const int t = it * (G * 2) + bid * 2 + half, b = t / SEQ;
        const u32x4 hw = *(const u32x4*)((const bf16_t*)(p.ws + WS_H2) + (size_t)t * DM + lt * 8);
        const float h0 = bflo(hw.x), h1 = bfhi(hw.x), h2 = bflo(hw.y), h3 = bfhi(hw.y), h4 = bflo(hw.z), h5 = bfhi(hw.z), h6 = bflo(hw.w), h7 = bfhi(hw.w);
        float o0 = 0.f, o1 = 0.f, o2 = 0.f, o3 = 0.f, o4 = 0.f, o5 = 0.f, o6 = 0.f, o7 = 0.f;
        const int* idx = (const int*)(p.ws + WS_IDX) + (size_t)t * 128; const float* gate = (const float*)(p.ws + WS_GATE) + (size_t)t * 128;
        for (int e = 0; e < 128; ++e) {
            const int ex = idx[e];
            const u32x4 uw = *(const u32x4*)(U + (size_t)ex * DM + lt * 8);
            float d = bflo(uw.x) * h0 + bfhi(uw.x) * h1 + bflo(uw.y) * h2 + bfhi(uw.y) * h3 + bflo(uw.z) * h4 + bfhi(uw.z) * h5 + bflo(uw.w) * h6 + bfhi(uw.w) * h7;
            d = wave_sum(d);
            if (lane == 0) red[wv] = d;
            SYNC();
            const float pre = red[0] + red[1] + red[2] + red[3];
            const float a = 0.5f * pre * (1.f + erff(pre * 0.70710678118654752f)) * gate[e];
            SYNC();
            const u32x4 vw = *(const u32x4*)(V + (size_t)ex * DM + lt * 8);
            o0 += a * bflo(vw.x); o1 += a * bfhi(vw.x); o2 += a * bflo(vw.y); o3 += a * bfhi(vw.y); o4 += a * bflo(vw.z); o5 += a * bfhi(vw.z); o6 += a * bflo(vw.w); o7 += a * bfhi(vw.w);
        }
        const float* g2 = (const float*)(p.ws + WS_MOD) + (size_t)b * 6 * DM + 5 * DM + lt * 8;
        float* outp = p.out + (size_t)t * DM + lt * 8;
        const f32x4 x0 = *(const f32x4*)outp, x1 = *(const f32x4*)(outp + 4), ga = *(const f32x4*)g2, gb = *(const f32x4*)(g2 + 4);
        *(f32x4*)outp = (f32x4){x0.x + ga.x * o0, x0.y + ga.y * o1, x0.z + ga.z * o2, x0.w + ga.w * o3};
        *(f32x4*)(outp + 4) = (f32x4){x1.x + gb.x * o4, x1.y + gb.y * o5, x1.z + gb.z * o6, x1.w + gb.w * o7};
    }
}
typedef __bf16 bf16x2_t __attribute__((ext_vector_type(2)));
__device__ __forceinline__ float dot2bf(unsigned a, unsigned b, float c) { return __builtin_amdgcn_fdot2_f32_bf16(__builtin_bit_cast(bf16x2_t, a), __builtin_bit_cast(bf16x2_t, b), c, false); }
__device__ __forceinline__ void ph_peer(const Params& p, LAS unsigned char* ldsl, int wave, int lane, int gwave, int gnw) {
    LAS unsigned char* ring = ldsl + wave * 16384;
    const bf16_t* U = (const bf16_t*)(p.ws + WS_U16); const bf16_t* V = (const bf16_t*)(p.ws + WS_V16);
    const int e_lane = (lane >> 2) & 15; const unsigned lane16 = (unsigned)lane * 16u;
#define PEER_ISSUE(R) do { const int R_ = (R); const int i_ = ((R_ >> 5) << 4) + (R_ & 15); \
        const int e_ = (i_ < 64) ? __builtin_amdgcn_readlane(idx0, i_) : __builtin_amdgcn_readlane(idx1, i_ - 64); \
        const char* base_ = (const char*)(((R_ >> 4) & 1) ? V : U) + (size_t)(unsigned)e_ * (DM * 2); \
        const unsigned* src_ = (const unsigned*)(base_ + lane16); \
        LAS unsigned* dst_ = (LAS unsigned*)(ring + (R_ & 3) * 4096); \
        __builtin_amdgcn_global_load_lds(src_, dst_, 16, 0, 0); \
        __builtin_amdgcn_global_load_lds(src_, dst_, 16, 1024, 0); \
        __builtin_amdgcn_global_load_lds(src_, dst_, 16, 2048, 0); \
        __builtin_amdgcn_global_load_lds(src_, dst_, 16, 3072, 0); } while (0)
#define PEER_WAIT(n) asm volatile("s_waitcnt vmcnt(" #n ")" ::: "memory")
    for (int t = gwave; t < T; t += gnw) {
        const int b = t / SEQ;
        const int idx0 = ((const int*)(p.ws + WS_IDX))[(size_t)t * 128 + lane], idx1 = ((const int*)(p.ws + WS_IDX))[(size_t)t * 128 + 64 + lane];
        const float g0 = ((const float*)(p.ws + WS_GATE))[(size_t)t * 128 + lane], g1 = ((const float*)(p.ws + WS_GATE))[(size_t)t * 128 + 64 + lane];
        u32x4 hreg[4];
#pragma unroll
        for (int j = 0; j < 4; ++j) hreg[j] = *(const u32x4*)((const bf16_t*)(p.ws + WS_H2) + (size_t)t * DM + j * 512 + lane * 8);
        float out[4][8];
#pragma unroll
        for (int j = 0; j < 4; ++j)
#pragma unroll
            for (int i = 0; i < 8; ++i) out[j][i] = 0.f;
        PEER_ISSUE(0); PEER_ISSUE(1); PEER_ISSUE(2);
        for (int hh = 0; hh < 8; ++hh) {
            float pd[16];
#pragma unroll
            for (int k = 0; k < 16; ++k) {
                PEER_ISSUE(hh * 32 + k + 3); PEER_WAIT(12);
                const LAS unsigned char* sl = ring + (k & 3) * 4096 + lane * 16;
                float a = 0.f;
#pragma unroll
                for (int j = 0; j < 4; ++j) { const u32x4 w = *(const LAS u32x4*)(sl + j * 1024);
                    a = dot2bf(w.x, hreg[j].x, a); a = dot2bf(w.y, hreg[j].y, a); a = dot2bf(w.z, hreg[j].z, a); a = dot2bf(w.w, hreg[j].w, a); }
                asm volatile("" : "+v"(a));
                pd[k] = a;
            }
            float q8[8], q4[4], q2[2], q1;
            { const bool hi = (lane & 32) != 0;
#pragma unroll
              for (int i = 0; i < 8; ++i) { const float keep = hi ? pd[i + 8] : pd[i], send = hi ? pd[i] : pd[i + 8]; q8[i] = keep + __shfl_xor(send, 32); } }
            { const bool hi = (lane & 16) != 0;
#pragma unroll
              for (int i = 0; i < 4; ++i) { const float keep = hi ? q8[i + 4] : q8[i], send = hi ? q8[i] : q8[i + 4]; q4[i] = keep + __shfl_xor(send, 16); } }
            { const bool hi = (lane & 8) != 0;
#pragma unroll
              for (int i = 0; i < 2; ++i) { const float keep = hi ? q4[i + 2] : q4[i], send = hi ? q4[i] : q4[i + 2]; q2[i] = keep + __shfl_xor(send, 8); } }
            { const bool hi = (lane & 4) != 0; const float keep = hi ? q2[1] : q2[0], send = hi ? q2[0] : q2[1]; q1 = keep + __shfl_xor(send, 4); }
            q1 += __shfl_xor(q1, 1); q1 += __shfl_xor(q1, 2);
            const float gsel = (hh < 4) ? g0 : g1;
            const float gate = __shfl(gsel, (hh & 3) * 16 + e_lane);
            const float act = 0.5f * q1 * (1.f + erff(q1 * 0.70710678118654752f)) * gate;
#pragma unroll
            for (int k = 0; k < 16; ++k) {
                if (k < 13) { PEER_ISSUE(hh * 32 + 16 + k + 3); PEER_WAIT(12); }
                else if (hh < 7) { PEER_ISSUE(hh * 32 + 16 + k + 3); PEER_WAIT(12); }
                else if (k == 13) PEER_WAIT(8); else if (k == 14) PEER_WAIT(4); else PEER_WAIT(0);
                const float a = __builtin_bit_cast(float, __builtin_amdgcn_readlane(__builtin_bit_cast(int, act), 4 * k));
                const LAS unsigned char* sl = ring + (k & 3) * 4096 + lane * 16;
#pragma unroll
                for (int j = 0; j < 4; ++j) { const u32x4 w = *(const LAS u32x4*)(sl + j * 1024);
                    out[j][0] += a * bflo(w.x); out[j][1] += a * bfhi(w.x); out[j][2] += a * bflo(w.y); out[j][3] += a * bfhi(w.y);
                    out[j][4] += a * bflo(w.z); out[j][5] += a * bfhi(w.z); out[j][6] += a * bflo(w.w); out[j][7] += a * bfhi(w.w);
                    asm volatile("" : "+v"(out[j][0]), "+v"(out[j][1]), "+v"(out[j][2]), "+v"(out[j][3]), "+v"(out[j][4]), "+v"(out[j][5]), "+v"(out[j][6]), "+v"(out[j][7])); }
            }
        }
        const float* g2 = (const float*)(p.ws + WS_MOD) + (size_t)b * 6 * DM + 5 * DM;
        float* outp = p.out + (size_t)t * DM;
#pragma unroll
        for (int j = 0; j < 4; ++j) {
            const int c = j * 512 + lane * 8;
            const f32x4 x0 = *(const f32x4*)(outp + c), x1 = *(const f32x4*)(outp + c + 4), ga = *(const f32x4*)(g2 + c), gb = *(const f32x4*)(g2 + c + 4);
            *(f32x4*)(outp + c) = (f32x4){x0.x + ga.x * out[j][0], x0.y + ga.y * out[j][1], x0.z + ga.z * out[j][2], x0.w + ga.w * out[j][3]};
            *(f32x4*)(outp + c + 4) = (f32x4){x1.x + gb.x * out[j][4], x1.y + gb.y * out[j][5], x1.z + gb.z * out[j][6], x1.w + gb.w * out[j][7]};
        }
    }
#undef PEER_ISSUE
#undef PEER_WAIT
}
typedef short bf16x8 __attribute__((ext_vector_type(8)));
typedef short s16x4 __attribute__((ext_vector_type(4)));
typedef float f32x16 __attribute__((ext_vector_type(16)));
typedef float f32x2_t __attribute__((ext_vector_type(2)));
__device__ __forceinline__ int crow(int r, int hi) { return (r & 3) + 8 * (r >> 2) + 4 * hi; }
__device__ __forceinline__ unsigned cvtpk(float lo, float hi) { f32x2_t v = {lo, hi}; bf16x2_t b = __builtin_convertvector(v, bf16x2_t); return __builtin_bit_cast(unsigned, b); }
__device__ __forceinline__ s16x4 vtr(const LAS unsigned char* pp) { return __builtin_bit_cast(s16x4, __builtin_amdgcn_ds_read_tr16_b64_v4i16((LAS s16x4*)pp)); }
#define TR_PAIR(lo_, hi_, addr_, off_, hioff_) do { asm volatile("ds_read_b64_tr_b16 %0, %1 offset:%c2" : "=&v"(lo_) : "v"(addr_), "i"(off_) : "memory"); \
        asm volatile("ds_read_b64_tr_b16 %0, %1 offset:%c2" : "=&v"(hi_) : "v"(addr_), "i"((off_) + (hioff_)) : "memory"); } while (0)
#define LDS_WAIT_PIN() do { asm volatile("s_waitcnt lgkmcnt(0)" ::: "memory"); __builtin_amdgcn_sched_barrier(0); } while (0)
constexpr int AT_SLOT = 40960, AT_VOFF = 24576;
__device__ __forceinline__ void attn_unit(const Params& p, LAS unsigned char* ldsl, int bh, int qb, int wave, int lane) {
    const int r32 = lane & 31, hi = lane >> 5, b = bh >> 3, h = bh & 7;
    const bf16_t* Kbh = (const bf16_t*)(p.ws + WS_K) + (size_t)bh * SEQ * 192;
    const bf16_t* Vb = (const bf16_t*)(p.ws + WS_V) + (size_t)bh * SEQ * 128;
    const bf16_t* Qw = (const bf16_t*)(p.ws + WS_Q) + ((size_t)bh * SEQ + qb * 256 + wave * 32 + r32) * 192 + 8 * hi;
    const int NT = (qb * 256 + 256) / 64;
    int koff[3];
#pragma unroll
    for (int i = 0; i < 3; ++i) { const int o = 64 * (wave * 3 + i) + lane, k = o / 24, sl = o - 24 * k; int c = sl - ((k >> 1) & 7); c += (c < 0) ? 24 : 0; koff[i] = k * 192 + c * 8; }
    const int vid = wave * 2;
    const bf16_t* vsrc = Vb + (size_t)(16 * (vid & 3) + (lane >> 2)) * 128 + (vid >> 2) * 32 + (lane & 3) * 8;
#define AT_ISSUE(t, slot) do { const bf16_t* ks_ = Kbh + (size_t)(t) * 64 * 192; LAS unsigned char* sb_ = ldsl + (slot) * AT_SLOT; \
        __builtin_amdgcn_global_load_lds((const unsigned*)(ks_ + koff[0]), (LAS unsigned*)(sb_ + (wave * 3 + 0) * 1024), 16, 0, 0); \
        __builtin_amdgcn_global_load_lds((const unsigned*)(ks_ + koff[1]), (LAS unsigned*)(sb_ + (wave * 3 + 1) * 1024), 16, 0, 0); \
        __builtin_amdgcn_global_load_lds((const unsigned*)(ks_ + koff[2]), (LAS unsigned*)(sb_ + (wave * 3 + 2) * 1024), 16, 0, 0); \
        const bf16_t* vs_ = vsrc + (size_t)(t) * 64 * 128; \
        __builtin_amdgcn_global_load_lds((const unsigned*)(vs_), (LAS unsigned*)(sb_ + AT_VOFF + vid * 1024), 16, 0, 0); \
        __builtin_amdgcn_global_load_lds((const unsigned*)(vs_ + (size_t)16 * 128), (LAS unsigned*)(sb_ + AT_VOFF + (vid + 1) * 1024), 16, 0, 0); } while (0)
    bf16x8 qr[12];
#pragma unroll
    for (int s = 0; s < 12; ++s) qr[s] = *(const bf16x8*)(Qw + 16 * s);
#pragma unroll
    for (int s = 0; s < 12; ++s) asm volatile("" : "+v"(qr[s]));
    AT_ISSUE(0, 0); AT_ISSUE(1, 1);
    f32x16 o[4];
#pragma unroll
    for (int d0 = 0; d0 < 4; ++d0)
#pragma unroll
        for (int r = 0; r < 16; ++r) o[d0][r] = 0.f;
    float m = -1e30f, l = 0.f;
    const int kfo = r32 * 384, kc0 = hi + ((r32 >> 1) & 7);
    const int vfo = AT_VOFF + ((lane >> 4) & 1) * 32 + (lane & 3) * 8 + (4 * hi + ((lane & 15) >> 2)) * 64;
    const int qrel = wave * 32 + r32;
    int slot = 0;
    for (int t = 0; t < NT; ++t) {
        if (t + 1 < NT) asm volatile("s_waitcnt vmcnt(5)" ::: "memory"); else asm volatile("s_waitcnt vmcnt(0)" ::: "memory");
        __builtin_amdgcn_s_barrier(); asm volatile("" ::: "memory");
        if (t + 2 < NT) { const int s2 = (slot == 0) ? 2 : slot - 1; AT_ISSUE(t + 2, s2); }
        const int jb = t - (NT - 4);
        if (!(jb >= 0 && 64 * jb > wave * 32 + 31)) {
            const LAS unsigned char* kp = ldsl + slot * AT_SLOT + kfo;
            int kc = kc0; asm volatile("" : "+v"(kc));
            f32x16 p0, p1;
#pragma unroll
            for (int r = 0; r < 16; ++r) { p0[r] = 0.f; p1[r] = 0.f; }
#pragma unroll
            for (int s = 0; s < 12; ++s) {
                int sl_ = kc + 2 * s; sl_ -= (sl_ >= 24) ? 24 : 0;
                const bf16x8 k0 = *(const LAS bf16x8*)(kp + sl_ * 16), k1 = *(const LAS bf16x8*)(kp + sl_ * 16 + 32 * 384);
                p0 = __builtin_amdgcn_mfma_f32_32x32x16_bf16(k0, qr[s], p0, 0, 0, 0);
                p1 = __builtin_amdgcn_mfma_f32_32x32x16_bf16(k1, qr[s], p1, 0, 0, 0);
            }
            if (jb >= 0 && 64 * jb + 63 > wave * 32) {
#pragma unroll
                for (int r = 0; r < 16; ++r) { const int kv = 64 * jb + crow(r, hi); if (kv > qrel) p0[r] = -INFINITY; if (kv + 32 > qrel) p1[r] = -INFINITY; }
            }
            float rm = fmaxf(p0[0], p1[0]);
#pragma unroll
            for (int r = 1; r < 16; ++r) rm = fmaxf(rm, fmaxf(p0[r], p1[r]));
            rm = fmaxf(rm, __shfl_xor(rm, 32));
            const float mn = fmaxf(m, rm);
            if (__any(mn > m)) {
                const float alpha = __builtin_amdgcn_exp2f(m - mn);
                l *= alpha;
#pragma unroll
                for (int r = 0; r < 16; ++r) { const float ar = __shfl(alpha, crow(r, hi));
#pragma unroll
                    for (int d0 = 0; d0 < 4; ++d0) o[d0][r] *= ar; }
                m = mn;
            }
            float ls = 0.f;
#pragma unroll
            for (int r = 0; r < 16; ++r) { p0[r] = __builtin_amdgcn_exp2f(p0[r] - m); p1[r] = __builtin_amdgcn_exp2f(p1[r] - m); ls += p0[r] + p1[r]; }
            l += ls;
            bf16x8 pa[4];
            { u32x4 w;
              w.x = cvtpk(p0[0], p0[1]); w.y = cvtpk(p0[2], p0[3]); w.z = cvtpk(p0[4], p0[5]); w.w = cvtpk(p0[6], p0[7]); pa[0] = __builtin_bit_cast(bf16x8, w);
              w.x = cvtpk(p0[8], p0[9]); w.y = cvtpk(p0[10], p0[11]); w.z = cvtpk(p0[12], p0[13]); w.w = cvtpk(p0[14], p0[15]); pa[1] = __builtin_bit_cast(bf16x8, w);
              w.x = cvtpk(p1[0], p1[1]); w.y = cvtpk(p1[2], p1[3]); w.z = cvtpk(p1[4], p1[5]); w.w = cvtpk(p1[6], p1[7]); pa[2] = __builtin_bit_cast(bf16x8, w);
              w.x = cvtpk(p1[8], p1[9]); w.y = cvtpk(p1[10], p1[11]); w.z = cvtpk(p1[12], p1[13]); w.w = cvtpk(p1[14], p1[15]); pa[3] = __builtin_bit_cast(bf16x8, w); }
            const unsigned vpa = (unsigned)(size_t)(ldsl + slot * AT_SLOT + vfo);
#pragma unroll
            for (int d0 = 0; d0 < 4; ++d0) {
                s16x4 lo[4], hh[4];
                TR_PAIR(lo[0], hh[0], vpa, d0 * 4096 + 0 * 1024, 512); TR_PAIR(lo[1], hh[1], vpa, d0 * 4096 + 1 * 1024, 512);
                TR_PAIR(lo[2], hh[2], vpa, d0 * 4096 + 2 * 1024, 512); TR_PAIR(lo[3], hh[3], vpa, d0 * 4096 + 3 * 1024, 512);
                LDS_WAIT_PIN();
#pragma unroll
                for (int ks = 0; ks < 4; ++ks)
                    o[d0] = __builtin_amdgcn_mfma_f32_32x32x16_bf16(pa[ks], (bf16x8){lo[ks][0], lo[ks][1], lo[ks][2], lo[ks][3], hh[ks][0], hh[ks][1], hh[ks][2], hh[ks][3]}, o[d0], 0, 0, 0);
            }
        }
        slot = (slot == 2) ? 0 : slot + 1;
    }
    l += __shfl_xor(l, 32);
    const float inv = 1.f / l;
    bf16_t* Ow = (bf16_t*)(p.ws + WS_MIXRAW) + ((size_t)b * SEQ + qb * 256 + wave * 32) * DM + h * 128 + r32;
#pragma unroll
    for (int r = 0; r < 16; ++r) { const float ir = __shfl(inv, crow(r, hi));
#pragma unroll
        for (int d0 = 0; d0 < 4; ++d0) Ow[(size_t)crow(r, hi) * DM + d0 * 32] = (bf16_t)f2bf(o[d0][r] * ir); }
    __builtin_amdgcn_sched_barrier(0);
    float ssr[16];
#pragma unroll
    for (int r = 0; r < 16; ++r) { const float ir = __shfl(inv, crow(r, hi)); const float v0 = o[0][r] * ir, v1 = o[1][r] * ir, v2 = o[2][r] * ir, v3 = o[3][r] * ir; ssr[r] = (v0 * v0 + v1 * v1) + (v2 * v2 + v3 * v3); }
    float q8[8], q4[4], q2[2], q1;
    { const bool bb = (lane & 16) != 0;
#pragma unroll
      for (int i = 0; i < 8; ++i) { const float keep = bb ? ssr[i + 8] : ssr[i], send = bb ? ssr[i] : ssr[i + 8]; q8[i] = keep + __shfl_xor(send, 16); } }
    { const bool bb = (lane & 8) != 0;
#pragma unroll
      for (int i = 0; i < 4; ++i) { const float keep = bb ? q8[i + 4] : q8[i], send = bb ? q8[i] : q8[i + 4]; q4[i] = keep + __shfl_xor(send, 8); } }
    { const bool bb = (lane & 4) != 0;
#pragma unroll
      for (int i = 0; i < 2; ++i) { const float keep = bb ? q4[i + 2] : q4[i], send = bb ? q4[i] : q4[i + 2]; q2[i] = keep + __shfl_xor(send, 4); } }
    { const bool bb = (lane & 2) != 0; const float keep = bb ? q2[1] : q2[0], send = bb ? q2[0] : q2[1]; q1 = keep + __shfl_xor(send, 2); }
    q1 += __shfl_xor(q1, 1);
    { const int rs = ((lane >> 4) & 1) * 8 + ((lane >> 3) & 1) * 4 + ((lane >> 2) & 1) * 2 + ((lane >> 1) & 1);
      if ((lane & 1) == 0) ((float*)(p.ws + WS_PSQA))[((size_t)b * SEQ + qb * 256 + wave * 32 + crow(rs, hi)) * 8 + h] = q1; }
    asm volatile("s_waitcnt lgkmcnt(0)" ::: "memory"); __builtin_amdgcn_s_barrier(); asm volatile("" ::: "memory");
#undef AT_ISSUE
}
__device__ __forceinline__ void ph_attn(const Params& p, LAS unsigned char* ldsl, int bid, int G, int wave, int lane) {
    const int vcu = (bid & 7) * (G >> 3) + (bid >> 3);
    const int bh = vcu >> 2, s = vcu & 3;
    attn_unit(p, ldsl, bh, 7 - s, wave, lane);
    attn_unit(p, ldsl, bh, s, wave, lane);
}
__device__ __forceinline__ int f2sort(float f) { const int u = __builtin_bit_cast(int, f); return u ^ ((u >> 31) & 0x7fffffff); }
__device__ __forceinline__ float sort2f(int k) { return __builtin_bit_cast(float, k ^ ((k >> 31) & 0x7fffffff)); }
#define CE_(a_, b_) do { const int hi_ = max(a_, b_); b_ = min(a_, b_); a_ = hi_; } while (0)
#define INS16(L, x) do { int x_ = (x); _Pragma("unroll") for (int i_ = 0; i_ < 16; ++i_) { const int hi_ = max(L[i_], x_); x_ = min(L[i_], x_); L[i_] = hi_; } } while (0)
#define SORT16(v) do { CE_(v[0], v[13]); CE_(v[1], v[12]); CE_(v[2], v[15]); CE_(v[3], v[14]); CE_(v[4], v[8]); CE_(v[5], v[6]); CE_(v[7], v[11]); CE_(v[9], v[10]); CE_(v[0], v[5]); CE_(v[1], v[7]); CE_(v[2], v[9]); CE_(v[3], v[4]); CE_(v[6], v[13]); CE_(v[8], v[14]); CE_(v[10], v[15]); CE_(v[11], v[12]); CE_(v[0], v[1]); CE_(v[2], v[3]); CE_(v[4], v[5]); CE_(v[6], v[8]); CE_(v[7], v[9]); CE_(v[10], v[11]); CE_(v[12], v[13]); CE_(v[14], v[15]); CE_(v[0], v[2]); CE_(v[1], v[3]); CE_(v[4], v[10]); CE_(v[5], v[11]); CE_(v[6], v[7]); CE_(v[8], v[9]); CE_(v[12], v[14]); CE_(v[13], v[15]); CE_(v[1], v[2]); CE_(v[3], v[12]); CE_(v[4], v[6]); CE_(v[5], v[7]); CE_(v[8], v[10]); CE_(v[9], v[11]); CE_(v[13], v[14]); CE_(v[1], v[4]); CE_(v[2], v[6]); CE_(v[5], v[8]); CE_(v[7], v[10]); CE_(v[9], v[13]); CE_(v[11], v[14]); CE_(v[2], v[4]); CE_(v[3], v[6]); CE_(v[9], v[12]); CE_(v[11], v[13]); CE_(v[3], v[5]); CE_(v[6], v[8]); CE_(v[7], v[9]); CE_(v[10], v[12]); CE_(v[3], v[4]); CE_(v[5], v[6]); CE_(v[7], v[8]); CE_(v[9], v[10]); CE_(v[11], v[12]); CE_(v[6], v[7]); CE_(v[8], v[9]); } while (0)
#define BMERGE16(v) do { CE_(v[0], v[8]); CE_(v[1], v[9]); CE_(v[2], v[10]); CE_(v[3], v[11]); CE_(v[4], v[12]); CE_(v[5], v[13]); CE_(v[6], v[14]); CE_(v[7], v[15]); CE_(v[0], v[4]); CE_(v[1], v[5]); CE_(v[2], v[6]); CE_(v[3], v[7]); CE_(v[8], v[12]); CE_(v[9], v[13]); CE_(v[10], v[14]); CE_(v[11], v[15]); CE_(v[0], v[2]); CE_(v[1], v[3]); CE_(v[4], v[6]); CE_(v[5], v[7]); CE_(v[8], v[10]); CE_(v[9], v[11]); CE_(v[12], v[14]); CE_(v[13], v[15]); CE_(v[0], v[1]); CE_(v[2], v[3]); CE_(v[4], v[5]); CE_(v[6], v[7]); CE_(v[8], v[9]); CE_(v[10], v[11]); CE_(v[12], v[13]); CE_(v[14], v[15]); } while (0)
__device__ __forceinline__ void ph_route(const Params& p, LAS unsigned char* ldsl, int wave, int lane, int gwave, int gnw) {
    const int r32 = lane & 31, hi = lane >> 5;
    const bf16_t* SK = (const bf16_t*)(p.ws + WS_SUBK);
    LAS unsigned char* tab = ldsl + wave * 4096 + lane * 32;
    for (int item = gwave; item < (T / 32) * 8; item += gnw) {
        const int tile = item >> 3, h = item & 7, t0 = tile * 32;
        int hi4 = hi * 4; asm volatile("" : "+v"(hi4));
        int S0[16], S1[16];
#pragma unroll
        for (int j = 0; j < 2; ++j) {
            const bf16_t* qp = (const bf16_t*)(p.ws + WS_QP) + (size_t)(t0 + r32) * DM + h * 256 + j * 128 + 8 * hi;
            asm volatile("" : "+v"(qp));
            bf16x8 bq[8];
#pragma unroll
            for (int s = 0; s < 8; ++s) bq[s] = *(const bf16x8*)(qp + 16 * s);
            int L[16];
#pragma unroll
            for (int kb = 0; kb < 4; ++kb) {
                const bf16_t* ap = SK + ((size_t)(h * 2 + j) * 128 + kb * 32 + r32) * 128 + 8 * hi;
                asm volatile("" : "+v"(ap));
                f32x16 acc;
#pragma unroll
                for (int r = 0; r < 16; ++r) acc[r] = 0.f;
#pragma unroll
                for (int s = 0; s < 8; ++s) acc = __builtin_amdgcn_mfma_f32_32x32x16_bf16(*(const bf16x8*)(ap + 16 * s), bq[s], acc, 0, 0, 0);
                int v[16];
#pragma unroll
                for (int r = 0; r < 16; ++r) v[r] = (f2sort(acc[r]) & ~127) | ((127 - (kb * 32 + (r & 3) + 8 * (r >> 2))) - hi4);
                SORT16(v);
                if (kb == 0) {
#pragma unroll
                    for (int i = 0; i < 16; ++i) L[i] = v[i];
                } else {
#pragma unroll
                    for (int i = 0; i < 16; ++i) L[i] = max(L[i], v[15 - i]);
                    BMERGE16(L);
                }
                __builtin_amdgcn_sched_barrier(0);
            }
            int Y[16];
#pragma unroll
            for (int i = 0; i < 16; ++i) Y[i] = __shfl_xor(L[i], 32);
#pragma unroll
            for (int i = 0; i < 16; ++i) L[i] = max(L[i], Y[15 - i]);
            BMERGE16(L);
#pragma unroll
            for (int i = 0; i < 16; ++i) { if (j == 0) S0[i] = L[i]; else S1[i] = L[i]; }
        }
        float f0[16], f1[16];
        {
            unsigned w0[4], w1[4];
#pragma unroll
            for (int i = 0; i < 16; ++i) { f0[i] = sort2f(S0[i] & ~127); f1[i] = sort2f(S1[i] & ~127); }
#pragma unroll
            for (int q = 0; q < 4; ++q) {
                w0[q] = (unsigned)(127 - (S0[4 * q] & 127)) | ((unsigned)(127 - (S0[4 * q + 1] & 127)) << 8) | ((unsigned)(127 - (S0[4 * q + 2] & 127)) << 16) | ((unsigned)(127 - (S0[4 * q + 3] & 127)) << 24);
                w1[q] = (unsigned)(127 - (S1[4 * q] & 127)) | ((unsigned)(127 - (S1[4 * q + 1] & 127)) << 8) | ((unsigned)(127 - (S1[4 * q + 2] & 127)) << 16) | ((unsigned)(127 - (S1[4 * q + 3] & 127)) << 24);
            }
            *(LAS u32x4*)(tab) = (u32x4){w0[0], w0[1], w0[2], w0[3]};
            *(LAS u32x4*)(tab + 16) = (u32x4){w1[0], w1[1], w1[2], w1[3]};
        }
        int Lv[16];
        Lv[0] = (f2sort(f0[0] + f1[0]) & ~255) | 255;
        Lv[1] = (f2sort(f0[0] + f1[1]) & ~255) | 254;
        Lv[2] = (f2sort(f0[0] + f1[2]) & ~255) | 253;
        Lv[3] = (f2sort(f0[0] + f1[3]) & ~255) | 252;
        Lv[4] = (f2sort(f0[0] + f1[4]) & ~255) | 251;
        Lv[5] = (f2sort(f0[0] + f1[5]) & ~255) | 250;
        Lv[6] = (f2sort(f0[0] + f1[6]) & ~255) | 249;
        Lv[7] = (f2sort(f0[0] + f1[7]) & ~255) | 248;
        Lv[8] = (f2sort(f0[0] + f1[8]) & ~255) | 247;
        Lv[9] = (f2sort(f0[0] + f1[9]) & ~255) | 246;
        Lv[10] = (f2sort(f0[0] + f1[10]) & ~255) | 245;
        Lv[11] = (f2sort(f0[0] + f1[11]) & ~255) | 244;
        Lv[12] = (f2sort(f0[0] + f1[12]) & ~255) | 243;
        Lv[13] = (f2sort(f0[0] + f1[13]) & ~255) | 242;
        Lv[14] = (f2sort(f0[0] + f1[14]) & ~255) | 241;
        Lv[15] = (f2sort(f0[0] + f1[15]) & ~255) | 240;
        { int cv_ = (f2sort(f0[1] + f1[0]) & ~255) | 239; INS16(Lv, cv_); __builtin_amdgcn_sched_barrier(0); }
        { int cv_ = (f2sort(f0[1] + f1[1]) & ~255) | 238; INS16(Lv, cv_); __builtin_amdgcn_sched_barrier(0); }
        { int cv_ = (f2sort(f0[1] + f1[2]) & ~255) | 237; INS16(Lv, cv_); __builtin_amdgcn_sched_barrier(0); }
        { int cv_ = (f2sort(f0[1] + f1[3]) & ~255) | 236; INS16(Lv, cv_); __builtin_amdgcn_sched_barrier(0); }
        { int cv_ = (f2sort(f0[1] + f1[4]) & ~255) | 235; INS16(Lv, cv_); __builtin_amdgcn_sched_barrier(0); }
        { int cv_ = (f2sort(f0[1] + f1[5]) & ~255) | 234; INS16(Lv, cv_); __builtin_amdgcn_sched_barrier(0); }
        { int cv_ = (f2sort(f0[1] + f1[6]) & ~255) | 233; INS16(Lv, cv_); __builtin_amdgcn_sched_barrier(0); }
        { int cv_ = (f2sort(f0[1] + f1[7]) & ~255) | 232; INS16(Lv, cv_); __builtin_amdgcn_sched_barrier(0); }
        { int cv_ = (f2sort(f0[2] + f1[0]) & ~255) | 223; INS16(Lv, cv_); __builtin_amdgcn_sched_barrier(0); }
        { int cv_ = (f2sort(f0[2] + f1[1]) & ~255) | 222; INS16(Lv, cv_); __builtin_amdgcn_sched_barrier(0); }
        { int cv_ = (f2sort(f0[2] + f1[2]) & ~255) | 221; INS16(Lv, cv_); __builtin_amdgcn_sched_barrier(0); }
        { int cv_ = (f2sort(f0[2] + f1[3]) & ~255) | 220; INS16(Lv, cv_); __builtin_amdgcn_sched_barrier(0); }
        { int cv_ = (f2sort(f0[2] + f1[4]) & ~255) | 219; INS16(Lv, cv_); __builtin_amdgcn_sched_barrier(0); }
        { int cv_ = (f2sort(f0[3] + f1[0]) & ~255) | 207; INS16(Lv, cv_); __builtin_amdgcn_sched_barrier(0); }
        { int cv_ = (f2sort(f0[3] + f1[1]) & ~255) | 206; INS16(Lv, cv_); __builtin_amdgcn_sched_barrier(0); }
        { int cv_ = (f2sort(f0[3] + f1[2]) & ~255) | 205; INS16(Lv, cv_); __builtin_amdgcn_sched_barrier(0); }
        { int cv_ = (f2sort(f0[3] + f1[3]) & ~255) | 204; INS16(Lv, cv_); __builtin_amdgcn_sched_barrier(0); }
        { int cv_ = (f2sort(f0[4] + f1[0]) & ~255) | 191; INS16(Lv, cv_); __builtin_amdgcn_sched_barrier(0); }
        { int cv_ = (f2sort(f0[4] + f1[1]) & ~255) | 190; INS16(Lv, cv_); __builtin_amdgcn_sched_barrier(0); }
        { int cv_ = (f2sort(f0[4] + f1[2]) & ~255) | 189; INS16(Lv, cv_); __builtin_amdgcn_sched_barrier(0); }
        { int cv_ = (f2sort(f0[5] + f1[0]) & ~255) | 175; INS16(Lv, cv_); __builtin_amdgcn_sched_barrier(0); }
        { int cv_ = (f2sort(f0[5] + f1[1]) & ~255) | 174; INS16(Lv, cv_); __builtin_amdgcn_sched_barrier(0); }
        { int cv_ = (f2sort(f0[6] + f1[0]) & ~255) | 159; INS16(Lv, cv_); __builtin_amdgcn_sched_barrier(0); }
        { int cv_ = (f2sort(f0[6] + f1[1]) & ~255) | 158; INS16(Lv, cv_); __builtin_amdgcn_sched_barrier(0); }
        { int cv_ = (f2sort(f0[7] + f1[0]) & ~255) | 143; INS16(Lv, cv_); __builtin_amdgcn_sched_barrier(0); }
        { int cv_ = (f2sort(f0[7] + f1[1]) & ~255) | 142; INS16(Lv, cv_); __builtin_amdgcn_sched_barrier(0); }
        { int cv_ = (f2sort(f0[8] + f1[0]) & ~255) | 127; INS16(Lv, cv_); __builtin_amdgcn_sched_barrier(0); }
        { int cv_ = (f2sort(f0[9] + f1[0]) & ~255) | 111; INS16(Lv, cv_); __builtin_amdgcn_sched_barrier(0); }
        { int cv_ = (f2sort(f0[10] + f1[0]) & ~255) | 95; INS16(Lv, cv_); __builtin_amdgcn_sched_barrier(0); }
        { int cv_ = (f2sort(f0[11] + f1[0]) & ~255) | 79; INS16(Lv, cv_); __builtin_amdgcn_sched_barrier(0); }
        { int cv_ = (f2sort(f0[12] + f1[0]) & ~255) | 63; INS16(Lv, cv_); __builtin_amdgcn_sched_barrier(0); }
        { int cv_ = (f2sort(f0[13] + f1[0]) & ~255) | 47; INS16(Lv, cv_); __builtin_amdgcn_sched_barrier(0); }
        { int cv_ = (f2sort(f0[14] + f1[0]) & ~255) | 31; INS16(Lv, cv_); __builtin_amdgcn_sched_barrier(0); }
        { int cv_ = (f2sort(f0[15] + f1[0]) & ~255) | 15; INS16(Lv, cv_); __builtin_amdgcn_sched_barrier(0); }
        float g[16]; float sum = 0.f; const float mx = sort2f(Lv[0] & ~255);
        int Le[16];
#pragma unroll
        for (int i = 0; i < 16; ++i) {
            g[i] = __expf(sort2f(Lv[i] & ~255) - mx); sum += g[i];
            const int pos = 255 - (Lv[i] & 255);
            const int ia = *(const LAS unsigned char*)(tab + (pos >> 4)), ib = *(const LAS unsigned char*)(tab + 16 + (pos & 15));
            Le[i] = ia * 128 + ib;
        }
        const float inv = 1.f / sum;
        if (hi == 0) {
            int* ip = (int*)(p.ws + WS_IDX) + (size_t)(t0 + r32) * 128 + h * 16; float* gp = (float*)(p.ws + WS_GATE) + (size_t)(t0 + r32) * 128 + h * 16;
#pragma unroll
            for (int i = 0; i < 4; ++i) {
                *(u32x4*)(ip + 4 * i) = (u32x4){(unsigned)Le[4 * i], (unsigned)Le[4 * i + 1], (unsigned)Le[4 * i + 2], (unsigned)Le[4 * i + 3]};
                *(f32x4*)(gp + 4 * i) = (f32x4){g[4 * i] * inv, g[4 * i + 1] * inv, g[4 * i + 2] * inv, g[4 * i + 3] * inv};
            }
        }
        asm volatile("s_waitcnt lgkmcnt(0)" ::: "memory");
    }
}
__device__ __forceinline__ void ph_conv(const Params& p, int gwave, int gnw, int lane) {
    const bf16_t* proj = (const bf16_t*)(p.ws + WS_PROJ);
    bf16_t* xa = (bf16_t*)(p.ws + WS_XBCA);
    for (int task = gwave; task < 1536 + 256; task += gnw) {
        if (task < 1536) {
            const int run = task / 3, cg = (task % 3) * 64 + lane, c0 = cg * 8;
            const int t0 = run * 32, s0 = t0 % SEQ;
            float w0[8], w1[8], w2[8], w3[8], bs[8], h1[8], h2[8], h3[8];
#pragma unroll
            for (int i = 0; i < 8; ++i) { w0[i] = p.conv_w[0 * 1536 + c0 + i]; w1[i] = p.conv_w[1 * 1536 + c0 + i]; w2[i] = p.conv_w[2 * 1536 + c0 + i]; w3[i] = p.conv_w[3 * 1536 + c0 + i]; bs[i] = p.conv_b[c0 + i]; h1[i] = 0.f; h2[i] = 0.f; h3[i] = 0.f; }
            const bf16_t* src = proj + (size_t)t0 * NPROJ + C_XBC + c0;
            if (s0 > 0) {
                const u32x4 a = *(const u32x4*)(src - (size_t)1 * NPROJ), b = *(const u32x4*)(src - (size_t)2 * NPROJ), c = *(const u32x4*)(src - (size_t)3 * NPROJ);
                h1[0] = bflo(a.x); h1[1] = bfhi(a.x); h1[2] = bflo(a.y); h1[3] = bfhi(a.y); h1[4] = bflo(a.z); h1[5] = bfhi(a.z); h1[6] = bflo(a.w); h1[7] = bfhi(a.w);
                h2[0] = bflo(b.x); h2[1] = bfhi(b.x); h2[2] = bflo(b.y); h2[3] = bfhi(b.y); h2[4] = bflo(b.z); h2[5] = bfhi(b.z); h2[6] = bflo(b.w); h2[7] = bfhi(b.w);
                h3[0] = bflo(c.x); h3[1] = bfhi(c.x); h3[2] = bflo(c.y); h3[3] = bfhi(c.y); h3[4] = bflo(c.z); h3[5] = bfhi(c.z); h3[6] = bflo(c.w); h3[7] = bfhi(c.w);
            }
            bf16_t* dst = xa + (size_t)t0 * 1536 + c0;
#pragma unroll 16
            for (int i = 0; i < 32; ++i) {
                const u32x4 a = *(const u32x4*)(src + (size_t)i * NPROJ);
                float cur[8] = {bflo(a.x), bfhi(a.x), bflo(a.y), bfhi(a.y), bflo(a.z), bfhi(a.z), bflo(a.w), bfhi(a.w)};
                float o[8];
#pragma unroll
                for (int k = 0; k < 8; ++k) { o[k] = silu_fast(bs[k] + w3[k] * cur[k] + w2[k] * h1[k] + w1[k] * h2[k] + w0[k] * h3[k]); h3[k] = h2[k]; h2[k] = h1[k]; h1[k] = cur[k]; }
                u32x4 w; w.x = pk2(o[0], o[1]); w.y = pk2(o[2], o[3]); w.z = pk2(o[4], o[5]); w.w = pk2(o[6], o[7]);
                *(u32x4*)(dst + (size_t)i * 1536) = w;
            }
        } else {
            const int t = (task - 1536) * 64 + lane;
            const u32x4 a = *(const u32x4*)(proj + (size_t)t * NPROJ + C_DT), b = *(const u32x4*)(proj + (size_t)t * NPROJ + C_DT + 8);
            const float raw[16] = {bflo(a.x), bfhi(a.x), bflo(a.y), bfhi(a.y), bflo(a.z), bfhi(a.z), bflo(a.w), bfhi(a.w), bflo(b.x), bfhi(b.x), bflo(b.y), bfhi(b.y), bflo(b.z), bfhi(b.z), bflo(b.w), bfhi(b.w)};
            float* dto = (float*)(p.ws + WS_DT) + (size_t)t * 16; float* cso = (float*)(p.ws + WS_CS) + (size_t)t * 16;
            float dtv[16], csv[16];
#pragma unroll
            for (int hh = 0; hh < 16; ++hh) {
                const float v = raw[hh] + p.dt_bias[hh];
                const float dt = (v > 20.f) ? v : log1pf(__expf(v));
                float c = dt * (-__expf(p.a_log[hh]));
#pragma unroll
                for (int o = 1; o < 64; o <<= 1) { const float u = __shfl_up(c, o); if (lane >= o) c += u; }
                dtv[hh] = dt; csv[hh] = c;
            }
#pragma unroll
            for (int q = 0; q < 4; ++q) { *(f32x4*)(dto + 4 * q) = (f32x4){dtv[4 * q], dtv[4 * q + 1], dtv[4 * q + 2], dtv[4 * q + 3]}; *(f32x4*)(cso + 4 * q) = (f32x4){csv[4 * q], csv[4 * q + 1], csv[4 * q + 2], csv[4 * q + 3]}; }
        }
    }
}
constexpr int P4_ROW = 1152;
__device__ __forceinline__ void fp4_row_load(const Params& p, int row, int lane, f32x4 (&v)[8]) {
    const f32x4* src = (const f32x4*)(((row >= 16384) ? p.v_exp : p.u_exp) + (size_t)(row & 16383) * DM) + lane;
#pragma unroll
    for (int j = 0; j < 8; ++j) v[j] = src[64 * j];
}
__device__ __forceinline__ void fp4_row_store(const Params& p, int row, int lane, const f32x4 (&v)[8]) {
    float mx = 0.f;
#pragma unroll
    for (int j = 0; j < 8; ++j) mx = fmaxf(mx, fmaxf(fmaxf(fabsf(v[j].x), fabsf(v[j].y)), fmaxf(fabsf(v[j].z), fabsf(v[j].w))));
    unsigned sb = (__builtin_bit_cast(unsigned, mx * (1.f / 6.f)) + 0x000fffffu) >> 20;
    if ((float)__builtin_bit_cast(float, sb << 20) * 6.f < mx) sb += 1u;
    sb = min(max(sb, 825u), 824u + 255u) - 824u;
    const float inv = 1.f / __builtin_bit_cast(float, (sb + 824u) << 20);
    unsigned w[4];
#pragma unroll
    for (int q = 0; q < 4; ++q) {
        const f32x4 a = v[2 * q] * inv, b = v[2 * q + 1] * inv;
        unsigned r = 0u;
        r = __builtin_amdgcn_cvt_scalef32_pk_fp4_f32(r, a.x, a.y, 1.0f, 0);
        r = __builtin_amdgcn_cvt_scalef32_pk_fp4_f32(r, a.z, a.w, 1.0f, 1);
        r = __builtin_amdgcn_cvt_scalef32_pk_fp4_f32(r, b.x, b.y, 1.0f, 2);
        r = __builtin_amdgcn_cvt_scalef32_pk_fp4_f32(r, b.z, b.w, 1.0f, 3);
        w[q] = r;
    }
    const size_t e = (size_t)(row & 16383), x = (size_t)(lane >> 3);
    *(u32x4*)(p.ws + ((row >= 16384) ? WS_V4D : WS_U4D) + x * ((size_t)16384 * 128) + e * 128 + (lane & 7) * 16) = (u32x4){w[0], w[1], w[2], w[3]};
    *(unsigned char*)(p.ws + ((row >= 16384) ? WS_V4S : WS_U4S) + x * ((size_t)16384 * 8) + e * 8 + (lane & 7)) = (unsigned char)sb;
}
constexpr int SSD_IN = 41472, SSD_BM = 0, SSD_CM = 16384, SSD_XS = 32768, SSD_Z = 36864, SSD_DT = 40960, SSD_CS = 41216, SSD_ST = 3 * SSD_IN, SSD_PART = SSD_ST + 16384, SSD_SYNC = SSD_PART + 4096;
__device__ __forceinline__ void ssd_decay_block(f32x16& cbt, const f32x4 (&c4)[4], const f32x4 (&d4)[4], float cs_l, int sb, int l, int hi, bool diag) {
#pragma unroll
    for (int q = 0; q < 4; ++q) {
#pragma unroll
        for (int i = 0; i < 4; ++i) {
            const int s = 32 * sb + 8 * q + 4 * hi + i;
            float e = __expf(cs_l - c4[q][i]) * d4[q][i];
            if (diag) e = (s <= l) ? e : 0.f;
            cbt[4 * q + i] *= e;
        }
    }
}
__device__ __forceinline__ void ph_ssd(const Params& p, LAS unsigned char* ldsl, int bid, int wave, int lane) {
    const int b = bid >> 5, h = (bid >> 1) & 15, ph = bid & 1, g = h >> 3;
    const int r32 = lane & 31, hi = lane >> 5;
    const size_t tb0 = (size_t)b * SEQ;
    LAS unsigned* sync = (LAS unsigned*)(ldsl + SSD_SYNC);
    if (threadIdx.x < 16) sync[threadIdx.x] = (threadIdx.x >= 14) ? 0xffffffffu : 0u;
    for (int i = threadIdx.x; i < 8192 / 16; i += NTHR) *(LAS u32x4*)(ldsl + SSD_ST + i * 16) = (u32x4){0u, 0u, 0u, 0u};
    asm volatile("s_waitcnt lgkmcnt(0)" ::: "memory"); __builtin_amdgcn_s_barrier(); asm volatile("" ::: "memory");
    if (wave >= 6) {
        const int cvw = bid * 2 + (wave - 6);
        f32x4 ra[8], rb[8], rc[8], rd[8];
        fp4_row_load(p, cvw, lane, ra); fp4_row_load(p, 512 + cvw, lane, rb); fp4_row_load(p, 1024 + cvw, lane, rc); fp4_row_load(p, 1536 + cvw, lane, rd);
        for (int c = 0; c < 16; ++c) {
            fp4_row_store(p, (4 * c) * 512 + cvw, lane, ra);
            if (c + 1 < 16) fp4_row_load(p, (4 * c + 4) * 512 + cvw, lane, ra);
            fp4_row_store(p, (4 * c + 1) * 512 + cvw, lane, rb);
            if (c + 1 < 16) fp4_row_load(p, (4 * c + 5) * 512 + cvw, lane, rb);
            fp4_row_store(p, (4 * c + 2) * 512 + cvw, lane, rc);
            if (c + 1 < 16) fp4_row_load(p, (4 * c + 6) * 512 + cvw, lane, rc);
            fp4_row_store(p, (4 * c + 3) * 512 + cvw, lane, rd);
            if (c + 1 < 16) fp4_row_load(p, (4 * c + 7) * 512 + cvw, lane, rd);
        }
    } else {
        const bf16_t* xa = (const bf16_t*)(p.ws + WS_XBCA); const bf16_t* proj = (const bf16_t*)(p.ws + WS_PROJ);
        const float dsk = p.d_skip[h];
        const int dq = (wave - 2) & 3;
        const int dr0 = 4 * dq + (lane >> 4);
        const bf16_t* bsrc = xa + (tb0 + dr0) * 1536 + 1024 + g * 128 + (((lane & 15) ^ (dr0 & 15)) * 8);
        const bf16_t* csrc = xa + (tb0 + dr0) * 1536 + 1280 + g * 128 + (((lane & 15) ^ (dr0 & 15)) * 8);
        const bf16_t* xsrc = xa + (tb0 + 16 * dq + (lane >> 2)) * 1536 + h * 64 + ph * 32 + (lane & 3) * 8;
        const bf16_t* zsrc = proj + (tb0 + 16 * dq + (lane >> 2)) * NPROJ + C_Z + h * 64 + ph * 32 + (lane & 3) * 8;
        const float* dsrc = (const float*)(p.ws + ((dq == 0) ? WS_DT : WS_CS)) + (tb0 + lane) * 16 + h;
#define SSD_G16(src, dst) __builtin_amdgcn_global_load_lds((const unsigned*)(src), (LAS unsigned*)(dst), 16, 0, 0)
#define SSD_ISSUE(c, buf) do { if (wave >= 2) { LAS unsigned char* in_ = ldsl + (buf) * SSD_IN; const size_t to_ = (size_t)(c) * 64 * 1536; \
        SSD_G16(bsrc + to_, in_ + SSD_BM + dq * 1024); SSD_G16(bsrc + to_ + 16 * 1536, in_ + SSD_BM + (dq + 4) * 1024); SSD_G16(bsrc + to_ + 32 * 1536, in_ + SSD_BM + (dq + 8) * 1024); SSD_G16(bsrc + to_ + 48 * 1536, in_ + SSD_BM + (dq + 12) * 1024); \
        SSD_G16(csrc + to_, in_ + SSD_CM + dq * 1024); SSD_G16(csrc + to_ + 16 * 1536, in_ + SSD_CM + (dq + 4) * 1024); SSD_G16(csrc + to_ + 32 * 1536, in_ + SSD_CM + (dq + 8) * 1024); SSD_G16(csrc + to_ + 48 * 1536, in_ + SSD_CM + (dq + 12) * 1024); \
        SSD_G16(xsrc + to_, in_ + SSD_XS + dq * 1024); SSD_G16(zsrc + (size_t)(c) * 64 * NPROJ, in_ + SSD_Z + dq * 1024); \
        if (dq < 2) __builtin_amdgcn_global_load_lds((const unsigned*)(dsrc + (size_t)(c) * 64 * 16), (LAS unsigned*)(in_ + ((dq == 0) ? SSD_DT : SSD_CS)), 4, 0, 0); } } while (0)
        f32x16 S;
#pragma unroll
        for (int r = 0; r < 16; ++r) S[r] = 0.f;
        SSD_ISSUE(0, 0); SSD_ISSUE(1, 1);
        const int xfo = ((lane >> 4) & 1) * 32 + (lane & 3) * 8 + (4 * hi + ((lane & 15) >> 2)) * 64;
        for (int c = 0; c < SEQ / 64; ++c) {
            if (wave >= 2) { if (c + 1 >= SEQ / 64) asm volatile("s_waitcnt vmcnt(0)" ::: "memory"); else if (dq < 2) asm volatile("s_waitcnt vmcnt(11)" ::: "memory"); else asm volatile("s_waitcnt vmcnt(10)" ::: "memory"); }
            asm volatile("s_waitcnt lgkmcnt(0)" ::: "memory");
            {
                const unsigned sa = (unsigned)(size_t)(ldsl + SSD_SYNC), tgt = (unsigned)(c + 1);
                asm volatile("ds_write_b32 %0, %1" :: "v"(sa + 32u + 4u * (unsigned)wave), "v"(tgt) : "memory");
                for (;;) { u32x4 a, b_; asm volatile("ds_read_b128 %0, %2 offset:32\n\tds_read_b128 %1, %2 offset:48\n\ts_waitcnt lgkmcnt(0)" : "=&v"(a), "=&v"(b_) : "v"(sa) : "memory");
                    const unsigned m = min(min(min(a.x, a.y), min(a.z, a.w)), min(min(b_.x, b_.y), min(b_.z, b_.w)));
                    if (__builtin_amdgcn_readfirstlane(m) >= tgt) break; __builtin_amdgcn_s_sleep(1); }
            }
            asm volatile("" ::: "memory");
            if (c + 2 < SEQ / 64) SSD_ISSUE(c + 2, (c + 2) % 3);
            const LAS unsigned char* in = ldsl + (c % 3) * SSD_IN;
            const LAS unsigned char* STin = ldsl + SSD_ST + (c & 1) * 8192;
            LAS unsigned char* STout = ldsl + SSD_ST + ((c + 1) & 1) * 8192;
            const LAS float* dtl = (const LAS float*)(in + SSD_DT); const LAS float* csl = (const LAS float*)(in + SSD_CS);
            if (wave < 2) {
                const int lb = wave, l = 32 * lb + r32;
                const unsigned xpa = (unsigned)(size_t)(in + SSD_XS + xfo + (32 * lb) * 64);
                s16x4 lo0, hh0, lo1, hh1; TR_PAIR(lo0, hh0, xpa, 0, 512); TR_PAIR(lo1, hh1, xpa, 1024, 512);
                const int l1 = 32 + r32;
                const float cs_l = csl[l], cs_l1 = csl[l1];
                bf16x8 cf[8], bdf[8], cf1[8]; f32x4 c4[4], d4[4];
#pragma unroll
                for (int ks = 0; ks < 8; ++ks) {
                    cf[ks] = *(const LAS bf16x8*)(in + SSD_CM + l * 256 + (((2 * ks + hi) ^ (l & 15)) << 4));
                    bdf[ks] = *(const LAS bf16x8*)(in + SSD_BM + l * 256 + (((2 * ks + hi) ^ (l & 15)) << 4));
                    if (wave == 0) cf1[ks] = *(const LAS bf16x8*)(in + SSD_CM + l1 * 256 + (((2 * ks + hi) ^ (l1 & 15)) << 4));
                }
                LDS_WAIT_PIN();
#pragma unroll
                for (int q = 0; q < 4; ++q) { c4[q] = *(const LAS f32x4*)(csl + 32 * lb + 8 * q + 4 * hi); d4[q] = *(const LAS f32x4*)(dtl + 32 * lb + 8 * q + 4 * hi); }
                const bf16x8 xf0 = (bf16x8){lo0[0], lo0[1], lo0[2], lo0[3], hh0[0], hh0[1], hh0[2], hh0[3]}, xf1 = (bf16x8){lo1[0], lo1[1], lo1[2], lo1[3], hh1[0], hh1[1], hh1[2], hh1[3]};
                if (wave == 0) {
                    f32x16 ca, cb;
#pragma unroll
                    for (int r = 0; r < 16; ++r) { ca[r] = 0.f; cb[r] = 0.f; }
#pragma unroll
                    for (int ks = 0; ks < 8; ks += 2) { ca = __builtin_amdgcn_mfma_f32_32x32x16_bf16(bdf[ks], cf1[ks], ca, 0, 0, 0); cb = __builtin_amdgcn_mfma_f32_32x32x16_bf16(bdf[ks + 1], cf1[ks + 1], cb, 0, 0, 0); }
                    ca += cb;
                    ssd_decay_block(ca, c4, d4, cs_l1, 0, l1, hi, false);
                    u32x4 w0, w1;
                    w0.x = cvtpk(ca[0], ca[1]); w0.y = cvtpk(ca[2], ca[3]); w0.z = cvtpk(ca[4], ca[5]); w0.w = cvtpk(ca[6], ca[7]);
                    w1.x = cvtpk(ca[8], ca[9]); w1.y = cvtpk(ca[10], ca[11]); w1.z = cvtpk(ca[12], ca[13]); w1.w = cvtpk(ca[14], ca[15]);
                    f32x16 pa;
#pragma unroll
                    for (int r = 0; r < 16; ++r) pa[r] = 0.f;
                    pa = __builtin_amdgcn_mfma_f32_32x32x16_bf16(xf0, __builtin_bit_cast(bf16x8, w0), pa, 0, 0, 0);
                    pa = __builtin_amdgcn_mfma_f32_32x32x16_bf16(xf1, __builtin_bit_cast(bf16x8, w1), pa, 0, 0, 0);
                    LAS unsigned char* pp = ldsl + SSD_PART + lane * 64;
#pragma unroll
                    for (int q = 0; q < 4; ++q) *(LAS f32x4*)(pp + q * 16) = (f32x4){pa[4 * q], pa[4 * q + 1], pa[4 * q + 2], pa[4 * q + 3]};
                    asm volatile("s_waitcnt lgkmcnt(0)" ::: "memory");
                    asm volatile("ds_write_b32 %0, %1" :: "v"((unsigned)(size_t)(ldsl + SSD_SYNC) + 4u), "v"((unsigned)(c + 1)) : "memory");
                }
                f32x16 acc;
                {
                    f32x16 ca, cb;
#pragma unroll
                    for (int r = 0; r < 16; ++r) { ca[r] = 0.f; cb[r] = 0.f; acc[r] = 0.f; }
#pragma unroll
                    for (int ks = 0; ks < 8; ks += 2) { ca = __builtin_amdgcn_mfma_f32_32x32x16_bf16(bdf[ks], cf[ks], ca, 0, 0, 0); cb = __builtin_amdgcn_mfma_f32_32x32x16_bf16(bdf[ks + 1], cf[ks + 1], cb, 0, 0, 0); }
                    ca += cb;
                    ssd_decay_block(ca, c4, d4, cs_l, lb, l, hi, true);
                    u32x4 w0, w1;
                    w0.x = cvtpk(ca[0], ca[1]); w0.y = cvtpk(ca[2], ca[3]); w0.z = cvtpk(ca[4], ca[5]); w0.w = cvtpk(ca[6], ca[7]);
                    w1.x = cvtpk(ca[8], ca[9]); w1.y = cvtpk(ca[10], ca[11]); w1.z = cvtpk(ca[12], ca[13]); w1.w = cvtpk(ca[14], ca[15]);
                    acc = __builtin_amdgcn_mfma_f32_32x32x16_bf16(xf0, __builtin_bit_cast(bf16x8, w0), acc, 0, 0, 0);
                    acc = __builtin_amdgcn_mfma_f32_32x32x16_bf16(xf1, __builtin_bit_cast(bf16x8, w1), acc, 0, 0, 0);
                }
                {
                    f32x16 ya, yb;
#pragma unroll
                    for (int r = 0; r < 16; ++r) { ya[r] = 0.f; yb[r] = 0.f; }
#pragma unroll
                    for (int ks = 0; ks < 8; ks += 2) { ya = __builtin_amdgcn_mfma_f32_32x32x16_bf16(*(const LAS bf16x8*)(STin + (2 * ks + hi) * 512 + r32 * 16), cf[ks], ya, 0, 0, 0); yb = __builtin_amdgcn_mfma_f32_32x32x16_bf16(*(const LAS bf16x8*)(STin + (2 * ks + 2 + hi) * 512 + r32 * 16), cf[ks + 1], yb, 0, 0, 0); }
                    const float ecs = __expf(cs_l);
#pragma unroll
                    for (int r = 0; r < 16; ++r) acc[r] += (ya[r] + yb[r]) * ecs;
                }
                if (wave == 1) {
                    for (;;) { unsigned fl; asm volatile("ds_read_b32 %0, %1 offset:4\n\ts_waitcnt lgkmcnt(0)" : "=&v"(fl) : "v"((unsigned)(size_t)(ldsl + SSD_SYNC)) : "memory");
                        if (__builtin_amdgcn_readfirstlane(fl) >= (unsigned)(c + 1)) break; __builtin_amdgcn_s_sleep(1); }
                    asm volatile("" ::: "memory");
                    const LAS unsigned char* pp = ldsl + SSD_PART + lane * 64;
#pragma unroll
                    for (int q = 0; q < 4; ++q) { const f32x4 v = *(const LAS f32x4*)(pp + q * 16); acc[4 * q] += v[0]; acc[4 * q + 1] += v[1]; acc[4 * q + 2] += v[2]; acc[4 * q + 3] += v[3]; }
                }
                float yss = 0.f;
                {
                    LAS unsigned char* zrow = (LAS unsigned char*)(ldsl + (c % 3) * SSD_IN + SSD_Z) + l * 64 + 8 * hi;
                    u32x2 xw[4], zw[4];
#pragma unroll
                    for (int q = 0; q < 4; ++q) { xw[q] = *(const LAS u32x2*)(in + SSD_XS + l * 64 + (8 * q + 4 * hi) * 2); zw[q] = *(const LAS u32x2*)(zrow + 16 * q); }
#pragma unroll
                    for (int q = 0; q < 4; ++q) {
                        const float y0 = (acc[4 * q + 0] + dsk * bflo(xw[q].x)) * silu_fast(bflo(zw[q].x)), y1 = (acc[4 * q + 1] + dsk * bfhi(xw[q].x)) * silu_fast(bfhi(zw[q].x));
                        const float y2 = (acc[4 * q + 2] + dsk * bflo(xw[q].y)) * silu_fast(bflo(zw[q].y)), y3 = (acc[4 * q + 3] + dsk * bfhi(xw[q].y)) * silu_fast(bfhi(zw[q].y));
                        yss += (y0 * y0 + y1 * y1) + (y2 * y2 + y3 * y3);
                        u32x2 o; o.x = pk2(y0, y1); o.y = pk2(y2, y3);
                        *(LAS u32x2*)(zrow + 16 * q) = o;
                    }
                    asm volatile("s_waitcnt lgkmcnt(0)" ::: "memory");
                    const LAS unsigned char* zt = (const LAS unsigned char*)(ldsl + (c % 3) * SSD_IN + SSD_Z) + (32 * lb + (lane >> 2)) * 64 + (lane & 3) * 16;
                    bf16_t* yo = (bf16_t*)(p.ws + WS_MIXRAW) + (tb0 + (size_t)c * 64 + 32 * lb + (lane >> 2)) * DM + 1024 + h * 64 + ph * 32 + (lane & 3) * 8;
                    const u32x4 o0 = *(const LAS u32x4*)(zt), o1 = *(const LAS u32x4*)(zt + 16 * 64);
                    *(u32x4*)(yo) = o0; *(u32x4*)(yo + (size_t)16 * DM) = o1;
                }
                yss += __shfl_xor(yss, 32);
                if (hi == 0) ((float*)(p.ws + WS_PSQS))[(tb0 + (size_t)c * 64 + l) * 32 + h * 2 + ph] = yss;
            } else {
                const int nb = wave - 2;
                const float cs63 = csl[63];
                { const float dec = __expf(cs63);
#pragma unroll
                  for (int r = 0; r < 16; ++r) S[r] *= dec; }
                const int brow = 4 * hi + ((lane & 15) >> 2), bch = 4 * nb + 2 * ((lane >> 4) & 1) + ((lane & 3) >> 1);
                const unsigned xpa = (unsigned)(size_t)(in + xfo);
                const unsigned bpa = (unsigned)(size_t)(in + SSD_BM + brow * 256 + ((bch ^ brow) << 4) + (lane & 1) * 8);
                const unsigned bpb = (unsigned)(size_t)(in + SSD_BM + (brow + 8) * 256 + ((bch ^ (brow + 8)) << 4) + (lane & 1) * 8);
                s16x4 lo[4], hh[4], blo[4], bhh[4]; f32x4 c0[4], c1[4], d0[4], d1[4];
                TR_PAIR(lo[0], hh[0], xpa, SSD_XS + 0 * 1024, 512); TR_PAIR(lo[1], hh[1], xpa, SSD_XS + 1 * 1024, 512); TR_PAIR(lo[2], hh[2], xpa, SSD_XS + 2 * 1024, 512); TR_PAIR(lo[3], hh[3], xpa, SSD_XS + 3 * 1024, 512);
                asm volatile("ds_read_b64_tr_b16 %0, %1 offset:%c2" : "=&v"(blo[0]) : "v"(bpa), "i"(0 * 4096) : "memory"); asm volatile("ds_read_b64_tr_b16 %0, %1 offset:%c2" : "=&v"(bhh[0]) : "v"(bpb), "i"(0 * 4096) : "memory");
                asm volatile("ds_read_b64_tr_b16 %0, %1 offset:%c2" : "=&v"(blo[1]) : "v"(bpa), "i"(1 * 4096) : "memory"); asm volatile("ds_read_b64_tr_b16 %0, %1 offset:%c2" : "=&v"(bhh[1]) : "v"(bpb), "i"(1 * 4096) : "memory");
                asm volatile("ds_read_b64_tr_b16 %0, %1 offset:%c2" : "=&v"(blo[2]) : "v"(bpa), "i"(2 * 4096) : "memory"); asm volatile("ds_read_b64_tr_b16 %0, %1 offset:%c2" : "=&v"(bhh[2]) : "v"(bpb), "i"(2 * 4096) : "memory");
                asm volatile("ds_read_b64_tr_b16 %0, %1 offset:%c2" : "=&v"(blo[3]) : "v"(bpa), "i"(3 * 4096) : "memory"); asm volatile("ds_read_b64_tr_b16 %0, %1 offset:%c2" : "=&v"(bhh[3]) : "v"(bpb), "i"(3 * 4096) : "memory");
#pragma unroll
                for (int ks = 0; ks < 4; ++ks) { c0[ks] = *(const LAS f32x4*)(csl + 16 * ks + 4 * hi); c1[ks] = *(const LAS f32x4*)(csl + 16 * ks + 8 + 4 * hi);
                                                 d0[ks] = *(const LAS f32x4*)(dtl + 16 * ks + 4 * hi); d1[ks] = *(const LAS f32x4*)(dtl + 16 * ks + 8 + 4 * hi); }
                LDS_WAIT_PIN();
                u32x4 aw[4];
#pragma unroll
                for (int ks = 0; ks < 4; ++ks) {
                    float xf[8];
#pragma unroll
                    for (int j = 0; j < 4; ++j) { xf[j] = bf2f((unsigned short)lo[ks][j]) * __expf(cs63 - c0[ks][j]) * d0[ks][j]; xf[4 + j] = bf2f((unsigned short)hh[ks][j]) * __expf(cs63 - c1[ks][j]) * d1[ks][j]; }
                    aw[ks].x = cvtpk(xf[0], xf[1]); aw[ks].y = cvtpk(xf[2], xf[3]); aw[ks].z = cvtpk(xf[4], xf[5]); aw[ks].w = cvtpk(xf[6], xf[7]);
                }
#pragma unroll
                for (int ks = 0; ks < 4; ++ks)
                    S = __builtin_amdgcn_mfma_f32_32x32x16_bf16(__builtin_bit_cast(bf16x8, aw[ks]), (bf16x8){blo[ks][0], blo[ks][1], blo[ks][2], blo[ks][3], bhh[ks][0], bhh[ks][1], bhh[ks][2], bhh[ks][3]}, S, 0, 0, 0);
                const int n = 32 * nb + r32;
#pragma unroll
                for (int r = 0; r < 16; ++r) *(LAS unsigned short*)(STout + (n >> 3) * 512 + crow(r, hi) * 16 + (n & 7) * 2) = (unsigned short)f2bf(S[r]);
            }
        }
#undef SSD_ISSUE
#undef SSD_G16
    }
    asm volatile("s_waitcnt vmcnt(0) lgkmcnt(0)" ::: "memory");
    __builtin_amdgcn_s_barrier(); asm volatile("" ::: "memory");
}
constexpr size_t P5_DSL = (size_t)16384 * 128, P5_SSL = (size_t)16384 * 8;
constexpr int PD = 4;
template <int CTRL> __device__ __forceinline__ float dpp_xadd(float v) { return v + __builtin_bit_cast(float, __builtin_amdgcn_update_dpp(0, __builtin_bit_cast(int, v), CTRL, 0xf, 0xf, false)); }
#define P5_CVT(wd, bs) __builtin_amdgcn_cvt_scalef32_pk_f32_fp4((wd), 1.0f, (bs))
#define P5_LOAD16(dst, src) do { const u32x4* s_ = (const u32x4*)(src); const u32x4 a_ = s_[0], b_ = s_[1], c_ = s_[2], d_ = s_[3]; \
        dst[0] = a_.x; dst[1] = a_.y; dst[2] = a_.z; dst[3] = a_.w; dst[4] = b_.x; dst[5] = b_.y; dst[6] = b_.z; dst[7] = b_.w; \
        dst[8] = c_.x; dst[9] = c_.y; dst[10] = c_.z; dst[11] = c_.w; dst[12] = d_.x; dst[13] = d_.y; dst[14] = d_.z; dst[15] = d_.w; } while (0)
#define P5_ISSUE(slot, e) do { if constexpr (PV == 8) { const size_t e_ = (size_t)((unsigned)__builtin_amdgcn_readfirstlane((int)(e)) & 2047u); wq[slot] = *(const u32x4*)(TD + (e_ << 10) + g * 128 + q16); } \
        else if constexpr (PV == 2) { } else { wq[slot] = *(const u32x4*)(TD + (size_t)(((unsigned)(e) << 7) + q16)); } } while (0)
#define P5_SCB(e) ((unsigned)SC[(e) * 8u])
#define P5_SCALE(code) __builtin_bit_cast(float, ((code) << 20) + 0x33800000u)
#define P5_TABLE(off) do { const u32x4* src_ = (const u32x4*)(p.ws + (off) + (size_t)x * P5_SSL); \
        int k0_ = wave * 64 + lane; asm volatile("" : "+v"(k0_)); \
        for (int k_ = k0_; k_ < (int)(P5_SSL / 16); k_ += NTHR) ((LAS u32x4*)ldsl)[k_] = src_[k_]; __syncthreads(); } while (0)
template <int PV> __device__ __forceinline__ void ph_peer_u(const Params& p, LAS unsigned char* ldsl, int bid, int wave, int lane) {
    const int x = bid & 7, r = (bid >> 3) * NWAVES + wave, g = lane >> 3, q = lane & 7, colb = 32 * x + 4 * q;
    const unsigned char* TD = p.ws + WS_U4D + (size_t)x * P5_DSL; const unsigned q16 = q * 16; const LAS unsigned char* SC = ldsl + q;
    P5_TABLE(WS_U4S);
    const unsigned* IDX = (const unsigned*)(p.ws + WS_IDX) + g * 16; const bf16_t* XM = (const bf16_t*)(p.ws + WS_X1M) + colb; const float* PSQ = (const float*)(p.ws + WS_PSQX) + (lane & 31);
    float* PART = (float*)(p.ws + WS_PART) + (size_t)x * 128 + g * 16;
    unsigned ec[16], en[16]; u32x4 wq[PD]; unsigned sb; f32x2_t hf[16]; f32x4 sh[8]; u32x2 xn[8]; float pqn;
    {
        P5_LOAD16(ec, IDX + (size_t)r * 128);
        const float* shp = (const float*)(p.ws + WS_MOD) + 3 * DM + colb;
#pragma unroll
        for (int j = 0; j < 8; ++j) sh[j] = *(const f32x4*)(shp + j * 256);
        float pq = PSQ[(size_t)r * 32]; pq = dpp_xadd<0xB1>(pq); pq = dpp_xadd<0x4E>(pq); pq = dpp_xadd<0x141>(pq); pq = dpp_xadd<0x140>(pq); pq += __shfl_xor(pq, 16);
        const float r2 = rsqrtf(pq * (1.f / DM) + EPS);
#pragma unroll
        for (int j = 0; j < 8; ++j) { const u32x2 a = *(const u32x2*)(XM + (size_t)r * DM + j * 256);
            hf[2 * j] = (f32x2_t){bflo(a.x) * r2 + sh[j][0], bfhi(a.x) * r2 + sh[j][1]}; hf[2 * j + 1] = (f32x2_t){bflo(a.y) * r2 + sh[j][2], bfhi(a.y) * r2 + sh[j][3]}; }
#pragma unroll
        for (int i = 0; i < PD; ++i) P5_ISSUE(i, ec[i]);
        sb = P5_SCB(ec[0]);
    }
    auto tok = [&](unsigned (&ec)[16], unsigned (&en)[16], const int n) __attribute__((always_inline)) {
        const int t = r + 256 * n, tn = r + 256 * min(n + 1, 63);
        P5_LOAD16(en, IDX + (size_t)tn * 128);
#pragma unroll
        for (int j = 0; j < 8; ++j) xn[j] = *(const u32x2*)(XM + (size_t)tn * DM + j * 256);
        pqn = PSQ[(size_t)tn * 32];
        if (((n + 1) & 7) == 0 && n < 63) {
            const float* shp = (const float*)(p.ws + WS_MOD) + (size_t)((n + 1) >> 3) * 6 * DM + 3 * DM + colb;
#pragma unroll
            for (int j = 0; j < 8; ++j) sh[j] = *(const f32x4*)(shp + j * 256);
        }
        float sp[16];
#pragma unroll
        for (int i = 0; i < 16; ++i) {
            __builtin_amdgcn_sched_barrier(0);
            const u32x4 w = wq[i % PD];
            if (i + PD < 16) P5_ISSUE(i % PD, ec[(i + PD) & 15]); else P5_ISSUE(i % PD, en[(i + PD) & 15]);
            const unsigned sbn = P5_SCB((i < 15) ? ec[(i + 1) & 15] : en[0]);
            const float scl = P5_SCALE(sb); sb = sbn;
            f32x2_t a2 = (f32x2_t){0.f, 0.f}, b2 = (f32x2_t){0.f, 0.f};
            a2 += P5_CVT(w.x, 0) * hf[0]; b2 += P5_CVT(w.x, 1) * hf[1]; a2 += P5_CVT(w.x, 2) * hf[2]; b2 += P5_CVT(w.x, 3) * hf[3];
            a2 += P5_CVT(w.y, 0) * hf[4]; b2 += P5_CVT(w.y, 1) * hf[5]; a2 += P5_CVT(w.y, 2) * hf[6]; b2 += P5_CVT(w.y, 3) * hf[7];
            a2 += P5_CVT(w.z, 0) * hf[8]; b2 += P5_CVT(w.z, 1) * hf[9]; a2 += P5_CVT(w.z, 2) * hf[10]; b2 += P5_CVT(w.z, 3) * hf[11];
            a2 += P5_CVT(w.w, 0) * hf[12]; b2 += P5_CVT(w.w, 1) * hf[13]; a2 += P5_CVT(w.w, 2) * hf[14]; b2 += P5_CVT(w.w, 3) * hf[15];
            a2 += b2;
            float a = (a2.x + a2.y) * scl;
            asm volatile("" : "+v"(a));
            sp[i] = a;
        }
        {
            float r8[8], r4[4], r2[2];
            { const bool hi = (q & 4) != 0;
#pragma unroll
              for (int k = 0; k < 8; ++k) { const float keep = hi ? sp[k + 8] : sp[k], send = hi ? sp[k] : sp[k + 8]; r8[k] = keep + __builtin_bit_cast(float, __builtin_amdgcn_update_dpp(0, __builtin_bit_cast(int, send), 0x141, 0xf, 0xf, false)); } }
            { const bool hi = (q & 2) != 0;
#pragma unroll
              for (int k = 0; k < 4; ++k) { const float keep = hi ? r8[k + 4] : r8[k], send = hi ? r8[k] : r8[k + 4]; r4[k] = keep + __builtin_bit_cast(float, __builtin_amdgcn_update_dpp(0, __builtin_bit_cast(int, send), 0x4E, 0xf, 0xf, false)); } }
            { const bool hi = (q & 1) != 0;
#pragma unroll
              for (int k = 0; k < 2; ++k) { const float keep = hi ? r4[k + 2] : r4[k], send = hi ? r4[k] : r4[k + 2]; r2[k] = keep + __builtin_bit_cast(float, __builtin_amdgcn_update_dpp(0, __builtin_bit_cast(int, send), 0xB1, 0xf, 0xf, false)); } }
            *(f32x2_t*)(PART + (size_t)t * 1024 + 2 * q) = (f32x2_t){r2[0], r2[1]};
        }
        { float pq = pqn; pq = dpp_xadd<0xB1>(pq); pq = dpp_xadd<0x4E>(pq); pq = dpp_xadd<0x141>(pq); pq = dpp_xadd<0x140>(pq); pq += __shfl_xor(pq, 16);
          const float r2 = rsqrtf(pq * (1.f / DM) + EPS);
#pragma unroll
          for (int j = 0; j < 8; ++j) { const u32x2 a = xn[j];
              hf[2 * j] = (f32x2_t){bflo(a.x) * r2 + sh[j][0], bfhi(a.x) * r2 + sh[j][1]}; hf[2 * j + 1] = (f32x2_t){bflo(a.y) * r2 + sh[j][2], bfhi(a.y) * r2 + sh[j][3]}; }
        }
    };
    for (int n = 0; n < 64; n += 2) { tok(ec, en, n); tok(en, ec, n + 1); }
}
__device__ __forceinline__ void ph_peer_s(const Params& p, int gwave, int gnw, int lane) {
    for (int t = gwave; t < T; t += gnw) {
        const float* pp = (const float*)(p.ws + WS_PART) + (size_t)t * 1024 + lane * 2; float* gp = (float*)(p.ws + WS_GATE) + (size_t)t * 128 + lane * 2;
        f32x2_t s = *(const f32x2_t*)pp;
#pragma unroll
        for (int x = 1; x < 8; ++x) s += *(const f32x2_t*)(pp + x * 128);
        const f32x2_t gt = *(const f32x2_t*)gp;
        *(f32x2_t*)gp = (f32x2_t){0.5f * s.x * (1.f + erff(s.x * 0.70710678118654752f)) * gt.x, 0.5f * s.y * (1.f + erff(s.y * 0.70710678118654752f)) * gt.y};
    }
}
template <int PV> __device__ __forceinline__ void ph_peer_v(const Params& p, LAS unsigned char* ldsl, int bid, int wave, int lane) {
    const int x = bid & 7, r = (bid >> 3) * NWAVES + wave, g = lane >> 3, q = lane & 7, col = 256 * g + 32 * x + 4 * q;
    const unsigned char* TD = p.ws + WS_V4D + (size_t)x * P5_DSL; const unsigned q16 = q * 16; const LAS unsigned char* SC = ldsl + q;
    P5_TABLE(WS_V4S);
    const unsigned* IDX = (const unsigned*)(p.ws + WS_IDX) + g * 16; const unsigned* CF = (const unsigned*)(p.ws + WS_GATE) + g * 16;
    unsigned ec[16], en[16], cc[16], cn[16]; u32x4 wq[PD]; unsigned sb;
    if constexpr (PV == 2) {
#pragma unroll
        for (int i = 0; i < PD; ++i) { wq[i] = (u32x4){0x12345678u + lane, 0x9abcdef0u, 0x13572468u, 0x2468ace0u}; asm volatile("" : "+v"(wq[i])); } }
    P5_LOAD16(ec, IDX + (size_t)r * 128); P5_LOAD16(cc, CF + (size_t)r * 128);
#pragma unroll
    for (int i = 0; i < PD; ++i) P5_ISSUE(i, ec[i]);
    sb = P5_SCB(ec[0]);
    auto tok = [&](unsigned (&ec)[16], unsigned (&en)[16], unsigned (&cc)[16], unsigned (&cn)[16], const int n) __attribute__((always_inline)) {
        const int t = r + 256 * n, tn = r + 256 * min(n + 1, 63), b = n >> 3;
        P5_LOAD16(en, IDX + (size_t)tn * 128); P5_LOAD16(cn, CF + (size_t)tn * 128);
        const u32x2 xm = *(const u32x2*)((const bf16_t*)(p.ws + WS_X1M) + (size_t)t * DM + col);
        const f32x4 ga = *(const f32x4*)((const float*)(p.ws + WS_MOD) + (size_t)b * 6 * DM + 5 * DM + col), sc = *(const f32x4*)((const float*)(p.ws + WS_MOD) + (size_t)b * 6 * DM + 4 * DM + col);
        f32x2_t out[16];
#pragma unroll
        for (int i = 0; i < 16; ++i) {
            __builtin_amdgcn_sched_barrier(0);
            u32x4 w = wq[i % PD]; if constexpr (PV == 2) asm volatile("" : "+v"(w));
            if (i + PD < 16) P5_ISSUE(i % PD, ec[(i + PD) & 15]); else P5_ISSUE(i % PD, en[(i + PD) & 15]);
            const unsigned sbn = P5_SCB((i < 15) ? ec[(i + 1) & 15] : en[0]);
            const float a = __builtin_bit_cast(float, cc[i]) * P5_SCALE(sb); sb = sbn;
            f32x2_t aa = (f32x2_t){a, a}; asm volatile("" : "+v"(aa));
            if (i == 0) {
                out[0] = aa * P5_CVT(w.x, 0); out[1] = aa * P5_CVT(w.x, 1); out[2] = aa * P5_CVT(w.x, 2); out[3] = aa * P5_CVT(w.x, 3);
                out[4] = aa * P5_CVT(w.y, 0); out[5] = aa * P5_CVT(w.y, 1); out[6] = aa * P5_CVT(w.y, 2); out[7] = aa * P5_CVT(w.y, 3);
                out[8] = aa * P5_CVT(w.z, 0); out[9] = aa * P5_CVT(w.z, 1); out[10] = aa * P5_CVT(w.z, 2); out[11] = aa * P5_CVT(w.z, 3);
                out[12] = aa * P5_CVT(w.w, 0); out[13] = aa * P5_CVT(w.w, 1); out[14] = aa * P5_CVT(w.w, 2); out[15] = aa * P5_CVT(w.w, 3);
            } else {
            out[0] += aa * P5_CVT(w.x, 0); out[1] += aa * P5_CVT(w.x, 1); out[2] += aa * P5_CVT(w.x, 2); out[3] += aa * P5_CVT(w.x, 3);
            out[4] += aa * P5_CVT(w.y, 0); out[5] += aa * P5_CVT(w.y, 1); out[6] += aa * P5_CVT(w.y, 2); out[7] += aa * P5_CVT(w.y, 3);
            asm volatile("" : "+v"(out[0]), "+v"(out[1]), "+v"(out[2]), "+v"(out[3]), "+v"(out[4]), "+v"(out[5]), "+v"(out[6]), "+v"(out[7]));
            out[8] += aa * P5_CVT(w.z, 0); out[9] += aa * P5_CVT(w.z, 1); out[10] += aa * P5_CVT(w.z, 2); out[11] += aa * P5_CVT(w.z, 3);
            out[12] += aa * P5_CVT(w.w, 0); out[13] += aa * P5_CVT(w.w, 1); out[14] += aa * P5_CVT(w.w, 2); out[15] += aa * P5_CVT(w.w, 3);
            asm volatile("" : "+v"(out[8]), "+v"(out[9]), "+v"(out[10]), "+v"(out[11]), "+v"(out[12]), "+v"(out[13]), "+v"(out[14]), "+v"(out[15]));
            }
        }
        f32x2_t o8[8], o4[4], o2[2];
#define P5_SW(fn, a_, b_, d_) do { float x_ = a_, y_ = b_; asm volatile("s_nop 1\n\t" fn " %0, %1" : "+v"(x_), "+v"(y_)); d_ = x_ + y_; } while (0)
#pragma unroll
        for (int k = 0; k < 8; ++k) { P5_SW("v_permlane32_swap_b32", out[k].x, out[k + 8].x, o8[k].x); P5_SW("v_permlane32_swap_b32", out[k].y, out[k + 8].y, o8[k].y); }
#pragma unroll
        for (int k = 0; k < 4; ++k) { P5_SW("v_permlane16_swap_b32", o8[k].x, o8[k + 4].x, o4[k].x); P5_SW("v_permlane16_swap_b32", o8[k].y, o8[k + 4].y, o4[k].y); }
#undef P5_SW
        { const bool hi = (lane & 8) != 0;
#pragma unroll
          for (int k = 0; k < 2; ++k) { const f32x2_t keep = hi ? o4[k + 2] : o4[k], send = hi ? o4[k] : o4[k + 2]; o2[k] = keep + (f32x2_t){__shfl_xor(send.x, 8), __shfl_xor(send.y, 8)}; } }
        *(f32x4*)(p.out + (size_t)t * DM + col) = (f32x4){bflo(xm.x) * __builtin_amdgcn_rcpf(1.f + sc.x) + ga.x * o2[0].x, bfhi(xm.x) * __builtin_amdgcn_rcpf(1.f + sc.y) + ga.y * o2[0].y,
                                                          bflo(xm.y) * __builtin_amdgcn_rcpf(1.f + sc.z) + ga.z * o2[1].x, bfhi(xm.y) * __builtin_amdgcn_rcpf(1.f + sc.w) + ga.w * o2[1].y};
    };
    for (int n = 0; n < 64; n += 2) { tok(ec, en, cc, cn, n); tok(en, ec, cn, cc, n + 1); }
}
#undef P5_CVT
#undef P5_LOAD16
#undef P5_ISSUE
#undef P5_SCB
#undef P5_SCALE
#undef P5_TABLE
constexpr int RING_BYTES = 131072, LDSCTL_OFF = 146432, MISC_OFF = LDSCTL_OFF + 320, LDS_BYTES = 147456;
static_assert(SSD_SYNC + 64 <= LDSCTL_OFF, "SSD LDS map");
constexpr int NPH = 15;
#ifndef MK_PER_PHASE
#define MK_PER_PHASE 0
#endif

__global__ void __launch_bounds__(NTHR, 2) mega(Params p) {
    extern __shared__ __attribute__((aligned(16))) unsigned char lds[];
    LAS unsigned char* ldsl = (LAS unsigned char*)lds;
    const int tid = threadIdx.x, lane = tid & 63, wave = __builtin_amdgcn_readfirstlane(tid >> 6);
    const int G = gridDim.x, bid = blockIdx.x;
    unsigned char* ws = p.ws;
    gu32* ctl = (gu32*)(ws + WS_CTL);
    for (int u = tid; u < (LDS_BYTES - LDSCTL_OFF) / 4; u += NTHR) ((LAS unsigned*)(ldsl + LDSCTL_OFF))[u] = 0u;
    __syncthreads();
    volatile LAS unsigned* MISC = (volatile LAS unsigned*)(ldsl + MISC_OFF);
    XcdBarrier bar; bar.bar = (unsigned*)(ctl + CW_BAR); bar.x = 0; bar.st = nullptr;
    if (!MK_PER_PHASE) bar = xcd_barrier_post((unsigned*)(ctl + CW_BAR), MISC + 8);
#define IN(k) (p.ph_lo <= (k) && (k) < p.ph_hi)
#define LN() ({ int l_ = lane; asm volatile("" : "+v"(l_)); l_; })
#define WV() ({ int w_ = wave; asm volatile("" : "+s"(w_)); w_; })
#define SEAM(k) do { if ((k) + 1 < p.ph_hi) xcd_barrier(bar); } while (0)
    const int gtid = bid * NTHR + tid, gn = G * NTHR, gwave = bid * NWAVES + wave, gnw = G * NWAVES;
    float* mod = (float*)(ws + WS_MOD);

    if (IN(0)) {
        if (bid < 96) ph_mod(p, lds, tid, bid);
        else ph_transposes(p, lds, WV(), LN(), (bid - 96) * NWAVES + wave, (G - 96) * NWAVES);
        ph_rope_tab(p, gtid, gn);
        ph_convert(p.sub_keys, (bf16_t*)(ws + WS_SUBK), (size_t)8 * 2 * 128 * 128 / 4, gtid, gn);
        SEAM(0);
    }
    if (IN(1)) { ph_modrows(p.x, (bf16_t*)(ws + WS_H), mod, 0, 1, gwave, gnw, LN()); ph_bias2(p, gwave, gnw, LN()); SEAM(1); }
    if (IN(2)) {
        pg8::Gemm g{(const bf16_t*)(ws + WS_H), (const bf16_t*)(ws + WS_WINT), T, NPROJ, DM, DM}; pg8::StaticOrder S; S.init(T, NPROJ, G, bid);
        pg8::EpiBf16<0> E{(bf16_t*)(ws + WS_PROJ), NPROJ, nullptr, 0, 0, 1.f};
        pg8::gemm_phase<pg8::EpiBf16<0>, pg8::StaticOrder, true, true>(ldsl, g, S, E);
        SEAM(2);
    }
    if (IN(3)) {
        { pg8::Gemm g{(const bf16_t*)(ws + WS_PROJ) + C_CQ, (const bf16_t*)(ws + WS_WUQT), T, NQ, 512, NPROJ}; pg8::StaticOrder S; S.init(T, NQ, G, bid);
          pg8::EpiBf16<0> E{(bf16_t*)(ws + WS_QRAW), NQ, nullptr, 0, 0, 1.f};
          pg8::gemm_phase<pg8::EpiBf16<0>, pg8::StaticOrder, true, true>(ldsl, g, S, E); }
        { pg8::Gemm g{(const bf16_t*)(ws + WS_PROJ) + C_CKV, (const bf16_t*)(ws + WS_WUKVT), T, NKV, 256, NPROJ}; pg8::SkewOrder S; S.init(T, NKV, G, bid);
          pg8::EpiBf16<0> E{(bf16_t*)(ws + WS_KVRAW), NKV, nullptr, 0, 0, 1.f};
          pg8::gemm_phase<pg8::EpiBf16<0>, pg8::SkewOrder, true, true>(ldsl, g, S, E); }
        SEAM(3);
    }
    if (IN(4)) { ph_qkv_post(p, gwave, gnw, LN()); ph_conv(p, gwave, gnw, LN()); SEAM(4); }
    if (IN(5)) { ph_attn(p, ldsl, bid, G, WV(), LN()); ph_ssd(p, ldsl, bid, WV(), LN()); SEAM(5); }
    if (IN(8)) {
        pg8::Gemm g{(const bf16_t*)(ws + WS_MIXRAW), (const bf16_t*)(ws + WS_WOUTT), T, DM, DM, DM}; pg8::StaticOrder S; S.init(T, DM, G, bid);
        pg8::Unit u0, u1; S.next(0, u0); if (!S.next(1, u1)) u1 = u0;
        LAS float* kt = (LAS float*)(ldsl + RING_BYTES);
        { const int slot = tid >> 8, r = tid & 255, row = (slot ? u1.pm : u0.pm) * 256 + r;
          const f32x4* pa = (const f32x4*)((const float*)(ws + WS_PSQA) + (size_t)row * 8); const f32x4* ps = (const f32x4*)((const float*)(ws + WS_PSQS) + (size_t)row * 32);
          const f32x4 a0 = pa[0], a1 = pa[1]; float sa = ((a0[0] + a0[1]) + (a0[2] + a0[3])) + ((a1[0] + a1[1]) + (a1[2] + a1[3])), s0 = 0.f, s1 = 0.f;
#pragma unroll
          for (int q = 0; q < 4; ++q) { const f32x4 v = ps[q], w = ps[4 + q]; s0 += (v[0] + v[1]) + (v[2] + v[3]); s1 += (w[0] + w[1]) + (w[2] + w[3]); }
          const float ra = rsqrtf(sa * (1.f / 1024.f) + EPS), r0 = rsqrtf(s0 * (1.f / 512.f) + EPS), r1 = rsqrtf(s1 * (1.f / 512.f) + EPS);
          kt[tid * 4 + 0] = ra / r0; kt[tid * 4 + 1] = r0 / r1; kt[tid * 4 + 2] = r1; kt[tid * 4 + 3] = 0.f; }
        __syncthreads();
        pg8::EpiX1 E{p.x, mod, (bf16_t*)(ws + WS_X1M), (float*)(ws + WS_PSQX), DM, SEQ, kt, u0.pm};
        pg8::gemm_phase<pg8::EpiX1, pg8::StaticOrder, true, true>(ldsl, g, S, E);
        SEAM(8);
    }
    if (IN(10)) {
        pg8::Gemm g{(const bf16_t*)(ws + WS_X1M), (const bf16_t*)(ws + WS_WQT), T, DM, DM, DM}; pg8::StaticOrder S; S.init(T, DM, G, bid);
        pg8::Unit u0, u1; S.next(0, u0); if (!S.next(1, u1)) u1 = u0;
        LAS float* rt = (LAS float*)(ldsl + RING_BYTES);
        { const int slot = tid >> 8, r = tid & 255, row = (slot ? u1.pm : u0.pm) * 256 + r; const f32x4* pq = (const f32x4*)((const float*)(ws + WS_PSQX) + (size_t)row * 32); float s_ = 0.f;
#pragma unroll
          for (int q = 0; q < 8; ++q) { const f32x4 v = pq[q]; s_ += (v[0] + v[1]) + (v[2] + v[3]); }
          rt[tid] = rsqrtf(s_ * (1.f / DM) + EPS); }
        __syncthreads();
        pg8::EpiScaleBias E{(bf16_t*)(ws + WS_QP), DM, (const float*)(ws + WS_BIAS2), SEQ, rt, u0.pm};
        pg8::gemm_phase<pg8::EpiScaleBias, pg8::StaticOrder, true, true>(ldsl, g, S, E);
        SEAM(10);
    }
    if (IN(11)) { ph_route(p, ldsl, WV(), LN(), gwave, gnw); SEAM(11); }
    if (IN(12)) { ph_peer_u<0>(p, ldsl, bid, WV(), LN()); SEAM(12); }
    if (IN(13)) { ph_peer_s(p, gwave, gnw, LN()); SEAM(13); }
#ifdef PROBE_EMASK
    if (IN(14)) { if (p.emask == 2) ph_peer_v<2>(p, ldsl, bid, WV(), LN()); else if (p.emask == 8) ph_peer_v<8>(p, ldsl, bid, WV(), LN()); else ph_peer_v<0>(p, ldsl, bid, WV(), LN()); }
#else
    if (IN(14)) { ph_peer_v<0>(p, ldsl, bid, WV(), LN()); }
#endif
#ifdef PROBE_VALU
    if (IN(14)) {
        f32x2_t a0 = {1.f, 2.f}, a1 = a0, a2 = a0, a3 = a0; unsigned w = (unsigned)lane * 0x9E3779B9u; f32x2_t m = {1.0001f, 0.9999f};
        asm volatile("" : "+v"(w), "+v"(m));
        for (int i = 0; i < 400; ++i) {
#if PROBE_VALU == 1
#define PV4 "v_cvt_scalef32_pk_f32_fp4 %0, %4, 1.0\n v_cvt_scalef32_pk_f32_fp4 %1, %4, 1.0 op_sel:[1,0,0]\n v_cvt_scalef32_pk_f32_fp4 %2, %4, 1.0 op_sel:[0,1,0]\n v_cvt_scalef32_pk_f32_fp4 %3, %4, 1.0 op_sel:[1,1,0]\n"
            asm volatile(PV4 PV4 PV4 PV4 PV4 PV4 PV4 PV4 PV4 PV4 PV4 PV4 PV4 PV4 PV4 PV4 : "=&v"(a0), "=&v"(a1), "=&v"(a2), "=&v"(a3) : "v"(w));
#elif PROBE_VALU == 2
#define PV4 "v_pk_fma_f32 %0, %0, %4, %4\n v_pk_fma_f32 %1, %1, %4, %4\n v_pk_fma_f32 %2, %2, %4, %4\n v_pk_fma_f32 %3, %3, %4, %4\n"
            asm volatile(PV4 PV4 PV4 PV4 PV4 PV4 PV4 PV4 PV4 PV4 PV4 PV4 PV4 PV4 PV4 PV4 : "+v"(a0), "+v"(a1), "+v"(a2), "+v"(a3) : "v"(m));
#elif PROBE_VALU == 4
#define PV4 "v_pk_fma_f32 %0, %4, %5, %0\n v_pk_fma_f32 %1, %5, %6, %1\n v_pk_fma_f32 %2, %6, %4, %2\n v_pk_fma_f32 %3, %4, %6, %3\n"
            { f32x2_t m1 = m * 1.5f, m2 = m * 0.25f; asm volatile("" : "+v"(m1), "+v"(m2));
              asm volatile(PV4 PV4 PV4 PV4 PV4 PV4 PV4 PV4 PV4 PV4 PV4 PV4 PV4 PV4 PV4 PV4 : "+v"(a0), "+v"(a1), "+v"(a2), "+v"(a3) : "v"(m), "v"(m1), "v"(m2)); }
#elif PROBE_VALU == 5
#define PV4 "v_cvt_scalef32_pk_f32_fp4 %1, %4, 1.0\n v_pk_fma_f32 %0, %5, %1, %0\n v_cvt_scalef32_pk_f32_fp4 %1, %4, 1.0 op_sel:[1,0,0]\n v_pk_fma_f32 %0, %6, %1, %0\n"
            { f32x2_t m1 = m * 1.5f, m2 = m * 0.25f; asm volatile("" : "+v"(m1), "+v"(m2));
              asm volatile(PV4 PV4 PV4 PV4 PV4 PV4 PV4 PV4 PV4 PV4 PV4 PV4 PV4 PV4 PV4 PV4 : "+v"(a0), "=&v"(a1) : "v"(a2), "v"(a3), "v"(w), "v"(m1), "v"(m2)); }
#elif PROBE_VALU == 6
#define PV4 "v_cvt_scalef32_pk_f32_fp4 %1, %4, 1.0\n v_pk_fma_f32 %0, %5, %1, %0 op_sel_hi:[0,1,1]\n v_cvt_scalef32_pk_f32_fp4 %1, %4, 1.0 op_sel:[1,0,0]\n v_pk_fma_f32 %2, %5, %1, %2 op_sel_hi:[0,1,1]\n"
            { f32x2_t m1 = m * 1.5f; asm volatile("" : "+v"(m1));
              asm volatile(PV4 PV4 PV4 PV4 PV4 PV4 PV4 PV4 PV4 PV4 PV4 PV4 PV4 PV4 PV4 PV4 : "+v"(a0), "=&v"(a1), "+v"(a2) : "v"(a3), "v"(w), "v"(m1)); }
#else
#define PV4 "v_fma_f32 %0, %0, %4, %4\n v_fma_f32 %1, %1, %4, %4\n v_fma_f32 %2, %2, %4, %4\n v_fma_f32 %3, %3, %4, %4\n"
            { float b0 = a0.x, b1 = a1.x, b2 = a2.x, b3 = a3.x, mm = m.x;
              asm volatile(PV4 PV4 PV4 PV4 PV4 PV4 PV4 PV4 PV4 PV4 PV4 PV4 PV4 PV4 PV4 PV4 : "+v"(b0), "+v"(b1), "+v"(b2), "+v"(b3) : "v"(mm)); a0.x = b0; a1.x = b1; a2.x = b2; a3.x = b3; }
#endif
        }
    }
#endif
#undef IN
#undef SEAM
}

extern "C" void kernel_launch(void* const* d_in, const int* in_sizes, int n_in, void* d_out, int out_size, void* d_ws, size_t ws_size, hipStream_t stream) {
    static int grid = 0;
    if (grid == 0) {
        if (n_in != 24 || ws_size < WS_END) { fprintf(stderr, "kernel_launch: unexpected inputs / workspace (%d, %zu)\n", n_in, ws_size); grid = -1; return; }
        if (hipFuncSetAttribute((const void*)mega, hipFuncAttributeMaxDynamicSharedMemorySize, LDS_BYTES) != hipSuccess) { fprintf(stderr, "kernel_launch: hipFuncSetAttribute failed\n"); grid = -1; return; }
        (void)hipGetLastError();
        grid = 256;
    }
    if (grid < 0) return;
    (void)hipMemsetAsync((char*)d_ws + WS_CTL, 0, CTL_ZERO_BYTES, stream);
    Params p{};
    p.x = (const float*)d_in[0]; p.c = (const float*)d_in[1]; p.pos = (const int*)d_in[2]; p.w_ada = (const float*)d_in[3]; p.b_ada = (const float*)d_in[4];
    p.w_in = (const float*)d_in[5]; p.q_a_norm = (const float*)d_in[6]; p.w_uq = (const float*)d_in[7]; p.kv_a_norm = (const float*)d_in[8]; p.w_ukv = (const float*)d_in[9];
    p.q_norm = (const float*)d_in[10]; p.k_norm = (const float*)d_in[11]; p.attn_out_norm = (const float*)d_in[12]; p.conv_w = (const float*)d_in[13]; p.conv_b = (const float*)d_in[14];
    p.dt_bias = (const float*)d_in[15]; p.a_log = (const float*)d_in[16]; p.d_skip = (const float*)d_in[17]; p.ssd_norm = (const float*)d_in[18]; p.w_out = (const float*)d_in[19];
    p.w_query = (const float*)d_in[20]; p.sub_keys = (const float*)d_in[21]; p.u_exp = (const float*)d_in[22]; p.v_exp = (const float*)d_in[23];
    p.out = (float*)d_out; p.ws = (unsigned char*)d_ws;
#if MK_PER_PHASE
    for (int ph = 0; ph < NPH; ++ph) { p.ph_lo = ph; p.ph_hi = ph + 1; hipLaunchKernelGGL(mega, dim3(grid), dim3(NTHR), LDS_BYTES, stream, p); }
#elif defined(PROBE_SEQ)
    { const int seq[] = {PROBE_SEQ}; const int nl = (int)(sizeof(seq) / sizeof(int)) / 2;
      for (int li = 0; li < nl; ++li) { if (li) (void)hipMemsetAsync((char*)d_ws + WS_CTL, 0, CTL_ZERO_BYTES, stream);
          p.ph_lo = seq[2 * li]; p.ph_hi = seq[2 * li + 1];
#ifdef PROBE_EMASK
          p.emask = (li == 1) ? (PROBE_EMASK) : 0;
#endif
          hipLaunchKernelGGL(mega, dim3(grid), dim3(NTHR), LDS_BYTES, stream, p); } }
#else
    p.ph_lo = 0; p.ph_hi = NPH;
    hipLaunchKernelGGL(mega, dim3(grid), dim3(NTHR), LDS_BYTES, stream, p);
#endif
}
```

```cpp
#include <hip/hip_runtime.h>
#include <cstdint>
#include <cstdio>
#include <cmath>

constexpr int DM = 2048, NB = 8, SEQ = 2048, T = NB * SEQ;
constexpr int IN_COLS = 3408, NPROJ = 3584;
constexpr int C_CQ = 0, C_CKV = 512, C_KR = 768, C_Z = 832, C_XBC = 1856, C_DT = 3392;
constexpr int NQ = 1536, NKV = 2048;
constexpr float EPS = 1e-6f;
constexpr int NTHR = 512, NWAVES = 8;

typedef unsigned short bf16_t;
typedef unsigned u32x4 __attribute__((ext_vector_type(4)));
typedef float f32x4 __attribute__((ext_vector_type(4)));
typedef unsigned u32x2 __attribute__((ext_vector_type(2)));
#define GAS __attribute__((address_space(1)))
#define LAS __attribute__((address_space(3)))
typedef GAS unsigned gu32;
typedef GAS unsigned long long gu64;
#define RLX_AGENT __ATOMIC_RELAXED, __HIP_MEMORY_SCOPE_AGENT

__device__ __forceinline__ unsigned f2bf(float f) { unsigned u = __builtin_bit_cast(unsigned, f); return (u + 0x7fffu + ((u >> 16) & 1u)) >> 16; }
__device__ __forceinline__ float bf2f(unsigned h) { return __builtin_bit_cast(float, h << 16); }
__device__ __forceinline__ unsigned pk2(float lo, float hi) { return f2bf(lo) | (f2bf(hi) << 16); }
__device__ __forceinline__ float bflo(unsigned w) { return __builtin_bit_cast(float, w << 16); }
__device__ __forceinline__ float bfhi(unsigned w) { return __builtin_bit_cast(float, w & 0xffff0000u); }
__device__ __forceinline__ float silu_f(float v) { return v / (1.f + __expf(-v)); }
__device__ __forceinline__ float wave_sum(float v) {
#pragma unroll
    for (int o = 1; o < 64; o <<= 1) v += __shfl_xor(v, o);
    return v;
}

constexpr size_t MiB = 1u << 20;
constexpr size_t WS_CTL = 0, CTL_ZERO_BYTES = 64 * 1024, WS_MOD = 1 * MiB, WS_ROPEC = 2 * MiB, WS_ROPES = 4 * MiB, WS_SUBK = 6 * MiB, WS_WUQT = 7 * MiB, WS_WUKVT = 9 * MiB,
                 WS_WINT = 10 * MiB, WS_WOUTT = 24 * MiB, WS_WQT = 32 * MiB,
                 WS_US = 40 * MiB, WS_VS = 41 * MiB, WS_PSQX = 42 * MiB, WS_BIAS2 = 44 * MiB, WS_RINV2 = 44 * MiB + 512 * 1024, WS_PSQA = 45 * MiB, WS_PSQS = 46 * MiB, WS_CS = 50 * MiB, WS_DT = 51 * MiB, WS_IDX = 52 * MiB, WS_GATE = 60 * MiB, WS_U16 = 68 * MiB, WS_V16 = 132 * MiB, WS_U8 = 68 * MiB, WS_V8 = 100 * MiB, WS_MIXRAW = 372 * MiB, WS_U4D = 436 * MiB, WS_U4S = 452 * MiB, WS_V4D = 456 * MiB, WS_V4S = 472 * MiB, WS_PART = 196 * MiB,
                 WS_K = 68 * MiB, WS_YSSD = 68 * MiB, WS_XBCA = 116 * MiB, WS_ATTN = 164 * MiB,
                 WS_H = 196 * MiB, WS_Q = 196 * MiB, WS_MIXIN = 196 * MiB, WS_H2 = 196 * MiB, WS_X1M = 68 * MiB,
                 WS_PROJ = 260 * MiB, WS_QP = 260 * MiB, WS_QRAW = 372 * MiB, WS_KVRAW = 420 * MiB, WS_V = 484 * MiB, WS_END = 516 * MiB;
constexpr int CW_BAR = 1024;

struct Params {
    const float *x, *c; const int* pos;
    const float *w_ada, *b_ada, *w_in, *q_a_norm, *w_uq, *kv_a_norm, *w_ukv, *q_norm, *k_norm, *attn_out_norm, *conv_w, *conv_b, *dt_bias, *a_log,
        *d_skip, *ssd_norm, *w_out, *w_query, *sub_keys, *u_exp, *v_exp;
    float* out; unsigned char* ws;
    int ph_lo, ph_hi;
#ifdef PROBE_EMASK
    int emask;
#endif
};
namespace pg8 {
#define PG8_LAS __attribute__((address_space(3)))
typedef unsigned short bf16_t;
typedef short bf16x8 __attribute__((ext_vector_type(8)));
typedef float f32x4 __attribute__((ext_vector_type(4)));
typedef unsigned u32x4 __attribute__((ext_vector_type(4)));
constexpr int BM = 256, BK = 64, HALF = 128, HTB = HALF * BK * 2  , STAGE_BYTES = 8 * HTB, NXCD = 8, WGM = 32;

__host__ __device__ __forceinline__ int lds_byte(int r, int c) { const int st = (r >> 4) * 2 + (c >> 5), rr = r & 15, cc = c & 31, ob = rr * 64 + cc * 2; return st * 1024 + (ob ^ (((ob >> 9) & 1) << 5)); }
__host__ __device__ __forceinline__ void stage_rc(int b, int& R, int& C) { const int st = b / 1024, sb = b % 1024, swz = sb ^ (((sb >> 9) & 1) << 5); R = (st >> 1) * 16 + swz / 64; C = (st & 1) * 32 + (swz % 64) / 2; }
__host__ __device__ __forceinline__ int perm32(int rho) { const int n = rho >> 4, i = rho & 15; return 8 * (i >> 2) + 4 * n + (i & 3); }

struct Unit { int pm, pn; };
struct Gemm { const bf16_t* A; const bf16_t* Bt; int M, N, K, lda; };

struct StaticOrder {
    int nM, nN, nwg, G, c;
    __host__ __device__ void init(int M, int N, int G_, int c_) { nM = M / BM; nN = N / BM; nwg = nM * nN; G = G_; c = c_; }
    __host__ __device__ bool next(int i, Unit& u) const {
        const long L = (long)i * G + c; if (L >= nwg) return false;
        int wgid = (int)L;
        const int nig = WGM * nN, gid = wgid / nig, fm = gid * WGM, gsz = (nM - fm) < WGM ? (nM - fm) : WGM;
        u.pm = fm + ((wgid % nig) % gsz); u.pn = (wgid % nig) / gsz; return true;
    }
    __device__ __forceinline__ void a_ready(const Unit&) const {}
    __device__ __forceinline__ void done(const Unit&) const {}
};

struct SkewOrder : StaticOrder {
    __host__ __device__ bool next(int i, Unit& u) const {
        const int h = G / 2; long L;
        if (c < h) { if (i > 0) return false; L = c; } else { if (i > 2) return false; L = h + 3L * (c - h) + i; }
        if (L >= nwg) return false;
        int wgid = (int)L;
        const int nig = WGM * nN, gid = wgid / nig, fm = gid * WGM, gsz = (nM - fm) < WGM ? (nM - fm) : WGM;
        u.pm = fm + ((wgid % nig) % gsz); u.pn = (wgid % nig) / gsz; return true;
    }
};

__device__ __forceinline__ unsigned cvt_pk_bf16(float lo, float hi) { unsigned r; asm volatile("v_cvt_pk_bf16_f32 %0, %1, %2" : "=v"(r) : "v"(lo), "v"(hi)); return r; }
typedef float f32x2 __attribute__((ext_vector_type(2)));
__device__ __forceinline__ f32x2 gelu_pk(f32x2 v) {
    const f32x2 av = __builtin_elementwise_abs(v), d = av * 0.2316418882f + 1.0f;
    f32x2 t; t.x = __builtin_amdgcn_rcpf(d.x); t.y = __builtin_amdgcn_rcpf(d.y);
    f32x2 q = t * 0.5307027145f + (-0.7265760135f); q = q * t + 0.7107068705f; q = q * t + (-0.142248368f); q = q * t + 0.127414796f; q = q * t;
    const f32x2 s = (v * v) * (-0.72134752044f);
    f32x2 e; e.x = __builtin_amdgcn_exp2f(s.x); e.y = __builtin_amdgcn_exp2f(s.y);
    const f32x2 m = v * (q * e), r = v - m;
    f32x2 o; o.x = v.x < 0.f ? m.x : r.x; o.y = v.y < 0.f ? m.y : r.y; return o;
}

template <int ACT  > struct EpiBf16 {
    static constexpr bool PERM = true, AFTER_DRAIN = false, KSCALE = false; static_assert(ACT == 0 || ACT == 1, "EpiBf16: ACT is 0 (none) or 1 (gelu_pk)");
    bf16_t* O; int ldc; const float* bias; int split_cols; size_t split_stride; float scale0;
    __device__ __forceinline__ void operator()(const f32x4 (&acc)[2][2][4][2], const Unit& u, int wr, int wc, int fr, int fq) const {
        const int row0 = u.pm * BM + wr * 64 + fr; int colt = u.pn * BM; bf16_t* base = O;
        float sc = 1.f; if (split_cols) { const int t = colt / split_cols; base += (size_t)t * split_stride; colt -= t * split_cols; if (t == 0) sc = scale0; }
        const int col0 = colt + wc * 32 + 8 * fq, bcol0 = u.pn * BM + wc * 32 + 8 * fq;
        f32x4 bv[2][2];
#pragma unroll
        for (int bj = 0; bj < 2; ++bj)
#pragma unroll
            for (int n = 0; n < 2; ++n) bv[bj][n] = bias ? *(const f32x4*)(bias + bcol0 + bj * HALF + 4 * n) : (f32x4){0.f, 0.f, 0.f, 0.f};
#pragma unroll
        for (int ai = 0; ai < 2; ++ai)
#pragma unroll
            for (int m = 0; m < 4; ++m) { bf16_t* rowp = base + (size_t)(row0 + ai * HALF + m * 16) * ldc + col0;
#pragma unroll
                for (int bj = 0; bj < 2; ++bj) { f32x4 v0 = acc[ai][bj][m][0] + bv[bj][0], v1 = acc[ai][bj][m][1] + bv[bj][1];
                    if (ACT == 1) { f32x2 a = gelu_pk((f32x2){v0[0], v0[1]}), b = gelu_pk((f32x2){v0[2], v0[3]}), c = gelu_pk((f32x2){v1[0], v1[1]}), d = gelu_pk((f32x2){v1[2], v1[3]});
                        v0 = (f32x4){a.x, a.y, b.x, b.y}; v1 = (f32x4){c.x, c.y, d.x, d.y}; }
                    v0 = v0 * sc; v1 = v1 * sc; u32x4 w; w.x = cvt_pk_bf16(v0[0], v0[1]); w.y = cvt_pk_bf16(v0[2], v0[3]); w.z = cvt_pk_bf16(v1[0], v1[1]); w.w = cvt_pk_bf16(v1[2], v1[3]);
                    *(u32x4*)(rowp + bj * HALF) = w; } }
    }
};
struct EpiResid {
    static constexpr bool PERM = false, AFTER_DRAIN = false, KSCALE = false;
    const float* resid; float* out; const float* gate; int ldc, rows_per_batch, gate_stride;
    __device__ __forceinline__ void operator()(const f32x4 (&acc)[2][2][4][2], const Unit& u, int wr, int wc, int fr, int fq) const {
        const int col0 = u.pn * BM + wc * 32 + 4 * fq;
        const int b = (u.pm * BM) / rows_per_batch;
        f32x4 gv[2][2];
#pragma unroll
        for (int bj = 0; bj < 2; ++bj)
#pragma unroll
            for (int n = 0; n < 2; ++n) gv[bj][n] = *(const f32x4*)(gate + (size_t)b * gate_stride + col0 + bj * HALF + n * 16);
#pragma unroll
        for (int ai = 0; ai < 2; ++ai)
#pragma unroll
            for (int m = 0; m < 4; ++m) {
                const size_t off = (size_t)(u.pm * BM + ai * HALF + wr * 64 + m * 16 + fr) * ldc + col0;
#pragma unroll
                for (int bj = 0; bj < 2; ++bj)
#pragma unroll
                    for (int n = 0; n < 2; ++n) {
                        const f32x4 bs = *(const f32x4*)(resid + off + bj * HALF + n * 16);
                        *(f32x4*)(out + off + bj * HALF + n * 16) = bs + gv[bj][n] * acc[ai][bj][m][n];
                    }
                if (m & 1) asm volatile("" ::: "memory");
            }
    }
};

struct EpiX1 {
    static constexpr int PSQ_ROWS = 16384;
    static constexpr bool PERM = true, AFTER_DRAIN = false, KSCALE = true;
    static constexpr int KS1 = 16, KS2 = 24;
    const float* resid; const float* mod; bf16_t* xm; float* psq; int ldc, rows_per_batch; const PG8_LAS float* kt; int pm0;
    __device__ __forceinline__ void kscale(f32x4 (&acc)[2][2][4][2], const Unit& u, int t, int wr, int fr) const {
        const PG8_LAS float* tab = kt + ((u.pm == pm0) ? 0 : 1024) + ((t == KS1) ? 0 : 1);
#pragma unroll
        for (int ai = 0; ai < 2; ++ai)
#pragma unroll
            for (int m = 0; m < 4; ++m) { const float f = tab[(ai * HALF + wr * 64 + m * 16 + fr) * 4];
#pragma unroll
                for (int bj = 0; bj < 2; ++bj) { acc[ai][bj][m][0] *= f; acc[ai][bj][m][1] *= f; } }
    }
    __device__ __forceinline__ void operator()(const f32x4 (&acc)[2][2][4][2], const Unit& u, int wr, int wc, int fr, int fq) const {
        const int b = (u.pm * BM) / rows_per_batch;
        const float* g1 = mod + (size_t)b * 6 * ldc + 2 * ldc; const float* s2 = mod + (size_t)b * 6 * ldc + 4 * ldc;
        const int col0 = u.pn * BM + wc * 32 + 8 * fq;
        const PG8_LAS float* tab = kt + ((u.pm == pm0) ? 0 : 1024) + 2;
        f32x4 gv[2][2], sv[2][2];
#pragma unroll
        for (int bj = 0; bj < 2; ++bj)
#pragma unroll
            for (int n = 0; n < 2; ++n) { gv[bj][n] = *(const f32x4*)(g1 + col0 + bj * HALF + 4 * n); sv[bj][n] = *(const f32x4*)(s2 + col0 + bj * HALF + 4 * n) + 1.0f; }
#pragma unroll
        for (int ai = 0; ai < 2; ++ai)
#pragma unroll
            for (int m = 0; m < 4; ++m) {
                const int lr = ai * HALF + wr * 64 + m * 16 + fr, row = u.pm * BM + lr; const size_t off = (size_t)row * ldc + col0;
                const float rf = tab[lr * 4];
                float ss = 0.f;
#pragma unroll
                for (int bj = 0; bj < 2; ++bj) {
                    const f32x4 r0 = *(const f32x4*)(resid + off + bj * HALF), r1 = *(const f32x4*)(resid + off + bj * HALF + 4);
                    const f32x4 x0 = r0 + gv[bj][0] * (acc[ai][bj][m][0] * rf), x1 = r1 + gv[bj][1] * (acc[ai][bj][m][1] * rf);
                    ss += (x0[0] * x0[0] + x0[1] * x0[1]) + (x0[2] * x0[2] + x0[3] * x0[3]) + (x1[0] * x1[0] + x1[1] * x1[1]) + (x1[2] * x1[2] + x1[3] * x1[3]);
                    const f32x4 y0 = x0 * sv[bj][0], y1 = x1 * sv[bj][1];
                    u32x4 w; w.x = cvt_pk_bf16(y0[0], y0[1]); w.y = cvt_pk_bf16(y0[2], y0[3]); w.z = cvt_pk_bf16(y1[0], y1[1]); w.w = cvt_pk_bf16(y1[2], y1[3]);
                    *(u32x4*)(xm + off + bj * HALF) = w;
                }
                ss += __shfl_xor(ss, 16); ss += __shfl_xor(ss, 32);
                if (fq == 0) psq[(size_t)(u.pn * 4 + wc) * PSQ_ROWS + row] = ss;
            }
    }
};
struct EpiScaleBias {
    static constexpr bool PERM = true, AFTER_DRAIN = false, KSCALE = false;
    bf16_t* O; int ldc; const float* bias; int rows_per_batch; const PG8_LAS float* rt; int pm0;
    __device__ __forceinline__ void operator()(const f32x4 (&acc)[2][2][4][2], const Unit& u, int wr, int wc, int fr, int fq) const {
        const int b = (u.pm * BM) / rows_per_batch; const float* bp = bias + (size_t)b * ldc;
        const int col0 = u.pn * BM + wc * 32 + 8 * fq;
        const PG8_LAS float* rtu = rt + ((u.pm == pm0) ? 0 : 256);
        f32x4 bv[2][2];
#pragma unroll
        for (int bj = 0; bj < 2; ++bj)
#pragma unroll
            for (int n = 0; n < 2; ++n) bv[bj][n] = *(const f32x4*)(bp + col0 + bj * HALF + 4 * n);
#pragma unroll
        for (int ai = 0; ai < 2; ++ai)
#pragma unroll
            for (int m = 0; m < 4; ++m) {
                const int lr = ai * HALF + wr * 64 + m * 16 + fr; const float rs = rtu[lr];
                bf16_t* rowp = O + (size_t)(u.pm * BM + lr) * ldc + col0;
#pragma unroll
                for (int bj = 0; bj < 2; ++bj) {
                    const f32x4 v0 = acc[ai][bj][m][0] * rs + bv[bj][0], v1 = acc[ai][bj][m][1] * rs + bv[bj][1];
                    u32x4 w; w.x = cvt_pk_bf16(v0[0], v0[1]); w.y = cvt_pk_bf16(v0[2], v0[3]); w.z = cvt_pk_bf16(v1[0], v1[1]); w.w = cvt_pk_bf16(v1[2], v1[3]);
                    *(u32x4*)(rowp + bj * HALF) = w;
                }
            }
    }
};
template <class Epi, class Sched, bool ALIGN_EPI = false, bool SP2 = false>
__device__ __forceinline__ void gemm_phase(PG8_LAS unsigned char* lds, const Gemm g, const Sched& S, const Epi& E) {
    const int tid = threadIdx.x, wid = __builtin_amdgcn_readfirstlane(tid >> 6), lane = tid & 63, wr = wid >> 2, wc = wid & 3, fr = lane & 15, fq = lane >> 4;
    const int K = g.K, nt = K / BK;
    unsigned voffA[2], voffB[2];
#pragma unroll
    for (int i = 0; i < 2; ++i) { int R, C; stage_rc(tid * 16 + i * 8192, R, C); const int Rb = Epi::PERM ? ((R & ~31) + perm32(R & 31)) : R;
        voffA[i] = (unsigned)(R * g.lda + C) * 2u; voffB[i] = (unsigned)(Rb * K + C) * 2u; }
    const size_t kstep = (size_t)(BK * 2);
    const size_t hstep = (size_t)HALF * K * 2;
    const size_t tstep = 2 * hstep; const size_t hstepA = (size_t)HALF * g.lda * 2, tstepA = 2 * hstepA;
    const unsigned ldsw = (unsigned)wid * 1024u;
    const int aoff = lds_byte(wr * 64 + fr, fq * 8), boff = lds_byte(wc * 32 + fr, fq * 8);
#define PG8_SA(b, h) (((b) * 2 + (h)) * HTB)
#define PG8_SB(b, h) ((4 + (b) * 2 + (h)) * HTB)
#define PG8_STAGE(bufoff, gbase, voff) do { _Pragma("unroll") for (int _i = 0; _i < 2; ++_i) \
        __builtin_amdgcn_global_load_lds((const unsigned*)((const char*)(gbase) + (voff)[_i]), (PG8_LAS unsigned*)(lds + (bufoff) + ldsw + _i * 8192), 16, 0, 0); } while (0)
#define PG8_LDA(dst, b, h) do { _Pragma("unroll") for (int m = 0; m < 4; ++m) _Pragma("unroll") for (int k = 0; k < 2; ++k) dst[m][k] = *(const PG8_LAS bf16x8*)(lds + PG8_SA(b, h) + aoff + m * 2048 + k * 1024); } while (0)
#define PG8_LDB(dst, b, h) do { _Pragma("unroll") for (int n = 0; n < 2; ++n) _Pragma("unroll") for (int k = 0; k < 2; ++k) dst[n][k] = *(const PG8_LAS bf16x8*)(lds + PG8_SB(b, h) + boff + n * 2048 + k * 1024); } while (0)
#define PG8_MMA(ai, bj, At, Bt) do { __builtin_amdgcn_s_setprio(1); _Pragma("unroll") for (int m = 0; m < 4; ++m) _Pragma("unroll") for (int n = 0; n < 2; ++n) _Pragma("unroll") for (int k = 0; k < 2; ++k) \
        acc[ai][bj][m][n] = __builtin_amdgcn_mfma_f32_16x16x32_bf16(Bt[n][k], At[m][k], acc[ai][bj][m][n], 0, 0, 0); __builtin_amdgcn_s_setprio(0); } while (0)
#define PG8_WAIT_V(n) asm volatile("s_waitcnt vmcnt(" #n ")" ::: "memory")
#define PG8_WAIT_L(n) asm volatile("s_waitcnt lgkmcnt(" #n ")" ::: "memory")
#define PG8_BAR __builtin_amdgcn_s_barrier()
#define PG8_SCHED __builtin_amdgcn_sched_barrier(0)
    Unit cur, nxt; int ui = 0;
    if (!S.next(0, cur)) return;
    f32x4 acc[2][2][4][2];
#pragma unroll
    for (int a = 0; a < 2; ++a)
#pragma unroll
        for (int b = 0; b < 2; ++b)
#pragma unroll
            for (int m = 0; m < 4; ++m)
#pragma unroll
                for (int n = 0; n < 2; ++n) acc[a][b][m][n] = (f32x4){0.f, 0.f, 0.f, 0.f};
    bf16x8 At[4][2], B0[2][2], B1[2][2];
    const char* cA = (const char*)g.A + (size_t)cur.pm * tstepA; const char* cB = (const char*)g.Bt + (size_t)cur.pn * tstep;
    S.a_ready(cur);
    if constexpr (SP2) {
        PG8_STAGE(PG8_SB(0, 0), cB, voffB); PG8_STAGE(PG8_SB(0, 1), cB + hstep, voffB); PG8_STAGE(PG8_SA(0, 0), cA, voffA); PG8_STAGE(PG8_SA(0, 1), cA + hstepA, voffA);
        if (wr == 1) PG8_BAR;
        PG8_WAIT_V(2); PG8_BAR;
        PG8_STAGE(PG8_SB(1, 0), cB + kstep, voffB); PG8_STAGE(PG8_SA(1, 0), cA + kstep, voffA); PG8_STAGE(PG8_SB(1, 1), cB + hstep + kstep, voffB);
        PG8_WAIT_V(6); PG8_BAR;
    } else {
        PG8_STAGE(PG8_SB(0, 0), cB, voffB); PG8_STAGE(PG8_SA(0, 0), cA, voffA); PG8_STAGE(PG8_SB(0, 1), cB + hstep, voffB); PG8_STAGE(PG8_SA(0, 1), cA + hstepA, voffA);
        if (wr == 1) PG8_BAR;
        PG8_WAIT_V(4); PG8_BAR;
        PG8_STAGE(PG8_SB(1, 0), cB + kstep, voffB); PG8_STAGE(PG8_SA(1, 0), cA + kstep, voffA); PG8_STAGE(PG8_SB(1, 1), cB + hstep + kstep, voffB);
        PG8_WAIT_V(6); PG8_BAR;
    }
    for (;;) {
        const bool has_next = S.next(ui + 1, nxt);
        const char* nA = has_next ? (const char*)g.A + (size_t)nxt.pm * tstepA : cA; const char* nB = has_next ? (const char*)g.Bt + (size_t)nxt.pn * tstep : cB;
        for (int t = 0; t < nt; t += 2) {
            const bool last = (t == nt - 2);
            const char* a1 = cA + (size_t)(t + 1) * kstep;
            const char* a2 = last ? nA : cA + (size_t)(t + 2) * kstep; const char* b2 = last ? nB : cB + (size_t)(t + 2) * kstep;
            const char* a3 = a2 + kstep; const char* b3 = b2 + kstep;
            if (last && has_next) S.a_ready(nxt);
            if constexpr (Epi::KSCALE) { if (t == Epi::KS1 || t == Epi::KS2) E.kscale(acc, cur, t, wr, fr); }
            if constexpr (SP2) {
            PG8_LDB(B0, 0, 0); PG8_LDB(B1, 0, 1); PG8_SCHED; PG8_LDA(At, 0, 0); PG8_STAGE(PG8_SA(1, 1), a1 + hstepA, voffA);
            PG8_WAIT_V(8); PG8_WAIT_L(0); PG8_BAR; PG8_MMA(0, 0, At, B0); PG8_MMA(0, 1, At, B1); PG8_BAR; PG8_SCHED;
            PG8_LDA(At, 0, 1); PG8_STAGE(PG8_SB(0, 0), b2, voffB); PG8_STAGE(PG8_SB(0, 1), b2 + hstep, voffB); PG8_STAGE(PG8_SA(0, 0), a2, voffA);
            PG8_WAIT_V(8); PG8_WAIT_L(0); PG8_BAR; PG8_MMA(1, 0, At, B0); PG8_MMA(1, 1, At, B1); PG8_BAR; PG8_SCHED;
            PG8_LDB(B0, 1, 0); PG8_LDB(B1, 1, 1); PG8_SCHED; PG8_LDA(At, 1, 0); PG8_STAGE(PG8_SA(0, 1), a2 + hstepA, voffA);
            PG8_WAIT_V(8); PG8_WAIT_L(0); PG8_BAR; PG8_MMA(0, 0, At, B0); PG8_MMA(0, 1, At, B1); PG8_BAR; PG8_SCHED;
            PG8_LDA(At, 1, 1); PG8_STAGE(PG8_SB(1, 0), b3, voffB); PG8_STAGE(PG8_SB(1, 1), b3 + hstep, voffB); PG8_STAGE(PG8_SA(1, 0), a3, voffA);
            PG8_WAIT_V(8); PG8_WAIT_L(0); PG8_BAR; PG8_MMA(1, 0, At, B0); PG8_MMA(1, 1, At, B1); PG8_BAR; PG8_SCHED;
            } else {
            PG8_LDB(B0, 0, 0); PG8_SCHED; PG8_LDA(At, 0, 0); PG8_STAGE(PG8_SA(1, 1), a1 + hstepA, voffA);
            PG8_WAIT_L(8); PG8_BAR; PG8_WAIT_L(0); PG8_MMA(0, 0, At, B0); PG8_BAR; PG8_SCHED;
            PG8_LDB(B1, 0, 1); PG8_STAGE(PG8_SB(0, 0), b2, voffB);
            PG8_BAR; PG8_WAIT_L(0); PG8_MMA(0, 1, At, B1); PG8_BAR;
            PG8_LDA(At, 0, 1); PG8_STAGE(PG8_SA(0, 0), a2, voffA);
            PG8_BAR; PG8_WAIT_L(0); PG8_MMA(1, 0, At, B0); PG8_BAR; PG8_SCHED;
            PG8_STAGE(PG8_SB(0, 1), b2 + hstep, voffB);
            PG8_WAIT_V(6); PG8_BAR; PG8_MMA(1, 1, At, B1); PG8_BAR;
            PG8_LDB(B0, 1, 0); PG8_SCHED; PG8_LDA(At, 1, 0); PG8_STAGE(PG8_SA(0, 1), a2 + hstepA, voffA);
            PG8_WAIT_L(8); PG8_BAR; PG8_WAIT_L(0); PG8_MMA(0, 0, At, B0); PG8_BAR; PG8_SCHED;
            PG8_LDB(B1, 1, 1); PG8_STAGE(PG8_SB(1, 0), b3, voffB);
            PG8_BAR; PG8_WAIT_L(0); PG8_MMA(0, 1, At, B1); PG8_BAR;
            PG8_LDA(At, 1, 1); PG8_STAGE(PG8_SA(1, 0), a3, voffA);
            PG8_BAR; PG8_WAIT_L(0); PG8_MMA(1, 0, At, B0); PG8_BAR; PG8_SCHED;
            PG8_STAGE(PG8_SB(1, 1), b3 + hstep, voffB);
            PG8_WAIT_V(6); PG8_BAR; PG8_MMA(1, 1, At, B1); PG8_BAR;
            }
        }
        if constexpr (ALIGN_EPI) { if (wr == 0) PG8_BAR; }
        if constexpr (!Epi::AFTER_DRAIN) { E(acc, cur, wr, wc, fr, fq); S.done(cur); }
        if (!has_next) break;
#pragma unroll
        for (int a = 0; a < 2; ++a)
#pragma unroll
            for (int b = 0; b < 2; ++b)
#pragma unroll
                for (int m = 0; m < 4; ++m)
#pragma unroll
                    for (int n = 0; n < 2; ++n) acc[a][b][m][n] = (f32x4){0.f, 0.f, 0.f, 0.f};
        cur = nxt; cA = nA; cB = nB; ++ui;
        if constexpr (ALIGN_EPI) { if (wr == 1) PG8_BAR; }
    }
    PG8_WAIT_V(0);
    if constexpr (!ALIGN_EPI) { if (wr == 0) PG8_BAR; }
    PG8_BAR;
    if constexpr (Epi::AFTER_DRAIN) { E.fused(acc, cur, wr, wc, fr, fq, lds, wid, lane); S.done(cur); }
#undef PG8_SA
#undef PG8_SB
#undef PG8_STAGE
#undef PG8_LDA
#undef PG8_LDB
#undef PG8_MMA
#undef PG8_WAIT_V
#undef PG8_WAIT_L
#undef PG8_BAR
#undef PG8_SCHED
}
}
#define LDS_WAIT() asm volatile("s_waitcnt lgkmcnt(0)" ::: "memory")
#define XB_TMO      128
#define XB_XCNT(j)  (256  + 64 * (j))
#define XB_XSUB(j)  (1280 + 64 * (j))
#define XB_XGEN(j)  (2304 + 64 * (j))
#define XB_TOP      3328
#define XB_TOPGEN   3392
#define XCD_BAR_WORDS 3456
#define XB_SPIN_CAP (1u << 18)

__device__ __forceinline__ unsigned xb_ld(unsigned* p)              { return __hip_atomic_load(p, __ATOMIC_RELAXED, __HIP_MEMORY_SCOPE_AGENT); }
__device__ __forceinline__ unsigned xb_add(unsigned* p, unsigned v) { return __hip_atomic_fetch_add(p, v, __ATOMIC_RELAXED, __HIP_MEMORY_SCOPE_AGENT); }
__device__ __forceinline__ unsigned xb_xcc_id() { return (unsigned)__builtin_amdgcn_s_getreg((3 << 11) | 20) & 0xFu; }
#define XB_SPIN(cond, bar) do { unsigned _sp = 0; while (cond) { __builtin_amdgcn_s_sleep(1); \
    if ((++_sp & 255u) == 0u) { if (xb_ld(&(bar)[XB_TMO])) break; if (_sp > XB_SPIN_CAP) { atomicAdd(&(bar)[XB_TMO], 1u); break; } } } } while (0)

struct XcdBarrier {
    unsigned* bar; unsigned x;
    volatile LAS unsigned* st;
};

__device__ __forceinline__ XcdBarrier xcd_barrier_post(unsigned* bar, volatile LAS unsigned* st) {
    XcdBarrier b; b.bar = bar; b.x = xb_xcc_id(); b.st = st;
    if (threadIdx.x == 0) (void)xb_add(&bar[XB_XCNT(b.x)], 1u);
    return b;
}
__device__ __forceinline__ void xcd_barrier_complete(unsigned* bar, unsigned x, unsigned& nloc, unsigned& nx) {
    const unsigned G = gridDim.x * gridDim.y * gridDim.z;
    unsigned sum, cnt, mine, sp = 0u;
    for (;;) {
        sum = 0u; cnt = 0u; mine = 0u;
#pragma unroll
        for (unsigned j = 0; j < 16; ++j) { const unsigned c = xb_ld(&bar[XB_XCNT(j)]); sum += c; cnt += (c > 0u) ? 1u : 0u; mine = (j == x) ? c : mine; }
        if (sum == G) break;
        __builtin_amdgcn_s_sleep(1);
        if ((++sp & 255u) == 0u) { if (xb_ld(&bar[XB_TMO])) break; if (sp > XB_SPIN_CAP) { atomicAdd(&bar[XB_TMO], 1u); break; } }
    }
    nloc = mine > 0u ? mine : 1u; nx = cnt > 0u ? cnt : 1u;
}

__device__ __forceinline__ void xcd_barrier(const XcdBarrier& b) {
    asm volatile("s_waitcnt vmcnt(0)" ::: "memory");
    __syncthreads();
    if (threadIdx.x == 0) {
        unsigned* bar = b.bar;
        __builtin_amdgcn_s_waitcnt(0);
        unsigned nloc = b.st[0], nx = b.st[1];
        if (nloc == 0u) { xcd_barrier_complete(bar, b.x, nloc, nx); b.st[0] = nloc; b.st[1] = nx; }
        const unsigned old = xb_add(&bar[XB_XSUB(b.x)], 1u);
        const unsigned gen = old / nloc;
        if (old + 1u == (gen + 1u) * nloc) {
            __builtin_amdgcn_fence(__ATOMIC_RELEASE, "agent");
            asm volatile("s_waitcnt vmcnt(0)" ::: "memory");
            const unsigned og = xb_add(&bar[XB_TOP], 1u);
            const unsigned tg = og / nx;
            if (og + 1u == (tg + 1u) * nx) xb_add(&bar[XB_TOPGEN], 1u);
            else XB_SPIN(xb_ld(&bar[XB_TOPGEN]) == tg, bar);
            __builtin_amdgcn_fence(__ATOMIC_ACQUIRE, "agent");
            xb_add(&bar[XB_XGEN(b.x)], 1u);
            asm volatile("s_waitcnt vmcnt(0)" ::: "memory");
        } else {
            XB_SPIN(xb_ld(&bar[XB_XGEN(b.x)]) == gen, bar);
            __builtin_amdgcn_fence(__ATOMIC_ACQUIRE, "agent");
            asm volatile("s_waitcnt vmcnt(0)" ::: "memory");
        }
    }
    __syncthreads();
}
#define SYNC() __syncthreads()
__device__ __forceinline__ float silu_fast(float v) { return v * __builtin_amdgcn_rcpf(1.f + __expf(-v)); }
__device__ __forceinline__ float sq2(unsigned w) { const float a = bflo(w), b = bfhi(w); return a * a + b * b; }

__device__ __forceinline__ void ph_mod(const Params& p, unsigned char* lds, int tid, int vb) {
    float* cact = (float*)lds; float* red = (float*)(lds + 65536);
    const int lane = tid & 63, wv = tid >> 6, c4 = lane & 31, kh = lane >> 5;
    for (int i = tid; i < NB * DM; i += NTHR) { const int b = i / DM, k = i % DM; cact[k * NB + b] = silu_f(p.c[i]); }
    SYNC();
    const int n = vb * 128 + 4 * c4;
    f32x4 acc[NB];
#pragma unroll
    for (int b = 0; b < NB; ++b) acc[b] = (f32x4){0.f, 0.f, 0.f, 0.f};
    const float* w = p.w_ada + (size_t)(wv * 256 + kh) * (6 * DM) + n;
#pragma unroll 8
    for (int i = 0; i < 128; ++i) {
        const f32x4 wk = *(const f32x4*)(w + (size_t)(2 * i) * (6 * DM));
        const f32x4 ca = *(const f32x4*)(cact + (wv * 256 + 2 * i + kh) * NB), cb = *(const f32x4*)(cact + (wv * 256 + 2 * i + kh) * NB + 4);
        acc[0] += wk * ca.x; acc[1] += wk * ca.y; acc[2] += wk * ca.z; acc[3] += wk * ca.w; acc[4] += wk * cb.x; acc[5] += wk * cb.y; acc[6] += wk * cb.z; acc[7] += wk * cb.w;
    }
#pragma unroll
    for (int b = 0; b < NB; ++b) { acc[b].x += __shfl_xor(acc[b].x, 32); acc[b].y += __shfl_xor(acc[b].y, 32); acc[b].z += __shfl_xor(acc[b].z, 32); acc[b].w += __shfl_xor(acc[b].w, 32); }
    if (lane < 32) {
#pragma unroll
        for (int b = 0; b < NB; ++b) *(f32x4*)(red + (wv * NB + b) * 128 + 4 * c4) = acc[b];
    }
    SYNC();
    for (int o = tid; o < NB * 128; o += NTHR) {
        const int b = o >> 7, col = o & 127;
        float s = p.b_ada[vb * 128 + col];
#pragma unroll
        for (int w8 = 0; w8 < 8; ++w8) s += red[(w8 * NB + b) * 128 + col];
        ((float*)(p.ws + WS_MOD))[b * 6 * DM + vb * 128 + col] = s;
    }
    SYNC();
}
__device__ __forceinline__ void ph_rope_tab(const Params& p, int gtid, int gn) {
    const int f = gtid & 31;
    const float inv = 1.0f / powf(10000.0f, (float)f * (2.0f / 64.0f));
    for (int i = gtid; i < T * 32; i += gn) {
        const int t = i >> 5;
        const float ang = (float)p.pos[t] * inv;
        float sv, cv; sincosf(ang, &sv, &cv);
        ((float*)(p.ws + WS_ROPEC))[i] = cv;
        ((float*)(p.ws + WS_ROPES))[i] = sv;
    }
}
__device__ __forceinline__ void tr_item(const float* W, int K, int N, int Npad, bf16_t* WT, const float* g0, const float* g1, int gs, float* scr, int item, int lane) {
    const int nblk = Npad / 128, kb = item / nblk, nb = item % nblk, k0 = 32 * kb, n0 = 128 * nb;
    const int c4 = lane & 31, kh = lane >> 5, n = n0 + 4 * c4; const bool ok = n < N;
#pragma unroll 8
    for (int i = 0; i < 16; ++i) {
        const int kk = 2 * i + kh, k = k0 + kk;
        f32x4 v = ok ? *(const f32x4*)(W + (size_t)k * N + n) : (f32x4){0.f, 0.f, 0.f, 0.f};
        if (g0) v = v * ((k < gs) ? g0[k] : g1[k - gs]);
        *(f32x4*)(scr + kk * 132 + 4 * c4) = v;
    }
    asm volatile("s_waitcnt lgkmcnt(0)" ::: "memory");
#pragma unroll
    for (int j = 0; j < 8; ++j) {
        const int idx = lane + 64 * j, nn = idx >> 2, ck = idx & 3; const float* sp = scr + (8 * ck) * 132 + nn;
        u32x4 o; o.x = pk2(sp[0 * 132], sp[1 * 132]); o.y = pk2(sp[2 * 132], sp[3 * 132]); o.z = pk2(sp[4 * 132], sp[5 * 132]); o.w = pk2(sp[6 * 132], sp[7 * 132]);
        *(u32x4*)(WT + (size_t)(n0 + nn) * K + k0 + 8 * ck) = o;
    }
    asm volatile("s_waitcnt lgkmcnt(0)" ::: "memory");
}
constexpr int TR_N0 = (DM / 32) * (NPROJ / 128), TR_N1 = (512 / 32) * (NQ / 128), TR_N2 = (256 / 32) * (NKV / 128), TR_N3 = (DM / 32) * (DM / 128), TR_N4 = TR_N3;
constexpr int TR_TOTAL = TR_N0 + TR_N1 + TR_N2 + TR_N3 + TR_N4;
__device__ __forceinline__ void ph_transposes(const Params& p, unsigned char* lds, int wave, int lane, int first, int stride, int lo, int hi) {
    float* scr = (float*)(lds + wave * 17408);
    for (int it = lo + first; it < hi; it += stride) {
        int r = it;
        if (r < TR_N0) { tr_item(p.w_in, DM, IN_COLS, NPROJ, (bf16_t*)(p.ws + WS_WINT), nullptr, nullptr, 0, scr, r, lane); continue; } r -= TR_N0;
        if (r < TR_N1) { tr_item(p.w_uq, 512, NQ, NQ, (bf16_t*)(p.ws + WS_WUQT), p.q_a_norm, p.q_a_norm, 512, scr, r, lane); continue; } r -= TR_N1;
        if (r < TR_N2) { tr_item(p.w_ukv, 256, NKV, NKV, (bf16_t*)(p.ws + WS_WUKVT), p.kv_a_norm, p.kv_a_norm, 256, scr, r, lane); continue; } r -= TR_N2;
        if (r < TR_N3) { tr_item(p.w_out, DM, DM, DM, (bf16_t*)(p.ws + WS_WOUTT), p.attn_out_norm, p.ssd_norm, 1024, scr, r, lane); continue; } r -= TR_N3;
        tr_item(p.w_query, DM, DM, DM, (bf16_t*)(p.ws + WS_WQT), nullptr, nullptr, 0, scr, r, lane);
    }
}
__device__ __forceinline__ void ph_convert(const float* src, bf16_t* dst, size_t n4, int gtid, int gn) {
    for (size_t i = gtid; i < n4; i += (size_t)gn) {
        const f32x4 v = ((const f32x4*)src)[i];
        uint2 o; o.x = pk2(v.x, v.y); o.y = pk2(v.z, v.w);
        ((uint2*)dst)[i] = o;
    }
}
__device__ __forceinline__ void ph_modrows(const float* in, bf16_t* outp, const float* mod, int sh_idx, int sc_idx, int gwave, int gnw, int lane) {
    const int rpw = T / gnw, row0 = gwave * rpw, b = row0 / SEQ;
    const f32x4* shp = (const f32x4*)(mod + (size_t)b * 6 * DM + sh_idx * DM) + lane;
    const f32x4* scp = (const f32x4*)(mod + (size_t)b * 6 * DM + sc_idx * DM) + lane;
    f32x4 sh[8], sc[8], v[8], vn[8];
#pragma unroll
    for (int j = 0; j < 8; ++j) { sh[j] = shp[64 * j]; sc[j] = scp[64 * j] + 1.0f; }
    { const f32x4* xr = (const f32x4*)(in + (size_t)row0 * DM) + lane;
#pragma unroll
      for (int j = 0; j < 8; ++j) v[j] = xr[64 * j]; }
    for (int k = 0; k < rpw; ++k) {
        const int row = row0 + k;
        if (k + 1 < rpw) { const f32x4* xr = (const f32x4*)(in + (size_t)(row + 1) * DM) + lane;
#pragma unroll
            for (int j = 0; j < 8; ++j) vn[j] = xr[64 * j]; }
        float s = 0.f;
#pragma unroll
        for (int j = 0; j < 8; ++j) s += (v[j].x * v[j].x + v[j].y * v[j].y) + (v[j].z * v[j].z + v[j].w * v[j].w);
        const float r = rsqrtf(wave_sum(s) * (1.f / DM) + EPS);
        uint2* o = (uint2*)(outp + (size_t)row * DM) + lane;
#pragma unroll
        for (int j = 0; j < 8; ++j) {
            uint2 w; w.x = pk2(v[j].x * r * sc[j].x + sh[j].x, v[j].y * r * sc[j].y + sh[j].y); w.y = pk2(v[j].z * r * sc[j].z + sh[j].z, v[j].w * r * sc[j].w + sh[j].w);
            o[64 * j] = w;
        }
#pragma unroll
        for (int j = 0; j < 8; ++j) v[j] = vn[j];
    }
}
__device__ __forceinline__ void ph_bias2(const Params& p, int gwave, int gnw, int lane) {
    const float* mod = (const float*)(p.ws + WS_MOD);
    for (int n = gwave; n < DM; n += gnw) {
        const bf16_t* wr_ = (const bf16_t*)(p.ws + WS_WQT) + (size_t)n * DM + lane * 8;
        float wv[4][8];
#pragma unroll
        for (int j = 0; j < 4; ++j) { const u32x4 w = *(const u32x4*)(wr_ + j * 512);
            wv[j][0] = bflo(w.x); wv[j][1] = bfhi(w.x); wv[j][2] = bflo(w.y); wv[j][3] = bfhi(w.y); wv[j][4] = bflo(w.z); wv[j][5] = bfhi(w.z); wv[j][6] = bflo(w.w); wv[j][7] = bfhi(w.w); }
#pragma unroll
        for (int b = 0; b < NB; ++b) {
            const float* sh = mod + (size_t)b * 6 * DM + 3 * DM + lane * 8; float a = 0.f;
#pragma unroll
            for (int j = 0; j < 4; ++j) { const f32x4 s0 = *(const f32x4*)(sh + j * 512), s1 = *(const f32x4*)(sh + j * 512 + 4);
                a += (wv[j][0] * s0[0] + wv[j][1] * s0[1]) + (wv[j][2] * s0[2] + wv[j][3] * s0[3]) + (wv[j][4] * s1[0] + wv[j][5] * s1[1]) + (wv[j][6] * s1[2] + wv[j][7] * s1[3]); }
            a = wave_sum(a);
            if (lane == 0) ((float*)(p.ws + WS_BIAS2))[b * DM + n] = a;
        }
    }
}
constexpr float QSCALE = 0.07216878364870322f * 1.4426950408889634f;
__device__ __forceinline__ float ssq8(u32x4 w) { return (sq2(w.x) + sq2(w.y)) + (sq2(w.z) + sq2(w.w)); }
__device__ __forceinline__ u32x4 scale8(u32x4 w, float s, const float (&g)[8]) {
    u32x4 o; o.x = pk2(bflo(w.x) * s * g[0], bfhi(w.x) * s * g[1]); o.y = pk2(bflo(w.y) * s * g[2], bfhi(w.y) * s * g[3]);
    o.z = pk2(bflo(w.z) * s * g[4], bfhi(w.z) * s * g[5]); o.w = pk2(bflo(w.w) * s * g[6], bfhi(w.w) * s * g[7]); return o;
}
__device__ __forceinline__ u32x4 rope8(u32x4 w, u32x4 pw, float s, const float (&go)[8], const float (&gp)[8], f32x4 c0, f32x4 c1, f32x4 s0, f32x4 s1, float sgn) {
    const float a[8] = {bflo(w.x) * s * go[0], bfhi(w.x) * s * go[1], bflo(w.y) * s * go[2], bfhi(w.y) * s * go[3], bflo(w.z) * s * go[4], bfhi(w.z) * s * go[5], bflo(w.w) * s * go[6], bfhi(w.w) * s * go[7]};
    const float b[8] = {bflo(pw.x) * s * gp[0], bfhi(pw.x) * s * gp[1], bflo(pw.y) * s * gp[2], bfhi(pw.y) * s * gp[3], bflo(pw.z) * s * gp[4], bfhi(pw.z) * s * gp[5], bflo(pw.w) * s * gp[6], bfhi(pw.w) * s * gp[7]};
    u32x4 o;
    o.x = pk2(a[0] * c0.x + sgn * b[0] * s0.x, a[1] * c0.y + sgn * b[1] * s0.y); o.y = pk2(a[2] * c0.z + sgn * b[2] * s0.z, a[3] * c0.w + sgn * b[3] * s0.w);
    o.z = pk2(a[4] * c1.x + sgn * b[4] * s1.x, a[5] * c1.y + sgn * b[5] * s1.y); o.w = pk2(a[6] * c1.z + sgn * b[6] * s1.z, a[7] * c1.w + sgn * b[7] * s1.w);
    return o;
}
__device__ __forceinline__ u32x4 shfl_xor4(u32x4 w, int m) { u32x4 o; o.x = __shfl_xor(w.x, m); o.y = __shfl_xor(w.y, m); o.z = __shfl_xor(w.z, m); o.w = __shfl_xor(w.w, m); return o; }
__device__ __forceinline__ void ph_qkv_post(const Params& p, int gwave, int gnw, int lane) {
    unsigned char* ws = p.ws;
    const int g16 = lane >> 4, pos = lane & 15, hr = lane >> 3, rpos = lane & 7, f0 = (rpos & 3) * 8;
    const float sgn = (rpos < 4) ? -1.f : 1.f;
    float gqn[8], gqr[8], gqp[8], gkn[8], gkr[8], gkp[8];
#pragma unroll
    for (int i = 0; i < 8; ++i) { gqn[i] = p.q_norm[pos * 8 + i]; gqr[i] = p.q_norm[128 + rpos * 8 + i]; gqp[i] = p.q_norm[128 + (rpos ^ 4) * 8 + i];
                                  gkn[i] = p.k_norm[pos * 8 + i]; gkr[i] = p.k_norm[128 + rpos * 8 + i]; gkp[i] = p.k_norm[128 + (rpos ^ 4) * 8 + i]; }
    for (int t = gwave; t < T; t += gnw) {
        const bf16_t* proj = (const bf16_t*)(ws + WS_PROJ) + (size_t)t * NPROJ;
        const bf16_t* qraw = (const bf16_t*)(ws + WS_QRAW) + (size_t)t * NQ;
        const bf16_t* kvraw = (const bf16_t*)(ws + WS_KVRAW) + (size_t)t * NKV;
        const u32x4 cq = *(const u32x4*)(proj + C_CQ + lane * 8);
        const u32x4 ck = *(const u32x4*)(proj + C_CKV + (lane & 31) * 8);
        const u32x4 kr = *(const u32x4*)(proj + C_KR + rpos * 8);
        const u32x4 qn0 = *(const u32x4*)(qraw + g16 * 192 + pos * 8), qn1 = *(const u32x4*)(qraw + (4 + g16) * 192 + pos * 8), qr = *(const u32x4*)(qraw + hr * 192 + 128 + rpos * 8);
        const u32x4 kn0 = *(const u32x4*)(kvraw + g16 * 256 + pos * 8), kn1 = *(const u32x4*)(kvraw + (4 + g16) * 256 + pos * 8);
        const u32x4 v0 = *(const u32x4*)(kvraw + g16 * 256 + 128 + pos * 8), v1 = *(const u32x4*)(kvraw + (4 + g16) * 256 + 128 + pos * 8);
        const float* rcp = (const float*)(ws + WS_ROPEC) + (size_t)t * 32 + f0; const float* rsp = (const float*)(ws + WS_ROPES) + (size_t)t * 32 + f0;
        const f32x4 c0 = *(const f32x4*)rcp, c1 = *(const f32x4*)(rcp + 4), s0 = *(const f32x4*)rsp, s1 = *(const f32x4*)(rsp + 4);
        const float rcq = rsqrtf(wave_sum(ssq8(cq)) * (1.f / 512.f) + EPS);
        const float rckv = rsqrtf(wave_sum(lane < 32 ? ssq8(ck) : 0.f) * (1.f / 256.f) + EPS);
        float skr = ssq8(kr), nq0 = ssq8(qn0), nq1 = ssq8(qn1), rqs = ssq8(qr), nk0 = ssq8(kn0), nk1 = ssq8(kn1);
#pragma unroll
        for (int o = 1; o < 8; o <<= 1) { skr += __shfl_xor(skr, o); rqs += __shfl_xor(rqs, o); nq0 += __shfl_xor(nq0, o); nq1 += __shfl_xor(nq1, o); nk0 += __shfl_xor(nk0, o); nk1 += __shfl_xor(nk1, o); }
        nq0 += __shfl_xor(nq0, 8); nq1 += __shfl_xor(nq1, 8); nk0 += __shfl_xor(nk0, 8); nk1 += __shfl_xor(nk1, 8);
        const float rc2 = rcq * rcq, rk2 = rckv * rckv;
        const float tq0 = nq0 + __shfl(rqs, 8 * g16), tq1 = nq1 + __shfl(rqs, 8 * (4 + g16));
        const float tqa = __shfl(nq0, 16 * (hr & 3)), tqb = __shfl(nq1, 16 * (hr & 3));
        const float tqr = rqs + ((hr < 4) ? tqa : tqb);
        const float sq0 = rsqrtf(tq0 * rc2 * (1.f / 192.f) + EPS) * rcq * QSCALE, sq1 = rsqrtf(tq1 * rc2 * (1.f / 192.f) + EPS) * rcq * QSCALE, sqr = rsqrtf(tqr * rc2 * (1.f / 192.f) + EPS) * rcq * QSCALE;
        const float rk0 = rsqrtf((nk0 * rk2 + skr) * (1.f / 192.f) + EPS), rk1 = rsqrtf((nk1 * rk2 + skr) * (1.f / 192.f) + EPS);
        const float rka = __shfl(rk0, 16 * (hr & 3)), rkb = __shfl(rk1, 16 * (hr & 3));
        const float rkr = (hr < 4) ? rka : rkb;
        const u32x4 pqr = shfl_xor4(qr, 4), pkr = shfl_xor4(kr, 4);
        const int b = t / SEQ, sidx = t % SEQ;
        bf16_t* Q0 = (bf16_t*)(ws + WS_Q) + ((size_t)(b * 8 + g16) * SEQ + sidx) * 192; bf16_t* Q1 = Q0 + (size_t)4 * SEQ * 192; bf16_t* Qr = (bf16_t*)(ws + WS_Q) + ((size_t)(b * 8 + hr) * SEQ + sidx) * 192;
        bf16_t* K0 = (bf16_t*)(ws + WS_K) + ((size_t)(b * 8 + g16) * SEQ + sidx) * 192; bf16_t* K1 = K0 + (size_t)4 * SEQ * 192; bf16_t* Kr = (bf16_t*)(ws + WS_K) + ((size_t)(b * 8 + hr) * SEQ + sidx) * 192;
        bf16_t* V0 = (bf16_t*)(ws + WS_V) + ((size_t)(b * 8 + g16) * SEQ + sidx) * 128; bf16_t* V1 = V0 + (size_t)4 * SEQ * 128;
        *(u32x4*)(Q0 + pos * 8) = scale8(qn0, sq0, gqn); *(u32x4*)(Q1 + pos * 8) = scale8(qn1, sq1, gqn);
        *(u32x4*)(Qr + 128 + rpos * 8) = rope8(qr, pqr, sqr, gqr, gqp, c0, c1, s0, s1, sgn);
        *(u32x4*)(K0 + pos * 8) = scale8(kn0, rckv * rk0, gkn); *(u32x4*)(K1 + pos * 8) = scale8(kn1, rckv * rk1, gkn);
        *(u32x4*)(Kr + 128 + rpos * 8) = rope8(kr, pkr, rkr, gkr, gkp, c0, c1, s0, s1, sgn);
        const float one[8] = {1.f, 1.f, 1.f, 1.f, 1.f, 1.f, 1.f, 1.f};
        *(u32x4*)(V0 + pos * 8) = scale8(v0, rckv, one); *(u32x4*)(V1 + pos * 8) = scale8(v1, rckv, one);
    }
}
__device__ __forceinline__ void ph_attn_naive(const Params& p, unsigned char* lds, int tid, int bid, int G) {
    const int lane = tid & 63, wv = tid >> 6;
    float* ps = (float*)lds + wv * SEQ;
    float* qs = (float*)(lds + 65536) + wv * 192;
    for (int it = 0; it < (T * 8) / (G * 8); ++it) {
        const int sb = (it & 1) ? (G - 1 - bid) : bid;
        const int gi = it * (G * 8) + sb * 8 + wv;
        const int bh = gi / SEQ, s = gi % SEQ, b = bh >> 3, h = bh & 7;
        const bf16_t* Q = (const bf16_t*)(p.ws + WS_Q) + (size_t)gi * 192;
        const bf16_t* K = (const bf16_t*)(p.ws + WS_K) + (size_t)bh * SEQ * 192;
        const bf16_t* V = (const bf16_t*)(p.ws + WS_KVRAW) + (size_t)(b * SEQ) * NKV + h * 256 + 128;
        for (int d = lane; d < 192; d += 64) qs[d] = bf2f(Q[d]);
        SYNC();
        float mx = -1e30f;
        for (int k0 = 0; k0 <= s; k0 += 64) {
            const int key = k0 + lane; float sc = -INFINITY;
            if (key <= s) {
                const u32x4* kp = (const u32x4*)(K + (size_t)key * 192); float a = 0.f;
                for (int c = 0; c < 24; ++c) { const u32x4 w = kp[c]; const float* q = &qs[c * 8];
                    a += bflo(w.x) * q[0] + bfhi(w.x) * q[1] + bflo(w.y) * q[2] + bfhi(w.y) * q[3] + bflo(w.z) * q[4] + bfhi(w.z) * q[5] + bflo(w.w) * q[6] + bfhi(w.w) * q[7]; }
                sc = a;
            }
            ps[key] = sc;
            mx = fmaxf(mx, sc);
        }
#pragma unroll
        for (int o = 1; o < 64; o <<= 1) mx = fmaxf(mx, __shfl_xor(mx, o));
        SYNC();
        float sum = 0.f;
        for (int key = lane; key <= s; key += 64) { const float e = exp2f(ps[key] - mx); ps[key] = e; sum += e; }
        sum = wave_sum(sum);
        SYNC();
        float o0 = 0.f, o1 = 0.f;
        for (int key = 0; key <= s; ++key) { const float pr = ps[key]; const unsigned w = *(const unsigned*)(V + (size_t)key * NKV + 2 * lane); o0 += pr * bflo(w); o1 += pr * bfhi(w); }
        const float inv = 1.f / sum; o0 *= inv; o1 *= inv;
        const int t = b * SEQ + s;
        *(unsigned*)((bf16_t*)(p.ws + WS_ATTN) + (size_t)t * 1024 + h * 128 + 2 * lane) = pk2(o0, o1);
        SYNC();
    }
}
__device__ __forceinline__ void ph_conv_naive(const Params& p, int gtid, int gn) {
    const bf16_t* proj = (const bf16_t*)(p.ws + WS_PROJ);
    for (int i = gtid; i < T * 1552; i += gn) {
        const int t = i / 1552, c = i % 1552, s = t % SEQ;
        if (c < 1536) {
            float a = p.conv_b[c];
            for (int k = 0; k < 4; ++k) { const int ss = s - 3 + k; if (ss >= 0) a += p.conv_w[k * 1536 + c] * bf2f(proj[(size_t)(t - 3 + k) * NPROJ + C_XBC + c]); }
            ((bf16_t*)(p.ws + WS_XBCA))[(size_t)t * 1536 + c] = (bf16_t)f2bf(silu_f(a));
        } else {
            const int hh = c - 1536; const float v = bf2f(proj[(size_t)t * NPROJ + C_DT + hh]) + p.dt_bias[hh];
            ((float*)(p.ws + WS_DT))[(size_t)t * 16 + hh] = (v > 20.f) ? v : log1pf(__expf(v));
        }
    }
}
__device__ __forceinline__ void ph_ssd_naive(const Params& p, int vb, int lt) {
    const int b = vb >> 4, h = vb & 15, g = h >> 3, pp = lt >> 2, nq = lt & 3;
    const bf16_t* xa = (const bf16_t*)(p.ws + WS_XBCA); const float* dtp = (const float*)(p.ws + WS_DT);
    const bf16_t* proj = (const bf16_t*)(p.ws + WS_PROJ);
    const float a = -__expf(p.a_log[h]), dsk = p.d_skip[h];
    float st[32];
#pragma unroll
    for (int n = 0; n < 32; ++n) st[n] = 0.f;
    for (int s = 0; s < SEQ; ++s) {
        const size_t t = (size_t)b * SEQ + s;
        const float dt = dtp[t * 16 + h], dA = __expf(dt * a);
        const float xv = bf2f(xa[t * 1536 + h * 64 + pp]);
        const bf16_t* Bp = xa + t * 1536 + 1024 + g * 128 + nq * 32; const bf16_t* Cp = xa + t * 1536 + 1280 + g * 128 + nq * 32;
        float y = 0.f; const float dx = dt * xv;
#pragma unroll
        for (int n = 0; n < 32; ++n) { st[n] = st[n] * dA + dx * bf2f(Bp[n]); y += bf2f(Cp[n]) * st[n]; }
        y += __shfl_xor(y, 1); y += __shfl_xor(y, 2);
        if (nq == 0) {
            const float z = bf2f(proj[t * NPROJ + C_Z + h * 64 + pp]);
            ((bf16_t*)(p.ws + WS_YSSD))[t * 1024 + h * 64 + pp] = (bf16_t)f2bf((y + dsk * xv) * silu_f(z));
        }
    }
}
__device__ __forceinline__ void ph_mixnorm(const Params& p, int gwave, int gnw, int lane) {
    for (int t = gwave; t < T; t += gnw) {
        const uint2* ain = (const uint2*)((const bf16_t*)(p.ws + WS_ATTN) + (size_t)t * 1024); const uint2* yin = (const uint2*)((const bf16_t*)(p.ws + WS_YSSD) + (size_t)t * 1024);
        uint2 a[4], y[4]; float sa = 0.f, s0 = 0.f, s1 = 0.f;
#pragma unroll
        for (int j = 0; j < 4; ++j) { a[j] = ain[lane + 64 * j]; y[j] = yin[lane + 64 * j]; sa += sq2(a[j].x) + sq2(a[j].y); const float q = sq2(y[j].x) + sq2(y[j].y); if (j < 2) s0 += q; else s1 += q; }
        const float ra = rsqrtf(wave_sum(sa) * (1.f / 1024.f) + EPS), r0 = rsqrtf(wave_sum(s0) * (1.f / 512.f) + EPS), r1 = rsqrtf(wave_sum(s1) * (1.f / 512.f) + EPS);
        uint2* o = (uint2*)((bf16_t*)(p.ws + WS_MIXIN) + (size_t)t * DM);
#pragma unroll
        for (int j = 0; j < 4; ++j) {
            uint2 r; r.x = pk2(bflo(a[j].x) * ra, bfhi(a[j].x) * ra); r.y = pk2(bflo(a[j].y) * ra, bfhi(a[j].y) * ra); o[lane + 64 * j] = r;
            const float rr = (j < 2) ? r0 : r1;
            uint2 q; q.x = pk2(bflo(y[j].x) * rr, bfhi(y[j].x) * rr); q.y = pk2(bflo(y[j].y) * rr, bfhi(y[j].y) * rr); o[256 + lane + 64 * j] = q;
        }
    }
}
__device__ __forceinline__ void ph_route_naive(const Params& p, unsigned char* lds, int tid, int bid, int G) {
    const int sub = tid >> 7, lt = tid & 127;
    float* base = (float*)(lds + sub * 4096);
    float* q = base; float* sc = base + 256; float* ts = base + 512; int* ti = (int*)(base + 544); float* cs = base + 576; float* bs = base + 832; int* bi = (int*)(base + 848);
    const bf16_t* sk = (const bf16_t*)(p.ws + WS_SUBK);
    for (int it = 0; it < (T * 8) / (G * 4); ++it) {
        const int vb = it * (G * 4) + bid * 4 + sub, t = vb >> 3, h = vb & 7;
        const bf16_t* qp = (const bf16_t*)(p.ws + WS_QP) + (size_t)t * DM + h * 256;
        q[lt] = bf2f(qp[lt]); q[128 + lt] = bf2f(qp[128 + lt]);
        SYNC();
#pragma unroll
        for (int j = 0; j < 2; ++j) {
            const u32x4* kp = (const u32x4*)(sk + ((size_t)(h * 2 + j) * 128 + lt) * 128); float a = 0.f;
            for (int c = 0; c < 16; ++c) { const u32x4 w = kp[c]; const float* qq = q + j * 128 + c * 8;
                a += bflo(w.x) * qq[0] + bfhi(w.x) * qq[1] + bflo(w.y) * qq[2] + bfhi(w.y) * qq[3] + bflo(w.z) * qq[4] + bfhi(w.z) * qq[5] + bflo(w.w) * qq[6] + bfhi(w.w) * qq[7]; }
            sc[j * 128 + lt] = a;
        }
        SYNC();
#pragma unroll
        for (int j = 0; j < 2; ++j) {
            const float v = sc[j * 128 + lt]; int rank = 0;
            for (int k = 0; k < 128; ++k) { const float o = sc[j * 128 + k]; rank += (o > v || (o == v && k < lt)) ? 1 : 0; }
            if (rank < 16) { ts[j * 16 + rank] = v; ti[j * 16 + rank] = lt; }
        }
        SYNC();
        cs[lt] = ts[lt >> 4] + ts[16 + (lt & 15)]; cs[128 + lt] = ts[8 + (lt >> 4)] + ts[16 + (lt & 15)];
        SYNC();
#pragma unroll
        for (int r = 0; r < 2; ++r) {
            const int ci = lt + 128 * r; const float v = cs[ci]; int rank = 0;
            for (int k = 0; k < 256; ++k) { const float o = cs[k]; rank += (o > v || (o == v && k < ci)) ? 1 : 0; }
            if (rank < 16) { bs[rank] = v; bi[rank] = ti[ci >> 4] * 128 + ti[16 + (ci & 15)]; }
        }
        SYNC();
        if (lt < 16) {
            const float mx = bs[0]; float sum = 0.f;
            for (int k = 0; k < 16; ++k) sum += __expf(bs[k] - mx);
            ((float*)(p.ws + WS_GATE))[(size_t)t * 128 + h * 16 + lt] = __expf(bs[lt] - mx) / sum;
            ((int*)(p.ws + WS_IDX))[(size_t)t * 128 + h * 16 + lt] = bi[lt];
        }
        SYNC();
    }
}
__device__ __forceinline__ void ph_peer_naive(const Params& p, unsigned char* lds, int tid, int bid, int G) {
    const int half = tid >> 8, lt = tid & 255, lane = tid & 63, wv = lt >> 6;
    float* red = (float*)(lds + half * 64);
    const bf16_t* U = (const bf16_t*)(p.ws + WS_U16); const bf16_t* V = (const bf16_t*)(p.ws + WS_V16);
    for (int it = 0; it < T / (G * 2); ++it) {
        const int t = it * (G * 2) + bid * 2 + half, b = t / SEQ;
        const u32x4 hw = *(const u32x4*)((const bf16_t*)(p.ws + WS_H2) + (size_t)t * DM + lt * 8);
        const float h0 = bflo(hw.x), h1 = bfhi(hw.x), h2 = bflo(hw.y), h3 = bfhi(hw.y), h4 = bflo(hw.z), h5 = bfhi(hw.z), h6 = bflo(hw.w), h7 = bfhi(hw.w);
        float o0 = 0.f, o1 = 0.f, o2 = 0.f, o3 = 0.f, o4 = 0.f, o5 = 0.f, o6 = 0.f, o7 = 0.f;
        const int* idx = (const int*)(p.ws + WS_IDX) + (size_t)t * 128; const float* gate = (const float*)(p.ws + WS_GATE) + (size_t)t * 128;
        for (int e = 0; e < 128; ++e) {
            const int ex = idx[e];
            const u32x4 uw = *(const u32x4*)(U + (size_t)ex * DM + lt * 8);
            float d = bflo(uw.x) * h0 + bfhi(uw.x) * h1 + bflo(uw.y) * h2 + bfhi(uw.y) * h3 + bflo(uw.z) * h4 + bfhi(uw.z) * h5 + bflo(uw.w) * h6 + bfhi(uw.w) * h7;
            d = wave_sum(d);
            if (lane == 0) red[wv] = d;
            SYNC();
            const float pre = red[0] + red[1] + red[2] + red[3];
            const float a = 0.5f * pre * (1.f + erff(pre * 0.70710678118654752f)) * gate[e];
            SYNC();
            const u32x4 vw = *(const u32x4*)(V + (size_t)ex * DM + lt * 8);
            o0 += a * bflo(vw.x); o1 += a * bfhi(vw.x); o2 += a * bflo(vw.y); o3 += a * bfhi(vw.y); o4 += a * bflo(vw.z); o5 += a * bfhi(vw.z); o6 += a * bflo(vw.w); o7 += a * bfhi(vw.w);
        }
        const float* g2 = (const float*)(p.ws + WS_MOD) + (size_t)b * 6 * DM + 5 * DM + lt * 8;
        float* outp = p.out + (size_t)t * DM + lt * 8;
        const f32x4 x0 = *(const f32x4*)outp, x1 = *(const f32x4*)(outp + 4), ga = *(const f32x4*)g2, gb = *(const f32x4*)(g2 + 4);
        *(f32x4*)outp = (f32x4){x0.x + ga.x * o0, x0.y + ga.y * o1, x0.z + ga.z * o2, x0.w + ga.w * o3};
        *(f32x4*)(outp + 4) = (f32x4){x1.x + gb.x * o4, x1.y + gb.y * o5, x1.z + gb.z * o6, x1.w + gb.w * o7};
    }
}
typedef __bf16 bf16x2_t __attribute__((ext_vector_type(2)));
__device__ __forceinline__ float dot2bf(unsigned a, unsigned b, float c) { return __builtin_amdgcn_fdot2_f32_bf16(__builtin_bit_cast(bf16x2_t, a), __builtin_bit_cast(bf16x2_t, b), c, false); }
__device__ __forceinline__ void ph_peer(const Params& p, LAS unsigned char* ldsl, int wave, int lane, int gwave, int gnw) {
    LAS unsigned char* ring = ldsl + wave * 16384;
    const bf16_t* U = (const bf16_t*)(p.ws + WS_U16); const bf16_t* V = (const bf16_t*)(p.ws + WS_V16);
    const int e_lane = (lane >> 2) & 15; const unsigned lane16 = (unsigned)lane * 16u;
#define PEER_ISSUE(R) do { const int R_ = (R); const int i_ = ((R_ >> 5) << 4) + (R_ & 15); \
        const int e_ = (i_ < 64) ? __builtin_amdgcn_readlane(idx0, i_) : __builtin_amdgcn_readlane(idx1, i_ - 64); \
        const char* base_ = (const char*)(((R_ >> 4) & 1) ? V : U) + (size_t)(unsigned)e_ * (DM * 2); \
        const unsigned* src_ = (const unsigned*)(base_ + lane16); \
        LAS unsigned* dst_ = (LAS unsigned*)(ring + (R_ & 3) * 4096); \
        __builtin_amdgcn_global_load_lds(src_, dst_, 16, 0, 0); \
        __builtin_amdgcn_global_load_lds(src_, dst_, 16, 1024, 0); \
        __builtin_amdgcn_global_load_lds(src_, dst_, 16, 2048, 0); \
        __builtin_amdgcn_global_load_lds(src_, dst_, 16, 3072, 0); } while (0)
#define PEER_WAIT(n) asm volatile("s_waitcnt vmcnt(" #n ")" ::: "memory")
    for (int t = gwave; t < T; t += gnw) {
        const int b = t / SEQ;
        const int idx0 = ((const int*)(p.ws + WS_IDX))[(size_t)t * 128 + lane], idx1 = ((const int*)(p.ws + WS_IDX))[(size_t)t * 128 + 64 + lane];
        const float g0 = ((const float*)(p.ws + WS_GATE))[(size_t)t * 128 + lane], g1 = ((const float*)(p.ws + WS_GATE))[(size_t)t * 128 + 64 + lane];
        u32x4 hreg[4];
#pragma unroll
        for (int j = 0; j < 4; ++j) hreg[j] = *(const u32x4*)((const bf16_t*)(p.ws + WS_H2) + (size_t)t * DM + j * 512 + lane * 8);
        float out[4][8];
#pragma unroll
        for (int j = 0; j < 4; ++j)
#pragma unroll
            for (int i = 0; i < 8; ++i) out[j][i] = 0.f;
        PEER_ISSUE(0); PEER_ISSUE(1); PEER_ISSUE(2);
        for (int hh = 0; hh < 8; ++hh) {
            float pd[16];
#pragma unroll
            for (int k = 0; k < 16; ++k) {
                PEER_ISSUE(hh * 32 + k + 3); PEER_WAIT(12);
                const LAS unsigned char* sl = ring + (k & 3) * 4096 + lane * 16;
                float a = 0.f;
#pragma unroll
                for (int j = 0; j < 4; ++j) { const u32x4 w = *(const LAS u32x4*)(sl + j * 1024);
                    a = dot2bf(w.x, hreg[j].x, a); a = dot2bf(w.y, hreg[j].y, a); a = dot2bf(w.z, hreg[j].z, a); a = dot2bf(w.w, hreg[j].w, a); }
                asm volatile("" : "+v"(a));
                pd[k] = a;
            }
            float q8[8], q4[4], q2[2], q1;
            { const bool hi = (lane & 32) != 0;
#pragma unroll
              for (int i = 0; i < 8; ++i) { const float keep = hi ? pd[i + 8] : pd[i], send = hi ? pd[i] : pd[i + 8]; q8[i] = keep + __shfl_xor(send, 32); } }
            { const bool hi = (lane & 16) != 0;
#pragma unroll
              for (int i = 0; i < 4; ++i) { const float keep = hi ? q8[i + 4] : q8[i], send = hi ? q8[i] : q8[i + 4]; q4[i] = keep + __shfl_xor(send, 16); } }
            { const bool hi = (lane & 8) != 0;
#pragma unroll
              for (int i = 0; i < 2; ++i) { const float keep = hi ? q4[i + 2] : q4[i], send = hi ? q4[i] : q4[i + 2]; q2[i] = keep + __shfl_xor(send, 8); } }
            { const bool hi = (lane & 4) != 0; const float keep = hi ? q2[1] : q2[0], send = hi ? q2[0] : q2[1]; q1 = keep + __shfl_xor(send, 4); }
            q1 += __shfl_xor(q1, 1); q1 += __shfl_xor(q1, 2);
            const float gsel = (hh < 4) ? g0 : g1;
            const float gate = __shfl(gsel, (hh & 3) * 16 + e_lane);
            const float act = 0.5f * q1 * (1.f + erff(q1 * 0.70710678118654752f)) * gate;
#pragma unroll
            for (int k = 0; k < 16; ++k) {
                if (k < 13) { PEER_ISSUE(hh * 32 + 16 + k + 3); PEER_WAIT(12); }
                else if (hh < 7) { PEER_ISSUE(hh * 32 + 16 + k + 3); PEER_WAIT(12); }
                else if (k == 13) PEER_WAIT(8); else if (k == 14) PEER_WAIT(4); else PEER_WAIT(0);
                const float a = __builtin_bit_cast(float, __builtin_amdgcn_readlane(__builtin_bit_cast(int, act), 4 * k));
                const LAS unsigned char* sl = ring + (k & 3) * 4096 + lane * 16;
#pragma unroll
                for (int j = 0; j < 4; ++j) { const u32x4 w = *(const LAS u32x4*)(sl + j * 1024);
                    out[j][0] += a * bflo(w.x); out[j][1] += a * bfhi(w.x); out[j][2] += a * bflo(w.y); out[j][3] += a * bfhi(w.y);
                    out[j][4] += a * bflo(w.z); out[j][5] += a * bfhi(w.z); out[j][6] += a * bflo(w.w); out[j][7] += a * bfhi(w.w);
                    asm volatile("" : "+v"(out[j][0]), "+v"(out[j][1]), "+v"(out[j][2]), "+v"(out[j][3]), "+v"(out[j][4]), "+v"(out[j][5]), "+v"(out[j][6]), "+v"(out[j][7])); }
            }
        }
        const float* g2 = (const float*)(p.ws + WS_MOD) + (size_t)b * 6 * DM + 5 * DM;
        float* outp = p.out + (size_t)t * DM;
#pragma unroll
        for (int j = 0; j < 4; ++j) {
            const int c = j * 512 + lane * 8;
            const f32x4 x0 = *(const f32x4*)(outp + c), x1 = *(const f32x4*)(outp + c + 4), ga = *(const f32x4*)(g2 + c), gb = *(const f32x4*)(g2 + c + 4);
            *(f32x4*)(outp + c) = (f32x4){x0.x + ga.x * out[j][0], x0.y + ga.y * out[j][1], x0.z + ga.z * out[j][2], x0.w + ga.w * out[j][3]};
            *(f32x4*)(outp + c + 4) = (f32x4){x1.x + gb.x * out[j][4], x1.y + gb.y * out[j][5], x1.z + gb.z * out[j][6], x1.w + gb.w * out[j][7]};
        }
    }
#undef PEER_ISSUE
#undef PEER_WAIT
}
typedef short bf16x8 __attribute__((ext_vector_type(8)));
typedef short s16x4 __attribute__((ext_vector_type(4)));
typedef float f32x16 __attribute__((ext_vector_type(16)));
typedef float f32x2_t __attribute__((ext_vector_type(2)));
__device__ __forceinline__ int crow(int r, int hi) { return (r & 3) + 8 * (r >> 2) + 4 * hi; }
__device__ __forceinline__ unsigned cvtpk(float lo, float hi) { f32x2_t v = {lo, hi}; bf16x2_t b = __builtin_convertvector(v, bf16x2_t); return __builtin_bit_cast(unsigned, b); }
__device__ __forceinline__ s16x4 vtr(const LAS unsigned char* pp) { return __builtin_bit_cast(s16x4, __builtin_amdgcn_ds_read_tr16_b64_v4i16((LAS s16x4*)pp)); }
#define TR_PAIR(lo_, hi_, addr_, off_, hioff_) do { asm volatile("ds_read_b64_tr_b16 %0, %1 offset:%c2" : "=&v"(lo_) : "v"(addr_), "i"(off_) : "memory"); \
        asm volatile("ds_read_b64_tr_b16 %0, %1 offset:%c2" : "=&v"(hi_) : "v"(addr_), "i"((off_) + (hioff_)) : "memory"); } while (0)
#define LDS_WAIT_PIN() do { asm volatile("s_waitcnt lgkmcnt(0)" ::: "memory"); __builtin_amdgcn_sched_barrier(0); } while (0)
constexpr int AT_SLOT = 40960, AT_VOFF = 24576;
__device__ __forceinline__ void attn_unit(const Params& p, LAS unsigned char* ldsl, int bh, int qb, int wave, int lane) {
    asm volatile("" : "+v"(lane));
    const int r32 = lane & 31, hi = lane >> 5, b = bh >> 3, h = bh & 7;
    const bf16_t* Kbh = (const bf16_t*)(p.ws + WS_K) + (size_t)bh * SEQ * 192;
    const bf16_t* Vb = (const bf16_t*)(p.ws + WS_V) + (size_t)bh * SEQ * 128;
    const int NT = (qb * 256 + 256) / 64;
    unsigned koff[3];
#pragma unroll
    for (int i = 0; i < 3; ++i) { const int o = 64 * (wave * 3 + i) + lane, k = o / 24, sl = o - 24 * k; int c = sl - ((k >> 1) & 7); c += (c < 0) ? 24 : 0; koff[i] = (unsigned)(k * 192 + c * 8) * 2u; }
    const int vid = wave * 2;
    const unsigned voff = (unsigned)((16 * (vid & 3) + (lane >> 2)) * 128 + (vid >> 2) * 32 + (lane & 3) * 8) * 2u;
#define AT_ISSUE(t, slot) do { const unsigned char* ks_ = (const unsigned char*)(Kbh + (size_t)(t) * 64 * 192); LAS unsigned char* sb_ = ldsl + (slot) * AT_SLOT; \
        __builtin_amdgcn_global_load_lds((const unsigned*)(ks_ + koff[0]), (LAS unsigned*)(sb_ + (wave * 3 + 0) * 1024), 16, 0, 0); \
        __builtin_amdgcn_global_load_lds((const unsigned*)(ks_ + koff[1]), (LAS unsigned*)(sb_ + (wave * 3 + 1) * 1024), 16, 0, 0); \
        __builtin_amdgcn_global_load_lds((const unsigned*)(ks_ + koff[2]), (LAS unsigned*)(sb_ + (wave * 3 + 2) * 1024), 16, 0, 0); \
        const unsigned char* vs_ = (const unsigned char*)(Vb + (size_t)(t) * 64 * 128); \
        __builtin_amdgcn_global_load_lds((const unsigned*)(vs_ + voff), (LAS unsigned*)(sb_ + AT_VOFF + vid * 1024), 16, 0, 0); \
        __builtin_amdgcn_global_load_lds((const unsigned*)(vs_ + voff + 16u * 128u * 2u), (LAS unsigned*)(sb_ + AT_VOFF + (vid + 1) * 1024), 16, 0, 0); } while (0)
    bf16x8 qr[12];
    {
        const unsigned char* Qblk = (const unsigned char*)((const bf16_t*)(p.ws + WS_Q) + ((size_t)bh * SEQ + qb * 256 + wave * 32) * 192);
        LAS unsigned char* qs = ldsl + wave * 12288;
#pragma unroll
        for (int k = 0; k < 12; ++k) {
            const int o = 64 * k + lane, row = o / 24, sl = o - 24 * row; int c = sl - ((row >> 1) & 7); c += (c < 0) ? 24 : 0;
            __builtin_amdgcn_global_load_lds((const unsigned*)(Qblk + (unsigned)(row * 384 + c * 16)), (LAS unsigned*)(qs + k * 1024), 16, 0, 0);
        }
        asm volatile("s_waitcnt vmcnt(0)" ::: "memory");
        const LAS unsigned char* qrow = qs + r32 * 384; const int qc0 = hi + ((r32 >> 1) & 7);
#pragma unroll
        for (int s = 0; s < 12; ++s) { int sl_ = qc0 + 2 * s; sl_ -= (sl_ >= 24) ? 24 : 0; qr[s] = *(const LAS bf16x8*)(qrow + sl_ * 16); }
#pragma unroll
        for (int s = 0; s < 12; ++s) asm volatile("" : "+v"(qr[s]));
        asm volatile("s_waitcnt lgkmcnt(0)" ::: "memory"); __builtin_amdgcn_s_barrier(); asm volatile("" ::: "memory");
    }
    AT_ISSUE(0, 0); AT_ISSUE(1, 1);
    f32x16 o[4];
#pragma unroll
    for (int d0 = 0; d0 < 4; ++d0)
#pragma unroll
        for (int r = 0; r < 16; ++r) o[d0][r] = 0.f;
    float m = -1e30f, l = 0.f;
    const int kfo = r32 * 384, kc0 = hi + ((r32 >> 1) & 7);
    const int vfo = AT_VOFF + ((lane >> 4) & 1) * 32 + (lane & 3) * 8 + (4 * hi + ((lane & 15) >> 2)) * 64;
    const int qrel = wave * 32 + r32;
    int slot = 0;
    for (int t = 0; t < NT; ++t) {
        if (t + 1 < NT) asm volatile("s_waitcnt vmcnt(5)" ::: "memory"); else asm volatile("s_waitcnt vmcnt(0)" ::: "memory");
        __builtin_amdgcn_s_barrier(); asm volatile("" ::: "memory");
        if (t + 2 < NT) { const int s2 = (slot == 0) ? 2 : slot - 1; AT_ISSUE(t + 2, s2); }
        const int jb = t - (NT - 4);
        if (!(jb >= 0 && 64 * jb > wave * 32 + 31)) {
            const LAS unsigned char* kp = ldsl + slot * AT_SLOT + kfo;
            int kc = kc0; asm volatile("" : "+v"(kc));
            f32x16 p0, p1;
#pragma unroll
            for (int r = 0; r < 16; ++r) { p0[r] = 0.f; p1[r] = 0.f; }
#pragma unroll
            for (int s = 0; s < 12; ++s) {
                int sl_ = kc + 2 * s; sl_ -= (sl_ >= 24) ? 24 : 0;
                const bf16x8 k0 = *(const LAS bf16x8*)(kp + sl_ * 16), k1 = *(const LAS bf16x8*)(kp + sl_ * 16 + 32 * 384);
                p0 = __builtin_amdgcn_mfma_f32_32x32x16_bf16(k0, qr[s], p0, 0, 0, 0);
                p1 = __builtin_amdgcn_mfma_f32_32x32x16_bf16(k1, qr[s], p1, 0, 0, 0);
            }
            if (jb >= 0 && 64 * jb + 63 > wave * 32) {
#pragma unroll
                for (int r = 0; r < 16; ++r) { const int kv = 64 * jb + crow(r, hi); if (kv > qrel) p0[r] = -INFINITY; if (kv + 32 > qrel) p1[r] = -INFINITY; }
            }
            float rm = fmaxf(p0[0], p1[0]);
#pragma unroll
            for (int r = 1; r < 16; ++r) rm = fmaxf(rm, fmaxf(p0[r], p1[r]));
            rm = fmaxf(rm, __shfl_xor(rm, 32));
            const float mn = fmaxf(m, rm);
            if (__any(rm > m + 8.f)) {

                const float alpha = __builtin_amdgcn_exp2f(m - mn);
                l *= alpha;
#pragma unroll
                for (int r = 0; r < 16; ++r) { const float ar = __shfl(alpha, crow(r, hi));
#pragma unroll
                    for (int d0 = 0; d0 < 4; ++d0) o[d0][r] *= ar; }
                m = mn;
            }
            float ls = 0.f;
#pragma unroll
            for (int r = 0; r < 16; ++r) { p0[r] = __builtin_amdgcn_exp2f(p0[r] - m); p1[r] = __builtin_amdgcn_exp2f(p1[r] - m); ls += p0[r] + p1[r]; }
            l += ls;
            bf16x8 pa[4];
            { u32x4 w;
              w.x = cvtpk(p0[0], p0[1]); w.y = cvtpk(p0[2], p0[3]); w.z = cvtpk(p0[4], p0[5]); w.w = cvtpk(p0[6], p0[7]); pa[0] = __builtin_bit_cast(bf16x8, w);
              w.x = cvtpk(p0[8], p0[9]); w.y = cvtpk(p0[10], p0[11]); w.z = cvtpk(p0[12], p0[13]); w.w = cvtpk(p0[14], p0[15]); pa[1] = __builtin_bit_cast(bf16x8, w);
              w.x = cvtpk(p1[0], p1[1]); w.y = cvtpk(p1[2], p1[3]); w.z = cvtpk(p1[4], p1[5]); w.w = cvtpk(p1[6], p1[7]); pa[2] = __builtin_bit_cast(bf16x8, w);
              w.x = cvtpk(p1[8], p1[9]); w.y = cvtpk(p1[10], p1[11]); w.z = cvtpk(p1[12], p1[13]); w.w = cvtpk(p1[14], p1[15]); pa[3] = __builtin_bit_cast(bf16x8, w); }
            const unsigned vpa = (unsigned)(size_t)(ldsl + slot * AT_SLOT + vfo);
            s16x4 lo[2][4], hh[2][4];
#define AT_VREAD(bf, d0_) do { TR_PAIR(lo[bf][0], hh[bf][0], vpa, (d0_) * 4096 + 0 * 1024, 512); TR_PAIR(lo[bf][1], hh[bf][1], vpa, (d0_) * 4096 + 1 * 1024, 512); \
                TR_PAIR(lo[bf][2], hh[bf][2], vpa, (d0_) * 4096 + 2 * 1024, 512); TR_PAIR(lo[bf][3], hh[bf][3], vpa, (d0_) * 4096 + 3 * 1024, 512); } while (0)
#define AT_VWAIT(n, bf) do { asm volatile("s_waitcnt lgkmcnt(" #n ")" : "+v"(lo[bf][0]), "+v"(hh[bf][0]), "+v"(lo[bf][1]), "+v"(hh[bf][1]), "+v"(lo[bf][2]), "+v"(hh[bf][2]), "+v"(lo[bf][3]), "+v"(hh[bf][3]) :: "memory"); __builtin_amdgcn_sched_barrier(0); } while (0)
            AT_VREAD(0, 0);
#pragma unroll
            for (int d0 = 0; d0 < 4; ++d0) {
                const int bf = d0 & 1;
                if (d0 < 3) { AT_VREAD(bf ^ 1, d0 + 1); AT_VWAIT(8, bf); } else AT_VWAIT(0, bf);
#pragma unroll
                for (int ks = 0; ks < 4; ++ks)
                    o[d0] = __builtin_amdgcn_mfma_f32_32x32x16_bf16(pa[ks], (bf16x8){lo[bf][ks][0], lo[bf][ks][1], lo[bf][ks][2], lo[bf][ks][3], hh[bf][ks][0], hh[bf][ks][1], hh[bf][ks][2], hh[bf][ks][3]}, o[d0], 0, 0, 0);
            }
#undef AT_VREAD
#undef AT_VWAIT
        }
        slot = (slot == 2) ? 0 : slot + 1;
    }
    l += __shfl_xor(l, 32);
    const float inv = 1.f / l;
    bf16_t* Ow = (bf16_t*)(p.ws + WS_MIXRAW) + ((size_t)b * SEQ + qb * 256 + wave * 32) * DM + h * 128 + r32;
#pragma unroll
    for (int r = 0; r < 16; ++r) { const float ir = __shfl(inv, crow(r, hi));
#pragma unroll
        for (int d0 = 0; d0 < 4; ++d0) Ow[(size_t)crow(r, hi) * DM + d0 * 32] = (bf16_t)f2bf(o[d0][r] * ir); }
    __builtin_amdgcn_sched_barrier(0);
    float ssr[16];
#pragma unroll
    for (int r = 0; r < 16; ++r) { const float ir = __shfl(inv, crow(r, hi)); const float v0 = o[0][r] * ir, v1 = o[1][r] * ir, v2 = o[2][r] * ir, v3 = o[3][r] * ir; ssr[r] = (v0 * v0 + v1 * v1) + (v2 * v2 + v3 * v3); }
    float q8[8], q4[4], q2[2], q1;
    { const bool bb = (lane & 16) != 0;
#pragma unroll
      for (int i = 0; i < 8; ++i) { const float keep = bb ? ssr[i + 8] : ssr[i], send = bb ? ssr[i] : ssr[i + 8]; q8[i] = keep + __shfl_xor(send, 16); } }
    { const bool bb = (lane & 8) != 0;
#pragma unroll
      for (int i = 0; i < 4; ++i) { const float keep = bb ? q8[i + 4] : q8[i], send = bb ? q8[i] : q8[i + 4]; q4[i] = keep + __shfl_xor(send, 8); } }
    { const bool bb = (lane & 4) != 0;
#pragma unroll
      for (int i = 0; i < 2; ++i) { const float keep = bb ? q4[i + 2] : q4[i], send = bb ? q4[i] : q4[i + 2]; q2[i] = keep + __shfl_xor(send, 4); } }
    { const bool bb = (lane & 2) != 0; const float keep = bb ? q2[1] : q2[0], send = bb ? q2[0] : q2[1]; q1 = keep + __shfl_xor(send, 2); }
    q1 += __shfl_xor(q1, 1);
    { const int rs = ((lane >> 4) & 1) * 8 + ((lane >> 3) & 1) * 4 + ((lane >> 2) & 1) * 2 + ((lane >> 1) & 1);
      if ((lane & 1) == 0) ((float*)(p.ws + WS_PSQA))[((size_t)b * SEQ + qb * 256 + wave * 32 + crow(rs, hi)) * 8 + h] = q1; }
    asm volatile("s_waitcnt lgkmcnt(0)" ::: "memory"); __builtin_amdgcn_s_barrier(); asm volatile("" ::: "memory");
#undef AT_ISSUE
}
__device__ __forceinline__ void ph_attn(const Params& p, LAS unsigned char* ldsl, int bid, int G, int wave, int lane) {
    const int vcu = (bid & 7) * (G >> 3) + (bid >> 3);
    const int bh = vcu >> 2, s = vcu & 3;
    attn_unit(p, ldsl, bh, 7 - s, wave, lane);
    attn_unit(p, ldsl, bh, s, wave, lane);
}
__device__ __forceinline__ int f2sort(float f) { const int u = __builtin_bit_cast(int, f); return u ^ ((u >> 31) & 0x7fffffff); }
__device__ __forceinline__ float sort2f(int k) { return __builtin_bit_cast(float, k ^ ((k >> 31) & 0x7fffffff)); }
#define CE_(a_, b_) do { const int hi_ = max(a_, b_); b_ = min(a_, b_); a_ = hi_; } while (0)
#define INS16(L, x) do { int x_ = (x); _Pragma("unroll") for (int i_ = 0; i_ < 16; ++i_) { const int hi_ = max(L[i_], x_); x_ = min(L[i_], x_); L[i_] = hi_; } } while (0)
#define SORT16(v) do { CE_(v[0], v[13]); CE_(v[1], v[12]); CE_(v[2], v[15]); CE_(v[3], v[14]); CE_(v[4], v[8]); CE_(v[5], v[6]); CE_(v[7], v[11]); CE_(v[9], v[10]); CE_(v[0], v[5]); CE_(v[1], v[7]); CE_(v[2], v[9]); CE_(v[3], v[4]); CE_(v[6], v[13]); CE_(v[8], v[14]); CE_(v[10], v[15]); CE_(v[11], v[12]); CE_(v[0], v[1]); CE_(v[2], v[3]); CE_(v[4], v[5]); CE_(v[6], v[8]); CE_(v[7], v[9]); CE_(v[10], v[11]); CE_(v[12], v[13]); CE_(v[14], v[15]); CE_(v[0], v[2]); CE_(v[1], v[3]); CE_(v[4], v[10]); CE_(v[5], v[11]); CE_(v[6], v[7]); CE_(v[8], v[9]); CE_(v[12], v[14]); CE_(v[13], v[15]); CE_(v[1], v[2]); CE_(v[3], v[12]); CE_(v[4], v[6]); CE_(v[5], v[7]); CE_(v[8], v[10]); CE_(v[9], v[11]); CE_(v[13], v[14]); CE_(v[1], v[4]); CE_(v[2], v[6]); CE_(v[5], v[8]); CE_(v[7], v[10]); CE_(v[9], v[13]); CE_(v[11], v[14]); CE_(v[2], v[4]); CE_(v[3], v[6]); CE_(v[9], v[12]); CE_(v[11], v[13]); CE_(v[3], v[5]); CE_(v[6], v[8]); CE_(v[7], v[9]); CE_(v[10], v[12]); CE_(v[3], v[4]); CE_(v[5], v[6]); CE_(v[7], v[8]); CE_(v[9], v[10]); CE_(v[11], v[12]); CE_(v[6], v[7]); CE_(v[8], v[9]); } while (0)
#define BMERGE16(v) do { CE_(v[0], v[8]); CE_(v[1], v[9]); CE_(v[2], v[10]); CE_(v[3], v[11]); CE_(v[4], v[12]); CE_(v[5], v[13]); CE_(v[6], v[14]); CE_(v[7], v[15]); CE_(v[0], v[4]); CE_(v[1], v[5]); CE_(v[2], v[6]); CE_(v[3], v[7]); CE_(v[8], v[12]); CE_(v[9], v[13]); CE_(v[10], v[14]); CE_(v[11], v[15]); CE_(v[0], v[2]); CE_(v[1], v[3]); CE_(v[4], v[6]); CE_(v[5], v[7]); CE_(v[8], v[10]); CE_(v[9], v[11]); CE_(v[12], v[14]); CE_(v[13], v[15]); CE_(v[0], v[1]); CE_(v[2], v[3]); CE_(v[4], v[5]); CE_(v[6], v[7]); CE_(v[8], v[9]); CE_(v[10], v[11]); CE_(v[12], v[13]); CE_(v[14], v[15]); } while (0)
__device__ __forceinline__ void ph_route(const Params& p, LAS unsigned char* ldsl, int wave, int lane, int gwave, int gnw) {
    const int r32 = lane & 31, hi = lane >> 5;
    const bf16_t* SK = (const bf16_t*)(p.ws + WS_SUBK);
    LAS unsigned char* tab = ldsl + wave * 4096 + lane * 32;
    const int bid_ = gwave >> 3, h = bid_ & 7;
    LAS unsigned char* skl = ldsl + 32768;
    { const u32x4* src = (const u32x4*)(SK + (size_t)h * 2 * 128 * 128); int i0 = wave * 64 + lane; asm volatile("" : "+v"(i0));
      for (int i = i0; i < 4096; i += NTHR) *(LAS u32x4*)(skl + (i >> 4) * 272 + (i & 15) * 16) = src[i];
      __syncthreads(); }
    for (int tile = (bid_ >> 3) * NWAVES + wave; tile < T / 32; tile += (gnw >> 6) * NWAVES) {
        const int t0 = tile * 32;
        int hi4 = hi * 4; asm volatile("" : "+v"(hi4));
        int S0[16], S1[16];
#pragma unroll
        for (int j = 0; j < 2; ++j) {
            const bf16_t* qp = (const bf16_t*)(p.ws + WS_QP) + (size_t)(t0 + r32) * DM + h * 256 + j * 128 + 8 * hi;
            asm volatile("" : "+v"(qp));
            bf16x8 bq[8];
#pragma unroll
            for (int s = 0; s < 8; ++s) bq[s] = *(const bf16x8*)(qp + 16 * s);
            int L[16];
#pragma unroll
            for (int kb = 0; kb < 4; ++kb) {
                const LAS unsigned char* ap = skl + (j * 128 + kb * 32 + r32) * 272 + hi * 16;
                f32x16 acc;
#pragma unroll
                for (int r = 0; r < 16; ++r) acc[r] = 0.f;
#pragma unroll
                for (int s = 0; s < 8; ++s) acc = __builtin_amdgcn_mfma_f32_32x32x16_bf16(*(const LAS bf16x8*)(ap + 32 * s), bq[s], acc, 0, 0, 0);
                int v[16];
#pragma unroll
                for (int r = 0; r < 16; ++r) v[r] = (f2sort(acc[r]) & ~127) | ((127 - (kb * 32 + (r & 3) + 8 * (r >> 2))) - hi4);
                SORT16(v);
                if (kb == 0) {
#pragma unroll
                    for (int i = 0; i < 16; ++i) L[i] = v[i];
                } else {
#pragma unroll
                    for (int i = 0; i < 16; ++i) L[i] = max(L[i], v[15 - i]);
                    BMERGE16(L);
                }
                __builtin_amdgcn_sched_barrier(0);
            }
            int Y[16];
#pragma unroll
            for (int i = 0; i < 16; ++i) Y[i] = __shfl_xor(L[i], 32);
#pragma unroll
            for (int i = 0; i < 16; ++i) L[i] = max(L[i], Y[15 - i]);
            BMERGE16(L);
#pragma unroll
            for (int i = 0; i < 16; ++i) { if (j == 0) S0[i] = L[i]; else S1[i] = L[i]; }
        }
        float f0[16], f1[16];
        {
            unsigned w0[4], w1[4];
#pragma unroll
            for (int i = 0; i < 16; ++i) { f0[i] = sort2f(S0[i] & ~127); f1[i] = sort2f(S1[i] & ~127); }
#pragma unroll
            for (int q = 0; q < 4; ++q) {
                w0[q] = (unsigned)(127 - (S0[4 * q] & 127)) | ((unsigned)(127 - (S0[4 * q + 1] & 127)) << 8) | ((unsigned)(127 - (S0[4 * q + 2] & 127)) << 16) | ((unsigned)(127 - (S0[4 * q + 3] & 127)) << 24);
                w1[q] = (unsigned)(127 - (S1[4 * q] & 127)) | ((unsigned)(127 - (S1[4 * q + 1] & 127)) << 8) | ((unsigned)(127 - (S1[4 * q + 2] & 127)) << 16) | ((unsigned)(127 - (S1[4 * q + 3] & 127)) << 24);
            }
            *(LAS u32x4*)(tab) = (u32x4){w0[0], w0[1], w0[2], w0[3]};
            *(LAS u32x4*)(tab + 16) = (u32x4){w1[0], w1[1], w1[2], w1[3]};
        }
        int Lv[16];
        const bool hb = (hi != 0);
        Lv[0] = hb ? ((f2sort(f0[1] + f1[0]) & ~255) | 239) : ((f2sort(f0[0] + f1[0]) & ~255) | 255);
        Lv[1] = hb ? ((f2sort(f0[1] + f1[1]) & ~255) | 238) : ((f2sort(f0[0] + f1[1]) & ~255) | 254);
        Lv[2] = hb ? ((f2sort(f0[1] + f1[2]) & ~255) | 237) : ((f2sort(f0[0] + f1[2]) & ~255) | 253);
        Lv[3] = hb ? ((f2sort(f0[1] + f1[3]) & ~255) | 236) : ((f2sort(f0[0] + f1[3]) & ~255) | 252);
        Lv[4] = hb ? ((f2sort(f0[1] + f1[4]) & ~255) | 235) : ((f2sort(f0[0] + f1[4]) & ~255) | 251);
        Lv[5] = hb ? ((f2sort(f0[1] + f1[5]) & ~255) | 234) : ((f2sort(f0[0] + f1[5]) & ~255) | 250);
        Lv[6] = hb ? ((f2sort(f0[1] + f1[6]) & ~255) | 233) : ((f2sort(f0[0] + f1[6]) & ~255) | 249);
        Lv[7] = hb ? ((f2sort(f0[1] + f1[7]) & ~255) | 232) : ((f2sort(f0[0] + f1[7]) & ~255) | 248);
        Lv[8] = hb ? (int)0x80000000 : ((f2sort(f0[0] + f1[8]) & ~255) | 247);
        Lv[9] = hb ? (int)0x80000000 : ((f2sort(f0[0] + f1[9]) & ~255) | 246);
        Lv[10] = hb ? (int)0x80000000 : ((f2sort(f0[0] + f1[10]) & ~255) | 245);
        Lv[11] = hb ? (int)0x80000000 : ((f2sort(f0[0] + f1[11]) & ~255) | 244);
        Lv[12] = hb ? (int)0x80000000 : ((f2sort(f0[0] + f1[12]) & ~255) | 243);
        Lv[13] = hb ? (int)0x80000000 : ((f2sort(f0[0] + f1[13]) & ~255) | 242);
        Lv[14] = hb ? (int)0x80000000 : ((f2sort(f0[0] + f1[14]) & ~255) | 241);
        Lv[15] = hb ? (int)0x80000000 : ((f2sort(f0[0] + f1[15]) & ~255) | 240);
        { const float v_ = hb ? (f0[2] + f1[1]) : (f0[2] + f1[0]); int cv_ = (f2sort(v_) & ~255) | (hb ? 222 : 223); INS16(Lv, cv_); __builtin_amdgcn_sched_barrier(0); }
        { const float v_ = hb ? (f0[2] + f1[3]) : (f0[2] + f1[2]); int cv_ = (f2sort(v_) & ~255) | (hb ? 220 : 221); INS16(Lv, cv_); __builtin_amdgcn_sched_barrier(0); }
        { const float v_ = hb ? (f0[3] + f1[0]) : (f0[2] + f1[4]); int cv_ = (f2sort(v_) & ~255) | (hb ? 207 : 219); INS16(Lv, cv_); __builtin_amdgcn_sched_barrier(0); }
        { const float v_ = hb ? (f0[3] + f1[2]) : (f0[3] + f1[1]); int cv_ = (f2sort(v_) & ~255) | (hb ? 205 : 206); INS16(Lv, cv_); __builtin_amdgcn_sched_barrier(0); }
        { const float v_ = hb ? (f0[4] + f1[0]) : (f0[3] + f1[3]); int cv_ = (f2sort(v_) & ~255) | (hb ? 191 : 204); INS16(Lv, cv_); __builtin_amdgcn_sched_barrier(0); }
        { const float v_ = hb ? (f0[4] + f1[2]) : (f0[4] + f1[1]); int cv_ = (f2sort(v_) & ~255) | (hb ? 189 : 190); INS16(Lv, cv_); __builtin_amdgcn_sched_barrier(0); }
        { const float v_ = hb ? (f0[5] + f1[1]) : (f0[5] + f1[0]); int cv_ = (f2sort(v_) & ~255) | (hb ? 174 : 175); INS16(Lv, cv_); __builtin_amdgcn_sched_barrier(0); }
        { const float v_ = hb ? (f0[6] + f1[1]) : (f0[6] + f1[0]); int cv_ = (f2sort(v_) & ~255) | (hb ? 158 : 159); INS16(Lv, cv_); __builtin_amdgcn_sched_barrier(0); }
        { const float v_ = hb ? (f0[7] + f1[1]) : (f0[7] + f1[0]); int cv_ = (f2sort(v_) & ~255) | (hb ? 142 : 143); INS16(Lv, cv_); __builtin_amdgcn_sched_barrier(0); }
        { const float v_ = hb ? (f0[9] + f1[0]) : (f0[8] + f1[0]); int cv_ = (f2sort(v_) & ~255) | (hb ? 111 : 127); INS16(Lv, cv_); __builtin_amdgcn_sched_barrier(0); }
        { const float v_ = hb ? (f0[11] + f1[0]) : (f0[10] + f1[0]); int cv_ = (f2sort(v_) & ~255) | (hb ? 79 : 95); INS16(Lv, cv_); __builtin_amdgcn_sched_barrier(0); }
        { const float v_ = hb ? (f0[13] + f1[0]) : (f0[12] + f1[0]); int cv_ = (f2sort(v_) & ~255) | (hb ? 47 : 63); INS16(Lv, cv_); __builtin_amdgcn_sched_barrier(0); }
        { const float v_ = hb ? (f0[15] + f1[0]) : (f0[14] + f1[0]); int cv_ = (f2sort(v_) & ~255) | (hb ? 15 : 31); INS16(Lv, cv_); __builtin_amdgcn_sched_barrier(0); }
        { int Y[16];
#pragma unroll
          for (int i = 0; i < 16; ++i) Y[i] = __shfl_xor(Lv[i], 32);
#pragma unroll
          for (int i = 0; i < 16; ++i) Lv[i] = max(Lv[i], Y[15 - i]);
          BMERGE16(Lv); }
        float g[16]; float sum = 0.f; const float mx = sort2f(Lv[0] & ~255);
        int Le[16];
#pragma unroll
        for (int i = 0; i < 16; ++i) {
            g[i] = __expf(sort2f(Lv[i] & ~255) - mx); sum += g[i];
            const int pos = 255 - (Lv[i] & 255);
            const int ia = *(const LAS unsigned char*)(tab + (pos >> 4)), ib = *(const LAS unsigned char*)(tab + 16 + (pos & 15));
            Le[i] = ia * 128 + ib;
        }
        const float inv = 1.f / sum;
        if (hi == 0) {
            int* ip = (int*)(p.ws + WS_IDX) + (size_t)(t0 + r32) * 128 + h * 16; float* gp = (float*)(p.ws + WS_GATE) + (size_t)(t0 + r32) * 128 + h * 16;
#pragma unroll
            for (int i = 0; i < 4; ++i) {
                *(u32x4*)(ip + 4 * i) = (u32x4){(unsigned)Le[4 * i], (unsigned)Le[4 * i + 1], (unsigned)Le[4 * i + 2], (unsigned)Le[4 * i + 3]};
                *(f32x4*)(gp + 4 * i) = (f32x4){g[4 * i] * inv, g[4 * i + 1] * inv, g[4 * i + 2] * inv, g[4 * i + 3] * inv};
            }
        }
        asm volatile("s_waitcnt lgkmcnt(0)" ::: "memory");
    }
}
__device__ __forceinline__ void ph_conv(const Params& p, int gwave, int gnw, int lane) {
    const bf16_t* proj = (const bf16_t*)(p.ws + WS_PROJ);
    bf16_t* xa = (bf16_t*)(p.ws + WS_XBCA);
    for (int task = gwave; task < 1536 + 256; task += gnw) {
        if (task < 1536) {
            const int run = task / 3, cg = (task % 3) * 64 + lane, c0 = cg * 8;
            const int t0 = run * 32, s0 = t0 % SEQ;
            float w0[8], w1[8], w2[8], w3[8], bs[8], h1[8], h2[8], h3[8];
#pragma unroll
            for (int i = 0; i < 8; ++i) { w0[i] = p.conv_w[0 * 1536 + c0 + i]; w1[i] = p.conv_w[1 * 1536 + c0 + i]; w2[i] = p.conv_w[2 * 1536 + c0 + i]; w3[i] = p.conv_w[3 * 1536 + c0 + i]; bs[i] = p.conv_b[c0 + i]; h1[i] = 0.f; h2[i] = 0.f; h3[i] = 0.f; }
            const bf16_t* src = proj + (size_t)t0 * NPROJ + C_XBC + c0;
            if (s0 > 0) {
                const u32x4 a = *(const u32x4*)(src - (size_t)1 * NPROJ), b = *(const u32x4*)(src - (size_t)2 * NPROJ), c = *(const u32x4*)(src - (size_t)3 * NPROJ);
                h1[0] = bflo(a.x); h1[1] = bfhi(a.x); h1[2] = bflo(a.y); h1[3] = bfhi(a.y); h1[4] = bflo(a.z); h1[5] = bfhi(a.z); h1[6] = bflo(a.w); h1[7] = bfhi(a.w);
                h2[0] = bflo(b.x); h2[1] = bfhi(b.x); h2[2] = bflo(b.y); h2[3] = bfhi(b.y); h2[4] = bflo(b.z); h2[5] = bfhi(b.z); h2[6] = bflo(b.w); h2[7] = bfhi(b.w);
                h3[0] = bflo(c.x); h3[1] = bfhi(c.x); h3[2] = bflo(c.y); h3[3] = bfhi(c.y); h3[4] = bflo(c.z); h3[5] = bfhi(c.z); h3[6] = bflo(c.w); h3[7] = bfhi(c.w);
            }
            bf16_t* dst = xa + (size_t)t0 * 1536 + c0;
#pragma unroll 16
            for (int i = 0; i < 32; ++i) {
                const u32x4 a = *(const u32x4*)(src + (size_t)i * NPROJ);
                float cur[8] = {bflo(a.x), bfhi(a.x), bflo(a.y), bfhi(a.y), bflo(a.z), bfhi(a.z), bflo(a.w), bfhi(a.w)};
                float o[8];
#pragma unroll
                for (int k = 0; k < 8; ++k) { o[k] = silu_fast(bs[k] + w3[k] * cur[k] + w2[k] * h1[k] + w1[k] * h2[k] + w0[k] * h3[k]); h3[k] = h2[k]; h2[k] = h1[k]; h1[k] = cur[k]; }
                u32x4 w; w.x = pk2(o[0], o[1]); w.y = pk2(o[2], o[3]); w.z = pk2(o[4], o[5]); w.w = pk2(o[6], o[7]);
                *(u32x4*)(dst + (size_t)i * 1536) = w;
            }
        } else {
            const int t = (task - 1536) * 64 + lane;
            const u32x4 a = *(const u32x4*)(proj + (size_t)t * NPROJ + C_DT), b = *(const u32x4*)(proj + (size_t)t * NPROJ + C_DT + 8);
            const float raw[16] = {bflo(a.x), bfhi(a.x), bflo(a.y), bfhi(a.y), bflo(a.z), bfhi(a.z), bflo(a.w), bfhi(a.w), bflo(b.x), bfhi(b.x), bflo(b.y), bfhi(b.y), bflo(b.z), bfhi(b.z), bflo(b.w), bfhi(b.w)};
            float* dto = (float*)(p.ws + WS_DT) + (size_t)t * 16; float* cso = (float*)(p.ws + WS_CS) + (size_t)t * 16;
            float dtv[16], csv[16];
#pragma unroll
            for (int hh = 0; hh < 16; ++hh) {
                const float v = raw[hh] + p.dt_bias[hh];
                const float dt = (v > 20.f) ? v : log1pf(__expf(v));
                float c = dt * (-__expf(p.a_log[hh]));
#pragma unroll
                for (int o = 1; o < 64; o <<= 1) { const float u = __shfl_up(c, o); if (lane >= o) c += u; }
                dtv[hh] = dt; csv[hh] = c;
            }
#pragma unroll
            for (int q = 0; q < 4; ++q) { *(f32x4*)(dto + 4 * q) = (f32x4){dtv[4 * q], dtv[4 * q + 1], dtv[4 * q + 2], dtv[4 * q + 3]}; *(f32x4*)(cso + 4 * q) = (f32x4){csv[4 * q], csv[4 * q + 1], csv[4 * q + 2], csv[4 * q + 3]}; }
        }
    }
}
constexpr int P4_ROW = 1152;
__device__ __forceinline__ void fp4_row_load(const Params& p, int row, int lane, f32x4 (&v)[8]) {
    const f32x4* src = (const f32x4*)(((row >= 16384) ? p.v_exp : p.u_exp) + (size_t)(row & 16383) * DM) + lane;
#pragma unroll
    for (int j = 0; j < 8; ++j) v[j] = src[64 * j];
}
__device__ __forceinline__ void fp4_row_store(const Params& p, int row, int lane, const f32x4 (&v)[8]) {
    float mx = 0.f;
#pragma unroll
    for (int j = 0; j < 8; ++j) mx = fmaxf(mx, fmaxf(fmaxf(fabsf(v[j].x), fabsf(v[j].y)), fmaxf(fabsf(v[j].z), fabsf(v[j].w))));
    unsigned sb = (__builtin_bit_cast(unsigned, mx * (1.f / 6.f)) + 0x000fffffu) >> 20;
    if ((float)__builtin_bit_cast(float, sb << 20) * 6.f < mx) sb += 1u;
    sb = min(max(sb, 825u), 824u + 255u) - 824u;
    const float inv = 1.f / __builtin_bit_cast(float, (sb + 824u) << 20);
    unsigned w[4];
#pragma unroll
    for (int q = 0; q < 4; ++q) {
        const f32x4 a = v[2 * q] * inv, b = v[2 * q + 1] * inv;
        unsigned r = 0u;
        r = __builtin_amdgcn_cvt_scalef32_pk_fp4_f32(r, a.x, a.y, 1.0f, 0);
        r = __builtin_amdgcn_cvt_scalef32_pk_fp4_f32(r, a.z, a.w, 1.0f, 1);
        r = __builtin_amdgcn_cvt_scalef32_pk_fp4_f32(r, b.x, b.y, 1.0f, 2);
        r = __builtin_amdgcn_cvt_scalef32_pk_fp4_f32(r, b.z, b.w, 1.0f, 3);
        w[q] = r;
    }
    const size_t e = (size_t)(row & 16383), x = (size_t)(lane >> 3);
    *(u32x4*)(p.ws + ((row >= 16384) ? WS_V4D : WS_U4D) + x * ((size_t)16384 * 128) + e * 128 + (lane & 7) * 16) = (u32x4){w[0], w[1], w[2], w[3]};
    *(unsigned char*)(p.ws + ((row >= 16384) ? WS_V4S : WS_U4S) + x * ((size_t)16384 * 8) + e * 8 + (lane & 7)) = (unsigned char)sb;
}
constexpr int SSD_IN = 41472, SSD_BM = 0, SSD_CM = 16384, SSD_XS = 32768, SSD_Z = 36864, SSD_DT = 40960, SSD_CS = 41216, SSD_ST = 3 * SSD_IN, SSD_PART = SSD_ST + 16384, SSD_SYNC = SSD_PART + 4096;
__device__ __forceinline__ void ssd_decay_block(f32x16& cbt, const f32x4 (&c4)[4], const f32x4 (&d4)[4], float cs_l, int sb, int l, int hi, bool diag) {
#pragma unroll
    for (int q = 0; q < 4; ++q) {
#pragma unroll
        for (int i = 0; i < 4; ++i) {
            const int s = 32 * sb + 8 * q + 4 * hi + i;
            float e = __expf(cs_l - c4[q][i]) * d4[q][i];
            if (diag) e = (s <= l) ? e : 0.f;
            cbt[4 * q + i] *= e;
        }
    }
}
__device__ __forceinline__ void ph_ssd(const Params& p, LAS unsigned char* ldsl, int bid, int wave, int lane) {
    const int b = bid >> 5, h = (bid >> 1) & 15, ph = bid & 1, g = h >> 3;
    const int r32 = lane & 31, hi = lane >> 5;
    const size_t tb0 = (size_t)b * SEQ;
    LAS unsigned* sync = (LAS unsigned*)(ldsl + SSD_SYNC);
    if (threadIdx.x < 16) sync[threadIdx.x] = (threadIdx.x >= 14) ? 0xffffffffu : 0u;
    for (int i = threadIdx.x; i < 8192 / 16; i += NTHR) *(LAS u32x4*)(ldsl + SSD_ST + i * 16) = (u32x4){0u, 0u, 0u, 0u};
    asm volatile("s_waitcnt lgkmcnt(0)" ::: "memory"); __builtin_amdgcn_s_barrier(); asm volatile("" ::: "memory");
    if (wave >= 6) {
        const int cvw = bid * 2 + (wave - 6);
        f32x4 ra[8], rb[8], rc[8], rd[8];
        fp4_row_load(p, cvw, lane, ra); fp4_row_load(p, 512 + cvw, lane, rb); fp4_row_load(p, 1024 + cvw, lane, rc); fp4_row_load(p, 1536 + cvw, lane, rd);
        for (int c = 0; c < 16; ++c) {
            fp4_row_store(p, (4 * c) * 512 + cvw, lane, ra);
            if (c + 1 < 16) fp4_row_load(p, (4 * c + 4) * 512 + cvw, lane, ra);
            fp4_row_store(p, (4 * c + 1) * 512 + cvw, lane, rb);
            if (c + 1 < 16) fp4_row_load(p, (4 * c + 5) * 512 + cvw, lane, rb);
            fp4_row_store(p, (4 * c + 2) * 512 + cvw, lane, rc);
            if (c + 1 < 16) fp4_row_load(p, (4 * c + 6) * 512 + cvw, lane, rc);
            fp4_row_store(p, (4 * c + 3) * 512 + cvw, lane, rd);
            if (c + 1 < 16) fp4_row_load(p, (4 * c + 7) * 512 + cvw, lane, rd);
        }
    } else {
        const bf16_t* xa = (const bf16_t*)(p.ws + WS_XBCA); const bf16_t* proj = (const bf16_t*)(p.ws + WS_PROJ);
        const float dsk = p.d_skip[h];
        const int dq = (wave - 2) & 3;
        const int dr0 = 4 * dq + (lane >> 4);
        const bf16_t* bsrc = xa + (tb0 + dr0) * 1536 + 1024 + g * 128 + (((lane & 15) ^ (dr0 & 15)) * 8);
        const bf16_t* csrc = xa + (tb0 + dr0) * 1536 + 1280 + g * 128 + (((lane & 15) ^ (dr0 & 15)) * 8);
        const bf16_t* xsrc = xa + (tb0 + 16 * dq + (lane >> 2)) * 1536 + h * 64 + ph * 32 + (lane & 3) * 8;
        const bf16_t* zsrc = proj + (tb0 + 16 * dq + (lane >> 2)) * NPROJ + C_Z + h * 64 + ph * 32 + (lane & 3) * 8;
        const float* dsrc = (const float*)(p.ws + ((dq == 0) ? WS_DT : WS_CS)) + (tb0 + lane) * 16 + h;
#define SSD_G16(src, dst) __builtin_amdgcn_global_load_lds((const unsigned*)(src), (LAS unsigned*)(dst), 16, 0, 0)
#define SSD_ISSUE(c, buf) do { if (wave >= 2) { LAS unsigned char* in_ = ldsl + (buf) * SSD_IN; const size_t to_ = (size_t)(c) * 64 * 1536; \
        SSD_G16(bsrc + to_, in_ + SSD_BM + dq * 1024); SSD_G16(bsrc + to_ + 16 * 1536, in_ + SSD_BM + (dq + 4) * 1024); SSD_G16(bsrc + to_ + 32 * 1536, in_ + SSD_BM + (dq + 8) * 1024); SSD_G16(bsrc + to_ + 48 * 1536, in_ + SSD_BM + (dq + 12) * 1024); \
        SSD_G16(csrc + to_, in_ + SSD_CM + dq * 1024); SSD_G16(csrc + to_ + 16 * 1536, in_ + SSD_CM + (dq + 4) * 1024); SSD_G16(csrc + to_ + 32 * 1536, in_ + SSD_CM + (dq + 8) * 1024); SSD_G16(csrc + to_ + 48 * 1536, in_ + SSD_CM + (dq + 12) * 1024); \
        SSD_G16(xsrc + to_, in_ + SSD_XS + dq * 1024); SSD_G16(zsrc + (size_t)(c) * 64 * NPROJ, in_ + SSD_Z + dq * 1024); \
        if (dq < 2) __builtin_amdgcn_global_load_lds((const unsigned*)(dsrc + (size_t)(c) * 64 * 16), (LAS unsigned*)(in_ + ((dq == 0) ? SSD_DT : SSD_CS)), 4, 0, 0); } } while (0)
        f32x16 S;
#pragma unroll
        for (int r = 0; r < 16; ++r) S[r] = 0.f;
        SSD_ISSUE(0, 0); SSD_ISSUE(1, 1);
        const int xfo = ((lane >> 4) & 1) * 32 + (lane & 3) * 8 + (4 * hi + ((lane & 15) >> 2)) * 64;
        for (int c = 0; c < SEQ / 64; ++c) {
            if (wave >= 2) { if (c + 1 >= SEQ / 64) asm volatile("s_waitcnt vmcnt(0)" ::: "memory"); else if (dq < 2) asm volatile("s_waitcnt vmcnt(11)" ::: "memory"); else asm volatile("s_waitcnt vmcnt(10)" ::: "memory"); }
            asm volatile("s_waitcnt lgkmcnt(0)" ::: "memory");
            {
                const unsigned sa = (unsigned)(size_t)(ldsl + SSD_SYNC), tgt = (unsigned)(c + 1);
                asm volatile("ds_write_b32 %0, %1" :: "v"(sa + 32u + 4u * (unsigned)wave), "v"(tgt) : "memory");
                for (;;) { u32x4 a, b_; asm volatile("ds_read_b128 %0, %2 offset:32\n\tds_read_b128 %1, %2 offset:48\n\ts_waitcnt lgkmcnt(0)" : "=&v"(a), "=&v"(b_) : "v"(sa) : "memory");
                    const unsigned m = min(min(min(a.x, a.y), min(a.z, a.w)), min(min(b_.x, b_.y), min(b_.z, b_.w)));
                    if (__builtin_amdgcn_readfirstlane(m) >= tgt) break; __builtin_amdgcn_s_sleep(1); }
            }
            asm volatile("" ::: "memory");
            if (c + 2 < SEQ / 64) SSD_ISSUE(c + 2, (c + 2) % 3);
            const LAS unsigned char* in = ldsl + (c % 3) * SSD_IN;
            const LAS unsigned char* STin = ldsl + SSD_ST + (c & 1) * 8192;
            LAS unsigned char* STout = ldsl + SSD_ST + ((c + 1) & 1) * 8192;
            const LAS float* dtl = (const LAS float*)(in + SSD_DT); const LAS float* csl = (const LAS float*)(in + SSD_CS);
            if (wave < 2) {
                const int lb = wave, l = 32 * lb + r32;
                const unsigned xpa = (unsigned)(size_t)(in + SSD_XS + xfo + (32 * lb) * 64);
                s16x4 lo0, hh0, lo1, hh1; TR_PAIR(lo0, hh0, xpa, 0, 512); TR_PAIR(lo1, hh1, xpa, 1024, 512);
                const int l1 = 32 + r32;
                const float cs_l = csl[l], cs_l1 = csl[l1];
                bf16x8 cf[8], bdf[8], cf1[8]; f32x4 c4[4], d4[4];
#pragma unroll
                for (int ks = 0; ks < 8; ++ks) {
                    cf[ks] = *(const LAS bf16x8*)(in + SSD_CM + l * 256 + (((2 * ks + hi) ^ (l & 15)) << 4));
                    bdf[ks] = *(const LAS bf16x8*)(in + SSD_BM + l * 256 + (((2 * ks + hi) ^ (l & 15)) << 4));
                    if (wave == 0) cf1[ks] = *(const LAS bf16x8*)(in + SSD_CM + l1 * 256 + (((2 * ks + hi) ^ (l1 & 15)) << 4));
                }
                LDS_WAIT_PIN();
#pragma unroll
                for (int q = 0; q < 4; ++q) { c4[q] = *(const LAS f32x4*)(csl + 32 * lb + 8 * q + 4 * hi); d4[q] = *(const LAS f32x4*)(dtl + 32 * lb + 8 * q + 4 * hi); }
                const bf16x8 xf0 = (bf16x8){lo0[0], lo0[1], lo0[2], lo0[3], hh0[0], hh0[1], hh0[2], hh0[3]}, xf1 = (bf16x8){lo1[0], lo1[1], lo1[2], lo1[3], hh1[0], hh1[1], hh1[2], hh1[3]};
                if (wave == 0) {
                    f32x16 ca, cb;
#pragma unroll
                    for (int r = 0; r < 16; ++r) { ca[r] = 0.f; cb[r] = 0.f; }
#pragma unroll
                    for (int ks = 0; ks < 8; ks += 2) { ca = __builtin_amdgcn_mfma_f32_32x32x16_bf16(bdf[ks], cf1[ks], ca, 0, 0, 0); cb = __builtin_amdgcn_mfma_f32_32x32x16_bf16(bdf[ks + 1], cf1[ks + 1], cb, 0, 0, 0); }
                    ca += cb;
                    ssd_decay_block(ca, c4, d4, cs_l1, 0, l1, hi, false);
                    u32x4 w0, w1;
                    w0.x = cvtpk(ca[0], ca[1]); w0.y = cvtpk(ca[2], ca[3]); w0.z = cvtpk(ca[4], ca[5]); w0.w = cvtpk(ca[6], ca[7]);
                    w1.x = cvtpk(ca[8], ca[9]); w1.y = cvtpk(ca[10], ca[11]); w1.z = cvtpk(ca[12], ca[13]); w1.w = cvtpk(ca[14], ca[15]);
                    f32x16 pa;
#pragma unroll
                    for (int r = 0; r < 16; ++r) pa[r] = 0.f;
                    pa = __builtin_amdgcn_mfma_f32_32x32x16_bf16(xf0, __builtin_bit_cast(bf16x8, w0), pa, 0, 0, 0);
                    pa = __builtin_amdgcn_mfma_f32_32x32x16_bf16(xf1, __builtin_bit_cast(bf16x8, w1), pa, 0, 0, 0);
                    LAS unsigned char* pp = ldsl + SSD_PART + lane * 64;
#pragma unroll
                    for (int q = 0; q < 4; ++q) *(LAS f32x4*)(pp + q * 16) = (f32x4){pa[4 * q], pa[4 * q + 1], pa[4 * q + 2], pa[4 * q + 3]};
                    asm volatile("s_waitcnt lgkmcnt(0)" ::: "memory");
                    asm volatile("ds_write_b32 %0, %1" :: "v"((unsigned)(size_t)(ldsl + SSD_SYNC) + 4u), "v"((unsigned)(c + 1)) : "memory");
                }
                f32x16 acc;
                {
                    f32x16 ca, cb;
#pragma unroll
                    for (int r = 0; r < 16; ++r) { ca[r] = 0.f; cb[r] = 0.f; acc[r] = 0.f; }
#pragma unroll
                    for (int ks = 0; ks < 8; ks += 2) { ca = __builtin_amdgcn_mfma_f32_32x32x16_bf16(bdf[ks], cf[ks], ca, 0, 0, 0); cb = __builtin_amdgcn_mfma_f32_32x32x16_bf16(bdf[ks + 1], cf[ks + 1], cb, 0, 0, 0); }
                    ca += cb;
                    ssd_decay_block(ca, c4, d4, cs_l, lb, l, hi, true);
                    u32x4 w0, w1;
                    w0.x = cvtpk(ca[0], ca[1]); w0.y = cvtpk(ca[2], ca[3]); w0.z = cvtpk(ca[4], ca[5]); w0.w = cvtpk(ca[6], ca[7]);
                    w1.x = cvtpk(ca[8], ca[9]); w1.y = cvtpk(ca[10], ca[11]); w1.z = cvtpk(ca[12], ca[13]); w1.w = cvtpk(ca[14], ca[15]);
                    acc = __builtin_amdgcn_mfma_f32_32x32x16_bf16(xf0, __builtin_bit_cast(bf16x8, w0), acc, 0, 0, 0);
                    acc = __builtin_amdgcn_mfma_f32_32x32x16_bf16(xf1, __builtin_bit_cast(bf16x8, w1), acc, 0, 0, 0);
                }
                {
                    f32x16 ya, yb;
#pragma unroll
                    for (int r = 0; r < 16; ++r) { ya[r] = 0.f; yb[r] = 0.f; }
#pragma unroll
                    for (int ks = 0; ks < 8; ks += 2) { ya = __builtin_amdgcn_mfma_f32_32x32x16_bf16(*(const LAS bf16x8*)(STin + (2 * ks + hi) * 512 + r32 * 16), cf[ks], ya, 0, 0, 0); yb = __builtin_amdgcn_mfma_f32_32x32x16_bf16(*(const LAS bf16x8*)(STin + (2 * ks + 2 + hi) * 512 + r32 * 16), cf[ks + 1], yb, 0, 0, 0); }
                    const float ecs = __expf(cs_l);
#pragma unroll
                    for (int r = 0; r < 16; ++r) acc[r] += (ya[r] + yb[r]) * ecs;
                }
                if (wave == 1) {
                    for (;;) { unsigned fl; asm volatile("ds_read_b32 %0, %1 offset:4\n\ts_waitcnt lgkmcnt(0)" : "=&v"(fl) : "v"((unsigned)(size_t)(ldsl + SSD_SYNC)) : "memory");
                        if (__builtin_amdgcn_readfirstlane(fl) >= (unsigned)(c + 1)) break; __builtin_amdgcn_s_sleep(1); }
                    asm volatile("" ::: "memory");
                    const LAS unsigned char* pp = ldsl + SSD_PART + lane * 64;
#pragma unroll
                    for (int q = 0; q < 4; ++q) { const f32x4 v = *(const LAS f32x4*)(pp + q * 16); acc[4 * q] += v[0]; acc[4 * q + 1] += v[1]; acc[4 * q + 2] += v[2]; acc[4 * q + 3] += v[3]; }
                }
                float yss = 0.f;
                {
                    LAS unsigned char* zrow = (LAS unsigned char*)(ldsl + (c % 3) * SSD_IN + SSD_Z) + l * 64 + 8 * hi;
                    u32x2 xw[4], zw[4];
#pragma unroll
                    for (int q = 0; q < 4; ++q) { xw[q] = *(const LAS u32x2*)(in + SSD_XS + l * 64 + (8 * q + 4 * hi) * 2); zw[q] = *(const LAS u32x2*)(zrow + 16 * q); }
#pragma unroll
                    for (int q = 0; q < 4; ++q) {
                        const float y0 = (acc[4 * q + 0] + dsk * bflo(xw[q].x)) * silu_fast(bflo(zw[q].x)), y1 = (acc[4 * q + 1] + dsk * bfhi(xw[q].x)) * silu_fast(bfhi(zw[q].x));
                        const float y2 = (acc[4 * q + 2] + dsk * bflo(xw[q].y)) * silu_fast(bflo(zw[q].y)), y3 = (acc[4 * q + 3] + dsk * bfhi(xw[q].y)) * silu_fast(bfhi(zw[q].y));
                        yss += (y0 * y0 + y1 * y1) + (y2 * y2 + y3 * y3);
                        u32x2 o; o.x = pk2(y0, y1); o.y = pk2(y2, y3);
                        *(LAS u32x2*)(zrow + 16 * q) = o;
                    }
                    asm volatile("s_waitcnt lgkmcnt(0)" ::: "memory");
                    const LAS unsigned char* zt = (const LAS unsigned char*)(ldsl + (c % 3) * SSD_IN + SSD_Z) + (32 * lb + (lane >> 2)) * 64 + (lane & 3) * 16;
                    bf16_t* yo = (bf16_t*)(p.ws + WS_MIXRAW) + (tb0 + (size_t)c * 64 + 32 * lb + (lane >> 2)) * DM + 1024 + h * 64 + ph * 32 + (lane & 3) * 8;
                    const u32x4 o0 = *(const LAS u32x4*)(zt), o1 = *(const LAS u32x4*)(zt + 16 * 64);
                    *(u32x4*)(yo) = o0; *(u32x4*)(yo + (size_t)16 * DM) = o1;
                }
                yss += __shfl_xor(yss, 32);
                if (hi == 0) ((float*)(p.ws + WS_PSQS))[(tb0 + (size_t)c * 64 + l) * 32 + h * 2 + ph] = yss;
            } else {
                const int nb = wave - 2;
                const float cs63 = csl[63];
                { const float dec = __expf(cs63);
#pragma unroll
                  for (int r = 0; r < 16; ++r) S[r] *= dec; }
                const int brow = 4 * hi + ((lane & 15) >> 2), bch = 4 * nb + 2 * ((lane >> 4) & 1) + ((lane & 3) >> 1);
                const unsigned xpa = (unsigned)(size_t)(in + xfo);
                const unsigned bpa = (unsigned)(size_t)(in + SSD_BM + brow * 256 + ((bch ^ brow) << 4) + (lane & 1) * 8);
                const unsigned bpb = (unsigned)(size_t)(in + SSD_BM + (brow + 8) * 256 + ((bch ^ (brow + 8)) << 4) + (lane & 1) * 8);
                s16x4 lo[4], hh[4], blo[4], bhh[4]; f32x4 c0[4], c1[4], d0[4], d1[4];
                TR_PAIR(lo[0], hh[0], xpa, SSD_XS + 0 * 1024, 512); TR_PAIR(lo[1], hh[1], xpa, SSD_XS + 1 * 1024, 512); TR_PAIR(lo[2], hh[2], xpa, SSD_XS + 2 * 1024, 512); TR_PAIR(lo[3], hh[3], xpa, SSD_XS + 3 * 1024, 512);
                asm volatile("ds_read_b64_tr_b16 %0, %1 offset:%c2" : "=&v"(blo[0]) : "v"(bpa), "i"(0 * 4096) : "memory"); asm volatile("ds_read_b64_tr_b16 %0, %1 offset:%c2" : "=&v"(bhh[0]) : "v"(bpb), "i"(0 * 4096) : "memory");
                asm volatile("ds_read_b64_tr_b16 %0, %1 offset:%c2" : "=&v"(blo[1]) : "v"(bpa), "i"(1 * 4096) : "memory"); asm volatile("ds_read_b64_tr_b16 %0, %1 offset:%c2" : "=&v"(bhh[1]) : "v"(bpb), "i"(1 * 4096) : "memory");
                asm volatile("ds_read_b64_tr_b16 %0, %1 offset:%c2" : "=&v"(blo[2]) : "v"(bpa), "i"(2 * 4096) : "memory"); asm volatile("ds_read_b64_tr_b16 %0, %1 offset:%c2" : "=&v"(bhh[2]) : "v"(bpb), "i"(2 * 4096) : "memory");
                asm volatile("ds_read_b64_tr_b16 %0, %1 offset:%c2" : "=&v"(blo[3]) : "v"(bpa), "i"(3 * 4096) : "memory"); asm volatile("ds_read_b64_tr_b16 %0, %1 offset:%c2" : "=&v"(bhh[3]) : "v"(bpb), "i"(3 * 4096) : "memory");
#pragma unroll
                for (int ks = 0; ks < 4; ++ks) { c0[ks] = *(const LAS f32x4*)(csl + 16 * ks + 4 * hi); c1[ks] = *(const LAS f32x4*)(csl + 16 * ks + 8 + 4 * hi);
                                                 d0[ks] = *(const LAS f32x4*)(dtl + 16 * ks + 4 * hi); d1[ks] = *(const LAS f32x4*)(dtl + 16 * ks + 8 + 4 * hi); }
                LDS_WAIT_PIN();
                u32x4 aw[4];
#pragma unroll
                for (int ks = 0; ks < 4; ++ks) {
                    float xf[8];
#pragma unroll
                    for (int j = 0; j < 4; ++j) { xf[j] = bf2f((unsigned short)lo[ks][j]) * __expf(cs63 - c0[ks][j]) * d0[ks][j]; xf[4 + j] = bf2f((unsigned short)hh[ks][j]) * __expf(cs63 - c1[ks][j]) * d1[ks][j]; }
                    aw[ks].x = cvtpk(xf[0], xf[1]); aw[ks].y = cvtpk(xf[2], xf[3]); aw[ks].z = cvtpk(xf[4], xf[5]); aw[ks].w = cvtpk(xf[6], xf[7]);
                }
#pragma unroll
                for (int ks = 0; ks < 4; ++ks)
                    S = __builtin_amdgcn_mfma_f32_32x32x16_bf16(__builtin_bit_cast(bf16x8, aw[ks]), (bf16x8){blo[ks][0], blo[ks][1], blo[ks][2], blo[ks][3], bhh[ks][0], bhh[ks][1], bhh[ks][2], bhh[ks][3]}, S, 0, 0, 0);
                const int n = 32 * nb + r32;
#pragma unroll
                for (int r = 0; r < 16; ++r) *(LAS unsigned short*)(STout + (n >> 3) * 512 + crow(r, hi) * 16 + (n & 7) * 2) = (unsigned short)f2bf(S[r]);
            }
        }
#undef SSD_ISSUE
#undef SSD_G16
    }
    asm volatile("s_waitcnt vmcnt(0) lgkmcnt(0)" ::: "memory");
    __builtin_amdgcn_s_barrier(); asm volatile("" ::: "memory");
}
constexpr size_t P5_DSL = (size_t)16384 * 128, P5_SSL = (size_t)16384 * 8;
constexpr int PD = 4;
template <int CTRL> __device__ __forceinline__ float dpp_xadd(float v) { return v + __builtin_bit_cast(float, __builtin_amdgcn_update_dpp(0, __builtin_bit_cast(int, v), CTRL, 0xf, 0xf, false)); }
#define P5_CVT(wd, bs) __builtin_amdgcn_cvt_scalef32_pk_f32_fp4((wd), 1.0f, (bs))
#define P5_LOAD16(dst, src) do { const u32x4* s_ = (const u32x4*)(src); const u32x4 a_ = s_[0], b_ = s_[1], c_ = s_[2], d_ = s_[3]; \
        dst[0] = a_.x; dst[1] = a_.y; dst[2] = a_.z; dst[3] = a_.w; dst[4] = b_.x; dst[5] = b_.y; dst[6] = b_.z; dst[7] = b_.w; \
        dst[8] = c_.x; dst[9] = c_.y; dst[10] = c_.z; dst[11] = c_.w; dst[12] = d_.x; dst[13] = d_.y; dst[14] = d_.z; dst[15] = d_.w; } while (0)
#define P5_ISSUE(slot, e) do { if constexpr (PV == 8) { const size_t e_ = (size_t)((unsigned)__builtin_amdgcn_readfirstlane((int)(e)) & 2047u); wq[slot] = *(const u32x4*)(TD + (e_ << 10) + g * 128 + q16); } \
        else if constexpr (PV == 2) { } else { wq[slot] = *(const u32x4*)(TD + (size_t)(((unsigned)(e) << 7) + q16)); } } while (0)
#define P5_SCB(e) ((unsigned)SC[(e) * 8u])
#define P5_SCALE(code) __builtin_bit_cast(float, ((code) << 20) + 0x33800000u)
#define P5_TABLE(off) do { const u32x4* src_ = (const u32x4*)(p.ws + (off) + (size_t)x * P5_SSL); \
        int k0_ = wave * 64 + lane; asm volatile("" : "+v"(k0_)); \
        for (int k_ = k0_; k_ < (int)(P5_SSL / 16); k_ += NTHR) ((LAS u32x4*)ldsl)[k_] = src_[k_]; __syncthreads(); } while (0)
template <int PV> __device__ __forceinline__ void ph_peer_u(const Params& p, LAS unsigned char* ldsl, int bid, int wave, int lane) {
    const int x = bid & 7, r = (bid >> 3) * NWAVES + wave, g = lane >> 3, q = lane & 7, colb = 32 * x + 4 * q;
    const unsigned char* TD = p.ws + WS_U4D + (size_t)x * P5_DSL; const unsigned q16 = q * 16; const LAS unsigned char* SC = ldsl + q;
    const unsigned* IDX = (const unsigned*)(p.ws + WS_IDX) + g * 16; const bf16_t* XM = (const bf16_t*)(p.ws + WS_X1M) + colb; const float* PSQ = (const float*)(p.ws + WS_RINV2);
    float* PART = (float*)(p.ws + WS_PART) + (size_t)x * 128 + g * 16;
    unsigned ec[16], en[16]; u32x4 wq[PD]; unsigned sb; f32x2_t hf[16]; f32x4 sh[8]; u32x2 xn[8]; float pqn;
    {
        P5_LOAD16(ec, IDX + (size_t)r * 128);
        const float* shp = (const float*)(p.ws + WS_MOD) + 3 * DM + colb;
#pragma unroll
        for (int j = 0; j < 8; ++j) sh[j] = *(const f32x4*)(shp + j * 256);
        const float r2 = PSQ[r];
#pragma unroll
        for (int j = 0; j < 8; ++j) { const u32x2 a = *(const u32x2*)(XM + (size_t)r * DM + j * 256);
            hf[2 * j] = (f32x2_t){bflo(a.x) * r2 + sh[j][0], bfhi(a.x) * r2 + sh[j][1]}; hf[2 * j + 1] = (f32x2_t){bflo(a.y) * r2 + sh[j][2], bfhi(a.y) * r2 + sh[j][3]}; }
#pragma unroll
        for (int i = 0; i < PD; ++i) P5_ISSUE(i, ec[i]);
        P5_TABLE(WS_U4S);
        sb = P5_SCB(ec[0]);
    }
    auto tok = [&](unsigned (&ec)[16], unsigned (&en)[16], const int n) __attribute__((always_inline)) {
        const int t = r + 256 * n, tn = r + 256 * min(n + 1, 63);
        P5_LOAD16(en, IDX + (size_t)tn * 128);
#pragma unroll
        for (int j = 0; j < 8; ++j) xn[j] = *(const u32x2*)(XM + (size_t)tn * DM + j * 256);
        pqn = PSQ[tn];
        if (((n + 1) & 7) == 0 && n < 63) {
            const float* shp = (const float*)(p.ws + WS_MOD) + (size_t)((n + 1) >> 3) * 6 * DM + 3 * DM + colb;
#pragma unroll
            for (int j = 0; j < 8; ++j) sh[j] = *(const f32x4*)(shp + j * 256);
        }
        float sp[16];
#pragma unroll
        for (int i = 0; i < 16; ++i) {
            __builtin_amdgcn_sched_barrier(0);
            const u32x4 w = wq[i % PD];
            if (i + PD < 16) P5_ISSUE(i % PD, ec[(i + PD) & 15]); else P5_ISSUE(i % PD, en[(i + PD) & 15]);
            const unsigned sbn = P5_SCB((i < 15) ? ec[(i + 1) & 15] : en[0]);
            const float scl = P5_SCALE(sb); sb = sbn;
            f32x2_t a2 = (f32x2_t){0.f, 0.f}, b2 = (f32x2_t){0.f, 0.f};
            a2 += P5_CVT(w.x, 0) * hf[0]; b2 += P5_CVT(w.x, 1) * hf[1]; a2 += P5_CVT(w.x, 2) * hf[2]; b2 += P5_CVT(w.x, 3) * hf[3];
            a2 += P5_CVT(w.y, 0) * hf[4]; b2 += P5_CVT(w.y, 1) * hf[5]; a2 += P5_CVT(w.y, 2) * hf[6]; b2 += P5_CVT(w.y, 3) * hf[7];
            a2 += P5_CVT(w.z, 0) * hf[8]; b2 += P5_CVT(w.z, 1) * hf[9]; a2 += P5_CVT(w.z, 2) * hf[10]; b2 += P5_CVT(w.z, 3) * hf[11];
            a2 += P5_CVT(w.w, 0) * hf[12]; b2 += P5_CVT(w.w, 1) * hf[13]; a2 += P5_CVT(w.w, 2) * hf[14]; b2 += P5_CVT(w.w, 3) * hf[15];
            a2 += b2;
            float a = (a2.x + a2.y) * scl;
            asm volatile("" : "+v"(a));
            sp[i] = a;
        }
        {
            float r8[8], r4[4], r2[2];
            { const bool hi = (q & 4) != 0;
#pragma unroll
              for (int k = 0; k < 8; ++k) { const float keep = hi ? sp[k + 8] : sp[k], send = hi ? sp[k] : sp[k + 8]; r8[k] = keep + __builtin_bit_cast(float, __builtin_amdgcn_update_dpp(0, __builtin_bit_cast(int, send), 0x141, 0xf, 0xf, false)); } }
            { const bool hi = (q & 2) != 0;
#pragma unroll
              for (int k = 0; k < 4; ++k) { const float keep = hi ? r8[k + 4] : r8[k], send = hi ? r8[k] : r8[k + 4]; r4[k] = keep + __builtin_bit_cast(float, __builtin_amdgcn_update_dpp(0, __builtin_bit_cast(int, send), 0x4E, 0xf, 0xf, false)); } }
            { const bool hi = (q & 1) != 0;
#pragma unroll
              for (int k = 0; k < 2; ++k) { const float keep = hi ? r4[k + 2] : r4[k], send = hi ? r4[k] : r4[k + 2]; r2[k] = keep + __builtin_bit_cast(float, __builtin_amdgcn_update_dpp(0, __builtin_bit_cast(int, send), 0xB1, 0xf, 0xf, false)); } }
            *(f32x2_t*)(PART + (size_t)t * 1024 + 2 * q) = (f32x2_t){r2[0], r2[1]};
        }
        { const float r2 = pqn;
#pragma unroll
          for (int j = 0; j < 8; ++j) { const u32x2 a = xn[j];
              hf[2 * j] = (f32x2_t){bflo(a.x) * r2 + sh[j][0], bfhi(a.x) * r2 + sh[j][1]}; hf[2 * j + 1] = (f32x2_t){bflo(a.y) * r2 + sh[j][2], bfhi(a.y) * r2 + sh[j][3]}; }
        }
    };
    for (int n = 0; n < 64; n += 2) { tok(ec, en, n); tok(en, ec, n + 1); }
}
__device__ __forceinline__ void ph_peer_s(const Params& p, int gwave, int gnw, int lane) {
    for (int t = gwave; t < T; t += gnw) {
        const float* pp = (const float*)(p.ws + WS_PART) + (size_t)t * 1024 + lane * 2; float* gp = (float*)(p.ws + WS_GATE) + (size_t)t * 128 + lane * 2;
        f32x2_t s = *(const f32x2_t*)pp;
#pragma unroll
        for (int x = 1; x < 8; ++x) s += *(const f32x2_t*)(pp + x * 128);
        const f32x2_t gt = *(const f32x2_t*)gp;
        *(f32x2_t*)gp = (f32x2_t){0.5f * s.x * (1.f + erff(s.x * 0.70710678118654752f)) * gt.x, 0.5f * s.y * (1.f + erff(s.y * 0.70710678118654752f)) * gt.y};
    }
}
template <int PV> __device__ __forceinline__ void ph_peer_v(const Params& p, LAS unsigned char* ldsl, int bid, int wave, int lane) {
    const int x = bid & 7, r = (bid >> 3) * NWAVES + wave, g = lane >> 3, q = lane & 7, col = 256 * g + 32 * x + 4 * q;
    const unsigned char* TD = p.ws + WS_V4D + (size_t)x * P5_DSL; const unsigned q16 = q * 16; const LAS unsigned char* SC = ldsl + q;
    const unsigned* IDX = (const unsigned*)(p.ws + WS_IDX) + g * 16; const unsigned* CF = (const unsigned*)(p.ws + WS_GATE) + g * 16;
    unsigned ec[16], en[16], cc[16], cn[16]; u32x4 wq[PD]; unsigned sb;
    if constexpr (PV == 2) {
#pragma unroll
        for (int i = 0; i < PD; ++i) { wq[i] = (u32x4){0x12345678u + lane, 0x9abcdef0u, 0x13572468u, 0x2468ace0u}; asm volatile("" : "+v"(wq[i])); } }
    P5_LOAD16(ec, IDX + (size_t)r * 128); P5_LOAD16(cc, CF + (size_t)r * 128);
#pragma unroll
    for (int i = 0; i < PD; ++i) P5_ISSUE(i, ec[i]);
    P5_TABLE(WS_V4S);
    sb = P5_SCB(ec[0]);
    f32x4 ga = {0.f, 0.f, 0.f, 0.f}, rs = ga;
    auto tok = [&](unsigned (&ec)[16], unsigned (&en)[16], unsigned (&cc)[16], unsigned (&cn)[16], const int n) __attribute__((always_inline)) {
        const int t = r + 256 * n, tn = r + 256 * min(n + 1, 63), b = n >> 3;
        P5_LOAD16(en, IDX + (size_t)tn * 128); P5_LOAD16(cn, CF + (size_t)tn * 128);
        const u32x2 xm = *(const u32x2*)((const bf16_t*)(p.ws + WS_X1M) + (size_t)t * DM + col);
        if ((n & 7) == 0) {
            ga = *(const f32x4*)((const float*)(p.ws + WS_MOD) + (size_t)b * 6 * DM + 5 * DM + col); const f32x4 sc = *(const f32x4*)((const float*)(p.ws + WS_MOD) + (size_t)b * 6 * DM + 4 * DM + col);
            rs = (f32x4){__builtin_amdgcn_rcpf(1.f + sc.x), __builtin_amdgcn_rcpf(1.f + sc.y), __builtin_amdgcn_rcpf(1.f + sc.z), __builtin_amdgcn_rcpf(1.f + sc.w)}; }
        f32x2_t out[16];
#pragma unroll
        for (int i = 0; i < 16; ++i) {
            __builtin_amdgcn_sched_barrier(0);
            u32x4 w = wq[i % PD]; if constexpr (PV == 2) asm volatile("" : "+v"(w));
            if (i + PD < 16) P5_ISSUE(i % PD, ec[(i + PD) & 15]); else P5_ISSUE(i % PD, en[(i + PD) & 15]);
            const unsigned sbn = P5_SCB((i < 15) ? ec[(i + 1) & 15] : en[0]);
            const float a = __builtin_bit_cast(float, cc[i]) * P5_SCALE(sb); sb = sbn;
            f32x2_t aa = (f32x2_t){a, a}; asm volatile("" : "+v"(aa));
            if (i == 0) {
                out[0] = aa * P5_CVT(w.x, 0); out[1] = aa * P5_CVT(w.x, 1); out[2] = aa * P5_CVT(w.x, 2); out[3] = aa * P5_CVT(w.x, 3);
                out[4] = aa * P5_CVT(w.y, 0); out[5] = aa * P5_CVT(w.y, 1); out[6] = aa * P5_CVT(w.y, 2); out[7] = aa * P5_CVT(w.y, 3);
                out[8] = aa * P5_CVT(w.z, 0); out[9] = aa * P5_CVT(w.z, 1); out[10] = aa * P5_CVT(w.z, 2); out[11] = aa * P5_CVT(w.z, 3);
                out[12] = aa * P5_CVT(w.w, 0); out[13] = aa * P5_CVT(w.w, 1); out[14] = aa * P5_CVT(w.w, 2); out[15] = aa * P5_CVT(w.w, 3);
            } else {
            out[0] += aa * P5_CVT(w.x, 0); out[1] += aa * P5_CVT(w.x, 1); out[2] += aa * P5_CVT(w.x, 2); out[3] += aa * P5_CVT(w.x, 3);
            out[4] += aa * P5_CVT(w.y, 0); out[5] += aa * P5_CVT(w.y, 1); out[6] += aa * P5_CVT(w.y, 2); out[7] += aa * P5_CVT(w.y, 3);
            asm volatile("" : "+v"(out[0]), "+v"(out[1]), "+v"(out[2]), "+v"(out[3]), "+v"(out[4]), "+v"(out[5]), "+v"(out[6]), "+v"(out[7]));
            out[8] += aa * P5_CVT(w.z, 0); out[9] += aa * P5_CVT(w.z, 1); out[10] += aa * P5_CVT(w.z, 2); out[11] += aa * P5_CVT(w.z, 3);
            out[12] += aa * P5_CVT(w.w, 0); out[13] += aa * P5_CVT(w.w, 1); out[14] += aa * P5_CVT(w.w, 2); out[15] += aa * P5_CVT(w.w, 3);
            asm volatile("" : "+v"(out[8]), "+v"(out[9]), "+v"(out[10]), "+v"(out[11]), "+v"(out[12]), "+v"(out[13]), "+v"(out[14]), "+v"(out[15]));
            }
        }
        f32x2_t o8[8], o4[4], o2[2];
#define P5_SW(fn, a_, b_, d_) do { float x_ = a_, y_ = b_; asm volatile("s_nop 1\n\t" fn " %0, %1" : "+v"(x_), "+v"(y_)); d_ = x_ + y_; } while (0)
#pragma unroll
        for (int k = 0; k < 8; ++k) { P5_SW("v_permlane32_swap_b32", out[k].x, out[k + 8].x, o8[k].x); P5_SW("v_permlane32_swap_b32", out[k].y, out[k + 8].y, o8[k].y); }
#pragma unroll
        for (int k = 0; k < 4; ++k) { P5_SW("v_permlane16_swap_b32", o8[k].x, o8[k + 4].x, o4[k].x); P5_SW("v_permlane16_swap_b32", o8[k].y, o8[k + 4].y, o4[k].y); }
#undef P5_SW
        { const bool hi = (lane & 8) != 0;
#pragma unroll
          for (int k = 0; k < 2; ++k) { const f32x2_t keep = hi ? o4[k + 2] : o4[k], send = hi ? o4[k] : o4[k + 2]; o2[k] = keep + (f32x2_t){__shfl_xor(send.x, 8), __shfl_xor(send.y, 8)}; } }
        *(f32x4*)(p.out + (size_t)t * DM + col) = (f32x4){bflo(xm.x) * rs.x + ga.x * o2[0].x, bfhi(xm.x) * rs.y + ga.y * o2[0].y, bflo(xm.y) * rs.z + ga.z * o2[1].x, bfhi(xm.y) * rs.w + ga.w * o2[1].y};
    };
    for (int n = 0; n < 64; n += 2) { tok(ec, en, cc, cn, n); tok(en, ec, cn, cc, n + 1); }
}
#undef P5_CVT
#undef P5_LOAD16
#undef P5_ISSUE
#undef P5_SCB
#undef P5_SCALE
#undef P5_TABLE
constexpr int RING_BYTES = 131072, LDSCTL_OFF = 146432, MISC_OFF = LDSCTL_OFF + 320, LDS_BYTES = 147456;
static_assert(SSD_SYNC + 64 <= LDSCTL_OFF, "SSD LDS map");
constexpr int NPH = 15;
#ifndef MK_PER_PHASE
#define MK_PER_PHASE 0
#endif

__global__ void __launch_bounds__(NTHR, 2) mega(Params p) {
    extern __shared__ __attribute__((aligned(16))) unsigned char lds[];
    LAS unsigned char* ldsl = (LAS unsigned char*)lds;
    const int tid = threadIdx.x, lane = tid & 63, wave = __builtin_amdgcn_readfirstlane(tid >> 6);
    const int G = gridDim.x, bid = blockIdx.x;
    unsigned char* ws = p.ws;
    gu32* ctl = (gu32*)(ws + WS_CTL);
    for (int u = tid; u < (LDS_BYTES - LDSCTL_OFF) / 4; u += NTHR) ((LAS unsigned*)(ldsl + LDSCTL_OFF))[u] = 0u;
    __syncthreads();
    volatile LAS unsigned* MISC = (volatile LAS unsigned*)(ldsl + MISC_OFF);
    XcdBarrier bar; bar.bar = (unsigned*)(ctl + CW_BAR); bar.x = 0; bar.st = nullptr;
    if (!MK_PER_PHASE) bar = xcd_barrier_post((unsigned*)(ctl + CW_BAR), MISC + 8);
#define IN(k) (p.ph_lo <= (k) && (k) < p.ph_hi)
#define LN() ({ int l_ = lane; asm volatile("" : "+v"(l_)); l_; })
#define WV() ({ int w_ = wave; asm volatile("" : "+s"(w_)); w_; })
#define SEAM(k) do { if ((k) + 1 < p.ph_hi) xcd_barrier(bar); } while (0)
    const int gtid = bid * NTHR + tid, gn = G * NTHR, gwave = bid * NWAVES + wave, gnw = G * NWAVES;
    float* mod = (float*)(ws + WS_MOD);

    if (IN(0)) {
        if (bid < 96) ph_mod(p, lds, tid, bid);
        else ph_transposes(p, lds, WV(), LN(), (bid - 96) * NWAVES + wave, (G - 96) * NWAVES, 0, TR_N0 + TR_N1 + TR_N2);
        SEAM(0);
    }
    if (IN(1)) { ph_modrows(p.x, (bf16_t*)(ws + WS_H), mod, 0, 1, gwave, gnw, LN()); SEAM(1); }
    if (IN(2)) {
        pg8::Gemm g{(const bf16_t*)(ws + WS_H), (const bf16_t*)(ws + WS_WINT), T, NPROJ, DM, DM}; pg8::StaticOrder S; S.init(T, NPROJ, G, bid);
        pg8::EpiBf16<0> E{(bf16_t*)(ws + WS_PROJ), NPROJ, nullptr, 0, 0, 1.f};
        pg8::gemm_phase<pg8::EpiBf16<0>, pg8::StaticOrder, true, true>(ldsl, g, S, E);
        if (bid >= G / 2) { __syncthreads(); ph_transposes(p, lds, WV(), LN(), (bid - G / 2) * NWAVES + wave, (G / 2) * NWAVES, TR_N0 + TR_N1 + TR_N2, TR_TOTAL);
            const int gt2 = (bid - G / 2) * NTHR + tid, gn2 = (G / 2) * NTHR;
            ph_rope_tab(p, gt2, gn2); ph_convert(p.sub_keys, (bf16_t*)(ws + WS_SUBK), (size_t)8 * 2 * 128 * 128 / 4, gt2, gn2); }
        SEAM(2);
    }
    if (IN(3)) {
        { pg8::Gemm g{(const bf16_t*)(ws + WS_PROJ) + C_CQ, (const bf16_t*)(ws + WS_WUQT), T, NQ, 512, NPROJ}; pg8::StaticOrder S; S.init(T, NQ, G, bid);
          pg8::EpiBf16<0> E{(bf16_t*)(ws + WS_QRAW), NQ, nullptr, 0, 0, 1.f};
          pg8::gemm_phase<pg8::EpiBf16<0>, pg8::StaticOrder, true, true>(ldsl, g, S, E); }
        { pg8::Gemm g{(const bf16_t*)(ws + WS_PROJ) + C_CKV, (const bf16_t*)(ws + WS_WUKVT), T, NKV, 256, NPROJ}; pg8::SkewOrder S; S.init(T, NKV, G, bid);
          pg8::EpiBf16<0> E{(bf16_t*)(ws + WS_KVRAW), NKV, nullptr, 0, 0, 1.f};
          pg8::gemm_phase<pg8::EpiBf16<0>, pg8::SkewOrder, true, true>(ldsl, g, S, E); }
        SEAM(3);
    }
    if (IN(4)) { ph_qkv_post(p, gwave, gnw, LN()); ph_conv(p, gwave, gnw, LN()); ph_bias2(p, gwave, gnw, LN()); SEAM(4); }
    if (IN(5)) { ph_attn(p, ldsl, bid, G, WV(), LN()); ph_ssd(p, ldsl, bid, WV(), LN()); SEAM(5); }
    if (IN(8)) {
        pg8::Gemm g{(const bf16_t*)(ws + WS_MIXRAW), (const bf16_t*)(ws + WS_WOUTT), T, DM, DM, DM}; pg8::StaticOrder S; S.init(T, DM, G, bid);
        pg8::Unit u0, u1; S.next(0, u0); if (!S.next(1, u1)) u1 = u0;
        LAS float* kt = (LAS float*)(ldsl + RING_BYTES);
        { const int slot = tid >> 8, r = tid & 255, row = (slot ? u1.pm : u0.pm) * 256 + r;
          const f32x4* pa = (const f32x4*)((const float*)(ws + WS_PSQA) + (size_t)row * 8); const f32x4* ps = (const f32x4*)((const float*)(ws + WS_PSQS) + (size_t)row * 32);
          const f32x4 a0 = pa[0], a1 = pa[1]; float sa = ((a0[0] + a0[1]) + (a0[2] + a0[3])) + ((a1[0] + a1[1]) + (a1[2] + a1[3])), s0 = 0.f, s1 = 0.f;
#pragma unroll
          for (int q = 0; q < 4; ++q) { const f32x4 v = ps[q], w = ps[4 + q]; s0 += (v[0] + v[1]) + (v[2] + v[3]); s1 += (w[0] + w[1]) + (w[2] + w[3]); }
          const float ra = rsqrtf(sa * (1.f / 1024.f) + EPS), r0 = rsqrtf(s0 * (1.f / 512.f) + EPS), r1 = rsqrtf(s1 * (1.f / 512.f) + EPS);
          kt[tid * 4 + 0] = ra / r0; kt[tid * 4 + 1] = r0 / r1; kt[tid * 4 + 2] = r1; kt[tid * 4 + 3] = 0.f; }
        __syncthreads();
        pg8::EpiX1 E{p.x, mod, (bf16_t*)(ws + WS_X1M), (float*)(ws + WS_PSQX), DM, SEQ, kt, u0.pm};
        pg8::gemm_phase<pg8::EpiX1, pg8::StaticOrder, true, true>(ldsl, g, S, E);
        SEAM(8);
    }
    if (IN(10)) {
        pg8::Gemm g{(const bf16_t*)(ws + WS_X1M), (const bf16_t*)(ws + WS_WQT), T, DM, DM, DM}; pg8::StaticOrder S; S.init(T, DM, G, bid);
        pg8::Unit u0, u1; S.next(0, u0); if (!S.next(1, u1)) u1 = u0;
        LAS float* rt = (LAS float*)(ldsl + RING_BYTES);
        { const int slot = tid >> 8, r = tid & 255, row = (slot ? u1.pm : u0.pm) * 256 + r; const float* pq = (const float*)(ws + WS_PSQX) + row; float s_ = 0.f;
#pragma unroll
          for (int q = 0; q < 32; ++q) s_ += pq[(size_t)q * T];
          const float rv_ = rsqrtf(s_ * (1.f / DM) + EPS); rt[tid] = rv_; ((float*)(ws + WS_RINV2))[row] = rv_; }
        __syncthreads();
        pg8::EpiScaleBias E{(bf16_t*)(ws + WS_QP), DM, (const float*)(ws + WS_BIAS2), SEQ, rt, u0.pm};
        pg8::gemm_phase<pg8::EpiScaleBias, pg8::StaticOrder, true, true>(ldsl, g, S, E);
        SEAM(10);
    }
    if (IN(11)) { ph_route(p, ldsl, WV(), LN(), gwave, gnw); SEAM(11); }
    if (IN(12)) { ph_peer_u<0>(p, ldsl, bid, WV(), LN()); SEAM(12); }
    if (IN(13)) { ph_peer_s(p, gwave, gnw, LN()); SEAM(13); }
#ifdef PROBE_EMASK
    if (IN(14)) { if (p.emask == 2) ph_peer_v<2>(p, ldsl, bid, WV(), LN()); else if (p.emask == 8) ph_peer_v<8>(p, ldsl, bid, WV(), LN()); else ph_peer_v<0>(p, ldsl, bid, WV(), LN()); }
#else
    if (IN(14)) { ph_peer_v<0>(p, ldsl, bid, WV(), LN()); }
#endif
#ifdef PROBE_VALU
    if (IN(14)) {
        f32x2_t a0 = {1.f, 2.f}, a1 = a0, a2 = a0, a3 = a0; unsigned w = (unsigned)lane * 0x9E3779B9u; f32x2_t m = {1.0001f, 0.9999f};
        asm volatile("" : "+v"(w), "+v"(m));
        for (int i = 0; i < 400; ++i) {
#if PROBE_VALU == 1
#define PV4 "v_cvt_scalef32_pk_f32_fp4 %0, %4, 1.0\n v_cvt_scalef32_pk_f32_fp4 %1, %4, 1.0 op_sel:[1,0,0]\n v_cvt_scalef32_pk_f32_fp4 %2, %4, 1.0 op_sel:[0,1,0]\n v_cvt_scalef32_pk_f32_fp4 %3, %4, 1.0 op_sel:[1,1,0]\n"
            asm volatile(PV4 PV4 PV4 PV4 PV4 PV4 PV4 PV4 PV4 PV4 PV4 PV4 PV4 PV4 PV4 PV4 : "=&v"(a0), "=&v"(a1), "=&v"(a2), "=&v"(a3) : "v"(w));
#elif PROBE_VALU == 2
#define PV4 "v_pk_fma_f32 %0, %0, %4, %4\n v_pk_fma_f32 %1, %1, %4, %4\n v_pk_fma_f32 %2, %2, %4, %4\n v_pk_fma_f32 %3, %3, %4, %4\n"
            asm volatile(PV4 PV4 PV4 PV4 PV4 PV4 PV4 PV4 PV4 PV4 PV4 PV4 PV4 PV4 PV4 PV4 : "+v"(a0), "+v"(a1), "+v"(a2), "+v"(a3) : "v"(m));
#elif PROBE_VALU == 4
#define PV4 "v_pk_fma_f32 %0, %4, %5, %0\n v_pk_fma_f32 %1, %5, %6, %1\n v_pk_fma_f32 %2, %6, %4, %2\n v_pk_fma_f32 %3, %4, %6, %3\n"
            { f32x2_t m1 = m * 1.5f, m2 = m * 0.25f; asm volatile("" : "+v"(m1), "+v"(m2));
              asm volatile(PV4 PV4 PV4 PV4 PV4 PV4 PV4 PV4 PV4 PV4 PV4 PV4 PV4 PV4 PV4 PV4 : "+v"(a0), "+v"(a1), "+v"(a2), "+v"(a3) : "v"(m), "v"(m1), "v"(m2)); }
#elif PROBE_VALU == 5
#define PV4 "v_cvt_scalef32_pk_f32_fp4 %1, %4, 1.0\n v_pk_fma_f32 %0, %5, %1, %0\n v_cvt_scalef32_pk_f32_fp4 %1, %4, 1.0 op_sel:[1,0,0]\n v_pk_fma_f32 %0, %6, %1, %0\n"
            { f32x2_t m1 = m * 1.5f, m2 = m * 0.25f; asm volatile("" : "+v"(m1), "+v"(m2));
              asm volatile(PV4 PV4 PV4 PV4 PV4 PV4 PV4 PV4 PV4 PV4 PV4 PV4 PV4 PV4 PV4 PV4 : "+v"(a0), "=&v"(a1) : "v"(a2), "v"(a3), "v"(w), "v"(m1), "v"(m2)); }
#elif PROBE_VALU == 6
#define PV4 "v_cvt_scalef32_pk_f32_fp4 %1, %4, 1.0\n v_pk_fma_f32 %0, %5, %1, %0 op_sel_hi:[0,1,1]\n v_cvt_scalef32_pk_f32_fp4 %1, %4, 1.0 op_sel:[1,0,0]\n v_pk_fma_f32 %2, %5, %1, %2 op_sel_hi:[0,1,1]\n"
            { f32x2_t m1 = m * 1.5f; asm volatile("" : "+v"(m1));
              asm volatile(PV4 PV4 PV4 PV4 PV4 PV4 PV4 PV4 PV4 PV4 PV4 PV4 PV4 PV4 PV4 PV4 : "+v"(a0), "=&v"(a1), "+v"(a2) : "v"(a3), "v"(w), "v"(m1)); }
#else
#define PV4 "v_fma_f32 %0, %0, %4, %4\n v_fma_f32 %1, %1, %4, %4\n v_fma_f32 %2, %2, %4, %4\n v_fma_f32 %3, %3, %4, %4\n"
            { float b0 = a0.x, b1 = a1.x, b2 = a2.x, b3 = a3.x, mm = m.x;
              asm volatile(PV4 PV4 PV4 PV4 PV4 PV4 PV4 PV4 PV4 PV4 PV4 PV4 PV4 PV4 PV4 PV4 : "+v"(b0), "+v"(b1), "+v"(b2), "+v"(b3) : "v"(mm)); a0.x = b0; a1.x = b1; a2.x = b2; a3.x = b3; }
#endif
        }
    }
#endif
#undef IN
#undef SEAM
}

extern "C" void kernel_launch(void* const* d_in, const int* in_sizes, int n_in, void* d_out, int out_size, void* d_ws, size_t ws_size, hipStream_t stream) {
    static int grid = 0;
    if (grid == 0) {
        if (n_in != 24 || ws_size < WS_END) { fprintf(stderr, "kernel_launch: unexpected inputs / workspace (%d, %zu)\n", n_in, ws_size); grid = -1; return; }
        if (hipFuncSetAttribute((const void*)mega, hipFuncAttributeMaxDynamicSharedMemorySize, LDS_BYTES) != hipSuccess) { fprintf(stderr, "kernel_launch: hipFuncSetAttribute failed\n"); grid = -1; return; }
        (void)hipGetLastError();
        grid = 256;
    }
    if (grid < 0) return;
    (void)hipMemsetAsync((char*)d_ws + WS_CTL, 0, CTL_ZERO_BYTES, stream);
    Params p{};
    p.x = (const float*)d_in[0]; p.c = (const float*)d_in[1]; p.pos = (const int*)d_in[2]; p.w_ada = (const float*)d_in[3]; p.b_ada = (const float*)d_in[4];
    p.w_in = (const float*)d_in[5]; p.q_a_norm = (const float*)d_in[6]; p.w_uq = (const float*)d_in[7]; p.kv_a_norm = (const float*)d_in[8]; p.w_ukv = (const float*)d_in[9];
    p.q_norm = (const float*)d_in[10]; p.k_norm = (const float*)d_in[11]; p.attn_out_norm = (const float*)d_in[12]; p.conv_w = (const float*)d_in[13]; p.conv_b = (const float*)d_in[14];
    p.dt_bias = (const float*)d_in[15]; p.a_log = (const float*)d_in[16]; p.d_skip = (const float*)d_in[17]; p.ssd_norm = (const float*)d_in[18]; p.w_out = (const float*)d_in[19];
    p.w_query = (const float*)d_in[20]; p.sub_keys = (const float*)d_in[21]; p.u_exp = (const float*)d_in[22]; p.v_exp = (const float*)d_in[23];
    p.out = (float*)d_out; p.ws = (unsigned char*)d_ws;
#if MK_PER_PHASE
    for (int ph = 0; ph < NPH; ++ph) { p.ph_lo = ph; p.ph_hi = ph + 1; hipLaunchKernelGGL(mega, dim3(grid), dim3(NTHR), LDS_BYTES, stream, p); }
#elif defined(PROBE_SEQ)
    { const int seq[] = {PROBE_SEQ}; const int nl = (int)(sizeof(seq) / sizeof(int)) / 2;
      for (int li = 0; li < nl; ++li) { if (li) (void)hipMemsetAsync((char*)d_ws + WS_CTL, 0, CTL_ZERO_BYTES, stream);
          p.ph_lo = seq[2 * li]; p.ph_hi = seq[2 * li + 1];
#ifdef PROBE_EMASK
          p.emask = (li == 1) ? (PROBE_EMASK) : 0;
#endif
          hipLaunchKernelGGL(mega, dim3(grid), dim3(NTHR), LDS_BYTES, stream, p); } }
#else
    p.ph_lo = 0; p.ph_hi = NPH;
    hipLaunchKernelGGL(mega, dim3(grid), dim3(NTHR), LDS_BYTES, stream, p);
#endif
}
```
